# Optimizing an MI355X kernel written in HIP

```python
import jax, jax.numpy as jnp
from jax import lax
import numpy as np

D_MODEL = 1024
BATCH = 2
SEQ = 8192
DEPTH = 2

GRID_W = 64
CTX_LEN = 256
MIX_WIDTH = D_MODEL
ML_HEADS = 4
ML_WIDTH = MIX_WIDTH // 2
ML_V_DIM = ML_WIDTH // ML_HEADS
ML_QK_DIM = ML_V_DIM // 2
HG_WIDTH = MIX_WIDTH - ML_WIDTH
HG_EXPAND = 128
HG_HEADS = HG_WIDTH // HG_EXPAND
CHUNK = 64
CONV_K = 3
N_EXPERTS = 32
TOP_K = 4
D_EXPERT = D_MODEL
SWIGLU_LIMIT = 7.0
SWIGLU_ALPHA = 1.702
MOE_BLOCK = 256
EPS = 1e-6
IN_SPLITS = (2 * ML_HEADS * ML_QK_DIM, ML_WIDTH, ML_WIDTH, 4 * ML_HEADS, 2 * HG_WIDTH, HG_WIDTH, HG_WIDTH, HG_WIDTH)
IN_WIDTH = sum(IN_SPLITS)

kernel_name = 'hybrid_mlstm_hgrn2_moe_dit'


def rms_norm(x, g):
    xf = x.astype(jnp.float32)
    y = xf * lax.rsqrt(jnp.mean(xf * xf, axis=-1, keepdims=True) + EPS)
    return (y * g).astype(x.dtype)


def adaln(cond, w, b):
    mod = (jax.nn.silu(cond) @ w + b)[..., None, :]
    return jnp.split(mod, 6, axis=-1)


def modulate(h, shift, scale):
    return h * (1 + scale) + shift


def split_cols(p):
    return jnp.split(p, np.cumsum(IN_SPLITS)[:-1].tolist(), axis=-1)


def to_heads(t, n_heads):
    b, l, _ = t.shape
    return t.reshape(b, l, n_heads, -1).transpose(0, 2, 1, 3)


def from_heads(t):
    b, h, l, d = t.shape
    return t.transpose(0, 2, 1, 3).reshape(b, l, h * d)


def head_rms(h, g):
    h = h * lax.rsqrt(jnp.mean(h * h, axis=-1, keepdims=True) + EPS)
    return from_heads(h) * g


def grid_conv(t, w, width):
    b, l, ch = t.shape
    rows = l // width
    img = t.reshape(b, rows, width, ch)
    out = lax.conv_general_dilated(img, w[:, :, None, :], window_strides=(1, 1), padding='SAME',
                                   dimension_numbers=('NHWC', 'HWIO', 'NHWC'), feature_group_count=ch)
    return jax.nn.silu(out.reshape(b, l, ch))


def to_chunks(t):
    b, h, l = t.shape[:3]
    return jnp.moveaxis(t.reshape(b, h, l // CHUNK, CHUNK, *t.shape[3:]), 2, 0)


def from_chunks(t):
    t = jnp.moveaxis(t, 0, 2)
    b, h, nc, cl = t.shape[:4]
    return t.reshape(b, h, nc * cl, *t.shape[4:])


def mlstm_scan(q, k, v, ig, lf, state):
    tri = jnp.tril(jnp.ones((CHUNK, CHUNK), bool))

    def step(carry, inp):
        C, n, m = carry
        qc, kc, vc, ic, fc = inp
        b = jnp.cumsum(fc, axis=-1)
        a_inter = b + m[..., None]
        d = jnp.where(tri, b[..., :, None] - b[..., None, :] + ic[..., None, :], -jnp.inf)
        m_t = jnp.maximum(a_inter, d.max(-1))
        s = jnp.einsum('bhtd,bhsd->bhts', qc, kc) * jnp.exp(d - m_t[..., None])
        w_inter = jnp.exp(a_inter - m_t)
        num = s @ vc + w_inter[..., None] * jnp.einsum('bhtd,bhvd->bhtv', qc, C)
        den = s.sum(-1) + w_inter * jnp.einsum('bhtd,bhd->bht', qc, n)
        h = num / jnp.maximum(jnp.abs(den), jnp.exp(-m_t))[..., None]
        g = b[..., -1]
        e = g[..., None] - b + ic
        m_new = jnp.maximum(g + m, e.max(-1))
        we = jnp.exp(e - m_new[..., None])
        wc = jnp.exp(g + m - m_new)
        C = wc[..., None, None] * C + jnp.einsum('bhs,bhsv,bhsd->bhvd', we, vc, kc)
        n = wc[..., None] * n + jnp.einsum('bhs,bhsd->bhd', we, kc)
        return (C, n, m_new), h

    state, h = lax.scan(step, state, tuple(to_chunks(t) for t in (q, k, v, ig, lf)))
    return from_chunks(h), state


def hgrn2_scan(q, k, v, lf, S):
    tri = jnp.tril(jnp.ones((CHUNK, CHUNK), bool))[:, :, None]

    def step(S, inp):
        qc, kc, vc, fc = inp
        b = jnp.cumsum(fc, axis=2)
        decay = jnp.exp(jnp.where(tri, b[:, :, :, None, :] - b[:, :, None, :, :], -jnp.inf))
        a = jnp.einsum('bhtd,bhsd,bhtsd->bhts', qc, kc, decay)
        o = a @ vc + jnp.einsum('bhtd,bhdv->bhtv', qc * jnp.exp(b), S)
        g = b[:, :, -1:]
        S = jnp.exp(g[:, :, 0])[..., None] * S + jnp.einsum('bhsd,bhsv->bhdv', kc * jnp.exp(g - b), vc)
        return S, o

    S, o = lax.scan(step, S, tuple(to_chunks(t) for t in (q, k, v, lf)))
    return from_chunks(o), S


def bidirectional(scan_fn, ctx_fwd, ctx_bwd, lat_fwd, lat_bwd, state0):
    rev = lambda ts: tuple(jnp.flip(t, axis=2) for t in ts)
    hc_f, sc_f = scan_fn(*ctx_fwd, state0)
    hl_f, _ = scan_fn(*lat_fwd, sc_f)
    hc_b, sc_b = scan_fn(*rev(ctx_bwd), state0)
    hl_b, _ = scan_fn(*rev(lat_bwd), sc_b)
    return hc_f + jnp.flip(hc_b, axis=2), hl_f + jnp.flip(hl_b, axis=2)


def mlstm_prep(qk, v, gates, conv_w, gate_b, width):
    b, l, _ = v.shape
    qk = grid_conv(qk, conv_w, width).astype(jnp.float32)
    q, k = jnp.split(qk, 2, axis=-1)
    q = to_heads(q, ML_HEADS) * ML_QK_DIM ** -0.5
    k = to_heads(k, ML_HEADS)
    v = to_heads(v.astype(jnp.float32), ML_HEADS)
    g = (gates.astype(jnp.float32).reshape(b, l, 4, ML_HEADS) + gate_b).transpose(2, 0, 3, 1)
    fwd = (q, k, v, g[0], jax.nn.log_sigmoid(g[2]))
    bwd = (q, k, v, g[1], jax.nn.log_sigmoid(g[3]))
    return fwd, bwd


def mlstm_mixer(ctx_parts, lat_parts, conv_w, gate_b, norm_g):
    c_qk, c_v, c_o, c_g = ctx_parts
    l_qk, l_v, l_o, l_g = lat_parts
    c_fwd, c_bwd = mlstm_prep(c_qk, c_v, c_g, conv_w, gate_b, c_v.shape[1])
    l_fwd, l_bwd = mlstm_prep(l_qk, l_v, l_g, conv_w, gate_b, GRID_W)
    b = c_v.shape[0]
    state0 = (jnp.zeros((b, ML_HEADS, ML_V_DIM, ML_QK_DIM), jnp.float32),
              jnp.zeros((b, ML_HEADS, ML_QK_DIM), jnp.float32),
              jnp.zeros((b, ML_HEADS), jnp.float32))
    hc, hl = bidirectional(mlstm_scan, c_fwd, c_bwd, l_fwd, l_bwd, state0)
    yc = jax.nn.sigmoid(c_o.astype(jnp.float32)) * head_rms(hc, norm_g)
    yl = jax.nn.sigmoid(l_o.astype(jnp.float32)) * head_rms(hl, norm_g)
    return yc, yl


def hgrn2_prep(qi, ff, fb, conv_w, f_b, lb, width):
    qi = grid_conv(qi, conv_w, width).astype(jnp.float32)
    q, i = jnp.split(qi, 2, axis=-1)
    q = to_heads(q, HG_HEADS)
    v = to_heads(i, HG_HEADS)

    def forget(pre, bias):
        return to_heads(lb + (1 - lb) * jax.nn.sigmoid(pre.astype(jnp.float32) + bias), HG_HEADS)

    f_fwd = forget(ff, f_b[0])
    f_bwd = forget(fb, f_b[1])
    return (q, 1 - f_fwd, v, jnp.log(f_fwd)), (q, 1 - f_bwd, v, jnp.log(f_bwd))


def hgrn2_mixer(ctx_parts, lat_parts, conv_w, f_b, lb, norm_g):
    c_qi, c_ff, c_fb, c_go = ctx_parts
    l_qi, l_ff, l_fb, l_go = lat_parts
    c_fwd, c_bwd = hgrn2_prep(c_qi, c_ff, c_fb, conv_w, f_b, lb, c_qi.shape[1])
    l_fwd, l_bwd = hgrn2_prep(l_qi, l_ff, l_fb, conv_w, f_b, lb, GRID_W)
    b = c_qi.shape[0]
    state0 = jnp.zeros((b, HG_HEADS, HG_EXPAND, HG_WIDTH // HG_HEADS), jnp.float32)
    hc, hl = bidirectional(hgrn2_scan, c_fwd, c_bwd, l_fwd, l_bwd, state0)
    yc = jax.nn.silu(c_go.astype(jnp.float32)) * head_rms(hc, norm_g)
    yl = jax.nn.silu(l_go.astype(jnp.float32)) * head_rms(hl, norm_g)
    return yc, yl


def moe_ffn(h, router_w, router_b, w_gu, b_gu, w_down, b_down):
    t, d = h.shape
    logits = (h @ router_w + router_b).astype(jnp.float32)
    top_val, top_idx = lax.top_k(logits, TOP_K)
    gates = jax.nn.softmax(top_val, axis=-1)
    n = t * TOP_K
    n_blocks = -(-n // MOE_BLOCK) + N_EXPERTS
    flat_e = top_idx.reshape(-1)
    flat_tok = jnp.repeat(jnp.arange(t, dtype=jnp.int32), TOP_K)
    order = jnp.argsort(flat_e)
    sorted_e = flat_e[order]
    counts = jnp.bincount(flat_e, length=N_EXPERTS)
    padded = (counts + MOE_BLOCK - 1) // MOE_BLOCK * MOE_BLOCK
    start = jnp.cumsum(counts) - counts
    padded_end = jnp.cumsum(padded)
    pad_start = padded_end - padded
    dest = pad_start[sorted_e] + jnp.arange(n) - start[sorted_e]
    slot_tok = jnp.full((n_blocks * MOE_BLOCK,), t, jnp.int32).at[dest].set(flat_tok[order])
    slot_gate = jnp.zeros((n_blocks * MOE_BLOCK,), jnp.float32).at[dest].set(gates.reshape(-1)[order])
    block_e = jnp.minimum(jnp.searchsorted(padded_end, jnp.arange(n_blocks) * MOE_BLOCK, side='right'), N_EXPERTS - 1)
    h_pad = jnp.concatenate([h, jnp.zeros((1, d), h.dtype)], axis=0)
    xb = h_pad[slot_tok].reshape(n_blocks, MOE_BLOCK, d)

    def expert_block(args):
        xe, e = args
        gu = xe @ w_gu[e] + b_gu[e]
        glu, lin = jnp.split(gu, 2, axis=-1)
        glu = jnp.minimum(glu, SWIGLU_LIMIT)
        lin = jnp.clip(lin, -SWIGLU_LIMIT, SWIGLU_LIMIT)
        return (glu * jax.nn.sigmoid(SWIGLU_ALPHA * glu) * (lin + 1)) @ w_down[e] + b_down[e]

    yb = lax.map(expert_block, (xb, block_e)).reshape(n_blocks * MOE_BLOCK, d)
    out = jnp.zeros_like(h_pad).at[slot_tok].add(yb * slot_gate[:, None].astype(yb.dtype))
    return out[:t]


def setup_inputs(seed: int = 0) -> dict:
    key = jax.random.key(seed)
    ks = jax.random.split(key, 28)
    nrm = lambda k, shape, scale: jax.random.normal(k, shape, jnp.float32) * scale
    D = D_MODEL
    mlstm_gate_b = jnp.concatenate([
        nrm(ks[9], (DEPTH, 2, ML_HEADS), 0.1),
        jnp.linspace(3.0, 6.0, ML_HEADS) + nrm(ks[10], (DEPTH, 2, ML_HEADS), 0.1)], axis=1)
    return {
        'x': nrm(ks[0], (BATCH, SEQ, D), 1.0),
        'c': nrm(ks[1], (BATCH, D), 1.0),
        'ctx': nrm(ks[2], (BATCH, CTX_LEN, D), 1.0),
        'c_ctx': nrm(ks[3], (D,), 1.0),
        'w_ada': nrm(ks[4], (DEPTH, D, 6 * D), 0.5 * D ** -0.5),
        'b_ada': nrm(ks[5], (DEPTH, 6 * D), 0.02),
        'norm1_g': 1.0 + nrm(ks[6], (DEPTH, D), 0.02),
        'w_in': nrm(ks[7], (DEPTH, D, IN_WIDTH), D ** -0.5),
        'mlstm_conv': nrm(ks[8], (DEPTH, CONV_K, CONV_K, 2 * ML_HEADS * ML_QK_DIM), 1.0 / CONV_K),
        'mlstm_gate_b': mlstm_gate_b,
        'mlstm_norm_g': 1.0 + nrm(ks[11], (DEPTH, ML_WIDTH), 0.02),
        'hgrn_conv': nrm(ks[12], (DEPTH, CONV_K, CONV_K, 2 * HG_WIDTH), 1.0 / CONV_K),
        'hgrn_f_b': 1.0 + nrm(ks[13], (DEPTH, 2, HG_WIDTH), 0.5),
        'hgrn_lb_raw': nrm(ks[14], (DEPTH, HG_WIDTH), 0.5),
        'hgrn_norm_g': 1.0 + nrm(ks[15], (DEPTH, HG_WIDTH), 0.02),
        'w_out': nrm(ks[16], (DEPTH, MIX_WIDTH, D), MIX_WIDTH ** -0.5),
        'norm2_g': 1.0 + nrm(ks[17], (DEPTH, D), 0.02),
        'router_w': nrm(ks[18], (DEPTH, D, N_EXPERTS), D ** -0.5),
        'router_b': nrm(ks[19], (DEPTH, N_EXPERTS), 0.01),
        'w_gu': nrm(ks[20], (DEPTH, N_EXPERTS, D, 2 * D_EXPERT), D ** -0.5),
        'b_gu': nrm(ks[21], (DEPTH, N_EXPERTS, 2 * D_EXPERT), 0.02),
        'w_down': nrm(ks[22], (DEPTH, N_EXPERTS, D_EXPERT, D), D_EXPERT ** -0.5),
        'b_down': nrm(ks[23], (DEPTH, N_EXPERTS, D), 0.02),
        'final_g': 1.0 + nrm(ks[24], (D,), 0.02),
    }


def reference(x, c, ctx, c_ctx, w_ada, b_ada, norm1_g, w_in, mlstm_conv, mlstm_gate_b, mlstm_norm_g,
              hgrn_conv, hgrn_f_b, hgrn_lb_raw, hgrn_norm_g, w_out, norm2_g, router_w, router_b,
              w_gu, b_gu, w_down, b_down, final_g):
    bsz, seq, d = x.shape
    ctx_len = ctx.shape[1]
    lb_w = jax.nn.softmax(hgrn_lb_raw.astype(jnp.float32), axis=0)
    lower_bounds = jnp.cumsum(lb_w, axis=0) - lb_w[0]
    for l in range(DEPTH):
        last = l == DEPTH - 1
        sh1, sc1, g1, sh2, sc2, g2 = adaln(c, w_ada[l], b_ada[l])
        csh1, csc1, cg1, csh2, csc2, cg2 = adaln(c_ctx, w_ada[l], b_ada[l])
        pl = split_cols(modulate(rms_norm(x, norm1_g[l]), sh1, sc1) @ w_in[l])
        pc = split_cols(modulate(rms_norm(ctx, norm1_g[l]), csh1, csc1) @ w_in[l])
        yc_ml, yl_ml = mlstm_mixer(pc[:4], pl[:4], mlstm_conv[l], mlstm_gate_b[l], mlstm_norm_g[l])
        yc_hg, yl_hg = hgrn2_mixer(pc[4:], pl[4:], hgrn_conv[l], hgrn_f_b[l], lower_bounds[l], hgrn_norm_g[l])
        x = x + g1 * (jnp.concatenate([yl_ml, yl_hg], axis=-1).astype(x.dtype) @ w_out[l])
        hl2 = modulate(rms_norm(x, norm2_g[l]), sh2, sc2).reshape(bsz * seq, d)
        if last:
            x = x + g2 * moe_ffn(hl2, router_w[l], router_b[l], w_gu[l], b_gu[l], w_down[l], b_down[l]).reshape(x.shape)
        else:
            ctx = ctx + cg1 * (jnp.concatenate([yc_ml, yc_hg], axis=-1).astype(ctx.dtype) @ w_out[l])
            hc2 = modulate(rms_norm(ctx, norm2_g[l]), csh2, csc2).reshape(bsz * ctx_len, d)
            f = moe_ffn(jnp.concatenate([hc2, hl2], axis=0), router_w[l], router_b[l], w_gu[l], b_gu[l], w_down[l], b_down[l])
            ctx = ctx + cg2 * f[:bsz * ctx_len].reshape(ctx.shape)
            x = x + g2 * f[bsz * ctx_len:].reshape(x.shape)
    return rms_norm(x, final_g)
```

```cpp
#include <hip/hip_runtime.h>
#include <cstdio>
#include <cstdint>

#define GAS __attribute__((address_space(1)))
#define LAS __attribute__((address_space(3)))
typedef unsigned short bf16;
typedef float f32x4 __attribute__((ext_vector_type(4)));
typedef unsigned u32x4 __attribute__((ext_vector_type(4)));
typedef unsigned u32x2 __attribute__((ext_vector_type(2)));

constexpr int D = 1024, BATCH = 2, SEQ = 8192, DEPTH = 2, CTX = 256, GRIDW = 64;
constexpr int NLAT = BATCH * SEQ, NCTX = BATCH * CTX, NTOK = NLAT + NCTX;
constexpr int INW = 4112, PW = 4096;
constexpr int PC_QK = 0, PC_V = 512, PC_O = 1024, PC_QI = 1536, PC_FF = 2560, PC_FB = 3072, PC_GO = 3584;
constexpr int NEXP = 32, TOPK = 4, DEXP = 1024;
constexpr int MAXSLOT = (NTOK * TOPK / 256 + NEXP) * 256;
constexpr int MAXTILE = MAXSLOT / 256;
constexpr float EPS = 1e-6f;

constexpr size_t MiB = 1u << 20;
constexpr size_t WS_CTL = 0;
constexpr size_t WS_MOD = 1 * MiB;
constexpr size_t WS_GATES = 2 * MiB;
constexpr size_t WS_ROUTE = 4 * MiB;
constexpr size_t WS_X = 8 * MiB;
constexpr size_t WS_H = 76 * MiB;
constexpr size_t WS_P = 112 * MiB;
constexpr size_t WS_CQK = 246 * MiB;
constexpr size_t WS_CQI = 264 * MiB;
constexpr size_t WS_HF = 300 * MiB;
constexpr size_t WS_HB = 368 * MiB;
constexpr size_t WS_Y = 436 * MiB;
constexpr size_t WS_ACT = 472 * MiB;
constexpr size_t WS_YS = 622 * MiB;
constexpr size_t WS_END = 772 * MiB;
constexpr int RT_TOPI = 0;
constexpr int RT_TOPG = RT_TOPI + NTOK * 4;
constexpr int RT_POS = RT_TOPG + NTOK * 4;
constexpr int RT_SLOT = RT_POS + NTOK * 4;
constexpr int RT_LIST = RT_SLOT + NTOK * 4;
constexpr int RT_SGATE = RT_LIST + MAXSLOT;
constexpr int RT_TILEE = RT_SGATE + MAXSLOT;
constexpr int RT_END = RT_TILEE + MAXTILE + 8;
static_assert((size_t)RT_END * 4 <= 4 * MiB, "route map");
constexpr int CW_CNT = 1024;
constexpr int CW_BAR = 4096;

__device__ __forceinline__ unsigned f2bf(float f) { unsigned u = __builtin_bit_cast(unsigned, f); return (u + 0x7fffu + ((u >> 16) & 1u)) >> 16; }
__device__ __forceinline__ unsigned pk2(float lo, float hi) { return f2bf(lo) | (f2bf(hi) << 16); }
__device__ __forceinline__ float bf2f(unsigned short b) { return __builtin_bit_cast(float, (unsigned)b << 16); }
__device__ __forceinline__ float bflo(unsigned w) { return __builtin_bit_cast(float, w << 16); }
__device__ __forceinline__ float bfhi(unsigned w) { return __builtin_bit_cast(float, w & 0xffff0000u); }
__device__ __forceinline__ float sigmoidf_(float x) { return 1.f / (1.f + __expf(-x)); }
__device__ __forceinline__ float siluf_(float x) { return x / (1.f + __expf(-x)); }
__device__ __forceinline__ float logsigmoidf_(float x) { return x >= 0.f ? -log1pf(__expf(-x)) : x - log1pf(__expf(x)); }
__device__ __forceinline__ float wave_sum(float v) {
#pragma unroll
    for (int o = 1; o < 64; o <<= 1) v += __shfl_xor(v, o);
    return v;
}
__device__ __forceinline__ int mrow_of(int r) { return r < NLAT ? (r >> 13) : 2; }

struct Args { const float* in[24]; float* out; unsigned char* ws; int ph_lo, ph_hi; };

enum { I_X = 0, I_C, I_CTX, I_CCTX, I_WADA, I_BADA, I_N1G, I_WIN, I_MLCONV, I_MLGB, I_MLNG, I_HGCONV, I_HGFB, I_HGLB, I_HGNG, I_WOUT, I_N2G, I_RW, I_RB, I_WGU, I_BGU, I_WDN, I_BDN, I_FG };

constexpr int NWAVES = 8, NTHR = 512;
constexpr int LDS_BYTES = 147456;

struct Frame {
    LAS unsigned char* lds;
    float* out; unsigned char* ws;
    int tid, lane, wave, vcu, G;
};

__device__ __forceinline__ void ph_init(Frame& F, const Args& A) {
    const int gt = F.vcu * NTHR + F.tid, NG = F.G * NTHR;
    const f32x4* xs = (const f32x4*)A.in[I_X]; const f32x4* cs = (const f32x4*)A.in[I_CTX]; f32x4* X = (f32x4*)(F.ws + WS_X);
    for (int i = gt; i < NLAT * 256; i += NG) X[i] = xs[i];
    for (int i = gt; i < NCTX * 256; i += NG) X[NLAT * 256 + i] = cs[i];
    if (gt < 128) ((u32x4*)(F.ws + WS_H + (size_t)NTOK * D * 2))[gt] = (u32x4){0u, 0u, 0u, 0u};
    LAS float* sc = (LAS float*)F.lds;
    LAS float* part = sc + 3 * 1024;
    for (int i = F.tid; i < 3 * 1024; i += NTHR) { const int r = i >> 10, k = i & 1023; const float c = r < 2 ? A.in[I_C][r * 1024 + k] : A.in[I_CCTX][k]; sc[i] = siluf_(c); }
    __syncthreads();
    for (int item = F.vcu; item < DEPTH * 96; item += F.G) {
        const int l = item / 96, j = (item % 96) * 64 + F.lane;
        const float* w = A.in[I_WADA] + (size_t)l * D * 6144 + j;
        float a0 = 0.f, a1 = 0.f, a2 = 0.f;
        for (int k = F.wave * 128; k < F.wave * 128 + 128; ++k) { const float wv = w[(size_t)k * 6144]; a0 += sc[k] * wv; a1 += sc[1024 + k] * wv; a2 += sc[2048 + k] * wv; }
        part[(F.wave * 3 + 0) * 64 + F.lane] = a0; part[(F.wave * 3 + 1) * 64 + F.lane] = a1; part[(F.wave * 3 + 2) * 64 + F.lane] = a2;
        __syncthreads();
        if (F.tid < 192) { const int r = F.tid >> 6, ln = F.tid & 63; float s = 0.f;
#pragma unroll
            for (int w8 = 0; w8 < 8; ++w8) s += part[(w8 * 3 + r) * 64 + ln];
            const int jj = (item % 96) * 64 + ln;
            ((float*)(F.ws + WS_MOD))[(l * 3 + r) * 6144 + jj] = s + A.in[I_BADA][l * 6144 + jj]; }
        __syncthreads();
    }
}

template <int MODE>
__device__ __forceinline__ void ph_norm(Frame& F, const Args& A, int l, int nrows) {
    constexpr int NV = MODE == 0 ? 16 : 32;
    LAS float* wl = (LAS float*)F.lds;
    if (MODE == 0) { const float* w = A.in[I_WIN] + (size_t)l * D * INW + 1536;
        for (int i = F.tid; i < 16 * 1024; i += NTHR) { const int k = i >> 4, g = i & 15; wl[g * 1024 + k] = w[(size_t)k * INW + g]; } __syncthreads(); }
    if (MODE == 1) { const float* w = A.in[I_RW] + (size_t)l * D * NEXP;
        for (int i = F.tid; i < 32 * 1024; i += NTHR) { const int k = i >> 5, g = i & 31; wl[g * 1024 + k] = w[(size_t)k * NEXP + g]; } __syncthreads(); }
    const float* X = (const float*)(F.ws + WS_X);
    const float* gam = MODE == 0 ? A.in[I_N1G] + l * D : (MODE == 1 ? A.in[I_N2G] + l * D : A.in[I_FG]);
    const float* MOD = (const float*)(F.ws + WS_MOD) + (size_t)l * 3 * 6144;
    for (int r = F.vcu * NWAVES + F.wave; r < nrows; r += F.G * NWAVES) {
        const f32x4* xr = (const f32x4*)(X + (size_t)r * D) + F.lane;
        f32x4 v[4]; float ss = 0.f;
#pragma unroll
        for (int j = 0; j < 4; ++j) { v[j] = xr[64 * j]; ss += (v[j].x * v[j].x + v[j].y * v[j].y) + (v[j].z * v[j].z + v[j].w * v[j].w); }
        const float rstd = rsqrtf(wave_sum(ss) * (1.f / D) + EPS);
        const float* mod = MOD + mrow_of(r) * 6144 + (MODE == 0 ? 0 : 3072);
#pragma unroll
        for (int j = 0; j < 4; ++j) { const int c = 256 * j + 4 * F.lane; const f32x4 g = *(const f32x4*)(gam + c);
            v[j] = v[j] * rstd * g;
            if (MODE != 2) { const f32x4 sh = *(const f32x4*)(mod + c), scl = *(const f32x4*)(mod + 1024 + c); v[j] = v[j] * (1.f + scl) + sh; } }
        if (MODE == 2) { f32x4* o = (f32x4*)(F.out + (size_t)r * D) + F.lane;
#pragma unroll
            for (int j = 0; j < 4; ++j) o[64 * j] = v[j];
            continue; }
        u32x2* ho = (u32x2*)(F.ws + WS_H + (size_t)r * D * 2) + F.lane;
#pragma unroll
        for (int j = 0; j < 4; ++j) ho[64 * j] = (u32x2){pk2(v[j].x, v[j].y), pk2(v[j].z, v[j].w)};
        float mine = 0.f;
#pragma unroll 2
        for (int g = 0; g < NV; ++g) { float a = 0.f;
#pragma unroll
            for (int j = 0; j < 4; ++j) { const f32x4 w = *(const LAS f32x4*)(wl + g * 1024 + 256 * j + 4 * F.lane); a += (v[j].x * w.x + v[j].y * w.y) + (v[j].z * w.z + v[j].w * w.w); }
            a = wave_sum(a); mine = (F.lane == g) ? a : mine; }
        if (MODE == 0) {
            if (F.lane < 16) { float val = mine + A.in[I_MLGB][l * 16 + F.lane];
                if (F.lane >= 8) val = logsigmoidf_(val);
                ((float*)(F.ws + WS_GATES))[(size_t)r * 16 + F.lane] = val; }
        } else {
            float lv = F.lane < 32 ? mine + A.in[I_RB][l * NEXP + (F.lane & 31)] : -INFINITY;
            float tv[4]; int ti[4];
#pragma unroll
            for (int p = 0; p < 4; ++p) { float best = lv;
#pragma unroll
                for (int o = 1; o < 64; o <<= 1) best = fmaxf(best, __shfl_xor(best, o));
                const unsigned long long bal = __ballot(lv == best); const int bi = __ffsll((long long)bal) - 1;
                tv[p] = best; ti[p] = bi; if (F.lane == bi) lv = -INFINITY; }
            const float e1 = __expf(tv[1] - tv[0]), e2 = __expf(tv[2] - tv[0]), e3 = __expf(tv[3] - tv[0]); const float inv = 1.f / (1.f + e1 + e2 + e3);
            if (F.lane == 0) {
                int* rt = (int*)(F.ws + WS_ROUTE); unsigned* cnt = (unsigned*)(F.ws + WS_CTL) + CW_CNT + 64 * l;
                const float gs[4] = {inv, e1 * inv, e2 * inv, e3 * inv};
#pragma unroll
                for (int p = 0; p < 4; ++p) { rt[RT_TOPI + r * 4 + p] = ti[p]; ((float*)rt)[RT_TOPG + r * 4 + p] = gs[p]; rt[RT_POS + r * 4 + p] = (int)atomicAdd(cnt + ti[p], 1u); }
            }
        }
    }
}

__device__ __forceinline__ void ph_lists(Frame& F, const Args& A, int l, int nrows) {
    LAS int* off = (LAS int*)F.lds;
    const unsigned* cnt = (const unsigned*)(F.ws + WS_CTL) + CW_CNT + 64 * l;
    int* rt = (int*)(F.ws + WS_ROUTE);
    if (F.tid == 0) { int o = 0; for (int e = 0; e < NEXP; ++e) { const int c = (int)__hip_atomic_load(cnt + e, __ATOMIC_RELAXED, __HIP_MEMORY_SCOPE_AGENT); off[e] = o; off[64 + e] = c; o += (c + 255) & ~255; } off[32] = o; }
    __syncthreads();
    const int gt = F.vcu * NTHR + F.tid, NG = F.G * NTHR;
    for (int i = gt; i < nrows * 4; i += NG) { const int e = rt[RT_TOPI + i], s = off[e] + rt[RT_POS + i]; rt[RT_SLOT + i] = s; rt[RT_LIST + s] = i >> 2; ((float*)rt)[RT_SGATE + s] = ((const float*)rt)[RT_TOPG + i]; }
    const int total = off[32];
    for (int s = gt; s < total; s += NG) { int e = 0;
#pragma unroll 1
        for (int q = 1; q < NEXP; ++q) if (s >= off[q]) e = q;
        if (s - off[e] >= off[64 + e]) { rt[RT_LIST + s] = NTOK; ((float*)rt)[RT_SGATE + s] = 0.f; }
        if ((s & 255) == 0) rt[RT_TILEE + 8 + (s >> 8)] = e; }
    if (gt == 0) rt[RT_TILEE] = total >> 8;
}

__device__ __forceinline__ void ph_conv(Frame& F, const Args& A, int l) {
    LAS float* cw = (LAS float*)F.lds;
    for (int i = F.tid; i < 9 * 1536; i += NTHR) { const int t = i / 1536, c = i % 1536; cw[i] = c < 512 ? A.in[I_MLCONV][(size_t)l * 9 * 512 + t * 512 + c] : A.in[I_HGCONV][(size_t)l * 9 * 1024 + t * 1024 + (c - 512)]; }
    __syncthreads();
    const bf16* P = (const bf16*)(F.ws + WS_P);
    const int gt = F.vcu * NTHR + F.tid, NG = F.G * NTHR;
    for (int it = gt; it < NTOK * 192; it += NG) {
        const int r = it / 192, cg = it % 192, c = cg * 8;
        const int pc = c < 512 ? PC_QK + c : PC_QI + (c - 512);
        float a[8] = {0.f, 0.f, 0.f, 0.f, 0.f, 0.f, 0.f, 0.f};
        int base, row, col, nrow, ncol;
        if (r < NLAT) { const int b = r >> 13, t = r & 8191; base = b << 13; row = t >> 6; col = t & 63; nrow = 128; ncol = 64; }
        else { const int q = r - NLAT, b = q >> 8; base = NLAT + (b << 8); row = 0; col = q & 255; nrow = 1; ncol = 256; }
#pragma unroll
        for (int dy = -1; dy <= 1; ++dy)
#pragma unroll
            for (int dx = -1; dx <= 1; ++dx) {
                const int rr = row + dy, cc = col + dx;
                if (rr < 0 || rr >= nrow || cc < 0 || cc >= ncol) continue;
                const u32x4 pv = *(const u32x4*)(P + (size_t)(base + rr * ncol + cc) * PW + pc);
                const LAS float* w = cw + ((dy + 1) * 3 + (dx + 1)) * 1536 + c;
                a[0] += bflo(pv.x) * w[0]; a[1] += bfhi(pv.x) * w[1]; a[2] += bflo(pv.y) * w[2]; a[3] += bfhi(pv.y) * w[3];
                a[4] += bflo(pv.z) * w[4]; a[5] += bfhi(pv.z) * w[5]; a[6] += bflo(pv.w) * w[6]; a[7] += bfhi(pv.w) * w[7];
            }
        const float sc = c < 256 ? 0.125f : 1.f;
#pragma unroll
        for (int i = 0; i < 8; ++i) a[i] = siluf_(a[i]) * sc;
        const u32x4 o = (u32x4){pk2(a[0], a[1]), pk2(a[2], a[3]), pk2(a[4], a[5]), pk2(a[6], a[7])};
        if (c < 512) *(u32x4*)(F.ws + WS_CQK + ((size_t)r * 512 + c) * 2) = o; else *(u32x4*)(F.ws + WS_CQI + ((size_t)r * 1024 + (c - 512)) * 2) = o;
    }
}

__device__ __forceinline__ void ph_hnorm(Frame& F, const Args& A, int l, int nrows_lat_only) {
    const float* HF = (const float*)(F.ws + WS_HF); const float* HB = (const float*)(F.ws + WS_HB);
    const bf16* P = (const bf16*)(F.ws + WS_P);
    const int nrows = nrows_lat_only ? NLAT : NTOK;
    for (int r = F.vcu * NWAVES + F.wave; r < nrows; r += F.G * NWAVES) {
        u32x2* yo = (u32x2*)(F.ws + WS_Y + (size_t)r * D * 2) + F.lane;
#pragma unroll
        for (int j = 0; j < 4; ++j) {
            const int c = 256 * j + 4 * F.lane;
            f32x4 h = *(const f32x4*)(HF + (size_t)r * D + c) + *(const f32x4*)(HB + (size_t)r * D + c);
            float ss = (h.x * h.x + h.y * h.y) + (h.z * h.z + h.w * h.w);
#pragma unroll
            for (int o = 1; o < 32; o <<= 1) ss += __shfl_xor(ss, o);
            const float rstd = rsqrtf(ss * (1.f / 128.f) + EPS);
            const f32x4 g = c < 512 ? *(const f32x4*)(A.in[I_MLNG] + l * 512 + c) : *(const f32x4*)(A.in[I_HGNG] + l * 512 + (c - 512));
            const u32x2 gw = *(const u32x2*)(P + (size_t)r * PW + (c < 512 ? PC_O + c : PC_GO + (c - 512)));
            float ga[4] = {bflo(gw.x), bfhi(gw.x), bflo(gw.y), bfhi(gw.y)};
#pragma unroll
            for (int i = 0; i < 4; ++i) ga[i] = c < 512 ? sigmoidf_(ga[i]) : siluf_(ga[i]);
            h = h * rstd * g;
            yo[64 * j] = (u32x2){pk2(h.x * ga[0], h.y * ga[1]), pk2(h.z * ga[2], h.w * ga[3])};
        }
    }
}

__device__ __forceinline__ void ph_combine(Frame& F, const Args& A, int l, int nrows) {
    float* X = (float*)(F.ws + WS_X); const int* rt = (const int*)(F.ws + WS_ROUTE);
    const float* MOD = (const float*)(F.ws + WS_MOD) + (size_t)l * 3 * 6144;
    for (int r = F.vcu * NWAVES + F.wave; r < nrows; r += F.G * NWAVES) {
        const float* g2 = MOD + mrow_of(r) * 6144 + 5 * 1024;
        int s[4];
#pragma unroll
        for (int k = 0; k < 4; ++k) s[k] = rt[RT_SLOT + r * 4 + k];
#pragma unroll
        for (int j = 0; j < 4; ++j) { const int c = 256 * j + 4 * F.lane; f32x4 a = (f32x4){0.f, 0.f, 0.f, 0.f};
#pragma unroll
            for (int k = 0; k < 4; ++k) { const u32x2 w = *(const u32x2*)(F.ws + WS_YS + ((size_t)s[k] * D + c) * 2); a += (f32x4){bflo(w.x), bfhi(w.x), bflo(w.y), bfhi(w.y)}; }
            f32x4* xp = (f32x4*)(X + (size_t)r * D + c); *xp = *xp + *(const f32x4*)(g2 + c) * a; }
    }
}

enum { PH_INIT = 0, PH_NORM1, PH_INPROJ, PH_CONV, PH_SCAN, PH_HNORM, PH_OUTPROJ, PH_NORM2, PH_LISTS, PH_GU, PH_DOWN, PH_COMBINE, PH_FINAL };

__global__ void __launch_bounds__(NTHR, 2) fwd(Args a, int ph, int l) {
    extern __shared__ __attribute__((aligned(16))) unsigned char lds_raw[];
    Frame F; F.lds = (LAS unsigned char*)lds_raw; F.out = a.out; F.ws = a.ws;
    F.tid = threadIdx.x; F.lane = F.tid & 63; F.wave = __builtin_amdgcn_readfirstlane(F.tid >> 6);
    F.G = gridDim.x; { const int bx = blockIdx.x; F.vcu = (F.G % 8 == 0) ? (bx % 8) * (F.G / 8) + bx / 8 : bx; }
    const int nrows = (l == DEPTH - 1) ? NLAT : NTOK;
    switch (ph) {
        case PH_INIT: ph_init(F, a); break;
        case PH_NORM1: ph_norm<0>(F, a, l, NTOK); break;
        case PH_CONV: ph_conv(F, a, l); break;
        case PH_HNORM: ph_hnorm(F, a, l, l == DEPTH - 1); break;
        case PH_NORM2: ph_norm<1>(F, a, l, nrows); break;
        case PH_LISTS: ph_lists(F, a, l, nrows); break;
        case PH_COMBINE: ph_combine(F, a, l, nrows); break;
        case PH_FINAL: ph_norm<2>(F, a, 0, NLAT); break;
        default: break;
    }
}

template <int NB, class Epi>
__global__ void __launch_bounds__(256) naive_gemm(const bf16* A, int lda, const int* gather, const int* tile_e, int M, const float* B, size_t bexp, int ldb, int N, int K, int bshift_from, int bshift, int bgrp, Epi E) {
    __shared__ float As[16][68]; __shared__ float Bs[NB][16][68];
    const int m0 = blockIdx.y * 64, n0 = blockIdx.x * 64, tid = threadIdx.x, tx = tid & 15, ty = tid >> 4;
    int e = 0;
    if (tile_e) { const int nt = tile_e[0]; if (m0 >= nt * 256) return; e = tile_e[8 + (m0 >> 8)]; } else if (m0 >= M) return;
    const float* Bp = B + (size_t)e * bexp + (n0 + (n0 >= bshift_from ? bshift : 0));
    const int ar = tid >> 2, ak = (tid & 3) * 4; const int arow = gather ? gather[m0 + ar] : (m0 + ar);
    const bf16* Ap = A + (size_t)arow * lda + ak;
    const int bk = tid >> 4, bn = (tid & 15) * 4;
    float acc[NB][4][4];
#pragma unroll
    for (int g = 0; g < NB; ++g)
#pragma unroll
        for (int i = 0; i < 4; ++i)
#pragma unroll
            for (int j = 0; j < 4; ++j) acc[g][i][j] = 0.f;
    for (int k0 = 0; k0 < K; k0 += 16) {
        const u32x2 av = *(const u32x2*)(Ap + k0);
        As[ak + 0][ar] = bflo(av.x); As[ak + 1][ar] = bfhi(av.x); As[ak + 2][ar] = bflo(av.y); As[ak + 3][ar] = bfhi(av.y);
#pragma unroll
        for (int g = 0; g < NB; ++g) { const f32x4 bv = *(const f32x4*)(Bp + (size_t)(k0 + bk) * ldb + g * bgrp + bn); *(f32x4*)&Bs[g][bk][bn] = bv; }
        __syncthreads();
#pragma unroll
        for (int k = 0; k < 16; ++k) { const f32x4 a4 = *(const f32x4*)&As[k][ty * 4];
#pragma unroll
            for (int g = 0; g < NB; ++g) { const f32x4 b4 = *(const f32x4*)&Bs[g][k][tx * 4];
#pragma unroll
                for (int i = 0; i < 4; ++i) { acc[g][i][0] += a4[i] * b4[0]; acc[g][i][1] += a4[i] * b4[1]; acc[g][i][2] += a4[i] * b4[2]; acc[g][i][3] += a4[i] * b4[3]; } } }
        __syncthreads();
    }
#pragma unroll
    for (int i = 0; i < 4; ++i)
#pragma unroll
        for (int j = 0; j < 4; ++j) E(m0 + ty * 4 + i, n0 + tx * 4 + j, acc[0][i][j], NB == 2 ? acc[NB - 1][i][j] : 0.f, e);
}
struct EpiP { bf16* P; __device__ void operator()(int r, int c, float v, float, int) const { P[(size_t)r * PW + c] = (bf16)f2bf(v); } };
struct EpiOut { float* X; const float* MOD; __device__ void operator()(int r, int c, float v, float, int) const { X[(size_t)r * D + c] += MOD[mrow_of(r) * 6144 + 2048 + c] * v; } };
struct EpiGU { bf16* ACT; const float* bgu; __device__ void operator()(int r, int c, float g, float li, int e) const {
    g += bgu[(size_t)e * 2048 + c]; li += bgu[(size_t)e * 2048 + 1024 + c]; g = fminf(g, 7.f); li = fminf(fmaxf(li, -7.f), 7.f);
    ACT[(size_t)r * DEXP + c] = (bf16)f2bf(g * sigmoidf_(1.702f * g) * (li + 1.f)); } };
struct EpiDown { bf16* YS; const float* bdn; const float* sgate; __device__ void operator()(int r, int c, float v, float, int e) const { YS[(size_t)r * D + c] = (bf16)f2bf((v + bdn[(size_t)e * D + c]) * sgate[r]); } };

__global__ void __launch_bounds__(128) naive_mlstm(const bf16* CQK, const bf16* P, const float* GATES, float* HF, float* HB) {
    __shared__ float qs[8][64], ks[8][64];
    const int b = blockIdx.x >> 3, h = (blockIdx.x >> 1) & 3, dir = blockIdx.x & 1, tid = threadIdx.x;
    float C[64], n[64], m = 0.f;
#pragma unroll
    for (int d = 0; d < 64; ++d) { C[d] = 0.f; n[d] = 0.f; }
    float* OUT = dir ? HB : HF;
    for (int p0 = 0; p0 < CTX + SEQ; p0 += 8) {
        __syncthreads();
        { const int st = tid >> 4, pc = tid & 15, p = p0 + st; int row;
          if (p < CTX) row = NLAT + b * CTX + (dir ? CTX - 1 - p : p); else { const int q = p - CTX; row = b * SEQ + (dir ? SEQ - 1 - q : q); }
          const u32x4 w = *(const u32x4*)(CQK + (size_t)row * 512 + (pc < 8 ? h * 64 + pc * 8 : 256 + h * 64 + (pc - 8) * 8));
          float* dst = pc < 8 ? &qs[st][pc * 8] : &ks[st][(pc - 8) * 8];
          dst[0] = bflo(w.x); dst[1] = bfhi(w.x); dst[2] = bflo(w.y); dst[3] = bfhi(w.y); dst[4] = bflo(w.z); dst[5] = bfhi(w.z); dst[6] = bflo(w.w); dst[7] = bfhi(w.w); }
        __syncthreads();
        for (int st = 0; st < 8; ++st) {
            const int p = p0 + st; int row;
            if (p < CTX) row = NLAT + b * CTX + (dir ? CTX - 1 - p : p); else { const int q = p - CTX; row = b * SEQ + (dir ? SEQ - 1 - q : q); }
            const float ig = GATES[(size_t)row * 16 + dir * 4 + h], lf = GATES[(size_t)row * 16 + 8 + dir * 4 + h];
            const float v = bf2f(P[(size_t)row * PW + PC_V + h * 128 + tid]);
            const float mn = fmaxf(lf + m, ig), a = __expf(lf + m - mn), w = __expf(ig - mn), wv = w * v; m = mn;
            float num = 0.f, den = 0.f;
#pragma unroll
            for (int d = 0; d < 64; ++d) { const float kd = ks[st][d], qd = qs[st][d]; C[d] = a * C[d] + wv * kd; n[d] = a * n[d] + w * kd; num += C[d] * qd; den += n[d] * qd; }
            OUT[(size_t)row * D + h * 128 + tid] = num / fmaxf(fabsf(den), __expf(-mn));
        }
    }
}
__global__ void __launch_bounds__(128) naive_hgrn(const bf16* CQI, const bf16* P, const float* fb_l, const float* lbraw, int l, float* HF, float* HB) {
    __shared__ float fs[8][128], ks[8][128], qs[8][128];
    const int b = blockIdx.x >> 3, h = (blockIdx.x >> 1) & 3, dir = blockIdx.x & 1, tid = threadIdx.x, ch = h * 128 + tid;
    float S[128];
#pragma unroll
    for (int d = 0; d < 128; ++d) S[d] = 0.f;
    float lb = 0.f;
    if (l == 1) { const float r0 = lbraw[ch], r1 = lbraw[512 + ch], mx = fmaxf(r0, r1), e0 = __expf(r0 - mx), e1 = __expf(r1 - mx); lb = e1 / (e0 + e1); }
    const float bias = fb_l[dir * 512 + ch];
    float* OUT = dir ? HB : HF;
    for (int p0 = 0; p0 < CTX + SEQ; p0 += 8) {
        __syncthreads();
        float vv[8]; int rows[8];
#pragma unroll
        for (int st = 0; st < 8; ++st) { const int p = p0 + st; int row;
            if (p < CTX) row = NLAT + b * CTX + (dir ? CTX - 1 - p : p); else { const int q = p - CTX; row = b * SEQ + (dir ? SEQ - 1 - q : q); }
            rows[st] = row;
            const float z = bf2f(P[(size_t)row * PW + (dir ? PC_FB : PC_FF) + ch]) + bias;
            fs[st][tid] = lb + (1.f - lb) * sigmoidf_(z); ks[st][tid] = (1.f - lb) * sigmoidf_(-z);
            qs[st][tid] = bf2f(CQI[(size_t)row * 1024 + ch]); vv[st] = bf2f(CQI[(size_t)row * 1024 + 512 + ch]); }
        __syncthreads();
#pragma unroll
        for (int st = 0; st < 8; ++st) { float o = 0.f; const float v = vv[st];
#pragma unroll
            for (int d = 0; d < 128; ++d) { S[d] = fs[st][d] * S[d] + ks[st][d] * v; o += qs[st][d] * S[d]; }
            OUT[(size_t)rows[st] * D + 512 + ch] = o; }
    }
}

extern "C" void kernel_launch(void* const* d_in, const int* in_sizes, int n_in, void* d_out, int out_size, void* d_ws, size_t ws_size, hipStream_t stream) {
    static int grid = 0;
    if (grid == 0) {
        if (n_in != 24 || in_sizes[0] != NLAT * D || out_size != NLAT * D || ws_size < WS_END) { fprintf(stderr, "kernel_launch: unexpected shapes n_in %d in0 %d out %d ws %zu (need %zu)\n", n_in, n_in > 0 ? in_sizes[0] : -1, out_size, ws_size, (size_t)WS_END); grid = -1; return; }
        int dev = 0, cus = 0;
        if (hipGetDevice(&dev) != hipSuccess || hipDeviceGetAttribute(&cus, hipDeviceAttributeMultiprocessorCount, dev) != hipSuccess) { grid = -1; return; }
        if (hipFuncSetAttribute((const void*)fwd, hipFuncAttributeMaxDynamicSharedMemorySize, LDS_BYTES) != hipSuccess) { fprintf(stderr, "kernel_launch: hipFuncSetAttribute failed\n"); grid = -1; return; }
        grid = cus;
    }
    if (grid < 0) return;
    (void)hipMemsetAsync((char*)d_ws + WS_CTL, 0, 1 * MiB, stream);
    Args a{};
    for (int i = 0; i < 24; ++i) a.in[i] = (const float*)d_in[i];
    a.out = (float*)d_out; a.ws = (unsigned char*)d_ws; a.ph_lo = 0; a.ph_hi = 0;
    unsigned char* ws = (unsigned char*)d_ws;
    const float* const* in = a.in;
    int* rt = (int*)(ws + WS_ROUTE);
#define PHASE(ph, l) hipLaunchKernelGGL(fwd, dim3(grid), dim3(NTHR), LDS_BYTES, stream, a, (int)(ph), (int)(l))
    PHASE(PH_INIT, 0);
    for (int l = 0; l < DEPTH; ++l) {
        const int nrows = (l == DEPTH - 1) ? NLAT : NTOK;
        const float* MOD = (const float*)(ws + WS_MOD) + (size_t)l * 3 * 6144;
        PHASE(PH_NORM1, l);
        hipLaunchKernelGGL((naive_gemm<1, EpiP>), dim3(PW / 64, NTOK / 64), dim3(256), 0, stream, (const bf16*)(ws + WS_H), D, (const int*)nullptr, (const int*)nullptr, NTOK,
                           in[I_WIN] + (size_t)l * D * INW, (size_t)0, INW, PW, D, 1536, 16, 0, EpiP{(bf16*)(ws + WS_P)});
        PHASE(PH_CONV, l);
        hipLaunchKernelGGL(naive_mlstm, dim3(16), dim3(128), 0, stream, (const bf16*)(ws + WS_CQK), (const bf16*)(ws + WS_P), (const float*)(ws + WS_GATES), (float*)(ws + WS_HF), (float*)(ws + WS_HB));
        hipLaunchKernelGGL(naive_hgrn, dim3(16), dim3(128), 0, stream, (const bf16*)(ws + WS_CQI), (const bf16*)(ws + WS_P), in[I_HGFB] + (size_t)l * 1024, in[I_HGLB], l, (float*)(ws + WS_HF), (float*)(ws + WS_HB));
        PHASE(PH_HNORM, l);
        hipLaunchKernelGGL((naive_gemm<1, EpiOut>), dim3(D / 64, nrows / 64), dim3(256), 0, stream, (const bf16*)(ws + WS_Y), D, (const int*)nullptr, (const int*)nullptr, nrows,
                           in[I_WOUT] + (size_t)l * D * D, (size_t)0, D, D, D, 1 << 30, 0, 0, EpiOut{(float*)(ws + WS_X), MOD});
        PHASE(PH_NORM2, l);
        PHASE(PH_LISTS, l);
        hipLaunchKernelGGL((naive_gemm<2, EpiGU>), dim3(DEXP / 64, MAXSLOT / 64), dim3(256), 0, stream, (const bf16*)(ws + WS_H), D, (const int*)(rt + RT_LIST), (const int*)(rt + RT_TILEE), MAXSLOT,
                           in[I_WGU] + (size_t)l * NEXP * D * 2048, (size_t)D * 2048, 2048, DEXP, D, 1 << 30, 0, 1024, EpiGU{(bf16*)(ws + WS_ACT), in[I_BGU] + (size_t)l * NEXP * 2048});
        hipLaunchKernelGGL((naive_gemm<1, EpiDown>), dim3(D / 64, MAXSLOT / 64), dim3(256), 0, stream, (const bf16*)(ws + WS_ACT), DEXP, (const int*)nullptr, (const int*)(rt + RT_TILEE), MAXSLOT,
                           in[I_WDN] + (size_t)l * NEXP * DEXP * D, (size_t)DEXP * D, D, D, DEXP, 1 << 30, 0, 0, EpiDown{(bf16*)(ws + WS_YS), in[I_BDN] + (size_t)l * NEXP * D, (const float*)(rt + RT_SGATE)});
        PHASE(PH_COMBINE, l);
    }
    PHASE(PH_FINAL, 0);
#undef PHASE
}
```

```cpp
#include <hip/hip_runtime.h>
#include <cstdio>
#include <cstdint>

#define GAS __attribute__((address_space(1)))
#define LAS __attribute__((address_space(3)))
typedef unsigned short bf16;
typedef float f32x4 __attribute__((ext_vector_type(4)));
typedef unsigned u32x4 __attribute__((ext_vector_type(4)));
typedef unsigned u32x2 __attribute__((ext_vector_type(2)));

constexpr int D = 1024, BATCH = 2, SEQ = 8192, DEPTH = 2, CTX = 256, GRIDW = 64;
constexpr int NLAT = BATCH * SEQ, NCTX = BATCH * CTX, NTOK = NLAT + NCTX;
constexpr int INW = 4112, PW = 4096;
constexpr int PC_QK = 0, PC_V = 512, PC_O = 1024, PC_QI = 1536, PC_FF = 2560, PC_FB = 3072, PC_GO = 3584;
constexpr int NEXP = 32, TOPK = 4, DEXP = 1024;
constexpr int MAXSLOT = (NTOK * TOPK / 256 + NEXP) * 256;
constexpr int MAXTILE = MAXSLOT / 256;
constexpr float EPS = 1e-6f;

constexpr size_t MiB = 1u << 20;
constexpr size_t WS_CTL = 0;
constexpr size_t WS_MOD = 1 * MiB;
constexpr size_t WS_GATES = 2 * MiB;
constexpr size_t WS_ROUTE = 4 * MiB;
constexpr size_t WS_X = 8 * MiB;
constexpr size_t WS_H = 76 * MiB;
constexpr size_t WS_P = 112 * MiB;
constexpr size_t WS_CQK = 246 * MiB;
constexpr size_t WS_CQI = 264 * MiB;
constexpr size_t WS_HF = 300 * MiB;
constexpr size_t WS_HB = 368 * MiB;
constexpr size_t WS_Y = 436 * MiB;
constexpr size_t WS_ACT = 472 * MiB;
constexpr size_t WS_YS = 622 * MiB;
constexpr size_t WS_WIN = 772 * MiB;
constexpr size_t WS_WOUT = 788 * MiB;
constexpr size_t WS_WGU = 792 * MiB;
constexpr size_t WS_WDN = 1048 * MiB;
constexpr size_t WS_END = 1176 * MiB;
constexpr int RT_TOPI = 0;
constexpr int RT_TOPG = RT_TOPI + NTOK * 4;
constexpr int RT_POS = RT_TOPG + NTOK * 4;
constexpr int RT_SLOT = RT_POS + NTOK * 4;
constexpr int RT_LIST = RT_SLOT + NTOK * 4;
constexpr int RT_SGATE = RT_LIST + MAXSLOT;
constexpr int RT_TILEE = RT_SGATE + MAXSLOT;
constexpr int RT_END = RT_TILEE + MAXTILE + 8;
static_assert((size_t)RT_END * 4 <= 4 * MiB, "route map");
constexpr int CW_CNT = 1024;
constexpr int CW_BAR = 4096;

__device__ __forceinline__ unsigned f2bf(float f) { unsigned u = __builtin_bit_cast(unsigned, f); return (u + 0x7fffu + ((u >> 16) & 1u)) >> 16; }
__device__ __forceinline__ unsigned pk2(float lo, float hi) { return f2bf(lo) | (f2bf(hi) << 16); }
__device__ __forceinline__ float bf2f(unsigned short b) { return __builtin_bit_cast(float, (unsigned)b << 16); }
__device__ __forceinline__ float bflo(unsigned w) { return __builtin_bit_cast(float, w << 16); }
__device__ __forceinline__ float bfhi(unsigned w) { return __builtin_bit_cast(float, w & 0xffff0000u); }
__device__ __forceinline__ float sigmoidf_(float x) { return 1.f / (1.f + __expf(-x)); }
__device__ __forceinline__ float siluf_(float x) { return x / (1.f + __expf(-x)); }
__device__ __forceinline__ float logsigmoidf_(float x) { return x >= 0.f ? -log1pf(__expf(-x)) : x - log1pf(__expf(x)); }
__device__ __forceinline__ float wave_sum(float v) {
#pragma unroll
    for (int o = 1; o < 64; o <<= 1) v += __shfl_xor(v, o);
    return v;
}
__device__ __forceinline__ int mrow_of(int r) { return r < NLAT ? (r >> 13) : 2; }

struct Args { const float* in[24]; float* out; unsigned char* ws; int ph_lo, ph_hi; };

enum { I_X = 0, I_C, I_CTX, I_CCTX, I_WADA, I_BADA, I_N1G, I_WIN, I_MLCONV, I_MLGB, I_MLNG, I_HGCONV, I_HGFB, I_HGLB, I_HGNG, I_WOUT, I_N2G, I_RW, I_RB, I_WGU, I_BGU, I_WDN, I_BDN, I_FG };

constexpr int NWAVES = 8, NTHR = 512;
constexpr int LDS_BYTES = 147456;

struct Frame {
    LAS unsigned char* lds;
    float* out; unsigned char* ws;
    int tid, lane, wave, vcu, G;
};

__device__ __forceinline__ void ph_init(Frame& F, const Args& A) {
    const int gt = F.vcu * NTHR + F.tid, NG = F.G * NTHR;
    const f32x4* xs = (const f32x4*)A.in[I_X]; const f32x4* cs = (const f32x4*)A.in[I_CTX]; f32x4* X = (f32x4*)(F.ws + WS_X);
    for (int i = gt; i < NLAT * 256; i += NG) X[i] = xs[i];
    for (int i = gt; i < NCTX * 256; i += NG) X[NLAT * 256 + i] = cs[i];
    if (gt < 128) ((u32x4*)(F.ws + WS_H + (size_t)NTOK * D * 2))[gt] = (u32x4){0u, 0u, 0u, 0u};
    LAS float* sc = (LAS float*)F.lds;
    LAS float* part = sc + 3 * 1024;
    for (int i = F.tid; i < 3 * 1024; i += NTHR) { const int r = i >> 10, k = i & 1023; const float c = r < 2 ? A.in[I_C][r * 1024 + k] : A.in[I_CCTX][k]; sc[i] = siluf_(c); }
    __syncthreads();
    for (int item = F.vcu; item < DEPTH * 96; item += F.G) {
        const int l = item / 96, j = (item % 96) * 64 + F.lane;
        const float* w = A.in[I_WADA] + (size_t)l * D * 6144 + j;
        float a0 = 0.f, a1 = 0.f, a2 = 0.f;
        for (int k = F.wave * 128; k < F.wave * 128 + 128; ++k) { const float wv = w[(size_t)k * 6144]; a0 += sc[k] * wv; a1 += sc[1024 + k] * wv; a2 += sc[2048 + k] * wv; }
        part[(F.wave * 3 + 0) * 64 + F.lane] = a0; part[(F.wave * 3 + 1) * 64 + F.lane] = a1; part[(F.wave * 3 + 2) * 64 + F.lane] = a2;
        __syncthreads();
        if (F.tid < 192) { const int r = F.tid >> 6, ln = F.tid & 63; float s = 0.f;
#pragma unroll
            for (int w8 = 0; w8 < 8; ++w8) s += part[(w8 * 3 + r) * 64 + ln];
            const int jj = (item % 96) * 64 + ln;
            ((float*)(F.ws + WS_MOD))[(l * 3 + r) * 6144 + jj] = s + A.in[I_BADA][l * 6144 + jj]; }
        __syncthreads();
    }
}

template <int MODE>
__device__ __forceinline__ void ph_norm(Frame& F, const Args& A, int l, int nrows) {
    constexpr int NV = MODE == 0 ? 16 : 32;
    LAS float* wl = (LAS float*)F.lds;
    if (MODE == 0) { const float* w = A.in[I_WIN] + (size_t)l * D * INW + 1536;
        for (int i = F.tid; i < 16 * 1024; i += NTHR) { const int k = i >> 4, g = i & 15; wl[g * 1024 + k] = w[(size_t)k * INW + g]; } __syncthreads(); }
    if (MODE == 1) { const float* w = A.in[I_RW] + (size_t)l * D * NEXP;
        for (int i = F.tid; i < 32 * 1024; i += NTHR) { const int k = i >> 5, g = i & 31; wl[g * 1024 + k] = w[(size_t)k * NEXP + g]; } __syncthreads(); }
    const float* X = (const float*)(F.ws + WS_X);
    const float* gam = MODE == 0 ? A.in[I_N1G] + l * D : (MODE == 1 ? A.in[I_N2G] + l * D : A.in[I_FG]);
    const float* MOD = (const float*)(F.ws + WS_MOD) + (size_t)l * 3 * 6144;
    for (int r = F.vcu * NWAVES + F.wave; r < nrows; r += F.G * NWAVES) {
        const f32x4* xr = (const f32x4*)(X + (size_t)r * D) + F.lane;
        f32x4 v[4]; float ss = 0.f;
#pragma unroll
        for (int j = 0; j < 4; ++j) { v[j] = xr[64 * j]; ss += (v[j].x * v[j].x + v[j].y * v[j].y) + (v[j].z * v[j].z + v[j].w * v[j].w); }
        const float rstd = rsqrtf(wave_sum(ss) * (1.f / D) + EPS);
        const float* mod = MOD + mrow_of(r) * 6144 + (MODE == 0 ? 0 : 3072);
#pragma unroll
        for (int j = 0; j < 4; ++j) { const int c = 256 * j + 4 * F.lane; const f32x4 g = *(const f32x4*)(gam + c);
            v[j] = v[j] * rstd * g;
            if (MODE != 2) { const f32x4 sh = *(const f32x4*)(mod + c), scl = *(const f32x4*)(mod + 1024 + c); v[j] = v[j] * (1.f + scl) + sh; } }
        if (MODE == 2) { f32x4* o = (f32x4*)(F.out + (size_t)r * D) + F.lane;
#pragma unroll
            for (int j = 0; j < 4; ++j) o[64 * j] = v[j];
            continue; }
        u32x2* ho = (u32x2*)(F.ws + WS_H + (size_t)r * D * 2) + F.lane;
#pragma unroll
        for (int j = 0; j < 4; ++j) ho[64 * j] = (u32x2){pk2(v[j].x, v[j].y), pk2(v[j].z, v[j].w)};
        float mine = 0.f;
#pragma unroll 2
        for (int g = 0; g < NV; ++g) { float a = 0.f;
#pragma unroll
            for (int j = 0; j < 4; ++j) { const f32x4 w = *(const LAS f32x4*)(wl + g * 1024 + 256 * j + 4 * F.lane); a += (v[j].x * w.x + v[j].y * w.y) + (v[j].z * w.z + v[j].w * w.w); }
            a = wave_sum(a); mine = (F.lane == g) ? a : mine; }
        if (MODE == 0) {
            if (F.lane < 16) { float val = mine + A.in[I_MLGB][l * 16 + F.lane];
                if (F.lane >= 8) val = logsigmoidf_(val);
                ((float*)(F.ws + WS_GATES))[(size_t)r * 16 + F.lane] = val; }
        } else {
            float lv = F.lane < 32 ? mine + A.in[I_RB][l * NEXP + (F.lane & 31)] : -INFINITY;
            float tv[4]; int ti[4];
#pragma unroll
            for (int p = 0; p < 4; ++p) { float best = lv;
#pragma unroll
                for (int o = 1; o < 64; o <<= 1) best = fmaxf(best, __shfl_xor(best, o));
                const unsigned long long bal = __ballot(lv == best); const int bi = __ffsll((long long)bal) - 1;
                tv[p] = best; ti[p] = bi; if (F.lane == bi) lv = -INFINITY; }
            const float e1 = __expf(tv[1] - tv[0]), e2 = __expf(tv[2] - tv[0]), e3 = __expf(tv[3] - tv[0]); const float inv = 1.f / (1.f + e1 + e2 + e3);
            if (F.lane == 0) {
                int* rt = (int*)(F.ws + WS_ROUTE); unsigned* cnt = (unsigned*)(F.ws + WS_CTL) + CW_CNT + 64 * l;
                const float gs[4] = {inv, e1 * inv, e2 * inv, e3 * inv};
#pragma unroll
                for (int p = 0; p < 4; ++p) { rt[RT_TOPI + r * 4 + p] = ti[p]; ((float*)rt)[RT_TOPG + r * 4 + p] = gs[p]; rt[RT_POS + r * 4 + p] = (int)atomicAdd(cnt + ti[p], 1u); }
            }
        }
    }
}

__device__ __forceinline__ void ph_lists(Frame& F, const Args& A, int l, int nrows) {
    LAS int* off = (LAS int*)F.lds;
    const unsigned* cnt = (const unsigned*)(F.ws + WS_CTL) + CW_CNT + 64 * l;
    int* rt = (int*)(F.ws + WS_ROUTE);
    if (F.tid == 0) { int o = 0; for (int e = 0; e < NEXP; ++e) { const int c = (int)__hip_atomic_load(cnt + e, __ATOMIC_RELAXED, __HIP_MEMORY_SCOPE_AGENT); off[e] = o; off[64 + e] = c; o += (c + 255) & ~255; } off[32] = o; }
    __syncthreads();
    const int gt = F.vcu * NTHR + F.tid, NG = F.G * NTHR;
    for (int i = gt; i < nrows * 4; i += NG) { const int e = rt[RT_TOPI + i], s = off[e] + rt[RT_POS + i]; rt[RT_SLOT + i] = s; rt[RT_LIST + s] = i >> 2; ((float*)rt)[RT_SGATE + s] = ((const float*)rt)[RT_TOPG + i]; }
    const int total = off[32];
    for (int s = gt; s < total; s += NG) { int e = 0;
#pragma unroll 1
        for (int q = 1; q < NEXP; ++q) if (s >= off[q]) e = q;
        if (s - off[e] >= off[64 + e]) { rt[RT_LIST + s] = NTOK; ((float*)rt)[RT_SGATE + s] = 0.f; }
        if ((s & 255) == 0) rt[RT_TILEE + 8 + (s >> 8)] = e; }
    if (gt == 0) rt[RT_TILEE] = total >> 8;
}

__device__ __forceinline__ void ph_conv(Frame& F, const Args& A, int l) {
    LAS float* cw = (LAS float*)F.lds;
    for (int i = F.tid; i < 9 * 1536; i += NTHR) { const int t = i / 1536, c = i % 1536; cw[i] = c < 512 ? A.in[I_MLCONV][(size_t)l * 9 * 512 + t * 512 + c] : A.in[I_HGCONV][(size_t)l * 9 * 1024 + t * 1024 + (c - 512)]; }
    __syncthreads();
    const bf16* P = (const bf16*)(F.ws + WS_P);
    const int gt = F.vcu * NTHR + F.tid, NG = F.G * NTHR;
    for (int it = gt; it < NTOK * 192; it += NG) {
        const int r = it / 192, cg = it % 192, c = cg * 8;
        const int pc = c < 512 ? PC_QK + c : PC_QI + (c - 512);
        float a[8] = {0.f, 0.f, 0.f, 0.f, 0.f, 0.f, 0.f, 0.f};
        int base, row, col, nrow, ncol;
        if (r < NLAT) { const int b = r >> 13, t = r & 8191; base = b << 13; row = t >> 6; col = t & 63; nrow = 128; ncol = 64; }
        else { const int q = r - NLAT, b = q >> 8; base = NLAT + (b << 8); row = 0; col = q & 255; nrow = 1; ncol = 256; }
#pragma unroll
        for (int dy = -1; dy <= 1; ++dy)
#pragma unroll
            for (int dx = -1; dx <= 1; ++dx) {
                const int rr = row + dy, cc = col + dx;
                if (rr < 0 || rr >= nrow || cc < 0 || cc >= ncol) continue;
                const u32x4 pv = *(const u32x4*)(P + (size_t)(base + rr * ncol + cc) * PW + pc);
                const LAS float* w = cw + ((dy + 1) * 3 + (dx + 1)) * 1536 + c;
                a[0] += bflo(pv.x) * w[0]; a[1] += bfhi(pv.x) * w[1]; a[2] += bflo(pv.y) * w[2]; a[3] += bfhi(pv.y) * w[3];
                a[4] += bflo(pv.z) * w[4]; a[5] += bfhi(pv.z) * w[5]; a[6] += bflo(pv.w) * w[6]; a[7] += bfhi(pv.w) * w[7];
            }
        const float sc = c < 256 ? 0.125f : 1.f;
#pragma unroll
        for (int i = 0; i < 8; ++i) a[i] = siluf_(a[i]) * sc;
        const u32x4 o = (u32x4){pk2(a[0], a[1]), pk2(a[2], a[3]), pk2(a[4], a[5]), pk2(a[6], a[7])};
        if (c < 512) *(u32x4*)(F.ws + WS_CQK + ((size_t)r * 512 + c) * 2) = o; else *(u32x4*)(F.ws + WS_CQI + ((size_t)r * 1024 + (c - 512)) * 2) = o;
    }
}

__device__ __forceinline__ void ph_hnorm(Frame& F, const Args& A, int l, int nrows_lat_only) {
    const float* HF = (const float*)(F.ws + WS_HF); const float* HB = (const float*)(F.ws + WS_HB);
    const bf16* P = (const bf16*)(F.ws + WS_P);
    const int nrows = nrows_lat_only ? NLAT : NTOK;
    for (int r = F.vcu * NWAVES + F.wave; r < nrows; r += F.G * NWAVES) {
        u32x2* yo = (u32x2*)(F.ws + WS_Y + (size_t)r * D * 2) + F.lane;
#pragma unroll
        for (int j = 0; j < 4; ++j) {
            const int c = 256 * j + 4 * F.lane;
            f32x4 h = *(const f32x4*)(HF + (size_t)r * D + c) + *(const f32x4*)(HB + (size_t)r * D + c);
            float ss = (h.x * h.x + h.y * h.y) + (h.z * h.z + h.w * h.w);
#pragma unroll
            for (int o = 1; o < 32; o <<= 1) ss += __shfl_xor(ss, o);
            const float rstd = rsqrtf(ss * (1.f / 128.f) + EPS);
            const f32x4 g = c < 512 ? *(const f32x4*)(A.in[I_MLNG] + l * 512 + c) : *(const f32x4*)(A.in[I_HGNG] + l * 512 + (c - 512));
            const u32x2 gw = *(const u32x2*)(P + (size_t)r * PW + (c < 512 ? PC_O + c : PC_GO + (c - 512)));
            float ga[4] = {bflo(gw.x), bfhi(gw.x), bflo(gw.y), bfhi(gw.y)};
#pragma unroll
            for (int i = 0; i < 4; ++i) ga[i] = c < 512 ? sigmoidf_(ga[i]) : siluf_(ga[i]);
            h = h * rstd * g;
            yo[64 * j] = (u32x2){pk2(h.x * ga[0], h.y * ga[1]), pk2(h.z * ga[2], h.w * ga[3])};
        }
    }
}

__device__ __forceinline__ void ph_combine(Frame& F, const Args& A, int l, int nrows) {
    float* X = (float*)(F.ws + WS_X); const int* rt = (const int*)(F.ws + WS_ROUTE);
    const float* MOD = (const float*)(F.ws + WS_MOD) + (size_t)l * 3 * 6144;
    for (int r = F.vcu * NWAVES + F.wave; r < nrows; r += F.G * NWAVES) {
        const float* g2 = MOD + mrow_of(r) * 6144 + 5 * 1024;
        int s[4];
#pragma unroll
        for (int k = 0; k < 4; ++k) s[k] = rt[RT_SLOT + r * 4 + k];
#pragma unroll
        for (int j = 0; j < 4; ++j) { const int c = 256 * j + 4 * F.lane; f32x4 a = (f32x4){0.f, 0.f, 0.f, 0.f};
#pragma unroll
            for (int k = 0; k < 4; ++k) { const u32x2 w = *(const u32x2*)(F.ws + WS_YS + ((size_t)s[k] * D + c) * 2); a += (f32x4){bflo(w.x), bfhi(w.x), bflo(w.y), bfhi(w.y)}; }
            f32x4* xp = (f32x4*)(X + (size_t)r * D + c); *xp = *xp + *(const f32x4*)(g2 + c) * a; }
    }
}


namespace pg8 {
typedef short bf16x8 __attribute__((ext_vector_type(8)));
constexpr int BM = 256, BK = 64, HALF = 128, HTB = HALF * BK * 2, STAGE_BYTES = 8 * HTB, NXCD = 8, WGM = 8;
__device__ __forceinline__ int lds_byte(int r, int c) { const int st = (r >> 4) * 2 + (c >> 5), rr = r & 15, cc = c & 31, ob = rr * 64 + cc * 2; return st * 1024 + (ob ^ (((ob >> 9) & 1) << 5)); }
__device__ __forceinline__ void stage_rc(int b, int& R, int& C) { const int st = b / 1024, sb = b % 1024, swz = sb ^ (((sb >> 9) & 1) << 5); R = (st >> 1) * 16 + swz / 64; C = (st & 1) * 32 + (swz % 64) / 2; }
__device__ __forceinline__ int perm32(int rho) { const int n = rho >> 4, i = rho & 15; return 8 * (i >> 2) + 4 * n + (i & 3); }
struct Unit { int pm, pn; };
struct Gemm { const bf16* A; const bf16* Bt; int K; const int* gather; const int* tile_e; size_t bexp;   };
struct StaticOrder {
    int nM, nN, nwg, G, c;
    __device__ void init(int nM_, int nN_, int G_, int c_) { nM = nM_; nN = nN_; nwg = nM * nN; G = G_; c = c_; }
    __device__ bool next(int i, Unit& u) const {
        const long L = (long)i * G + c; if (L >= nwg) return false;
        int wgid = (int)L; { const int q = nwg / NXCD, r = nwg % NXCD, xcd = wgid % NXCD, off = wgid / NXCD; wgid = (xcd < r ? xcd * (q + 1) : r * (q + 1) + (xcd - r) * q) + off; }
        const int nig = WGM * nN, gid = wgid / nig, fm = gid * WGM, gsz = (nM - fm) < WGM ? (nM - fm) : WGM;
        u.pm = fm + ((wgid % nig) % gsz); u.pn = (wgid % nig) / gsz; return true;
    }
};
__device__ __forceinline__ unsigned cvt_pk_bf16(float lo, float hi) { unsigned r; asm volatile("v_cvt_pk_bf16_f32 %0, %1, %2" : "=v"(r) : "v"(lo), "v"(hi)); return r; }

struct EpiBf16 {
    static constexpr bool PERM = true;
    bf16* O; int ldc;
    __device__ __forceinline__ void operator()(const f32x4 (&acc)[2][2][4][2], const Unit& u, int wr, int wc, int fr, int fq) const {
        const int row0 = u.pm * BM + wr * 64 + fr, col0 = u.pn * BM + wc * 32 + 8 * fq;
#pragma unroll
        for (int ai = 0; ai < 2; ++ai)
#pragma unroll
            for (int m = 0; m < 4; ++m) { bf16* rowp = O + (size_t)(row0 + ai * HALF + m * 16) * ldc + col0;
#pragma unroll
                for (int bj = 0; bj < 2; ++bj) { const f32x4 v0 = acc[ai][bj][m][0], v1 = acc[ai][bj][m][1];
                    u32x4 w; w.x = cvt_pk_bf16(v0[0], v0[1]); w.y = cvt_pk_bf16(v0[2], v0[3]); w.z = cvt_pk_bf16(v1[0], v1[1]); w.w = cvt_pk_bf16(v1[2], v1[3]);
                    *(u32x4*)(rowp + bj * HALF) = w; } }
    }
};
struct EpiResid {
    static constexpr bool PERM = false;
    float* X; const float* MODg;
    __device__ __forceinline__ void operator()(const f32x4 (&acc)[2][2][4][2], const Unit& u, int wr, int wc, int fr, int fq) const {
        const int row0 = u.pm * BM + wr * 64 + fr, col0 = u.pn * BM + wc * 32 + 4 * fq;
        const float* gp = MODg + mrow_of(u.pm * BM) * 6144 + col0;
        f32x4 gv[2][2];
#pragma unroll
        for (int bj = 0; bj < 2; ++bj)
#pragma unroll
            for (int n = 0; n < 2; ++n) gv[bj][n] = *(const f32x4*)(gp + bj * HALF + n * 16);
#pragma unroll
        for (int ai = 0; ai < 2; ++ai)
#pragma unroll
            for (int m = 0; m < 4; ++m) { float* rowp = X + (size_t)(row0 + ai * HALF + m * 16) * D + col0;
#pragma unroll
                for (int bj = 0; bj < 2; ++bj)
#pragma unroll
                    for (int n = 0; n < 2; ++n) { f32x4* p = (f32x4*)(rowp + bj * HALF + n * 16); *p = *p + gv[bj][n] * acc[ai][bj][m][n]; } }
    }
};
struct EpiSwiglu {
    static constexpr bool PERM = true;
    bf16* ACT; const float* bgu; const int* tile_e;
    __device__ __forceinline__ void operator()(const f32x4 (&acc)[2][2][4][2], const Unit& u, int wr, int wc, int fr, int fq) const {
        const int e = tile_e[8 + u.pm];
        const int row0 = u.pm * BM + wr * 64 + fr, col0 = u.pn * HALF + wc * 32 + 8 * fq;
        const float* bp = bgu + (size_t)e * 2048 + col0;
        const f32x4 bg0 = *(const f32x4*)bp, bg1 = *(const f32x4*)(bp + 4), bl0 = *(const f32x4*)(bp + 1024), bl1 = *(const f32x4*)(bp + 1028);
#pragma unroll
        for (int ai = 0; ai < 2; ++ai)
#pragma unroll
            for (int m = 0; m < 4; ++m) {
                f32x4 g0 = acc[ai][0][m][0] + bg0, g1 = acc[ai][0][m][1] + bg1, l0 = acc[ai][1][m][0] + bl0, l1 = acc[ai][1][m][1] + bl1; float o[8];
#pragma unroll
                for (int i = 0; i < 4; ++i) { float g = fminf(g0[i], 7.f), li = fminf(fmaxf(l0[i], -7.f), 7.f); o[i] = g * sigmoidf_(1.702f * g) * (li + 1.f);
                    g = fminf(g1[i], 7.f); li = fminf(fmaxf(l1[i], -7.f), 7.f); o[4 + i] = g * sigmoidf_(1.702f * g) * (li + 1.f); }
                u32x4 w; w.x = cvt_pk_bf16(o[0], o[1]); w.y = cvt_pk_bf16(o[2], o[3]); w.z = cvt_pk_bf16(o[4], o[5]); w.w = cvt_pk_bf16(o[6], o[7]);
                *(u32x4*)(ACT + (size_t)(row0 + ai * HALF + m * 16) * DEXP + col0) = w; }
    }
};
struct EpiDown {
    static constexpr bool PERM = true;
    bf16* YS; const float* bdn; const float* sgate; const int* tile_e;
    __device__ __forceinline__ void operator()(const f32x4 (&acc)[2][2][4][2], const Unit& u, int wr, int wc, int fr, int fq) const {
        const int e = tile_e[8 + u.pm];
        const int row0 = u.pm * BM + wr * 64 + fr, col0 = u.pn * BM + wc * 32 + 8 * fq;
        f32x4 bv[2][2];
#pragma unroll
        for (int bj = 0; bj < 2; ++bj)
#pragma unroll
            for (int n = 0; n < 2; ++n) bv[bj][n] = *(const f32x4*)(bdn + (size_t)e * D + col0 + bj * HALF + 4 * n);
#pragma unroll
        for (int ai = 0; ai < 2; ++ai)
#pragma unroll
            for (int m = 0; m < 4; ++m) { const int row = row0 + ai * HALF + m * 16; const float sg = sgate[row]; bf16* rowp = YS + (size_t)row * D + col0;
#pragma unroll
                for (int bj = 0; bj < 2; ++bj) { const f32x4 v0 = (acc[ai][bj][m][0] + bv[bj][0]) * sg, v1 = (acc[ai][bj][m][1] + bv[bj][1]) * sg;
                    u32x4 w; w.x = cvt_pk_bf16(v0[0], v0[1]); w.y = cvt_pk_bf16(v0[2], v0[3]); w.z = cvt_pk_bf16(v1[0], v1[1]); w.w = cvt_pk_bf16(v1[2], v1[3]);
                    *(u32x4*)(rowp + bj * HALF) = w; } }
    }
};

template <class Epi, class Sched, bool ALIGN_EPI>
__device__ __forceinline__ void gemm_phase(LAS unsigned char* lds, const Gemm g, const Sched& S, const Epi& E) {
    const int tid = threadIdx.x, wid = __builtin_amdgcn_readfirstlane(tid >> 6), lane = tid & 63, wr = wid >> 2, wc = wid & 3, fr = lane & 15, fq = lane >> 4;
    const int K = g.K, nt = K / BK;
    int RA[2]; unsigned cbA[2], voffB[2];
#pragma unroll
    for (int i = 0; i < 2; ++i) { int R, C; stage_rc(tid * 16 + i * 8192, R, C); const int Rb = Epi::PERM ? ((R & ~31) + perm32(R & 31)) : R;
        RA[i] = R; cbA[i] = (unsigned)C * 2u; voffB[i] = (unsigned)(Rb * K + C) * 2u; }
    const size_t kstep = (size_t)(BK * 2);
    const size_t hstep = (size_t)HALF * K * 2;
    const size_t tstep = 2 * hstep;
    const unsigned ldsw = (unsigned)wid * 1024u;
    const int aoff = lds_byte(wr * 64 + fr, fq * 8), boff = lds_byte(wc * 32 + fr, fq * 8);
#define PG8_SA(b, h) (((b) * 2 + (h)) * HTB)
#define PG8_SB(b, h) ((4 + (b) * 2 + (h)) * HTB)
#define PG8_STAGE(bufoff, gbase, voff) do { _Pragma("unroll") for (int _i = 0; _i < 2; ++_i) \
        __builtin_amdgcn_global_load_lds((const unsigned*)((const char*)(gbase) + (voff)[_i]), (LAS unsigned*)(lds + (bufoff) + ldsw + _i * 8192), 16, 0, 0); } while (0)
#define PG8_LDA(dst, b, h) do { _Pragma("unroll") for (int m = 0; m < 4; ++m) _Pragma("unroll") for (int k = 0; k < 2; ++k) dst[m][k] = *(const LAS bf16x8*)(lds + PG8_SA(b, h) + aoff + m * 2048 + k * 1024); } while (0)
#define PG8_LDB(dst, b, h) do { _Pragma("unroll") for (int n = 0; n < 2; ++n) _Pragma("unroll") for (int k = 0; k < 2; ++k) dst[n][k] = *(const LAS bf16x8*)(lds + PG8_SB(b, h) + boff + n * 2048 + k * 1024); } while (0)
#define PG8_MMA(ai, bj, At, Bt) do { __builtin_amdgcn_s_setprio(1); _Pragma("unroll") for (int m = 0; m < 4; ++m) _Pragma("unroll") for (int n = 0; n < 2; ++n) _Pragma("unroll") for (int k = 0; k < 2; ++k) \
        acc[ai][bj][m][n] = __builtin_amdgcn_mfma_f32_16x16x32_bf16(Bt[n][k], At[m][k], acc[ai][bj][m][n], 0, 0, 0); __builtin_amdgcn_s_setprio(0); } while (0)
#define PG8_WAIT_V(n) asm volatile("s_waitcnt vmcnt(" #n ")" ::: "memory")
#define PG8_WAIT_L(n) asm volatile("s_waitcnt lgkmcnt(" #n ")" ::: "memory")
#define PG8_BAR __builtin_amdgcn_s_barrier()
#define PG8_SCHED __builtin_amdgcn_sched_barrier(0)
#define PG8_AOFF(va, u) do { _Pragma("unroll") for (int _h = 0; _h < 2; ++_h) _Pragma("unroll") for (int _i = 0; _i < 2; ++_i) { const int _r = (u).pm * BM + _h * HALF + RA[_i]; \
        const int _row = g.gather ? g.gather[_r] : _r; va[_h][_i] = (unsigned)_row * (unsigned)(K * 2) + cbA[_i]; } } while (0)
#define PG8_BBASE(u) ((const char*)g.Bt + ((g.tile_e ? (size_t)g.tile_e[8 + (u).pm] * g.bexp : (size_t)0) * 2) + (size_t)(u).pn * tstep)
    Unit cur, nxt; int ui = 0;
    if (!S.next(0, cur)) return;
    f32x4 acc[2][2][4][2];
#pragma unroll
    for (int a = 0; a < 2; ++a)
#pragma unroll
        for (int b = 0; b < 2; ++b)
#pragma unroll
            for (int m = 0; m < 4; ++m)
#pragma unroll
                for (int n = 0; n < 2; ++n) acc[a][b][m][n] = (f32x4){0.f, 0.f, 0.f, 0.f};
    bf16x8 At[4][2], B0[2][2], B1[2][2];
    const char* Ab = (const char*)g.A;
    unsigned cva[2][2], nva[2][2];
    PG8_AOFF(cva, cur);
    const char* cB = PG8_BBASE(cur);
    PG8_STAGE(PG8_SB(0, 0), cB, voffB); PG8_STAGE(PG8_SB(0, 1), cB + hstep, voffB); PG8_STAGE(PG8_SA(0, 0), Ab, cva[0]); PG8_STAGE(PG8_SA(0, 1), Ab, cva[1]);
    if (wr == 1) PG8_BAR;
    PG8_WAIT_V(2); PG8_BAR;
    PG8_STAGE(PG8_SB(1, 0), cB + kstep, voffB); PG8_STAGE(PG8_SA(1, 0), Ab + kstep, cva[0]); PG8_STAGE(PG8_SB(1, 1), cB + hstep + kstep, voffB);
    PG8_WAIT_V(6); PG8_BAR;
    for (;;) {
        const bool has_next = S.next(ui + 1, nxt);
        const char* nB = cB;
        if (has_next) { PG8_AOFF(nva, nxt); nB = PG8_BBASE(nxt); }
        else {
#pragma unroll
            for (int h = 0; h < 2; ++h)
#pragma unroll
                for (int i = 0; i < 2; ++i) nva[h][i] = cva[h][i]; }
        for (int t = 0; t < nt; t += 2) {
            const bool last = (t == nt - 2);
            const char* a1 = Ab + (size_t)(t + 1) * kstep;
            const char* a2 = last ? Ab : Ab + (size_t)(t + 2) * kstep; const char* b2 = last ? nB : cB + (size_t)(t + 2) * kstep;
            const char* a3 = a2 + kstep; const char* b3 = b2 + kstep;
            unsigned s2[2][2];
#pragma unroll
            for (int h = 0; h < 2; ++h)
#pragma unroll
                for (int i = 0; i < 2; ++i) s2[h][i] = last ? nva[h][i] : cva[h][i];
            PG8_LDB(B0, 0, 0); PG8_LDB(B1, 0, 1); PG8_SCHED; PG8_LDA(At, 0, 0); PG8_STAGE(PG8_SA(1, 1), a1, cva[1]);
            PG8_WAIT_V(8); PG8_WAIT_L(0); PG8_BAR; PG8_MMA(0, 0, At, B0); PG8_MMA(0, 1, At, B1); PG8_BAR; PG8_SCHED;
            PG8_LDA(At, 0, 1); PG8_STAGE(PG8_SB(0, 0), b2, voffB); PG8_STAGE(PG8_SB(0, 1), b2 + hstep, voffB); PG8_STAGE(PG8_SA(0, 0), a2, s2[0]);
            PG8_WAIT_V(8); PG8_WAIT_L(0); PG8_BAR; PG8_MMA(1, 0, At, B0); PG8_MMA(1, 1, At, B1); PG8_BAR; PG8_SCHED;
            PG8_LDB(B0, 1, 0); PG8_LDB(B1, 1, 1); PG8_SCHED; PG8_LDA(At, 1, 0); PG8_STAGE(PG8_SA(0, 1), a2, s2[1]);
            PG8_WAIT_V(8); PG8_WAIT_L(0); PG8_BAR; PG8_MMA(0, 0, At, B0); PG8_MMA(0, 1, At, B1); PG8_BAR; PG8_SCHED;
            PG8_LDA(At, 1, 1); PG8_STAGE(PG8_SB(1, 0), b3, voffB); PG8_STAGE(PG8_SB(1, 1), b3 + hstep, voffB); PG8_STAGE(PG8_SA(1, 0), a3, s2[0]);
            PG8_WAIT_V(8); PG8_WAIT_L(0); PG8_BAR; PG8_MMA(1, 0, At, B0); PG8_MMA(1, 1, At, B1); PG8_BAR; PG8_SCHED;
        }
        if constexpr (ALIGN_EPI) { if (wr == 0) PG8_BAR; }
        E(acc, cur, wr, wc, fr, fq);
        if (!has_next) break;
#pragma unroll
        for (int a = 0; a < 2; ++a)
#pragma unroll
            for (int b = 0; b < 2; ++b)
#pragma unroll
                for (int m = 0; m < 4; ++m)
#pragma unroll
                    for (int n = 0; n < 2; ++n) acc[a][b][m][n] = (f32x4){0.f, 0.f, 0.f, 0.f};
        cur = nxt; cB = nB; ++ui;
#pragma unroll
        for (int h = 0; h < 2; ++h)
#pragma unroll
            for (int i = 0; i < 2; ++i) cva[h][i] = nva[h][i];
        if constexpr (ALIGN_EPI) { if (wr == 1) PG8_BAR; }
    }
    PG8_WAIT_V(0);
    if constexpr (!ALIGN_EPI) { if (wr == 0) PG8_BAR; }
    PG8_BAR;
#undef PG8_SA
#undef PG8_SB
#undef PG8_STAGE
#undef PG8_LDA
#undef PG8_LDB
#undef PG8_MMA
#undef PG8_WAIT_V
#undef PG8_WAIT_L
#undef PG8_BAR
#undef PG8_SCHED
#undef PG8_AOFF
#undef PG8_BBASE
}
}

__device__ __forceinline__ void transpose_item(const float* W, int ldw, int K, bf16* WT, int k0, int n0, int drow0, LAS float* scr, int lane) {
#pragma unroll 8
    for (int i = 0; i < 32; ++i) { const int kk = 2 * i + (lane >> 5); scr[kk * 33 + (lane & 31)] = W[(size_t)(k0 + kk) * ldw + n0 + (lane & 31)]; }
    asm volatile("s_waitcnt lgkmcnt(0)" ::: "memory");
    const int c = lane & 7;
#pragma unroll
    for (int j = 0; j < 4; ++j) { const int n = (lane >> 3) + 8 * j; const LAS float* s = scr + (8 * c) * 33 + n;
        u32x4 o; o.x = pk2(s[0 * 33], s[1 * 33]); o.y = pk2(s[2 * 33], s[3 * 33]); o.z = pk2(s[4 * 33], s[5 * 33]); o.w = pk2(s[6 * 33], s[7 * 33]);
        *(u32x4*)(WT + (size_t)(drow0 + n) * K + k0 + 8 * c) = o; }
    asm volatile("s_waitcnt lgkmcnt(0)" ::: "memory");
}
__device__ __forceinline__ void ph_convert(Frame& F, const Args& A) {
    LAS float* scr = (LAS float*)(F.lds + 32768 + F.wave * 8448);
    const int gw = F.vcu * NWAVES + F.wave, NGW = F.G * NWAVES;
    constexpr int I_IN = DEPTH * 16 * 128, I_OUT = DEPTH * 16 * 32, I_GU = DEPTH * NEXP * 16 * 64, I_DN = DEPTH * NEXP * 16 * 32;
    for (int it = gw; it < I_IN + I_OUT + I_GU + I_DN; it += NGW) {
        int r = it;
        if (r < I_IN) { const int l = r / 2048, q = r % 2048, kb = q / 128, nb = q % 128, d0 = nb * 32, n0 = d0 < 1536 ? d0 : d0 + 16;
            transpose_item(A.in[I_WIN] + (size_t)l * D * INW, INW, D, (bf16*)(F.ws + WS_WIN) + (size_t)l * PW * D, kb * 64, n0, d0, scr, F.lane); continue; }
        r -= I_IN;
        if (r < I_OUT) { const int l = r / 512, q = r % 512, kb = q / 32, nb = q % 32;
            transpose_item(A.in[I_WOUT] + (size_t)l * D * D, D, D, (bf16*)(F.ws + WS_WOUT) + (size_t)l * D * D, kb * 64, nb * 32, nb * 32, scr, F.lane); continue; }
        r -= I_OUT;
        if (r < I_GU) { const int m = r / 1024, q = r % 1024, kb = q / 64, nb = q % 64, n0 = nb * 32;
            const int cc = n0 & 1023, d0 = (cc >> 7) * 256 + (n0 >= 1024 ? 128 : 0) + (cc & 127);
            transpose_item(A.in[I_WGU] + (size_t)m * D * 2048, 2048, D, (bf16*)(F.ws + WS_WGU) + (size_t)m * 2048 * D, kb * 64, n0, d0, scr, F.lane); continue; }
        r -= I_GU;
        { const int m = r / 512, q = r % 512, kb = q / 32, nb = q % 32;
            transpose_item(A.in[I_WDN] + (size_t)m * DEXP * D, D, DEXP, (bf16*)(F.ws + WS_WDN) + (size_t)m * D * DEXP, kb * 64, nb * 32, nb * 32, scr, F.lane); }
    }
}

enum { PH_INIT = 0, PH_NORM1, PH_INPROJ, PH_CONV, PH_SCAN, PH_HNORM, PH_OUTPROJ, PH_NORM2, PH_LISTS, PH_GU, PH_DOWN, PH_COMBINE, PH_FINAL };

__global__ void __launch_bounds__(NTHR, 2) fwd(Args a, int ph, int l) {
    extern __shared__ __attribute__((aligned(16))) unsigned char lds_raw[];
    Frame F; F.lds = (LAS unsigned char*)lds_raw; F.out = a.out; F.ws = a.ws;
    F.tid = threadIdx.x; F.lane = F.tid & 63; F.wave = __builtin_amdgcn_readfirstlane(F.tid >> 6);
    F.G = gridDim.x; { const int bx = blockIdx.x; F.vcu = (F.G % 8 == 0) ? (bx % 8) * (F.G / 8) + bx / 8 : bx; }
    const int nrows = (l == DEPTH - 1) ? NLAT : NTOK;
    switch (ph) {
        case PH_INIT: ph_init(F, a); ph_convert(F, a); break;
        case PH_INPROJ: { pg8::Gemm g{(const bf16*)(F.ws + WS_H), (const bf16*)(F.ws + WS_WIN) + (size_t)l * PW * D, D, nullptr, nullptr, 0};
            pg8::StaticOrder S; S.init(NTOK / 256, PW / 256, F.G, (int)blockIdx.x); pg8::EpiBf16 E{(bf16*)(F.ws + WS_P), PW};
            pg8::gemm_phase<pg8::EpiBf16, pg8::StaticOrder, true>(F.lds, g, S, E); } break;
        case PH_NORM1: ph_norm<0>(F, a, l, NTOK); break;
        case PH_CONV: ph_conv(F, a, l); break;
        case PH_OUTPROJ: { pg8::Gemm g{(const bf16*)(F.ws + WS_Y), (const bf16*)(F.ws + WS_WOUT) + (size_t)l * D * D, D, nullptr, nullptr, 0};
            pg8::StaticOrder S; S.init(nrows / 256, D / 256, F.G, (int)blockIdx.x);
            pg8::EpiResid E{(float*)(F.ws + WS_X), (const float*)(F.ws + WS_MOD) + (size_t)l * 3 * 6144 + 2048};
            pg8::gemm_phase<pg8::EpiResid, pg8::StaticOrder, true>(F.lds, g, S, E); } break;
        case PH_GU: { const int* rt = (const int*)(F.ws + WS_ROUTE); const int ntile = rt[RT_TILEE];
            pg8::Gemm g{(const bf16*)(F.ws + WS_H), (const bf16*)(F.ws + WS_WGU) + (size_t)l * NEXP * 2048 * D, D, rt + RT_LIST, rt + RT_TILEE, (size_t)2048 * D};
            pg8::StaticOrder S; S.init(ntile, 2048 / 256, F.G, (int)blockIdx.x);
            pg8::EpiSwiglu E{(bf16*)(F.ws + WS_ACT), a.in[I_BGU] + (size_t)l * NEXP * 2048, rt + RT_TILEE};
            pg8::gemm_phase<pg8::EpiSwiglu, pg8::StaticOrder, true>(F.lds, g, S, E); } break;
        case PH_DOWN: { const int* rt = (const int*)(F.ws + WS_ROUTE); const int ntile = rt[RT_TILEE];
            pg8::Gemm g{(const bf16*)(F.ws + WS_ACT), (const bf16*)(F.ws + WS_WDN) + (size_t)l * NEXP * D * DEXP, DEXP, nullptr, rt + RT_TILEE, (size_t)D * DEXP};
            pg8::StaticOrder S; S.init(ntile, D / 256, F.G, (int)blockIdx.x);
            pg8::EpiDown E{(bf16*)(F.ws + WS_YS), a.in[I_BDN] + (size_t)l * NEXP * D, (const float*)(rt + RT_SGATE), rt + RT_TILEE};
            pg8::gemm_phase<pg8::EpiDown, pg8::StaticOrder, true>(F.lds, g, S, E); } break;
        case PH_HNORM: ph_hnorm(F, a, l, l == DEPTH - 1); break;
        case PH_NORM2: ph_norm<1>(F, a, l, nrows); break;
        case PH_LISTS: ph_lists(F, a, l, nrows); break;
        case PH_COMBINE: ph_combine(F, a, l, nrows); break;
        case PH_FINAL: ph_norm<2>(F, a, 0, NLAT); break;
        default: break;
    }
}

template <int NB, class Epi>
__global__ void __launch_bounds__(256) naive_gemm(const bf16* A, int lda, const int* gather, const int* tile_e, int M, const float* B, size_t bexp, int ldb, int N, int K, int bshift_from, int bshift, int bgrp, Epi E) {
    __shared__ float As[16][68]; __shared__ float Bs[NB][16][68];
    const int m0 = blockIdx.y * 64, n0 = blockIdx.x * 64, tid = threadIdx.x, tx = tid & 15, ty = tid >> 4;
    int e = 0;
    if (tile_e) { const int nt = tile_e[0]; if (m0 >= nt * 256) return; e = tile_e[8 + (m0 >> 8)]; } else if (m0 >= M) return;
    const float* Bp = B + (size_t)e * bexp + (n0 + (n0 >= bshift_from ? bshift : 0));
    const int ar = tid >> 2, ak = (tid & 3) * 4; const int arow = gather ? gather[m0 + ar] : (m0 + ar);
    const bf16* Ap = A + (size_t)arow * lda + ak;
    const int bk = tid >> 4, bn = (tid & 15) * 4;
    float acc[NB][4][4];
#pragma unroll
    for (int g = 0; g < NB; ++g)
#pragma unroll
        for (int i = 0; i < 4; ++i)
#pragma unroll
            for (int j = 0; j < 4; ++j) acc[g][i][j] = 0.f;
    for (int k0 = 0; k0 < K; k0 += 16) {
        const u32x2 av = *(const u32x2*)(Ap + k0);
        As[ak + 0][ar] = bflo(av.x); As[ak + 1][ar] = bfhi(av.x); As[ak + 2][ar] = bflo(av.y); As[ak + 3][ar] = bfhi(av.y);
#pragma unroll
        for (int g = 0; g < NB; ++g) { const f32x4 bv = *(const f32x4*)(Bp + (size_t)(k0 + bk) * ldb + g * bgrp + bn); *(f32x4*)&Bs[g][bk][bn] = bv; }
        __syncthreads();
#pragma unroll
        for (int k = 0; k < 16; ++k) { const f32x4 a4 = *(const f32x4*)&As[k][ty * 4];
#pragma unroll
            for (int g = 0; g < NB; ++g) { const f32x4 b4 = *(const f32x4*)&Bs[g][k][tx * 4];
#pragma unroll
                for (int i = 0; i < 4; ++i) { acc[g][i][0] += a4[i] * b4[0]; acc[g][i][1] += a4[i] * b4[1]; acc[g][i][2] += a4[i] * b4[2]; acc[g][i][3] += a4[i] * b4[3]; } } }
        __syncthreads();
    }
#pragma unroll
    for (int i = 0; i < 4; ++i)
#pragma unroll
        for (int j = 0; j < 4; ++j) E(m0 + ty * 4 + i, n0 + tx * 4 + j, acc[0][i][j], NB == 2 ? acc[NB - 1][i][j] : 0.f, e);
}
struct EpiP { bf16* P; __device__ void operator()(int r, int c, float v, float, int) const { P[(size_t)r * PW + c] = (bf16)f2bf(v); } };
struct EpiOut { float* X; const float* MOD; __device__ void operator()(int r, int c, float v, float, int) const { X[(size_t)r * D + c] += MOD[mrow_of(r) * 6144 + 2048 + c] * v; } };
struct EpiGU { bf16* ACT; const float* bgu; __device__ void operator()(int r, int c, float g, float li, int e) const {
    g += bgu[(size_t)e * 2048 + c]; li += bgu[(size_t)e * 2048 + 1024 + c]; g = fminf(g, 7.f); li = fminf(fmaxf(li, -7.f), 7.f);
    ACT[(size_t)r * DEXP + c] = (bf16)f2bf(g * sigmoidf_(1.702f * g) * (li + 1.f)); } };
struct EpiDown { bf16* YS; const float* bdn; const float* sgate; __device__ void operator()(int r, int c, float v, float, int e) const { YS[(size_t)r * D + c] = (bf16)f2bf((v + bdn[(size_t)e * D + c]) * sgate[r]); } };

__global__ void __launch_bounds__(128) naive_mlstm(const bf16* CQK, const bf16* P, const float* GATES, float* HF, float* HB) {
    __shared__ float qs[8][64], ks[8][64];
    const int b = blockIdx.x >> 3, h = (blockIdx.x >> 1) & 3, dir = blockIdx.x & 1, tid = threadIdx.x;
    float C[64], n[64], m = 0.f;
#pragma unroll
    for (int d = 0; d < 64; ++d) { C[d] = 0.f; n[d] = 0.f; }
    float* OUT = dir ? HB : HF;
    for (int p0 = 0; p0 < CTX + SEQ; p0 += 8) {
        __syncthreads();
        { const int st = tid >> 4, pc = tid & 15, p = p0 + st; int row;
          if (p < CTX) row = NLAT + b * CTX + (dir ? CTX - 1 - p : p); else { const int q = p - CTX; row = b * SEQ + (dir ? SEQ - 1 - q : q); }
          const u32x4 w = *(const u32x4*)(CQK + (size_t)row * 512 + (pc < 8 ? h * 64 + pc * 8 : 256 + h * 64 + (pc - 8) * 8));
          float* dst = pc < 8 ? &qs[st][pc * 8] : &ks[st][(pc - 8) * 8];
          dst[0] = bflo(w.x); dst[1] = bfhi(w.x); dst[2] = bflo(w.y); dst[3] = bfhi(w.y); dst[4] = bflo(w.z); dst[5] = bfhi(w.z); dst[6] = bflo(w.w); dst[7] = bfhi(w.w); }
        __syncthreads();
        for (int st = 0; st < 8; ++st) {
            const int p = p0 + st; int row;
            if (p < CTX) row = NLAT + b * CTX + (dir ? CTX - 1 - p : p); else { const int q = p - CTX; row = b * SEQ + (dir ? SEQ - 1 - q : q); }
            const float ig = GATES[(size_t)row * 16 + dir * 4 + h], lf = GATES[(size_t)row * 16 + 8 + dir * 4 + h];
            const float v = bf2f(P[(size_t)row * PW + PC_V + h * 128 + tid]);
            const float mn = fmaxf(lf + m, ig), a = __expf(lf + m - mn), w = __expf(ig - mn), wv = w * v; m = mn;
            float num = 0.f, den = 0.f;
#pragma unroll
            for (int d = 0; d < 64; ++d) { const float kd = ks[st][d], qd = qs[st][d]; C[d] = a * C[d] + wv * kd; n[d] = a * n[d] + w * kd; num += C[d] * qd; den += n[d] * qd; }
            OUT[(size_t)row * D + h * 128 + tid] = num / fmaxf(fabsf(den), __expf(-mn));
        }
    }
}
__global__ void __launch_bounds__(128) naive_hgrn(const bf16* CQI, const bf16* P, const float* fb_l, const float* lbraw, int l, float* HF, float* HB) {
    __shared__ float fs[8][128], ks[8][128], qs[8][128];
    const int b = blockIdx.x >> 3, h = (blockIdx.x >> 1) & 3, dir = blockIdx.x & 1, tid = threadIdx.x, ch = h * 128 + tid;
    float S[128];
#pragma unroll
    for (int d = 0; d < 128; ++d) S[d] = 0.f;
    float lb = 0.f;
    if (l == 1) { const float r0 = lbraw[ch], r1 = lbraw[512 + ch], mx = fmaxf(r0, r1), e0 = __expf(r0 - mx), e1 = __expf(r1 - mx); lb = e1 / (e0 + e1); }
    const float bias = fb_l[dir * 512 + ch];
    float* OUT = dir ? HB : HF;
    for (int p0 = 0; p0 < CTX + SEQ; p0 += 8) {
        __syncthreads();
        float vv[8]; int rows[8];
#pragma unroll
        for (int st = 0; st < 8; ++st) { const int p = p0 + st; int row;
            if (p < CTX) row = NLAT + b * CTX + (dir ? CTX - 1 - p : p); else { const int q = p - CTX; row = b * SEQ + (dir ? SEQ - 1 - q : q); }
            rows[st] = row;
            const float z = bf2f(P[(size_t)row * PW + (dir ? PC_FB : PC_FF) + ch]) + bias;
            fs[st][tid] = lb + (1.f - lb) * sigmoidf_(z); ks[st][tid] = (1.f - lb) * sigmoidf_(-z);
            qs[st][tid] = bf2f(CQI[(size_t)row * 1024 + ch]); vv[st] = bf2f(CQI[(size_t)row * 1024 + 512 + ch]); }
        __syncthreads();
#pragma unroll
        for (int st = 0; st < 8; ++st) { float o = 0.f; const float v = vv[st];
#pragma unroll
            for (int d = 0; d < 128; ++d) { S[d] = fs[st][d] * S[d] + ks[st][d] * v; o += qs[st][d] * S[d]; }
            OUT[(size_t)rows[st] * D + 512 + ch] = o; }
    }
}

extern "C" void kernel_launch(void* const* d_in, const int* in_sizes, int n_in, void* d_out, int out_size, void* d_ws, size_t ws_size, hipStream_t stream) {
    static int grid = 0;
    if (grid == 0) {
        if (n_in != 24 || in_sizes[0] != NLAT * D || out_size != NLAT * D || ws_size < WS_END) { fprintf(stderr, "kernel_launch: unexpected shapes n_in %d in0 %d out %d ws %zu (need %zu)\n", n_in, n_in > 0 ? in_sizes[0] : -1, out_size, ws_size, (size_t)WS_END); grid = -1; return; }
        int dev = 0, cus = 0;
        if (hipGetDevice(&dev) != hipSuccess || hipDeviceGetAttribute(&cus, hipDeviceAttributeMultiprocessorCount, dev) != hipSuccess) { grid = -1; return; }
        if (hipFuncSetAttribute((const void*)fwd, hipFuncAttributeMaxDynamicSharedMemorySize, LDS_BYTES) != hipSuccess) { fprintf(stderr, "kernel_launch: hipFuncSetAttribute failed\n"); grid = -1; return; }
        grid = cus;
    }
    if (grid < 0) return;
    (void)hipMemsetAsync((char*)d_ws + WS_CTL, 0, 1 * MiB, stream);
    Args a{};
    for (int i = 0; i < 24; ++i) a.in[i] = (const float*)d_in[i];
    a.out = (float*)d_out; a.ws = (unsigned char*)d_ws; a.ph_lo = 0; a.ph_hi = 0;
    unsigned char* ws = (unsigned char*)d_ws;
    const float* const* in = a.in;
    int* rt = (int*)(ws + WS_ROUTE);
#define PHASE(ph, l) hipLaunchKernelGGL(fwd, dim3(grid), dim3(NTHR), LDS_BYTES, stream, a, (int)(ph), (int)(l))
    PHASE(PH_INIT, 0);
    for (int l = 0; l < DEPTH; ++l) {
        const int nrows = (l == DEPTH - 1) ? NLAT : NTOK;
        const float* MOD = (const float*)(ws + WS_MOD) + (size_t)l * 3 * 6144;
        PHASE(PH_NORM1, l);
        PHASE(PH_INPROJ, l);
        PHASE(PH_CONV, l);
        hipLaunchKernelGGL(naive_mlstm, dim3(16), dim3(128), 0, stream, (const bf16*)(ws + WS_CQK), (const bf16*)(ws + WS_P), (const float*)(ws + WS_GATES), (float*)(ws + WS_HF), (float*)(ws + WS_HB));
        hipLaunchKernelGGL(naive_hgrn, dim3(16), dim3(128), 0, stream, (const bf16*)(ws + WS_CQI), (const bf16*)(ws + WS_P), in[I_HGFB] + (size_t)l * 1024, in[I_HGLB], l, (float*)(ws + WS_HF), (float*)(ws + WS_HB));
        PHASE(PH_HNORM, l);
        PHASE(PH_OUTPROJ, l);
        PHASE(PH_NORM2, l);
        PHASE(PH_LISTS, l);
        PHASE(PH_GU, l);
        PHASE(PH_DOWN, l);
        PHASE(PH_COMBINE, l);
    }
    PHASE(PH_FINAL, 0);
#undef PHASE
}
```

```cpp
#include <hip/hip_runtime.h>
#include <cstdio>
#include <cstdint>

#define GAS __attribute__((address_space(1)))
#define LAS __attribute__((address_space(3)))
typedef unsigned short bf16;
typedef float f32x4 __attribute__((ext_vector_type(4)));
typedef unsigned u32x4 __attribute__((ext_vector_type(4)));
typedef unsigned u32x2 __attribute__((ext_vector_type(2)));

constexpr int D = 1024, BATCH = 2, SEQ = 8192, DEPTH = 2, CTX = 256, GRIDW = 64;
constexpr int NLAT = BATCH * SEQ, NCTX = BATCH * CTX, NTOK = NLAT + NCTX;
constexpr int INW = 4112, PW = 4096;
constexpr int PC_QK = 0, PC_V = 512, PC_O = 1024, PC_QI = 1536, PC_FF = 2560, PC_FB = 3072, PC_GO = 3584;
constexpr int NEXP = 32, TOPK = 4, DEXP = 1024;
constexpr int MAXSLOT = (NTOK * TOPK / 256 + NEXP) * 256;
constexpr int MAXTILE = MAXSLOT / 256;
constexpr float EPS = 1e-6f;

constexpr size_t MiB = 1u << 20;
constexpr size_t WS_CTL = 0;
constexpr size_t WS_MOD = 1 * MiB;
constexpr size_t WS_GATES = 2 * MiB;
constexpr size_t WS_ROUTE = 4 * MiB;
constexpr size_t WS_X = 8 * MiB;
constexpr size_t WS_H = 76 * MiB;
constexpr size_t WS_P = 112 * MiB;
constexpr size_t WS_CQK = 246 * MiB;
constexpr size_t WS_CQI = 264 * MiB;
constexpr size_t WS_HF = 300 * MiB;
constexpr size_t WS_HB = 368 * MiB;
constexpr size_t WS_Y = 436 * MiB;
constexpr size_t WS_ACT = 472 * MiB;
constexpr size_t WS_YS = 622 * MiB;
constexpr size_t WS_WIN = 772 * MiB;
constexpr size_t WS_WOUT = 788 * MiB;
constexpr size_t WS_WGU = 792 * MiB;
constexpr size_t WS_WDN = 1048 * MiB;
constexpr size_t WS_MLC = 1176 * MiB;
constexpr size_t WS_MLN = 1246 * MiB;
constexpr size_t WS_MLS = 1247 * MiB;
constexpr size_t WS_HGS = 1248 * MiB;
constexpr size_t WS_HGG = 1388 * MiB;
constexpr size_t WS_END = 1390 * MiB;
constexpr int NTC = 132;
constexpr int RT_TOPI = 0;
constexpr int RT_TOPG = RT_TOPI + NTOK * 4;
constexpr int RT_POS = RT_TOPG + NTOK * 4;
constexpr int RT_SLOT = RT_POS + NTOK * 4;
constexpr int RT_LIST = RT_SLOT + NTOK * 4;
constexpr int RT_SGATE = RT_LIST + MAXSLOT;
constexpr int RT_TILEE = RT_SGATE + MAXSLOT;
constexpr int RT_END = RT_TILEE + MAXTILE + 8;
static_assert((size_t)RT_END * 4 <= 4 * MiB, "route map");
constexpr int CW_CNT = 1024;
constexpr int CW_BAR = 4096;

__device__ __forceinline__ unsigned f2bf(float f) { unsigned u = __builtin_bit_cast(unsigned, f); return (u + 0x7fffu + ((u >> 16) & 1u)) >> 16; }
__device__ __forceinline__ unsigned pk2(float lo, float hi) { return f2bf(lo) | (f2bf(hi) << 16); }
__device__ __forceinline__ float bf2f(unsigned short b) { return __builtin_bit_cast(float, (unsigned)b << 16); }
__device__ __forceinline__ float bflo(unsigned w) { return __builtin_bit_cast(float, w << 16); }
__device__ __forceinline__ float bfhi(unsigned w) { return __builtin_bit_cast(float, w & 0xffff0000u); }
__device__ __forceinline__ float sigmoidf_(float x) { return 1.f / (1.f + __expf(-x)); }
__device__ __forceinline__ float siluf_(float x) { return x / (1.f + __expf(-x)); }
__device__ __forceinline__ float logsigmoidf_(float x) { return x >= 0.f ? -log1pf(__expf(-x)) : x - log1pf(__expf(x)); }
__device__ __forceinline__ float wave_sum(float v) {
#pragma unroll
    for (int o = 1; o < 64; o <<= 1) v += __shfl_xor(v, o);
    return v;
}
__device__ __forceinline__ int mrow_of(int r) { return r < NLAT ? (r >> 13) : 2; }

struct Args { const float* in[24]; float* out; unsigned char* ws; int ph_lo, ph_hi; };
typedef const __attribute__((address_space(4))) Args CArgs;

enum { I_X = 0, I_C, I_CTX, I_CCTX, I_WADA, I_BADA, I_N1G, I_WIN, I_MLCONV, I_MLGB, I_MLNG, I_HGCONV, I_HGFB, I_HGLB, I_HGNG, I_WOUT, I_N2G, I_RW, I_RB, I_WGU, I_BGU, I_WDN, I_BDN, I_FG };

constexpr int NWAVES = 8, NTHR = 512;
constexpr int LDS_BYTES = 147456;

struct Frame {
    LAS unsigned char* lds;
    float* out; unsigned char* ws;
    int tid, lane, wave, vcu, G;
};

__device__ __forceinline__ void ph_init(Frame& F, CArgs& A) {
    const int gt = F.vcu * NTHR + F.tid, NG = F.G * NTHR;
    const f32x4* xs = (const f32x4*)A.in[I_X]; const f32x4* cs = (const f32x4*)A.in[I_CTX]; f32x4* X = (f32x4*)(F.ws + WS_X);
    for (int i = gt; i < NLAT * 256; i += NG) X[i] = xs[i];
    for (int i = gt; i < NCTX * 256; i += NG) X[NLAT * 256 + i] = cs[i];
    if (gt < 128) ((u32x4*)(F.ws + WS_H + (size_t)NTOK * D * 2))[gt] = (u32x4){0u, 0u, 0u, 0u};
    LAS float* sc = (LAS float*)F.lds;
    LAS float* part = sc + 3 * 1024;
    for (int i = F.tid; i < 3 * 1024; i += NTHR) { const int r = i >> 10, k = i & 1023; const float c = r < 2 ? A.in[I_C][r * 1024 + k] : A.in[I_CCTX][k]; sc[i] = siluf_(c); }
    __syncthreads();
    for (int item = F.vcu; item < DEPTH * 96; item += F.G) {
        const int l = item / 96, j = (item % 96) * 64 + F.lane;
        const float* w = A.in[I_WADA] + (size_t)l * D * 6144 + j;
        float a0 = 0.f, a1 = 0.f, a2 = 0.f;
        for (int k = F.wave * 128; k < F.wave * 128 + 128; ++k) { const float wv = w[(size_t)k * 6144]; a0 += sc[k] * wv; a1 += sc[1024 + k] * wv; a2 += sc[2048 + k] * wv; }
        part[(F.wave * 3 + 0) * 64 + F.lane] = a0; part[(F.wave * 3 + 1) * 64 + F.lane] = a1; part[(F.wave * 3 + 2) * 64 + F.lane] = a2;
        __syncthreads();
        if (F.tid < 192) { const int r = F.tid >> 6, ln = F.tid & 63; float s = 0.f;
#pragma unroll
            for (int w8 = 0; w8 < 8; ++w8) s += part[(w8 * 3 + r) * 64 + ln];
            const int jj = (item % 96) * 64 + ln;
            ((float*)(F.ws + WS_MOD))[(l * 3 + r) * 6144 + jj] = s + A.in[I_BADA][l * 6144 + jj]; }
        __syncthreads();
    }
}

template <int MODE>
__device__ __forceinline__ void ph_norm(Frame& F, CArgs& A, int l, int nrows) {
    constexpr int NV = MODE == 0 ? 16 : 32;
    LAS float* wl = (LAS float*)F.lds;
    if (MODE == 0) { const float* w = A.in[I_WIN] + (size_t)l * D * INW + 1536;
        for (int i = F.tid; i < 16 * 1024; i += NTHR) { const int k = i >> 4, g = i & 15; wl[g * 1024 + k] = w[(size_t)k * INW + g]; } __syncthreads(); }
    if (MODE == 1) { const float* w = A.in[I_RW] + (size_t)l * D * NEXP;
        for (int i = F.tid; i < 32 * 1024; i += NTHR) { const int k = i >> 5, g = i & 31; wl[g * 1024 + k] = w[(size_t)k * NEXP + g]; } __syncthreads(); }
    const float* X = (const float*)(F.ws + WS_X);
    const float* gam = MODE == 0 ? A.in[I_N1G] + l * D : (MODE == 1 ? A.in[I_N2G] + l * D : A.in[I_FG]);
    const float* MOD = (const float*)(F.ws + WS_MOD) + (size_t)l * 3 * 6144;
    for (int r = F.vcu * NWAVES + F.wave; r < nrows; r += F.G * NWAVES) {
        const f32x4* xr = (const f32x4*)(X + (size_t)r * D) + F.lane;
        f32x4 v[4]; float ss = 0.f;
#pragma unroll
        for (int j = 0; j < 4; ++j) { v[j] = xr[64 * j]; ss += (v[j].x * v[j].x + v[j].y * v[j].y) + (v[j].z * v[j].z + v[j].w * v[j].w); }
        const float rstd = rsqrtf(wave_sum(ss) * (1.f / D) + EPS);
        const float* mod = MOD + mrow_of(r) * 6144 + (MODE == 0 ? 0 : 3072);
#pragma unroll
        for (int j = 0; j < 4; ++j) { const int c = 256 * j + 4 * F.lane; const f32x4 g = *(const f32x4*)(gam + c);
            v[j] = v[j] * rstd * g;
            if (MODE != 2) { const f32x4 sh = *(const f32x4*)(mod + c), scl = *(const f32x4*)(mod + 1024 + c); v[j] = v[j] * (1.f + scl) + sh; } }
        if (MODE == 2) { f32x4* o = (f32x4*)(F.out + (size_t)r * D) + F.lane;
#pragma unroll
            for (int j = 0; j < 4; ++j) o[64 * j] = v[j];
            continue; }
        u32x2* ho = (u32x2*)(F.ws + WS_H + (size_t)r * D * 2) + F.lane;
#pragma unroll
        for (int j = 0; j < 4; ++j) ho[64 * j] = (u32x2){pk2(v[j].x, v[j].y), pk2(v[j].z, v[j].w)};
        float mine = 0.f;
#pragma unroll 2
        for (int g = 0; g < NV; ++g) { float a = 0.f;
#pragma unroll
            for (int j = 0; j < 4; ++j) { const f32x4 w = *(const LAS f32x4*)(wl + g * 1024 + 256 * j + 4 * F.lane); a += (v[j].x * w.x + v[j].y * w.y) + (v[j].z * w.z + v[j].w * w.w); }
            a = wave_sum(a); mine = (F.lane == g) ? a : mine; }
        if (MODE == 0) {
            if (F.lane < 16) { float val = mine + A.in[I_MLGB][l * 16 + F.lane];
                if (F.lane >= 8) val = logsigmoidf_(val);
                ((float*)(F.ws + WS_GATES))[(size_t)r * 16 + F.lane] = val; }
        } else {
            float lv = F.lane < 32 ? mine + A.in[I_RB][l * NEXP + (F.lane & 31)] : -INFINITY;
            float tv[4]; int ti[4];
#pragma unroll
            for (int p = 0; p < 4; ++p) { float best = lv;
#pragma unroll
                for (int o = 1; o < 64; o <<= 1) best = fmaxf(best, __shfl_xor(best, o));
                const unsigned long long bal = __ballot(lv == best); const int bi = __ffsll((long long)bal) - 1;
                tv[p] = best; ti[p] = bi; if (F.lane == bi) lv = -INFINITY; }
            const float e1 = __expf(tv[1] - tv[0]), e2 = __expf(tv[2] - tv[0]), e3 = __expf(tv[3] - tv[0]); const float inv = 1.f / (1.f + e1 + e2 + e3);
            if (F.lane == 0) {
                int* rt = (int*)(F.ws + WS_ROUTE); unsigned* cnt = (unsigned*)(F.ws + WS_CTL) + CW_CNT + 64 * l;
                const float gs[4] = {inv, e1 * inv, e2 * inv, e3 * inv};
#pragma unroll
                for (int p = 0; p < 4; ++p) { rt[RT_TOPI + r * 4 + p] = ti[p]; ((float*)rt)[RT_TOPG + r * 4 + p] = gs[p]; rt[RT_POS + r * 4 + p] = (int)atomicAdd(cnt + ti[p], 1u); }
            }
        }
    }
}

__device__ __forceinline__ void ph_lists(Frame& F, CArgs& A, int l, int nrows) {
    LAS int* off = (LAS int*)F.lds;
    const unsigned* cnt = (const unsigned*)(F.ws + WS_CTL) + CW_CNT + 64 * l;
    int* rt = (int*)(F.ws + WS_ROUTE);
    if (F.tid == 0) { int o = 0; for (int e = 0; e < NEXP; ++e) { const int c = (int)__hip_atomic_load(cnt + e, __ATOMIC_RELAXED, __HIP_MEMORY_SCOPE_AGENT); off[e] = o; off[64 + e] = c; o += (c + 255) & ~255; } off[32] = o; }
    __syncthreads();
    const int gt = F.vcu * NTHR + F.tid, NG = F.G * NTHR;
    for (int i = gt; i < nrows * 4; i += NG) { const int e = rt[RT_TOPI + i], s = off[e] + rt[RT_POS + i]; rt[RT_SLOT + i] = s; rt[RT_LIST + s] = i >> 2; ((float*)rt)[RT_SGATE + s] = ((const float*)rt)[RT_TOPG + i]; }
    const int total = off[32];
    for (int s = gt; s < total; s += NG) { int e = 0;
#pragma unroll 1
        for (int q = 1; q < NEXP; ++q) if (s >= off[q]) e = q;
        if (s - off[e] >= off[64 + e]) { rt[RT_LIST + s] = NTOK; ((float*)rt)[RT_SGATE + s] = 0.f; }
        if ((s & 255) == 0) rt[RT_TILEE + 8 + (s >> 8)] = e; }
    if (gt == 0) rt[RT_TILEE] = total >> 8;
}

__device__ __forceinline__ void ph_conv(Frame& F, CArgs& A, int l) {
    LAS float* cw = (LAS float*)F.lds;
    for (int i = F.tid; i < 9 * 1536; i += NTHR) { const int t = i / 1536, c = i % 1536; cw[i] = c < 512 ? A.in[I_MLCONV][(size_t)l * 9 * 512 + t * 512 + c] : A.in[I_HGCONV][(size_t)l * 9 * 1024 + t * 1024 + (c - 512)]; }
    __syncthreads();
    const bf16* P = (const bf16*)(F.ws + WS_P);
    const int gt = F.vcu * NTHR + F.tid, NG = F.G * NTHR;
    for (int it = gt; it < NTOK * 192; it += NG) {
        const int r = it / 192, cg = it % 192, c = cg * 8;
        const int pc = c < 512 ? PC_QK + c : PC_QI + (c - 512);
        float a[8] = {0.f, 0.f, 0.f, 0.f, 0.f, 0.f, 0.f, 0.f};
        int base, row, col, nrow, ncol;
        if (r < NLAT) { const int b = r >> 13, t = r & 8191; base = b << 13; row = t >> 6; col = t & 63; nrow = 128; ncol = 64; }
        else { const int q = r - NLAT, b = q >> 8; base = NLAT + (b << 8); row = 0; col = q & 255; nrow = 1; ncol = 256; }
#pragma unroll
        for (int dy = -1; dy <= 1; ++dy)
#pragma unroll
            for (int dx = -1; dx <= 1; ++dx) {
                const int rr = row + dy, cc = col + dx;
                if (rr < 0 || rr >= nrow || cc < 0 || cc >= ncol) continue;
                const u32x4 pv = *(const u32x4*)(P + (size_t)(base + rr * ncol + cc) * PW + pc);
                const LAS float* w = cw + ((dy + 1) * 3 + (dx + 1)) * 1536 + c;
                a[0] += bflo(pv.x) * w[0]; a[1] += bfhi(pv.x) * w[1]; a[2] += bflo(pv.y) * w[2]; a[3] += bfhi(pv.y) * w[3];
                a[4] += bflo(pv.z) * w[4]; a[5] += bfhi(pv.z) * w[5]; a[6] += bflo(pv.w) * w[6]; a[7] += bfhi(pv.w) * w[7];
            }
        const float sc = c < 256 ? 0.125f : 1.f;
#pragma unroll
        for (int i = 0; i < 8; ++i) a[i] = siluf_(a[i]) * sc;
        const u32x4 o = (u32x4){pk2(a[0], a[1]), pk2(a[2], a[3]), pk2(a[4], a[5]), pk2(a[6], a[7])};
        if (c < 512) *(u32x4*)(F.ws + WS_CQK + ((size_t)r * 512 + c) * 2) = o; else *(u32x4*)(F.ws + WS_CQI + ((size_t)r * 1024 + (c - 512)) * 2) = o;
    }
}

__device__ __forceinline__ void ph_hnorm(Frame& F, CArgs& A, int l, int nrows_lat_only) {
    const float* HF = (const float*)(F.ws + WS_HF);
    const bf16* P = (const bf16*)(F.ws + WS_P);
    const int nrows = nrows_lat_only ? NLAT : NTOK;
    for (int r = F.vcu * NWAVES + F.wave; r < nrows; r += F.G * NWAVES) {
        u32x2* yo = (u32x2*)(F.ws + WS_Y + (size_t)r * D * 2) + F.lane;
#pragma unroll
        for (int j = 0; j < 4; ++j) {
            const int c = 256 * j + 4 * F.lane;
            f32x4 h = *(const f32x4*)(HF + (size_t)r * D + c);
            float ss = (h.x * h.x + h.y * h.y) + (h.z * h.z + h.w * h.w);
#pragma unroll
            for (int o = 1; o < 32; o <<= 1) ss += __shfl_xor(ss, o);
            const float rstd = rsqrtf(ss * (1.f / 128.f) + EPS);
            const f32x4 g = c < 512 ? *(const f32x4*)(A.in[I_MLNG] + l * 512 + c) : *(const f32x4*)(A.in[I_HGNG] + l * 512 + (c - 512));
            const u32x2 gw = *(const u32x2*)(P + (size_t)r * PW + (c < 512 ? PC_O + c : PC_GO + (c - 512)));
            float ga[4] = {bflo(gw.x), bfhi(gw.x), bflo(gw.y), bfhi(gw.y)};
#pragma unroll
            for (int i = 0; i < 4; ++i) ga[i] = c < 512 ? sigmoidf_(ga[i]) : siluf_(ga[i]);
            h = h * rstd * g;
            yo[64 * j] = (u32x2){pk2(h.x * ga[0], h.y * ga[1]), pk2(h.z * ga[2], h.w * ga[3])};
        }
    }
}

__device__ __forceinline__ void ph_combine(Frame& F, CArgs& A, int l, int nrows) {
    float* X = (float*)(F.ws + WS_X); const int* rt = (const int*)(F.ws + WS_ROUTE);
    const float* MOD = (const float*)(F.ws + WS_MOD) + (size_t)l * 3 * 6144;
    for (int r = F.vcu * NWAVES + F.wave; r < nrows; r += F.G * NWAVES) {
        const float* g2 = MOD + mrow_of(r) * 6144 + 5 * 1024;
        int s[4];
#pragma unroll
        for (int k = 0; k < 4; ++k) s[k] = rt[RT_SLOT + r * 4 + k];
#pragma unroll
        for (int j = 0; j < 4; ++j) { const int c = 256 * j + 4 * F.lane; f32x4 a = (f32x4){0.f, 0.f, 0.f, 0.f};
#pragma unroll
            for (int k = 0; k < 4; ++k) { const u32x2 w = *(const u32x2*)(F.ws + WS_YS + ((size_t)s[k] * D + c) * 2); a += (f32x4){bflo(w.x), bfhi(w.x), bflo(w.y), bfhi(w.y)}; }
            f32x4* xp = (f32x4*)(X + (size_t)r * D + c); *xp = *xp + *(const f32x4*)(g2 + c) * a; }
    }
}


namespace pg8 {
typedef short bf16x8 __attribute__((ext_vector_type(8)));
constexpr int BM = 256, BK = 64, HALF = 128, HTB = HALF * BK * 2, STAGE_BYTES = 8 * HTB, NXCD = 8, WGM = 8;
__device__ __forceinline__ int lds_byte(int r, int c) { const int st = (r >> 4) * 2 + (c >> 5), rr = r & 15, cc = c & 31, ob = rr * 64 + cc * 2; return st * 1024 + (ob ^ (((ob >> 9) & 1) << 5)); }
__device__ __forceinline__ void stage_rc(int b, int& R, int& C) { const int st = b / 1024, sb = b % 1024, swz = sb ^ (((sb >> 9) & 1) << 5); R = (st >> 1) * 16 + swz / 64; C = (st & 1) * 32 + (swz % 64) / 2; }
__device__ __forceinline__ int perm32(int rho) { const int n = rho >> 4, i = rho & 15; return 8 * (i >> 2) + 4 * n + (i & 3); }
struct Unit { int pm, pn; };
struct Gemm { const bf16* A; const bf16* Bt; int K; const int* gather; const int* tile_e; size_t bexp;   };
struct StaticOrder {
    int nM, nN, nwg, G, c;
    __device__ void init(int nM_, int nN_, int G_, int c_) { nM = nM_; nN = nN_; nwg = nM * nN; G = G_; c = c_; }
    __device__ bool next(int i, Unit& u) const {
        const long L = (long)i * G + c; if (L >= nwg) return false;
        int wgid = (int)L; { const int q = nwg / NXCD, r = nwg % NXCD, xcd = wgid % NXCD, off = wgid / NXCD; wgid = (xcd < r ? xcd * (q + 1) : r * (q + 1) + (xcd - r) * q) + off; }
        const int nig = WGM * nN, gid = wgid / nig, fm = gid * WGM, gsz = (nM - fm) < WGM ? (nM - fm) : WGM;
        u.pm = fm + ((wgid % nig) % gsz); u.pn = (wgid % nig) / gsz; return true;
    }
};
__device__ __forceinline__ unsigned cvt_pk_bf16(float lo, float hi) { unsigned r; asm volatile("v_cvt_pk_bf16_f32 %0, %1, %2" : "=v"(r) : "v"(lo), "v"(hi)); return r; }

struct EpiBf16 {
    static constexpr bool PERM = true;
    bf16* O; int ldc;
    __device__ __forceinline__ void operator()(const f32x4 (&acc)[2][2][4][2], const Unit& u, int wr, int wc, int fr, int fq) const {
        const int row0 = u.pm * BM + wr * 64 + fr, col0 = u.pn * BM + wc * 32 + 8 * fq;
#pragma unroll
        for (int ai = 0; ai < 2; ++ai)
#pragma unroll
            for (int m = 0; m < 4; ++m) { bf16* rowp = O + (size_t)(row0 + ai * HALF + m * 16) * ldc + col0;
#pragma unroll
                for (int bj = 0; bj < 2; ++bj) { const f32x4 v0 = acc[ai][bj][m][0], v1 = acc[ai][bj][m][1];
                    u32x4 w; w.x = cvt_pk_bf16(v0[0], v0[1]); w.y = cvt_pk_bf16(v0[2], v0[3]); w.z = cvt_pk_bf16(v1[0], v1[1]); w.w = cvt_pk_bf16(v1[2], v1[3]);
                    *(u32x4*)(rowp + bj * HALF) = w; } }
    }
};
struct EpiResid {
    static constexpr bool PERM = false;
    float* X; const float* MODg;
    __device__ __forceinline__ void operator()(const f32x4 (&acc)[2][2][4][2], const Unit& u, int wr, int wc, int fr, int fq) const {
        const int row0 = u.pm * BM + wr * 64 + fr, col0 = u.pn * BM + wc * 32 + 4 * fq;
        const float* gp = MODg + mrow_of(u.pm * BM) * 6144 + col0;
        f32x4 gv[2][2];
#pragma unroll
        for (int bj = 0; bj < 2; ++bj)
#pragma unroll
            for (int n = 0; n < 2; ++n) gv[bj][n] = *(const f32x4*)(gp + bj * HALF + n * 16);
#pragma unroll
        for (int ai = 0; ai < 2; ++ai)
#pragma unroll
            for (int m = 0; m < 4; ++m) { float* rowp = X + (size_t)(row0 + ai * HALF + m * 16) * D + col0;
#pragma unroll
                for (int bj = 0; bj < 2; ++bj)
#pragma unroll
                    for (int n = 0; n < 2; ++n) { f32x4* p = (f32x4*)(rowp + bj * HALF + n * 16); *p = *p + gv[bj][n] * acc[ai][bj][m][n]; } }
    }
};
struct EpiSwiglu {
    static constexpr bool PERM = true;
    bf16* ACT; const float* bgu; const int* tile_e;
    __device__ __forceinline__ void operator()(const f32x4 (&acc)[2][2][4][2], const Unit& u, int wr, int wc, int fr, int fq) const {
        const int e = tile_e[8 + u.pm];
        const int row0 = u.pm * BM + wr * 64 + fr, col0 = u.pn * HALF + wc * 32 + 8 * fq;
        const float* bp = bgu + (size_t)e * 2048 + col0;
        const f32x4 bg0 = *(const f32x4*)bp, bg1 = *(const f32x4*)(bp + 4), bl0 = *(const f32x4*)(bp + 1024), bl1 = *(const f32x4*)(bp + 1028);
#pragma unroll
        for (int ai = 0; ai < 2; ++ai)
#pragma unroll
            for (int m = 0; m < 4; ++m) {
                f32x4 g0 = acc[ai][0][m][0] + bg0, g1 = acc[ai][0][m][1] + bg1, l0 = acc[ai][1][m][0] + bl0, l1 = acc[ai][1][m][1] + bl1; float o[8];
#pragma unroll
                for (int i = 0; i < 4; ++i) { float g = fminf(g0[i], 7.f), li = fminf(fmaxf(l0[i], -7.f), 7.f); o[i] = g * sigmoidf_(1.702f * g) * (li + 1.f);
                    g = fminf(g1[i], 7.f); li = fminf(fmaxf(l1[i], -7.f), 7.f); o[4 + i] = g * sigmoidf_(1.702f * g) * (li + 1.f); }
                u32x4 w; w.x = cvt_pk_bf16(o[0], o[1]); w.y = cvt_pk_bf16(o[2], o[3]); w.z = cvt_pk_bf16(o[4], o[5]); w.w = cvt_pk_bf16(o[6], o[7]);
                *(u32x4*)(ACT + (size_t)(row0 + ai * HALF + m * 16) * DEXP + col0) = w; }
    }
};
struct EpiDown {
    static constexpr bool PERM = true;
    bf16* YS; const float* bdn; const float* sgate; const int* tile_e;
    __device__ __forceinline__ void operator()(const f32x4 (&acc)[2][2][4][2], const Unit& u, int wr, int wc, int fr, int fq) const {
        const int e = tile_e[8 + u.pm];
        const int row0 = u.pm * BM + wr * 64 + fr, col0 = u.pn * BM + wc * 32 + 8 * fq;
        f32x4 bv[2][2];
#pragma unroll
        for (int bj = 0; bj < 2; ++bj)
#pragma unroll
            for (int n = 0; n < 2; ++n) bv[bj][n] = *(const f32x4*)(bdn + (size_t)e * D + col0 + bj * HALF + 4 * n);
#pragma unroll
        for (int ai = 0; ai < 2; ++ai)
#pragma unroll
            for (int m = 0; m < 4; ++m) { const int row = row0 + ai * HALF + m * 16; const float sg = sgate[row]; bf16* rowp = YS + (size_t)row * D + col0;
#pragma unroll
                for (int bj = 0; bj < 2; ++bj) { const f32x4 v0 = (acc[ai][bj][m][0] + bv[bj][0]) * sg, v1 = (acc[ai][bj][m][1] + bv[bj][1]) * sg;
                    u32x4 w; w.x = cvt_pk_bf16(v0[0], v0[1]); w.y = cvt_pk_bf16(v0[2], v0[3]); w.z = cvt_pk_bf16(v1[0], v1[1]); w.w = cvt_pk_bf16(v1[2], v1[3]);
                    *(u32x4*)(rowp + bj * HALF) = w; } }
    }
};

template <class Epi, class Sched, bool ALIGN_EPI>
__device__ __forceinline__ void gemm_phase(LAS unsigned char* lds, const Gemm g, const Sched& S, const Epi& E, const int tid) {
    const int wid = __builtin_amdgcn_readfirstlane(tid >> 6), lane = tid & 63, wr = wid >> 2, wc = wid & 3, fr = lane & 15, fq = lane >> 4;
    const int K = g.K, nt = K / BK;
    int RA[2]; unsigned cbA[2], voffB[2];
#pragma unroll
    for (int i = 0; i < 2; ++i) { int R, C; stage_rc(tid * 16 + i * 8192, R, C); const int Rb = Epi::PERM ? ((R & ~31) + perm32(R & 31)) : R;
        RA[i] = R; cbA[i] = (unsigned)C * 2u; voffB[i] = (unsigned)(Rb * K + C) * 2u; }
    const size_t kstep = (size_t)(BK * 2);
    const size_t hstep = (size_t)HALF * K * 2;
    const size_t tstep = 2 * hstep;
    const unsigned ldsw = (unsigned)wid * 1024u;
    const int aoff = lds_byte(wr * 64 + fr, fq * 8), boff = lds_byte(wc * 32 + fr, fq * 8);
#define PG8_SA(b, h) (((b) * 2 + (h)) * HTB)
#define PG8_SB(b, h) ((4 + (b) * 2 + (h)) * HTB)
#define PG8_STAGE(bufoff, gbase, voff) do { _Pragma("unroll") for (int _i = 0; _i < 2; ++_i) \
        __builtin_amdgcn_global_load_lds((const unsigned*)((const char*)(gbase) + (voff)[_i]), (LAS unsigned*)(lds + (bufoff) + ldsw + _i * 8192), 16, 0, 0); } while (0)
#define PG8_LDA(dst, b, h) do { _Pragma("unroll") for (int m = 0; m < 4; ++m) _Pragma("unroll") for (int k = 0; k < 2; ++k) dst[m][k] = *(const LAS bf16x8*)(lds + PG8_SA(b, h) + aoff + m * 2048 + k * 1024); } while (0)
#define PG8_LDB(dst, b, h) do { _Pragma("unroll") for (int n = 0; n < 2; ++n) _Pragma("unroll") for (int k = 0; k < 2; ++k) dst[n][k] = *(const LAS bf16x8*)(lds + PG8_SB(b, h) + boff + n * 2048 + k * 1024); } while (0)
#define PG8_MMA(ai, bj, At, Bt) do { __builtin_amdgcn_s_setprio(1); _Pragma("unroll") for (int m = 0; m < 4; ++m) _Pragma("unroll") for (int n = 0; n < 2; ++n) _Pragma("unroll") for (int k = 0; k < 2; ++k) \
        acc[ai][bj][m][n] = __builtin_amdgcn_mfma_f32_16x16x32_bf16(Bt[n][k], At[m][k], acc[ai][bj][m][n], 0, 0, 0); __builtin_amdgcn_s_setprio(0); } while (0)
#define PG8_WAIT_V(n) asm volatile("s_waitcnt vmcnt(" #n ")" ::: "memory")
#define PG8_WAIT_L(n) asm volatile("s_waitcnt lgkmcnt(" #n ")" ::: "memory")
#define PG8_BAR __builtin_amdgcn_s_barrier()
#define PG8_SCHED __builtin_amdgcn_sched_barrier(0)
#define PG8_AOFF(va, u) do { _Pragma("unroll") for (int _h = 0; _h < 2; ++_h) _Pragma("unroll") for (int _i = 0; _i < 2; ++_i) { const int _r = (u).pm * BM + _h * HALF + RA[_i]; \
        const int _row = g.gather ? g.gather[_r] : _r; va[_h][_i] = (unsigned)_row * (unsigned)(K * 2) + cbA[_i]; } } while (0)
#define PG8_BBASE(u) ((const char*)g.Bt + ((g.tile_e ? (size_t)g.tile_e[8 + (u).pm] * g.bexp : (size_t)0) * 2) + (size_t)(u).pn * tstep)
    Unit cur, nxt; int ui = 0;
    if (!S.next(0, cur)) return;
    f32x4 acc[2][2][4][2];
#pragma unroll
    for (int a = 0; a < 2; ++a)
#pragma unroll
        for (int b = 0; b < 2; ++b)
#pragma unroll
            for (int m = 0; m < 4; ++m)
#pragma unroll
                for (int n = 0; n < 2; ++n) acc[a][b][m][n] = (f32x4){0.f, 0.f, 0.f, 0.f};
    bf16x8 At[4][2], B0[2][2], B1[2][2];
    const char* Ab = (const char*)g.A;
    unsigned cva[2][2], nva[2][2];
    PG8_AOFF(cva, cur);
    const char* cB = PG8_BBASE(cur);
    PG8_STAGE(PG8_SB(0, 0), cB, voffB); PG8_STAGE(PG8_SB(0, 1), cB + hstep, voffB); PG8_STAGE(PG8_SA(0, 0), Ab, cva[0]); PG8_STAGE(PG8_SA(0, 1), Ab, cva[1]);
    if (wr == 1) PG8_BAR;
    PG8_WAIT_V(2); PG8_BAR;
    PG8_STAGE(PG8_SB(1, 0), cB + kstep, voffB); PG8_STAGE(PG8_SA(1, 0), Ab + kstep, cva[0]); PG8_STAGE(PG8_SB(1, 1), cB + hstep + kstep, voffB);
    PG8_WAIT_V(6); PG8_BAR;
    for (;;) {
        const bool has_next = S.next(ui + 1, nxt);
        const char* nB = cB;
        if (has_next) { PG8_AOFF(nva, nxt); nB = PG8_BBASE(nxt); }
        else {
#pragma unroll
            for (int h = 0; h < 2; ++h)
#pragma unroll
                for (int i = 0; i < 2; ++i) nva[h][i] = cva[h][i]; }
        for (int t = 0; t < nt; t += 2) {
            const bool last = (t == nt - 2);
            const char* a1 = Ab + (size_t)(t + 1) * kstep;
            const char* a2 = last ? Ab : Ab + (size_t)(t + 2) * kstep; const char* b2 = last ? nB : cB + (size_t)(t + 2) * kstep;
            const char* a3 = a2 + kstep; const char* b3 = b2 + kstep;
            unsigned s2[2][2];
#pragma unroll
            for (int h = 0; h < 2; ++h)
#pragma unroll
                for (int i = 0; i < 2; ++i) s2[h][i] = last ? nva[h][i] : cva[h][i];
            PG8_LDB(B0, 0, 0); PG8_LDB(B1, 0, 1); PG8_SCHED; PG8_LDA(At, 0, 0); PG8_STAGE(PG8_SA(1, 1), a1, cva[1]);
            PG8_WAIT_V(8); PG8_WAIT_L(0); PG8_BAR; PG8_MMA(0, 0, At, B0); PG8_MMA(0, 1, At, B1); PG8_BAR; PG8_SCHED;
            PG8_LDA(At, 0, 1); PG8_STAGE(PG8_SB(0, 0), b2, voffB); PG8_STAGE(PG8_SB(0, 1), b2 + hstep, voffB); PG8_STAGE(PG8_SA(0, 0), a2, s2[0]);
            PG8_WAIT_V(8); PG8_WAIT_L(0); PG8_BAR; PG8_MMA(1, 0, At, B0); PG8_MMA(1, 1, At, B1); PG8_BAR; PG8_SCHED;
            PG8_LDB(B0, 1, 0); PG8_LDB(B1, 1, 1); PG8_SCHED; PG8_LDA(At, 1, 0); PG8_STAGE(PG8_SA(0, 1), a2, s2[1]);
            PG8_WAIT_V(8); PG8_WAIT_L(0); PG8_BAR; PG8_MMA(0, 0, At, B0); PG8_MMA(0, 1, At, B1); PG8_BAR; PG8_SCHED;
            PG8_LDA(At, 1, 1); PG8_STAGE(PG8_SB(1, 0), b3, voffB); PG8_STAGE(PG8_SB(1, 1), b3 + hstep, voffB); PG8_STAGE(PG8_SA(1, 0), a3, s2[0]);
            PG8_WAIT_V(8); PG8_WAIT_L(0); PG8_BAR; PG8_MMA(1, 0, At, B0); PG8_MMA(1, 1, At, B1); PG8_BAR; PG8_SCHED;
        }
        if constexpr (ALIGN_EPI) { if (wr == 0) PG8_BAR; }
        E(acc, cur, wr, wc, fr, fq);
        if (!has_next) break;
#pragma unroll
        for (int a = 0; a < 2; ++a)
#pragma unroll
            for (int b = 0; b < 2; ++b)
#pragma unroll
                for (int m = 0; m < 4; ++m)
#pragma unroll
                    for (int n = 0; n < 2; ++n) acc[a][b][m][n] = (f32x4){0.f, 0.f, 0.f, 0.f};
        cur = nxt; cB = nB; ++ui;
#pragma unroll
        for (int h = 0; h < 2; ++h)
#pragma unroll
            for (int i = 0; i < 2; ++i) cva[h][i] = nva[h][i];
        if constexpr (ALIGN_EPI) { if (wr == 1) PG8_BAR; }
    }
    PG8_WAIT_V(0);
    if constexpr (!ALIGN_EPI) { if (wr == 0) PG8_BAR; }
    PG8_BAR;
#undef PG8_SA
#undef PG8_SB
#undef PG8_STAGE
#undef PG8_LDA
#undef PG8_LDB
#undef PG8_MMA
#undef PG8_WAIT_V
#undef PG8_WAIT_L
#undef PG8_BAR
#undef PG8_SCHED
#undef PG8_AOFF
#undef PG8_BBASE
}
}


typedef short bf16x8_t __attribute__((ext_vector_type(8)));
typedef float f32x16 __attribute__((ext_vector_type(16)));
template <int K>
__device__ __forceinline__ void mm32(f32x16& acc, const LAS unsigned char* A, int sa, const LAS unsigned char* B, int sb, int lane) {
    const LAS unsigned char* ap = A + (lane & 31) * sa + (lane >> 5) * 16;
    const LAS unsigned char* bp = B + (lane & 31) * sb + (lane >> 5) * 16;
#pragma unroll
    for (int k = 0; k < K; k += 16) { const bf16x8_t a = *(const LAS bf16x8_t*)(ap + k * 2); const bf16x8_t b = *(const LAS bf16x8_t*)(bp + k * 2);
        acc = __builtin_amdgcn_mfma_f32_32x32x16_bf16(a, b, acc, 0, 0, 0); }
}
__device__ __forceinline__ int rowmap(int reg, int hi) { return (reg & 3) + 8 * (reg >> 2) + 4 * hi; }
__device__ __forceinline__ float wave_incl_sum(float v, int lane) {
#pragma unroll
    for (int o = 1; o < 64; o <<= 1) { const float t = __shfl_up(v, o); v = lane >= o ? v + t : v; }
    return v;
}
__device__ __forceinline__ float wave_incl_max(float v, int lane) {
#pragma unroll
    for (int o = 1; o < 64; o <<= 1) { const float t = __shfl_up(v, o); v = lane >= o ? fmaxf(v, t) : v; }
    return v;
}
__device__ __forceinline__ float wave_max(float v) {
#pragma unroll
    for (int o = 1; o < 64; o <<= 1) v = fmaxf(v, __shfl_xor(v, o));
    return v;
}
__device__ __forceinline__ int chunk_row0(int b, int tc) { return tc < 4 ? NLAT + b * CTX + tc * 64 : b * SEQ + (tc - 4) * 64; }
constexpr int ST64 = 144, ST128 = 272;

__device__ __forceinline__ void stage_vt(LAS unsigned char* VT, const bf16* src, int pitch, int row0, int col0, int tid) {
    const int cp = tid & 63, tg = tid >> 6; unsigned lo[4], hi[4];
#pragma unroll
    for (int i = 0; i < 4; ++i) { const unsigned w0 = *(const unsigned*)(src + (size_t)(row0 + tg * 8 + 2 * i) * pitch + col0 + 2 * cp), w1 = *(const unsigned*)(src + (size_t)(row0 + tg * 8 + 2 * i + 1) * pitch + col0 + 2 * cp);
        lo[i] = (w0 & 0xffffu) | (w1 << 16); hi[i] = (w0 >> 16) | (w1 & 0xffff0000u); }
    *(LAS u32x4*)(VT + (2 * cp) * ST64 + tg * 16) = (u32x4){lo[0], lo[1], lo[2], lo[3]};
    *(LAS u32x4*)(VT + (2 * cp + 1) * ST64 + tg * 16) = (u32x4){hi[0], hi[1], hi[2], hi[3]};
}

__device__ __forceinline__ void ml_passA(Frame& F, int task) {
    const int b = task / (4 * NTC), h = (task / NTC) & 3, tc = task % NTC, row0 = chunk_row0(b, tc);
    LAS unsigned char* VT = F.lds; LAS unsigned char* KT = F.lds + 18432;
    LAS float* wts = (LAS float*)(F.lds + 36864);
    const bf16* P = (const bf16*)(F.ws + WS_P); const bf16* CQK = (const bf16*)(F.ws + WS_CQK);
    const float* GT = (const float*)(F.ws + WS_GATES); float* MLS = (float*)(F.ws + WS_MLS);
    const int sidf = (b * 4 + h) * 2;
    __syncthreads();
    if (F.wave == 0) { const int s = F.lane; const float* gp = GT + (size_t)(row0 + s) * 16;
        const float igf = gp[h], igb = gp[4 + h], lff = gp[8 + h], lfb = gp[12 + h];
        const float pf = wave_incl_sum(lff, s), gf = __shfl(pf, 63), ef = (gf - pf) + igf, mf = wave_max(ef);
        const float pb = wave_incl_sum(lfb, s), gb = __shfl(pb, 63), eb = (pb - lfb) + igb, mb = wave_max(eb);
        wts[s] = __expf(ef - mf); wts[64 + s] = __expf(eb - mb);
        if (s == 0) { float* o = MLS + (size_t)(sidf * NTC + tc) * 4; o[0] = gf; o[1] = mf; o = MLS + (size_t)((sidf + 1) * NTC + tc) * 4; o[0] = gb; o[1] = mb; } }
    stage_vt(VT, P, PW, row0, PC_V + h * 128, F.tid);
    __syncthreads();
    { const int cp = F.tid & 31, tg = F.tid >> 5; unsigned kw[4];
#pragma unroll
      for (int i = 0; i < 4; ++i) kw[i] = *(const unsigned*)(CQK + (size_t)(row0 + tg * 4 + i) * 512 + 256 + h * 64 + 2 * cp);
#pragma unroll
      for (int dir = 0; dir < 2; ++dir) { float lo[4], hi[4];
#pragma unroll
          for (int i = 0; i < 4; ++i) { const float w = wts[dir * 64 + tg * 4 + i]; lo[i] = bflo(kw[i]) * w; hi[i] = bfhi(kw[i]) * w; }
          *(LAS u32x2*)(KT + dir * 9216 + (2 * cp) * ST64 + tg * 8) = (u32x2){pk2(lo[0], lo[1]), pk2(lo[2], lo[3])};
          *(LAS u32x2*)(KT + dir * 9216 + (2 * cp + 1) * ST64 + tg * 8) = (u32x2){pk2(hi[0], hi[1]), pk2(hi[2], hi[3])}; } }
    __syncthreads();
    { const int dir = F.wave >> 2, mt = F.wave & 3; float* C = (float*)(F.ws + WS_MLC) + (size_t)((sidf + dir) * NTC + tc) * 8192;
#pragma unroll
      for (int nt = 0; nt < 2; ++nt) { f32x16 acc;
#pragma unroll
          for (int i = 0; i < 16; ++i) acc[i] = 0.f;
          mm32<64>(acc, VT + 32 * mt * ST64, ST64, KT + dir * 9216 + 32 * nt * ST64, ST64, F.lane);
#pragma unroll
          for (int r = 0; r < 16; ++r) C[(32 * mt + rowmap(r, F.lane >> 5)) * 64 + 32 * nt + (F.lane & 31)] = acc[r]; } }
    if (F.tid < 128) { const int dir = F.tid >> 6, d = F.tid & 63; const LAS unsigned char* rp = KT + dir * 9216 + d * ST64; float sum = 0.f;
#pragma unroll
        for (int i = 0; i < 8; ++i) { const u32x4 w = *(const LAS u32x4*)(rp + i * 16); sum += (bflo(w.x) + bfhi(w.x)) + (bflo(w.y) + bfhi(w.y)) + (bflo(w.z) + bfhi(w.z)) + (bflo(w.w) + bfhi(w.w)); }
        ((float*)(F.ws + WS_MLN))[(size_t)((sidf + dir) * NTC + tc) * 64 + d] = sum; }
}
__device__ __forceinline__ int tc_seq(int dir, int j) { return dir == 0 ? j : (j < 4 ? 3 - j : 135 - j); }
__device__ __forceinline__ void ml_passB(Frame& F) {
    float* MLS = (float*)(F.ws + WS_MLS);
    for (int item = F.vcu * NTHR + F.tid; item < 16 * 8256; item += F.G * NTHR) {
        const int scan = item / 8256, e = item % 8256, dir = scan & 1;
        float* base = e < 8192 ? (float*)(F.ws + WS_MLC) + (size_t)scan * NTC * 8192 + e : (float*)(F.ws + WS_MLN) + (size_t)scan * NTC * 64 + (e - 8192);
        const int stride = e < 8192 ? 8192 : 64;
        float m = 0.f, st = 0.f;
        for (int j0 = 0; j0 < NTC; j0 += 12) {
            float dv[12];
#pragma unroll
            for (int i = 0; i < 12; ++i) dv[i] = base[(size_t)tc_seq(dir, j0 + i) * stride];
#pragma unroll
            for (int i = 0; i < 12; ++i) { const int tc = tc_seq(dir, j0 + i); float* sp = MLS + (size_t)(scan * NTC + tc) * 4;
                const float g = sp[0], ml = sp[1], mn = fmaxf(g + m, ml), a = __expf(g + m - mn), w = __expf(ml - mn);
                if (e == 0) sp[2] = m;
                base[(size_t)tc * stride] = st; st = a * st + w * dv[i]; m = mn; }
        }
    }
}
__device__ __forceinline__ void ml_passC(Frame& F, int task) {
    const int b = task / (4 * NTC), h = (task / NTC) & 3, tc = task % NTC, row0 = chunk_row0(b, tc);
    LAS unsigned char* Q = F.lds; LAS unsigned char* Kn = F.lds + 9216; LAS unsigned char* VT = F.lds + 18432; LAS unsigned char* Cs = F.lds + 36864;
    LAS unsigned char* Pm = F.lds + 55296; LAS unsigned char* Qs = F.lds + 64512;
    LAS float* sm = (LAS float*)(F.lds + 73728);
    const bf16* P = (const bf16*)(F.ws + WS_P); const bf16* CQK = (const bf16*)(F.ws + WS_CQK);
    const float* GT = (const float*)(F.ws + WS_GATES); const float* MLS = (const float*)(F.ws + WS_MLS);
    const int sidf = (b * 4 + h) * 2, tid = F.tid, lane = F.lane;
    __syncthreads();
    { const int row = tid >> 3, pc = tid & 7;
      *(LAS u32x4*)(Q + row * ST64 + pc * 16) = *(const u32x4*)(CQK + (size_t)(row0 + row) * 512 + h * 64 + pc * 8);
      *(LAS u32x4*)(Kn + row * ST64 + pc * 16) = *(const u32x4*)(CQK + (size_t)(row0 + row) * 512 + 256 + h * 64 + pc * 8); }
    stage_vt(VT, P, PW, row0, PC_V + h * 128, tid);
    if (F.wave < 2) { const int dir = F.wave, s = lane; const float* gp = GT + (size_t)(row0 + s) * 16; const float ig = gp[dir * 4 + h], lf = gp[8 + dir * 4 + h];
        const float ms = MLS[(size_t)((sidf + dir) * NTC + tc) * 4 + 2];
        float bt, u, pm;
        if (dir == 0) { bt = wave_incl_sum(lf, s); u = ig - bt; pm = wave_incl_max(u, s); }
        else { const float pf = wave_incl_sum(lf, s), tot = __shfl(pf, 63); bt = tot - pf + lf; u = ig - bt;
               float r = __shfl(u, 63 - s); r = wave_incl_max(r, s); pm = __shfl(r, 63 - s); }
        const float M = fmaxf(ms, pm);
        LAS float* o = sm + dir * 256; o[s] = u; o[64 + s] = M; o[128 + s] = __expf(ms - M); o[192 + s] = __expf(-(bt + M)); }
    __syncthreads();
    f32x16 qk;
#pragma unroll
    for (int i = 0; i < 16; ++i) qk[i] = 0.f;
    if (F.wave < 4) mm32<64>(qk, Q + 32 * (F.wave >> 1) * ST64, ST64, Kn + 32 * (F.wave & 1) * ST64, ST64, lane);
    f32x16 hs;
#pragma unroll
    for (int i = 0; i < 16; ++i) hs[i] = 0.f;
#pragma unroll 1
    for (int dir = 0; dir < 2; ++dir) {
        const LAS float* sd = sm + dir * 256;
        { const float* C = (const float*)(F.ws + WS_MLC) + (size_t)((sidf + dir) * NTC + tc) * 8192; const int v = tid >> 2, pc = tid & 3;
          const f32x4* cp = (const f32x4*)(C + v * 64 + pc * 16); const f32x4 c0 = cp[0], c1 = cp[1], c2 = cp[2], c3 = cp[3];
          *(LAS u32x4*)(Cs + v * ST64 + pc * 32) = (u32x4){pk2(c0.x, c0.y), pk2(c0.z, c0.w), pk2(c1.x, c1.y), pk2(c1.z, c1.w)};
          *(LAS u32x4*)(Cs + v * ST64 + pc * 32 + 16) = (u32x4){pk2(c2.x, c2.y), pk2(c2.z, c2.w), pk2(c3.x, c3.y), pk2(c3.z, c3.w)}; }
        { const int row = tid >> 3, pc = tid & 7; const u32x4 q = *(const LAS u32x4*)(Q + row * ST64 + pc * 16); const float w = sd[128 + row];
          *(LAS u32x4*)(Qs + row * ST64 + pc * 16) = (u32x4){pk2(bflo(q.x) * w, bfhi(q.x) * w), pk2(bflo(q.y) * w, bfhi(q.y) * w), pk2(bflo(q.z) * w, bfhi(q.z) * w), pk2(bflo(q.w) * w, bfhi(q.w) * w)}; }
        if (tid < 64) sm[512 + tid] = ((const float*)(F.ws + WS_MLN))[(size_t)((sidf + dir) * NTC + tc) * 64 + tid];
        if (F.wave < 4) { const int s = 32 * (F.wave & 1) + (lane & 31); const float us = sd[s];
#pragma unroll
            for (int r = 0; r < 16; ++r) { const int t = 32 * (F.wave >> 1) + rowmap(r, lane >> 5); const bool ok = dir == 0 ? (s <= t) : (s >= t);
                const float p = ok ? qk[r] * __expf(us - sd[64 + t]) : 0.f;
                *(LAS unsigned short*)(Pm + t * ST64 + s * 2) = (unsigned short)f2bf(p); } }
        __syncthreads();
        if (tid < 64) { const int t = tid; float den = 0.f, qn = 0.f;
#pragma unroll
            for (int i = 0; i < 8; ++i) { const u32x4 w = *(const LAS u32x4*)(Pm + t * ST64 + i * 16); den += (bflo(w.x) + bfhi(w.x)) + (bflo(w.y) + bfhi(w.y)) + (bflo(w.z) + bfhi(w.z)) + (bflo(w.w) + bfhi(w.w));
                const u32x4 q = *(const LAS u32x4*)(Q + t * ST64 + i * 16); const LAS float* nv = sm + 512 + i * 8;
                qn += bflo(q.x) * nv[0] + bfhi(q.x) * nv[1] + bflo(q.y) * nv[2] + bfhi(q.y) * nv[3] + bflo(q.z) * nv[4] + bfhi(q.z) * nv[5] + bflo(q.w) * nv[6] + bfhi(q.w) * nv[7]; }
            den += sd[128 + t] * qn; sm[576 + t] = 1.f / fmaxf(fabsf(den), sd[192 + t]); }
        f32x16 acc;
#pragma unroll
        for (int i = 0; i < 16; ++i) acc[i] = 0.f;
        { const int mt = F.wave >> 2, nt = F.wave & 3;
          mm32<64>(acc, Pm + 32 * mt * ST64, ST64, VT + 32 * nt * ST64, ST64, lane);
          mm32<64>(acc, Qs + 32 * mt * ST64, ST64, Cs + 32 * nt * ST64, ST64, lane); }
        __syncthreads();
#pragma unroll
        for (int r = 0; r < 16; ++r) hs[r] += acc[r] * sm[576 + 32 * (F.wave >> 2) + rowmap(r, lane >> 5)];
        __syncthreads();
    }
    { float* HF = (float*)(F.ws + WS_HF); const int mt = F.wave >> 2, nt = F.wave & 3;
#pragma unroll
      for (int r = 0; r < 16; ++r) HF[(size_t)(row0 + 32 * mt + rowmap(r, lane >> 5)) * D + h * 128 + 32 * nt + (lane & 31)] = hs[r]; }
}


struct HgPrep { float k[16], x[16]; float T[4]; };
template <int dir>
__device__ __forceinline__ void hg_prep(Frame& F, CArgs& A, int l, int h, int row0, LAS float* tot, HgPrep& R) {
    const int d = F.tid & 127, qtr = F.tid >> 7, ch = h * 128 + d;
    float lb = 0.f;
    if (l == 1) { const float r0 = A.in[I_HGLB][ch], r1 = A.in[I_HGLB][512 + ch], mx = fmaxf(r0, r1), e0 = __expf(r0 - mx), e1 = __expf(r1 - mx); lb = e1 / (e0 + e1); }
    const float bias = A.in[I_HGFB][l * 1024 + dir * 512 + ch], omlb = 1.f - lb;
    const bf16* P = (const bf16*)(F.ws + WS_P) + (size_t)(row0 + qtr * 16) * PW + (dir == 0 ? PC_FF : PC_FB) + ch;
    float cs = 0.f;
#pragma unroll
    for (int i = 0; i < 16; ++i) {
        const float z = fminf(fmaxf(bf2f(P[(size_t)i * PW]) + bias, -30.f), 30.f);
        const float ez = __expf(-z), sg = 1.f / (1.f + ez);
        R.k[i] = omlb * ez * sg;
        const float lf = __logf(lb + omlb * sg);
        if (dir == 0) { cs += lf; R.x[i] = cs; } else { R.x[i] = cs; cs += lf; } }
    tot[dir * 512 + qtr * 128 + d] = cs;
    __syncthreads();
    float off = 0.f;
#pragma unroll
    for (int q = 0; q < 4; ++q) { R.T[q] = tot[dir * 512 + q * 128 + d]; if (q < qtr) off += R.T[q]; }
#pragma unroll
    for (int i = 0; i < 16; ++i) R.x[i] += off;
}
__device__ __forceinline__ void put16(LAS unsigned char* p, const float (&v)[16]) {
    *(LAS u32x4*)p = (u32x4){pk2(v[0], v[1]), pk2(v[2], v[3]), pk2(v[4], v[5]), pk2(v[6], v[7])};
    *(LAS u32x4*)(p + 16) = (u32x4){pk2(v[8], v[9]), pk2(v[10], v[11]), pk2(v[12], v[13]), pk2(v[14], v[15])};
}
__device__ __forceinline__ void hg_passA(Frame& F, CArgs& A, int l, int task) {
    const int b = task / (4 * NTC), h = (task / NTC) & 3, tc = task % NTC, row0 = chunk_row0(b, tc);
    LAS unsigned char* VT = F.lds; LAS unsigned char* KT = F.lds + 18432; LAS float* tot = (LAS float*)(F.lds + 55296);
    const int sidf = (b * 4 + h) * 2, d = F.tid & 127, qtr = F.tid >> 7;
    __syncthreads();
    stage_vt(VT, (const bf16*)(F.ws + WS_CQI), 1024, row0, 512 + h * 128, F.tid);
    float* GG = (float*)(F.ws + WS_HGG);
    { HgPrep R; hg_prep<0>(F, A, l, h, row0, tot, R);
      const float G = (R.T[0] + R.T[1]) + (R.T[2] + R.T[3]);
      if (qtr == 0) GG[(size_t)(sidf * NTC + tc) * 128 + d] = G;
      float t[16];
#pragma unroll
      for (int i = 0; i < 16; ++i) t[i] = R.k[i] * __expf(G - R.x[i]);
      put16(KT + d * ST64 + qtr * 32, t); }
    { HgPrep R; hg_prep<1>(F, A, l, h, row0, tot, R);
      const float G = (R.T[0] + R.T[1]) + (R.T[2] + R.T[3]);
      if (qtr == 0) GG[(size_t)((sidf + 1) * NTC + tc) * 128 + d] = G;
      float t[16];
#pragma unroll
      for (int i = 0; i < 16; ++i) t[i] = R.k[i] * __expf(R.x[i]);
      put16(KT + 18432 + d * ST64 + qtr * 32, t); }
    __syncthreads();
    { const int dir = F.wave >> 2, mt = F.wave & 3; float* S = (float*)(F.ws + WS_HGS) + (size_t)((sidf + dir) * NTC + tc) * 16384;
#pragma unroll
      for (int nt = 0; nt < 4; ++nt) { f32x16 acc;
#pragma unroll
          for (int i = 0; i < 16; ++i) acc[i] = 0.f;
          mm32<64>(acc, VT + 32 * mt * ST64, ST64, KT + dir * 18432 + 32 * nt * ST64, ST64, F.lane);
#pragma unroll
          for (int r = 0; r < 16; ++r) S[(32 * mt + rowmap(r, F.lane >> 5)) * 128 + 32 * nt + (F.lane & 31)] = acc[r]; } }
}
__device__ __forceinline__ void hg_passB(Frame& F) {
    const float* GG = (const float*)(F.ws + WS_HGG);
    for (int item = F.vcu * NTHR + F.tid; item < 16 * 16384; item += F.G * NTHR) {
        const int scan = item >> 14, e = item & 16383, dir = scan & 1, d = e & 127;
        float* base = (float*)(F.ws + WS_HGS) + (size_t)scan * NTC * 16384 + e;
        const float* gb = GG + (size_t)scan * NTC * 128 + d;
        float st = 0.f;
        for (int j0 = 0; j0 < NTC; j0 += 12) {
            float dv[12], gv[12];
#pragma unroll
            for (int i = 0; i < 12; ++i) { const int tc = tc_seq(dir, j0 + i); dv[i] = base[(size_t)tc * 16384]; gv[i] = gb[tc * 128]; }
#pragma unroll
            for (int i = 0; i < 12; ++i) { const int tc = tc_seq(dir, j0 + i); base[(size_t)tc * 16384] = st; st = __expf(gv[i]) * st + dv[i]; }
        }
    }
}
__device__ __forceinline__ void hg_passC(Frame& F, CArgs& A, int l, int task) {
    const int b = task / (4 * NTC), h = (task / NTC) & 3, tc = task % NTC, row0 = chunk_row0(b, tc);
    LAS unsigned char* VT = F.lds; LAS unsigned char* Ss = F.lds + 18432; LAS unsigned char* Qh = F.lds + 53248; LAS unsigned char* Kh = F.lds + 70656;
    LAS unsigned char* Qc = F.lds + 88064; LAS unsigned char* Kc = F.lds + 96768; LAS unsigned char* Qt = F.lds + 105472; LAS unsigned char* Am = F.lds + 122880;
    LAS float* tot = (LAS float*)(F.lds + 132096);
    const bf16* CQI = (const bf16*)(F.ws + WS_CQI);
    const int sidf = (b * 4 + h) * 2, tid = F.tid, lane = F.lane, d = tid & 127, qtr = tid >> 7;
    __syncthreads();
    stage_vt(VT, CQI, 1024, row0, 512 + h * 128, tid);
    f32x16 acc;
#pragma unroll
    for (int i = 0; i < 16; ++i) acc[i] = 0.f;
#pragma unroll
    for (int dir = 0; dir < 2; ++dir) {
        HgPrep R;
        if (dir == 0) hg_prep<0>(F, A, l, h, row0, tot, R); else hg_prep<1>(F, A, l, h, row0, tot, R);
        float q[16];
#pragma unroll
        for (int i = 0; i < 16; ++i) q[i] = bf2f(CQI[(size_t)(row0 + qtr * 16 + i) * 1024 + h * 128 + d]);
        const float T0 = R.T[0], T1 = R.T[1], T2 = R.T[2], T3 = R.T[3];
        const float sg = dir == 0 ? 1.f : -1.f;
        const float rI = sg * ((qtr >> 1) == 0 ? T0 : (T0 + T1) + T2);
        const float rO = sg * (T0 + T1);
        const float Gall = (T0 + T1) + (T2 + T3);
        { const float* S = (const float*)(F.ws + WS_HGS) + (size_t)((sidf + dir) * NTC + tc) * 16384; const int v = tid >> 2, pc = tid & 3;
          const f32x4* sp = (const f32x4*)(S + v * 128 + pc * 32);
#pragma unroll
          for (int j = 0; j < 2; ++j) { const f32x4 c0 = sp[4 * j], c1 = sp[4 * j + 1], c2 = sp[4 * j + 2], c3 = sp[4 * j + 3];
              *(LAS u32x4*)(Ss + v * ST128 + pc * 64 + j * 32) = (u32x4){pk2(c0.x, c0.y), pk2(c0.z, c0.w), pk2(c1.x, c1.y), pk2(c1.z, c1.w)};
              *(LAS u32x4*)(Ss + v * ST128 + pc * 64 + j * 32 + 16) = (u32x4){pk2(c2.x, c2.y), pk2(c2.z, c2.w), pk2(c3.x, c3.y), pk2(c3.z, c3.w)}; } }
#pragma unroll
        for (int i = 0; i < 16; ++i) {
            const int t = qtr * 16 + i; const float x = dir == 0 ? R.x[i] : -R.x[i], kk = R.k[i];
            const float eh = __expf(x - rI);
            *(LAS unsigned short*)(Qh + t * ST128 + d * 2) = (unsigned short)f2bf(q[i] * eh);
            *(LAS unsigned short*)(Kh + t * ST128 + d * 2) = (unsigned short)f2bf(kk * __expf(rI - x));
            const bool isq = dir == 0 ? (qtr >= 2) : (qtr < 2);
            if (isq) *(LAS unsigned short*)(Qc + (t & 31) * ST128 + d * 2) = (unsigned short)f2bf(q[i] * __expf(x - rO));
            else     *(LAS unsigned short*)(Kc + (t & 31) * ST128 + d * 2) = (unsigned short)f2bf(kk * __expf(rO - x));
            *(LAS unsigned short*)(Qt + t * ST128 + d * 2) = (unsigned short)f2bf(q[i] * __expf(dir == 0 ? x : Gall + x));
        }
        __syncthreads();
        if (F.wave < 4) { f32x16 a;
#pragma unroll
            for (int i = 0; i < 16; ++i) a[i] = 0.f;
            int tt = 0, ts = 0;
            if (F.wave < 2) { tt = ts = F.wave; mm32<128>(a, Qh + 32 * tt * ST128, ST128, Kh + 32 * ts * ST128, ST128, lane);
#pragma unroll
                for (int r = 0; r < 16; ++r) { const int tl = rowmap(r, lane >> 5), sl = lane & 31; const bool ok = dir == 0 ? (sl <= tl) : (sl >= tl); a[r] = ok ? a[r] : 0.f; } }
            else if (F.wave == 2) { tt = dir == 0 ? 1 : 0; ts = 1 - tt; mm32<128>(a, Qc, ST128, Kc, ST128, lane); }
            else { tt = dir == 0 ? 0 : 1; ts = 1 - tt; }
#pragma unroll
            for (int r = 0; r < 16; ++r) *(LAS unsigned short*)(Am + (32 * tt + rowmap(r, lane >> 5)) * ST64 + (32 * ts + (lane & 31)) * 2) = (unsigned short)f2bf(a[r]); }
        __syncthreads();
        { const int mt = F.wave >> 2, nt = F.wave & 3;
          mm32<64>(acc, Am + 32 * mt * ST64, ST64, VT + 32 * nt * ST64, ST64, lane);
          mm32<128>(acc, Qt + 32 * mt * ST128, ST128, Ss + 32 * nt * ST128, ST128, lane); }
        __syncthreads();
    }
    { float* HF = (float*)(F.ws + WS_HF); const int mt = F.wave >> 2, nt = F.wave & 3;
#pragma unroll
      for (int r = 0; r < 16; ++r) HF[(size_t)(row0 + 32 * mt + rowmap(r, lane >> 5)) * D + 512 + h * 128 + 32 * nt + (lane & 31)] = acc[r]; }
}

__device__ __forceinline__ void transpose_item(const float* W, int ldw, int K, bf16* WT, int k0, int n0, int drow0, LAS float* scr, int lane) {
#pragma unroll 8
    for (int i = 0; i < 32; ++i) { const int kk = 2 * i + (lane >> 5); scr[kk * 33 + (lane & 31)] = W[(size_t)(k0 + kk) * ldw + n0 + (lane & 31)]; }
    asm volatile("s_waitcnt lgkmcnt(0)" ::: "memory");
    const int c = lane & 7;
#pragma unroll
    for (int j = 0; j < 4; ++j) { const int n = (lane >> 3) + 8 * j; const LAS float* s = scr + (8 * c) * 33 + n;
        u32x4 o; o.x = pk2(s[0 * 33], s[1 * 33]); o.y = pk2(s[2 * 33], s[3 * 33]); o.z = pk2(s[4 * 33], s[5 * 33]); o.w = pk2(s[6 * 33], s[7 * 33]);
        *(u32x4*)(WT + (size_t)(drow0 + n) * K + k0 + 8 * c) = o; }
    asm volatile("s_waitcnt lgkmcnt(0)" ::: "memory");
}
__device__ __forceinline__ void ph_convert(Frame& F, CArgs& A) {
    LAS float* scr = (LAS float*)(F.lds + 32768 + F.wave * 8448);
    const int gw = F.vcu * NWAVES + F.wave, NGW = F.G * NWAVES;
    constexpr int I_IN = DEPTH * 16 * 128, I_OUT = DEPTH * 16 * 32, I_GU = DEPTH * NEXP * 16 * 64, I_DN = DEPTH * NEXP * 16 * 32;
    for (int it = gw; it < I_IN + I_OUT + I_GU + I_DN; it += NGW) {
        int r = it;
        if (r < I_IN) { const int l = r / 2048, q = r % 2048, kb = q / 128, nb = q % 128, d0 = nb * 32, n0 = d0 < 1536 ? d0 : d0 + 16;
            transpose_item(A.in[I_WIN] + (size_t)l * D * INW, INW, D, (bf16*)(F.ws + WS_WIN) + (size_t)l * PW * D, kb * 64, n0, d0, scr, F.lane); continue; }
        r -= I_IN;
        if (r < I_OUT) { const int l = r / 512, q = r % 512, kb = q / 32, nb = q % 32;
            transpose_item(A.in[I_WOUT] + (size_t)l * D * D, D, D, (bf16*)(F.ws + WS_WOUT) + (size_t)l * D * D, kb * 64, nb * 32, nb * 32, scr, F.lane); continue; }
        r -= I_OUT;
        if (r < I_GU) { const int m = r / 1024, q = r % 1024, kb = q / 64, nb = q % 64, n0 = nb * 32;
            const int cc = n0 & 1023, d0 = (cc >> 7) * 256 + (n0 >= 1024 ? 128 : 0) + (cc & 127);
            transpose_item(A.in[I_WGU] + (size_t)m * D * 2048, 2048, D, (bf16*)(F.ws + WS_WGU) + (size_t)m * 2048 * D, kb * 64, n0, d0, scr, F.lane); continue; }
        r -= I_GU;
        { const int m = r / 512, q = r % 512, kb = q / 32, nb = q % 32;
            transpose_item(A.in[I_WDN] + (size_t)m * DEXP * D, D, DEXP, (bf16*)(F.ws + WS_WDN) + (size_t)m * D * DEXP, kb * 64, nb * 32, nb * 32, scr, F.lane); }
    }
}


#define XB_TMO      128
#define XB_XCNT(j)  (256  + 64 * (j))
#define XB_XSUB(j)  (1280 + 64 * (j))
#define XB_XGEN(j)  (2304 + 64 * (j))
#define XB_TOP      3328
#define XB_TOPGEN   3392
#define XCD_BAR_WORDS 3456
#define XB_SPIN_CAP (1u << 18)
__device__ __forceinline__ unsigned xb_ld(unsigned* p)              { return __hip_atomic_load(p, __ATOMIC_RELAXED, __HIP_MEMORY_SCOPE_AGENT); }
__device__ __forceinline__ unsigned xb_add(unsigned* p, unsigned v) { return __hip_atomic_fetch_add(p, v, __ATOMIC_RELAXED, __HIP_MEMORY_SCOPE_AGENT); }
__device__ __forceinline__ unsigned xb_xcc_id() { return (unsigned)__builtin_amdgcn_s_getreg((3 << 11) | 20) & 0xFu; }
#define XB_SPIN(cond, bar) do { unsigned _sp = 0; while (cond) { __builtin_amdgcn_s_sleep(1); \
    if ((++_sp & 255u) == 0u) { if (xb_ld(&(bar)[XB_TMO])) break; if (_sp > XB_SPIN_CAP) { atomicAdd(&(bar)[XB_TMO], 1u); break; } } } } while (0)
struct XcdBarrier { unsigned* bar; unsigned x; volatile LAS unsigned* st; };
__device__ __forceinline__ XcdBarrier xcd_barrier_post(unsigned* bar, volatile LAS unsigned* st) {
    XcdBarrier b; b.bar = bar; b.x = xb_xcc_id(); b.st = st;
    if (threadIdx.x == 0) (void)xb_add(&bar[XB_XCNT(b.x)], 1u);
    return b;
}
__device__ __forceinline__ void xcd_barrier_complete(unsigned* bar, unsigned x, unsigned& nloc, unsigned& nx) {
    const unsigned G = gridDim.x * gridDim.y * gridDim.z;
    unsigned sum, cnt, mine, sp = 0u;
    for (;;) {
        sum = 0u; cnt = 0u; mine = 0u;
#pragma unroll
        for (unsigned j = 0; j < 16; ++j) { const unsigned c = xb_ld(&bar[XB_XCNT(j)]); sum += c; cnt += (c > 0u) ? 1u : 0u; mine = (j == x) ? c : mine; }
        if (sum == G) break;
        __builtin_amdgcn_s_sleep(1);
        if ((++sp & 255u) == 0u) { if (xb_ld(&bar[XB_TMO])) break; if (sp > XB_SPIN_CAP) { atomicAdd(&bar[XB_TMO], 1u); break; } }
    }
    nloc = mine > 0u ? mine : 1u; nx = cnt > 0u ? cnt : 1u;
}
__device__ __forceinline__ void xcd_barrier(const XcdBarrier& b) {
    asm volatile("s_waitcnt vmcnt(0)" ::: "memory");
    __syncthreads();
    if (threadIdx.x == 0) {
        unsigned* bar = b.bar;
        __builtin_amdgcn_s_waitcnt(0);
        unsigned nloc = b.st[0], nx = b.st[1];
        if (nloc == 0u) { xcd_barrier_complete(bar, b.x, nloc, nx); b.st[0] = nloc; b.st[1] = nx; }
        const unsigned old = xb_add(&bar[XB_XSUB(b.x)], 1u);
        const unsigned gen = old / nloc;
        if (old + 1u == (gen + 1u) * nloc) {
            __builtin_amdgcn_fence(__ATOMIC_RELEASE, "agent");
            asm volatile("s_waitcnt vmcnt(0)" ::: "memory");
            const unsigned og = xb_add(&bar[XB_TOP], 1u);
            const unsigned tg = og / nx;
            if (og + 1u == (tg + 1u) * nx) xb_add(&bar[XB_TOPGEN], 1u);
            else XB_SPIN(xb_ld(&bar[XB_TOPGEN]) == tg, bar);
            __builtin_amdgcn_fence(__ATOMIC_ACQUIRE, "agent");
            xb_add(&bar[XB_XGEN(b.x)], 1u);
            asm volatile("s_waitcnt vmcnt(0)" ::: "memory");
        } else {
            XB_SPIN(xb_ld(&bar[XB_XGEN(b.x)]) == gen, bar);
            __builtin_amdgcn_fence(__ATOMIC_ACQUIRE, "agent");
            asm volatile("s_waitcnt vmcnt(0)" ::: "memory");
        }
    }
    __syncthreads();
}

enum { PH_INIT = 0, PH_NORM1, PH_INPROJ, PH_CONV, PH_SCANA, PH_SCANB, PH_SCANC, PH_HNORM, PH_OUTPROJ, PH_NORM2, PH_LISTS, PH_GU, PH_DOWN, PH_COMBINE, PH_FINAL };

constexpr int NPHASE = 1 + 13 * DEPTH + 1;
template <int ph, int l>
__device__ __forceinline__ void run_phase(LAS unsigned char* lds_raw) {
    int tid_ = threadIdx.x; asm volatile("" : "+v"(tid_));
    CArgs* ap_ = (CArgs*)__builtin_amdgcn_kernarg_segment_ptr(); asm volatile("" : "+s"(ap_));
    CArgs& A_ = *ap_;
    unsigned char* ws_ = A_.ws; asm volatile("" : "+s"(ws_));
    unsigned lb_ = 0u, bx_ = blockIdx.x, gx_ = gridDim.x; asm volatile("" : "+s"(lb_), "+s"(bx_), "+s"(gx_));
    Frame F; F.lds = lds_raw + lb_; F.out = A_.out; F.ws = ws_;
    F.tid = tid_; F.lane = F.tid & 63; F.wave = __builtin_amdgcn_readfirstlane(F.tid >> 6);
    F.G = (int)gx_; { const int bx = (int)bx_; F.vcu = (F.G % 8 == 0) ? (bx % 8) * (F.G / 8) + bx / 8 : bx; }
    constexpr int nrows = (l == DEPTH - 1) ? NLAT : NTOK;
    switch (ph) {
        case PH_INIT: ph_init(F, A_); ph_convert(F, A_); break;
        case PH_INPROJ: { pg8::Gemm g{(const bf16*)(F.ws + WS_H), (const bf16*)(F.ws + WS_WIN) + (size_t)l * PW * D, D, nullptr, nullptr, 0};
            pg8::StaticOrder S; S.init(NTOK / 256, PW / 256, F.G, (int)bx_); pg8::EpiBf16 E{(bf16*)(F.ws + WS_P), PW};
            pg8::gemm_phase<pg8::EpiBf16, pg8::StaticOrder, true>(F.lds, g, S, E, F.tid); } break;
        case PH_NORM1: ph_norm<0>(F, A_, l, NTOK); break;
        case PH_CONV: ph_conv(F, A_, l); break;
        case PH_SCANA: for (int t = F.vcu; t < 16 * NTC; t += F.G) { if (t < 8 * NTC) ml_passA(F, t); else hg_passA(F, A_, l, t - 8 * NTC); } break;
        case PH_SCANB: ml_passB(F); hg_passB(F); break;
        case PH_SCANC: for (int t = F.vcu; t < 16 * NTC; t += F.G) { if (t < 8 * NTC) ml_passC(F, t); else hg_passC(F, A_, l, t - 8 * NTC); } break;
        case PH_OUTPROJ: { pg8::Gemm g{(const bf16*)(F.ws + WS_Y), (const bf16*)(F.ws + WS_WOUT) + (size_t)l * D * D, D, nullptr, nullptr, 0};
            pg8::StaticOrder S; S.init(nrows / 256, D / 256, F.G, (int)bx_);
            pg8::EpiResid E{(float*)(F.ws + WS_X), (const float*)(F.ws + WS_MOD) + (size_t)l * 3 * 6144 + 2048};
            pg8::gemm_phase<pg8::EpiResid, pg8::StaticOrder, true>(F.lds, g, S, E, F.tid); } break;
        case PH_GU: { const int* rt = (const int*)(F.ws + WS_ROUTE); const int ntile = rt[RT_TILEE];
            pg8::Gemm g{(const bf16*)(F.ws + WS_H), (const bf16*)(F.ws + WS_WGU) + (size_t)l * NEXP * 2048 * D, D, rt + RT_LIST, rt + RT_TILEE, (size_t)2048 * D};
            pg8::StaticOrder S; S.init(ntile, 2048 / 256, F.G, (int)bx_);
            pg8::EpiSwiglu E{(bf16*)(F.ws + WS_ACT), A_.in[I_BGU] + (size_t)l * NEXP * 2048, rt + RT_TILEE};
            pg8::gemm_phase<pg8::EpiSwiglu, pg8::StaticOrder, true>(F.lds, g, S, E, F.tid); } break;
        case PH_DOWN: { const int* rt = (const int*)(F.ws + WS_ROUTE); const int ntile = rt[RT_TILEE];
            pg8::Gemm g{(const bf16*)(F.ws + WS_ACT), (const bf16*)(F.ws + WS_WDN) + (size_t)l * NEXP * D * DEXP, DEXP, nullptr, rt + RT_TILEE, (size_t)D * DEXP};
            pg8::StaticOrder S; S.init(ntile, D / 256, F.G, (int)bx_);
            pg8::EpiDown E{(bf16*)(F.ws + WS_YS), A_.in[I_BDN] + (size_t)l * NEXP * D, (const float*)(rt + RT_SGATE), rt + RT_TILEE};
            pg8::gemm_phase<pg8::EpiDown, pg8::StaticOrder, true>(F.lds, g, S, E, F.tid); } break;
        case PH_HNORM: ph_hnorm(F, A_, l, l == DEPTH - 1); break;
        case PH_NORM2: ph_norm<1>(F, A_, l, nrows); break;
        case PH_LISTS: ph_lists(F, A_, l, nrows); break;
        case PH_COMBINE: ph_combine(F, A_, l, nrows); break;
        case PH_FINAL: ph_norm<2>(F, A_, 0, NLAT); break;
        default: break;
    }
}
__global__ void __launch_bounds__(NTHR, 2) fwd(Args a) {
    extern __shared__ __attribute__((aligned(16))) unsigned char lds_raw[];
    volatile LAS unsigned* bst = (volatile LAS unsigned*)((LAS unsigned char*)lds_raw + LDS_BYTES - 64);
    if (threadIdx.x < 16) bst[threadIdx.x] = 0u;
    __syncthreads();
    XcdBarrier bar = xcd_barrier_post((unsigned*)(a.ws + WS_CTL) + CW_BAR, bst);
    const int lo = a.ph_lo, hi = a.ph_hi;
#define RUN(pi, ph, l) do { if (lo <= (pi) && (pi) < hi) { if ((pi) > lo) xcd_barrier(bar); run_phase<ph, l>((LAS unsigned char*)lds_raw); } } while (0)
#define LAYER(l) RUN(1 + 13 * l, PH_NORM1, l); RUN(2 + 13 * l, PH_INPROJ, l); RUN(3 + 13 * l, PH_CONV, l); RUN(4 + 13 * l, PH_SCANA, l); RUN(5 + 13 * l, PH_SCANB, l); RUN(6 + 13 * l, PH_SCANC, l); \
    RUN(7 + 13 * l, PH_HNORM, l); RUN(8 + 13 * l, PH_OUTPROJ, l); RUN(9 + 13 * l, PH_NORM2, l); RUN(10 + 13 * l, PH_LISTS, l); RUN(11 + 13 * l, PH_GU, l); RUN(12 + 13 * l, PH_DOWN, l); RUN(13 + 13 * l, PH_COMBINE, l)
    RUN(0, PH_INIT, 0);
    LAYER(0);
    LAYER(1);
    RUN(NPHASE - 1, PH_FINAL, 0);
#undef LAYER
#undef RUN
}

template <int NB, class Epi>
__global__ void __launch_bounds__(256) naive_gemm(const bf16* A, int lda, const int* gather, const int* tile_e, int M, const float* B, size_t bexp, int ldb, int N, int K, int bshift_from, int bshift, int bgrp, Epi E) {
    __shared__ float As[16][68]; __shared__ float Bs[NB][16][68];
    const int m0 = blockIdx.y * 64, n0 = blockIdx.x * 64, tid = threadIdx.x, tx = tid & 15, ty = tid >> 4;
    int e = 0;
    if (tile_e) { const int nt = tile_e[0]; if (m0 >= nt * 256) return; e = tile_e[8 + (m0 >> 8)]; } else if (m0 >= M) return;
    const float* Bp = B + (size_t)e * bexp + (n0 + (n0 >= bshift_from ? bshift : 0));
    const int ar = tid >> 2, ak = (tid & 3) * 4; const int arow = gather ? gather[m0 + ar] : (m0 + ar);
    const bf16* Ap = A + (size_t)arow * lda + ak;
    const int bk = tid >> 4, bn = (tid & 15) * 4;
    float acc[NB][4][4];
#pragma unroll
    for (int g = 0; g < NB; ++g)
#pragma unroll
        for (int i = 0; i < 4; ++i)
#pragma unroll
            for (int j = 0; j < 4; ++j) acc[g][i][j] = 0.f;
    for (int k0 = 0; k0 < K; k0 += 16) {
        const u32x2 av = *(const u32x2*)(Ap + k0);
        As[ak + 0][ar] = bflo(av.x); As[ak + 1][ar] = bfhi(av.x); As[ak + 2][ar] = bflo(av.y); As[ak + 3][ar] = bfhi(av.y);
#pragma unroll
        for (int g = 0; g < NB; ++g) { const f32x4 bv = *(const f32x4*)(Bp + (size_t)(k0 + bk) * ldb + g * bgrp + bn); *(f32x4*)&Bs[g][bk][bn] = bv; }
        __syncthreads();
#pragma unroll
        for (int k = 0; k < 16; ++k) { const f32x4 a4 = *(const f32x4*)&As[k][ty * 4];
#pragma unroll
            for (int g = 0; g < NB; ++g) { const f32x4 b4 = *(const f32x4*)&Bs[g][k][tx * 4];
#pragma unroll
                for (int i = 0; i < 4; ++i) { acc[g][i][0] += a4[i] * b4[0]; acc[g][i][1] += a4[i] * b4[1]; acc[g][i][2] += a4[i] * b4[2]; acc[g][i][3] += a4[i] * b4[3]; } } }
        __syncthreads();
    }
#pragma unroll
    for (int i = 0; i < 4; ++i)
#pragma unroll
        for (int j = 0; j < 4; ++j) E(m0 + ty * 4 + i, n0 + tx * 4 + j, acc[0][i][j], NB == 2 ? acc[NB - 1][i][j] : 0.f, e);
}
struct EpiP { bf16* P; __device__ void operator()(int r, int c, float v, float, int) const { P[(size_t)r * PW + c] = (bf16)f2bf(v); } };
struct EpiOut { float* X; const float* MOD; __device__ void operator()(int r, int c, float v, float, int) const { X[(size_t)r * D + c] += MOD[mrow_of(r) * 6144 + 2048 + c] * v; } };
struct EpiGU { bf16* ACT; const float* bgu; __device__ void operator()(int r, int c, float g, float li, int e) const {
    g += bgu[(size_t)e * 2048 + c]; li += bgu[(size_t)e * 2048 + 1024 + c]; g = fminf(g, 7.f); li = fminf(fmaxf(li, -7.f), 7.f);
    ACT[(size_t)r * DEXP + c] = (bf16)f2bf(g * sigmoidf_(1.702f * g) * (li + 1.f)); } };
struct EpiDown { bf16* YS; const float* bdn; const float* sgate; __device__ void operator()(int r, int c, float v, float, int e) const { YS[(size_t)r * D + c] = (bf16)f2bf((v + bdn[(size_t)e * D + c]) * sgate[r]); } };

__global__ void __launch_bounds__(128) naive_mlstm(const bf16* CQK, const bf16* P, const float* GATES, float* HF, float* HB) {
    __shared__ float qs[8][64], ks[8][64];
    const int b = blockIdx.x >> 3, h = (blockIdx.x >> 1) & 3, dir = blockIdx.x & 1, tid = threadIdx.x;
    float C[64], n[64], m = 0.f;
#pragma unroll
    for (int d = 0; d < 64; ++d) { C[d] = 0.f; n[d] = 0.f; }
    float* OUT = dir ? HB : HF;
    for (int p0 = 0; p0 < CTX + SEQ; p0 += 8) {
        __syncthreads();
        { const int st = tid >> 4, pc = tid & 15, p = p0 + st; int row;
          if (p < CTX) row = NLAT + b * CTX + (dir ? CTX - 1 - p : p); else { const int q = p - CTX; row = b * SEQ + (dir ? SEQ - 1 - q : q); }
          const u32x4 w = *(const u32x4*)(CQK + (size_t)row * 512 + (pc < 8 ? h * 64 + pc * 8 : 256 + h * 64 + (pc - 8) * 8));
          float* dst = pc < 8 ? &qs[st][pc * 8] : &ks[st][(pc - 8) * 8];
          dst[0] = bflo(w.x); dst[1] = bfhi(w.x); dst[2] = bflo(w.y); dst[3] = bfhi(w.y); dst[4] = bflo(w.z); dst[5] = bfhi(w.z); dst[6] = bflo(w.w); dst[7] = bfhi(w.w); }
        __syncthreads();
        for (int st = 0; st < 8; ++st) {
            const int p = p0 + st; int row;
            if (p < CTX) row = NLAT + b * CTX + (dir ? CTX - 1 - p : p); else { const int q = p - CTX; row = b * SEQ + (dir ? SEQ - 1 - q : q); }
            const float ig = GATES[(size_t)row * 16 + dir * 4 + h], lf = GATES[(size_t)row * 16 + 8 + dir * 4 + h];
            const float v = bf2f(P[(size_t)row * PW + PC_V + h * 128 + tid]);
            const float mn = fmaxf(lf + m, ig), a = __expf(lf + m - mn), w = __expf(ig - mn), wv = w * v; m = mn;
            float num = 0.f, den = 0.f;
#pragma unroll
            for (int d = 0; d < 64; ++d) { const float kd = ks[st][d], qd = qs[st][d]; C[d] = a * C[d] + wv * kd; n[d] = a * n[d] + w * kd; num += C[d] * qd; den += n[d] * qd; }
            OUT[(size_t)row * D + h * 128 + tid] = num / fmaxf(fabsf(den), __expf(-mn));
        }
    }
}
__global__ void __launch_bounds__(128) naive_hgrn(const bf16* CQI, const bf16* P, const float* fb_l, const float* lbraw, int l, float* HF, float* HB) {
    __shared__ float fs[8][128], ks[8][128], qs[8][128];
    const int b = blockIdx.x >> 3, h = (blockIdx.x >> 1) & 3, dir = blockIdx.x & 1, tid = threadIdx.x, ch = h * 128 + tid;
    float S[128];
#pragma unroll
    for (int d = 0; d < 128; ++d) S[d] = 0.f;
    float lb = 0.f;
    if (l == 1) { const float r0 = lbraw[ch], r1 = lbraw[512 + ch], mx = fmaxf(r0, r1), e0 = __expf(r0 - mx), e1 = __expf(r1 - mx); lb = e1 / (e0 + e1); }
    const float bias = fb_l[dir * 512 + ch];
    float* OUT = dir ? HB : HF;
    for (int p0 = 0; p0 < CTX + SEQ; p0 += 8) {
        __syncthreads();
        float vv[8]; int rows[8];
#pragma unroll
        for (int st = 0; st < 8; ++st) { const int p = p0 + st; int row;
            if (p < CTX) row = NLAT + b * CTX + (dir ? CTX - 1 - p : p); else { const int q = p - CTX; row = b * SEQ + (dir ? SEQ - 1 - q : q); }
            rows[st] = row;
            const float z = bf2f(P[(size_t)row * PW + (dir ? PC_FB : PC_FF) + ch]) + bias;
            fs[st][tid] = lb + (1.f - lb) * sigmoidf_(z); ks[st][tid] = (1.f - lb) * sigmoidf_(-z);
            qs[st][tid] = bf2f(CQI[(size_t)row * 1024 + ch]); vv[st] = bf2f(CQI[(size_t)row * 1024 + 512 + ch]); }
        __syncthreads();
#pragma unroll
        for (int st = 0; st < 8; ++st) { float o = 0.f; const float v = vv[st];
#pragma unroll
            for (int d = 0; d < 128; ++d) { S[d] = fs[st][d] * S[d] + ks[st][d] * v; o += qs[st][d] * S[d]; }
            OUT[(size_t)rows[st] * D + 512 + ch] = o; }
    }
}

extern "C" void kernel_launch(void* const* d_in, const int* in_sizes, int n_in, void* d_out, int out_size, void* d_ws, size_t ws_size, hipStream_t stream) {
    static int grid = 0;
    if (grid == 0) {
        if (n_in != 24 || in_sizes[0] != NLAT * D || out_size != NLAT * D || ws_size < WS_END) { fprintf(stderr, "kernel_launch: unexpected shapes n_in %d in0 %d out %d ws %zu (need %zu)\n", n_in, n_in > 0 ? in_sizes[0] : -1, out_size, ws_size, (size_t)WS_END); grid = -1; return; }
        int dev = 0, cus = 0;
        if (hipGetDevice(&dev) != hipSuccess || hipDeviceGetAttribute(&cus, hipDeviceAttributeMultiprocessorCount, dev) != hipSuccess) { grid = -1; return; }
        if (hipFuncSetAttribute((const void*)fwd, hipFuncAttributeMaxDynamicSharedMemorySize, LDS_BYTES) != hipSuccess) { fprintf(stderr, "kernel_launch: hipFuncSetAttribute failed\n"); grid = -1; return; }
        grid = cus;
    }
    if (grid < 0) return;
    (void)hipMemsetAsync((char*)d_ws + WS_CTL, 0, 1 * MiB, stream);
    Args a{};
    for (int i = 0; i < 24; ++i) a.in[i] = (const float*)d_in[i];
    a.out = (float*)d_out; a.ws = (unsigned char*)d_ws; a.ph_lo = 0; a.ph_hi = 0;
    unsigned char* ws = (unsigned char*)d_ws;
    const float* const* in = a.in;
    int* rt = (int*)(ws + WS_ROUTE);
    a.ph_lo = 0; a.ph_hi = NPHASE;
    hipLaunchKernelGGL(fwd, dim3(grid), dim3(NTHR), LDS_BYTES, stream, a);
}
```

```cpp
#include <hip/hip_runtime.h>
#include <cstdio>
#include <cstdint>

#define GAS __attribute__((address_space(1)))
#define LAS __attribute__((address_space(3)))
typedef unsigned short bf16;
typedef float f32x4 __attribute__((ext_vector_type(4)));
typedef unsigned u32x4 __attribute__((ext_vector_type(4)));
typedef unsigned u32x2 __attribute__((ext_vector_type(2)));

constexpr int D = 1024, BATCH = 2, SEQ = 8192, DEPTH = 2, CTX = 256, GRIDW = 64;
constexpr int NLAT = BATCH * SEQ, NCTX = BATCH * CTX, NTOK = NLAT + NCTX;
constexpr int INW = 4112, PW = 4096;
constexpr int PC_QK = 0, PC_V = 512, PC_O = 1024, PC_QI = 1536, PC_FF = 2560, PC_FB = 3072, PC_GO = 3584;
constexpr int NEXP = 32, TOPK = 4, DEXP = 1024;
constexpr int MAXSLOT = (NTOK * TOPK / 256 + NEXP) * 256;
constexpr int MAXTILE = MAXSLOT / 256;
constexpr float EPS = 1e-6f;

constexpr size_t MiB = 1u << 20;
constexpr size_t WS_CTL = 0;
constexpr size_t WS_MOD = 1 * MiB;
constexpr size_t WS_GATES = 2 * MiB;
constexpr size_t WS_ROUTE = 4 * MiB;
constexpr size_t WS_X = 8 * MiB;
constexpr size_t WS_H = 76 * MiB;
constexpr size_t WS_P = 112 * MiB;
constexpr size_t WS_CQK = 246 * MiB;
constexpr size_t WS_CQI = 264 * MiB;
constexpr size_t WS_HF = 300 * MiB;
constexpr size_t WS_HB = 368 * MiB;
constexpr size_t WS_Y = 436 * MiB;
constexpr size_t WS_ACT = 472 * MiB;
constexpr size_t WS_YS = 622 * MiB;
constexpr size_t WS_WIN = 772 * MiB;
constexpr size_t WS_WOUT = 788 * MiB;
constexpr size_t WS_WGU = 792 * MiB;
constexpr size_t WS_WDN = 1048 * MiB;
constexpr size_t WS_MLC = 1176 * MiB;
constexpr size_t WS_MLN = 1246 * MiB;
constexpr size_t WS_MLS = 1247 * MiB;
constexpr size_t WS_HGS = 1248 * MiB;
constexpr size_t WS_HGG = 1388 * MiB;
constexpr size_t WS_MLCB = 1390 * MiB;
constexpr size_t WS_HGSB = 1426 * MiB;
constexpr size_t WS_END = 1496 * MiB;
constexpr int NTC = 132;
constexpr int RT_TOPI = 0;
constexpr int RT_TOPG = RT_TOPI + NTOK * 4;
constexpr int RT_POS = RT_TOPG + NTOK * 4;
constexpr int RT_SLOT = RT_POS + NTOK * 4;
constexpr int RT_LIST = RT_SLOT + NTOK * 4;
constexpr int RT_SGATE = RT_LIST + MAXSLOT;
constexpr int RT_TILEE = RT_SGATE + MAXSLOT;
constexpr int RT_BLKCNT = RT_TILEE + MAXTILE + 8;
constexpr int MAXG = 1024;
constexpr int RT_END = RT_BLKCNT + MAXG * 32;
static_assert((size_t)RT_END * 4 <= 4 * MiB, "route map");
constexpr int CW_CNT = 1024;
constexpr int CW_BAR = 4096;

typedef float f32x2_t __attribute__((ext_vector_type(2)));
typedef __bf16 bf16x2_t __attribute__((ext_vector_type(2)));
__device__ __forceinline__ unsigned pk2(float lo, float hi) { const f32x2_t v = {lo, hi}; return __builtin_bit_cast(unsigned, __builtin_convertvector(v, bf16x2_t)); }
__device__ __forceinline__ unsigned f2bf(float f) { return pk2(f, 0.f) & 0xffffu; }
__device__ __forceinline__ float bf2f(unsigned short b) { return __builtin_bit_cast(float, (unsigned)b << 16); }
__device__ __forceinline__ float bflo(unsigned w) { return __builtin_bit_cast(float, w << 16); }
__device__ __forceinline__ float bfhi(unsigned w) { return __builtin_bit_cast(float, w & 0xffff0000u); }
__device__ __forceinline__ float sigmoidf_(float x) { return 1.f / (1.f + __expf(-x)); }
__device__ __forceinline__ float siluf_(float x) { return x / (1.f + __expf(-x)); }
__device__ __forceinline__ float logsigmoidf_(float x) { return x >= 0.f ? -log1pf(__expf(-x)) : x - log1pf(__expf(x)); }
template <int CTRL, int ROWMASK, bool BOUND0>
__device__ __forceinline__ float dppf(float old, float x) { return __builtin_bit_cast(float, __builtin_amdgcn_update_dpp(__builtin_bit_cast(int, old), __builtin_bit_cast(int, x), CTRL, ROWMASK, 0xf, BOUND0)); }
__device__ __forceinline__ float half_sum_hi(float x) {
    x += dppf<0xB1, 0xf, true>(0.f, x); x += dppf<0x4E, 0xf, true>(0.f, x); x += dppf<0x114, 0xf, true>(0.f, x); x += dppf<0x118, 0xf, true>(0.f, x);
    x += dppf<0x142, 0xa, true>(0.f, x); return x; }
__device__ __forceinline__ float wave_sum(float v) {
    v = half_sum_hi(v); v += dppf<0x143, 0xc, true>(0.f, v); return __builtin_bit_cast(float, __builtin_amdgcn_readlane(__builtin_bit_cast(int, v), 63)); }
__device__ __forceinline__ float wave_incl_sum(float v, int) {
    v += dppf<0x111, 0xf, true>(0.f, v); v += dppf<0x112, 0xf, true>(0.f, v); v += dppf<0x114, 0xf, true>(0.f, v); v += dppf<0x118, 0xf, true>(0.f, v);
    v += dppf<0x142, 0xa, true>(0.f, v); v += dppf<0x143, 0xc, true>(0.f, v); return v; }
__device__ __forceinline__ float wave_incl_max(float v, int) {
    const float NI = -INFINITY;
    v = fmaxf(v, dppf<0x111, 0xf, false>(NI, v)); v = fmaxf(v, dppf<0x112, 0xf, false>(NI, v)); v = fmaxf(v, dppf<0x114, 0xf, false>(NI, v)); v = fmaxf(v, dppf<0x118, 0xf, false>(NI, v));
    v = fmaxf(v, dppf<0x142, 0xa, false>(NI, v)); v = fmaxf(v, dppf<0x143, 0xc, false>(NI, v)); return v; }
__device__ __forceinline__ float wave_max(float v) { v = wave_incl_max(v, 0); return __builtin_bit_cast(float, __builtin_amdgcn_readlane(__builtin_bit_cast(int, v), 63)); }
__device__ __forceinline__ int mrow_of(int r) { return r < NLAT ? (r >> 13) : 2; }

struct Args { const float* in[24]; float* out; unsigned char* ws; int ph_lo, ph_hi; };
typedef const __attribute__((address_space(4))) Args CArgs;

enum { I_X = 0, I_C, I_CTX, I_CCTX, I_WADA, I_BADA, I_N1G, I_WIN, I_MLCONV, I_MLGB, I_MLNG, I_HGCONV, I_HGFB, I_HGLB, I_HGNG, I_WOUT, I_N2G, I_RW, I_RB, I_WGU, I_BGU, I_WDN, I_BDN, I_FG };

constexpr int NWAVES = 8, NTHR = 512;
constexpr int LDS_BYTES = 147456;

struct Frame {
    LAS unsigned char* lds;
    float* out; unsigned char* ws;
    int tid, lane, wave, vcu, G;
};

__device__ __forceinline__ void ph_init(Frame& F, CArgs& A) {
    const int gt = F.vcu * NTHR + F.tid, NG = F.G * NTHR;
    if (gt < 128) ((u32x4*)(F.ws + WS_H + (size_t)NTOK * D * 2))[gt] = (u32x4){0u, 0u, 0u, 0u};
    LAS float* sc = (LAS float*)F.lds;
    LAS float* part = sc + 3 * 1024;
    for (int i = F.tid; i < 3 * 1024; i += NTHR) { const int r = i >> 10, k = i & 1023; const float c = r < 2 ? A.in[I_C][r * 1024 + k] : A.in[I_CCTX][k]; sc[i] = siluf_(c); }
    __syncthreads();
    for (int item = F.vcu; item < DEPTH * 96; item += F.G) {
        const int l = item / 96, j = (item % 96) * 64 + F.lane;
        const float* w = A.in[I_WADA] + (size_t)l * D * 6144 + j;
        float a0 = 0.f, a1 = 0.f, a2 = 0.f;
        for (int k0 = F.wave * 128; k0 < F.wave * 128 + 128; k0 += 32) { float wv[32];
#pragma unroll
            for (int i = 0; i < 32; ++i) wv[i] = w[(size_t)(k0 + i) * 6144];
#pragma unroll
            for (int i = 0; i < 32; ++i) { a0 += sc[k0 + i] * wv[i]; a1 += sc[1024 + k0 + i] * wv[i]; a2 += sc[2048 + k0 + i] * wv[i]; } }
        part[(F.wave * 3 + 0) * 64 + F.lane] = a0; part[(F.wave * 3 + 1) * 64 + F.lane] = a1; part[(F.wave * 3 + 2) * 64 + F.lane] = a2;
        __syncthreads();
        if (F.tid < 192) { const int r = F.tid >> 6, ln = F.tid & 63; float s = 0.f;
#pragma unroll
            for (int w8 = 0; w8 < 8; ++w8) s += part[(w8 * 3 + r) * 64 + ln];
            const int jj = (item % 96) * 64 + ln;
            ((float*)(F.ws + WS_MOD))[(l * 3 + r) * 6144 + jj] = s + A.in[I_BADA][l * 6144 + jj]; }
        __syncthreads();
    }
}

typedef unsigned u32x2v __attribute__((ext_vector_type(2)));
__device__ __forceinline__ float xor32(float send, int lane) { const unsigned u = __builtin_bit_cast(unsigned, send); const u32x2v r = __builtin_amdgcn_permlane32_swap(u, u, false, false);
    return __builtin_bit_cast(float, (lane & 32) ? r.x : r.y); }
__device__ __forceinline__ float xor16(float send, int lane) { const unsigned u = __builtin_bit_cast(unsigned, send); const u32x2v r = __builtin_amdgcn_permlane16_swap(u, u, false, false);
    return __builtin_bit_cast(float, (lane & 16) ? r.x : r.y); }
__device__ __forceinline__ float xor8(float x) { return dppf<0x140, 0xf, true>(0.f, dppf<0x141, 0xf, true>(0.f, x)); }
__device__ __forceinline__ float xor4(float x) { return dppf<0x141, 0xf, true>(0.f, dppf<0x1B, 0xf, true>(0.f, x)); }
__device__ __forceinline__ float xor2(float x) { return dppf<0x4E, 0xf, true>(0.f, x); }
__device__ __forceinline__ float xor1(float x) { return dppf<0xB1, 0xf, true>(0.f, x); }
template <int NV> __device__ __forceinline__ float reduce_scatter(float (&v)[NV], int lane) {
    float a16[16];
    if constexpr (NV == 32) { const bool hi = lane & 32;
#pragma unroll
        for (int i = 0; i < 16; ++i) { const float keep = hi ? v[16 + i] : v[i], send = hi ? v[i] : v[16 + i]; a16[i] = keep + xor32(send, lane); } }
    else {
#pragma unroll
        for (int i = 0; i < 16; ++i) a16[i] = v[i] + xor1(v[i]); }
    float a8[8], a4[4], a2[2];
    { const bool hi = lane & 16;
#pragma unroll
      for (int i = 0; i < 8; ++i) { const float keep = hi ? a16[8 + i] : a16[i], send = hi ? a16[i] : a16[8 + i]; a8[i] = keep + xor16(send, lane); } }
    { const bool hi = lane & 8;
#pragma unroll
      for (int i = 0; i < 4; ++i) { const float keep = hi ? a8[4 + i] : a8[i], send = hi ? a8[i] : a8[4 + i]; a4[i] = keep + xor8(send); } }
    { const bool hi = lane & 4;
#pragma unroll
      for (int i = 0; i < 2; ++i) { const float keep = hi ? a4[2 + i] : a4[i], send = hi ? a4[i] : a4[2 + i]; a2[i] = keep + xor4(send); } }
    float r;
    { const bool hi = lane & 2; const float keep = hi ? a2[1] : a2[0], send = hi ? a2[0] : a2[1]; r = keep + xor2(send); }
    if constexpr (NV == 32) r += xor1(r); else r += xor32(r, lane);
    return r;
}
struct RowIn { f32x4 x[4]; u32x2 y[4][4]; };
template <int SRC>
__device__ __forceinline__ void row_load(Frame& F, CArgs& A, int r, const int (&slot)[4], RowIn& R) {
    const float* src = SRC == 1 ? (r < NLAT ? A.in[I_X] + (size_t)r * D : A.in[I_CTX] + (size_t)(r - NLAT) * D) : (const float*)(F.ws + WS_X) + (size_t)r * D;
    const f32x4* xr = (const f32x4*)src + F.lane;
#pragma unroll
    for (int j = 0; j < 4; ++j) R.x[j] = xr[64 * j];
    if (SRC == 2) {
#pragma unroll
        for (int k = 0; k < 4; ++k) { const u32x2* yp = (const u32x2*)(F.ws + WS_YS + (size_t)slot[k] * D * 2) + F.lane;
#pragma unroll
            for (int j = 0; j < 4; ++j) R.y[k][j] = yp[64 * j]; } }
}
template <int SRC, int MODE>
__device__ __forceinline__ void ph_rows(Frame& F, CArgs& A, int lsrc, int l, int nrows) {
    constexpr int NV = MODE == 0 ? 16 : 32;
    LAS float* wl = (LAS float*)F.lds;
    if (MODE == 0) { const float* w = A.in[I_WIN] + (size_t)l * D * INW + 1536;
        for (int k = F.tid; k < 1024; k += NTHR) { const f32x4* wp = (const f32x4*)(w + (size_t)k * INW);
#pragma unroll
            for (int q = 0; q < 4; ++q) { const f32x4 v4 = wp[q]; wl[(4 * q + 0) * 1024 + k] = v4.x; wl[(4 * q + 1) * 1024 + k] = v4.y; wl[(4 * q + 2) * 1024 + k] = v4.z; wl[(4 * q + 3) * 1024 + k] = v4.w; } } __syncthreads(); }
    LAS unsigned* lcnt = (LAS unsigned*)(F.lds + 131072);
    if (MODE == 1) { const float* w = A.in[I_RW] + (size_t)l * D * NEXP; if (F.tid < 32) lcnt[F.tid] = 0u;
        for (int k = F.tid; k < 1024; k += NTHR) { const f32x4* wp = (const f32x4*)(w + (size_t)k * NEXP);
#pragma unroll
            for (int q = 0; q < 8; ++q) { const f32x4 v4 = wp[q]; wl[(4 * q + 0) * 1024 + k] = v4.x; wl[(4 * q + 1) * 1024 + k] = v4.y; wl[(4 * q + 2) * 1024 + k] = v4.z; wl[(4 * q + 3) * 1024 + k] = v4.w; } } __syncthreads(); }
    const float* gam = MODE == 0 ? A.in[I_N1G] + l * D : (MODE == 1 ? A.in[I_N2G] + l * D : A.in[I_FG]);
    const float* MOD = (const float*)(F.ws + WS_MOD) + (size_t)l * 3 * 6144;
    const float* MODS = (const float*)(F.ws + WS_MOD) + (size_t)lsrc * 3 * 6144;
    const int* rt = (const int*)(F.ws + WS_ROUTE);
    const int stride = F.G * NWAVES; int r = F.vcu * NWAVES + F.wave;
    RowIn cur; int s1[4] = {0, 0, 0, 0}, s2[4] = {0, 0, 0, 0};
    if (SRC == 2) { if (r < nrows) { const u32x4 q = *(const u32x4*)(rt + RT_SLOT + r * 4); s1[0] = q.x; s1[1] = q.y; s1[2] = q.z; s1[3] = q.w; }
                    if (r + stride < nrows) { const u32x4 q = *(const u32x4*)(rt + RT_SLOT + (r + stride) * 4); s2[0] = q.x; s2[1] = q.y; s2[2] = q.z; s2[3] = q.w; } }
    if (r < nrows) row_load<SRC>(F, A, r, s1, cur);
    for (; r < nrows; r += stride) {
        RowIn nxt; int s3[4] = {0, 0, 0, 0};
        if (SRC == 2 && r + 2 * stride < nrows) { const u32x4 q = *(const u32x4*)(rt + RT_SLOT + (r + 2 * stride) * 4); s3[0] = q.x; s3[1] = q.y; s3[2] = q.z; s3[3] = q.w; }
        if (r + stride < nrows) row_load<SRC>(F, A, r + stride, s2, nxt);
        f32x4 v[4];
#pragma unroll
        for (int j = 0; j < 4; ++j) v[j] = cur.x[j];
        if (SRC == 2) { const float* g2 = MODS + mrow_of(r) * 6144 + 5 * 1024;
#pragma unroll
            for (int j = 0; j < 4; ++j) { f32x4 a = (f32x4){0.f, 0.f, 0.f, 0.f};
#pragma unroll
                for (int k = 0; k < 4; ++k) { const u32x2 w = cur.y[k][j]; a += (f32x4){bflo(w.x), bfhi(w.x), bflo(w.y), bfhi(w.y)}; }
                v[j] = v[j] + *(const f32x4*)(g2 + 256 * j + 4 * F.lane) * a; } }
        if (SRC == 2 && MODE != 2) { f32x4* xo = (f32x4*)((float*)(F.ws + WS_X) + (size_t)r * D) + F.lane;
#pragma unroll
            for (int j = 0; j < 4; ++j) xo[64 * j] = v[j]; }
        float ss = 0.f;
#pragma unroll
        for (int j = 0; j < 4; ++j) ss += (v[j].x * v[j].x + v[j].y * v[j].y) + (v[j].z * v[j].z + v[j].w * v[j].w);
        const float rstd = rsqrtf(wave_sum(ss) * (1.f / D) + EPS);
        const float* mod = MOD + mrow_of(r) * 6144 + (MODE == 0 ? 0 : 3072);
#pragma unroll
        for (int j = 0; j < 4; ++j) { const int c = 256 * j + 4 * F.lane; const f32x4 g = *(const f32x4*)(gam + c);
            v[j] = v[j] * rstd * g;
            if (MODE != 2) { const f32x4 sh = *(const f32x4*)(mod + c), scl = *(const f32x4*)(mod + 1024 + c); v[j] = v[j] * (1.f + scl) + sh; } }
        if (MODE == 2) { f32x4* o = (f32x4*)(F.out + (size_t)r * D) + F.lane;
#pragma unroll
            for (int j = 0; j < 4; ++j) o[64 * j] = v[j]; }
        else {
            u32x2* ho = (u32x2*)(F.ws + WS_H + (size_t)r * D * 2) + F.lane;
#pragma unroll
            for (int j = 0; j < 4; ++j) ho[64 * j] = (u32x2){pk2(v[j].x, v[j].y), pk2(v[j].z, v[j].w)};
            float part[NV];
#pragma unroll
            for (int g = 0; g < NV; ++g) { f32x2_t a2 = {0.f, 0.f};
#pragma unroll
                for (int j = 0; j < 4; ++j) { const f32x4 w = *(const LAS f32x4*)(wl + g * 1024 + 256 * j + 4 * F.lane);
                    a2 += (f32x2_t){v[j].x, v[j].y} * (f32x2_t){w.x, w.y}; a2 += (f32x2_t){v[j].z, v[j].w} * (f32x2_t){w.z, w.w}; }
                part[g] = a2.x + a2.y; }
            const float mine = reduce_scatter<NV>(part, F.lane);
            if (MODE == 0) {
                const int g = (F.lane >> 1) & 15;
                if ((F.lane & 33) == 0) { float val = mine + A.in[I_MLGB][l * 16 + g];
                    if (g >= 8) val = logsigmoidf_(val);
                    ((float*)(F.ws + WS_GATES))[(size_t)r * 16 + g] = val; }
            } else {
                const int g = (F.lane >> 1) & 31;
                float lv = (F.lane & 1) == 0 ? mine + A.in[I_RB][l * NEXP + g] : -INFINITY;
                float tv[4]; int ti[4];
#pragma unroll
                for (int p = 0; p < 4; ++p) { const float best = wave_max(lv);
                    const unsigned long long bal = __ballot(lv == best); const int bi = __ffsll((long long)bal) - 1;
                    tv[p] = best; ti[p] = bi >> 1; if (F.lane == bi) lv = -INFINITY; }
                const float e1 = __expf(tv[1] - tv[0]), e2 = __expf(tv[2] - tv[0]), e3 = __expf(tv[3] - tv[0]); const float inv = 1.f / (1.f + e1 + e2 + e3);
                if (F.lane == 0) {
                    int* rtw = (int*)(F.ws + WS_ROUTE);
                    const float gs[4] = {inv, e1 * inv, e2 * inv, e3 * inv};
#pragma unroll
                    for (int p = 0; p < 4; ++p) { rtw[RT_TOPI + r * 4 + p] = ti[p]; ((float*)rtw)[RT_TOPG + r * 4 + p] = gs[p]; rtw[RT_POS + r * 4 + p] = (int)__hip_atomic_fetch_add(lcnt + ti[p], 1u, __ATOMIC_RELAXED, __HIP_MEMORY_SCOPE_WORKGROUP); }
                }
            }
        }
        cur = nxt;
#pragma unroll
        for (int k = 0; k < 4; ++k) { s2[k] = s3[k]; }
    }
    if (MODE == 1) { __syncthreads(); if (F.tid < 32) ((int*)(F.ws + WS_ROUTE))[RT_BLKCNT + F.vcu * 32 + F.tid] = (int)lcnt[F.tid]; }
}

__device__ __forceinline__ void ph_lists(Frame& F, CArgs& A, int l, int nrows) {
    LAS int* off = (LAS int*)F.lds;
    LAS int* pre = (LAS int*)(F.lds + 1024);
    int* rt = (int*)(F.ws + WS_ROUTE);
    if (F.tid < 32) { int run = 0; for (int v = 0; v < F.G; ++v) { pre[v * 32 + F.tid] = run; run += rt[RT_BLKCNT + v * 32 + F.tid]; } off[64 + F.tid] = run; }
    __syncthreads();
    if (F.tid == 0) { int o = 0; for (int e = 0; e < NEXP; ++e) { off[e] = o; o += (off[64 + e] + 255) & ~255; } off[32] = o; }
    __syncthreads();
    const int gt = F.vcu * NTHR + F.tid, NG = F.G * NTHR;
    for (int i = gt; i < nrows * 4; i += NG) { const int r = i >> 2, e = rt[RT_TOPI + i], v = (r % (F.G * NWAVES)) / NWAVES, s = off[e] + pre[v * 32 + e] + rt[RT_POS + i];
        rt[RT_SLOT + i] = s; rt[RT_LIST + s] = r; ((float*)rt)[RT_SGATE + s] = ((const float*)rt)[RT_TOPG + i]; }
    const int total = off[32];
    for (int s = gt; s < total; s += NG) { int e = 0;
#pragma unroll 1
        for (int q = 1; q < NEXP; ++q) if (s >= off[q]) e = q;
        if (s - off[e] >= off[64 + e]) { rt[RT_LIST + s] = NTOK; ((float*)rt)[RT_SGATE + s] = 0.f; }
        if ((s & 255) == 0) rt[RT_TILEE + 8 + (s >> 8)] = e; }
    if (gt == 0) rt[RT_TILEE] = total >> 8;
}

__device__ __forceinline__ void ph_conv(Frame& F, CArgs& A, int l) {
    LAS float* cw = (LAS float*)F.lds;
    { const f32x4* wm = (const f32x4*)(A.in[I_MLCONV] + (size_t)l * 9 * 512); const f32x4* wh = (const f32x4*)(A.in[I_HGCONV] + (size_t)l * 9 * 1024);
      f32x4 vm[3], vh[5];
#pragma unroll
      for (int j = 0; j < 3; ++j) { const int i = F.tid + NTHR * j; vm[j] = i < 9 * 128 ? wm[i] : (f32x4){0.f, 0.f, 0.f, 0.f}; }
#pragma unroll
      for (int j = 0; j < 5; ++j) { const int i = F.tid + NTHR * j; vh[j] = i < 9 * 256 ? wh[i] : (f32x4){0.f, 0.f, 0.f, 0.f}; }
#pragma unroll
      for (int j = 0; j < 3; ++j) { const int i = F.tid + NTHR * j; if (i < 9 * 128) *(LAS f32x4*)(cw + (i / 128) * 1536 + (i % 128) * 4) = vm[j]; }
#pragma unroll
      for (int j = 0; j < 5; ++j) { const int i = F.tid + NTHR * j; if (i < 9 * 256) *(LAS f32x4*)(cw + (i / 256) * 1536 + 512 + (i % 256) * 4) = vh[j]; } }
    __syncthreads();
    const bf16* P = (const bf16*)(F.ws + WS_P);
    const int gt = F.vcu * NTHR + F.tid, NG = F.G * NTHR;
    constexpr int NLATQ = BATCH * 128 * 16, NQ = NLATQ + BATCH * 64;
    for (int it = gt; it < NQ * 192; it += NG) {
        const int qd = it / 192, cg = it % 192, c = cg * 8, pc = c < 512 ? PC_QK + c : PC_QI + (c - 512);
        int base, row, x0, nrow, ncol;
        if (qd < NLATQ) { const int b = qd >> 11, y = (qd >> 4) & 127, xq = qd & 15; base = b << 13; row = y; x0 = xq * 4; nrow = 128; ncol = 64; }
        else { const int q = qd - NLATQ, b = q >> 6; base = NLAT + (b << 8); row = 0; x0 = (q & 63) * 4; nrow = 1; ncol = 256; }
        const int r0 = base + row * ncol + x0;
        u32x4 tap[3][6];
#pragma unroll
        for (int dy = 0; dy < 3; ++dy)
#pragma unroll
            for (int j = 0; j < 6; ++j) { const int rr = row + dy - 1, cc = x0 + j - 1; const bool v = rr >= 0 && rr < nrow && cc >= 0 && cc < ncol;
                const u32x4 t = *(const u32x4*)(P + (size_t)(v ? base + rr * ncol + cc : r0) * PW + pc);
                tap[dy][j] = v ? t : (u32x4){0u, 0u, 0u, 0u}; }
        f32x2_t a2[4][4];
#pragma unroll
        for (int o = 0; o < 4; ++o)
#pragma unroll
            for (int i = 0; i < 4; ++i) a2[o][i] = (f32x2_t){0.f, 0.f};
#pragma unroll
        for (int dy = 0; dy < 3; ++dy)
#pragma unroll
            for (int dx = 0; dx < 3; ++dx) { const LAS float* w = cw + (dy * 3 + dx) * 1536 + c; const f32x4 w0 = *(const LAS f32x4*)w, w1 = *(const LAS f32x4*)(w + 4);
                const f32x2_t wa = {w0.x, w0.y}, wb = {w0.z, w0.w}, wc = {w1.x, w1.y}, wd = {w1.z, w1.w};
#pragma unroll
                for (int o = 0; o < 4; ++o) { const u32x4 pv = tap[dy][o + dx];
                    a2[o][0] += (f32x2_t){bflo(pv.x), bfhi(pv.x)} * wa; a2[o][1] += (f32x2_t){bflo(pv.y), bfhi(pv.y)} * wb;
                    a2[o][2] += (f32x2_t){bflo(pv.z), bfhi(pv.z)} * wc; a2[o][3] += (f32x2_t){bflo(pv.w), bfhi(pv.w)} * wd; } }
        float a[4][8];
#pragma unroll
        for (int o = 0; o < 4; ++o)
#pragma unroll
            for (int i = 0; i < 4; ++i) { a[o][2 * i] = a2[o][i].x; a[o][2 * i + 1] = a2[o][i].y; }
        const float sc = c < 256 ? 0.125f : 1.f;
#pragma unroll
        for (int o = 0; o < 4; ++o) {
#pragma unroll
            for (int i = 0; i < 8; ++i) a[o][i] = siluf_(a[o][i]) * sc;
            const u32x4 ov = (u32x4){pk2(a[o][0], a[o][1]), pk2(a[o][2], a[o][3]), pk2(a[o][4], a[o][5]), pk2(a[o][6], a[o][7])};
            if (c < 512) *(u32x4*)(F.ws + WS_CQK + ((size_t)(r0 + o) * 512 + c) * 2) = ov; else *(u32x4*)(F.ws + WS_CQI + ((size_t)(r0 + o) * 1024 + (c - 512)) * 2) = ov; }
    }
}

namespace pg8 {
typedef short bf16x8 __attribute__((ext_vector_type(8)));
constexpr int BM = 256, BK = 64, HALF = 128, HTB = HALF * BK * 2, STAGE_BYTES = 8 * HTB, NXCD = 8, WGM = 8;
__device__ __forceinline__ int lds_byte(int r, int c) { const int st = (r >> 4) * 2 + (c >> 5), rr = r & 15, cc = c & 31, ob = rr * 64 + cc * 2; return st * 1024 + (ob ^ (((ob >> 9) & 1) << 5)); }
__device__ __forceinline__ void stage_rc(int b, int& R, int& C) { const int st = b / 1024, sb = b % 1024, swz = sb ^ (((sb >> 9) & 1) << 5); R = (st >> 1) * 16 + swz / 64; C = (st & 1) * 32 + (swz % 64) / 2; }
__device__ __forceinline__ int perm32(int rho) { const int n = rho >> 4, i = rho & 15; return 8 * (i >> 2) + 4 * n + (i & 3); }
struct Unit { int pm, pn, e; };
struct Gemm { const bf16* A; const bf16* Bt; int K; const int* gather; const int* tile_e; size_t bexp;   };
struct StaticOrder {
    int nM, nN, nwg, G, c;
    __device__ void init(int nM_, int nN_, int G_, int c_) { nM = nM_; nN = nN_; nwg = nM * nN; G = G_; c = c_; }
    __device__ bool next(int i, Unit& u) const {
        const long L = (long)i * G + c; if (L >= nwg) return false;
        int wgid = (int)L; { const int q = nwg / NXCD, r = nwg % NXCD, xcd = wgid % NXCD, off = wgid / NXCD; wgid = (xcd < r ? xcd * (q + 1) : r * (q + 1) + (xcd - r) * q) + off; }
        const int nig = WGM * nN, gid = wgid / nig, fm = gid * WGM, gsz = (nM - fm) < WGM ? (nM - fm) : WGM;
        u.pm = fm + ((wgid % nig) % gsz); u.pn = (wgid % nig) / gsz; u.e = 0; return true;
    }
};
__device__ __forceinline__ unsigned cvt_pk_bf16(float lo, float hi) { unsigned r; asm volatile("v_cvt_pk_bf16_f32 %0, %1, %2" : "=v"(r) : "v"(lo), "v"(hi)); return r; }

struct EpiBf16 {
    static constexpr bool PERM = true;
    bf16* O; int ldc;
    __device__ __forceinline__ void operator()(const f32x4 (&acc)[2][2][4][2], const Unit& u, int wr, int wc, int fr, int fq) const {
        const int row0 = u.pm * BM + wr * 64 + fr, col0 = u.pn * BM + wc * 32 + 8 * fq;
#pragma unroll
        for (int ai = 0; ai < 2; ++ai)
#pragma unroll
            for (int m = 0; m < 4; ++m) { bf16* rowp = O + (size_t)(row0 + ai * HALF + m * 16) * ldc + col0;
#pragma unroll
                for (int bj = 0; bj < 2; ++bj) { const f32x4 v0 = acc[ai][bj][m][0], v1 = acc[ai][bj][m][1];
                    u32x4 w; w.x = cvt_pk_bf16(v0[0], v0[1]); w.y = cvt_pk_bf16(v0[2], v0[3]); w.z = cvt_pk_bf16(v1[0], v1[1]); w.w = cvt_pk_bf16(v1[2], v1[3]);
                    *(u32x4*)(rowp + bj * HALF) = w; } }
    }
};
struct EpiResid {
    static constexpr bool PERM = false;
    float* X; const float* MODg; const float* Slat; const float* Sctx;
    __device__ __forceinline__ void operator()(const f32x4 (&acc)[2][2][4][2], const Unit& u, int wr, int wc, int fr, int fq) const {
        const int row0 = u.pm * BM + wr * 64 + fr, col0 = u.pn * BM + wc * 32 + 4 * fq;
        const float* gp = MODg + mrow_of(u.pm * BM) * 6144 + col0;
        f32x4 gv[2][2];
#pragma unroll
        for (int bj = 0; bj < 2; ++bj)
#pragma unroll
            for (int n = 0; n < 2; ++n) gv[bj][n] = *(const f32x4*)(gp + bj * HALF + n * 16);
#pragma unroll
        for (int ai = 0; ai < 2; ++ai) {
            f32x4 xv[4][2][2];
#pragma unroll
            for (int m = 0; m < 4; ++m) { const int rr = row0 + ai * HALF + m * 16; const float* rowp = (rr < NLAT ? Slat + (size_t)rr * D : Sctx + (size_t)(rr - NLAT) * D) + col0;
#pragma unroll
                for (int bj = 0; bj < 2; ++bj)
#pragma unroll
                    for (int n = 0; n < 2; ++n) xv[m][bj][n] = *(const f32x4*)(rowp + bj * HALF + n * 16); }
#pragma unroll
            for (int m = 0; m < 4; ++m) { float* rowp = X + (size_t)(row0 + ai * HALF + m * 16) * D + col0;
#pragma unroll
                for (int bj = 0; bj < 2; ++bj)
#pragma unroll
                    for (int n = 0; n < 2; ++n) *(f32x4*)(rowp + bj * HALF + n * 16) = xv[m][bj][n] + gv[bj][n] * acc[ai][bj][m][n]; } }
    }
};
struct EpiSwiglu {
    static constexpr bool PERM = true;
    bf16* ACT; const float* bgu; const int* tile_e;
    __device__ __forceinline__ void operator()(const f32x4 (&acc)[2][2][4][2], const Unit& u, int wr, int wc, int fr, int fq) const {
        const int e = u.e;
        const int row0 = u.pm * BM + wr * 64 + fr, col0 = u.pn * HALF + wc * 32 + 8 * fq;
        const float* bp = bgu + (size_t)e * 2048 + col0;
        const f32x4 bg0 = *(const f32x4*)bp, bg1 = *(const f32x4*)(bp + 4), bl0 = *(const f32x4*)(bp + 1024), bl1 = *(const f32x4*)(bp + 1028);
#pragma unroll
        for (int ai = 0; ai < 2; ++ai)
#pragma unroll
            for (int m = 0; m < 4; ++m) {
                f32x4 g0 = acc[ai][0][m][0] + bg0, g1 = acc[ai][0][m][1] + bg1, l0 = acc[ai][1][m][0] + bl0, l1 = acc[ai][1][m][1] + bl1; float o[8];
#pragma unroll
                for (int i = 0; i < 4; ++i) { g0[i] = fminf(g0[i], 7.f); g1[i] = fminf(g1[i], 7.f); l0[i] = fminf(fmaxf(l0[i], -7.f), 7.f); l1[i] = fminf(fmaxf(l1[i], -7.f), 7.f); }
                const f32x4 t0 = g0 * (-1.702f * 1.44269504f), t1 = g1 * (-1.702f * 1.44269504f);
                f32x4 e0, e1;
#pragma unroll
                for (int i = 0; i < 4; ++i) { e0[i] = __builtin_amdgcn_exp2f(t0[i]); e1[i] = __builtin_amdgcn_exp2f(t1[i]); }
                e0 = e0 + 1.f; e1 = e1 + 1.f;
#pragma unroll
                for (int i = 0; i < 4; ++i) { e0[i] = __builtin_amdgcn_rcpf(e0[i]); e1[i] = __builtin_amdgcn_rcpf(e1[i]); }
                const f32x4 r0 = (g0 * e0) * (l0 + 1.f), r1 = (g1 * e1) * (l1 + 1.f);
#pragma unroll
                for (int i = 0; i < 4; ++i) { o[i] = r0[i]; o[4 + i] = r1[i]; }
                u32x4 w; w.x = cvt_pk_bf16(o[0], o[1]); w.y = cvt_pk_bf16(o[2], o[3]); w.z = cvt_pk_bf16(o[4], o[5]); w.w = cvt_pk_bf16(o[6], o[7]);
                *(u32x4*)(ACT + (size_t)(row0 + ai * HALF + m * 16) * DEXP + col0) = w; }
    }
};
struct EpiDown {
    static constexpr bool PERM = true;
    bf16* YS; const float* bdn; const float* sgate; const int* tile_e;
    __device__ __forceinline__ void operator()(const f32x4 (&acc)[2][2][4][2], const Unit& u, int wr, int wc, int fr, int fq) const {
        const int e = u.e;
        const int row0 = u.pm * BM + wr * 64 + fr, col0 = u.pn * BM + wc * 32 + 8 * fq;
        f32x4 bv[2][2];
#pragma unroll
        for (int bj = 0; bj < 2; ++bj)
#pragma unroll
            for (int n = 0; n < 2; ++n) bv[bj][n] = *(const f32x4*)(bdn + (size_t)e * D + col0 + bj * HALF + 4 * n);
#pragma unroll
        for (int ai = 0; ai < 2; ++ai)
#pragma unroll
            for (int m = 0; m < 4; ++m) { const int row = row0 + ai * HALF + m * 16; const float sg = sgate[row]; bf16* rowp = YS + (size_t)row * D + col0;
#pragma unroll
                for (int bj = 0; bj < 2; ++bj) { const f32x4 v0 = (acc[ai][bj][m][0] + bv[bj][0]) * sg, v1 = (acc[ai][bj][m][1] + bv[bj][1]) * sg;
                    u32x4 w; w.x = cvt_pk_bf16(v0[0], v0[1]); w.y = cvt_pk_bf16(v0[2], v0[3]); w.z = cvt_pk_bf16(v1[0], v1[1]); w.w = cvt_pk_bf16(v1[2], v1[3]);
                    *(u32x4*)(rowp + bj * HALF) = w; } }
    }
};

template <class Epi, class Sched, bool ALIGN_EPI>
__device__ __forceinline__ void gemm_phase(LAS unsigned char* lds, const Gemm g, const Sched& S, const Epi& E, const int tid) {
    const int wid = __builtin_amdgcn_readfirstlane(tid >> 6), lane = tid & 63, wr = wid >> 2, wc = wid & 3, fr = lane & 15, fq = lane >> 4;
    const int K = g.K, nt = K / BK;
    int RA[2]; unsigned cbA[2], voffB[2];
#pragma unroll
    for (int i = 0; i < 2; ++i) { int R, C; stage_rc(tid * 16 + i * 8192, R, C); const int Rb = Epi::PERM ? ((R & ~31) + perm32(R & 31)) : R;
        RA[i] = R; cbA[i] = (unsigned)C * 2u; voffB[i] = (unsigned)(Rb * K + C) * 2u; }
    const size_t kstep = (size_t)(BK * 2);
    const size_t hstep = (size_t)HALF * K * 2;
    const size_t tstep = 2 * hstep;
    const unsigned ldsw = (unsigned)wid * 1024u;
    const int aoff = lds_byte(wr * 64 + fr, fq * 8), boff = lds_byte(wc * 32 + fr, fq * 8);
#define PG8_SA(b, h) (((b) * 2 + (h)) * HTB)
#define PG8_SB(b, h) ((4 + (b) * 2 + (h)) * HTB)
#define PG8_STAGE(bufoff, gbase, voff) do { _Pragma("unroll") for (int _i = 0; _i < 2; ++_i) \
        __builtin_amdgcn_global_load_lds((const unsigned*)((const char*)(gbase) + (voff)[_i]), (LAS unsigned*)(lds + (bufoff) + ldsw + _i * 8192), 16, 0, 0); } while (0)
#define PG8_LDA(dst, b, h) do { _Pragma("unroll") for (int m = 0; m < 4; ++m) _Pragma("unroll") for (int k = 0; k < 2; ++k) dst[m][k] = *(const LAS bf16x8*)(lds + PG8_SA(b, h) + aoff + m * 2048 + k * 1024); } while (0)
#define PG8_LDB(dst, b, h) do { _Pragma("unroll") for (int n = 0; n < 2; ++n) _Pragma("unroll") for (int k = 0; k < 2; ++k) dst[n][k] = *(const LAS bf16x8*)(lds + PG8_SB(b, h) + boff + n * 2048 + k * 1024); } while (0)
#define PG8_MMA(ai, bj, At, Bt) do { __builtin_amdgcn_s_setprio(1); _Pragma("unroll") for (int m = 0; m < 4; ++m) _Pragma("unroll") for (int n = 0; n < 2; ++n) _Pragma("unroll") for (int k = 0; k < 2; ++k) \
        acc[ai][bj][m][n] = __builtin_amdgcn_mfma_f32_16x16x32_bf16(Bt[n][k], At[m][k], acc[ai][bj][m][n], 0, 0, 0); __builtin_amdgcn_s_setprio(0); } while (0)
#define PG8_WAIT_V(n) asm volatile("s_waitcnt vmcnt(" #n ")" ::: "memory")
#define PG8_WAIT_L(n) asm volatile("s_waitcnt lgkmcnt(" #n ")" ::: "memory")
#define PG8_BAR __builtin_amdgcn_s_barrier()
#define PG8_SCHED __builtin_amdgcn_sched_barrier(0)
#define PG8_AOFF(va, u) do { _Pragma("unroll") for (int _h = 0; _h < 2; ++_h) _Pragma("unroll") for (int _i = 0; _i < 2; ++_i) { const int _r = (u).pm * BM + _h * HALF + RA[_i]; \
        const int _row = g.gather ? g.gather[_r] : _r; va[_h][_i] = (unsigned)_row * (unsigned)(K * 2) + cbA[_i]; } } while (0)
#define PG8_BBASE(u) ((u).e = g.tile_e ? g.tile_e[8 + (u).pm] : 0, (const char*)g.Bt + (size_t)(u).e * g.bexp * 2 + (size_t)(u).pn * tstep)
    Unit cur, nxt; int ui = 0;
    if (!S.next(0, cur)) return;
    f32x4 acc[2][2][4][2];
#pragma unroll
    for (int a = 0; a < 2; ++a)
#pragma unroll
        for (int b = 0; b < 2; ++b)
#pragma unroll
            for (int m = 0; m < 4; ++m)
#pragma unroll
                for (int n = 0; n < 2; ++n) acc[a][b][m][n] = (f32x4){0.f, 0.f, 0.f, 0.f};
    bf16x8 At[4][2], B0[2][2], B1[2][2];
    const char* Ab = (const char*)g.A;
    unsigned cva[2][2], nva[2][2];
    PG8_AOFF(cva, cur);
    const char* cB = PG8_BBASE(cur);
    PG8_STAGE(PG8_SB(0, 0), cB, voffB); PG8_STAGE(PG8_SB(0, 1), cB + hstep, voffB); PG8_STAGE(PG8_SA(0, 0), Ab, cva[0]); PG8_STAGE(PG8_SA(0, 1), Ab, cva[1]);
    if (wr == 1) PG8_BAR;
    PG8_WAIT_V(2); PG8_BAR;
    PG8_STAGE(PG8_SB(1, 0), cB + kstep, voffB); PG8_STAGE(PG8_SA(1, 0), Ab + kstep, cva[0]); PG8_STAGE(PG8_SB(1, 1), cB + hstep + kstep, voffB);
    PG8_WAIT_V(6); PG8_BAR;
    for (;;) {
        const bool has_next = S.next(ui + 1, nxt);
        const char* nB = cB;
        if (has_next) { PG8_AOFF(nva, nxt); nB = PG8_BBASE(nxt); }
        else {
#pragma unroll
            for (int h = 0; h < 2; ++h)
#pragma unroll
                for (int i = 0; i < 2; ++i) nva[h][i] = cva[h][i]; }
        for (int t = 0; t < nt; t += 2) {
            const bool last = (t == nt - 2);
            const char* a1 = Ab + (size_t)(t + 1) * kstep;
            const char* a2 = last ? Ab : Ab + (size_t)(t + 2) * kstep; const char* b2 = last ? nB : cB + (size_t)(t + 2) * kstep;
            const char* a3 = a2 + kstep; const char* b3 = b2 + kstep;
            unsigned s2[2][2];
#pragma unroll
            for (int h = 0; h < 2; ++h)
#pragma unroll
                for (int i = 0; i < 2; ++i) s2[h][i] = last ? nva[h][i] : cva[h][i];
            PG8_LDB(B0, 0, 0); PG8_LDB(B1, 0, 1); PG8_SCHED; PG8_LDA(At, 0, 0); PG8_STAGE(PG8_SA(1, 1), a1, cva[1]);
            PG8_WAIT_V(8); PG8_WAIT_L(0); PG8_BAR; PG8_MMA(0, 0, At, B0); PG8_MMA(0, 1, At, B1); PG8_BAR; PG8_SCHED;
            PG8_LDA(At, 0, 1); PG8_STAGE(PG8_SB(0, 0), b2, voffB); PG8_STAGE(PG8_SB(0, 1), b2 + hstep, voffB); PG8_STAGE(PG8_SA(0, 0), a2, s2[0]);
            PG8_WAIT_V(8); PG8_WAIT_L(0); PG8_BAR; PG8_MMA(1, 0, At, B0); PG8_MMA(1, 1, At, B1); PG8_BAR; PG8_SCHED;
            PG8_LDB(B0, 1, 0); PG8_LDB(B1, 1, 1); PG8_SCHED; PG8_LDA(At, 1, 0); PG8_STAGE(PG8_SA(0, 1), a2, s2[1]);
            PG8_WAIT_V(8); PG8_WAIT_L(0); PG8_BAR; PG8_MMA(0, 0, At, B0); PG8_MMA(0, 1, At, B1); PG8_BAR; PG8_SCHED;
            PG8_LDA(At, 1, 1); PG8_STAGE(PG8_SB(1, 0), b3, voffB); PG8_STAGE(PG8_SB(1, 1), b3 + hstep, voffB); PG8_STAGE(PG8_SA(1, 0), a3, s2[0]);
            PG8_WAIT_V(8); PG8_WAIT_L(0); PG8_BAR; PG8_MMA(1, 0, At, B0); PG8_MMA(1, 1, At, B1); PG8_BAR; PG8_SCHED;
        }
        if constexpr (ALIGN_EPI) { if (wr == 0) PG8_BAR; }
        E(acc, cur, wr, wc, fr, fq);
        if (!has_next) break;
#pragma unroll
        for (int a = 0; a < 2; ++a)
#pragma unroll
            for (int b = 0; b < 2; ++b)
#pragma unroll
                for (int m = 0; m < 4; ++m)
#pragma unroll
                    for (int n = 0; n < 2; ++n) acc[a][b][m][n] = (f32x4){0.f, 0.f, 0.f, 0.f};
        cur = nxt; cB = nB; ++ui;
#pragma unroll
        for (int h = 0; h < 2; ++h)
#pragma unroll
            for (int i = 0; i < 2; ++i) cva[h][i] = nva[h][i];
        if constexpr (ALIGN_EPI) { if (wr == 1) PG8_BAR; }
    }
    PG8_WAIT_V(0);
    if constexpr (!ALIGN_EPI) { if (wr == 0) PG8_BAR; }
    PG8_BAR;
#undef PG8_SA
#undef PG8_SB
#undef PG8_STAGE
#undef PG8_LDA
#undef PG8_LDB
#undef PG8_MMA
#undef PG8_WAIT_V
#undef PG8_WAIT_L
#undef PG8_BAR
#undef PG8_SCHED
#undef PG8_AOFF
#undef PG8_BBASE
}
}


#define LDS_BARRIER() do { asm volatile("s_waitcnt lgkmcnt(0)" ::: "memory"); __builtin_amdgcn_s_barrier(); asm volatile("" ::: "memory"); } while (0)
typedef short bf16x8_t __attribute__((ext_vector_type(8)));
typedef float f32x16 __attribute__((ext_vector_type(16)));
template <int K>
__device__ __forceinline__ void mm32(f32x16& acc, const LAS unsigned char* A, int sa, const LAS unsigned char* B, int sb, int lane) {
    const LAS unsigned char* ap = A + (lane & 31) * sa + (lane >> 5) * 16;
    const LAS unsigned char* bp = B + (lane & 31) * sb + (lane >> 5) * 16;
#pragma unroll
    for (int k0 = 0; k0 < K / 16; k0 += 4) {
        bf16x8_t a[4], b[4];
#pragma unroll
        for (int k = 0; k < 4; ++k) { a[k] = *(const LAS bf16x8_t*)(ap + (k0 + k) * 32); b[k] = *(const LAS bf16x8_t*)(bp + (k0 + k) * 32); }
#pragma unroll
        for (int k = 0; k < 4; ++k) acc = __builtin_amdgcn_mfma_f32_32x32x16_bf16(a[k], b[k], acc, 0, 0, 0);
    }
}
__device__ __forceinline__ int rowmap(int reg, int hi) { return (reg & 3) + 8 * (reg >> 2) + 4 * hi; }
__device__ __forceinline__ int chunk_row0(int b, int tc) { return tc < 4 ? NLAT + b * CTX + tc * 64 : b * SEQ + (tc - 4) * 64; }
constexpr int ST64 = 144, ST128 = 272;


__device__ __forceinline__ void touch(unsigned& x) { asm volatile("" : "+v"(x)); }
__device__ __forceinline__ void touch(float& x) { asm volatile("" : "+v"(x)); }
__device__ __forceinline__ void touch(u32x4& x) { asm volatile("" : "+v"(x)); }
struct VtRaw { unsigned w[8]; };
__device__ __forceinline__ void vt_load(VtRaw& R, const bf16* src, int pitch, int row0, int col0, int tid) {
    const int cp = tid & 63, tg = tid >> 6;
#pragma unroll
    for (int i = 0; i < 8; ++i) R.w[i] = *(const unsigned*)(src + (size_t)(row0 + tg * 8 + i) * pitch + col0 + 2 * cp);
}
__device__ __forceinline__ void vt_store(LAS unsigned char* VT, const VtRaw& R, int tid) {
    const int cp = tid & 63, tg = tid >> 6; unsigned lo[4], hi[4];
#pragma unroll
    for (int i = 0; i < 4; ++i) { const unsigned w0 = R.w[2 * i], w1 = R.w[2 * i + 1]; lo[i] = (w0 & 0xffffu) | (w1 << 16); hi[i] = (w0 >> 16) | (w1 & 0xffff0000u); }
    *(LAS u32x4*)(VT + (2 * cp) * ST64 + tg * 16) = (u32x4){lo[0], lo[1], lo[2], lo[3]};
    *(LAS u32x4*)(VT + (2 * cp + 1) * ST64 + tg * 16) = (u32x4){hi[0], hi[1], hi[2], hi[3]};
}
struct TaskId { int b, h, tc, row0, sidf; };
__device__ __forceinline__ TaskId task_id(int task) { TaskId t; t.b = task / (4 * NTC); t.h = (task / NTC) & 3; t.tc = task % NTC; t.row0 = chunk_row0(t.b, t.tc); t.sidf = (t.b * 4 + t.h) * 2; return t; }

struct MlARaw { VtRaw v; unsigned kw[4]; float g[4]; };
__device__ __forceinline__ void touch(MlARaw& R) {
#pragma unroll
    for (int i = 0; i < 8; ++i) touch(R.v.w[i]);
#pragma unroll
    for (int i = 0; i < 4; ++i) { touch(R.kw[i]); touch(R.g[i]); } }
__device__ __forceinline__ void ml_passA_load(Frame& F, int task, MlARaw& R) {
    const TaskId T = task_id(task);
    vt_load(R.v, (const bf16*)(F.ws + WS_P), PW, T.row0, PC_V + T.h * 128, F.tid);
    { const int cp = F.tid & 31, tg = F.tid >> 5; const bf16* CQK = (const bf16*)(F.ws + WS_CQK);
#pragma unroll
      for (int i = 0; i < 4; ++i) R.kw[i] = *(const unsigned*)(CQK + (size_t)(T.row0 + tg * 4 + i) * 512 + 256 + T.h * 64 + 2 * cp); }
    if (F.wave == 0) { const float* gp = (const float*)(F.ws + WS_GATES) + (size_t)(T.row0 + F.lane) * 16; R.g[0] = gp[T.h]; R.g[1] = gp[4 + T.h]; R.g[2] = gp[8 + T.h]; R.g[3] = gp[12 + T.h]; }
}
__device__ __forceinline__ void ml_passA_run(Frame& F, int task, const MlARaw& R) {
    const TaskId T = task_id(task); const int tc = T.tc, sidf = T.sidf;
    LAS unsigned char* VT = F.lds; LAS unsigned char* KT = F.lds + 18432;
    LAS float* wts = (LAS float*)(F.lds + 36864);
    float* MLS = (float*)(F.ws + WS_MLS);
    LDS_BARRIER();
    if (F.wave == 0) { const int s = F.lane;
        const float igf = R.g[0], igb = R.g[1], lff = R.g[2], lfb = R.g[3];
        const float pf = wave_incl_sum(lff, s), gf = __builtin_bit_cast(float, __builtin_amdgcn_readlane(__builtin_bit_cast(int, pf), 63)), ef = (gf - pf) + igf, mf = wave_max(ef);
        const float pb = wave_incl_sum(lfb, s), gb = __builtin_bit_cast(float, __builtin_amdgcn_readlane(__builtin_bit_cast(int, pb), 63)), eb = (pb - lfb) + igb, mb = wave_max(eb);
        wts[s] = __expf(ef - mf); wts[64 + s] = __expf(eb - mb);
        if (s == 0) { float* o = MLS + (size_t)(sidf * NTC + tc) * 4; o[0] = gf; o[1] = mf; o = MLS + (size_t)((sidf + 1) * NTC + tc) * 4; o[0] = gb; o[1] = mb; } }
    vt_store(VT, R.v, F.tid);
    LDS_BARRIER();
    { const int cp = F.tid & 31, tg = F.tid >> 5;
#pragma unroll
      for (int dir = 0; dir < 2; ++dir) { float lo[4], hi[4];
#pragma unroll
          for (int i = 0; i < 4; ++i) { const float w = wts[dir * 64 + tg * 4 + i]; lo[i] = bflo(R.kw[i]) * w; hi[i] = bfhi(R.kw[i]) * w; }
          *(LAS u32x2*)(KT + dir * 9216 + (2 * cp) * ST64 + tg * 8) = (u32x2){pk2(lo[0], lo[1]), pk2(lo[2], lo[3])};
          *(LAS u32x2*)(KT + dir * 9216 + (2 * cp + 1) * ST64 + tg * 8) = (u32x2){pk2(hi[0], hi[1]), pk2(hi[2], hi[3])}; } }
    LDS_BARRIER();
    { const int dir = F.wave >> 2, mt = F.wave & 3; bf16* C = (bf16*)(F.ws + WS_MLC) + (size_t)((sidf + dir) * NTC + tc) * 8192;
#pragma unroll
      for (int nt = 0; nt < 2; ++nt) { f32x16 acc;
#pragma unroll
          for (int i = 0; i < 16; ++i) acc[i] = 0.f;
          mm32<64>(acc, VT + 32 * mt * ST64, ST64, KT + dir * 9216 + 32 * nt * ST64, ST64, F.lane);
#pragma unroll
          for (int r = 0; r < 16; ++r) C[(32 * mt + rowmap(r, F.lane >> 5)) * 64 + 32 * nt + (F.lane & 31)] = (bf16)f2bf(acc[r]); } }
    if (F.tid < 128) { const int dir = F.tid >> 6, d = F.tid & 63; const LAS unsigned char* rp = KT + dir * 9216 + d * ST64; float sum = 0.f;
#pragma unroll
        for (int i = 0; i < 8; ++i) { const u32x4 w = *(const LAS u32x4*)(rp + i * 16); sum += (bflo(w.x) + bfhi(w.x)) + (bflo(w.y) + bfhi(w.y)) + (bflo(w.z) + bfhi(w.z)) + (bflo(w.w) + bfhi(w.w)); }
        ((float*)(F.ws + WS_MLN))[(size_t)((sidf + dir) * NTC + tc) * 64 + d] = sum; }
}
__device__ __forceinline__ int tc_seq(int dir, int j) { return dir == 0 ? j : (j < 4 ? 3 - j : 135 - j); }
__device__ __forceinline__ void scan_passB(Frame& F) {
    const float* GG = (const float*)(F.ws + WS_HGG); float* MLS = (float*)(F.ws + WS_MLS);
    const int t = F.tid;
    if (t < 128) {
        for (int item = F.vcu * 128 + t; item < 16 * 2048; item += F.G * 128) {
            const int scan = item >> 11, e = (item & 2047) * 8, dir = scan & 1, d = e & 127;
            const u32x4* base = (const u32x4*)((const bf16*)(F.ws + WS_HGS) + (size_t)scan * NTC * 16384 + e); u32x4* ob = (u32x4*)((bf16*)(F.ws + WS_HGSB) + (size_t)scan * NTC * 16384 + e);
            const f32x4* gb = (const f32x4*)(GG + (size_t)scan * NTC * 128 + d);
            float st[8];
#pragma unroll
            for (int k = 0; k < 8; ++k) st[k] = 0.f;
            for (int j0 = 0; j0 < NTC; j0 += 11) {
                u32x4 dv[11]; f32x4 g0[11], g1[11];
#pragma unroll
                for (int i = 0; i < 11; ++i) { const int tc = tc_seq(dir, j0 + i); dv[i] = base[(size_t)tc * 2048]; g0[i] = gb[tc * 32]; g1[i] = gb[tc * 32 + 1]; }
#pragma unroll
                for (int i = 0; i < 11; ++i) { const int tc = tc_seq(dir, j0 + i);
                    ob[(size_t)tc * 2048] = (u32x4){pk2(st[0], st[1]), pk2(st[2], st[3]), pk2(st[4], st[5]), pk2(st[6], st[7])};
                    const f32x4 ta = g0[i] * 1.44269504f, tb = g1[i] * 1.44269504f;
                    const f32x2_t e0 = {__builtin_amdgcn_exp2f(ta.x), __builtin_amdgcn_exp2f(ta.y)}, e1 = {__builtin_amdgcn_exp2f(ta.z), __builtin_amdgcn_exp2f(ta.w)}, e2 = {__builtin_amdgcn_exp2f(tb.x), __builtin_amdgcn_exp2f(tb.y)}, e3 = {__builtin_amdgcn_exp2f(tb.z), __builtin_amdgcn_exp2f(tb.w)};
                    const f32x2_t s0 = e0 * (f32x2_t){st[0], st[1]} + (f32x2_t){bflo(dv[i].x), bfhi(dv[i].x)}, s1 = e1 * (f32x2_t){st[2], st[3]} + (f32x2_t){bflo(dv[i].y), bfhi(dv[i].y)};
                    const f32x2_t s2 = e2 * (f32x2_t){st[4], st[5]} + (f32x2_t){bflo(dv[i].z), bfhi(dv[i].z)}, s3 = e3 * (f32x2_t){st[6], st[7]} + (f32x2_t){bflo(dv[i].w), bfhi(dv[i].w)};
                    st[0] = s0.x; st[1] = s0.y; st[2] = s1.x; st[3] = s1.y; st[4] = s2.x; st[5] = s2.y; st[6] = s3.x; st[7] = s3.y; }
            }
        }
    } else if (t < 192) {
        for (int item = F.vcu * 64 + (t - 128); item < 16 * 1024; item += F.G * 64) {
            const int scan = item >> 10, e = (item & 1023) * 8, dir = scan & 1;
            const u32x4* cb = (const u32x4*)((const bf16*)(F.ws + WS_MLC) + (size_t)scan * NTC * 8192 + e); u32x4* ob = (u32x4*)((bf16*)(F.ws + WS_MLCB) + (size_t)scan * NTC * 8192 + e);
            float m = 0.f, st[8];
#pragma unroll
            for (int k = 0; k < 8; ++k) st[k] = 0.f;
            for (int j0 = 0; j0 < NTC; j0 += 12) {
                u32x4 dv[12]; float gg[12], ml[12];
#pragma unroll
                for (int i = 0; i < 12; ++i) { const int tc = tc_seq(dir, j0 + i); dv[i] = cb[(size_t)tc * 1024]; const float* sp = MLS + (size_t)(scan * NTC + tc) * 4; gg[i] = sp[0]; ml[i] = sp[1]; }
#pragma unroll
                for (int i = 0; i < 12; ++i) { const int tc = tc_seq(dir, j0 + i);
                    const float mn = fmaxf(gg[i] + m, ml[i]), a = __expf(gg[i] + m - mn), w = __expf(ml[i] - mn);
                    if ((item & 1023) == 0) MLS[(size_t)(scan * NTC + tc) * 4 + 2] = m;
                    ob[(size_t)tc * 1024] = (u32x4){pk2(st[0], st[1]), pk2(st[2], st[3]), pk2(st[4], st[5]), pk2(st[6], st[7])};
                    const f32x2_t s0 = (f32x2_t){st[0], st[1]} * a + (f32x2_t){bflo(dv[i].x), bfhi(dv[i].x)} * w, s1 = (f32x2_t){st[2], st[3]} * a + (f32x2_t){bflo(dv[i].y), bfhi(dv[i].y)} * w;
                    const f32x2_t s2 = (f32x2_t){st[4], st[5]} * a + (f32x2_t){bflo(dv[i].z), bfhi(dv[i].z)} * w, s3 = (f32x2_t){st[6], st[7]} * a + (f32x2_t){bflo(dv[i].w), bfhi(dv[i].w)} * w;
                    st[0] = s0.x; st[1] = s0.y; st[2] = s1.x; st[3] = s1.y; st[4] = s2.x; st[5] = s2.y; st[6] = s3.x; st[7] = s3.y; m = mn; }
            }
        }
    } else if (t < 196) {
        for (int item = F.vcu * 4 + (t - 192); item < 16 * 64; item += F.G * 4) {
            const int scan = item >> 6, e = item & 63, dir = scan & 1; float* nb = (float*)(F.ws + WS_MLN) + (size_t)scan * NTC * 64 + e;
            float m = 0.f, s0 = 0.f;
            for (int j0 = 0; j0 < NTC; j0 += 12) {
                float dv[12];
#pragma unroll
                for (int i = 0; i < 12; ++i) dv[i] = nb[tc_seq(dir, j0 + i) * 64];
#pragma unroll
                for (int i = 0; i < 12; ++i) { const int tc = tc_seq(dir, j0 + i); const float* sp = MLS + (size_t)(scan * NTC + tc) * 4;
                    const float g = sp[0], ml = sp[1], mn = fmaxf(g + m, ml), a = __expf(g + m - mn), w = __expf(ml - mn);
                    nb[tc * 64] = s0; s0 = a * s0 + w * dv[i]; m = mn; }
            }
        }
    }
}
template <int MIX>
__device__ __forceinline__ void gate_load(Frame& F, int row0, int h, unsigned (&gate)[16]) {
    const int mt = F.wave >> 2, nt = F.wave & 3; const bf16* P = (const bf16*)(F.ws + WS_P) + (MIX == 0 ? PC_O : PC_GO) + h * 128 + 32 * nt + (F.lane & 31);
#pragma unroll
    for (int r = 0; r < 16; ++r) gate[r] = P[(size_t)(row0 + 32 * mt + rowmap(r, F.lane >> 5)) * PW];
}
template <int MIX>
__device__ __forceinline__ void head_epilogue(Frame& F, const float ng, const f32x16& hv, const unsigned (&gate)[16], LAS float* part, int row0, int h) {
    const int mt = F.wave >> 2, nt = F.wave & 3, lane = F.lane, hi = lane >> 5;
    float ps[16];
#pragma unroll
    for (int r = 0; r < 16; ++r) ps[r] = hv[r] * hv[r];
#pragma unroll
    for (int r = 0; r < 16; ++r) ps[r] = half_sum_hi(ps[r]);
    if ((lane & 31) == 31) {
#pragma unroll
        for (int r = 0; r < 16; ++r) part[(32 * mt + rowmap(r, hi)) * 4 + nt] = ps[r]; }
    LDS_BARRIER();
    bf16* Y = (bf16*)(F.ws + WS_Y) + (MIX == 0 ? 0 : 512) + h * 128 + 32 * nt + (lane & 31);
#pragma unroll
    for (int r = 0; r < 16; r += 2) { const int t0 = 32 * mt + rowmap(r, hi), t1 = 32 * mt + rowmap(r + 1, hi); const f32x4 p4 = *(const LAS f32x4*)(part + t0 * 4), q4 = *(const LAS f32x4*)(part + t1 * 4);
        const f32x2_t ms = (f32x2_t){(p4.x + p4.y) + (p4.z + p4.w), (q4.x + q4.y) + (q4.z + q4.w)} * (1.f / 128.f) + EPS;
        const f32x2_t rstd = {__builtin_amdgcn_rsqf(ms.x), __builtin_amdgcn_rsqf(ms.y)}, gz = {bf2f((unsigned short)gate[r]), bf2f((unsigned short)gate[r + 1])};
        const f32x2_t te = gz * (-1.44269504f), dn = (f32x2_t){__builtin_amdgcn_exp2f(te.x), __builtin_amdgcn_exp2f(te.y)} + 1.f;
        const f32x2_t sg = {__builtin_amdgcn_rcpf(dn.x), __builtin_amdgcn_rcpf(dn.y)}, gv = MIX == 0 ? sg : gz * sg;
        const f32x2_t y = ((f32x2_t){hv[r], hv[r + 1]} * rstd) * (gv * ng); const unsigned w = pk2(y.x, y.y);
        Y[(size_t)(row0 + t0) * D] = (bf16)w; Y[(size_t)(row0 + t1) * D] = (bf16)(w >> 16); }
}
struct MlCRaw { VtRaw v; u32x4 q, k; u32x4 cf[2]; float g0, g1, ms; };
__device__ __forceinline__ void touch(MlCRaw& R) {
#pragma unroll
    for (int i = 0; i < 8; ++i) touch(R.v.w[i]);
    touch(R.q); touch(R.k); touch(R.cf[0]); touch(R.cf[1]); touch(R.g0); touch(R.g1); touch(R.ms); }
__device__ __forceinline__ void ml_passC_load(Frame& F, int task, MlCRaw& R) {
    const TaskId T = task_id(task); const bf16* CQK = (const bf16*)(F.ws + WS_CQK);
    vt_load(R.v, (const bf16*)(F.ws + WS_P), PW, T.row0, PC_V + T.h * 128, F.tid);
    { const int row = F.tid >> 3, pc = F.tid & 7;
      R.q = *(const u32x4*)(CQK + (size_t)(T.row0 + row) * 512 + T.h * 64 + pc * 8); R.k = *(const u32x4*)(CQK + (size_t)(T.row0 + row) * 512 + 256 + T.h * 64 + pc * 8); }
    { const u32x4* cp = (const u32x4*)((const bf16*)(F.ws + WS_MLCB) + (size_t)(T.sidf * NTC + T.tc) * 8192 + (F.tid >> 2) * 64 + (F.tid & 3) * 16); R.cf[0] = cp[0]; R.cf[1] = cp[1]; }
    R.g0 = 0.f; R.g1 = 0.f; R.ms = 0.f;
    if (F.wave < 2) { const int dir = F.wave; const float* gp = (const float*)(F.ws + WS_GATES) + (size_t)(T.row0 + F.lane) * 16; R.g0 = gp[dir * 4 + T.h]; R.g1 = gp[8 + dir * 4 + T.h];
        R.ms = ((const float*)(F.ws + WS_MLS))[(size_t)((T.sidf + dir) * NTC + T.tc) * 4 + 2]; }
}
__device__ __forceinline__ void ml_passC_run(Frame& F, CArgs& A, int l, int task, const MlCRaw& R) {
    const TaskId T = task_id(task); const int h = T.h, tc = T.tc, row0 = T.row0, sidf = T.sidf;
    if (l == DEPTH - 1 && tc < 4) return;
    unsigned gate[16];
    const float ng = A.in[I_MLNG][l * 512 + h * 128 + 32 * (F.wave & 3) + (F.lane & 31)];
    LAS unsigned char* Q = F.lds; LAS unsigned char* Kn = F.lds + 9216; LAS unsigned char* VT = F.lds + 18432; LAS unsigned char* Cs = F.lds + 36864;
    LAS unsigned char* Pm = F.lds + 55296; LAS unsigned char* Qs = F.lds + 64512;
    LAS float* sm = (LAS float*)(F.lds + 73728);
    const int tid = F.tid, lane = F.lane;
    u32x4 cb[2]; { const u32x4* cp = (const u32x4*)((const bf16*)(F.ws + WS_MLCB) + (size_t)((sidf + 1) * NTC + tc) * 8192 + (tid >> 2) * 64 + (tid & 3) * 16); cb[0] = cp[0]; cb[1] = cp[1]; }
    float nv = 0.f; if (tid < 128) nv = ((const float*)(F.ws + WS_MLN))[(size_t)((sidf + (tid >> 6)) * NTC + tc) * 64 + (tid & 63)];
    LDS_BARRIER();
    { const int row = tid >> 3, pc = tid & 7; *(LAS u32x4*)(Q + row * ST64 + pc * 16) = R.q; *(LAS u32x4*)(Kn + row * ST64 + pc * 16) = R.k; }
    vt_store(VT, R.v, tid);
    if (tid < 128) sm[512 + tid] = nv;
    if (F.wave < 2) { const int dir = F.wave, s = lane; const float ig = R.g0, lf = R.g1, ms = R.ms;
        float bt, u, pm;
        if (dir == 0) { bt = wave_incl_sum(lf, s); u = ig - bt; pm = wave_incl_max(u, s); }
        else { const float pf = wave_incl_sum(lf, s), tot = __builtin_bit_cast(float, __builtin_amdgcn_readlane(__builtin_bit_cast(int, pf), 63)); bt = tot - pf + lf; u = ig - bt;
               float r = __shfl(u, 63 - s); r = wave_incl_max(r, s); pm = __shfl(r, 63 - s); }
        const float M = fmaxf(ms, pm);
        LAS float* o = sm + dir * 256; o[s] = u; o[64 + s] = M; o[128 + s] = __expf(ms - M); o[192 + s] = __expf(-(bt + M)); }
    LDS_BARRIER();
    f32x16 qk;
#pragma unroll
    for (int i = 0; i < 16; ++i) qk[i] = 0.f;
    if (F.wave < 4) mm32<64>(qk, Q + 32 * (F.wave >> 1) * ST64, ST64, Kn + 32 * (F.wave & 1) * ST64, ST64, lane);
    f32x16 hs;
#pragma unroll
    for (int i = 0; i < 16; ++i) hs[i] = 0.f;
#pragma unroll 1
    for (int dir = 0; dir < 2; ++dir) {
        const LAS float* sd = sm + dir * 256;
        { const int v = tid >> 2, pc = tid & 3; *(LAS u32x4*)(Cs + v * ST64 + pc * 32) = dir == 0 ? R.cf[0] : cb[0]; *(LAS u32x4*)(Cs + v * ST64 + pc * 32 + 16) = dir == 0 ? R.cf[1] : cb[1]; }
        { const int row = tid >> 3, pc = tid & 7; const u32x4 q = R.q; const float w = sd[128 + row];
          *(LAS u32x4*)(Qs + row * ST64 + pc * 16) = (u32x4){pk2(bflo(q.x) * w, bfhi(q.x) * w), pk2(bflo(q.y) * w, bfhi(q.y) * w), pk2(bflo(q.z) * w, bfhi(q.z) * w), pk2(bflo(q.w) * w, bfhi(q.w) * w)}; }
        if (F.wave < 4) { const int s = 32 * (F.wave & 1) + (lane & 31); const float us = sd[s]; float Mt[16];
#pragma unroll
            for (int r = 0; r < 16; ++r) Mt[r] = sd[64 + 32 * (F.wave >> 1) + rowmap(r, lane >> 5)];
#pragma unroll
            for (int r = 0; r < 16; r += 2) { const int t0 = 32 * (F.wave >> 1) + rowmap(r, lane >> 5), t1 = 32 * (F.wave >> 1) + rowmap(r + 1, lane >> 5);
                const bool ok0 = dir == 0 ? (s <= t0) : (s >= t0), ok1 = dir == 0 ? (s <= t1) : (s >= t1);
                f32x2_t ex = (f32x2_t){us - Mt[r], us - Mt[r + 1]}; ex.x = fminf(ex.x, 0.f); ex.y = fminf(ex.y, 0.f); ex = ex * 1.44269504f;
                const f32x2_t p = (f32x2_t){qk[r], qk[r + 1]} * (f32x2_t){__builtin_amdgcn_exp2f(ex.x), __builtin_amdgcn_exp2f(ex.y)}; const unsigned w = pk2(ok0 ? p.x : 0.f, ok1 ? p.y : 0.f);
                *(LAS unsigned short*)(Pm + t0 * ST64 + s * 2) = (unsigned short)w; *(LAS unsigned short*)(Pm + t1 * ST64 + s * 2) = (unsigned short)(w >> 16); } }
        LDS_BARRIER();
        if (tid < 256) { const int t = tid >> 2, qd = tid & 3; float den = 0.f, qn = 0.f;
#pragma unroll
            for (int i = 0; i < 2; ++i) { const u32x4 w = *(const LAS u32x4*)(Pm + t * ST64 + qd * 32 + i * 16); den += (bflo(w.x) + bfhi(w.x)) + (bflo(w.y) + bfhi(w.y)) + (bflo(w.z) + bfhi(w.z)) + (bflo(w.w) + bfhi(w.w));
                const u32x4 q = *(const LAS u32x4*)(Q + t * ST64 + qd * 32 + i * 16); const LAS float* nvp = sm + 512 + dir * 64 + qd * 16 + i * 8; const f32x4 n0 = *(const LAS f32x4*)nvp, n1 = *(const LAS f32x4*)(nvp + 4);
                qn += (bflo(q.x) * n0.x + bfhi(q.x) * n0.y) + (bflo(q.y) * n0.z + bfhi(q.y) * n0.w) + (bflo(q.z) * n1.x + bfhi(q.z) * n1.y) + (bflo(q.w) * n1.z + bfhi(q.w) * n1.w); }
            den += sd[128 + t] * qn;
            den += dppf<0xB1, 0xf, true>(0.f, den); den += dppf<0x4E, 0xf, true>(0.f, den);
            if (qd == 0) sm[640 + t] = 1.f / fmaxf(fabsf(den), sd[192 + t]); }
        f32x16 acc;
#pragma unroll
        for (int i = 0; i < 16; ++i) acc[i] = 0.f;
        { const int mt = F.wave >> 2, nt = F.wave & 3;
          mm32<64>(acc, Pm + 32 * mt * ST64, ST64, VT + 32 * nt * ST64, ST64, lane);
          mm32<64>(acc, Qs + 32 * mt * ST64, ST64, Cs + 32 * nt * ST64, ST64, lane); }
        LDS_BARRIER();
        float dsc[16];
#pragma unroll
        for (int r = 0; r < 16; ++r) dsc[r] = sm[640 + 32 * (F.wave >> 2) + rowmap(r, lane >> 5)];
#pragma unroll
        for (int r = 0; r < 16; ++r) hs[r] += acc[r] * dsc[r];
        if (dir == 0) LDS_BARRIER();
    }
    gate_load<0>(F, row0, h, gate);
    head_epilogue<0>(F, ng, hs, gate, sm + 768, row0, h);
}

struct HgPrep { float k[16], x[16]; float T[4]; };
__device__ __forceinline__ void hg_zload(Frame& F, int h, int row0, int dir, unsigned (&z)[16]) {
    const int d = F.tid & 127, qtr = F.tid >> 7;
    const bf16* P = (const bf16*)(F.ws + WS_P) + (size_t)(row0 + qtr * 16) * PW + (dir == 0 ? PC_FF : PC_FB) + h * 128 + d;
#pragma unroll
    for (int i = 0; i < 16; ++i) z[i] = P[(size_t)i * PW];
}
struct HgConst { float lb, bf, bb; };
__device__ __forceinline__ HgConst hg_const(Frame& F, CArgs& A, int l, int h) { const int ch = h * 128 + (F.tid & 127); HgConst c; c.lb = 0.f;
    if (l == 1) { const float r0 = A.in[I_HGLB][ch], r1 = A.in[I_HGLB][512 + ch], mx = fmaxf(r0, r1), e0 = __expf(r0 - mx), e1 = __expf(r1 - mx); c.lb = e1 / (e0 + e1); }
    c.bf = A.in[I_HGFB][l * 1024 + ch]; c.bb = A.in[I_HGFB][l * 1024 + 512 + ch]; return c; }
template <int dir>
__device__ __forceinline__ void hg_prep(Frame& F, const HgConst& C, int l, const unsigned (&zr)[16], LAS float* tot, HgPrep& R) {
    const int d = F.tid & 127, qtr = F.tid >> 7;
    const float lb = C.lb, bias = dir == 0 ? C.bf : C.bb, omlb = 1.f - lb;
    float cs = 0.f;
#pragma unroll
    for (int i = 0; i < 16; i += 2) {
        f32x2_t z = (f32x2_t){bf2f((unsigned short)zr[i]), bf2f((unsigned short)zr[i + 1])} + bias;
        z.x = fminf(fmaxf(z.x, -30.f), 30.f); z.y = fminf(fmaxf(z.y, -30.f), 30.f);
        const f32x2_t t = z * (-1.44269504f);
        const f32x2_t ez = {__builtin_amdgcn_exp2f(t.x), __builtin_amdgcn_exp2f(t.y)}, dn = ez + 1.f;
        const f32x2_t sg = {__builtin_amdgcn_rcpf(dn.x), __builtin_amdgcn_rcpf(dn.y)};
        const f32x2_t kk = (ez * sg) * omlb, ff = sg * omlb + lb;
        R.k[i] = kk.x; R.k[i + 1] = kk.y;
        const f32x2_t lf = (f32x2_t){__builtin_amdgcn_logf(ff.x), __builtin_amdgcn_logf(ff.y)} * 0.69314718f;
        if (dir == 0) { cs += lf.x; R.x[i] = cs; cs += lf.y; R.x[i + 1] = cs; } else { R.x[i] = cs; cs += lf.x; R.x[i + 1] = cs; cs += lf.y; } }
    tot[dir * 512 + qtr * 128 + d] = cs;
    LDS_BARRIER();
    float off = 0.f;
#pragma unroll
    for (int q = 0; q < 4; ++q) { R.T[q] = tot[dir * 512 + q * 128 + d]; if (q < qtr) off += R.T[q]; }
#pragma unroll
    for (int i = 0; i < 16; ++i) R.x[i] += off;
}
__device__ __forceinline__ void put16(LAS unsigned char* p, const float (&v)[16]) {
    *(LAS u32x4*)p = (u32x4){pk2(v[0], v[1]), pk2(v[2], v[3]), pk2(v[4], v[5]), pk2(v[6], v[7])};
    *(LAS u32x4*)(p + 16) = (u32x4){pk2(v[8], v[9]), pk2(v[10], v[11]), pk2(v[12], v[13]), pk2(v[14], v[15])};
}
struct HgARaw { VtRaw v; unsigned zf[16], zb[16]; };
__device__ __forceinline__ void touch(HgARaw& R) {
#pragma unroll
    for (int i = 0; i < 8; ++i) touch(R.v.w[i]);
#pragma unroll
    for (int i = 0; i < 16; ++i) { touch(R.zf[i]); touch(R.zb[i]); } }
__device__ __forceinline__ void hg_passA_load(Frame& F, int task, HgARaw& R) {
    const TaskId T = task_id(task);
    vt_load(R.v, (const bf16*)(F.ws + WS_CQI), 1024, T.row0, 512 + T.h * 128, F.tid);
    hg_zload(F, T.h, T.row0, 0, R.zf); hg_zload(F, T.h, T.row0, 1, R.zb);
}
__device__ __forceinline__ void hg_passA_run(Frame& F, CArgs& A, int l, int task, const HgARaw& RW) {
    const TaskId T = task_id(task); const int h = T.h, tc = T.tc, sidf = T.sidf;
    LAS unsigned char* VT = F.lds; LAS unsigned char* KT = F.lds + 18432; LAS float* tot = (LAS float*)(F.lds + 55296);
    const int d = F.tid & 127, qtr = F.tid >> 7;
    const HgConst HC = hg_const(F, A, l, h);
    LDS_BARRIER();
    vt_store(VT, RW.v, F.tid);
    float* GG = (float*)(F.ws + WS_HGG);
    { HgPrep R; hg_prep<0>(F, HC, l, RW.zf, tot, R);
      const float G = (R.T[0] + R.T[1]) + (R.T[2] + R.T[3]);
      if (qtr == 0) GG[(size_t)(sidf * NTC + tc) * 128 + d] = G;
      float t[16];
#pragma unroll
      for (int i = 0; i < 16; i += 2) { const f32x2_t te = ((f32x2_t){R.x[i], R.x[i + 1]} - G) * (-1.44269504f);
          const f32x2_t kv = (f32x2_t){R.k[i], R.k[i + 1]} * (f32x2_t){__builtin_amdgcn_exp2f(te.x), __builtin_amdgcn_exp2f(te.y)}; t[i] = kv.x; t[i + 1] = kv.y; }
      put16(KT + d * ST64 + qtr * 32, t); }
    { HgPrep R; hg_prep<1>(F, HC, l, RW.zb, tot, R);
      const float G = (R.T[0] + R.T[1]) + (R.T[2] + R.T[3]);
      if (qtr == 0) GG[(size_t)((sidf + 1) * NTC + tc) * 128 + d] = G;
      float t[16];
#pragma unroll
      for (int i = 0; i < 16; i += 2) { const f32x2_t te = (f32x2_t){R.x[i], R.x[i + 1]} * 1.44269504f;
          const f32x2_t kv = (f32x2_t){R.k[i], R.k[i + 1]} * (f32x2_t){__builtin_amdgcn_exp2f(te.x), __builtin_amdgcn_exp2f(te.y)}; t[i] = kv.x; t[i + 1] = kv.y; }
      put16(KT + 18432 + d * ST64 + qtr * 32, t); }
    LDS_BARRIER();
    { const int dir = F.wave >> 2, mt = F.wave & 3; bf16* S = (bf16*)(F.ws + WS_HGS) + (size_t)((sidf + dir) * NTC + tc) * 16384;
#pragma unroll
      for (int nt = 0; nt < 4; ++nt) { f32x16 acc;
#pragma unroll
          for (int i = 0; i < 16; ++i) acc[i] = 0.f;
          mm32<64>(acc, VT + 32 * mt * ST64, ST64, KT + dir * 18432 + 32 * nt * ST64, ST64, F.lane);
#pragma unroll
          for (int r = 0; r < 16; ++r) S[(32 * mt + rowmap(r, F.lane >> 5)) * 128 + 32 * nt + (F.lane & 31)] = (bf16)f2bf(acc[r]); } }
}
struct HgCRaw { VtRaw v; unsigned zf[16], q[16]; };
__device__ __forceinline__ void touch(HgCRaw& R) {
#pragma unroll
    for (int i = 0; i < 8; ++i) touch(R.v.w[i]);
#pragma unroll
    for (int i = 0; i < 16; ++i) { touch(R.zf[i]); touch(R.q[i]); } }
__device__ __forceinline__ void hg_passC_load(Frame& F, int task, HgCRaw& R) {
    const TaskId T = task_id(task); const bf16* CQI = (const bf16*)(F.ws + WS_CQI);
    vt_load(R.v, CQI, 1024, T.row0, 512 + T.h * 128, F.tid);
    hg_zload(F, T.h, T.row0, 0, R.zf);
    { const int d = F.tid & 127, qtr = F.tid >> 7;
#pragma unroll
      for (int i = 0; i < 16; ++i) R.q[i] = CQI[(size_t)(T.row0 + qtr * 16 + i) * 1024 + T.h * 128 + d]; }
}
__device__ __forceinline__ void hg_passC_run(Frame& F, CArgs& A, int l, int task, const HgCRaw& RW) {
    const TaskId T = task_id(task); const int h = T.h, tc = T.tc, row0 = T.row0, sidf = T.sidf;
    LAS unsigned char* VT = F.lds; LAS unsigned char* Ss = F.lds + 18432; LAS unsigned char* Qh = F.lds + 53248; LAS unsigned char* Kh = F.lds + 70656;
    LAS unsigned char* Qc = F.lds + 88064; LAS unsigned char* Kc = F.lds + 96768; LAS unsigned char* Qt = F.lds + 105472; LAS unsigned char* Am = F.lds + 122880;
    LAS float* tot = (LAS float*)(F.lds + 132096);
    const int tid = F.tid, lane = F.lane, d = tid & 127, qtr = tid >> 7;
    if (l == DEPTH - 1 && tc < 4) return;
    unsigned gate[16];
    const HgConst HC = hg_const(F, A, l, h);
    unsigned zb[16]; hg_zload(F, h, row0, 1, zb);
    u32x4 sf[4], sb[4]; { const u32x4* sp = (const u32x4*)((const bf16*)(F.ws + WS_HGSB) + (size_t)(sidf * NTC + tc) * 16384 + (tid >> 2) * 128 + (tid & 3) * 32);
#pragma unroll
      for (int j = 0; j < 4; ++j) { sf[j] = sp[j]; sb[j] = sp[j + (size_t)NTC * 16384 * 2 / 16]; } }
    LDS_BARRIER();
    vt_store(VT, RW.v, tid);
    f32x16 acc;
#pragma unroll
    for (int i = 0; i < 16; ++i) acc[i] = 0.f;
#pragma unroll
    for (int dir = 0; dir < 2; ++dir) {
        HgPrep R;
        if (dir == 1) gate_load<1>(F, row0, h, gate);
        if (dir == 0) hg_prep<0>(F, HC, l, RW.zf, tot, R); else hg_prep<1>(F, HC, l, zb, tot, R);
        const float T0 = R.T[0], T1 = R.T[1], T2 = R.T[2], T3 = R.T[3];
        const float sg = dir == 0 ? 1.f : -1.f;
        const float rI = sg * ((qtr >> 1) == 0 ? T0 : (T0 + T1) + T2);
        const float rO = sg * (T0 + T1);
        const float Gall = (T0 + T1) + (T2 + T3);
        const bool isq = dir == 0 ? (qtr >= 2) : (qtr < 2);
        const float cO = __expf(isq ? rI - rO : rO - rI), cT = __expf(dir == 0 ? rI : Gall + rI);
        { const int v = tid >> 2, pc = tid & 3;
#pragma unroll
          for (int j = 0; j < 4; ++j) *(LAS u32x4*)(Ss + v * ST128 + pc * 64 + j * 16) = dir == 0 ? sf[j] : sb[j]; }
#pragma unroll
        for (int i = 0; i < 16; i += 2) {
            const int t = qtr * 16 + i;
            const f32x2_t x = dir == 0 ? (f32x2_t){R.x[i], R.x[i + 1]} : (f32x2_t){-R.x[i], -R.x[i + 1]}, kk = {R.k[i], R.k[i + 1]}, qv = {bf2f((unsigned short)RW.q[i]), bf2f((unsigned short)RW.q[i + 1])};
            const f32x2_t te = (x - rI) * 1.44269504f;
            const f32x2_t eh = {__builtin_amdgcn_exp2f(te.x), __builtin_amdgcn_exp2f(te.y)}, ehr = {__builtin_amdgcn_rcpf(eh.x), __builtin_amdgcn_rcpf(eh.y)};
            const f32x2_t qe = qv * eh, ke = kk * ehr, of = (isq ? qe : ke) * cO, qt = qe * cT;
            const unsigned wq = pk2(qe.x, qe.y), wk = pk2(ke.x, ke.y), wo = pk2(of.x, of.y), wt = pk2(qt.x, qt.y);
            *(LAS unsigned short*)(Qh + t * ST128 + d * 2) = (unsigned short)wq; *(LAS unsigned short*)(Qh + (t + 1) * ST128 + d * 2) = (unsigned short)(wq >> 16);
            *(LAS unsigned short*)(Kh + t * ST128 + d * 2) = (unsigned short)wk; *(LAS unsigned short*)(Kh + (t + 1) * ST128 + d * 2) = (unsigned short)(wk >> 16);
            LAS unsigned char* oc = isq ? Qc : Kc;
            *(LAS unsigned short*)(oc + (t & 31) * ST128 + d * 2) = (unsigned short)wo; *(LAS unsigned short*)(oc + ((t + 1) & 31) * ST128 + d * 2) = (unsigned short)(wo >> 16);
            *(LAS unsigned short*)(Qt + t * ST128 + d * 2) = (unsigned short)wt; *(LAS unsigned short*)(Qt + (t + 1) * ST128 + d * 2) = (unsigned short)(wt >> 16);
        }
        LDS_BARRIER();
        if (F.wave < 4) { f32x16 a;
#pragma unroll
            for (int i = 0; i < 16; ++i) a[i] = 0.f;
            int tt = 0, ts = 0;
            if (F.wave < 2) { tt = ts = F.wave; mm32<128>(a, Qh + 32 * tt * ST128, ST128, Kh + 32 * ts * ST128, ST128, lane);
#pragma unroll
                for (int r = 0; r < 16; ++r) { const int tl = rowmap(r, lane >> 5), sl = lane & 31; const bool ok = dir == 0 ? (sl <= tl) : (sl >= tl); a[r] = ok ? a[r] : 0.f; } }
            else if (F.wave == 2) { tt = dir == 0 ? 1 : 0; ts = 1 - tt; mm32<128>(a, Qc, ST128, Kc, ST128, lane); }
            else { tt = dir == 0 ? 0 : 1; ts = 1 - tt; }
#pragma unroll
            for (int r = 0; r < 16; r += 2) { const unsigned w = pk2(a[r], a[r + 1]); *(LAS unsigned short*)(Am + (32 * tt + rowmap(r, lane >> 5)) * ST64 + (32 * ts + (lane & 31)) * 2) = (unsigned short)w;
                *(LAS unsigned short*)(Am + (32 * tt + rowmap(r + 1, lane >> 5)) * ST64 + (32 * ts + (lane & 31)) * 2) = (unsigned short)(w >> 16); } }
        LDS_BARRIER();
        { const int mt = F.wave >> 2, nt = F.wave & 3;
          mm32<64>(acc, Am + 32 * mt * ST64, ST64, VT + 32 * nt * ST64, ST64, lane);
          mm32<128>(acc, Qt + 32 * mt * ST128, ST128, Ss + 32 * nt * ST128, ST128, lane); }
        if (dir == 0) LDS_BARRIER();
    }
    const float ng = A.in[I_HGNG][l * 512 + h * 128 + 32 * (F.wave & 3) + (lane & 31)];
    head_epilogue<1>(F, ng, acc, gate, (LAS float*)(F.lds + 136192), row0, h);
}
#define TASK_LOOP(RAW, LOADFN, RUNFN, T0, T1) do { int t_ = F.vcu; while (t_ < (T0)) t_ += F.G; RAW cur_; if (t_ < (T1)) { LOADFN(t_ - (T0), cur_); } \
    for (; t_ < (T1); t_ += F.G) { touch(cur_); RAW nxt_; if (t_ + F.G < (T1)) { LOADFN(t_ + F.G - (T0), nxt_); } else nxt_ = cur_; RUNFN(t_ - (T0), cur_); cur_ = nxt_; } } while (0)

__device__ __forceinline__ void transpose_item(const float* W, int ldw, int K, bf16* WT, int k0, int n0, int drow0, LAS float* scr, int lane) {
    const int n4 = (lane & 7) * 4, kr = lane >> 3;
    f32x4 v[8];
#pragma unroll
    for (int i = 0; i < 8; ++i) v[i] = __builtin_nontemporal_load((const f32x4*)(W + (size_t)(k0 + 8 * i + kr) * ldw + n0 + n4));
#pragma unroll
    for (int i = 0; i < 8; ++i) { LAS float* p = scr + (8 * i + kr) * 33 + n4; p[0] = v[i].x; p[1] = v[i].y; p[2] = v[i].z; p[3] = v[i].w; }
    asm volatile("s_waitcnt lgkmcnt(0)" ::: "memory");
    const int c = lane & 7;
#pragma unroll
    for (int j = 0; j < 4; ++j) { const int n = (lane >> 3) + 8 * j; const LAS float* s = scr + (8 * c) * 33 + n;
        u32x4 o; o.x = pk2(s[0 * 33], s[1 * 33]); o.y = pk2(s[2 * 33], s[3 * 33]); o.z = pk2(s[4 * 33], s[5 * 33]); o.w = pk2(s[6 * 33], s[7 * 33]);
        *(u32x4*)(WT + (size_t)(drow0 + n) * K + k0 + 8 * c) = o; }
    asm volatile("s_waitcnt lgkmcnt(0)" ::: "memory");
}
__device__ __forceinline__ void ph_convert(Frame& F, CArgs& A, bool small_only) {
    LAS float* scr = (LAS float*)(F.lds + 32768 + F.wave * 8448);
    const int gw = F.vcu * NWAVES + F.wave, NGW = F.G * NWAVES;
    constexpr int I_IN = DEPTH * 16 * 128, I_OUT = DEPTH * 16 * 32, I_GU = DEPTH * NEXP * 16 * 64, I_DN = DEPTH * NEXP * 16 * 32;
    for (int it = gw; it < (small_only ? I_IN + I_OUT : I_IN + I_OUT + I_GU + I_DN); it += NGW) {
        int r = it;
        if (r < I_IN) { const int l = r / 2048, q = r % 2048, kb = q / 128, nb = q % 128, d0 = nb * 32, n0 = d0 < 1536 ? d0 : d0 + 16;
            transpose_item(A.in[I_WIN] + (size_t)l * D * INW, INW, D, (bf16*)(F.ws + WS_WIN) + (size_t)l * PW * D, kb * 64, n0, d0, scr, F.lane); continue; }
        r -= I_IN;
        if (r < I_OUT) { const int l = r / 512, q = r % 512, kb = q / 32, nb = q % 32;
            transpose_item(A.in[I_WOUT] + (size_t)l * D * D, D, D, (bf16*)(F.ws + WS_WOUT) + (size_t)l * D * D, kb * 64, nb * 32, nb * 32, scr, F.lane); continue; }
        r -= I_OUT;
        if (r < I_GU) { const int m = r / 1024, q = r % 1024, kb = q / 64, nb = q % 64, n0 = nb * 32;
            const int cc = n0 & 1023, d0 = (cc >> 7) * 256 + (n0 >= 1024 ? 128 : 0) + (cc & 127);
            transpose_item(A.in[I_WGU] + (size_t)m * D * 2048, 2048, D, (bf16*)(F.ws + WS_WGU) + (size_t)m * 2048 * D, kb * 64, n0, d0, scr, F.lane); continue; }
        r -= I_GU;
        { const int m = r / 512, q = r % 512, kb = q / 32, nb = q % 32;
            transpose_item(A.in[I_WDN] + (size_t)m * DEXP * D, D, DEXP, (bf16*)(F.ws + WS_WDN) + (size_t)m * D * DEXP, kb * 64, nb * 32, nb * 32, scr, F.lane); }
    }
}


constexpr int CV_NJ = 384;
__device__ __forceinline__ void moe_item_addr(CArgs& A, unsigned char* ws, int item, const float*& W, int& ldw, bf16*& WT, int& k0, int& n0, int& d0) {
    const int l = item / 49152, r = item % 49152;
    if (r < 32768) { const int e = r >> 10, q = r & 1023, kb = q >> 6, nb = q & 63; n0 = nb * 32; const int cc = n0 & 1023; d0 = (cc >> 7) * 256 + (n0 >= 1024 ? 128 : 0) + (cc & 127); k0 = kb * 64;
        W = A.in[I_WGU] + (size_t)(l * NEXP + e) * D * 2048; ldw = 2048; WT = (bf16*)(ws + WS_WGU) + (size_t)(l * NEXP + e) * 2048 * D; }
    else { const int r2 = r - 32768, e = r2 >> 9, q = r2 & 511, kb = q >> 5, nb = q & 31; n0 = nb * 32; d0 = n0; k0 = kb * 64;
        W = A.in[I_WDN] + (size_t)(l * NEXP + e) * DEXP * D; ldw = D; WT = (bf16*)(ws + WS_WDN) + (size_t)(l * NEXP + e) * D * DEXP; }
}
__device__ __forceinline__ void transpose_store(bf16* WT, int K, int k0, int d0, LAS float* scr, const f32x4 (&v)[8], int lane) {
    const int n4 = (lane & 7) * 4, kr = lane >> 3;
#pragma unroll
    for (int i = 0; i < 8; ++i) { LAS float* p = scr + (8 * i + kr) * 33 + n4; p[0] = v[i].x; p[1] = v[i].y; p[2] = v[i].z; p[3] = v[i].w; }
    asm volatile("s_waitcnt lgkmcnt(0)" ::: "memory");
    const int c = lane & 7;
#pragma unroll
    for (int j = 0; j < 4; ++j) { const int n = (lane >> 3) + 8 * j; const LAS float* sp = scr + (8 * c) * 33 + n;
        u32x4 o; o.x = pk2(sp[0 * 33], sp[1 * 33]); o.y = pk2(sp[2 * 33], sp[3 * 33]); o.z = pk2(sp[4 * 33], sp[5 * 33]); o.w = pk2(sp[6 * 33], sp[7 * 33]);
        *(u32x4*)(WT + (size_t)(d0 + n) * K + k0 + 8 * c) = o; }
    asm volatile("s_waitcnt lgkmcnt(0)" ::: "memory");
}
__device__ __forceinline__ void convert_moe_all(unsigned char* ws, LAS unsigned char* lds, CArgs& A, int cw, int nw, int wave, int lane, int it_lo = 0, int it_hi = 49152) {
    LAS float* scr = (LAS float*)(lds + wave * 16640);
    const int n4 = (lane & 15) * 4, kr = lane >> 4;
    for (int it = it_lo + cw; it < it_hi; it += 2 * nw) {
        const float* W[2]; bf16* WT[2]; int ldw[2], k0[2], n0[2], d0[2];
        const bool two = it + nw < it_hi;
#pragma unroll
        for (int u = 0; u < 2; ++u) { const int iu = (u == 1 && two) ? it + nw : it; const int le = iu / 768, r = iu % 768;
            if (r < 512) { const int kb = r >> 5, nb = r & 31; k0[u] = kb * 64; n0[u] = nb * 64; const int cc = n0[u] & 1023; d0[u] = (cc >> 7) * 256 + (n0[u] >= 1024 ? 128 : 0) + (cc & 127);
                W[u] = A.in[I_WGU] + (size_t)le * D * 2048; ldw[u] = 2048; WT[u] = (bf16*)(ws + WS_WGU) + (size_t)le * 2048 * D; }
            else { const int q = r - 512, kb = q >> 4, nb = q & 15; k0[u] = kb * 64; n0[u] = nb * 64; d0[u] = n0[u];
                W[u] = A.in[I_WDN] + (size_t)le * DEXP * D; ldw[u] = D; WT[u] = (bf16*)(ws + WS_WDN) + (size_t)le * D * DEXP; } }
        f32x4 v[2][16];
#pragma unroll
        for (int u = 0; u < 2; ++u)
#pragma unroll
            for (int i = 0; i < 16; ++i) v[u][i] = __builtin_nontemporal_load((const f32x4*)(W[u] + (size_t)(k0[u] + 4 * i + kr) * ldw[u] + n0[u] + n4));
#pragma unroll
        for (int u = 0; u < 2; ++u) { if (u == 1 && !two) break;
#pragma unroll
            for (int i = 0; i < 16; ++i) { LAS float* p = scr + (4 * i + kr) * 65 + n4; p[0] = v[u][i].x; p[1] = v[u][i].y; p[2] = v[u][i].z; p[3] = v[u][i].w; }
            asm volatile("s_waitcnt lgkmcnt(0)" ::: "memory");
            const int c = lane & 7;
#pragma unroll
            for (int j = 0; j < 8; ++j) { const int n = (lane >> 3) + 8 * j; const LAS float* sp = scr + (8 * c) * 65 + n;
                u32x4 o; o.x = pk2(sp[0 * 65], sp[1 * 65]); o.y = pk2(sp[2 * 65], sp[3 * 65]); o.z = pk2(sp[4 * 65], sp[5 * 65]); o.w = pk2(sp[6 * 65], sp[7 * 65]);
                *(u32x4*)(WT[u] + (size_t)(d0[u] + n) * 1024 + k0[u] + 8 * c) = o; }
            asm volatile("s_waitcnt lgkmcnt(0)" ::: "memory"); }
    }
}
__device__ __forceinline__ void convert_moe(unsigned char* ws, LAS unsigned char* lds, CArgs& A, int cw, int wave, int lane, int j0, int j1) {
    LAS float* scr = (LAS float*)(lds + wave * 8448);
    const int n4 = (lane & 7) * 4, kr = lane >> 3;
    for (int j = j0; j < j1; j += 2) {
        const float* W0; const float* W1; bf16* T0; bf16* T1; int l0, l1, ka, kb_, na, nb_, da, db;
        moe_item_addr(A, ws, cw + 256 * j, W0, l0, T0, ka, na, da);
        const bool two = j + 1 < j1; moe_item_addr(A, ws, cw + 256 * (two ? j + 1 : j), W1, l1, T1, kb_, nb_, db);
        f32x4 v0[8], v1[8];
#pragma unroll
        for (int i = 0; i < 8; ++i) v0[i] = __builtin_nontemporal_load((const f32x4*)(W0 + (size_t)(ka + 8 * i + kr) * l0 + na + n4));
#pragma unroll
        for (int i = 0; i < 8; ++i) v1[i] = __builtin_nontemporal_load((const f32x4*)(W1 + (size_t)(kb_ + 8 * i + kr) * l1 + nb_ + n4));
        transpose_store(T0, 1024, ka, da, scr, v0, lane);
        if (two) transpose_store(T1, 1024, kb_, db, scr, v1, lane);
    }
}

#define XB_TMO      128
#define XB_XCNT(j)  (256  + 64 * (j))
#define XB_XSUB(j)  (1280 + 64 * (j))
#define XB_XGEN(j)  (2304 + 64 * (j))
#define XB_TOP      3328
#define XB_TOPGEN   3392
#define XCD_BAR_WORDS 3456
#define XB_SPIN_CAP (1u << 18)
__device__ __forceinline__ unsigned xb_ld(unsigned* p)              { return __hip_atomic_load(p, __ATOMIC_RELAXED, __HIP_MEMORY_SCOPE_AGENT); }
__device__ __forceinline__ unsigned xb_add(unsigned* p, unsigned v) { return __hip_atomic_fetch_add(p, v, __ATOMIC_RELAXED, __HIP_MEMORY_SCOPE_AGENT); }
__device__ __forceinline__ unsigned xb_xcc_id() { return (unsigned)__builtin_amdgcn_s_getreg((3 << 11) | 20) & 0xFu; }
#define XB_SPIN(cond, bar) do { unsigned _sp = 0; while (cond) { __builtin_amdgcn_s_sleep(1); \
    if ((++_sp & 255u) == 0u) { if (xb_ld(&(bar)[XB_TMO])) break; if (_sp > XB_SPIN_CAP) { atomicAdd(&(bar)[XB_TMO], 1u); break; } } } } while (0)
struct XcdBarrier { unsigned* bar; unsigned x; volatile LAS unsigned* st; };
__device__ __forceinline__ XcdBarrier xcd_barrier_post(unsigned* bar, volatile LAS unsigned* st) {
    XcdBarrier b; b.bar = bar; b.x = xb_xcc_id(); b.st = st;
    if (threadIdx.x == 0) (void)xb_add(&bar[XB_XCNT(b.x)], 1u);
    return b;
}
__device__ __forceinline__ void xcd_barrier_complete(unsigned* bar, unsigned x, unsigned& nloc, unsigned& nx) {
    const unsigned G = gridDim.x * gridDim.y * gridDim.z;
    unsigned sum, cnt, mine, sp = 0u;
    for (;;) {
        sum = 0u; cnt = 0u; mine = 0u;
#pragma unroll
        for (unsigned j = 0; j < 16; ++j) { const unsigned c = xb_ld(&bar[XB_XCNT(j)]); sum += c; cnt += (c > 0u) ? 1u : 0u; mine = (j == x) ? c : mine; }
        if (sum == G) break;
        __builtin_amdgcn_s_sleep(1);
        if ((++sp & 255u) == 0u) { if (xb_ld(&bar[XB_TMO])) break; if (sp > XB_SPIN_CAP) { atomicAdd(&bar[XB_TMO], 1u); break; } }
    }
    nloc = mine > 0u ? mine : 1u; nx = cnt > 0u ? cnt : 1u;
}
__device__ __forceinline__ void xcd_barrier(const XcdBarrier& b) {
    asm volatile("s_waitcnt vmcnt(0)" ::: "memory");
    __syncthreads();
    if (threadIdx.x == 0) {
        unsigned* bar = b.bar;
        __builtin_amdgcn_s_waitcnt(0);
        unsigned nloc = b.st[0], nx = b.st[1];
        if (nloc == 0u) { xcd_barrier_complete(bar, b.x, nloc, nx); b.st[0] = nloc; b.st[1] = nx; }
        const unsigned old = xb_add(&bar[XB_XSUB(b.x)], 1u);
        const unsigned gen = old / nloc;
        if (old + 1u == (gen + 1u) * nloc) {
            __builtin_amdgcn_fence(__ATOMIC_RELEASE, "agent");
            asm volatile("s_waitcnt vmcnt(0)" ::: "memory");
            const unsigned og = xb_add(&bar[XB_TOP], 1u);
            const unsigned tg = og / nx;
            if (og + 1u == (tg + 1u) * nx) xb_add(&bar[XB_TOPGEN], 1u);
            else XB_SPIN(xb_ld(&bar[XB_TOPGEN]) == tg, bar);
            __builtin_amdgcn_fence(__ATOMIC_ACQUIRE, "agent");
            xb_add(&bar[XB_XGEN(b.x)], 1u);
            asm volatile("s_waitcnt vmcnt(0)" ::: "memory");
        } else {
            XB_SPIN(xb_ld(&bar[XB_XGEN(b.x)]) == gen, bar);
            __builtin_amdgcn_fence(__ATOMIC_ACQUIRE, "agent");
            asm volatile("s_waitcnt vmcnt(0)" ::: "memory");
        }
    }
    __syncthreads();
}

enum { PH_INIT = 0, PH_NORM1, PH_INPROJ, PH_CONV, PH_SCANA, PH_SCANB, PH_SCANC, PH_HNORM, PH_OUTPROJ, PH_NORM2, PH_LISTS, PH_GU, PH_DOWN, PH_COMBINE, PH_FINAL };

constexpr int NPHASE = 1 + 13 * DEPTH;
template <int ph, int l>
__device__ __forceinline__ void run_phase(LAS unsigned char* lds_raw) {
    int tid_ = threadIdx.x; asm volatile("" : "+v"(tid_));
    CArgs* ap_ = (CArgs*)__builtin_amdgcn_kernarg_segment_ptr(); asm volatile("" : "+s"(ap_));
    CArgs& A_ = *ap_;
    unsigned char* ws_ = A_.ws; asm volatile("" : "+s"(ws_));
    unsigned lb_ = 0u, bx_ = blockIdx.x, gx_ = gridDim.x; asm volatile("" : "+s"(lb_), "+s"(bx_), "+s"(gx_));
    Frame F; F.lds = lds_raw + lb_; F.out = A_.out; F.ws = ws_;
    F.tid = tid_; F.lane = F.tid & 63; F.wave = __builtin_amdgcn_readfirstlane(F.tid >> 6);
    F.G = (int)gx_; { const int bx = (int)bx_; F.vcu = (F.G % 8 == 0) ? (bx % 8) * (F.G / 8) + bx / 8 : bx; }
    constexpr int nrows = (l == DEPTH - 1) ? NLAT : NTOK;
    constexpr bool CVPH = (l == 0) && (ph <= PH_LISTS);
    constexpr int CQ0 = ph == PH_INIT ? 0 : ph == PH_NORM1 ? 25 : ph == PH_INPROJ ? 55 : ph == PH_CONV ? 140 : ph == PH_SCANA ? 165 : ph == PH_SCANB ? 205 : ph == PH_SCANC ? 233 : ph == PH_OUTPROJ ? 313 : ph == PH_NORM2 ? 344 : 378;
    constexpr int CQ1 = ph == PH_INIT ? 25 : ph == PH_NORM1 ? 55 : ph == PH_INPROJ ? 140 : ph == PH_CONV ? 165 : ph == PH_SCANA ? 205 : ph == PH_SCANB ? 233 : ph == PH_SCANC ? 313 : ph == PH_OUTPROJ ? 344 : ph == PH_NORM2 ? 378 : CV_NJ;
    const bool cvgrid = false;
    if (CVPH && cvgrid) {
        if (bx_ >= 224u) { const int cvcu = (int)(bx_ & 7u) * 4 + ((int)(bx_ >> 3) - 28); convert_moe(ws_, F.lds, A_, cvcu * 8 + F.wave, F.wave, F.lane, CQ0, CQ1); return; }
        F.G = 224; F.vcu = (int)(bx_ & 7u) * 28 + (int)(bx_ >> 3); gx_ = 224u;
    }
    switch (ph) {
        case PH_INIT: ph_init(F, A_); ph_convert(F, A_, true); break;
        case PH_INPROJ: {
            const bool cfirst = ((bx_ >> 3) & 1u) == 0u;
            int base, nblk;
            if (F.G == 256 && l == 0) { if (bx_ >= 32u) { const int ix = (int)bx_ - 32; nblk = 74 + (ix < 16 ? 1 : 0); base = ix * 74 + (ix < 16 ? ix : 16); } else { base = 16592 + (int)bx_ * 48; nblk = 48; } }
            else if (F.G == 256) { if (bx_ >= 32u) { base = ((int)bx_ - 32) * 100; nblk = 100; } else { base = 22400 + (int)bx_ * 68; nblk = 68; } }
            else { const int per = (24576 + F.G - 1) / F.G; base = F.vcu * per; nblk = base + per <= 24576 ? per : (base < 24576 ? 24576 - base : 0); }
            base += l * 24576;
            if (cfirst) { convert_moe_all(F.ws, F.lds, A_, F.wave, NWAVES, F.wave, F.lane, base, base + nblk); __syncthreads(); }
            { pg8::Gemm g{(const bf16*)(F.ws + WS_H), (const bf16*)(F.ws + WS_WIN) + (size_t)l * PW * D, D, nullptr, nullptr, 0};
              pg8::StaticOrder S; S.init(NTOK / 256, PW / 256, F.G, (int)bx_); pg8::EpiBf16 E{(bf16*)(F.ws + WS_P), PW};
              pg8::gemm_phase<pg8::EpiBf16, pg8::StaticOrder, true>(F.lds, g, S, E, F.tid); }
            if (!cfirst) { __syncthreads(); convert_moe_all(F.ws, F.lds, A_, F.wave, NWAVES, F.wave, F.lane, base, base + nblk); }
        } break;
        case PH_NORM1: if (l == 0) ph_rows<1, 0>(F, A_, 0, 0, NTOK); break;
        case PH_CONV: ph_conv(F, A_, l); break;
        case PH_SCANA: {
#define LD_(t, R) ml_passA_load(F, t, R)
#define RN_(t, R) ml_passA_run(F, t, R)
            TASK_LOOP(MlARaw, LD_, RN_, 0, 8 * NTC);
#undef LD_
#undef RN_
#define LD_(t, R) hg_passA_load(F, t, R)
#define RN_(t, R) hg_passA_run(F, A_, l, t, R)
            TASK_LOOP(HgARaw, LD_, RN_, 8 * NTC, 16 * NTC);
#undef LD_
#undef RN_
        } break;
        case PH_SCANB: scan_passB(F); break;
        case PH_SCANC: {
#define LD_(t, R) ml_passC_load(F, t, R)
#define RN_(t, R) ml_passC_run(F, A_, l, t, R)
            TASK_LOOP(MlCRaw, LD_, RN_, 0, 8 * NTC);
#undef LD_
#undef RN_
#define LD_(t, R) hg_passC_load(F, t, R)
#define RN_(t, R) hg_passC_run(F, A_, l, t, R)
            TASK_LOOP(HgCRaw, LD_, RN_, 8 * NTC, 16 * NTC);
#undef LD_
#undef RN_
        } break;
        case PH_OUTPROJ: { pg8::Gemm g{(const bf16*)(F.ws + WS_Y), (const bf16*)(F.ws + WS_WOUT) + (size_t)l * D * D, D, nullptr, nullptr, 0};
            pg8::StaticOrder S; S.init(nrows / 256, D / 256, F.G, (int)bx_);
            const float* xs = (const float*)(F.ws + WS_X);
            pg8::EpiResid E{(float*)(F.ws + WS_X), (const float*)(F.ws + WS_MOD) + (size_t)l * 3 * 6144 + 2048, l == 0 ? A_.in[I_X] : xs, l == 0 ? A_.in[I_CTX] : xs + (size_t)NLAT * D};
            pg8::gemm_phase<pg8::EpiResid, pg8::StaticOrder, true>(F.lds, g, S, E, F.tid);
            if (l == 0 && F.G == 256 && bx_ >= 8u) { __syncthreads(); const int base = 18128 + ((int)bx_ - 8) * 26; convert_moe_all(F.ws, F.lds, A_, F.wave, NWAVES, F.wave, F.lane, base, base + 26); } } break;
        case PH_GU: { const int* rt = (const int*)(F.ws + WS_ROUTE); const int ntile = rt[RT_TILEE];
            pg8::Gemm g{(const bf16*)(F.ws + WS_H), (const bf16*)(F.ws + WS_WGU) + (size_t)l * NEXP * 2048 * D, D, rt + RT_LIST, rt + RT_TILEE, (size_t)2048 * D};
            pg8::StaticOrder S; S.init(ntile, 2048 / 256, F.G, (int)bx_);
            pg8::EpiSwiglu E{(bf16*)(F.ws + WS_ACT), A_.in[I_BGU] + (size_t)l * NEXP * 2048, rt + RT_TILEE};
            pg8::gemm_phase<pg8::EpiSwiglu, pg8::StaticOrder, true>(F.lds, g, S, E, F.tid); } break;
        case PH_DOWN: { const int* rt = (const int*)(F.ws + WS_ROUTE); const int ntile = rt[RT_TILEE];
            pg8::Gemm g{(const bf16*)(F.ws + WS_ACT), (const bf16*)(F.ws + WS_WDN) + (size_t)l * NEXP * D * DEXP, DEXP, nullptr, rt + RT_TILEE, (size_t)D * DEXP};
            pg8::StaticOrder S; S.init(ntile, D / 256, F.G, (int)bx_);
            pg8::EpiDown E{(bf16*)(F.ws + WS_YS), A_.in[I_BDN] + (size_t)l * NEXP * D, (const float*)(rt + RT_SGATE), rt + RT_TILEE};
            pg8::gemm_phase<pg8::EpiDown, pg8::StaticOrder, true>(F.lds, g, S, E, F.tid); } break;
        case PH_NORM2: ph_rows<0, 1>(F, A_, l, l, nrows); break;
        case PH_LISTS: ph_lists(F, A_, l, nrows); break;
        case PH_COMBINE: if (l == DEPTH - 1) ph_rows<2, 2>(F, A_, l, 0, NLAT); else ph_rows<2, 0>(F, A_, l, l + 1, NTOK); break;
        default: break;
    }
}
__global__ void __launch_bounds__(NTHR, 2) fwd(Args a) {
    extern __shared__ __attribute__((aligned(16))) unsigned char lds_raw[];
    volatile LAS unsigned* bst = (volatile LAS unsigned*)((LAS unsigned char*)lds_raw + LDS_BYTES - 64);
    if (threadIdx.x < 16) bst[threadIdx.x] = 0u;
    __syncthreads();
    XcdBarrier bar = xcd_barrier_post((unsigned*)(a.ws + WS_CTL) + CW_BAR, bst);
#ifndef TPROBE
#define TPROBE 0
#endif
#ifndef TP0
#define TP0 0
#define TP1 0
#define TP2 0
#define TD0 800
#define TD1 800
#define TD2 800
#endif
    unsigned ta0 = 0u, ta1 = 0u, ta2 = 0u; unsigned long long tprev = 0;
    const bool stamper = TPROBE && blockIdx.x == 0;
    if (stamper) tprev = __builtin_amdgcn_s_memrealtime();
#define RUN(pi, ph, l) do { run_phase<ph, l>((LAS unsigned char*)lds_raw); if ((pi) != NPHASE - 1 || TPROBE) xcd_barrier(bar); \
    if (stamper) { const unsigned long long tn = __builtin_amdgcn_s_memrealtime(); const unsigned dt = (unsigned)(tn - tprev); tprev = tn; \
        if ((ph) == TP0) ta0 += dt; if ((ph) == TP1) ta1 += dt; if ((ph) == TP2) ta2 += dt; } } while (0)
#define LAYER(l) if (l == 0) RUN(1 + 13 * l, PH_NORM1, l); RUN(2 + 13 * l, PH_INPROJ, l); RUN(3 + 13 * l, PH_CONV, l); RUN(4 + 13 * l, PH_SCANA, l); RUN(5 + 13 * l, PH_SCANB, l); RUN(6 + 13 * l, PH_SCANC, l); \
    RUN(8 + 13 * l, PH_OUTPROJ, l); RUN(9 + 13 * l, PH_NORM2, l); RUN(10 + 13 * l, PH_LISTS, l); RUN(11 + 13 * l, PH_GU, l); RUN(12 + 13 * l, PH_DOWN, l); RUN(13 + 13 * l, PH_COMBINE, l)
    RUN(0, PH_INIT, 0);
    LAYER(0);
    LAYER(1);
#undef LAYER
#undef RUN
    if (TPROBE) {
        if (stamper) { const unsigned long long tn = __builtin_amdgcn_s_memrealtime();
            unsigned q0 = (ta0 + TD0 / 2) / TD0, q1 = (ta1 + TD1 / 2) / TD1, q2 = (ta2 + TD2 / 2) / TD2;
            q0 = q0 > 31u ? 31u : q0; q1 = q1 > 31u ? 31u : q1; q2 = q2 > 31u ? 31u : q2;
            const unsigned long long delay = (unsigned long long)(q0 + 32u * q1 + 1024u * q2) * 1600ull;
            while (__builtin_amdgcn_s_memrealtime() - tn < delay) __builtin_amdgcn_s_sleep(8);
        }
    }
}

extern "C" void kernel_launch(void* const* d_in, const int* in_sizes, int n_in, void* d_out, int out_size, void* d_ws, size_t ws_size, hipStream_t stream) {
    static int grid = 0;
    if (grid == 0) {
        if (n_in != 24 || in_sizes[0] != NLAT * D || out_size != NLAT * D || ws_size < WS_END) { fprintf(stderr, "kernel_launch: unexpected shapes n_in %d in0 %d out %d ws %zu (need %zu)\n", n_in, n_in > 0 ? in_sizes[0] : -1, out_size, ws_size, (size_t)WS_END); grid = -1; return; }
        int dev = 0, cus = 0;
        if (hipGetDevice(&dev) != hipSuccess || hipDeviceGetAttribute(&cus, hipDeviceAttributeMultiprocessorCount, dev) != hipSuccess) { grid = -1; return; }
        if (hipFuncSetAttribute((const void*)fwd, hipFuncAttributeMaxDynamicSharedMemorySize, LDS_BYTES) != hipSuccess) { fprintf(stderr, "kernel_launch: hipFuncSetAttribute failed\n"); grid = -1; return; }
        grid = cus;
    }
    if (grid < 0) return;
    (void)hipMemsetAsync((char*)d_ws + WS_CTL, 0, 1 * MiB, stream);
    Args a{};
    for (int i = 0; i < 24; ++i) a.in[i] = (const float*)d_in[i];
    a.out = (float*)d_out; a.ws = (unsigned char*)d_ws; a.ph_lo = 0; a.ph_hi = 0;
    unsigned char* ws = (unsigned char*)d_ws;
    const float* const* in = a.in;
    int* rt = (int*)(ws + WS_ROUTE);
    a.ph_lo = 0; a.ph_hi = NPHASE;
    hipLaunchKernelGGL(fwd, dim3(grid), dim3(NTHR), LDS_BYTES, stream, a);
}
```

```cpp
#include <hip/hip_runtime.h>
#include <cstdio>
#include <cstdint>

#define GAS __attribute__((address_space(1)))
#define LAS __attribute__((address_space(3)))
typedef unsigned short bf16;
typedef float f32x4 __attribute__((ext_vector_type(4)));
typedef unsigned u32x4 __attribute__((ext_vector_type(4)));
typedef unsigned u32x2 __attribute__((ext_vector_type(2)));

constexpr int D = 1024, BATCH = 2, SEQ = 8192, DEPTH = 2, CTX = 256, GRIDW = 64;
constexpr int NLAT = BATCH * SEQ, NCTX = BATCH * CTX, NTOK = NLAT + NCTX;
constexpr int INW = 4112, PW = 4096;
constexpr int PC_QK = 0, PC_V = 512, PC_O = 1024, PC_QI = 1536, PC_FF = 2560, PC_FB = 3072, PC_GO = 3584;
constexpr int NEXP = 32, TOPK = 4, DEXP = 1024;
constexpr int MAXSLOT = (NTOK * TOPK / 256 + NEXP) * 256;
constexpr int MAXTILE = MAXSLOT / 256;
constexpr float EPS = 1e-6f;

constexpr size_t MiB = 1u << 20;
constexpr size_t WS_CTL = 0;
constexpr size_t WS_MOD = 1 * MiB;
constexpr size_t WS_GATES = 2 * MiB;
constexpr size_t WS_ROUTE = 4 * MiB;
constexpr size_t WS_X = 8 * MiB;
constexpr size_t WS_H = 76 * MiB;
constexpr size_t WS_P = 112 * MiB;
constexpr size_t WS_CQK = 246 * MiB;
constexpr size_t WS_CQI = 264 * MiB;
constexpr size_t WS_HF = 300 * MiB;
constexpr size_t WS_HB = 368 * MiB;
constexpr size_t WS_Y = 436 * MiB;
constexpr size_t WS_ACT = 472 * MiB;
constexpr size_t WS_YS = 622 * MiB;
constexpr size_t WS_WIN = 772 * MiB;
constexpr size_t WS_WOUT = 788 * MiB;
constexpr size_t WS_WGU = 792 * MiB;
constexpr size_t WS_WDN = 1048 * MiB;
constexpr size_t WS_MLC = 1176 * MiB;
constexpr size_t WS_MLN = 1246 * MiB;
constexpr size_t WS_MLS = 1247 * MiB;
constexpr size_t WS_HGS = 1248 * MiB;
constexpr size_t WS_HGG = 1388 * MiB;
constexpr size_t WS_MLCB = 1390 * MiB;
constexpr size_t WS_HGSB = 1426 * MiB;
constexpr size_t WS_END = 1496 * MiB;
constexpr int NTC = 132;
constexpr int RT_TOPI = 0;
constexpr int RT_TOPG = RT_TOPI + NTOK * 4;
constexpr int RT_POS = RT_TOPG + NTOK * 4;
constexpr int RT_SLOT = RT_POS + NTOK * 4;
constexpr int RT_LIST = RT_SLOT + NTOK * 4;
constexpr int RT_SGATE = RT_LIST + MAXSLOT;
constexpr int RT_TILEE = RT_SGATE + MAXSLOT;
constexpr int RT_BLKCNT = RT_TILEE + MAXTILE + 8;
constexpr int MAXG = 1024;
constexpr int RT_END = RT_BLKCNT + MAXG * 32;
static_assert((size_t)RT_END * 4 <= 4 * MiB, "route map");
constexpr int CW_CNT = 1024;
constexpr int CW_BAR = 4096;

typedef float f32x2_t __attribute__((ext_vector_type(2)));
typedef __bf16 bf16x2_t __attribute__((ext_vector_type(2)));
__device__ __forceinline__ unsigned pk2(float lo, float hi) { const f32x2_t v = {lo, hi}; return __builtin_bit_cast(unsigned, __builtin_convertvector(v, bf16x2_t)); }
__device__ __forceinline__ unsigned f2bf(float f) { return pk2(f, 0.f) & 0xffffu; }
__device__ __forceinline__ float bf2f(unsigned short b) { return __builtin_bit_cast(float, (unsigned)b << 16); }
__device__ __forceinline__ float bflo(unsigned w) { return __builtin_bit_cast(float, w << 16); }
__device__ __forceinline__ float bfhi(unsigned w) { return __builtin_bit_cast(float, w & 0xffff0000u); }
__device__ __forceinline__ float sigmoidf_(float x) { return 1.f / (1.f + __expf(-x)); }
__device__ __forceinline__ float siluf_(float x) { return x / (1.f + __expf(-x)); }
__device__ __forceinline__ float logsigmoidf_(float x) { return x >= 0.f ? -log1pf(__expf(-x)) : x - log1pf(__expf(x)); }
template <int CTRL, int ROWMASK, bool BOUND0>
__device__ __forceinline__ float dppf(float old, float x) { return __builtin_bit_cast(float, __builtin_amdgcn_update_dpp(__builtin_bit_cast(int, old), __builtin_bit_cast(int, x), CTRL, ROWMASK, 0xf, BOUND0)); }
__device__ __forceinline__ float half_sum_hi(float x) {
    x += dppf<0xB1, 0xf, true>(0.f, x); x += dppf<0x4E, 0xf, true>(0.f, x); x += dppf<0x114, 0xf, true>(0.f, x); x += dppf<0x118, 0xf, true>(0.f, x);
    x += dppf<0x142, 0xa, true>(0.f, x); return x; }
__device__ __forceinline__ float wave_sum(float v) {
    v = half_sum_hi(v); v += dppf<0x143, 0xc, true>(0.f, v); return __builtin_bit_cast(float, __builtin_amdgcn_readlane(__builtin_bit_cast(int, v), 63)); }
__device__ __forceinline__ float wave_incl_sum(float v, int) {
    v += dppf<0x111, 0xf, true>(0.f, v); v += dppf<0x112, 0xf, true>(0.f, v); v += dppf<0x114, 0xf, true>(0.f, v); v += dppf<0x118, 0xf, true>(0.f, v);
    v += dppf<0x142, 0xa, true>(0.f, v); v += dppf<0x143, 0xc, true>(0.f, v); return v; }
__device__ __forceinline__ float wave_incl_max(float v, int) {
    const float NI = -INFINITY;
    v = fmaxf(v, dppf<0x111, 0xf, false>(NI, v)); v = fmaxf(v, dppf<0x112, 0xf, false>(NI, v)); v = fmaxf(v, dppf<0x114, 0xf, false>(NI, v)); v = fmaxf(v, dppf<0x118, 0xf, false>(NI, v));
    v = fmaxf(v, dppf<0x142, 0xa, false>(NI, v)); v = fmaxf(v, dppf<0x143, 0xc, false>(NI, v)); return v; }
__device__ __forceinline__ float wave_max(float v) { v = wave_incl_max(v, 0); return __builtin_bit_cast(float, __builtin_amdgcn_readlane(__builtin_bit_cast(int, v), 63)); }
__device__ __forceinline__ int mrow_of(int r) { return r < NLAT ? (r >> 13) : 2; }

struct Args { const float* in[24]; float* out; unsigned char* ws; int ph_lo, ph_hi; };
typedef const __attribute__((address_space(4))) Args CArgs;

enum { I_X = 0, I_C, I_CTX, I_CCTX, I_WADA, I_BADA, I_N1G, I_WIN, I_MLCONV, I_MLGB, I_MLNG, I_HGCONV, I_HGFB, I_HGLB, I_HGNG, I_WOUT, I_N2G, I_RW, I_RB, I_WGU, I_BGU, I_WDN, I_BDN, I_FG };

constexpr int NWAVES = 8, NTHR = 512;
constexpr int LDS_BYTES = 147456;

struct Frame {
    LAS unsigned char* lds;
    float* out; unsigned char* ws;
    int tid, lane, wave, vcu, G;
};

__device__ __forceinline__ void ph_init(Frame& F, CArgs& A) {
    const int gt = F.vcu * NTHR + F.tid, NG = F.G * NTHR;
    if (gt < 128) ((u32x4*)(F.ws + WS_H + (size_t)NTOK * D * 2))[gt] = (u32x4){0u, 0u, 0u, 0u};
    LAS float* sc = (LAS float*)F.lds;
    LAS float* part = sc + 3 * 1024;
    for (int i = F.tid; i < 3 * 1024; i += NTHR) { const int r = i >> 10, k = i & 1023; const float c = r < 2 ? A.in[I_C][r * 1024 + k] : A.in[I_CCTX][k]; sc[i] = siluf_(c); }
    __syncthreads();
    for (int item = F.vcu; item < DEPTH * 96; item += F.G) {
        const int l = item / 96, j = (item % 96) * 64 + F.lane;
        const float* w = A.in[I_WADA] + (size_t)l * D * 6144 + j;
        float a0 = 0.f, a1 = 0.f, a2 = 0.f;
        for (int k0 = F.wave * 128; k0 < F.wave * 128 + 128; k0 += 32) { float wv[32];
#pragma unroll
            for (int i = 0; i < 32; ++i) wv[i] = w[(size_t)(k0 + i) * 6144];
#pragma unroll
            for (int i = 0; i < 32; ++i) { a0 += sc[k0 + i] * wv[i]; a1 += sc[1024 + k0 + i] * wv[i]; a2 += sc[2048 + k0 + i] * wv[i]; } }
        part[(F.wave * 3 + 0) * 64 + F.lane] = a0; part[(F.wave * 3 + 1) * 64 + F.lane] = a1; part[(F.wave * 3 + 2) * 64 + F.lane] = a2;
        __syncthreads();
        if (F.tid < 192) { const int r = F.tid >> 6, ln = F.tid & 63; float s = 0.f;
#pragma unroll
            for (int w8 = 0; w8 < 8; ++w8) s += part[(w8 * 3 + r) * 64 + ln];
            const int jj = (item % 96) * 64 + ln;
            ((float*)(F.ws + WS_MOD))[(l * 3 + r) * 6144 + jj] = s + A.in[I_BADA][l * 6144 + jj]; }
        __syncthreads();
    }
}

typedef unsigned u32x2v __attribute__((ext_vector_type(2)));
__device__ __forceinline__ float xor32(float send, int lane) { const unsigned u = __builtin_bit_cast(unsigned, send); const u32x2v r = __builtin_amdgcn_permlane32_swap(u, u, false, false);
    return __builtin_bit_cast(float, (lane & 32) ? r.x : r.y); }
__device__ __forceinline__ float xor16(float send, int lane) { const unsigned u = __builtin_bit_cast(unsigned, send); const u32x2v r = __builtin_amdgcn_permlane16_swap(u, u, false, false);
    return __builtin_bit_cast(float, (lane & 16) ? r.x : r.y); }
__device__ __forceinline__ float xor8(float x) { return dppf<0x140, 0xf, true>(0.f, dppf<0x141, 0xf, true>(0.f, x)); }
__device__ __forceinline__ float xor4(float x) { return dppf<0x141, 0xf, true>(0.f, dppf<0x1B, 0xf, true>(0.f, x)); }
__device__ __forceinline__ float xor2(float x) { return dppf<0x4E, 0xf, true>(0.f, x); }
__device__ __forceinline__ float xor1(float x) { return dppf<0xB1, 0xf, true>(0.f, x); }
template <int NV> __device__ __forceinline__ float reduce_scatter(float (&v)[NV], int lane) {
    float a16[16];
    if constexpr (NV == 32) { const bool hi = lane & 32;
#pragma unroll
        for (int i = 0; i < 16; ++i) { const float keep = hi ? v[16 + i] : v[i], send = hi ? v[i] : v[16 + i]; a16[i] = keep + xor32(send, lane); } }
    else {
#pragma unroll
        for (int i = 0; i < 16; ++i) a16[i] = v[i] + xor1(v[i]); }
    float a8[8], a4[4], a2[2];
    { const bool hi = lane & 16;
#pragma unroll
      for (int i = 0; i < 8; ++i) { const float keep = hi ? a16[8 + i] : a16[i], send = hi ? a16[i] : a16[8 + i]; a8[i] = keep + xor16(send, lane); } }
    { const bool hi = lane & 8;
#pragma unroll
      for (int i = 0; i < 4; ++i) { const float keep = hi ? a8[4 + i] : a8[i], send = hi ? a8[i] : a8[4 + i]; a4[i] = keep + xor8(send); } }
    { const bool hi = lane & 4;
#pragma unroll
      for (int i = 0; i < 2; ++i) { const float keep = hi ? a4[2 + i] : a4[i], send = hi ? a4[i] : a4[2 + i]; a2[i] = keep + xor4(send); } }
    float r;
    { const bool hi = lane & 2; const float keep = hi ? a2[1] : a2[0], send = hi ? a2[0] : a2[1]; r = keep + xor2(send); }
    if constexpr (NV == 32) r += xor1(r); else r += xor32(r, lane);
    return r;
}
struct RowIn { f32x4 x[4]; u32x2 y[4][4]; };
template <int SRC>
__device__ __forceinline__ void row_load(Frame& F, CArgs& A, int r, const int (&slot)[4], RowIn& R) {
    const float* src = SRC == 1 ? (r < NLAT ? A.in[I_X] + (size_t)r * D : A.in[I_CTX] + (size_t)(r - NLAT) * D) : (const float*)(F.ws + WS_X) + (size_t)r * D;
    const f32x4* xr = (const f32x4*)src + F.lane;
#pragma unroll
    for (int j = 0; j < 4; ++j) R.x[j] = xr[64 * j];
    if (SRC == 2) {
#pragma unroll
        for (int k = 0; k < 4; ++k) { const u32x2* yp = (const u32x2*)(F.ws + WS_YS + (size_t)slot[k] * D * 2) + F.lane;
#pragma unroll
            for (int j = 0; j < 4; ++j) R.y[k][j] = yp[64 * j]; } }
}
template <int SRC, int MODE>
__device__ __forceinline__ void ph_rows(Frame& F, CArgs& A, int lsrc, int l, int nrows) {
    constexpr int NV = MODE == 0 ? 16 : 32;
    LAS float* wl = (LAS float*)F.lds;
    if (MODE == 0) { const float* w = A.in[I_WIN] + (size_t)l * D * INW + 1536;
        for (int k = F.tid; k < 1024; k += NTHR) { const f32x4* wp = (const f32x4*)(w + (size_t)k * INW);
#pragma unroll
            for (int q = 0; q < 4; ++q) { const f32x4 v4 = wp[q]; wl[(4 * q + 0) * 1024 + k] = v4.x; wl[(4 * q + 1) * 1024 + k] = v4.y; wl[(4 * q + 2) * 1024 + k] = v4.z; wl[(4 * q + 3) * 1024 + k] = v4.w; } } __syncthreads(); }
    LAS unsigned* lcnt = (LAS unsigned*)(F.lds + 131072);
    if (MODE == 1) { const float* w = A.in[I_RW] + (size_t)l * D * NEXP; if (F.tid < 32) lcnt[F.tid] = 0u;
        for (int k = F.tid; k < 1024; k += NTHR) { const f32x4* wp = (const f32x4*)(w + (size_t)k * NEXP);
#pragma unroll
            for (int q = 0; q < 8; ++q) { const f32x4 v4 = wp[q]; wl[(4 * q + 0) * 1024 + k] = v4.x; wl[(4 * q + 1) * 1024 + k] = v4.y; wl[(4 * q + 2) * 1024 + k] = v4.z; wl[(4 * q + 3) * 1024 + k] = v4.w; } } __syncthreads(); }
    const float* gam = MODE == 0 ? A.in[I_N1G] + l * D : (MODE == 1 ? A.in[I_N2G] + l * D : A.in[I_FG]);
    const float* MOD = (const float*)(F.ws + WS_MOD) + (size_t)l * 3 * 6144;
    const float* MODS = (const float*)(F.ws + WS_MOD) + (size_t)lsrc * 3 * 6144;
    const int* rt = (const int*)(F.ws + WS_ROUTE);
    const int stride = F.G * NWAVES; int r = F.vcu * NWAVES + F.wave;
    RowIn cur; int s1[4] = {0, 0, 0, 0}, s2[4] = {0, 0, 0, 0};
    if (SRC == 2) { if (r < nrows) { const u32x4 q = *(const u32x4*)(rt + RT_SLOT + r * 4); s1[0] = q.x; s1[1] = q.y; s1[2] = q.z; s1[3] = q.w; }
                    if (r + stride < nrows) { const u32x4 q = *(const u32x4*)(rt + RT_SLOT + (r + stride) * 4); s2[0] = q.x; s2[1] = q.y; s2[2] = q.z; s2[3] = q.w; } }
    if (r < nrows) row_load<SRC>(F, A, r, s1, cur);
    for (; r < nrows; r += stride) {
        RowIn nxt; int s3[4] = {0, 0, 0, 0};
        if (SRC == 2 && r + 2 * stride < nrows) { const u32x4 q = *(const u32x4*)(rt + RT_SLOT + (r + 2 * stride) * 4); s3[0] = q.x; s3[1] = q.y; s3[2] = q.z; s3[3] = q.w; }
        if (r + stride < nrows) row_load<SRC>(F, A, r + stride, s2, nxt);
        f32x4 v[4];
#pragma unroll
        for (int j = 0; j < 4; ++j) v[j] = cur.x[j];
        if (SRC == 2) { const float* g2 = MODS + mrow_of(r) * 6144 + 5 * 1024;
#pragma unroll
            for (int j = 0; j < 4; ++j) { f32x4 a = (f32x4){0.f, 0.f, 0.f, 0.f};
#pragma unroll
                for (int k = 0; k < 4; ++k) { const u32x2 w = cur.y[k][j]; a += (f32x4){bflo(w.x), bfhi(w.x), bflo(w.y), bfhi(w.y)}; }
                v[j] = v[j] + *(const f32x4*)(g2 + 256 * j + 4 * F.lane) * a; } }
        if (SRC == 2 && MODE != 2) { f32x4* xo = (f32x4*)((float*)(F.ws + WS_X) + (size_t)r * D) + F.lane;
#pragma unroll
            for (int j = 0; j < 4; ++j) xo[64 * j] = v[j]; }
        float ss = 0.f;
#pragma unroll
        for (int j = 0; j < 4; ++j) ss += (v[j].x * v[j].x + v[j].y * v[j].y) + (v[j].z * v[j].z + v[j].w * v[j].w);
        const float rstd = rsqrtf(wave_sum(ss) * (1.f / D) + EPS);
        const float* mod = MOD + mrow_of(r) * 6144 + (MODE == 0 ? 0 : 3072);
#pragma unroll
        for (int j = 0; j < 4; ++j) { const int c = 256 * j + 4 * F.lane; const f32x4 g = *(const f32x4*)(gam + c);
            v[j] = v[j] * rstd * g;
            if (MODE != 2) { const f32x4 sh = *(const f32x4*)(mod + c), scl = *(const f32x4*)(mod + 1024 + c); v[j] = v[j] * (1.f + scl) + sh; } }
        if (MODE == 2) { f32x4* o = (f32x4*)(F.out + (size_t)r * D) + F.lane;
#pragma unroll
            for (int j = 0; j < 4; ++j) o[64 * j] = v[j]; }
        else {
            u32x2* ho = (u32x2*)(F.ws + WS_H + (size_t)r * D * 2) + F.lane;
#pragma unroll
            for (int j = 0; j < 4; ++j) ho[64 * j] = (u32x2){pk2(v[j].x, v[j].y), pk2(v[j].z, v[j].w)};
            float part[NV];
#pragma unroll
            for (int g = 0; g < NV; ++g) { f32x2_t a2 = {0.f, 0.f};
#pragma unroll
                for (int j = 0; j < 4; ++j) { const f32x4 w = *(const LAS f32x4*)(wl + g * 1024 + 256 * j + 4 * F.lane);
                    a2 += (f32x2_t){v[j].x, v[j].y} * (f32x2_t){w.x, w.y}; a2 += (f32x2_t){v[j].z, v[j].w} * (f32x2_t){w.z, w.w}; }
                part[g] = a2.x + a2.y; }
            const float mine = reduce_scatter<NV>(part, F.lane);
            if (MODE == 0) {
                const int g = (F.lane >> 1) & 15;
                if ((F.lane & 33) == 0) { float val = mine + A.in[I_MLGB][l * 16 + g];
                    if (g >= 8) val = logsigmoidf_(val);
                    ((float*)(F.ws + WS_GATES))[(size_t)r * 16 + g] = val; }
            } else {
                const int g = (F.lane >> 1) & 31;
                float lv = (F.lane & 1) == 0 ? mine + A.in[I_RB][l * NEXP + g] : -INFINITY;
                float tv[4]; int ti[4];
#pragma unroll
                for (int p = 0; p < 4; ++p) { const float best = wave_max(lv);
                    const unsigned long long bal = __ballot(lv == best); const int bi = __ffsll((long long)bal) - 1;
                    tv[p] = best; ti[p] = bi >> 1; if (F.lane == bi) lv = -INFINITY; }
                const float e1 = __expf(tv[1] - tv[0]), e2 = __expf(tv[2] - tv[0]), e3 = __expf(tv[3] - tv[0]); const float inv = 1.f / (1.f + e1 + e2 + e3);
                if (F.lane == 0) {
                    int* rtw = (int*)(F.ws + WS_ROUTE);
                    const float gs[4] = {inv, e1 * inv, e2 * inv, e3 * inv};
#pragma unroll
                    for (int p = 0; p < 4; ++p) { rtw[RT_TOPI + r * 4 + p] = ti[p]; ((float*)rtw)[RT_TOPG + r * 4 + p] = gs[p]; rtw[RT_POS + r * 4 + p] = (int)__hip_atomic_fetch_add(lcnt + ti[p], 1u, __ATOMIC_RELAXED, __HIP_MEMORY_SCOPE_WORKGROUP); }
                }
            }
        }
        cur = nxt;
#pragma unroll
        for (int k = 0; k < 4; ++k) { s2[k] = s3[k]; }
    }
    if (MODE == 1) { __syncthreads(); if (F.tid < 32) ((int*)(F.ws + WS_ROUTE))[RT_BLKCNT + F.vcu * 32 + F.tid] = (int)lcnt[F.tid]; }
}

__device__ __forceinline__ void ph_lists(Frame& F, CArgs& A, int l, int nrows) {
    LAS int* off = (LAS int*)F.lds;
    LAS int* pre = (LAS int*)(F.lds + 1024);
    int* rt = (int*)(F.ws + WS_ROUTE);
    if (F.tid < 32) { int run = 0; for (int v = 0; v < F.G; ++v) { pre[v * 32 + F.tid] = run; run += rt[RT_BLKCNT + v * 32 + F.tid]; } off[64 + F.tid] = run; }
    __syncthreads();
    if (F.tid == 0) { int o = 0; for (int e = 0; e < NEXP; ++e) { off[e] = o; o += (off[64 + e] + 255) & ~255; } off[32] = o; }
    __syncthreads();
    const int gt = F.vcu * NTHR + F.tid, NG = F.G * NTHR;
    for (int i = gt; i < nrows * 4; i += NG) { const int r = i >> 2, e = rt[RT_TOPI + i], v = (r % (F.G * NWAVES)) / NWAVES, s = off[e] + pre[v * 32 + e] + rt[RT_POS + i];
        rt[RT_SLOT + i] = s; rt[RT_LIST + s] = r; ((float*)rt)[RT_SGATE + s] = ((const float*)rt)[RT_TOPG + i]; }
    const int total = off[32];
    for (int s = gt; s < total; s += NG) { int e = 0;
#pragma unroll 1
        for (int q = 1; q < NEXP; ++q) if (s >= off[q]) e = q;
        if (s - off[e] >= off[64 + e]) { rt[RT_LIST + s] = NTOK; ((float*)rt)[RT_SGATE + s] = 0.f; }
        if ((s & 255) == 0) rt[RT_TILEE + 8 + (s >> 8)] = e; }
    if (gt == 0) rt[RT_TILEE] = total >> 8;
}

__device__ __forceinline__ void ph_conv(Frame& F, CArgs& A, int l) {
    LAS float* cw = (LAS float*)F.lds;
    { const f32x4* wm = (const f32x4*)(A.in[I_MLCONV] + (size_t)l * 9 * 512); const f32x4* wh = (const f32x4*)(A.in[I_HGCONV] + (size_t)l * 9 * 1024);
      f32x4 vm[3], vh[5];
#pragma unroll
      for (int j = 0; j < 3; ++j) { const int i = F.tid + NTHR * j; vm[j] = i < 9 * 128 ? wm[i] : (f32x4){0.f, 0.f, 0.f, 0.f}; }
#pragma unroll
      for (int j = 0; j < 5; ++j) { const int i = F.tid + NTHR * j; vh[j] = i < 9 * 256 ? wh[i] : (f32x4){0.f, 0.f, 0.f, 0.f}; }
#pragma unroll
      for (int j = 0; j < 3; ++j) { const int i = F.tid + NTHR * j; if (i < 9 * 128) *(LAS f32x4*)(cw + (i / 128) * 1536 + (i % 128) * 4) = vm[j]; }
#pragma unroll
      for (int j = 0; j < 5; ++j) { const int i = F.tid + NTHR * j; if (i < 9 * 256) *(LAS f32x4*)(cw + (i / 256) * 1536 + 512 + (i % 256) * 4) = vh[j]; } }
    __syncthreads();
    const bf16* P = (const bf16*)(F.ws + WS_P);
    const int gt = F.vcu * NTHR + F.tid, NG = F.G * NTHR;
    constexpr int NLATQ = BATCH * 128 * 16, NQ = NLATQ + BATCH * 64;
    for (int it = gt; it < NQ * 192; it += NG) {
        const int qd = it / 192, cg = it % 192, c = cg * 8, pc = c < 512 ? PC_QK + c : PC_QI + (c - 512);
        int base, row, x0, nrow, ncol;
        if (qd < NLATQ) { const int b = qd >> 11, y = (qd >> 4) & 127, xq = qd & 15; base = b << 13; row = y; x0 = xq * 4; nrow = 128; ncol = 64; }
        else { const int q = qd - NLATQ, b = q >> 6; base = NLAT + (b << 8); row = 0; x0 = (q & 63) * 4; nrow = 1; ncol = 256; }
        const int r0 = base + row * ncol + x0;
        u32x4 tap[3][6];
#pragma unroll
        for (int dy = 0; dy < 3; ++dy)
#pragma unroll
            for (int j = 0; j < 6; ++j) { const int rr = row + dy - 1, cc = x0 + j - 1; const bool v = rr >= 0 && rr < nrow && cc >= 0 && cc < ncol;
                const u32x4 t = *(const u32x4*)(P + (size_t)(v ? base + rr * ncol + cc : r0) * PW + pc);
                tap[dy][j] = v ? t : (u32x4){0u, 0u, 0u, 0u}; }
        f32x2_t a2[4][4];
#pragma unroll
        for (int o = 0; o < 4; ++o)
#pragma unroll
            for (int i = 0; i < 4; ++i) a2[o][i] = (f32x2_t){0.f, 0.f};
#pragma unroll
        for (int dy = 0; dy < 3; ++dy)
#pragma unroll
            for (int dx = 0; dx < 3; ++dx) { const LAS float* w = cw + (dy * 3 + dx) * 1536 + c; const f32x4 w0 = *(const LAS f32x4*)w, w1 = *(const LAS f32x4*)(w + 4);
                const f32x2_t wa = {w0.x, w0.y}, wb = {w0.z, w0.w}, wc = {w1.x, w1.y}, wd = {w1.z, w1.w};
#pragma unroll
                for (int o = 0; o < 4; ++o) { const u32x4 pv = tap[dy][o + dx];
                    a2[o][0] += (f32x2_t){bflo(pv.x), bfhi(pv.x)} * wa; a2[o][1] += (f32x2_t){bflo(pv.y), bfhi(pv.y)} * wb;
                    a2[o][2] += (f32x2_t){bflo(pv.z), bfhi(pv.z)} * wc; a2[o][3] += (f32x2_t){bflo(pv.w), bfhi(pv.w)} * wd; } }
        float a[4][8];
#pragma unroll
        for (int o = 0; o < 4; ++o)
#pragma unroll
            for (int i = 0; i < 4; ++i) { a[o][2 * i] = a2[o][i].x; a[o][2 * i + 1] = a2[o][i].y; }
        const float sc = c < 256 ? 0.125f : 1.f;
#pragma unroll
        for (int o = 0; o < 4; ++o) {
#pragma unroll
            for (int i = 0; i < 8; ++i) a[o][i] = siluf_(a[o][i]) * sc;
            const u32x4 ov = (u32x4){pk2(a[o][0], a[o][1]), pk2(a[o][2], a[o][3]), pk2(a[o][4], a[o][5]), pk2(a[o][6], a[o][7])};
            if (c < 512) *(u32x4*)(F.ws + WS_CQK + ((size_t)(r0 + o) * 512 + c) * 2) = ov; else *(u32x4*)(F.ws + WS_CQI + ((size_t)(r0 + o) * 1024 + (c - 512)) * 2) = ov; }
    }
}

struct HnIn { f32x4 h[4]; u32x2 g[4]; };
__device__ __forceinline__ void hn_load(Frame& F, int r, HnIn& R) {
    const float* HF = (const float*)(F.ws + WS_HF); const bf16* P = (const bf16*)(F.ws + WS_P);
#pragma unroll
    for (int j = 0; j < 4; ++j) { const int c = 256 * j + 4 * F.lane; R.h[j] = *(const f32x4*)(HF + (size_t)r * D + c); R.g[j] = *(const u32x2*)(P + (size_t)r * PW + (c < 512 ? PC_O + c : PC_GO + (c - 512))); }
}
__device__ __forceinline__ void ph_hnorm(Frame& F, CArgs& A, int l, int nrows_lat_only) {
    const int nrows = nrows_lat_only ? NLAT : NTOK, stride = F.G * NWAVES;
    int r = F.vcu * NWAVES + F.wave; HnIn cur; if (r < nrows) hn_load(F, r, cur);
    for (; r < nrows; r += stride) {
        HnIn nxt; if (r + stride < nrows) hn_load(F, r + stride, nxt); else nxt = cur;
        u32x2* yo = (u32x2*)(F.ws + WS_Y + (size_t)r * D * 2) + F.lane;
#pragma unroll
        for (int j = 0; j < 4; ++j) {
            const int c = 256 * j + 4 * F.lane;
            f32x4 h = cur.h[j];
            float ss = (h.x * h.x + h.y * h.y) + (h.z * h.z + h.w * h.w);
#pragma unroll
            for (int o = 1; o < 32; o <<= 1) ss += __shfl_xor(ss, o);
            const float rstd = rsqrtf(ss * (1.f / 128.f) + EPS);
            const f32x4 g = c < 512 ? *(const f32x4*)(A.in[I_MLNG] + l * 512 + c) : *(const f32x4*)(A.in[I_HGNG] + l * 512 + (c - 512));
            const u32x2 gw = cur.g[j];
            float ga[4] = {bflo(gw.x), bfhi(gw.x), bflo(gw.y), bfhi(gw.y)};
#pragma unroll
            for (int i = 0; i < 4; ++i) ga[i] = c < 512 ? sigmoidf_(ga[i]) : siluf_(ga[i]);
            h = h * rstd * g;
            yo[64 * j] = (u32x2){pk2(h.x * ga[0], h.y * ga[1]), pk2(h.z * ga[2], h.w * ga[3])};
        }
        cur = nxt;
    }
}

namespace pg8 {
typedef short bf16x8 __attribute__((ext_vector_type(8)));
constexpr int BM = 256, BK = 64, HALF = 128, HTB = HALF * BK * 2, STAGE_BYTES = 8 * HTB, NXCD = 8, WGM = 8;
__device__ __forceinline__ int lds_byte(int r, int c) { const int st = (r >> 4) * 2 + (c >> 5), rr = r & 15, cc = c & 31, ob = rr * 64 + cc * 2; return st * 1024 + (ob ^ (((ob >> 9) & 1) << 5)); }
__device__ __forceinline__ void stage_rc(int b, int& R, int& C) { const int st = b / 1024, sb = b % 1024, swz = sb ^ (((sb >> 9) & 1) << 5); R = (st >> 1) * 16 + swz / 64; C = (st & 1) * 32 + (swz % 64) / 2; }
__device__ __forceinline__ int perm32(int rho) { const int n = rho >> 4, i = rho & 15; return 8 * (i >> 2) + 4 * n + (i & 3); }
struct Unit { int pm, pn, e; };
struct Gemm { const bf16* A; const bf16* Bt; int K; const int* gather; const int* tile_e; size_t bexp;   };
struct StaticOrder {
    int nM, nN, nwg, G, c;
    __device__ void init(int nM_, int nN_, int G_, int c_) { nM = nM_; nN = nN_; nwg = nM * nN; G = G_; c = c_; }
    __device__ bool next(int i, Unit& u) const {
        const long L = (long)i * G + c; if (L >= nwg) return false;
        int wgid = (int)L; { const int q = nwg / NXCD, r = nwg % NXCD, xcd = wgid % NXCD, off = wgid / NXCD; wgid = (xcd < r ? xcd * (q + 1) : r * (q + 1) + (xcd - r) * q) + off; }
        const int nig = WGM * nN, gid = wgid / nig, fm = gid * WGM, gsz = (nM - fm) < WGM ? (nM - fm) : WGM;
        u.pm = fm + ((wgid % nig) % gsz); u.pn = (wgid % nig) / gsz; u.e = 0; return true;
    }
};
__device__ __forceinline__ unsigned cvt_pk_bf16(float lo, float hi) { unsigned r; asm volatile("v_cvt_pk_bf16_f32 %0, %1, %2" : "=v"(r) : "v"(lo), "v"(hi)); return r; }

struct EpiBf16 {
    static constexpr bool PERM = true;
    __device__ __forceinline__ void prefetch(const Unit&, LAS unsigned char*, int, int, int) const {}
    bf16* O; int ldc;
    __device__ __forceinline__ void operator()(const f32x4 (&acc)[2][2][4][2], const Unit& u, int wr, int wc, int fr, int fq, const LAS unsigned char*, int) const {
        const int row0 = u.pm * BM + wr * 64 + fr, col0 = u.pn * BM + wc * 32 + 8 * fq;
#pragma unroll
        for (int ai = 0; ai < 2; ++ai)
#pragma unroll
            for (int m = 0; m < 4; ++m) { bf16* rowp = O + (size_t)(row0 + ai * HALF + m * 16) * ldc + col0;
#pragma unroll
                for (int bj = 0; bj < 2; ++bj) { const f32x4 v0 = acc[ai][bj][m][0], v1 = acc[ai][bj][m][1];
                    u32x4 w; w.x = cvt_pk_bf16(v0[0], v0[1]); w.y = cvt_pk_bf16(v0[2], v0[3]); w.z = cvt_pk_bf16(v1[0], v1[1]); w.w = cvt_pk_bf16(v1[2], v1[3]);
                    *(u32x4*)(rowp + bj * HALF) = w; } }
    }
};
struct EpiResid {
    static constexpr bool PERM = false;
    __device__ __forceinline__ void prefetch(const Unit&, LAS unsigned char*, int, int, int) const {}
    float* X; const float* MODg; const float* Slat; const float* Sctx;
    __device__ __forceinline__ void operator()(const f32x4 (&acc)[2][2][4][2], const Unit& u, int wr, int wc, int fr, int fq, const LAS unsigned char*, int) const {
        const int row0 = u.pm * BM + wr * 64 + fr, col0 = u.pn * BM + wc * 32 + 4 * fq;
        const float* gp = MODg + mrow_of(u.pm * BM) * 6144 + col0;
        f32x4 gv[2][2];
#pragma unroll
        for (int bj = 0; bj < 2; ++bj)
#pragma unroll
            for (int n = 0; n < 2; ++n) gv[bj][n] = *(const f32x4*)(gp + bj * HALF + n * 16);
#pragma unroll
        for (int ai = 0; ai < 2; ++ai) {
            f32x4 xv[4][2][2];
#pragma unroll
            for (int m = 0; m < 4; ++m) { const int rr = row0 + ai * HALF + m * 16; const float* rowp = (rr < NLAT ? Slat + (size_t)rr * D : Sctx + (size_t)(rr - NLAT) * D) + col0;
#pragma unroll
                for (int bj = 0; bj < 2; ++bj)
#pragma unroll
                    for (int n = 0; n < 2; ++n) xv[m][bj][n] = *(const f32x4*)(rowp + bj * HALF + n * 16); }
#pragma unroll
            for (int m = 0; m < 4; ++m) { float* rowp = X + (size_t)(row0 + ai * HALF + m * 16) * D + col0;
#pragma unroll
                for (int bj = 0; bj < 2; ++bj)
#pragma unroll
                    for (int n = 0; n < 2; ++n) *(f32x4*)(rowp + bj * HALF + n * 16) = xv[m][bj][n] + gv[bj][n] * acc[ai][bj][m][n]; } }
    }
};
struct EpiSwiglu {
    static constexpr bool PERM = true;
    bf16* ACT; const float* bgu; const int* tile_e;
    __device__ __forceinline__ void prefetch(const Unit& u, LAS unsigned char* lds, int wid, int lane, int par) const {
        if (wid == 0) { const float* src = bgu + (size_t)u.e * 2048 + u.pn * HALF + (lane < 32 ? lane * 4 : 1024 + (lane - 32) * 4);
            __builtin_amdgcn_global_load_lds((const unsigned*)src, (LAS unsigned*)(lds + 131072 + par * 2048), 16, 0, 0); }
    }
    __device__ __forceinline__ void operator()(const f32x4 (&acc)[2][2][4][2], const Unit& u, int wr, int wc, int fr, int fq, const LAS unsigned char* lds, int par) const {
        const int row0 = u.pm * BM + wr * 64 + fr, col0 = u.pn * HALF + wc * 32 + 8 * fq;
        const LAS float* bp = (const LAS float*)(lds + 131072 + par * 2048) + wc * 32 + 8 * fq;
        const f32x4 bg0 = *(const LAS f32x4*)bp, bg1 = *(const LAS f32x4*)(bp + 4), bl0 = *(const LAS f32x4*)(bp + 128), bl1 = *(const LAS f32x4*)(bp + 132);
#pragma unroll
        for (int ai = 0; ai < 2; ++ai)
#pragma unroll
            for (int m = 0; m < 4; ++m) {
                f32x4 g0 = acc[ai][0][m][0] + bg0, g1 = acc[ai][0][m][1] + bg1, l0 = acc[ai][1][m][0] + bl0, l1 = acc[ai][1][m][1] + bl1; float o[8];
#pragma unroll
                for (int i = 0; i < 4; ++i) { g0[i] = fminf(g0[i], 7.f); g1[i] = fminf(g1[i], 7.f); l0[i] = fminf(fmaxf(l0[i], -7.f), 7.f); l1[i] = fminf(fmaxf(l1[i], -7.f), 7.f); }
                const f32x4 t0 = g0 * (-1.702f * 1.44269504f), t1 = g1 * (-1.702f * 1.44269504f);
                f32x4 e0, e1;
#pragma unroll
                for (int i = 0; i < 4; ++i) { e0[i] = __builtin_amdgcn_exp2f(t0[i]); e1[i] = __builtin_amdgcn_exp2f(t1[i]); }
                e0 = e0 + 1.f; e1 = e1 + 1.f;
#pragma unroll
                for (int i = 0; i < 4; ++i) { e0[i] = __builtin_amdgcn_rcpf(e0[i]); e1[i] = __builtin_amdgcn_rcpf(e1[i]); }
                const f32x4 r0 = (g0 * e0) * (l0 + 1.f), r1 = (g1 * e1) * (l1 + 1.f);
#pragma unroll
                for (int i = 0; i < 4; ++i) { o[i] = r0[i]; o[4 + i] = r1[i]; }
                u32x4 w; w.x = cvt_pk_bf16(o[0], o[1]); w.y = cvt_pk_bf16(o[2], o[3]); w.z = cvt_pk_bf16(o[4], o[5]); w.w = cvt_pk_bf16(o[6], o[7]);
                *(u32x4*)(ACT + (size_t)(row0 + ai * HALF + m * 16) * DEXP + col0) = w; }
    }
};
struct EpiDown {
    static constexpr bool PERM = true;
    bf16* YS; const float* bdn; const float* sgate; const int* tile_e;
    __device__ __forceinline__ void prefetch(const Unit& u, LAS unsigned char* lds, int wid, int lane, int par) const {
        if (wid == 0) { __builtin_amdgcn_global_load_lds((const unsigned*)(bdn + (size_t)u.e * D + u.pn * BM + lane * 4), (LAS unsigned*)(lds + 131072 + par * 2048), 16, 0, 0);
                        __builtin_amdgcn_global_load_lds((const unsigned*)(sgate + u.pm * BM + lane * 4), (LAS unsigned*)(lds + 131072 + par * 2048 + 1024), 16, 0, 0); }
    }
    __device__ __forceinline__ void operator()(const f32x4 (&acc)[2][2][4][2], const Unit& u, int wr, int wc, int fr, int fq, const LAS unsigned char* lds, int par) const {
        asm volatile("" : "+v"(fr), "+v"(fq));
        const int row0 = u.pm * BM + wr * 64 + fr, col0 = u.pn * BM + wc * 32 + 8 * fq;
        const LAS float* bl = (const LAS float*)(lds + 131072 + par * 2048); const LAS float* sl = bl + 256 + wr * 64 + fr;
        f32x4 bv[2][2];
#pragma unroll
        for (int bj = 0; bj < 2; ++bj)
#pragma unroll
            for (int n = 0; n < 2; ++n) bv[bj][n] = *(const LAS f32x4*)(bl + bj * HALF + wc * 32 + 8 * fq + 4 * n);
#pragma unroll
        for (int ai = 0; ai < 2; ++ai)
#pragma unroll
            for (int m = 0; m < 4; ++m) { const int row = row0 + ai * HALF + m * 16; const float sg = sl[ai * HALF + m * 16]; bf16* rowp = YS + (size_t)row * D + col0;
#pragma unroll
                for (int bj = 0; bj < 2; ++bj) { const f32x4 v0 = (acc[ai][bj][m][0] + bv[bj][0]) * sg, v1 = (acc[ai][bj][m][1] + bv[bj][1]) * sg;
                    u32x4 w; w.x = cvt_pk_bf16(v0[0], v0[1]); w.y = cvt_pk_bf16(v0[2], v0[3]); w.z = cvt_pk_bf16(v1[0], v1[1]); w.w = cvt_pk_bf16(v1[2], v1[3]);
                    *(u32x4*)(rowp + bj * HALF) = w; } }
    }
};

template <class Epi, class Sched, bool ALIGN_EPI>
__device__ __forceinline__ void gemm_phase(LAS unsigned char* lds, const Gemm g, const Sched& S, const Epi& E, const int tid) {
    const int wid = __builtin_amdgcn_readfirstlane(tid >> 6), lane = tid & 63, wr = wid >> 2, wc = wid & 3, fr = lane & 15, fq = lane >> 4;
    const int K = g.K, nt = K / BK;
    int RA[2]; unsigned cbA[2], voffB[2];
#pragma unroll
    for (int i = 0; i < 2; ++i) { int R, C; stage_rc(tid * 16 + i * 8192, R, C); const int Rb = Epi::PERM ? ((R & ~31) + perm32(R & 31)) : R;
        RA[i] = R; cbA[i] = (unsigned)C * 2u; voffB[i] = (unsigned)(Rb * K + C) * 2u; }
    const size_t kstep = (size_t)(BK * 2);
    const size_t hstep = (size_t)HALF * K * 2;
    const size_t tstep = 2 * hstep;
    const unsigned ldsw = (unsigned)wid * 1024u;
    const int aoff = lds_byte(wr * 64 + fr, fq * 8), boff = lds_byte(wc * 32 + fr, fq * 8);
#define PG8_SA(b, h) (((b) * 2 + (h)) * HTB)
#define PG8_SB(b, h) ((4 + (b) * 2 + (h)) * HTB)
#define PG8_STAGE(bufoff, gbase, voff) do { _Pragma("unroll") for (int _i = 0; _i < 2; ++_i) \
        __builtin_amdgcn_global_load_lds((const unsigned*)((const char*)(gbase) + (voff)[_i]), (LAS unsigned*)(lds + (bufoff) + ldsw + _i * 8192), 16, 0, 0); } while (0)
#define PG8_LDA(dst, b, h) do { _Pragma("unroll") for (int m = 0; m < 4; ++m) _Pragma("unroll") for (int k = 0; k < 2; ++k) dst[m][k] = *(const LAS bf16x8*)(lds + PG8_SA(b, h) + aoff + m * 2048 + k * 1024); } while (0)
#define PG8_LDB(dst, b, h) do { _Pragma("unroll") for (int n = 0; n < 2; ++n) _Pragma("unroll") for (int k = 0; k < 2; ++k) dst[n][k] = *(const LAS bf16x8*)(lds + PG8_SB(b, h) + boff + n * 2048 + k * 1024); } while (0)
#define PG8_MMA(ai, bj, At, Bt) do { __builtin_amdgcn_s_setprio(1); _Pragma("unroll") for (int m = 0; m < 4; ++m) _Pragma("unroll") for (int n = 0; n < 2; ++n) _Pragma("unroll") for (int k = 0; k < 2; ++k) \
        acc[ai][bj][m][n] = __builtin_amdgcn_mfma_f32_16x16x32_bf16(Bt[n][k], At[m][k], acc[ai][bj][m][n], 0, 0, 0); __builtin_amdgcn_s_setprio(0); } while (0)
#define PG8_WAIT_V(n) asm volatile("s_waitcnt vmcnt(" #n ")" ::: "memory")
#define PG8_WAIT_L(n) asm volatile("s_waitcnt lgkmcnt(" #n ")" ::: "memory")
#define PG8_BAR __builtin_amdgcn_s_barrier()
#define PG8_SCHED __builtin_amdgcn_sched_barrier(0)
#define PG8_AOFF(va, u) do { _Pragma("unroll") for (int _h = 0; _h < 2; ++_h) _Pragma("unroll") for (int _i = 0; _i < 2; ++_i) { const int _r = (u).pm * BM + _h * HALF + RA[_i]; \
        const int _row = g.gather ? g.gather[_r] : _r; va[_h][_i] = (unsigned)_row * (unsigned)(K * 2) + cbA[_i]; } } while (0)
#define PG8_BBASE(u) ((u).e = g.tile_e ? g.tile_e[8 + (u).pm] : 0, (const char*)g.Bt + (size_t)(u).e * g.bexp * 2 + (size_t)(u).pn * tstep)
    Unit cur, nxt; int ui = 0;
    if (!S.next(0, cur)) return;
    f32x4 acc[2][2][4][2];
#pragma unroll
    for (int a = 0; a < 2; ++a)
#pragma unroll
        for (int b = 0; b < 2; ++b)
#pragma unroll
            for (int m = 0; m < 4; ++m)
#pragma unroll
                for (int n = 0; n < 2; ++n) acc[a][b][m][n] = (f32x4){0.f, 0.f, 0.f, 0.f};
    bf16x8 At[4][2], B0[2][2], B1[2][2];
    const char* Ab = (const char*)g.A;
    unsigned cva[2][2], nva[2][2];
    PG8_AOFF(cva, cur);
    const char* cB = PG8_BBASE(cur);
    E.prefetch(cur, lds, wid, lane, 0);
    PG8_STAGE(PG8_SB(0, 0), cB, voffB); PG8_STAGE(PG8_SB(0, 1), cB + hstep, voffB); PG8_STAGE(PG8_SA(0, 0), Ab, cva[0]); PG8_STAGE(PG8_SA(0, 1), Ab, cva[1]);
    if (wr == 1) PG8_BAR;
    PG8_WAIT_V(2); PG8_BAR;
    PG8_STAGE(PG8_SB(1, 0), cB + kstep, voffB); PG8_STAGE(PG8_SA(1, 0), Ab + kstep, cva[0]); PG8_STAGE(PG8_SB(1, 1), cB + hstep + kstep, voffB);
    PG8_WAIT_V(6); PG8_BAR;
    for (;;) {
        const bool has_next = S.next(ui + 1, nxt);
        const char* nB = cB;
        if (has_next) { PG8_AOFF(nva, nxt); nB = PG8_BBASE(nxt); }
        else {
#pragma unroll
            for (int h = 0; h < 2; ++h)
#pragma unroll
                for (int i = 0; i < 2; ++i) nva[h][i] = cva[h][i]; }
        for (int t = 0; t < nt; t += 2) {
            const bool last = (t == nt - 2);
            const char* a1 = Ab + (size_t)(t + 1) * kstep;
            const char* a2 = last ? Ab : Ab + (size_t)(t + 2) * kstep; const char* b2 = last ? nB : cB + (size_t)(t + 2) * kstep;
            const char* a3 = a2 + kstep; const char* b3 = b2 + kstep;
            PG8_LDB(B0, 0, 0); PG8_LDB(B1, 0, 1); PG8_SCHED; PG8_LDA(At, 0, 0); PG8_STAGE(PG8_SA(1, 1), a1, cva[1]);
            PG8_WAIT_V(8); PG8_WAIT_L(0); PG8_BAR; PG8_MMA(0, 0, At, B0); PG8_MMA(0, 1, At, B1); PG8_BAR; PG8_SCHED;
            PG8_LDA(At, 0, 1); PG8_STAGE(PG8_SB(0, 0), b2, voffB); PG8_STAGE(PG8_SB(0, 1), b2 + hstep, voffB); { const unsigned sv_[2] = {last ? nva[0][0] : cva[0][0], last ? nva[0][1] : cva[0][1]}; PG8_STAGE(PG8_SA(0, 0), a2, sv_); }
            PG8_WAIT_V(8); PG8_WAIT_L(0); PG8_BAR; PG8_MMA(1, 0, At, B0); PG8_MMA(1, 1, At, B1); PG8_BAR; PG8_SCHED;
            PG8_LDB(B0, 1, 0); PG8_LDB(B1, 1, 1); PG8_SCHED; PG8_LDA(At, 1, 0); { const unsigned sv_[2] = {last ? nva[1][0] : cva[1][0], last ? nva[1][1] : cva[1][1]}; PG8_STAGE(PG8_SA(0, 1), a2, sv_); }
            PG8_WAIT_V(8); PG8_WAIT_L(0); PG8_BAR; PG8_MMA(0, 0, At, B0); PG8_MMA(0, 1, At, B1); PG8_BAR; PG8_SCHED;
            PG8_LDA(At, 1, 1); PG8_STAGE(PG8_SB(1, 0), b3, voffB); PG8_STAGE(PG8_SB(1, 1), b3 + hstep, voffB); { const unsigned sv_[2] = {last ? nva[0][0] : cva[0][0], last ? nva[0][1] : cva[0][1]}; PG8_STAGE(PG8_SA(1, 0), a3, sv_); }
            PG8_WAIT_V(8); PG8_WAIT_L(0); PG8_BAR; PG8_MMA(1, 0, At, B0); PG8_MMA(1, 1, At, B1); PG8_BAR; PG8_SCHED;
        }
        if constexpr (ALIGN_EPI) { if (wr == 0) PG8_BAR; }
        E(acc, cur, wr, wc, fr, fq, lds, ui & 1);
        if (!has_next) break;
#pragma unroll
        for (int a = 0; a < 2; ++a)
#pragma unroll
            for (int b = 0; b < 2; ++b)
#pragma unroll
                for (int m = 0; m < 4; ++m)
#pragma unroll
                    for (int n = 0; n < 2; ++n) acc[a][b][m][n] = (f32x4){0.f, 0.f, 0.f, 0.f};
        cur = nxt; cB = nB; ++ui;
        E.prefetch(cur, lds, wid, lane, ui & 1);
#pragma unroll
        for (int h = 0; h < 2; ++h)
#pragma unroll
            for (int i = 0; i < 2; ++i) cva[h][i] = nva[h][i];
        if constexpr (ALIGN_EPI) { if (wr == 1) PG8_BAR; }
    }
    PG8_WAIT_V(0);
    if constexpr (!ALIGN_EPI) { if (wr == 0) PG8_BAR; }
    PG8_BAR;
#undef PG8_SA
#undef PG8_SB
#undef PG8_STAGE
#undef PG8_LDA
#undef PG8_LDB
#undef PG8_MMA
#undef PG8_WAIT_V
#undef PG8_WAIT_L
#undef PG8_BAR
#undef PG8_SCHED
#undef PG8_AOFF
#undef PG8_BBASE
}
}


#define LDS_BARRIER() do { asm volatile("s_waitcnt lgkmcnt(0)" ::: "memory"); __builtin_amdgcn_s_barrier(); asm volatile("" ::: "memory"); } while (0)
typedef short bf16x8_t __attribute__((ext_vector_type(8)));
typedef float f32x16 __attribute__((ext_vector_type(16)));
template <int K>
__device__ __forceinline__ void mm32(f32x16& acc, const LAS unsigned char* A, int sa, const LAS unsigned char* B, int sb, int lane) {
    const LAS unsigned char* ap = A + (lane & 31) * sa + (lane >> 5) * 16;
    const LAS unsigned char* bp = B + (lane & 31) * sb + (lane >> 5) * 16;
#pragma unroll
    for (int k0 = 0; k0 < K / 16; k0 += 4) {
        bf16x8_t a[4], b[4];
#pragma unroll
        for (int k = 0; k < 4; ++k) { a[k] = *(const LAS bf16x8_t*)(ap + (k0 + k) * 32); b[k] = *(const LAS bf16x8_t*)(bp + (k0 + k) * 32); }
#pragma unroll
        for (int k = 0; k < 4; ++k) acc = __builtin_amdgcn_mfma_f32_32x32x16_bf16(a[k], b[k], acc, 0, 0, 0);
    }
}
__device__ __forceinline__ int rowmap(int reg, int hi) { return (reg & 3) + 8 * (reg >> 2) + 4 * hi; }
__device__ __forceinline__ int chunk_row0(int b, int tc) { return tc < 4 ? NLAT + b * CTX + tc * 64 : b * SEQ + (tc - 4) * 64; }
constexpr int ST64 = 144, ST128 = 272;


__device__ __forceinline__ void touch(unsigned& x) { asm volatile("" : "+v"(x)); }
__device__ __forceinline__ void touch(float& x) { asm volatile("" : "+v"(x)); }
__device__ __forceinline__ void touch(u32x4& x) { asm volatile("" : "+v"(x)); }
struct VtRaw { unsigned w[8]; };
__device__ __forceinline__ void vt_load(VtRaw& R, const bf16* src, int pitch, int row0, int col0, int tid) {
    const int cp = tid & 63, tg = tid >> 6;
#pragma unroll
    for (int i = 0; i < 8; ++i) R.w[i] = *(const unsigned*)(src + (size_t)(row0 + tg * 8 + i) * pitch + col0 + 2 * cp);
}
__device__ __forceinline__ void vt_store(LAS unsigned char* VT, const VtRaw& R, int tid) {
    const int cp = tid & 63, tg = tid >> 6; unsigned lo[4], hi[4];
#pragma unroll
    for (int i = 0; i < 4; ++i) { const unsigned w0 = R.w[2 * i], w1 = R.w[2 * i + 1]; lo[i] = (w0 & 0xffffu) | (w1 << 16); hi[i] = (w0 >> 16) | (w1 & 0xffff0000u); }
    *(LAS u32x4*)(VT + (2 * cp) * ST64 + tg * 16) = (u32x4){lo[0], lo[1], lo[2], lo[3]};
    *(LAS u32x4*)(VT + (2 * cp + 1) * ST64 + tg * 16) = (u32x4){hi[0], hi[1], hi[2], hi[3]};
}
struct TaskId { int b, h, tc, row0, sidf; };
__device__ __forceinline__ TaskId task_id(int task) { TaskId t; t.b = task / (4 * NTC); t.h = (task / NTC) & 3; t.tc = task % NTC; t.row0 = chunk_row0(t.b, t.tc); t.sidf = (t.b * 4 + t.h) * 2; return t; }

struct MlARaw { VtRaw v; unsigned kw[4]; float g[4]; };
__device__ __forceinline__ void touch(MlARaw& R) {
#pragma unroll
    for (int i = 0; i < 8; ++i) touch(R.v.w[i]);
#pragma unroll
    for (int i = 0; i < 4; ++i) { touch(R.kw[i]); touch(R.g[i]); } }
__device__ __forceinline__ void ml_passA_load(Frame& F, int task, MlARaw& R) {
    const TaskId T = task_id(task);
    vt_load(R.v, (const bf16*)(F.ws + WS_P), PW, T.row0, PC_V + T.h * 128, F.tid);
    { const int cp = F.tid & 31, tg = F.tid >> 5; const bf16* CQK = (const bf16*)(F.ws + WS_CQK);
#pragma unroll
      for (int i = 0; i < 4; ++i) R.kw[i] = *(const unsigned*)(CQK + (size_t)(T.row0 + tg * 4 + i) * 512 + 256 + T.h * 64 + 2 * cp); }
    if (F.wave == 0) { const float* gp = (const float*)(F.ws + WS_GATES) + (size_t)(T.row0 + F.lane) * 16; R.g[0] = gp[T.h]; R.g[1] = gp[4 + T.h]; R.g[2] = gp[8 + T.h]; R.g[3] = gp[12 + T.h]; }
}
__device__ __forceinline__ void ml_passA_run(Frame& F, int task, const MlARaw& R) {
    const TaskId T = task_id(task); const int tc = T.tc, sidf = T.sidf;
    LAS unsigned char* VT = F.lds; LAS unsigned char* KT = F.lds + 18432;
    LAS float* wts = (LAS float*)(F.lds + 36864);
    float* MLS = (float*)(F.ws + WS_MLS);
    LDS_BARRIER();
    if (F.wave == 0) { const int s = F.lane;
        const float igf = R.g[0], igb = R.g[1], lff = R.g[2], lfb = R.g[3];
        const float pf = wave_incl_sum(lff, s), gf = __builtin_bit_cast(float, __builtin_amdgcn_readlane(__builtin_bit_cast(int, pf), 63)), ef = (gf - pf) + igf, mf = wave_max(ef);
        const float pb = wave_incl_sum(lfb, s), gb = __builtin_bit_cast(float, __builtin_amdgcn_readlane(__builtin_bit_cast(int, pb), 63)), eb = (pb - lfb) + igb, mb = wave_max(eb);
        wts[s] = __expf(ef - mf); wts[64 + s] = __expf(eb - mb);
        if (s == 0) { float* o = MLS + (size_t)(sidf * NTC + tc) * 4; o[0] = gf; o[1] = mf; o = MLS + (size_t)((sidf + 1) * NTC + tc) * 4; o[0] = gb; o[1] = mb; } }
    vt_store(VT, R.v, F.tid);
    LDS_BARRIER();
    { const int cp = F.tid & 31, tg = F.tid >> 5;
#pragma unroll
      for (int dir = 0; dir < 2; ++dir) { float lo[4], hi[4];
#pragma unroll
          for (int i = 0; i < 4; ++i) { const float w = wts[dir * 64 + tg * 4 + i]; lo[i] = bflo(R.kw[i]) * w; hi[i] = bfhi(R.kw[i]) * w; }
          *(LAS u32x2*)(KT + dir * 9216 + (2 * cp) * ST64 + tg * 8) = (u32x2){pk2(lo[0], lo[1]), pk2(lo[2], lo[3])};
          *(LAS u32x2*)(KT + dir * 9216 + (2 * cp + 1) * ST64 + tg * 8) = (u32x2){pk2(hi[0], hi[1]), pk2(hi[2], hi[3])}; } }
    LDS_BARRIER();
    { const int dir = F.wave >> 2, mt = F.wave & 3; bf16* C = (bf16*)(F.ws + WS_MLC) + (size_t)((sidf + dir) * NTC + tc) * 8192;
#pragma unroll
      for (int nt = 0; nt < 2; ++nt) { f32x16 acc;
#pragma unroll
          for (int i = 0; i < 16; ++i) acc[i] = 0.f;
          mm32<64>(acc, VT + 32 * mt * ST64, ST64, KT + dir * 9216 + 32 * nt * ST64, ST64, F.lane);
#pragma unroll
          for (int r = 0; r < 16; ++r) C[(32 * mt + rowmap(r, F.lane >> 5)) * 64 + 32 * nt + (F.lane & 31)] = (bf16)f2bf(acc[r]); } }
    if (F.tid < 128) { const int dir = F.tid >> 6, d = F.tid & 63; const LAS unsigned char* rp = KT + dir * 9216 + d * ST64; float sum = 0.f;
#pragma unroll
        for (int i = 0; i < 8; ++i) { const u32x4 w = *(const LAS u32x4*)(rp + i * 16); sum += (bflo(w.x) + bfhi(w.x)) + (bflo(w.y) + bfhi(w.y)) + (bflo(w.z) + bfhi(w.z)) + (bflo(w.w) + bfhi(w.w)); }
        ((float*)(F.ws + WS_MLN))[(size_t)((sidf + dir) * NTC + tc) * 64 + d] = sum; }
}
__device__ __forceinline__ int tc_seq(int dir, int j) { return dir == 0 ? j : (j < 4 ? 3 - j : 135 - j); }
__device__ __forceinline__ void scan_passB(Frame& F) {
    const float* GG = (const float*)(F.ws + WS_HGG); float* MLS = (float*)(F.ws + WS_MLS);
    const int t = F.tid;
    if (t < 128) {
        for (int item = F.vcu * 128 + t; item < 16 * 2048; item += F.G * 128) {
            const int scan = item >> 11, e = (item & 2047) * 8, dir = scan & 1, d = e & 127;
            const u32x4* base = (const u32x4*)((const bf16*)(F.ws + WS_HGS) + (size_t)scan * NTC * 16384 + e); u32x4* ob = (u32x4*)((bf16*)(F.ws + WS_HGSB) + (size_t)scan * NTC * 16384 + e);
            const f32x4* gb = (const f32x4*)(GG + (size_t)scan * NTC * 128 + d);
            float st[8];
#pragma unroll
            for (int k = 0; k < 8; ++k) st[k] = 0.f;
            for (int j0 = 0; j0 < NTC; j0 += 11) {
                u32x4 dv[11]; f32x4 g0[11], g1[11];
#pragma unroll
                for (int i = 0; i < 11; ++i) { const int tc = tc_seq(dir, j0 + i); dv[i] = base[(size_t)tc * 2048]; g0[i] = gb[tc * 32]; g1[i] = gb[tc * 32 + 1]; }
#pragma unroll
                for (int i = 0; i < 11; ++i) { const int tc = tc_seq(dir, j0 + i);
                    ob[(size_t)tc * 2048] = (u32x4){pk2(st[0], st[1]), pk2(st[2], st[3]), pk2(st[4], st[5]), pk2(st[6], st[7])};
                    const f32x4 ta = g0[i] * 1.44269504f, tb = g1[i] * 1.44269504f;
                    const f32x2_t e0 = {__builtin_amdgcn_exp2f(ta.x), __builtin_amdgcn_exp2f(ta.y)}, e1 = {__builtin_amdgcn_exp2f(ta.z), __builtin_amdgcn_exp2f(ta.w)}, e2 = {__builtin_amdgcn_exp2f(tb.x), __builtin_amdgcn_exp2f(tb.y)}, e3 = {__builtin_amdgcn_exp2f(tb.z), __builtin_amdgcn_exp2f(tb.w)};
                    const f32x2_t s0 = e0 * (f32x2_t){st[0], st[1]} + (f32x2_t){bflo(dv[i].x), bfhi(dv[i].x)}, s1 = e1 * (f32x2_t){st[2], st[3]} + (f32x2_t){bflo(dv[i].y), bfhi(dv[i].y)};
                    const f32x2_t s2 = e2 * (f32x2_t){st[4], st[5]} + (f32x2_t){bflo(dv[i].z), bfhi(dv[i].z)}, s3 = e3 * (f32x2_t){st[6], st[7]} + (f32x2_t){bflo(dv[i].w), bfhi(dv[i].w)};
                    st[0] = s0.x; st[1] = s0.y; st[2] = s1.x; st[3] = s1.y; st[4] = s2.x; st[5] = s2.y; st[6] = s3.x; st[7] = s3.y; }
            }
        }
    } else if (t < 192) {
        for (int item = F.vcu * 64 + (t - 128); item < 16 * 1024; item += F.G * 64) {
            const int scan = item >> 10, e = (item & 1023) * 8, dir = scan & 1;
            const u32x4* cb = (const u32x4*)((const bf16*)(F.ws + WS_MLC) + (size_t)scan * NTC * 8192 + e); u32x4* ob = (u32x4*)((bf16*)(F.ws + WS_MLCB) + (size_t)scan * NTC * 8192 + e);
            float m = 0.f, st[8];
#pragma unroll
            for (int k = 0; k < 8; ++k) st[k] = 0.f;
            for (int j0 = 0; j0 < NTC; j0 += 12) {
                u32x4 dv[12]; float gg[12], ml[12];
#pragma unroll
                for (int i = 0; i < 12; ++i) { const int tc = tc_seq(dir, j0 + i); dv[i] = cb[(size_t)tc * 1024]; const float* sp = MLS + (size_t)(scan * NTC + tc) * 4; gg[i] = sp[0]; ml[i] = sp[1]; }
#pragma unroll
                for (int i = 0; i < 12; ++i) { const int tc = tc_seq(dir, j0 + i);
                    const float mn = fmaxf(gg[i] + m, ml[i]), a = __expf(gg[i] + m - mn), w = __expf(ml[i] - mn);
                    if ((item & 1023) == 0) MLS[(size_t)(scan * NTC + tc) * 4 + 2] = m;
                    ob[(size_t)tc * 1024] = (u32x4){pk2(st[0], st[1]), pk2(st[2], st[3]), pk2(st[4], st[5]), pk2(st[6], st[7])};
                    const f32x2_t s0 = (f32x2_t){st[0], st[1]} * a + (f32x2_t){bflo(dv[i].x), bfhi(dv[i].x)} * w, s1 = (f32x2_t){st[2], st[3]} * a + (f32x2_t){bflo(dv[i].y), bfhi(dv[i].y)} * w;
                    const f32x2_t s2 = (f32x2_t){st[4], st[5]} * a + (f32x2_t){bflo(dv[i].z), bfhi(dv[i].z)} * w, s3 = (f32x2_t){st[6], st[7]} * a + (f32x2_t){bflo(dv[i].w), bfhi(dv[i].w)} * w;
                    st[0] = s0.x; st[1] = s0.y; st[2] = s1.x; st[3] = s1.y; st[4] = s2.x; st[5] = s2.y; st[6] = s3.x; st[7] = s3.y; m = mn; }
            }
        }
    } else if (t < 196) {
        for (int item = F.vcu * 4 + (t - 192); item < 16 * 64; item += F.G * 4) {
            const int scan = item >> 6, e = item & 63, dir = scan & 1; float* nb = (float*)(F.ws + WS_MLN) + (size_t)scan * NTC * 64 + e;
            float m = 0.f, s0 = 0.f;
            for (int j0 = 0; j0 < NTC; j0 += 12) {
                float dv[12];
#pragma unroll
                for (int i = 0; i < 12; ++i) dv[i] = nb[tc_seq(dir, j0 + i) * 64];
#pragma unroll
                for (int i = 0; i < 12; ++i) { const int tc = tc_seq(dir, j0 + i); const float* sp = MLS + (size_t)(scan * NTC + tc) * 4;
                    const float g = sp[0], ml = sp[1], mn = fmaxf(g + m, ml), a = __expf(g + m - mn), w = __expf(ml - mn);
                    nb[tc * 64] = s0; s0 = a * s0 + w * dv[i]; m = mn; }
            }
        }
    }
}
template <int MIX>
__device__ __forceinline__ void gate_load(Frame& F, int row0, int h, unsigned (&gate)[16]) {
    const int mt = F.wave >> 2, nt = F.wave & 3; const bf16* P = (const bf16*)(F.ws + WS_P) + (MIX == 0 ? PC_O : PC_GO) + h * 128 + 32 * nt + (F.lane & 31);
#pragma unroll
    for (int r = 0; r < 16; ++r) gate[r] = P[(size_t)(row0 + 32 * mt + rowmap(r, F.lane >> 5)) * PW];
}
template <int MIX>
__device__ __forceinline__ void head_epilogue(Frame& F, const float ng, const f32x16& hv, const unsigned (&gate)[16], LAS float* part, int row0, int h) {
    const int mt = F.wave >> 2, nt = F.wave & 3, lane = F.lane, hi = lane >> 5;
    float ps[16];
#pragma unroll
    for (int r = 0; r < 16; ++r) ps[r] = hv[r] * hv[r];
#pragma unroll
    for (int r = 0; r < 16; ++r) ps[r] = half_sum_hi(ps[r]);
    if ((lane & 31) == 31) {
#pragma unroll
        for (int r = 0; r < 16; ++r) part[(32 * mt + rowmap(r, hi)) * 4 + nt] = ps[r]; }
    LDS_BARRIER();
    bf16* Y = (bf16*)(F.ws + WS_Y) + (MIX == 0 ? 0 : 512) + h * 128 + 32 * nt + (lane & 31);
#pragma unroll
    for (int r = 0; r < 16; r += 2) { const int t0 = 32 * mt + rowmap(r, hi), t1 = 32 * mt + rowmap(r + 1, hi); const f32x4 p4 = *(const LAS f32x4*)(part + t0 * 4), q4 = *(const LAS f32x4*)(part + t1 * 4);
        const f32x2_t ms = (f32x2_t){(p4.x + p4.y) + (p4.z + p4.w), (q4.x + q4.y) + (q4.z + q4.w)} * (1.f / 128.f) + EPS;
        const f32x2_t rstd = {__builtin_amdgcn_rsqf(ms.x), __builtin_amdgcn_rsqf(ms.y)}, gz = {bf2f((unsigned short)gate[r]), bf2f((unsigned short)gate[r + 1])};
        const f32x2_t te = gz * (-1.44269504f), dn = (f32x2_t){__builtin_amdgcn_exp2f(te.x), __builtin_amdgcn_exp2f(te.y)} + 1.f;
        const f32x2_t sg = {__builtin_amdgcn_rcpf(dn.x), __builtin_amdgcn_rcpf(dn.y)}, gv = MIX == 0 ? sg : gz * sg;
        const f32x2_t y = ((f32x2_t){hv[r], hv[r + 1]} * rstd) * (gv * ng); const unsigned w = pk2(y.x, y.y);
        Y[(size_t)(row0 + t0) * D] = (bf16)w; Y[(size_t)(row0 + t1) * D] = (bf16)(w >> 16); }
}
struct MlCRaw { VtRaw v; u32x4 q, k; u32x4 cf[2]; float g0, g1, ms; };
__device__ __forceinline__ void touch(MlCRaw& R) {
#pragma unroll
    for (int i = 0; i < 8; ++i) touch(R.v.w[i]);
    touch(R.q); touch(R.k); touch(R.cf[0]); touch(R.cf[1]); touch(R.g0); touch(R.g1); touch(R.ms); }
__device__ __forceinline__ void ml_passC_load(Frame& F, int task, MlCRaw& R) {
    const TaskId T = task_id(task); const bf16* CQK = (const bf16*)(F.ws + WS_CQK);
    vt_load(R.v, (const bf16*)(F.ws + WS_P), PW, T.row0, PC_V + T.h * 128, F.tid);
    { const int row = F.tid >> 3, pc = F.tid & 7;
      R.q = *(const u32x4*)(CQK + (size_t)(T.row0 + row) * 512 + T.h * 64 + pc * 8); R.k = *(const u32x4*)(CQK + (size_t)(T.row0 + row) * 512 + 256 + T.h * 64 + pc * 8); }
    { const u32x4* cp = (const u32x4*)((const bf16*)(F.ws + WS_MLCB) + (size_t)(T.sidf * NTC + T.tc) * 8192 + (F.tid >> 2) * 64 + (F.tid & 3) * 16); R.cf[0] = cp[0]; R.cf[1] = cp[1]; }
    R.g0 = 0.f; R.g1 = 0.f; R.ms = 0.f;
    if (F.wave < 2) { const int dir = F.wave; const float* gp = (const float*)(F.ws + WS_GATES) + (size_t)(T.row0 + F.lane) * 16; R.g0 = gp[dir * 4 + T.h]; R.g1 = gp[8 + dir * 4 + T.h];
        R.ms = ((const float*)(F.ws + WS_MLS))[(size_t)((T.sidf + dir) * NTC + T.tc) * 4 + 2]; }
}
__device__ __forceinline__ void ml_passC_run(Frame& F, CArgs& A, int l, int task, const MlCRaw& R) {
    const TaskId T = task_id(task); const int h = T.h, tc = T.tc, row0 = T.row0, sidf = T.sidf;
    if (l == DEPTH - 1 && tc < 4) return;
    unsigned gate[16];
    const float ng = A.in[I_MLNG][l * 512 + h * 128 + 32 * (F.wave & 3) + (F.lane & 31)];
    LAS unsigned char* Q = F.lds; LAS unsigned char* Kn = F.lds + 9216; LAS unsigned char* VT = F.lds + 18432; LAS unsigned char* Cs = F.lds + 36864;
    LAS unsigned char* Pm = F.lds + 55296; LAS unsigned char* Qs = F.lds + 64512;
    LAS float* sm = (LAS float*)(F.lds + 73728);
    const int tid = F.tid, lane = F.lane;
    u32x4 cb[2]; { const u32x4* cp = (const u32x4*)((const bf16*)(F.ws + WS_MLCB) + (size_t)((sidf + 1) * NTC + tc) * 8192 + (tid >> 2) * 64 + (tid & 3) * 16); cb[0] = cp[0]; cb[1] = cp[1]; }
    float nv = 0.f; if (tid < 128) nv = ((const float*)(F.ws + WS_MLN))[(size_t)((sidf + (tid >> 6)) * NTC + tc) * 64 + (tid & 63)];
    LDS_BARRIER();
    { const int row = tid >> 3, pc = tid & 7; *(LAS u32x4*)(Q + row * ST64 + pc * 16) = R.q; *(LAS u32x4*)(Kn + row * ST64 + pc * 16) = R.k; }
    vt_store(VT, R.v, tid);
    if (tid < 128) sm[512 + tid] = nv;
    if (F.wave < 2) { const int dir = F.wave, s = lane; const float ig = R.g0, lf = R.g1, ms = R.ms;
        float bt, u, pm;
        if (dir == 0) { bt = wave_incl_sum(lf, s); u = ig - bt; pm = wave_incl_max(u, s); }
        else { const float pf = wave_incl_sum(lf, s), tot = __builtin_bit_cast(float, __builtin_amdgcn_readlane(__builtin_bit_cast(int, pf), 63)); bt = tot - pf + lf; u = ig - bt;
               float r = __shfl(u, 63 - s); r = wave_incl_max(r, s); pm = __shfl(r, 63 - s); }
        const float M = fmaxf(ms, pm);
        LAS float* o = sm + dir * 256; o[s] = u; o[64 + s] = M; o[128 + s] = __expf(ms - M); o[192 + s] = __expf(-(bt + M)); }
    LDS_BARRIER();
    f32x16 qk;
#pragma unroll
    for (int i = 0; i < 16; ++i) qk[i] = 0.f;
    if (F.wave < 4) mm32<64>(qk, Q + 32 * (F.wave >> 1) * ST64, ST64, Kn + 32 * (F.wave & 1) * ST64, ST64, lane);
    f32x16 hs;
#pragma unroll
    for (int i = 0; i < 16; ++i) hs[i] = 0.f;
#pragma unroll 1
    for (int dir = 0; dir < 2; ++dir) {
        const LAS float* sd = sm + dir * 256;
        { const int v = tid >> 2, pc = tid & 3; *(LAS u32x4*)(Cs + v * ST64 + pc * 32) = dir == 0 ? R.cf[0] : cb[0]; *(LAS u32x4*)(Cs + v * ST64 + pc * 32 + 16) = dir == 0 ? R.cf[1] : cb[1]; }
        { const int row = tid >> 3, pc = tid & 7; const u32x4 q = R.q; const float w = sd[128 + row];
          *(LAS u32x4*)(Qs + row * ST64 + pc * 16) = (u32x4){pk2(bflo(q.x) * w, bfhi(q.x) * w), pk2(bflo(q.y) * w, bfhi(q.y) * w), pk2(bflo(q.z) * w, bfhi(q.z) * w), pk2(bflo(q.w) * w, bfhi(q.w) * w)}; }
        if (F.wave < 4) { const int s = 32 * (F.wave & 1) + (lane & 31); const float us = sd[s]; float Mt[16];
#pragma unroll
            for (int r = 0; r < 16; ++r) Mt[r] = sd[64 + 32 * (F.wave >> 1) + rowmap(r, lane >> 5)];
#pragma unroll
            for (int r = 0; r < 16; r += 2) { const int t0 = 32 * (F.wave >> 1) + rowmap(r, lane >> 5), t1 = 32 * (F.wave >> 1) + rowmap(r + 1, lane >> 5);
                const bool ok0 = dir == 0 ? (s <= t0) : (s >= t0), ok1 = dir == 0 ? (s <= t1) : (s >= t1);
                f32x2_t ex = (f32x2_t){us - Mt[r], us - Mt[r + 1]}; ex.x = fminf(ex.x, 0.f); ex.y = fminf(ex.y, 0.f); ex = ex * 1.44269504f;
                const f32x2_t p = (f32x2_t){qk[r], qk[r + 1]} * (f32x2_t){__builtin_amdgcn_exp2f(ex.x), __builtin_amdgcn_exp2f(ex.y)}; const unsigned w = pk2(ok0 ? p.x : 0.f, ok1 ? p.y : 0.f);
                *(LAS unsigned short*)(Pm + t0 * ST64 + s * 2) = (unsigned short)w; *(LAS unsigned short*)(Pm + t1 * ST64 + s * 2) = (unsigned short)(w >> 16); } }
        LDS_BARRIER();
        if (tid < 256) { const int t = tid >> 2, qd = tid & 3; float den = 0.f, qn = 0.f;
#pragma unroll
            for (int i = 0; i < 2; ++i) { const u32x4 w = *(const LAS u32x4*)(Pm + t * ST64 + qd * 32 + i * 16); den += (bflo(w.x) + bfhi(w.x)) + (bflo(w.y) + bfhi(w.y)) + (bflo(w.z) + bfhi(w.z)) + (bflo(w.w) + bfhi(w.w));
                const u32x4 q = *(const LAS u32x4*)(Q + t * ST64 + qd * 32 + i * 16); const LAS float* nvp = sm + 512 + dir * 64 + qd * 16 + i * 8; const f32x4 n0 = *(const LAS f32x4*)nvp, n1 = *(const LAS f32x4*)(nvp + 4);
                qn += (bflo(q.x) * n0.x + bfhi(q.x) * n0.y) + (bflo(q.y) * n0.z + bfhi(q.y) * n0.w) + (bflo(q.z) * n1.x + bfhi(q.z) * n1.y) + (bflo(q.w) * n1.z + bfhi(q.w) * n1.w); }
            den += sd[128 + t] * qn;
            den += dppf<0xB1, 0xf, true>(0.f, den); den += dppf<0x4E, 0xf, true>(0.f, den);
            if (qd == 0) sm[640 + t] = 1.f / fmaxf(fabsf(den), sd[192 + t]); }
        f32x16 acc;
#pragma unroll
        for (int i = 0; i < 16; ++i) acc[i] = 0.f;
        { const int mt = F.wave >> 2, nt = F.wave & 3;
          mm32<64>(acc, Pm + 32 * mt * ST64, ST64, VT + 32 * nt * ST64, ST64, lane);
          mm32<64>(acc, Qs + 32 * mt * ST64, ST64, Cs + 32 * nt * ST64, ST64, lane); }
        LDS_BARRIER();
        float dsc[16];
#pragma unroll
        for (int r = 0; r < 16; ++r) dsc[r] = sm[640 + 32 * (F.wave >> 2) + rowmap(r, lane >> 5)];
#pragma unroll
        for (int r = 0; r < 16; ++r) hs[r] += acc[r] * dsc[r];
        if (dir == 0) LDS_BARRIER();
    }
    gate_load<0>(F, row0, h, gate);
    head_epilogue<0>(F, ng, hs, gate, sm + 768, row0, h);
}

struct HgPrep { float k[16], x[16]; float T[4]; };
__device__ __forceinline__ void hg_zload(Frame& F, int h, int row0, int dir, unsigned (&z)[16]) {
    const int d = F.tid & 127, qtr = F.tid >> 7;
    const bf16* P = (const bf16*)(F.ws + WS_P) + (size_t)(row0 + qtr * 16) * PW + (dir == 0 ? PC_FF : PC_FB) + h * 128 + d;
#pragma unroll
    for (int i = 0; i < 16; ++i) z[i] = P[(size_t)i * PW];
}
struct HgConst { float lb, bf, bb; };
__device__ __forceinline__ HgConst hg_const(Frame& F, CArgs& A, int l, int h) { const int ch = h * 128 + (F.tid & 127); HgConst c; c.lb = 0.f;
    if (l == 1) { const float r0 = A.in[I_HGLB][ch], r1 = A.in[I_HGLB][512 + ch], mx = fmaxf(r0, r1), e0 = __expf(r0 - mx), e1 = __expf(r1 - mx); c.lb = e1 / (e0 + e1); }
    c.bf = A.in[I_HGFB][l * 1024 + ch]; c.bb = A.in[I_HGFB][l * 1024 + 512 + ch]; return c; }
template <int dir>
__device__ __forceinline__ void hg_prep(Frame& F, const HgConst& C, int l, const unsigned (&zr)[16], LAS float* tot, HgPrep& R) {
    const int d = F.tid & 127, qtr = F.tid >> 7;
    const float lb = C.lb, bias = dir == 0 ? C.bf : C.bb, omlb = 1.f - lb;
    float cs = 0.f;
#pragma unroll
    for (int i = 0; i < 16; i += 2) {
        f32x2_t z = (f32x2_t){bf2f((unsigned short)zr[i]), bf2f((unsigned short)zr[i + 1])} + bias;
        z.x = fminf(fmaxf(z.x, -30.f), 30.f); z.y = fminf(fmaxf(z.y, -30.f), 30.f);
        const f32x2_t t = z * (-1.44269504f);
        const f32x2_t ez = {__builtin_amdgcn_exp2f(t.x), __builtin_amdgcn_exp2f(t.y)}, dn = ez + 1.f;
        const f32x2_t sg = {__builtin_amdgcn_rcpf(dn.x), __builtin_amdgcn_rcpf(dn.y)};
        const f32x2_t kk = (ez * sg) * omlb, ff = sg * omlb + lb;
        R.k[i] = kk.x; R.k[i + 1] = kk.y;
        const f32x2_t lf = (f32x2_t){__builtin_amdgcn_logf(ff.x), __builtin_amdgcn_logf(ff.y)} * 0.69314718f;
        if (dir == 0) { cs += lf.x; R.x[i] = cs; cs += lf.y; R.x[i + 1] = cs; } else { R.x[i] = cs; cs += lf.x; R.x[i + 1] = cs; cs += lf.y; } }
    tot[dir * 512 + qtr * 128 + d] = cs;
    LDS_BARRIER();
    float off = 0.f;
#pragma unroll
    for (int q = 0; q < 4; ++q) { R.T[q] = tot[dir * 512 + q * 128 + d]; if (q < qtr) off += R.T[q]; }
#pragma unroll
    for (int i = 0; i < 16; ++i) R.x[i] += off;
}
__device__ __forceinline__ void put16(LAS unsigned char* p, const float (&v)[16]) {
    *(LAS u32x4*)p = (u32x4){pk2(v[0], v[1]), pk2(v[2], v[3]), pk2(v[4], v[5]), pk2(v[6], v[7])};
    *(LAS u32x4*)(p + 16) = (u32x4){pk2(v[8], v[9]), pk2(v[10], v[11]), pk2(v[12], v[13]), pk2(v[14], v[15])};
}
struct HgARaw { VtRaw v; unsigned zf[16], zb[16]; };
__device__ __forceinline__ void touch(HgARaw& R) {
#pragma unroll
    for (int i = 0; i < 8; ++i) touch(R.v.w[i]);
#pragma unroll
    for (int i = 0; i < 16; ++i) { touch(R.zf[i]); touch(R.zb[i]); } }
__device__ __forceinline__ void hg_passA_load(Frame& F, int task, HgARaw& R) {
    const TaskId T = task_id(task);
    vt_load(R.v, (const bf16*)(F.ws + WS_CQI), 1024, T.row0, 512 + T.h * 128, F.tid);
    hg_zload(F, T.h, T.row0, 0, R.zf); hg_zload(F, T.h, T.row0, 1, R.zb);
}
__device__ __forceinline__ void hg_passA_run(Frame& F, CArgs& A, int l, int task, const HgARaw& RW) {
    const TaskId T = task_id(task); const int h = T.h, tc = T.tc, sidf = T.sidf;
    LAS unsigned char* VT = F.lds; LAS unsigned char* KT = F.lds + 18432; LAS float* tot = (LAS float*)(F.lds + 55296);
    const int d = F.tid & 127, qtr = F.tid >> 7;
    const HgConst HC = hg_const(F, A, l, h);
    LDS_BARRIER();
    vt_store(VT, RW.v, F.tid);
    float* GG = (float*)(F.ws + WS_HGG);
    { HgPrep R; hg_prep<0>(F, HC, l, RW.zf, tot, R);
      const float G = (R.T[0] + R.T[1]) + (R.T[2] + R.T[3]);
      if (qtr == 0) GG[(size_t)(sidf * NTC + tc) * 128 + d] = G;
      float t[16];
#pragma unroll
      for (int i = 0; i < 16; i += 2) { const f32x2_t te = ((f32x2_t){R.x[i], R.x[i + 1]} - G) * (-1.44269504f);
          const f32x2_t kv = (f32x2_t){R.k[i], R.k[i + 1]} * (f32x2_t){__builtin_amdgcn_exp2f(te.x), __builtin_amdgcn_exp2f(te.y)}; t[i] = kv.x; t[i + 1] = kv.y; }
      put16(KT + d * ST64 + qtr * 32, t); }
    { HgPrep R; hg_prep<1>(F, HC, l, RW.zb, tot, R);
      const float G = (R.T[0] + R.T[1]) + (R.T[2] + R.T[3]);
      if (qtr == 0) GG[(size_t)((sidf + 1) * NTC + tc) * 128 + d] = G;
      float t[16];
#pragma unroll
      for (int i = 0; i < 16; i += 2) { const f32x2_t te = (f32x2_t){R.x[i], R.x[i + 1]} * 1.44269504f;
          const f32x2_t kv = (f32x2_t){R.k[i], R.k[i + 1]} * (f32x2_t){__builtin_amdgcn_exp2f(te.x), __builtin_amdgcn_exp2f(te.y)}; t[i] = kv.x; t[i + 1] = kv.y; }
      put16(KT + 18432 + d * ST64 + qtr * 32, t); }
    LDS_BARRIER();
    { const int dir = F.wave >> 2, mt = F.wave & 3; bf16* S = (bf16*)(F.ws + WS_HGS) + (size_t)((sidf + dir) * NTC + tc) * 16384;
#pragma unroll
      for (int nt = 0; nt < 4; ++nt) { f32x16 acc;
#pragma unroll
          for (int i = 0; i < 16; ++i) acc[i] = 0.f;
          mm32<64>(acc, VT + 32 * mt * ST64, ST64, KT + dir * 18432 + 32 * nt * ST64, ST64, F.lane);
#pragma unroll
          for (int r = 0; r < 16; ++r) S[(32 * mt + rowmap(r, F.lane >> 5)) * 128 + 32 * nt + (F.lane & 31)] = (bf16)f2bf(acc[r]); } }
}
struct HgCRaw { VtRaw v; unsigned zf[16], q[16]; };
__device__ __forceinline__ void touch(HgCRaw& R) {
#pragma unroll
    for (int i = 0; i < 8; ++i) touch(R.v.w[i]);
#pragma unroll
    for (int i = 0; i < 16; ++i) { touch(R.zf[i]); touch(R.q[i]); } }
__device__ __forceinline__ void hg_passC_load(Frame& F, int task, HgCRaw& R) {
    const TaskId T = task_id(task); const bf16* CQI = (const bf16*)(F.ws + WS_CQI);
    vt_load(R.v, CQI, 1024, T.row0, 512 + T.h * 128, F.tid);
    hg_zload(F, T.h, T.row0, 0, R.zf);
    { const int d = F.tid & 127, qtr = F.tid >> 7;
#pragma unroll
      for (int i = 0; i < 16; ++i) R.q[i] = CQI[(size_t)(T.row0 + qtr * 16 + i) * 1024 + T.h * 128 + d]; }
}
__device__ __forceinline__ void hg_passC_run(Frame& F, CArgs& A, int l, int task, const HgCRaw& RW) {
    const TaskId T = task_id(task); const int h = T.h, tc = T.tc, row0 = T.row0, sidf = T.sidf;
    LAS unsigned char* VT = F.lds; LAS unsigned char* Ss = F.lds + 18432; LAS unsigned char* Qh = F.lds + 53248; LAS unsigned char* Kh = F.lds + 70656;
    LAS unsigned char* Qc = F.lds + 88064; LAS unsigned char* Kc = F.lds + 96768; LAS unsigned char* Qt = F.lds + 105472; LAS unsigned char* Am = F.lds + 122880;
    LAS float* tot = (LAS float*)(F.lds + 132096);
    const int tid = F.tid, lane = F.lane, d = tid & 127, qtr = tid >> 7;
    if (l == DEPTH - 1 && tc < 4) return;
    unsigned gate[16];
    const HgConst HC = hg_const(F, A, l, h);
    unsigned zb[16]; hg_zload(F, h, row0, 1, zb);
    u32x4 sf[4], sb[4]; { const u32x4* sp = (const u32x4*)((const bf16*)(F.ws + WS_HGSB) + (size_t)(sidf * NTC + tc) * 16384 + (tid >> 2) * 128 + (tid & 3) * 32);
#pragma unroll
      for (int j = 0; j < 4; ++j) { sf[j] = sp[j]; sb[j] = sp[j + (size_t)NTC * 16384 * 2 / 16]; } }
    LDS_BARRIER();
    vt_store(VT, RW.v, tid);
    f32x16 acc;
#pragma unroll
    for (int i = 0; i < 16; ++i) acc[i] = 0.f;
#pragma unroll
    for (int dir = 0; dir < 2; ++dir) {
        HgPrep R;
        if (dir == 1) gate_load<1>(F, row0, h, gate);
        if (dir == 0) hg_prep<0>(F, HC, l, RW.zf, tot, R); else hg_prep<1>(F, HC, l, zb, tot, R);
        const float T0 = R.T[0], T1 = R.T[1], T2 = R.T[2], T3 = R.T[3];
        const float sg = dir == 0 ? 1.f : -1.f;
        const float rI = sg * ((qtr >> 1) == 0 ? T0 : (T0 + T1) + T2);
        const float rO = sg * (T0 + T1);
        const float Gall = (T0 + T1) + (T2 + T3);
        const bool isq = dir == 0 ? (qtr >= 2) : (qtr < 2);
        const float cO = __expf(isq ? rI - rO : rO - rI), cT = __expf(dir == 0 ? rI : Gall + rI);
        { const int v = tid >> 2, pc = tid & 3;
#pragma unroll
          for (int j = 0; j < 4; ++j) *(LAS u32x4*)(Ss + v * ST128 + pc * 64 + j * 16) = dir == 0 ? sf[j] : sb[j]; }
#pragma unroll
        for (int i = 0; i < 16; i += 2) {
            const int t = qtr * 16 + i;
            const f32x2_t x = dir == 0 ? (f32x2_t){R.x[i], R.x[i + 1]} : (f32x2_t){-R.x[i], -R.x[i + 1]}, kk = {R.k[i], R.k[i + 1]}, qv = {bf2f((unsigned short)RW.q[i]), bf2f((unsigned short)RW.q[i + 1])};
            const f32x2_t te = (x - rI) * 1.44269504f;
            const f32x2_t eh = {__builtin_amdgcn_exp2f(te.x), __builtin_amdgcn_exp2f(te.y)}, ehr = {__builtin_amdgcn_rcpf(eh.x), __builtin_amdgcn_rcpf(eh.y)};
            const f32x2_t qe = qv * eh, ke = kk * ehr, of = (isq ? qe : ke) * cO, qt = qe * cT;
            const unsigned wq = pk2(qe.x, qe.y), wk = pk2(ke.x, ke.y), wo = pk2(of.x, of.y), wt = pk2(qt.x, qt.y);
            *(LAS unsigned short*)(Qh + t * ST128 + d * 2) = (unsigned short)wq; *(LAS unsigned short*)(Qh + (t + 1) * ST128 + d * 2) = (unsigned short)(wq >> 16);
            *(LAS unsigned short*)(Kh + t * ST128 + d * 2) = (unsigned short)wk; *(LAS unsigned short*)(Kh + (t + 1) * ST128 + d * 2) = (unsigned short)(wk >> 16);
            LAS unsigned char* oc = isq ? Qc : Kc;
            *(LAS unsigned short*)(oc + (t & 31) * ST128 + d * 2) = (unsigned short)wo; *(LAS unsigned short*)(oc + ((t + 1) & 31) * ST128 + d * 2) = (unsigned short)(wo >> 16);
            *(LAS unsigned short*)(Qt + t * ST128 + d * 2) = (unsigned short)wt; *(LAS unsigned short*)(Qt + (t + 1) * ST128 + d * 2) = (unsigned short)(wt >> 16);
        }
        LDS_BARRIER();
        if (F.wave < 4) { f32x16 a;
#pragma unroll
            for (int i = 0; i < 16; ++i) a[i] = 0.f;
            int tt = 0, ts = 0;
            if (F.wave < 2) { tt = ts = F.wave; mm32<128>(a, Qh + 32 * tt * ST128, ST128, Kh + 32 * ts * ST128, ST128, lane);
#pragma unroll
                for (int r = 0; r < 16; ++r) { const int tl = rowmap(r, lane >> 5), sl = lane & 31; const bool ok = dir == 0 ? (sl <= tl) : (sl >= tl); a[r] = ok ? a[r] : 0.f; } }
            else if (F.wave == 2) { tt = dir == 0 ? 1 : 0; ts = 1 - tt; mm32<128>(a, Qc, ST128, Kc, ST128, lane); }
            else { tt = dir == 0 ? 0 : 1; ts = 1 - tt; }
#pragma unroll
            for (int r = 0; r < 16; r += 2) { const unsigned w = pk2(a[r], a[r + 1]); *(LAS unsigned short*)(Am + (32 * tt + rowmap(r, lane >> 5)) * ST64 + (32 * ts + (lane & 31)) * 2) = (unsigned short)w;
                *(LAS unsigned short*)(Am + (32 * tt + rowmap(r + 1, lane >> 5)) * ST64 + (32 * ts + (lane & 31)) * 2) = (unsigned short)(w >> 16); } }
        LDS_BARRIER();
        { const int mt = F.wave >> 2, nt = F.wave & 3;
          mm32<64>(acc, Am + 32 * mt * ST64, ST64, VT + 32 * nt * ST64, ST64, lane);
          mm32<128>(acc, Qt + 32 * mt * ST128, ST128, Ss + 32 * nt * ST128, ST128, lane); }
        if (dir == 0) LDS_BARRIER();
    }
    const float ng = A.in[I_HGNG][l * 512 + h * 128 + 32 * (F.wave & 3) + (lane & 31)];
    head_epilogue<1>(F, ng, acc, gate, (LAS float*)(F.lds + 136192), row0, h);
}
#define TASK_LOOP(RAW, LOADFN, RUNFN, T0, T1) do { int t_ = F.vcu; while (t_ < (T0)) t_ += F.G; RAW cur_; if (t_ < (T1)) { LOADFN(t_ - (T0), cur_); } \
    for (; t_ < (T1); t_ += F.G) { touch(cur_); RAW nxt_; if (t_ + F.G < (T1)) { LOADFN(t_ + F.G - (T0), nxt_); } else nxt_ = cur_; RUNFN(t_ - (T0), cur_); cur_ = nxt_; } } while (0)

__device__ __forceinline__ void transpose_item(const float* W, int ldw, int K, bf16* WT, int k0, int n0, int drow0, LAS float* scr, int lane) {
    const int n4 = (lane & 7) * 4, kr = lane >> 3;
    f32x4 v[8];
#pragma unroll
    for (int i = 0; i < 8; ++i) v[i] = __builtin_nontemporal_load((const f32x4*)(W + (size_t)(k0 + 8 * i + kr) * ldw + n0 + n4));
#pragma unroll
    for (int i = 0; i < 8; ++i) { LAS float* p = scr + (8 * i + kr) * 33 + n4; p[0] = v[i].x; p[1] = v[i].y; p[2] = v[i].z; p[3] = v[i].w; }
    asm volatile("s_waitcnt lgkmcnt(0)" ::: "memory");
    const int c = lane & 7;
#pragma unroll
    for (int j = 0; j < 4; ++j) { const int n = (lane >> 3) + 8 * j; const LAS float* s = scr + (8 * c) * 33 + n;
        u32x4 o; o.x = pk2(s[0 * 33], s[1 * 33]); o.y = pk2(s[2 * 33], s[3 * 33]); o.z = pk2(s[4 * 33], s[5 * 33]); o.w = pk2(s[6 * 33], s[7 * 33]);
        *(u32x4*)(WT + (size_t)(drow0 + n) * K + k0 + 8 * c) = o; }
    asm volatile("s_waitcnt lgkmcnt(0)" ::: "memory");
}
__device__ __forceinline__ void ph_convert(Frame& F, CArgs& A, bool small_only) {
    LAS float* scr = (LAS float*)(F.lds + 32768 + F.wave * 8448);
    const int gw = F.vcu * NWAVES + F.wave, NGW = F.G * NWAVES;
    constexpr int I_IN = DEPTH * 16 * 128, I_OUT = DEPTH * 16 * 32, I_GU = DEPTH * NEXP * 16 * 64, I_DN = DEPTH * NEXP * 16 * 32;
    for (int it = gw; it < (small_only ? I_IN + I_OUT : I_IN + I_OUT + I_GU + I_DN); it += NGW) {
        int r = it;
        if (r < I_IN) { const int l = r / 2048, q = r % 2048, kb = q / 128, nb = q % 128, d0 = nb * 32, n0 = d0 < 1536 ? d0 : d0 + 16;
            transpose_item(A.in[I_WIN] + (size_t)l * D * INW, INW, D, (bf16*)(F.ws + WS_WIN) + (size_t)l * PW * D, kb * 64, n0, d0, scr, F.lane); continue; }
        r -= I_IN;
        if (r < I_OUT) { const int l = r / 512, q = r % 512, kb = q / 32, nb = q % 32;
            transpose_item(A.in[I_WOUT] + (size_t)l * D * D, D, D, (bf16*)(F.ws + WS_WOUT) + (size_t)l * D * D, kb * 64, nb * 32, nb * 32, scr, F.lane); continue; }
        r -= I_OUT;
        if (r < I_GU) { const int m = r / 1024, q = r % 1024, kb = q / 64, nb = q % 64, n0 = nb * 32;
            const int cc = n0 & 1023, d0 = (cc >> 7) * 256 + (n0 >= 1024 ? 128 : 0) + (cc & 127);
            transpose_item(A.in[I_WGU] + (size_t)m * D * 2048, 2048, D, (bf16*)(F.ws + WS_WGU) + (size_t)m * 2048 * D, kb * 64, n0, d0, scr, F.lane); continue; }
        r -= I_GU;
        { const int m = r / 512, q = r % 512, kb = q / 32, nb = q % 32;
            transpose_item(A.in[I_WDN] + (size_t)m * DEXP * D, D, DEXP, (bf16*)(F.ws + WS_WDN) + (size_t)m * D * DEXP, kb * 64, nb * 32, nb * 32, scr, F.lane); }
    }
}


constexpr int CV_NJ = 384;
__device__ __forceinline__ void moe_item_addr(CArgs& A, unsigned char* ws, int item, const float*& W, int& ldw, bf16*& WT, int& k0, int& n0, int& d0) {
    const int l = item / 49152, r = item % 49152;
    if (r < 32768) { const int e = r >> 10, q = r & 1023, kb = q >> 6, nb = q & 63; n0 = nb * 32; const int cc = n0 & 1023; d0 = (cc >> 7) * 256 + (n0 >= 1024 ? 128 : 0) + (cc & 127); k0 = kb * 64;
        W = A.in[I_WGU] + (size_t)(l * NEXP + e) * D * 2048; ldw = 2048; WT = (bf16*)(ws + WS_WGU) + (size_t)(l * NEXP + e) * 2048 * D; }
    else { const int r2 = r - 32768, e = r2 >> 9, q = r2 & 511, kb = q >> 5, nb = q & 31; n0 = nb * 32; d0 = n0; k0 = kb * 64;
        W = A.in[I_WDN] + (size_t)(l * NEXP + e) * DEXP * D; ldw = D; WT = (bf16*)(ws + WS_WDN) + (size_t)(l * NEXP + e) * D * DEXP; }
}
__device__ __forceinline__ void transpose_store(bf16* WT, int K, int k0, int d0, LAS float* scr, const f32x4 (&v)[8], int lane) {
    const int n4 = (lane & 7) * 4, kr = lane >> 3;
#pragma unroll
    for (int i = 0; i < 8; ++i) { LAS float* p = scr + (8 * i + kr) * 33 + n4; p[0] = v[i].x; p[1] = v[i].y; p[2] = v[i].z; p[3] = v[i].w; }
    asm volatile("s_waitcnt lgkmcnt(0)" ::: "memory");
    const int c = lane & 7;
#pragma unroll
    for (int j = 0; j < 4; ++j) { const int n = (lane >> 3) + 8 * j; const LAS float* sp = scr + (8 * c) * 33 + n;
        u32x4 o; o.x = pk2(sp[0 * 33], sp[1 * 33]); o.y = pk2(sp[2 * 33], sp[3 * 33]); o.z = pk2(sp[4 * 33], sp[5 * 33]); o.w = pk2(sp[6 * 33], sp[7 * 33]);
        *(u32x4*)(WT + (size_t)(d0 + n) * K + k0 + 8 * c) = o; }
    asm volatile("s_waitcnt lgkmcnt(0)" ::: "memory");
}
__device__ __forceinline__ void convert_moe_all(unsigned char* ws, LAS unsigned char* lds, CArgs& A, int cw, int nw, int wave, int lane, int it_lo = 0, int it_hi = 49152) {
    LAS float* scr = (LAS float*)(lds + wave * 16640);
    const int n4 = (lane & 15) * 4, kr = lane >> 4;
    for (int it = it_lo + cw; it < it_hi; it += 2 * nw) {
        const float* W[2]; bf16* WT[2]; int ldw[2], k0[2], n0[2], d0[2];
        const bool two = it + nw < it_hi;
#pragma unroll
        for (int u = 0; u < 2; ++u) { const int iu = (u == 1 && two) ? it + nw : it; const int le = iu / 768, r = iu % 768;
            if (r < 512) { const int kb = r >> 5, nb = r & 31; k0[u] = kb * 64; n0[u] = nb * 64; const int cc = n0[u] & 1023; d0[u] = (cc >> 7) * 256 + (n0[u] >= 1024 ? 128 : 0) + (cc & 127);
                W[u] = A.in[I_WGU] + (size_t)le * D * 2048; ldw[u] = 2048; WT[u] = (bf16*)(ws + WS_WGU) + (size_t)le * 2048 * D; }
            else { const int q = r - 512, kb = q >> 4, nb = q & 15; k0[u] = kb * 64; n0[u] = nb * 64; d0[u] = n0[u];
                W[u] = A.in[I_WDN] + (size_t)le * DEXP * D; ldw[u] = D; WT[u] = (bf16*)(ws + WS_WDN) + (size_t)le * D * DEXP; } }
        f32x4 v[2][16];
#pragma unroll
        for (int u = 0; u < 2; ++u)
#pragma unroll
            for (int i = 0; i < 16; ++i) v[u][i] = __builtin_nontemporal_load((const f32x4*)(W[u] + (size_t)(k0[u] + 4 * i + kr) * ldw[u] + n0[u] + n4));
#pragma unroll
        for (int u = 0; u < 2; ++u) { if (u == 1 && !two) break;
#pragma unroll
            for (int i = 0; i < 16; ++i) { LAS float* p = scr + (4 * i + kr) * 65 + n4; p[0] = v[u][i].x; p[1] = v[u][i].y; p[2] = v[u][i].z; p[3] = v[u][i].w; }
            asm volatile("s_waitcnt lgkmcnt(0)" ::: "memory");
            const int c = lane & 7;
#pragma unroll
            for (int j = 0; j < 8; ++j) { const int n = (lane >> 3) + 8 * j; const LAS float* sp = scr + (8 * c) * 65 + n;
                u32x4 o; o.x = pk2(sp[0 * 65], sp[1 * 65]); o.y = pk2(sp[2 * 65], sp[3 * 65]); o.z = pk2(sp[4 * 65], sp[5 * 65]); o.w = pk2(sp[6 * 65], sp[7 * 65]);
                *(u32x4*)(WT[u] + (size_t)(d0[u] + n) * 1024 + k0[u] + 8 * c) = o; }
            asm volatile("s_waitcnt lgkmcnt(0)" ::: "memory"); }
    }
}
__device__ __forceinline__ void convert_moe(unsigned char* ws, LAS unsigned char* lds, CArgs& A, int cw, int wave, int lane, int j0, int j1) {
    LAS float* scr = (LAS float*)(lds + wave * 8448);
    const int n4 = (lane & 7) * 4, kr = lane >> 3;
    for (int j = j0; j < j1; j += 2) {
        const float* W0; const float* W1; bf16* T0; bf16* T1; int l0, l1, ka, kb_, na, nb_, da, db;
        moe_item_addr(A, ws, cw + 256 * j, W0, l0, T0, ka, na, da);
        const bool two = j + 1 < j1; moe_item_addr(A, ws, cw + 256 * (two ? j + 1 : j), W1, l1, T1, kb_, nb_, db);
        f32x4 v0[8], v1[8];
#pragma unroll
        for (int i = 0; i < 8; ++i) v0[i] = __builtin_nontemporal_load((const f32x4*)(W0 + (size_t)(ka + 8 * i + kr) * l0 + na + n4));
#pragma unroll
        for (int i = 0; i < 8; ++i) v1[i] = __builtin_nontemporal_load((const f32x4*)(W1 + (size_t)(kb_ + 8 * i + kr) * l1 + nb_ + n4));
        transpose_store(T0, 1024, ka, da, scr, v0, lane);
        if (two) transpose_store(T1, 1024, kb_, db, scr, v1, lane);
    }
}

#define XB_TMO      128
#define XB_XCNT(j)  (256  + 64 * (j))
#define XB_XSUB(j)  (1280 + 64 * (j))
#define XB_XGEN(j)  (2304 + 64 * (j))
#define XB_TOP      3328
#define XB_TOPGEN   3392
#define XCD_BAR_WORDS 3456
#define XB_SPIN_CAP (1u << 18)
__device__ __forceinline__ unsigned xb_ld(unsigned* p)              { return __hip_atomic_load(p, __ATOMIC_RELAXED, __HIP_MEMORY_SCOPE_AGENT); }
__device__ __forceinline__ unsigned xb_add(unsigned* p, unsigned v) { return __hip_atomic_fetch_add(p, v, __ATOMIC_RELAXED, __HIP_MEMORY_SCOPE_AGENT); }
__device__ __forceinline__ unsigned xb_xcc_id() { return (unsigned)__builtin_amdgcn_s_getreg((3 << 11) | 20) & 0xFu; }
#define XB_SPIN(cond, bar) do { unsigned _sp = 0; while (cond) { __builtin_amdgcn_s_sleep(1); \
    if ((++_sp & 255u) == 0u) { if (xb_ld(&(bar)[XB_TMO])) break; if (_sp > XB_SPIN_CAP) { atomicAdd(&(bar)[XB_TMO], 1u); break; } } } } while (0)
struct XcdBarrier { unsigned* bar; unsigned x; volatile LAS unsigned* st; };
__device__ __forceinline__ XcdBarrier xcd_barrier_post(unsigned* bar, volatile LAS unsigned* st) {
    XcdBarrier b; b.bar = bar; b.x = xb_xcc_id(); b.st = st;
    if (threadIdx.x == 0) (void)xb_add(&bar[XB_XCNT(b.x)], 1u);
    return b;
}
__device__ __forceinline__ void xcd_barrier_complete(unsigned* bar, unsigned x, unsigned& nloc, unsigned& nx) {
    const unsigned G = gridDim.x * gridDim.y * gridDim.z;
    unsigned sum, cnt, mine, sp = 0u;
    for (;;) {
        sum = 0u; cnt = 0u; mine = 0u;
#pragma unroll
        for (unsigned j = 0; j < 16; ++j) { const unsigned c = xb_ld(&bar[XB_XCNT(j)]); sum += c; cnt += (c > 0u) ? 1u : 0u; mine = (j == x) ? c : mine; }
        if (sum == G) break;
        __builtin_amdgcn_s_sleep(1);
        if ((++sp & 255u) == 0u) { if (xb_ld(&bar[XB_TMO])) break; if (sp > XB_SPIN_CAP) { atomicAdd(&bar[XB_TMO], 1u); break; } }
    }
    nloc = mine > 0u ? mine : 1u; nx = cnt > 0u ? cnt : 1u;
}
__device__ __forceinline__ void xcd_barrier(const XcdBarrier& b) {
    asm volatile("s_waitcnt vmcnt(0)" ::: "memory");
    __syncthreads();
    if (threadIdx.x == 0) {
        unsigned* bar = b.bar;
        __builtin_amdgcn_s_waitcnt(0);
        unsigned nloc = b.st[0], nx = b.st[1];
        if (nloc == 0u) { xcd_barrier_complete(bar, b.x, nloc, nx); b.st[0] = nloc; b.st[1] = nx; }
        const unsigned old = xb_add(&bar[XB_XSUB(b.x)], 1u);
        const unsigned gen = old / nloc;
        if (old + 1u == (gen + 1u) * nloc) {
            __builtin_amdgcn_fence(__ATOMIC_RELEASE, "agent");
            asm volatile("s_waitcnt vmcnt(0)" ::: "memory");
            const unsigned og = xb_add(&bar[XB_TOP], 1u);
            const unsigned tg = og / nx;
            if (og + 1u == (tg + 1u) * nx) xb_add(&bar[XB_TOPGEN], 1u);
            else XB_SPIN(xb_ld(&bar[XB_TOPGEN]) == tg, bar);
            __builtin_amdgcn_fence(__ATOMIC_ACQUIRE, "agent");
            xb_add(&bar[XB_XGEN(b.x)], 1u);
            asm volatile("s_waitcnt vmcnt(0)" ::: "memory");
        } else {
            XB_SPIN(xb_ld(&bar[XB_XGEN(b.x)]) == gen, bar);
            __builtin_amdgcn_fence(__ATOMIC_ACQUIRE, "agent");
            asm volatile("s_waitcnt vmcnt(0)" ::: "memory");
        }
    }
    __syncthreads();
}

enum { PH_INIT = 0, PH_NORM1, PH_INPROJ, PH_CONV, PH_SCANA, PH_SCANB, PH_SCANC, PH_HNORM, PH_OUTPROJ, PH_NORM2, PH_LISTS, PH_GU, PH_DOWN, PH_COMBINE, PH_FINAL };

constexpr int NPHASE = 1 + 13 * DEPTH;
template <int ph, int l>
__device__ __forceinline__ void run_phase(LAS unsigned char* lds_raw) {
    int tid_ = threadIdx.x; asm volatile("" : "+v"(tid_));
    CArgs* ap_ = (CArgs*)__builtin_amdgcn_kernarg_segment_ptr(); asm volatile("" : "+s"(ap_));
    CArgs& A_ = *ap_;
    unsigned char* ws_ = A_.ws; asm volatile("" : "+s"(ws_));
    unsigned lb_ = 0u, bx_ = blockIdx.x, gx_ = gridDim.x; asm volatile("" : "+s"(lb_), "+s"(bx_), "+s"(gx_));
    Frame F; F.lds = lds_raw + lb_; F.out = A_.out; F.ws = ws_;
    F.tid = tid_; F.lane = F.tid & 63; F.wave = __builtin_amdgcn_readfirstlane(F.tid >> 6);
    F.G = (int)gx_; { const int bx = (int)bx_; F.vcu = (F.G % 8 == 0) ? (bx % 8) * (F.G / 8) + bx / 8 : bx; }
    constexpr int nrows = (l == DEPTH - 1) ? NLAT : NTOK;
    constexpr bool CVPH = (l == 0) && (ph <= PH_LISTS);
    constexpr int CQ0 = ph == PH_INIT ? 0 : ph == PH_NORM1 ? 25 : ph == PH_INPROJ ? 55 : ph == PH_CONV ? 140 : ph == PH_SCANA ? 165 : ph == PH_SCANB ? 205 : ph == PH_SCANC ? 233 : ph == PH_OUTPROJ ? 313 : ph == PH_NORM2 ? 344 : 378;
    constexpr int CQ1 = ph == PH_INIT ? 25 : ph == PH_NORM1 ? 55 : ph == PH_INPROJ ? 140 : ph == PH_CONV ? 165 : ph == PH_SCANA ? 205 : ph == PH_SCANB ? 233 : ph == PH_SCANC ? 313 : ph == PH_OUTPROJ ? 344 : ph == PH_NORM2 ? 378 : CV_NJ;
    const bool cvgrid = false;
    if (CVPH && cvgrid) {
        if (bx_ >= 224u) { const int cvcu = (int)(bx_ & 7u) * 4 + ((int)(bx_ >> 3) - 28); convert_moe(ws_, F.lds, A_, cvcu * 8 + F.wave, F.wave, F.lane, CQ0, CQ1); return; }
        F.G = 224; F.vcu = (int)(bx_ & 7u) * 28 + (int)(bx_ >> 3); gx_ = 224u;
    }
    switch (ph) {
        case PH_INIT: ph_init(F, A_); ph_convert(F, A_, true); break;
        case PH_INPROJ: {
            const bool cfirst = ((bx_ >> 3) & 1u) == 0u;
            int base, nblk;
            if (F.G == 256 && l == 0) { if (bx_ >= 32u) { const int ix = (int)bx_ - 32; nblk = 74 + (ix < 16 ? 1 : 0); base = ix * 74 + (ix < 16 ? ix : 16); } else { base = 16592 + (int)bx_ * 48; nblk = 48; } }
            else if (F.G == 256) { if (bx_ >= 32u) { base = ((int)bx_ - 32) * 100; nblk = 100; } else { base = 22400 + (int)bx_ * 68; nblk = 68; } }
            else { const int per = (24576 + F.G - 1) / F.G; base = F.vcu * per; nblk = base + per <= 24576 ? per : (base < 24576 ? 24576 - base : 0); }
            base += l * 24576;
            if (cfirst) { convert_moe_all(F.ws, F.lds, A_, F.wave, NWAVES, F.wave, F.lane, base, base + nblk); __syncthreads(); }
            { pg8::Gemm g{(const bf16*)(F.ws + WS_H), (const bf16*)(F.ws + WS_WIN) + (size_t)l * PW * D, D, nullptr, nullptr, 0};
              pg8::StaticOrder S; S.init(NTOK / 256, PW / 256, F.G, (int)bx_); pg8::EpiBf16 E{(bf16*)(F.ws + WS_P), PW};
              pg8::gemm_phase<pg8::EpiBf16, pg8::StaticOrder, true>(F.lds, g, S, E, F.tid); }
            if (!cfirst) { __syncthreads(); convert_moe_all(F.ws, F.lds, A_, F.wave, NWAVES, F.wave, F.lane, base, base + nblk); }
        } break;
        case PH_NORM1: if (l == 0) ph_rows<1, 0>(F, A_, 0, 0, NTOK); break;
        case PH_CONV: ph_conv(F, A_, l); break;
        case PH_SCANA: {
#define LD_(t, R) ml_passA_load(F, t, R)
#define RN_(t, R) ml_passA_run(F, t, R)
            TASK_LOOP(MlARaw, LD_, RN_, 0, 8 * NTC);
#undef LD_
#undef RN_
#define LD_(t, R) hg_passA_load(F, t, R)
#define RN_(t, R) hg_passA_run(F, A_, l, t, R)
            TASK_LOOP(HgARaw, LD_, RN_, 8 * NTC, 16 * NTC);
#undef LD_
#undef RN_
        } break;
        case PH_SCANB: scan_passB(F); break;
        case PH_SCANC: {
#define LD_(t, R) ml_passC_load(F, t, R)
#define RN_(t, R) ml_passC_run(F, A_, l, t, R)
            TASK_LOOP(MlCRaw, LD_, RN_, 0, 8 * NTC);
#undef LD_
#undef RN_
#define LD_(t, R) hg_passC_load(F, t, R)
#define RN_(t, R) hg_passC_run(F, A_, l, t, R)
            TASK_LOOP(HgCRaw, LD_, RN_, 8 * NTC, 16 * NTC);
#undef LD_
#undef RN_
        } break;
        case PH_OUTPROJ: { pg8::Gemm g{(const bf16*)(F.ws + WS_Y), (const bf16*)(F.ws + WS_WOUT) + (size_t)l * D * D, D, nullptr, nullptr, 0};
            pg8::StaticOrder S; S.init(nrows / 256, D / 256, F.G, (int)bx_);
            const float* xs = (const float*)(F.ws + WS_X);
            pg8::EpiResid E{(float*)(F.ws + WS_X), (const float*)(F.ws + WS_MOD) + (size_t)l * 3 * 6144 + 2048, l == 0 ? A_.in[I_X] : xs, l == 0 ? A_.in[I_CTX] : xs + (size_t)NLAT * D};
            pg8::gemm_phase<pg8::EpiResid, pg8::StaticOrder, true>(F.lds, g, S, E, F.tid);
            if (l == 0 && F.G == 256 && bx_ >= 8u) { __syncthreads(); const int base = 18128 + ((int)bx_ - 8) * 26; convert_moe_all(F.ws, F.lds, A_, F.wave, NWAVES, F.wave, F.lane, base, base + 26); } } break;
        case PH_GU: { const int* rt = (const int*)(F.ws + WS_ROUTE); const int ntile = rt[RT_TILEE];
            pg8::Gemm g{(const bf16*)(F.ws + WS_H), (const bf16*)(F.ws + WS_WGU) + (size_t)l * NEXP * 2048 * D, D, rt + RT_LIST, rt + RT_TILEE, (size_t)2048 * D};
            pg8::StaticOrder S; S.init(ntile, 2048 / 256, F.G, (int)bx_);
            pg8::EpiSwiglu E{(bf16*)(F.ws + WS_ACT), A_.in[I_BGU] + (size_t)l * NEXP * 2048, rt + RT_TILEE};
            pg8::gemm_phase<pg8::EpiSwiglu, pg8::StaticOrder, true>(F.lds, g, S, E, F.tid); } break;
        case PH_DOWN: { const int* rt = (const int*)(F.ws + WS_ROUTE); const int ntile = rt[RT_TILEE];
            pg8::Gemm g{(const bf16*)(F.ws + WS_ACT), (const bf16*)(F.ws + WS_WDN) + (size_t)l * NEXP * D * DEXP, DEXP, nullptr, rt + RT_TILEE, (size_t)D * DEXP};
            pg8::StaticOrder S; S.init(ntile, D / 256, F.G, (int)bx_);
            pg8::EpiDown E{(bf16*)(F.ws + WS_YS), A_.in[I_BDN] + (size_t)l * NEXP * D, (const float*)(rt + RT_SGATE), rt + RT_TILEE};
            pg8::gemm_phase<pg8::EpiDown, pg8::StaticOrder, true>(F.lds, g, S, E, F.tid); } break;
        case PH_HNORM: ph_hnorm(F, A_, l, l == DEPTH - 1); break;
        case PH_NORM2: ph_rows<0, 1>(F, A_, l, l, nrows); break;
        case PH_LISTS: ph_lists(F, A_, l, nrows); break;
        case PH_COMBINE: if (l == DEPTH - 1) ph_rows<2, 2>(F, A_, l, 0, NLAT); else ph_rows<2, 0>(F, A_, l, l + 1, NTOK); break;
        default: break;
    }
}
__global__ void __launch_bounds__(NTHR, 2) fwd(Args a) {
    extern __shared__ __attribute__((aligned(16))) unsigned char lds_raw[];
    volatile LAS unsigned* bst = (volatile LAS unsigned*)((LAS unsigned char*)lds_raw + LDS_BYTES - 64);
    if (threadIdx.x < 16) bst[threadIdx.x] = 0u;
    __syncthreads();
    XcdBarrier bar = xcd_barrier_post((unsigned*)(a.ws + WS_CTL) + CW_BAR, bst);
#ifndef TPROBE
#define TPROBE 0
#endif
#ifndef TP0
#define TP0 0
#define TP1 0
#define TP2 0
#define TD0 800
#define TD1 800
#define TD2 800
#endif
    unsigned ta0 = 0u, ta1 = 0u, ta2 = 0u; unsigned long long tprev = 0;
    const bool stamper = TPROBE && blockIdx.x == 0;
    if (stamper) tprev = __builtin_amdgcn_s_memrealtime();
#define RUN(pi, ph, l) do { run_phase<ph, l>((LAS unsigned char*)lds_raw); if ((pi) != NPHASE - 1 || TPROBE) xcd_barrier(bar); \
    if (stamper) { const unsigned long long tn = __builtin_amdgcn_s_memrealtime(); const unsigned dt = (unsigned)(tn - tprev); tprev = tn; \
        if ((ph) == TP0) ta0 += dt; if ((ph) == TP1) ta1 += dt; if ((ph) == TP2) ta2 += dt; } } while (0)
#define LAYER(l) if (l == 0) RUN(1 + 13 * l, PH_NORM1, l); RUN(2 + 13 * l, PH_INPROJ, l); RUN(3 + 13 * l, PH_CONV, l); RUN(4 + 13 * l, PH_SCANA, l); RUN(5 + 13 * l, PH_SCANB, l); RUN(6 + 13 * l, PH_SCANC, l); \
    RUN(8 + 13 * l, PH_OUTPROJ, l); RUN(9 + 13 * l, PH_NORM2, l); RUN(10 + 13 * l, PH_LISTS, l); RUN(11 + 13 * l, PH_GU, l); RUN(12 + 13 * l, PH_DOWN, l); RUN(13 + 13 * l, PH_COMBINE, l)
    RUN(0, PH_INIT, 0);
    LAYER(0);
    LAYER(1);
#undef LAYER
#undef RUN
    if (TPROBE) {
        if (stamper) { const unsigned long long tn = __builtin_amdgcn_s_memrealtime();
            unsigned q0 = (ta0 + TD0 / 2) / TD0, q1 = (ta1 + TD1 / 2) / TD1, q2 = (ta2 + TD2 / 2) / TD2;
            q0 = q0 > 31u ? 31u : q0; q1 = q1 > 31u ? 31u : q1; q2 = q2 > 31u ? 31u : q2;
            const unsigned long long delay = (unsigned long long)(q0 + 32u * q1 + 1024u * q2) * 1600ull;
            while (__builtin_amdgcn_s_memrealtime() - tn < delay) __builtin_amdgcn_s_sleep(8);
        }
    }
}

template <int NB, class Epi>
__global__ void __launch_bounds__(256) naive_gemm(const bf16* A, int lda, const int* gather, const int* tile_e, int M, const float* B, size_t bexp, int ldb, int N, int K, int bshift_from, int bshift, int bgrp, Epi E) {
    __shared__ float As[16][68]; __shared__ float Bs[NB][16][68];
    const int m0 = blockIdx.y * 64, n0 = blockIdx.x * 64, tid = threadIdx.x, tx = tid & 15, ty = tid >> 4;
    int e = 0;
    if (tile_e) { const int nt = tile_e[0]; if (m0 >= nt * 256) return; e = tile_e[8 + (m0 >> 8)]; } else if (m0 >= M) return;
    const float* Bp = B + (size_t)e * bexp + (n0 + (n0 >= bshift_from ? bshift : 0));
    const int ar = tid >> 2, ak = (tid & 3) * 4; const int arow = gather ? gather[m0 + ar] : (m0 + ar);
    const bf16* Ap = A + (size_t)arow * lda + ak;
    const int bk = tid >> 4, bn = (tid & 15) * 4;
    float acc[NB][4][4];
#pragma unroll
    for (int g = 0; g < NB; ++g)
#pragma unroll
        for (int i = 0; i < 4; ++i)
#pragma unroll
            for (int j = 0; j < 4; ++j) acc[g][i][j] = 0.f;
    for (int k0 = 0; k0 < K; k0 += 16) {
        const u32x2 av = *(const u32x2*)(Ap + k0);
        As[ak + 0][ar] = bflo(av.x); As[ak + 1][ar] = bfhi(av.x); As[ak + 2][ar] = bflo(av.y); As[ak + 3][ar] = bfhi(av.y);
#pragma unroll
        for (int g = 0; g < NB; ++g) { const f32x4 bv = *(const f32x4*)(Bp + (size_t)(k0 + bk) * ldb + g * bgrp + bn); *(f32x4*)&Bs[g][bk][bn] = bv; }
        __syncthreads();
#pragma unroll
        for (int k = 0; k < 16; ++k) { const f32x4 a4 = *(const f32x4*)&As[k][ty * 4];
#pragma unroll
            for (int g = 0; g < NB; ++g) { const f32x4 b4 = *(const f32x4*)&Bs[g][k][tx * 4];
#pragma unroll
                for (int i = 0; i < 4; ++i) { acc[g][i][0] += a4[i] * b4[0]; acc[g][i][1] += a4[i] * b4[1]; acc[g][i][2] += a4[i] * b4[2]; acc[g][i][3] += a4[i] * b4[3]; } } }
        __syncthreads();
    }
#pragma unroll
    for (int i = 0; i < 4; ++i)
#pragma unroll
        for (int j = 0; j < 4; ++j) E(m0 + ty * 4 + i, n0 + tx * 4 + j, acc[0][i][j], NB == 2 ? acc[NB - 1][i][j] : 0.f, e);
}
struct EpiP { bf16* P; __device__ void operator()(int r, int c, float v, float, int) const { P[(size_t)r * PW + c] = (bf16)f2bf(v); } };
struct EpiOut { float* X; const float* MOD; __device__ void operator()(int r, int c, float v, float, int) const { X[(size_t)r * D + c] += MOD[mrow_of(r) * 6144 + 2048 + c] * v; } };
struct EpiGU { bf16* ACT; const float* bgu; __device__ void operator()(int r, int c, float g, float li, int e) const {
    g += bgu[(size_t)e * 2048 + c]; li += bgu[(size_t)e * 2048 + 1024 + c]; g = fminf(g, 7.f); li = fminf(fmaxf(li, -7.f), 7.f);
    ACT[(size_t)r * DEXP + c] = (bf16)f2bf(g * sigmoidf_(1.702f * g) * (li + 1.f)); } };
struct EpiDown { bf16* YS; const float* bdn; const float* sgate; __device__ void operator()(int r, int c, float v, float, int e) const { YS[(size_t)r * D + c] = (bf16)f2bf((v + bdn[(size_t)e * D + c]) * sgate[r]); } };

__global__ void __launch_bounds__(128) naive_mlstm(const bf16* CQK, const bf16* P, const float* GATES, float* HF, float* HB) {
    __shared__ float qs[8][64], ks[8][64];
    const int b = blockIdx.x >> 3, h = (blockIdx.x >> 1) & 3, dir = blockIdx.x & 1, tid = threadIdx.x;
    float C[64], n[64], m = 0.f;
#pragma unroll
    for (int d = 0; d < 64; ++d) { C[d] = 0.f; n[d] = 0.f; }
    float* OUT = dir ? HB : HF;
    for (int p0 = 0; p0 < CTX + SEQ; p0 += 8) {
        __syncthreads();
        { const int st = tid >> 4, pc = tid & 15, p = p0 + st; int row;
          if (p < CTX) row = NLAT + b * CTX + (dir ? CTX - 1 - p : p); else { const int q = p - CTX; row = b * SEQ + (dir ? SEQ - 1 - q : q); }
          const u32x4 w = *(const u32x4*)(CQK + (size_t)row * 512 + (pc < 8 ? h * 64 + pc * 8 : 256 + h * 64 + (pc - 8) * 8));
          float* dst = pc < 8 ? &qs[st][pc * 8] : &ks[st][(pc - 8) * 8];
          dst[0] = bflo(w.x); dst[1] = bfhi(w.x); dst[2] = bflo(w.y); dst[3] = bfhi(w.y); dst[4] = bflo(w.z); dst[5] = bfhi(w.z); dst[6] = bflo(w.w); dst[7] = bfhi(w.w); }
        __syncthreads();
        for (int st = 0; st < 8; ++st) {
            const int p = p0 + st; int row;
            if (p < CTX) row = NLAT + b * CTX + (dir ? CTX - 1 - p : p); else { const int q = p - CTX; row = b * SEQ + (dir ? SEQ - 1 - q : q); }
            const float ig = GATES[(size_t)row * 16 + dir * 4 + h], lf = GATES[(size_t)row * 16 + 8 + dir * 4 + h];
            const float v = bf2f(P[(size_t)row * PW + PC_V + h * 128 + tid]);
            const float mn = fmaxf(lf + m, ig), a = __expf(lf + m - mn), w = __expf(ig - mn), wv = w * v; m = mn;
            float num = 0.f, den = 0.f;
#pragma unroll
            for (int d = 0; d < 64; ++d) { const float kd = ks[st][d], qd = qs[st][d]; C[d] = a * C[d] + wv * kd; n[d] = a * n[d] + w * kd; num += C[d] * qd; den += n[d] * qd; }
            OUT[(size_t)row * D + h * 128 + tid] = num / fmaxf(fabsf(den), __expf(-mn));
        }
    }
}
__global__ void __launch_bounds__(128) naive_hgrn(const bf16* CQI, const bf16* P, const float* fb_l, const float* lbraw, int l, float* HF, float* HB) {
    __shared__ float fs[8][128], ks[8][128], qs[8][128];
    const int b = blockIdx.x >> 3, h = (blockIdx.x >> 1) & 3, dir = blockIdx.x & 1, tid = threadIdx.x, ch = h * 128 + tid;
    float S[128];
#pragma unroll
    for (int d = 0; d < 128; ++d) S[d] = 0.f;
    float lb = 0.f;
    if (l == 1) { const float r0 = lbraw[ch], r1 = lbraw[512 + ch], mx = fmaxf(r0, r1), e0 = __expf(r0 - mx), e1 = __expf(r1 - mx); lb = e1 / (e0 + e1); }
    const float bias = fb_l[dir * 512 + ch];
    float* OUT = dir ? HB : HF;
    for (int p0 = 0; p0 < CTX + SEQ; p0 += 8) {
        __syncthreads();
        float vv[8]; int rows[8];
#pragma unroll
        for (int st = 0; st < 8; ++st) { const int p = p0 + st; int row;
            if (p < CTX) row = NLAT + b * CTX + (dir ? CTX - 1 - p : p); else { const int q = p - CTX; row = b * SEQ + (dir ? SEQ - 1 - q : q); }
            rows[st] = row;
            const float z = bf2f(P[(size_t)row * PW + (dir ? PC_FB : PC_FF) + ch]) + bias;
            fs[st][tid] = lb + (1.f - lb) * sigmoidf_(z); ks[st][tid] = (1.f - lb) * sigmoidf_(-z);
            qs[st][tid] = bf2f(CQI[(size_t)row * 1024 + ch]); vv[st] = bf2f(CQI[(size_t)row * 1024 + 512 + ch]); }
        __syncthreads();
#pragma unroll
        for (int st = 0; st < 8; ++st) { float o = 0.f; const float v = vv[st];
#pragma unroll
            for (int d = 0; d < 128; ++d) { S[d] = fs[st][d] * S[d] + ks[st][d] * v; o += qs[st][d] * S[d]; }
            OUT[(size_t)rows[st] * D + 512 + ch] = o; }
    }
}

extern "C" void kernel_launch(void* const* d_in, const int* in_sizes, int n_in, void* d_out, int out_size, void* d_ws, size_t ws_size, hipStream_t stream) {
    static int grid = 0;
    if (grid == 0) {
        if (n_in != 24 || in_sizes[0] != NLAT * D || out_size != NLAT * D || ws_size < WS_END) { fprintf(stderr, "kernel_launch: unexpected shapes n_in %d in0 %d out %d ws %zu (need %zu)\n", n_in, n_in > 0 ? in_sizes[0] : -1, out_size, ws_size, (size_t)WS_END); grid = -1; return; }
        int dev = 0, cus = 0;
        if (hipGetDevice(&dev) != hipSuccess || hipDeviceGetAttribute(&cus, hipDeviceAttributeMultiprocessorCount, dev) != hipSuccess) { grid = -1; return; }
        if (hipFuncSetAttribute((const void*)fwd, hipFuncAttributeMaxDynamicSharedMemorySize, LDS_BYTES) != hipSuccess) { fprintf(stderr, "kernel_launch: hipFuncSetAttribute failed\n"); grid = -1; return; }
        grid = cus;
    }
    if (grid < 0) return;
    (void)hipMemsetAsync((char*)d_ws + WS_CTL, 0, 1 * MiB, stream);
    Args a{};
    for (int i = 0; i < 24; ++i) a.in[i] = (const float*)d_in[i];
    a.out = (float*)d_out; a.ws = (unsigned char*)d_ws; a.ph_lo = 0; a.ph_hi = 0;
    unsigned char* ws = (unsigned char*)d_ws;
    const float* const* in = a.in;
    int* rt = (int*)(ws + WS_ROUTE);
    a.ph_lo = 0; a.ph_hi = NPHASE;
    hipLaunchKernelGGL(fwd, dim3(grid), dim3(NTHR), LDS_BYTES, stream, a);
}
```

```cpp
#include <hip/hip_runtime.h>
#include <cstdio>
#include <cstdint>

#define GAS __attribute__((address_space(1)))
#define LAS __attribute__((address_space(3)))
typedef unsigned short bf16;
typedef float f32x4 __attribute__((ext_vector_type(4)));
typedef unsigned u32x4 __attribute__((ext_vector_type(4)));
typedef unsigned u32x2 __attribute__((ext_vector_type(2)));

constexpr int D = 1024, BATCH = 2, SEQ = 8192, DEPTH = 2, CTX = 256, GRIDW = 64;
constexpr int NLAT = BATCH * SEQ, NCTX = BATCH * CTX, NTOK = NLAT + NCTX;
constexpr int INW = 4112, PW = 4096;
constexpr int PC_QK = 0, PC_V = 512, PC_O = 1024, PC_QI = 1536, PC_FF = 2560, PC_FB = 3072, PC_GO = 3584;
constexpr int NEXP = 32, TOPK = 4, DEXP = 1024;
constexpr int MAXSLOT = (NTOK * TOPK / 256 + NEXP) * 256;
constexpr int MAXTILE = MAXSLOT / 256;
constexpr float EPS = 1e-6f;

constexpr size_t MiB = 1u << 20;
constexpr size_t WS_CTL = 0;
constexpr size_t WS_MOD = 1 * MiB;
constexpr size_t WS_GATES = 2 * MiB;
constexpr size_t WS_ROUTE = 4 * MiB;
constexpr size_t WS_X = 8 * MiB;
constexpr size_t WS_H = 76 * MiB;
constexpr size_t WS_P = 112 * MiB;
constexpr size_t WS_CQK = 246 * MiB;
constexpr size_t WS_CQI = 264 * MiB;
constexpr size_t WS_HF = 300 * MiB;
constexpr size_t WS_HB = 368 * MiB;
constexpr size_t WS_Y = 436 * MiB;
constexpr size_t WS_ACT = 472 * MiB;
constexpr size_t WS_YS = 622 * MiB;
constexpr size_t WS_WIN = 772 * MiB;
constexpr size_t WS_WOUT = 788 * MiB;
constexpr size_t WS_WGU = 792 * MiB;
constexpr size_t WS_WDN = 1048 * MiB;
constexpr size_t WS_MLC = 1176 * MiB;
constexpr size_t WS_MLN = 1246 * MiB;
constexpr size_t WS_MLS = 1247 * MiB;
constexpr size_t WS_HGS = 1248 * MiB;
constexpr size_t WS_HGG = 1388 * MiB;
constexpr size_t WS_MLCB = 1390 * MiB;
constexpr size_t WS_HGSB = 1426 * MiB;
constexpr size_t WS_END = 1496 * MiB;
constexpr int NTC = 132;
constexpr int RT_TOPI = 0;
constexpr int RT_TOPG = RT_TOPI + NTOK * 4;
constexpr int RT_POS = RT_TOPG + NTOK * 4;
constexpr int RT_SLOT = RT_POS + NTOK * 4;
constexpr int RT_LIST = RT_SLOT + NTOK * 4;
constexpr int RT_SGATE = RT_LIST + MAXSLOT;
constexpr int RT_TILEE = RT_SGATE + MAXSLOT;
constexpr int RT_BLKCNT = RT_TILEE + MAXTILE + 8;
constexpr int MAXG = 1024;
constexpr int RT_END = RT_BLKCNT + MAXG * 32;
static_assert((size_t)RT_END * 4 <= 4 * MiB, "route map");
constexpr int CW_CNT = 1024;
constexpr int CW_BAR = 4096;

typedef float f32x2_t __attribute__((ext_vector_type(2)));
typedef __bf16 bf16x2_t __attribute__((ext_vector_type(2)));
__device__ __forceinline__ unsigned pk2(float lo, float hi) { const f32x2_t v = {lo, hi}; return __builtin_bit_cast(unsigned, __builtin_convertvector(v, bf16x2_t)); }
__device__ __forceinline__ unsigned f2bf(float f) { return pk2(f, 0.f) & 0xffffu; }
__device__ __forceinline__ float bf2f(unsigned short b) { return __builtin_bit_cast(float, (unsigned)b << 16); }
__device__ __forceinline__ float bflo(unsigned w) { return __builtin_bit_cast(float, w << 16); }
__device__ __forceinline__ float bfhi(unsigned w) { return __builtin_bit_cast(float, w & 0xffff0000u); }
__device__ __forceinline__ float sigmoidf_(float x) { return 1.f / (1.f + __expf(-x)); }
__device__ __forceinline__ float siluf_(float x) { return x / (1.f + __expf(-x)); }
__device__ __forceinline__ float logsigmoidf_(float x) { return x >= 0.f ? -log1pf(__expf(-x)) : x - log1pf(__expf(x)); }
template <int CTRL, int ROWMASK, bool BOUND0>
__device__ __forceinline__ float dppf(float old, float x) { return __builtin_bit_cast(float, __builtin_amdgcn_update_dpp(__builtin_bit_cast(int, old), __builtin_bit_cast(int, x), CTRL, ROWMASK, 0xf, BOUND0)); }
__device__ __forceinline__ float half_sum_hi(float x) {
    x += dppf<0xB1, 0xf, true>(0.f, x); x += dppf<0x4E, 0xf, true>(0.f, x); x += dppf<0x114, 0xf, true>(0.f, x); x += dppf<0x118, 0xf, true>(0.f, x);
    x += dppf<0x142, 0xa, true>(0.f, x); return x; }
__device__ __forceinline__ float wave_sum(float v) {
    v = half_sum_hi(v); v += dppf<0x143, 0xc, true>(0.f, v); return __builtin_bit_cast(float, __builtin_amdgcn_readlane(__builtin_bit_cast(int, v), 63)); }
__device__ __forceinline__ float wave_incl_sum(float v, int) {
    v += dppf<0x111, 0xf, true>(0.f, v); v += dppf<0x112, 0xf, true>(0.f, v); v += dppf<0x114, 0xf, true>(0.f, v); v += dppf<0x118, 0xf, true>(0.f, v);
    v += dppf<0x142, 0xa, true>(0.f, v); v += dppf<0x143, 0xc, true>(0.f, v); return v; }
__device__ __forceinline__ float wave_incl_max(float v, int) {
    const float NI = -INFINITY;
    v = fmaxf(v, dppf<0x111, 0xf, false>(NI, v)); v = fmaxf(v, dppf<0x112, 0xf, false>(NI, v)); v = fmaxf(v, dppf<0x114, 0xf, false>(NI, v)); v = fmaxf(v, dppf<0x118, 0xf, false>(NI, v));
    v = fmaxf(v, dppf<0x142, 0xa, false>(NI, v)); v = fmaxf(v, dppf<0x143, 0xc, false>(NI, v)); return v; }
__device__ __forceinline__ float wave_max(float v) { v = wave_incl_max(v, 0); return __builtin_bit_cast(float, __builtin_amdgcn_readlane(__builtin_bit_cast(int, v), 63)); }
__device__ __forceinline__ int mrow_of(int r) { return r < NLAT ? (r >> 13) : 2; }

struct Args { const float* in[24]; float* out; unsigned char* ws; int ph_lo, ph_hi; };
typedef const __attribute__((address_space(4))) Args CArgs;

enum { I_X = 0, I_C, I_CTX, I_CCTX, I_WADA, I_BADA, I_N1G, I_WIN, I_MLCONV, I_MLGB, I_MLNG, I_HGCONV, I_HGFB, I_HGLB, I_HGNG, I_WOUT, I_N2G, I_RW, I_RB, I_WGU, I_BGU, I_WDN, I_BDN, I_FG };

constexpr int NWAVES = 8, NTHR = 512;
constexpr int LDS_BYTES = 147456;

struct Frame {
    LAS unsigned char* lds;
    float* out; unsigned char* ws;
    int tid, lane, wave, vcu, G;
};

__device__ __forceinline__ void ph_init(Frame& F, CArgs& A) {
    const int gt = F.vcu * NTHR + F.tid, NG = F.G * NTHR;
    if (gt < 128) ((u32x4*)(F.ws + WS_H + (size_t)NTOK * D * 2))[gt] = (u32x4){0u, 0u, 0u, 0u};
    LAS float* sc = (LAS float*)F.lds;
    LAS float* part = sc + 3 * 1024;
    for (int i = F.tid; i < 3 * 1024; i += NTHR) { const int r = i >> 10, k = i & 1023; const float c = r < 2 ? A.in[I_C][r * 1024 + k] : A.in[I_CCTX][k]; sc[i] = siluf_(c); }
    __syncthreads();
    for (int item = F.vcu; item < DEPTH * 96; item += F.G) {
        const int l = item / 96, j = (item % 96) * 64 + F.lane;
        const float* w = A.in[I_WADA] + (size_t)l * D * 6144 + j;
        float a0 = 0.f, a1 = 0.f, a2 = 0.f;
        for (int k0 = F.wave * 128; k0 < F.wave * 128 + 128; k0 += 32) { float wv[32];
#pragma unroll
            for (int i = 0; i < 32; ++i) wv[i] = w[(size_t)(k0 + i) * 6144];
#pragma unroll
            for (int i = 0; i < 32; ++i) { a0 += sc[k0 + i] * wv[i]; a1 += sc[1024 + k0 + i] * wv[i]; a2 += sc[2048 + k0 + i] * wv[i]; } }
        part[(F.wave * 3 + 0) * 64 + F.lane] = a0; part[(F.wave * 3 + 1) * 64 + F.lane] = a1; part[(F.wave * 3 + 2) * 64 + F.lane] = a2;
        __syncthreads();
        if (F.tid < 192) { const int r = F.tid >> 6, ln = F.tid & 63; float s = 0.f;
#pragma unroll
            for (int w8 = 0; w8 < 8; ++w8) s += part[(w8 * 3 + r) * 64 + ln];
            const int jj = (item % 96) * 64 + ln;
            ((float*)(F.ws + WS_MOD))[(l * 3 + r) * 6144 + jj] = s + A.in[I_BADA][l * 6144 + jj]; }
        __syncthreads();
    }
}

typedef unsigned u32x2v __attribute__((ext_vector_type(2)));
__device__ __forceinline__ float xor32(float send, int lane) { const unsigned u = __builtin_bit_cast(unsigned, send); const u32x2v r = __builtin_amdgcn_permlane32_swap(u, u, false, false);
    return __builtin_bit_cast(float, (lane & 32) ? r.x : r.y); }
__device__ __forceinline__ float xor16(float send, int lane) { const unsigned u = __builtin_bit_cast(unsigned, send); const u32x2v r = __builtin_amdgcn_permlane16_swap(u, u, false, false);
    return __builtin_bit_cast(float, (lane & 16) ? r.x : r.y); }
__device__ __forceinline__ float xor8(float x) { return dppf<0x140, 0xf, true>(0.f, dppf<0x141, 0xf, true>(0.f, x)); }
__device__ __forceinline__ float xor4(float x) { return dppf<0x141, 0xf, true>(0.f, dppf<0x1B, 0xf, true>(0.f, x)); }
__device__ __forceinline__ float xor2(float x) { return dppf<0x4E, 0xf, true>(0.f, x); }
__device__ __forceinline__ float xor1(float x) { return dppf<0xB1, 0xf, true>(0.f, x); }
template <int NV> __device__ __forceinline__ float reduce_scatter(float (&v)[NV], int lane) {
    float a16[16];
    if constexpr (NV == 32) { const bool hi = lane & 32;
#pragma unroll
        for (int i = 0; i < 16; ++i) { const float keep = hi ? v[16 + i] : v[i], send = hi ? v[i] : v[16 + i]; a16[i] = keep + xor32(send, lane); } }
    else {
#pragma unroll
        for (int i = 0; i < 16; ++i) a16[i] = v[i] + xor1(v[i]); }
    float a8[8], a4[4], a2[2];
    { const bool hi = lane & 16;
#pragma unroll
      for (int i = 0; i < 8; ++i) { const float keep = hi ? a16[8 + i] : a16[i], send = hi ? a16[i] : a16[8 + i]; a8[i] = keep + xor16(send, lane); } }
    { const bool hi = lane & 8;
#pragma unroll
      for (int i = 0; i < 4; ++i) { const float keep = hi ? a8[4 + i] : a8[i], send = hi ? a8[i] : a8[4 + i]; a4[i] = keep + xor8(send); } }
    { const bool hi = lane & 4;
#pragma unroll
      for (int i = 0; i < 2; ++i) { const float keep = hi ? a4[2 + i] : a4[i], send = hi ? a4[i] : a4[2 + i]; a2[i] = keep + xor4(send); } }
    float r;
    { const bool hi = lane & 2; const float keep = hi ? a2[1] : a2[0], send = hi ? a2[0] : a2[1]; r = keep + xor2(send); }
    if constexpr (NV == 32) r += xor1(r); else r += xor32(r, lane);
    return r;
}
struct RowIn { f32x4 x[4]; u32x2 y[4][4]; };
template <int SRC>
__device__ __forceinline__ void row_load(Frame& F, CArgs& A, int r, const int (&slot)[4], RowIn& R) {
    const float* src = SRC == 1 ? (r < NLAT ? A.in[I_X] + (size_t)r * D : A.in[I_CTX] + (size_t)(r - NLAT) * D) : (const float*)(F.ws + WS_X) + (size_t)r * D;
    const f32x4* xr = (const f32x4*)src + F.lane;
#pragma unroll
    for (int j = 0; j < 4; ++j) R.x[j] = xr[64 * j];
    if (SRC == 2) {
#pragma unroll
        for (int k = 0; k < 4; ++k) { const u32x2* yp = (const u32x2*)(F.ws + WS_YS + (size_t)slot[k] * D * 2) + F.lane;
#pragma unroll
            for (int j = 0; j < 4; ++j) R.y[k][j] = yp[64 * j]; } }
}
#define LDS_BARRIER() do { asm volatile("s_waitcnt lgkmcnt(0)" ::: "memory"); __builtin_amdgcn_s_barrier(); asm volatile("" ::: "memory"); } while (0)
template <int SRC, int MODE>
__device__ __forceinline__ void ph_rows(Frame& F, CArgs& A, int lsrc, int l, int nrows) {
    constexpr int NV = MODE == 0 ? 16 : 32;
    constexpr int EPW = NV / 8;
    f32x2_t wp[EPW][4][2];
    LAS unsigned* lcnt = (LAS unsigned*)(F.lds + 131072);
    if (MODE == 1) { const float* w = A.in[I_RW] + (size_t)l * D * NEXP + 4 * F.wave; if (F.tid < 32) lcnt[F.tid] = 0u;
#pragma unroll
        for (int j = 0; j < 4; ++j) { f32x4 q[4];
#pragma unroll
            for (int i = 0; i < 4; ++i) q[i] = *(const f32x4*)(w + (size_t)(256 * j + 4 * F.lane + i) * NEXP);
#pragma unroll
            for (int e = 0; e < EPW; ++e) { wp[e][j][0] = (f32x2_t){q[0][e], q[1][e]}; wp[e][j][1] = (f32x2_t){q[2][e], q[3][e]}; } } }
    if (MODE == 0) { const float* w = A.in[I_WIN] + (size_t)l * D * INW + 1536 + 2 * F.wave;
#pragma unroll
        for (int j = 0; j < 4; ++j) { f32x2_t q[4];
#pragma unroll
            for (int i = 0; i < 4; ++i) q[i] = *(const f32x2_t*)(w + (size_t)(256 * j + 4 * F.lane + i) * INW);
#pragma unroll
            for (int e = 0; e < EPW; ++e) { wp[e][j][0] = (f32x2_t){q[0][e], q[1][e]}; wp[e][j][1] = (f32x2_t){q[2][e], q[3][e]}; } } }
    const float* gam = MODE == 0 ? A.in[I_N1G] + l * D : (MODE == 1 ? A.in[I_N2G] + l * D : A.in[I_FG]);
    const float* MOD = (const float*)(F.ws + WS_MOD) + (size_t)l * 3 * 6144;
    const float* MODS = (const float*)(F.ws + WS_MOD) + (size_t)lsrc * 3 * 6144;
    const int* rt = (const int*)(F.ws + WS_ROUTE);
    const int stride = F.G * NWAVES; int r = F.vcu * NWAVES + F.wave;
    RowIn cur; int s1[4] = {0, 0, 0, 0}, s2[4] = {0, 0, 0, 0};
    if (SRC == 2) { if (r < nrows) { const u32x4 q = *(const u32x4*)(rt + RT_SLOT + r * 4); s1[0] = q.x; s1[1] = q.y; s1[2] = q.z; s1[3] = q.w; }
                    if (r + stride < nrows) { const u32x4 q = *(const u32x4*)(rt + RT_SLOT + (r + stride) * 4); s2[0] = q.x; s2[1] = q.y; s2[2] = q.z; s2[3] = q.w; } }
    if (r < nrows) row_load<SRC>(F, A, r, s1, cur);
    for (; r < nrows; r += stride) {
        RowIn nxt; int s3[4] = {0, 0, 0, 0};
        if (SRC == 2 && r + 2 * stride < nrows) { const u32x4 q = *(const u32x4*)(rt + RT_SLOT + (r + 2 * stride) * 4); s3[0] = q.x; s3[1] = q.y; s3[2] = q.z; s3[3] = q.w; }
        if (r + stride < nrows) row_load<SRC>(F, A, r + stride, s2, nxt);
        f32x4 v[4];
#pragma unroll
        for (int j = 0; j < 4; ++j) v[j] = cur.x[j];
        if (SRC == 2) { const float* g2 = MODS + mrow_of(r) * 6144 + 5 * 1024;
#pragma unroll
            for (int j = 0; j < 4; ++j) { f32x4 a = (f32x4){0.f, 0.f, 0.f, 0.f};
#pragma unroll
                for (int k = 0; k < 4; ++k) { const u32x2 w = cur.y[k][j]; a += (f32x4){bflo(w.x), bfhi(w.x), bflo(w.y), bfhi(w.y)}; }
                v[j] = v[j] + *(const f32x4*)(g2 + 256 * j + 4 * F.lane) * a; } }
        if (SRC == 2 && MODE != 2) { f32x4* xo = (f32x4*)((float*)(F.ws + WS_X) + (size_t)r * D) + F.lane;
#pragma unroll
            for (int j = 0; j < 4; ++j) xo[64 * j] = v[j]; }
        float ss = 0.f;
#pragma unroll
        for (int j = 0; j < 4; ++j) ss += (v[j].x * v[j].x + v[j].y * v[j].y) + (v[j].z * v[j].z + v[j].w * v[j].w);
        const float rstd = rsqrtf(wave_sum(ss) * (1.f / D) + EPS);
        const float* mod = MOD + mrow_of(r) * 6144 + (MODE == 0 ? 0 : 3072);
#pragma unroll
        for (int j = 0; j < 4; ++j) { const int c = 256 * j + 4 * F.lane; const f32x4 g = *(const f32x4*)(gam + c);
            v[j] = v[j] * rstd * g;
            if (MODE != 2) { const f32x4 sh = *(const f32x4*)(mod + c), scl = *(const f32x4*)(mod + 1024 + c); v[j] = v[j] * (1.f + scl) + sh; } }
        if (MODE == 2) { f32x4* o = (f32x4*)(F.out + (size_t)r * D) + F.lane;
#pragma unroll
            for (int j = 0; j < 4; ++j) o[64 * j] = v[j]; }
        else {
            u32x2* ho = (u32x2*)(F.ws + WS_H + (size_t)r * D * 2) + F.lane;
#pragma unroll
            for (int j = 0; j < 4; ++j) ho[64 * j] = (u32x2){pk2(v[j].x, v[j].y), pk2(v[j].z, v[j].w)};
            LAS f32x4* hb = (LAS f32x4*)F.lds;
            LAS float* lg = (LAS float*)(F.lds + 32768);
#pragma unroll
            for (int j = 0; j < 4; ++j) hb[(F.wave * 4 + j) * 64 + F.lane] = v[j];
            LDS_BARRIER();
            float part[NV];
#pragma unroll
            for (int q = 0; q < 8; ++q) { f32x4 hq[4];
#pragma unroll
                for (int j = 0; j < 4; ++j) hq[j] = hb[(q * 4 + j) * 64 + F.lane];
#pragma unroll
                for (int e = 0; e < EPW; ++e) { f32x2_t a2 = {0.f, 0.f};
#pragma unroll
                    for (int j = 0; j < 4; ++j) { a2 += (f32x2_t){hq[j].x, hq[j].y} * wp[e][j][0]; a2 += (f32x2_t){hq[j].z, hq[j].w} * wp[e][j][1]; }
                    part[q * EPW + e] = a2.x + a2.y; } }
            const float mine = reduce_scatter<NV>(part, F.lane);
            if (MODE == 0) { const int g = (F.lane >> 1) & 15; if ((F.lane & 33) == 0) lg[(g >> 1) * 16 + 2 * F.wave + (g & 1)] = mine; }
            else { const int g = (F.lane >> 1) & 31; if ((F.lane & 1) == 0) lg[(g >> 2) * 32 + 4 * F.wave + (g & 3)] = mine; }
            LDS_BARRIER();
            if (MODE == 0) {
                if (F.lane < 16) { const int g = F.lane; float val = lg[F.wave * 16 + g] + A.in[I_MLGB][l * 16 + g];
                    if (g >= 8) val = logsigmoidf_(val);
                    ((float*)(F.ws + WS_GATES))[(size_t)r * 16 + g] = val; }
            } else {
                float lv = F.lane < 32 ? lg[F.wave * 32 + F.lane] + A.in[I_RB][l * NEXP + F.lane] : -INFINITY;
                float tv[4]; int ti[4];
#pragma unroll
                for (int p = 0; p < 4; ++p) { const float best = wave_max(lv);
                    const unsigned long long bal = __ballot(lv == best); const int bi = __ffsll((long long)bal) - 1;
                    tv[p] = best; ti[p] = bi; if (F.lane == bi) lv = -INFINITY; }
                const float e1 = __expf(tv[1] - tv[0]), e2 = __expf(tv[2] - tv[0]), e3 = __expf(tv[3] - tv[0]); const float inv = 1.f / (1.f + e1 + e2 + e3);
                if (F.lane == 0) {
                    int* rtw = (int*)(F.ws + WS_ROUTE);
                    const float gs[4] = {inv, e1 * inv, e2 * inv, e3 * inv};
#pragma unroll
                    for (int p = 0; p < 4; ++p) { rtw[RT_TOPI + r * 4 + p] = ti[p]; ((float*)rtw)[RT_TOPG + r * 4 + p] = gs[p]; rtw[RT_POS + r * 4 + p] = (int)__hip_atomic_fetch_add(lcnt + ti[p], 1u, __ATOMIC_RELAXED, __HIP_MEMORY_SCOPE_WORKGROUP); }
                }
            }
        }
        cur = nxt;
#pragma unroll
        for (int k = 0; k < 4; ++k) { s2[k] = s3[k]; }
    }
    if (MODE == 1) { __syncthreads(); if (F.tid < 32) ((int*)(F.ws + WS_ROUTE))[RT_BLKCNT + F.vcu * 32 + F.tid] = (int)lcnt[F.tid]; }
}

__device__ __forceinline__ void ph_lists(Frame& F, CArgs& A, int l, int nrows) {
    LAS int* off = (LAS int*)F.lds;
    LAS int* pre = (LAS int*)(F.lds + 1024);
    int* rt = (int*)(F.ws + WS_ROUTE);
    if (F.tid < 32) { int run = 0; for (int v = 0; v < F.G; ++v) { pre[v * 32 + F.tid] = run; run += rt[RT_BLKCNT + v * 32 + F.tid]; } off[64 + F.tid] = run; }
    __syncthreads();
    if (F.tid == 0) { int o = 0; for (int e = 0; e < NEXP; ++e) { off[e] = o; o += (off[64 + e] + 255) & ~255; } off[32] = o; }
    __syncthreads();
    const int gt = F.vcu * NTHR + F.tid, NG = F.G * NTHR;
    for (int i = gt; i < nrows * 4; i += NG) { const int r = i >> 2, e = rt[RT_TOPI + i], v = (r % (F.G * NWAVES)) / NWAVES, s = off[e] + pre[v * 32 + e] + rt[RT_POS + i];
        rt[RT_SLOT + i] = s; rt[RT_LIST + s] = r; ((float*)rt)[RT_SGATE + s] = ((const float*)rt)[RT_TOPG + i]; }
    const int total = off[32];
    for (int s = gt; s < total; s += NG) { int e = 0;
#pragma unroll 1
        for (int q = 1; q < NEXP; ++q) if (s >= off[q]) e = q;
        if (s - off[e] >= off[64 + e]) { rt[RT_LIST + s] = NTOK; ((float*)rt)[RT_SGATE + s] = 0.f; }
        if ((s & 255) == 0) rt[RT_TILEE + 8 + (s >> 8)] = e; }
    if (gt == 0) rt[RT_TILEE] = total >> 8;
}

__device__ __forceinline__ void ph_conv(Frame& F, CArgs& A, int l) {
    LAS float* cw = (LAS float*)F.lds;
    { const f32x4* wm = (const f32x4*)(A.in[I_MLCONV] + (size_t)l * 9 * 512); const f32x4* wh = (const f32x4*)(A.in[I_HGCONV] + (size_t)l * 9 * 1024);
      f32x4 vm[3], vh[5];
#pragma unroll
      for (int j = 0; j < 3; ++j) { const int i = F.tid + NTHR * j; vm[j] = i < 9 * 128 ? wm[i] : (f32x4){0.f, 0.f, 0.f, 0.f}; }
#pragma unroll
      for (int j = 0; j < 5; ++j) { const int i = F.tid + NTHR * j; vh[j] = i < 9 * 256 ? wh[i] : (f32x4){0.f, 0.f, 0.f, 0.f}; }
#pragma unroll
      for (int j = 0; j < 3; ++j) { const int i = F.tid + NTHR * j; if (i < 9 * 128) *(LAS f32x4*)(cw + (i / 128) * 1536 + (i % 128) * 4) = vm[j]; }
#pragma unroll
      for (int j = 0; j < 5; ++j) { const int i = F.tid + NTHR * j; if (i < 9 * 256) *(LAS f32x4*)(cw + (i / 256) * 1536 + 512 + (i % 256) * 4) = vh[j]; } }
    __syncthreads();
    const bf16* P = (const bf16*)(F.ws + WS_P);
    const int gt = F.vcu * NTHR + F.tid, NG = F.G * NTHR;
    constexpr int NLATQ = BATCH * 128 * 16, NQ = NLATQ + BATCH * 64;
    for (int it = gt; it < NQ * 192; it += NG) {
        const int qd = it / 192, cg = it % 192, c = cg * 8, pc = c < 512 ? PC_QK + c : PC_QI + (c - 512);
        int base, row, x0, nrow, ncol;
        if (qd < NLATQ) { const int b = qd >> 11, y = (qd >> 4) & 127, xq = qd & 15; base = b << 13; row = y; x0 = xq * 4; nrow = 128; ncol = 64; }
        else { const int q = qd - NLATQ, b = q >> 6; base = NLAT + (b << 8); row = 0; x0 = (q & 63) * 4; nrow = 1; ncol = 256; }
        const int r0 = base + row * ncol + x0;
        u32x4 tap[3][6];
#pragma unroll
        for (int dy = 0; dy < 3; ++dy)
#pragma unroll
            for (int j = 0; j < 6; ++j) { const int rr = row + dy - 1, cc = x0 + j - 1; const bool v = rr >= 0 && rr < nrow && cc >= 0 && cc < ncol;
                const u32x4 t = *(const u32x4*)(P + (size_t)(v ? base + rr * ncol + cc : r0) * PW + pc);
                tap[dy][j] = v ? t : (u32x4){0u, 0u, 0u, 0u}; }
        f32x2_t a2[4][4];
#pragma unroll
        for (int o = 0; o < 4; ++o)
#pragma unroll
            for (int i = 0; i < 4; ++i) a2[o][i] = (f32x2_t){0.f, 0.f};
#pragma unroll
        for (int dy = 0; dy < 3; ++dy)
#pragma unroll
            for (int dx = 0; dx < 3; ++dx) { const LAS float* w = cw + (dy * 3 + dx) * 1536 + c; const f32x4 w0 = *(const LAS f32x4*)w, w1 = *(const LAS f32x4*)(w + 4);
                const f32x2_t wa = {w0.x, w0.y}, wb = {w0.z, w0.w}, wc = {w1.x, w1.y}, wd = {w1.z, w1.w};
#pragma unroll
                for (int o = 0; o < 4; ++o) { const u32x4 pv = tap[dy][o + dx];
                    a2[o][0] += (f32x2_t){bflo(pv.x), bfhi(pv.x)} * wa; a2[o][1] += (f32x2_t){bflo(pv.y), bfhi(pv.y)} * wb;
                    a2[o][2] += (f32x2_t){bflo(pv.z), bfhi(pv.z)} * wc; a2[o][3] += (f32x2_t){bflo(pv.w), bfhi(pv.w)} * wd; } }
        float a[4][8];
#pragma unroll
        for (int o = 0; o < 4; ++o)
#pragma unroll
            for (int i = 0; i < 4; ++i) { a[o][2 * i] = a2[o][i].x; a[o][2 * i + 1] = a2[o][i].y; }
        const float sc = c < 256 ? 0.125f : 1.f;
#pragma unroll
        for (int o = 0; o < 4; ++o) {
#pragma unroll
            for (int i = 0; i < 8; ++i) a[o][i] = siluf_(a[o][i]) * sc;
            const u32x4 ov = (u32x4){pk2(a[o][0], a[o][1]), pk2(a[o][2], a[o][3]), pk2(a[o][4], a[o][5]), pk2(a[o][6], a[o][7])};
            if (c < 512) *(u32x4*)(F.ws + WS_CQK + ((size_t)(r0 + o) * 512 + c) * 2) = ov; else *(u32x4*)(F.ws + WS_CQI + ((size_t)(r0 + o) * 1024 + (c - 512)) * 2) = ov; }
    }
}

struct HnIn { f32x4 h[4]; u32x2 g[4]; };
__device__ __forceinline__ void hn_load(Frame& F, int r, HnIn& R) {
    const float* HF = (const float*)(F.ws + WS_HF); const bf16* P = (const bf16*)(F.ws + WS_P);
#pragma unroll
    for (int j = 0; j < 4; ++j) { const int c = 256 * j + 4 * F.lane; R.h[j] = *(const f32x4*)(HF + (size_t)r * D + c); R.g[j] = *(const u32x2*)(P + (size_t)r * PW + (c < 512 ? PC_O + c : PC_GO + (c - 512))); }
}
__device__ __forceinline__ void ph_hnorm(Frame& F, CArgs& A, int l, int nrows_lat_only) {
    const int nrows = nrows_lat_only ? NLAT : NTOK, stride = F.G * NWAVES;
    int r = F.vcu * NWAVES + F.wave; HnIn cur; if (r < nrows) hn_load(F, r, cur);
    for (; r < nrows; r += stride) {
        HnIn nxt; if (r + stride < nrows) hn_load(F, r + stride, nxt); else nxt = cur;
        u32x2* yo = (u32x2*)(F.ws + WS_Y + (size_t)r * D * 2) + F.lane;
#pragma unroll
        for (int j = 0; j < 4; ++j) {
            const int c = 256 * j + 4 * F.lane;
            f32x4 h = cur.h[j];
            float ss = (h.x * h.x + h.y * h.y) + (h.z * h.z + h.w * h.w);
#pragma unroll
            for (int o = 1; o < 32; o <<= 1) ss += __shfl_xor(ss, o);
            const float rstd = rsqrtf(ss * (1.f / 128.f) + EPS);
            const f32x4 g = c < 512 ? *(const f32x4*)(A.in[I_MLNG] + l * 512 + c) : *(const f32x4*)(A.in[I_HGNG] + l * 512 + (c - 512));
            const u32x2 gw = cur.g[j];
            float ga[4] = {bflo(gw.x), bfhi(gw.x), bflo(gw.y), bfhi(gw.y)};
#pragma unroll
            for (int i = 0; i < 4; ++i) ga[i] = c < 512 ? sigmoidf_(ga[i]) : siluf_(ga[i]);
            h = h * rstd * g;
            yo[64 * j] = (u32x2){pk2(h.x * ga[0], h.y * ga[1]), pk2(h.z * ga[2], h.w * ga[3])};
        }
        cur = nxt;
    }
}

namespace pg8 {
typedef short bf16x8 __attribute__((ext_vector_type(8)));
constexpr int BM = 256, BK = 64, HALF = 128, HTB = HALF * BK * 2, STAGE_BYTES = 8 * HTB, NXCD = 8, WGM = 8;
__device__ __forceinline__ int lds_byte(int r, int c) { const int st = (r >> 4) * 2 + (c >> 5), rr = r & 15, cc = c & 31, ob = rr * 64 + cc * 2; return st * 1024 + (ob ^ (((ob >> 9) & 1) << 5)); }
__device__ __forceinline__ void stage_rc(int b, int& R, int& C) { const int st = b / 1024, sb = b % 1024, swz = sb ^ (((sb >> 9) & 1) << 5); R = (st >> 1) * 16 + swz / 64; C = (st & 1) * 32 + (swz % 64) / 2; }
__device__ __forceinline__ int perm32(int rho) { const int n = rho >> 4, i = rho & 15; return 8 * (i >> 2) + 4 * n + (i & 3); }
struct Unit { int pm, pn, e; };
struct Gemm { const bf16* A; const bf16* Bt; int K; const int* gather; const int* tile_e; size_t bexp;   };
struct StaticOrder {
    int nM, nN, nwg, G, c;
    __device__ void init(int nM_, int nN_, int G_, int c_) { nM = nM_; nN = nN_; nwg = nM * nN; G = G_; c = c_; }
    __device__ bool next(int i, Unit& u) const {
        const long L = (long)i * G + c; if (L >= nwg) return false;
        int wgid = (int)L; { const int q = nwg / NXCD, r = nwg % NXCD, xcd = wgid % NXCD, off = wgid / NXCD; wgid = (xcd < r ? xcd * (q + 1) : r * (q + 1) + (xcd - r) * q) + off; }
        const int nig = WGM * nN, gid = wgid / nig, fm = gid * WGM, gsz = (nM - fm) < WGM ? (nM - fm) : WGM;
        u.pm = fm + ((wgid % nig) % gsz); u.pn = (wgid % nig) / gsz; u.e = 0; return true;
    }
};
__device__ __forceinline__ unsigned cvt_pk_bf16(float lo, float hi) { unsigned r; asm volatile("v_cvt_pk_bf16_f32 %0, %1, %2" : "=v"(r) : "v"(lo), "v"(hi)); return r; }

struct EpiBf16 {
    static constexpr bool PERM = true;
    bf16* O; int ldc;
    __device__ __forceinline__ void operator()(const f32x4 (&acc)[2][2][4][2], const Unit& u, int wr, int wc, int fr, int fq) const {
        const int row0 = u.pm * BM + wr * 64 + fr, col0 = u.pn * BM + wc * 32 + 8 * fq;
#pragma unroll
        for (int ai = 0; ai < 2; ++ai)
#pragma unroll
            for (int m = 0; m < 4; ++m) { bf16* rowp = O + (size_t)(row0 + ai * HALF + m * 16) * ldc + col0;
#pragma unroll
                for (int bj = 0; bj < 2; ++bj) { const f32x4 v0 = acc[ai][bj][m][0], v1 = acc[ai][bj][m][1];
                    u32x4 w; w.x = cvt_pk_bf16(v0[0], v0[1]); w.y = cvt_pk_bf16(v0[2], v0[3]); w.z = cvt_pk_bf16(v1[0], v1[1]); w.w = cvt_pk_bf16(v1[2], v1[3]);
                    *(u32x4*)(rowp + bj * HALF) = w; } }
    }
};
struct EpiResid {
    static constexpr bool PERM = false;
    float* X; const float* MODg; const float* Slat; const float* Sctx;
    __device__ __forceinline__ void operator()(const f32x4 (&acc)[2][2][4][2], const Unit& u, int wr, int wc, int fr, int fq) const {
        const int row0 = u.pm * BM + wr * 64 + fr, col0 = u.pn * BM + wc * 32 + 4 * fq;
        const float* gp = MODg + mrow_of(u.pm * BM) * 6144 + col0;
        f32x4 gv[2][2];
#pragma unroll
        for (int bj = 0; bj < 2; ++bj)
#pragma unroll
            for (int n = 0; n < 2; ++n) gv[bj][n] = *(const f32x4*)(gp + bj * HALF + n * 16);
#pragma unroll
        for (int ai = 0; ai < 2; ++ai) {
            f32x4 xv[4][2][2];
#pragma unroll
            for (int m = 0; m < 4; ++m) { const int rr = row0 + ai * HALF + m * 16; const float* rowp = (rr < NLAT ? Slat + (size_t)rr * D : Sctx + (size_t)(rr - NLAT) * D) + col0;
#pragma unroll
                for (int bj = 0; bj < 2; ++bj)
#pragma unroll
                    for (int n = 0; n < 2; ++n) xv[m][bj][n] = *(const f32x4*)(rowp + bj * HALF + n * 16); }
#pragma unroll
            for (int m = 0; m < 4; ++m) { float* rowp = X + (size_t)(row0 + ai * HALF + m * 16) * D + col0;
#pragma unroll
                for (int bj = 0; bj < 2; ++bj)
#pragma unroll
                    for (int n = 0; n < 2; ++n) *(f32x4*)(rowp + bj * HALF + n * 16) = xv[m][bj][n] + gv[bj][n] * acc[ai][bj][m][n]; } }
    }
};
struct EpiSwiglu {
    static constexpr bool PERM = true;
    bf16* ACT; const float* bgu; const int* tile_e;
    __device__ __forceinline__ void operator()(const f32x4 (&acc)[2][2][4][2], const Unit& u, int wr, int wc, int fr, int fq) const {
        const int e = u.e;
        const int row0 = u.pm * BM + wr * 64 + fr, col0 = u.pn * HALF + wc * 32 + 8 * fq;
        const float* bp = bgu + (size_t)e * 2048 + col0;
        const f32x4 bg0 = *(const f32x4*)bp, bg1 = *(const f32x4*)(bp + 4), bl0 = *(const f32x4*)(bp + 1024), bl1 = *(const f32x4*)(bp + 1028);
#pragma unroll
        for (int ai = 0; ai < 2; ++ai)
#pragma unroll
            for (int m = 0; m < 4; ++m) {
                f32x4 g0 = acc[ai][0][m][0] + bg0, g1 = acc[ai][0][m][1] + bg1, l0 = acc[ai][1][m][0] + bl0, l1 = acc[ai][1][m][1] + bl1; float o[8];
#pragma unroll
                for (int i = 0; i < 4; ++i) { g0[i] = fminf(g0[i], 7.f); g1[i] = fminf(g1[i], 7.f); l0[i] = fminf(fmaxf(l0[i], -7.f), 7.f); l1[i] = fminf(fmaxf(l1[i], -7.f), 7.f); }
                const f32x4 t0 = g0 * (-1.702f * 1.44269504f), t1 = g1 * (-1.702f * 1.44269504f);
                f32x4 e0, e1;
#pragma unroll
                for (int i = 0; i < 4; ++i) { e0[i] = __builtin_amdgcn_exp2f(t0[i]); e1[i] = __builtin_amdgcn_exp2f(t1[i]); }
                e0 = e0 + 1.f; e1 = e1 + 1.f;
#pragma unroll
                for (int i = 0; i < 4; ++i) { e0[i] = __builtin_amdgcn_rcpf(e0[i]); e1[i] = __builtin_amdgcn_rcpf(e1[i]); }
                const f32x4 r0 = (g0 * e0) * (l0 + 1.f), r1 = (g1 * e1) * (l1 + 1.f);
#pragma unroll
                for (int i = 0; i < 4; ++i) { o[i] = r0[i]; o[4 + i] = r1[i]; }
                u32x4 w; w.x = cvt_pk_bf16(o[0], o[1]); w.y = cvt_pk_bf16(o[2], o[3]); w.z = cvt_pk_bf16(o[4], o[5]); w.w = cvt_pk_bf16(o[6], o[7]);
                *(u32x4*)(ACT + (size_t)(row0 + ai * HALF + m * 16) * DEXP + col0) = w; }
    }
};
struct EpiDown {
    static constexpr bool PERM = true;
    bf16* YS; const float* bdn; const float* sgate; const int* tile_e;
    __device__ __forceinline__ void operator()(const f32x4 (&acc)[2][2][4][2], const Unit& u, int wr, int wc, int fr, int fq) const {
        const int e = u.e;
        const int row0 = u.pm * BM + wr * 64 + fr, col0 = u.pn * BM + wc * 32 + 8 * fq;
        f32x4 bv[2][2];
#pragma unroll
        for (int bj = 0; bj < 2; ++bj)
#pragma unroll
            for (int n = 0; n < 2; ++n) bv[bj][n] = *(const f32x4*)(bdn + (size_t)e * D + col0 + bj * HALF + 4 * n);
#pragma unroll
        for (int ai = 0; ai < 2; ++ai)
#pragma unroll
            for (int m = 0; m < 4; ++m) { const int row = row0 + ai * HALF + m * 16; const float sg = sgate[row]; bf16* rowp = YS + (size_t)row * D + col0;
#pragma unroll
                for (int bj = 0; bj < 2; ++bj) { const f32x4 v0 = (acc[ai][bj][m][0] + bv[bj][0]) * sg, v1 = (acc[ai][bj][m][1] + bv[bj][1]) * sg;
                    u32x4 w; w.x = cvt_pk_bf16(v0[0], v0[1]); w.y = cvt_pk_bf16(v0[2], v0[3]); w.z = cvt_pk_bf16(v1[0], v1[1]); w.w = cvt_pk_bf16(v1[2], v1[3]);
                    *(u32x4*)(rowp + bj * HALF) = w; } }
    }
};

template <class Epi, class Sched, bool ALIGN_EPI>
__device__ __forceinline__ void gemm_phase(LAS unsigned char* lds, const Gemm g, const Sched& S, const Epi& E, const int tid) {
    const int wid = __builtin_amdgcn_readfirstlane(tid >> 6), lane = tid & 63, wr = wid >> 2, wc = wid & 3, fr = lane & 15, fq = lane >> 4;
    const int K = g.K, nt = K / BK;
    int RA[2]; unsigned cbA[2], voffB[2];
#pragma unroll
    for (int i = 0; i < 2; ++i) { int R, C; stage_rc(tid * 16 + i * 8192, R, C); const int Rb = Epi::PERM ? ((R & ~31) + perm32(R & 31)) : R;
        RA[i] = R; cbA[i] = (unsigned)C * 2u; voffB[i] = (unsigned)(Rb * K + C) * 2u; }
    const size_t kstep = (size_t)(BK * 2);
    const size_t hstep = (size_t)HALF * K * 2;
    const size_t tstep = 2 * hstep;
    const unsigned ldsw = (unsigned)wid * 1024u;
    const int aoff = lds_byte(wr * 64 + fr, fq * 8), boff = lds_byte(wc * 32 + fr, fq * 8);
#define PG8_SA(b, h) (((b) * 2 + (h)) * HTB)
#define PG8_SB(b, h) ((4 + (b) * 2 + (h)) * HTB)
#define PG8_STAGE(bufoff, gbase, voff) do { _Pragma("unroll") for (int _i = 0; _i < 2; ++_i) \
        __builtin_amdgcn_global_load_lds((const unsigned*)((const char*)(gbase) + (voff)[_i]), (LAS unsigned*)(lds + (bufoff) + ldsw + _i * 8192), 16, 0, 0); } while (0)
#define PG8_LDA(dst, b, h) do { _Pragma("unroll") for (int m = 0; m < 4; ++m) _Pragma("unroll") for (int k = 0; k < 2; ++k) dst[m][k] = *(const LAS bf16x8*)(lds + PG8_SA(b, h) + aoff + m * 2048 + k * 1024); } while (0)
#define PG8_LDB(dst, b, h) do { _Pragma("unroll") for (int n = 0; n < 2; ++n) _Pragma("unroll") for (int k = 0; k < 2; ++k) dst[n][k] = *(const LAS bf16x8*)(lds + PG8_SB(b, h) + boff + n * 2048 + k * 1024); } while (0)
#define PG8_MMA(ai, bj, At, Bt) do { __builtin_amdgcn_s_setprio(1); _Pragma("unroll") for (int m = 0; m < 4; ++m) _Pragma("unroll") for (int n = 0; n < 2; ++n) _Pragma("unroll") for (int k = 0; k < 2; ++k) \
        acc[ai][bj][m][n] = __builtin_amdgcn_mfma_f32_16x16x32_bf16(Bt[n][k], At[m][k], acc[ai][bj][m][n], 0, 0, 0); __builtin_amdgcn_s_setprio(0); } while (0)
#define PG8_WAIT_V(n) asm volatile("s_waitcnt vmcnt(" #n ")" ::: "memory")
#define PG8_WAIT_L(n) asm volatile("s_waitcnt lgkmcnt(" #n ")" ::: "memory")
#define PG8_BAR __builtin_amdgcn_s_barrier()
#define PG8_SCHED __builtin_amdgcn_sched_barrier(0)
#define PG8_AOFF(va, u) do { _Pragma("unroll") for (int _h = 0; _h < 2; ++_h) _Pragma("unroll") for (int _i = 0; _i < 2; ++_i) { const int _r = (u).pm * BM + _h * HALF + RA[_i]; \
        const int _row = g.gather ? g.gather[_r] : _r; va[_h][_i] = (unsigned)_row * (unsigned)(K * 2) + cbA[_i]; } } while (0)
#define PG8_BBASE(u) ((u).e = g.tile_e ? g.tile_e[8 + (u).pm] : 0, (const char*)g.Bt + (size_t)(u).e * g.bexp * 2 + (size_t)(u).pn * tstep)
    Unit cur, nxt; int ui = 0;
    if (!S.next(0, cur)) return;
    f32x4 acc[2][2][4][2];
#pragma unroll
    for (int a = 0; a < 2; ++a)
#pragma unroll
        for (int b = 0; b < 2; ++b)
#pragma unroll
            for (int m = 0; m < 4; ++m)
#pragma unroll
                for (int n = 0; n < 2; ++n) acc[a][b][m][n] = (f32x4){0.f, 0.f, 0.f, 0.f};
    bf16x8 At[4][2], B0[2][2], B1[2][2];
    const char* Ab = (const char*)g.A;
    unsigned cva[2][2], nva[2][2];
    PG8_AOFF(cva, cur);
    const char* cB = PG8_BBASE(cur);
    PG8_STAGE(PG8_SB(0, 0), cB, voffB); PG8_STAGE(PG8_SB(0, 1), cB + hstep, voffB); PG8_STAGE(PG8_SA(0, 0), Ab, cva[0]); PG8_STAGE(PG8_SA(0, 1), Ab, cva[1]);
    if (wr == 1) PG8_BAR;
    PG8_WAIT_V(2); PG8_BAR;
    PG8_STAGE(PG8_SB(1, 0), cB + kstep, voffB); PG8_STAGE(PG8_SA(1, 0), Ab + kstep, cva[0]); PG8_STAGE(PG8_SB(1, 1), cB + hstep + kstep, voffB);
    PG8_WAIT_V(6); PG8_BAR;
    for (;;) {
        const bool has_next = S.next(ui + 1, nxt);
        const char* nB = cB;
        if (has_next) { PG8_AOFF(nva, nxt); nB = PG8_BBASE(nxt); }
        else {
#pragma unroll
            for (int h = 0; h < 2; ++h)
#pragma unroll
                for (int i = 0; i < 2; ++i) nva[h][i] = cva[h][i]; }
        for (int t = 0; t < nt; t += 2) {
            const bool last = (t == nt - 2);
            const char* a1 = Ab + (size_t)(t + 1) * kstep;
            const char* a2 = last ? Ab : Ab + (size_t)(t + 2) * kstep; const char* b2 = last ? nB : cB + (size_t)(t + 2) * kstep;
            const char* a3 = a2 + kstep; const char* b3 = b2 + kstep;
            unsigned s2[2][2];
#pragma unroll
            for (int h = 0; h < 2; ++h)
#pragma unroll
                for (int i = 0; i < 2; ++i) s2[h][i] = last ? nva[h][i] : cva[h][i];
            PG8_LDB(B0, 0, 0); PG8_LDB(B1, 0, 1); PG8_SCHED; PG8_LDA(At, 0, 0); PG8_STAGE(PG8_SA(1, 1), a1, cva[1]);
            PG8_WAIT_V(8); PG8_WAIT_L(0); PG8_BAR; PG8_MMA(0, 0, At, B0); PG8_MMA(0, 1, At, B1); PG8_BAR; PG8_SCHED;
            PG8_LDA(At, 0, 1); PG8_STAGE(PG8_SB(0, 0), b2, voffB); PG8_STAGE(PG8_SB(0, 1), b2 + hstep, voffB); PG8_STAGE(PG8_SA(0, 0), a2, s2[0]);
            PG8_WAIT_V(8); PG8_WAIT_L(0); PG8_BAR; PG8_MMA(1, 0, At, B0); PG8_MMA(1, 1, At, B1); PG8_BAR; PG8_SCHED;
            PG8_LDB(B0, 1, 0); PG8_LDB(B1, 1, 1); PG8_SCHED; PG8_LDA(At, 1, 0); PG8_STAGE(PG8_SA(0, 1), a2, s2[1]);
            PG8_WAIT_V(8); PG8_WAIT_L(0); PG8_BAR; PG8_MMA(0, 0, At, B0); PG8_MMA(0, 1, At, B1); PG8_BAR; PG8_SCHED;
            PG8_LDA(At, 1, 1); PG8_STAGE(PG8_SB(1, 0), b3, voffB); PG8_STAGE(PG8_SB(1, 1), b3 + hstep, voffB); PG8_STAGE(PG8_SA(1, 0), a3, s2[0]);
            PG8_WAIT_V(8); PG8_WAIT_L(0); PG8_BAR; PG8_MMA(1, 0, At, B0); PG8_MMA(1, 1, At, B1); PG8_BAR; PG8_SCHED;
        }
        if constexpr (ALIGN_EPI) { if (wr == 0) PG8_BAR; }
        E(acc, cur, wr, wc, fr, fq);
        if (!has_next) break;
#pragma unroll
        for (int a = 0; a < 2; ++a)
#pragma unroll
            for (int b = 0; b < 2; ++b)
#pragma unroll
                for (int m = 0; m < 4; ++m)
#pragma unroll
                    for (int n = 0; n < 2; ++n) acc[a][b][m][n] = (f32x4){0.f, 0.f, 0.f, 0.f};
        cur = nxt; cB = nB; ++ui;
#pragma unroll
        for (int h = 0; h < 2; ++h)
#pragma unroll
            for (int i = 0; i < 2; ++i) cva[h][i] = nva[h][i];
        if constexpr (ALIGN_EPI) { if (wr == 1) PG8_BAR; }
    }
    PG8_WAIT_V(0);
    if constexpr (!ALIGN_EPI) { if (wr == 0) PG8_BAR; }
    PG8_BAR;
#undef PG8_SA
#undef PG8_SB
#undef PG8_STAGE
#undef PG8_LDA
#undef PG8_LDB
#undef PG8_MMA
#undef PG8_WAIT_V
#undef PG8_WAIT_L
#undef PG8_BAR
#undef PG8_SCHED
#undef PG8_AOFF
#undef PG8_BBASE
}
}


typedef short bf16x8_t __attribute__((ext_vector_type(8)));
typedef float f32x16 __attribute__((ext_vector_type(16)));
template <int K>
__device__ __forceinline__ void mm32(f32x16& acc, const LAS unsigned char* A, int sa, const LAS unsigned char* B, int sb, int lane) {
    const LAS unsigned char* ap = A + (lane & 31) * sa + (lane >> 5) * 16;
    const LAS unsigned char* bp = B + (lane & 31) * sb + (lane >> 5) * 16;
#pragma unroll
    for (int k0 = 0; k0 < K / 16; k0 += 4) {
        bf16x8_t a[4], b[4];
#pragma unroll
        for (int k = 0; k < 4; ++k) { a[k] = *(const LAS bf16x8_t*)(ap + (k0 + k) * 32); b[k] = *(const LAS bf16x8_t*)(bp + (k0 + k) * 32); }
#pragma unroll
        for (int k = 0; k < 4; ++k) acc = __builtin_amdgcn_mfma_f32_32x32x16_bf16(a[k], b[k], acc, 0, 0, 0);
    }
}
__device__ __forceinline__ int rowmap(int reg, int hi) { return (reg & 3) + 8 * (reg >> 2) + 4 * hi; }
__device__ __forceinline__ int chunk_row0(int b, int tc) { return tc < 4 ? NLAT + b * CTX + tc * 64 : b * SEQ + (tc - 4) * 64; }
constexpr int ST64 = 144, ST128 = 272;


__device__ __forceinline__ void touch(unsigned& x) { asm volatile("" : "+v"(x)); }
__device__ __forceinline__ void touch(float& x) { asm volatile("" : "+v"(x)); }
__device__ __forceinline__ void touch(u32x4& x) { asm volatile("" : "+v"(x)); }
struct VtRaw { unsigned w[8]; };
__device__ __forceinline__ void vt_load(VtRaw& R, const bf16* src, int pitch, int row0, int col0, int tid) {
    const int cp = tid & 63, tg = tid >> 6;
#pragma unroll
    for (int i = 0; i < 8; ++i) R.w[i] = *(const unsigned*)(src + (size_t)(row0 + tg * 8 + i) * pitch + col0 + 2 * cp);
}
__device__ __forceinline__ void vt_store(LAS unsigned char* VT, const VtRaw& R, int tid) {
    const int cp = tid & 63, tg = tid >> 6; unsigned lo[4], hi[4];
#pragma unroll
    for (int i = 0; i < 4; ++i) { const unsigned w0 = R.w[2 * i], w1 = R.w[2 * i + 1]; lo[i] = (w0 & 0xffffu) | (w1 << 16); hi[i] = (w0 >> 16) | (w1 & 0xffff0000u); }
    *(LAS u32x4*)(VT + (2 * cp) * ST64 + tg * 16) = (u32x4){lo[0], lo[1], lo[2], lo[3]};
    *(LAS u32x4*)(VT + (2 * cp + 1) * ST64 + tg * 16) = (u32x4){hi[0], hi[1], hi[2], hi[3]};
}
struct TaskId { int b, h, tc, row0, sidf; };
__device__ __forceinline__ TaskId task_id(int task) { TaskId t; t.b = task / (4 * NTC); t.h = (task / NTC) & 3; t.tc = task % NTC; t.row0 = chunk_row0(t.b, t.tc); t.sidf = (t.b * 4 + t.h) * 2; return t; }

struct MlARaw { VtRaw v; unsigned kw[4]; float g[4]; };
__device__ __forceinline__ void touch(MlARaw& R) {
#pragma unroll
    for (int i = 0; i < 8; ++i) touch(R.v.w[i]);
#pragma unroll
    for (int i = 0; i < 4; ++i) { touch(R.kw[i]); touch(R.g[i]); } }
__device__ __forceinline__ void ml_passA_load(Frame& F, int task, MlARaw& R) {
    const TaskId T = task_id(task);
    vt_load(R.v, (const bf16*)(F.ws + WS_P), PW, T.row0, PC_V + T.h * 128, F.tid);
    { const int cp = F.tid & 31, tg = F.tid >> 5; const bf16* CQK = (const bf16*)(F.ws + WS_CQK);
#pragma unroll
      for (int i = 0; i < 4; ++i) R.kw[i] = *(const unsigned*)(CQK + (size_t)(T.row0 + tg * 4 + i) * 512 + 256 + T.h * 64 + 2 * cp); }
    if (F.wave == 0) { const float* gp = (const float*)(F.ws + WS_GATES) + (size_t)(T.row0 + F.lane) * 16; R.g[0] = gp[T.h]; R.g[1] = gp[4 + T.h]; R.g[2] = gp[8 + T.h]; R.g[3] = gp[12 + T.h]; }
}
__device__ __forceinline__ void ml_passA_run(Frame& F, int task, const MlARaw& R) {
    const TaskId T = task_id(task); const int tc = T.tc, sidf = T.sidf;
    LAS unsigned char* VT = F.lds; LAS unsigned char* KT = F.lds + 18432;
    LAS float* wts = (LAS float*)(F.lds + 36864);
    float* MLS = (float*)(F.ws + WS_MLS);
    LDS_BARRIER();
    if (F.wave == 0) { const int s = F.lane;
        const float igf = R.g[0], igb = R.g[1], lff = R.g[2], lfb = R.g[3];
        const float pf = wave_incl_sum(lff, s), gf = __builtin_bit_cast(float, __builtin_amdgcn_readlane(__builtin_bit_cast(int, pf), 63)), ef = (gf - pf) + igf, mf = wave_max(ef);
        const float pb = wave_incl_sum(lfb, s), gb = __builtin_bit_cast(float, __builtin_amdgcn_readlane(__builtin_bit_cast(int, pb), 63)), eb = (pb - lfb) + igb, mb = wave_max(eb);
        wts[s] = __expf(ef - mf); wts[64 + s] = __expf(eb - mb);
        if (s == 0) { float* o = MLS + (size_t)(sidf * NTC + tc) * 4; o[0] = gf; o[1] = mf; o = MLS + (size_t)((sidf + 1) * NTC + tc) * 4; o[0] = gb; o[1] = mb; } }
    vt_store(VT, R.v, F.tid);
    LDS_BARRIER();
    { const int cp = F.tid & 31, tg = F.tid >> 5;
#pragma unroll
      for (int dir = 0; dir < 2; ++dir) { float lo[4], hi[4];
#pragma unroll
          for (int i = 0; i < 4; ++i) { const float w = wts[dir * 64 + tg * 4 + i]; lo[i] = bflo(R.kw[i]) * w; hi[i] = bfhi(R.kw[i]) * w; }
          *(LAS u32x2*)(KT + dir * 9216 + (2 * cp) * ST64 + tg * 8) = (u32x2){pk2(lo[0], lo[1]), pk2(lo[2], lo[3])};
          *(LAS u32x2*)(KT + dir * 9216 + (2 * cp + 1) * ST64 + tg * 8) = (u32x2){pk2(hi[0], hi[1]), pk2(hi[2], hi[3])}; } }
    LDS_BARRIER();
    { const int dir = F.wave >> 2, mt = F.wave & 3; bf16* C = (bf16*)(F.ws + WS_MLC) + (size_t)((sidf + dir) * NTC + tc) * 8192;
#pragma unroll
      for (int nt = 0; nt < 2; ++nt) { f32x16 acc;
#pragma unroll
          for (int i = 0; i < 16; ++i) acc[i] = 0.f;
          mm32<64>(acc, VT + 32 * mt * ST64, ST64, KT + dir * 9216 + 32 * nt * ST64, ST64, F.lane);
#pragma unroll
          for (int r = 0; r < 16; ++r) C[(32 * mt + rowmap(r, F.lane >> 5)) * 64 + 32 * nt + (F.lane & 31)] = (bf16)f2bf(acc[r]); } }
    if (F.tid < 128) { const int dir = F.tid >> 6, d = F.tid & 63; const LAS unsigned char* rp = KT + dir * 9216 + d * ST64; float sum = 0.f;
#pragma unroll
        for (int i = 0; i < 8; ++i) { const u32x4 w = *(const LAS u32x4*)(rp + i * 16); sum += (bflo(w.x) + bfhi(w.x)) + (bflo(w.y) + bfhi(w.y)) + (bflo(w.z) + bfhi(w.z)) + (bflo(w.w) + bfhi(w.w)); }
        ((float*)(F.ws + WS_MLN))[(size_t)((sidf + dir) * NTC + tc) * 64 + d] = sum; }
}
__device__ __forceinline__ int tc_seq(int dir, int j) { return dir == 0 ? j : (j < 4 ? 3 - j : 135 - j); }
__device__ __forceinline__ void scan_passB(Frame& F) {
    const float* GG = (const float*)(F.ws + WS_HGG); float* MLS = (float*)(F.ws + WS_MLS);
    const int t = F.tid;
    if (t < 128) {
        for (int item = F.vcu * 128 + t; item < 16 * 2048; item += F.G * 128) {
            const int scan = item >> 11, e = (item & 2047) * 8, dir = scan & 1, d = e & 127;
            const u32x4* base = (const u32x4*)((const bf16*)(F.ws + WS_HGS) + (size_t)scan * NTC * 16384 + e); u32x4* ob = (u32x4*)((bf16*)(F.ws + WS_HGSB) + (size_t)scan * NTC * 16384 + e);
            const f32x4* gb = (const f32x4*)(GG + (size_t)scan * NTC * 128 + d);
            float st[8];
#pragma unroll
            for (int k = 0; k < 8; ++k) st[k] = 0.f;
            for (int j0 = 0; j0 < NTC; j0 += 11) {
                u32x4 dv[11]; f32x4 g0[11], g1[11];
#pragma unroll
                for (int i = 0; i < 11; ++i) { const int tc = tc_seq(dir, j0 + i); dv[i] = base[(size_t)tc * 2048]; g0[i] = gb[tc * 32]; g1[i] = gb[tc * 32 + 1]; }
#pragma unroll
                for (int i = 0; i < 11; ++i) { const int tc = tc_seq(dir, j0 + i);
                    ob[(size_t)tc * 2048] = (u32x4){pk2(st[0], st[1]), pk2(st[2], st[3]), pk2(st[4], st[5]), pk2(st[6], st[7])};
                    const f32x4 ta = g0[i] * 1.44269504f, tb = g1[i] * 1.44269504f;
                    const f32x2_t e0 = {__builtin_amdgcn_exp2f(ta.x), __builtin_amdgcn_exp2f(ta.y)}, e1 = {__builtin_amdgcn_exp2f(ta.z), __builtin_amdgcn_exp2f(ta.w)}, e2 = {__builtin_amdgcn_exp2f(tb.x), __builtin_amdgcn_exp2f(tb.y)}, e3 = {__builtin_amdgcn_exp2f(tb.z), __builtin_amdgcn_exp2f(tb.w)};
                    const f32x2_t s0 = e0 * (f32x2_t){st[0], st[1]} + (f32x2_t){bflo(dv[i].x), bfhi(dv[i].x)}, s1 = e1 * (f32x2_t){st[2], st[3]} + (f32x2_t){bflo(dv[i].y), bfhi(dv[i].y)};
                    const f32x2_t s2 = e2 * (f32x2_t){st[4], st[5]} + (f32x2_t){bflo(dv[i].z), bfhi(dv[i].z)}, s3 = e3 * (f32x2_t){st[6], st[7]} + (f32x2_t){bflo(dv[i].w), bfhi(dv[i].w)};
                    st[0] = s0.x; st[1] = s0.y; st[2] = s1.x; st[3] = s1.y; st[4] = s2.x; st[5] = s2.y; st[6] = s3.x; st[7] = s3.y; }
            }
        }
    } else if (t < 192) {
        for (int item = F.vcu * 64 + (t - 128); item < 16 * 1024; item += F.G * 64) {
            const int scan = item >> 10, e = (item & 1023) * 8, dir = scan & 1;
            const u32x4* cb = (const u32x4*)((const bf16*)(F.ws + WS_MLC) + (size_t)scan * NTC * 8192 + e); u32x4* ob = (u32x4*)((bf16*)(F.ws + WS_MLCB) + (size_t)scan * NTC * 8192 + e);
            float m = 0.f, st[8];
#pragma unroll
            for (int k = 0; k < 8; ++k) st[k] = 0.f;
            for (int j0 = 0; j0 < NTC; j0 += 12) {
                u32x4 dv[12]; float gg[12], ml[12];
#pragma unroll
                for (int i = 0; i < 12; ++i) { const int tc = tc_seq(dir, j0 + i); dv[i] = cb[(size_t)tc * 1024]; const float* sp = MLS + (size_t)(scan * NTC + tc) * 4; gg[i] = sp[0]; ml[i] = sp[1]; }
#pragma unroll
                for (int i = 0; i < 12; ++i) { const int tc = tc_seq(dir, j0 + i);
                    const float mn = fmaxf(gg[i] + m, ml[i]), a = __expf(gg[i] + m - mn), w = __expf(ml[i] - mn);
                    if ((item & 1023) == 0) MLS[(size_t)(scan * NTC + tc) * 4 + 2] = m;
                    ob[(size_t)tc * 1024] = (u32x4){pk2(st[0], st[1]), pk2(st[2], st[3]), pk2(st[4], st[5]), pk2(st[6], st[7])};
                    const f32x2_t s0 = (f32x2_t){st[0], st[1]} * a + (f32x2_t){bflo(dv[i].x), bfhi(dv[i].x)} * w, s1 = (f32x2_t){st[2], st[3]} * a + (f32x2_t){bflo(dv[i].y), bfhi(dv[i].y)} * w;
                    const f32x2_t s2 = (f32x2_t){st[4], st[5]} * a + (f32x2_t){bflo(dv[i].z), bfhi(dv[i].z)} * w, s3 = (f32x2_t){st[6], st[7]} * a + (f32x2_t){bflo(dv[i].w), bfhi(dv[i].w)} * w;
                    st[0] = s0.x; st[1] = s0.y; st[2] = s1.x; st[3] = s1.y; st[4] = s2.x; st[5] = s2.y; st[6] = s3.x; st[7] = s3.y; m = mn; }
            }
        }
    } else if (t < 196) {
        for (int item = F.vcu * 4 + (t - 192); item < 16 * 64; item += F.G * 4) {
            const int scan = item >> 6, e = item & 63, dir = scan & 1; float* nb = (float*)(F.ws + WS_MLN) + (size_t)scan * NTC * 64 + e;
            float m = 0.f, s0 = 0.f;
            for (int j0 = 0; j0 < NTC; j0 += 12) {
                float dv[12];
#pragma unroll
                for (int i = 0; i < 12; ++i) dv[i] = nb[tc_seq(dir, j0 + i) * 64];
#pragma unroll
                for (int i = 0; i < 12; ++i) { const int tc = tc_seq(dir, j0 + i); const float* sp = MLS + (size_t)(scan * NTC + tc) * 4;
                    const float g = sp[0], ml = sp[1], mn = fmaxf(g + m, ml), a = __expf(g + m - mn), w = __expf(ml - mn);
                    nb[tc * 64] = s0; s0 = a * s0 + w * dv[i]; m = mn; }
            }
        }
    }
}
template <int MIX>
__device__ __forceinline__ void gate_load(Frame& F, int row0, int h, unsigned (&gate)[16]) {
    const int mt = F.wave >> 2, nt = F.wave & 3; const bf16* P = (const bf16*)(F.ws + WS_P) + (MIX == 0 ? PC_O : PC_GO) + h * 128 + 32 * nt + (F.lane & 31);
#pragma unroll
    for (int r = 0; r < 16; ++r) gate[r] = P[(size_t)(row0 + 32 * mt + rowmap(r, F.lane >> 5)) * PW];
}
template <int MIX>
__device__ __forceinline__ void head_epilogue(Frame& F, const float ng, const f32x16& hv, const unsigned (&gate)[16], LAS float* part, int row0, int h) {
    const int mt = F.wave >> 2, nt = F.wave & 3, lane = F.lane, hi = lane >> 5;
    float ps[16];
#pragma unroll
    for (int r = 0; r < 16; ++r) ps[r] = hv[r] * hv[r];
#pragma unroll
    for (int r = 0; r < 16; ++r) ps[r] = half_sum_hi(ps[r]);
    if ((lane & 31) == 31) {
#pragma unroll
        for (int r = 0; r < 16; ++r) part[(32 * mt + rowmap(r, hi)) * 4 + nt] = ps[r]; }
    LDS_BARRIER();
    bf16* Y = (bf16*)(F.ws + WS_Y) + (MIX == 0 ? 0 : 512) + h * 128 + 32 * nt + (lane & 31);
#pragma unroll
    for (int r = 0; r < 16; r += 2) { const int t0 = 32 * mt + rowmap(r, hi), t1 = 32 * mt + rowmap(r + 1, hi); const f32x4 p4 = *(const LAS f32x4*)(part + t0 * 4), q4 = *(const LAS f32x4*)(part + t1 * 4);
        const f32x2_t ms = (f32x2_t){(p4.x + p4.y) + (p4.z + p4.w), (q4.x + q4.y) + (q4.z + q4.w)} * (1.f / 128.f) + EPS;
        const f32x2_t rstd = {__builtin_amdgcn_rsqf(ms.x), __builtin_amdgcn_rsqf(ms.y)}, gz = {bf2f((unsigned short)gate[r]), bf2f((unsigned short)gate[r + 1])};
        const f32x2_t te = gz * (-1.44269504f), dn = (f32x2_t){__builtin_amdgcn_exp2f(te.x), __builtin_amdgcn_exp2f(te.y)} + 1.f;
        const f32x2_t sg = {__builtin_amdgcn_rcpf(dn.x), __builtin_amdgcn_rcpf(dn.y)}, gv = MIX == 0 ? sg : gz * sg;
        const f32x2_t y = ((f32x2_t){hv[r], hv[r + 1]} * rstd) * (gv * ng); const unsigned w = pk2(y.x, y.y);
        Y[(size_t)(row0 + t0) * D] = (bf16)w; Y[(size_t)(row0 + t1) * D] = (bf16)(w >> 16); }
}
struct MlCRaw { VtRaw v; u32x4 q, k; u32x4 cf[2]; float g0, g1, ms; };
__device__ __forceinline__ void touch(MlCRaw& R) {
#pragma unroll
    for (int i = 0; i < 8; ++i) touch(R.v.w[i]);
    touch(R.q); touch(R.k); touch(R.cf[0]); touch(R.cf[1]); touch(R.g0); touch(R.g1); touch(R.ms); }
__device__ __forceinline__ void ml_passC_load(Frame& F, int task, MlCRaw& R) {
    const TaskId T = task_id(task); const bf16* CQK = (const bf16*)(F.ws + WS_CQK);
    vt_load(R.v, (const bf16*)(F.ws + WS_P), PW, T.row0, PC_V + T.h * 128, F.tid);
    { const int row = F.tid >> 3, pc = F.tid & 7;
      R.q = *(const u32x4*)(CQK + (size_t)(T.row0 + row) * 512 + T.h * 64 + pc * 8); R.k = *(const u32x4*)(CQK + (size_t)(T.row0 + row) * 512 + 256 + T.h * 64 + pc * 8); }
    { const u32x4* cp = (const u32x4*)((const bf16*)(F.ws + WS_MLCB) + (size_t)(T.sidf * NTC + T.tc) * 8192 + (F.tid >> 2) * 64 + (F.tid & 3) * 16); R.cf[0] = cp[0]; R.cf[1] = cp[1]; }
    R.g0 = 0.f; R.g1 = 0.f; R.ms = 0.f;
    if (F.wave < 2) { const int dir = F.wave; const float* gp = (const float*)(F.ws + WS_GATES) + (size_t)(T.row0 + F.lane) * 16; R.g0 = gp[dir * 4 + T.h]; R.g1 = gp[8 + dir * 4 + T.h];
        R.ms = ((const float*)(F.ws + WS_MLS))[(size_t)((T.sidf + dir) * NTC + T.tc) * 4 + 2]; }
}
__device__ __forceinline__ void ml_passC_run(Frame& F, CArgs& A, int l, int task, const MlCRaw& R) {
    const TaskId T = task_id(task); const int h = T.h, tc = T.tc, row0 = T.row0, sidf = T.sidf;
    if (l == DEPTH - 1 && tc < 4) return;
    unsigned gate[16];
    const float ng = A.in[I_MLNG][l * 512 + h * 128 + 32 * (F.wave & 3) + (F.lane & 31)];
    LAS unsigned char* Q = F.lds; LAS unsigned char* Kn = F.lds + 9216; LAS unsigned char* VT = F.lds + 18432; LAS unsigned char* Cs = F.lds + 36864;
    LAS unsigned char* Pm = F.lds + 55296; LAS unsigned char* Qs = F.lds + 64512;
    LAS float* sm = (LAS float*)(F.lds + 73728);
    const int tid = F.tid, lane = F.lane;
    u32x4 cb[2]; { const u32x4* cp = (const u32x4*)((const bf16*)(F.ws + WS_MLCB) + (size_t)((sidf + 1) * NTC + tc) * 8192 + (tid >> 2) * 64 + (tid & 3) * 16); cb[0] = cp[0]; cb[1] = cp[1]; }
    float nv = 0.f; if (tid < 128) nv = ((const float*)(F.ws + WS_MLN))[(size_t)((sidf + (tid >> 6)) * NTC + tc) * 64 + (tid & 63)];
    LDS_BARRIER();
    { const int row = tid >> 3, pc = tid & 7; *(LAS u32x4*)(Q + row * ST64 + pc * 16) = R.q; *(LAS u32x4*)(Kn + row * ST64 + pc * 16) = R.k; }
    vt_store(VT, R.v, tid);
    if (tid < 128) sm[512 + tid] = nv;
    if (F.wave < 2) { const int dir = F.wave, s = lane; const float ig = R.g0, lf = R.g1, ms = R.ms;
        float bt, u, pm;
        if (dir == 0) { bt = wave_incl_sum(lf, s); u = ig - bt; pm = wave_incl_max(u, s); }
        else { const float pf = wave_incl_sum(lf, s), tot = __builtin_bit_cast(float, __builtin_amdgcn_readlane(__builtin_bit_cast(int, pf), 63)); bt = tot - pf + lf; u = ig - bt;
               float r = __shfl(u, 63 - s); r = wave_incl_max(r, s); pm = __shfl(r, 63 - s); }
        const float M = fmaxf(ms, pm);
        LAS float* o = sm + dir * 256; o[s] = u; o[64 + s] = M; o[128 + s] = __expf(ms - M); o[192 + s] = __expf(-(bt + M)); }
    LDS_BARRIER();
    f32x16 qk;
#pragma unroll
    for (int i = 0; i < 16; ++i) qk[i] = 0.f;
    if (F.wave < 4) mm32<64>(qk, Q + 32 * (F.wave >> 1) * ST64, ST64, Kn + 32 * (F.wave & 1) * ST64, ST64, lane);
    f32x16 hs;
#pragma unroll
    for (int i = 0; i < 16; ++i) hs[i] = 0.f;
#pragma unroll 1
    for (int dir = 0; dir < 2; ++dir) {
        const LAS float* sd = sm + dir * 256;
        { const int v = tid >> 2, pc = tid & 3; *(LAS u32x4*)(Cs + v * ST64 + pc * 32) = dir == 0 ? R.cf[0] : cb[0]; *(LAS u32x4*)(Cs + v * ST64 + pc * 32 + 16) = dir == 0 ? R.cf[1] : cb[1]; }
        { const int row = tid >> 3, pc = tid & 7; const u32x4 q = R.q; const float w = sd[128 + row];
          *(LAS u32x4*)(Qs + row * ST64 + pc * 16) = (u32x4){pk2(bflo(q.x) * w, bfhi(q.x) * w), pk2(bflo(q.y) * w, bfhi(q.y) * w), pk2(bflo(q.z) * w, bfhi(q.z) * w), pk2(bflo(q.w) * w, bfhi(q.w) * w)}; }
        if (F.wave < 4) { const int s = 32 * (F.wave & 1) + (lane & 31); const float us = sd[s]; float Mt[16];
#pragma unroll
            for (int r = 0; r < 16; ++r) Mt[r] = sd[64 + 32 * (F.wave >> 1) + rowmap(r, lane >> 5)];
#pragma unroll
            for (int r = 0; r < 16; r += 2) { const int t0 = 32 * (F.wave >> 1) + rowmap(r, lane >> 5), t1 = 32 * (F.wave >> 1) + rowmap(r + 1, lane >> 5);
                const bool ok0 = dir == 0 ? (s <= t0) : (s >= t0), ok1 = dir == 0 ? (s <= t1) : (s >= t1);
                f32x2_t ex = (f32x2_t){us - Mt[r], us - Mt[r + 1]}; ex.x = fminf(ex.x, 0.f); ex.y = fminf(ex.y, 0.f); ex = ex * 1.44269504f;
                const f32x2_t p = (f32x2_t){qk[r], qk[r + 1]} * (f32x2_t){__builtin_amdgcn_exp2f(ex.x), __builtin_amdgcn_exp2f(ex.y)}; const unsigned w = pk2(ok0 ? p.x : 0.f, ok1 ? p.y : 0.f);
                *(LAS unsigned short*)(Pm + t0 * ST64 + s * 2) = (unsigned short)w; *(LAS unsigned short*)(Pm + t1 * ST64 + s * 2) = (unsigned short)(w >> 16); } }
        LDS_BARRIER();
        if (tid < 256) { const int t = tid >> 2, qd = tid & 3; float den = 0.f, qn = 0.f;
#pragma unroll
            for (int i = 0; i < 2; ++i) { const u32x4 w = *(const LAS u32x4*)(Pm + t * ST64 + qd * 32 + i * 16); den += (bflo(w.x) + bfhi(w.x)) + (bflo(w.y) + bfhi(w.y)) + (bflo(w.z) + bfhi(w.z)) + (bflo(w.w) + bfhi(w.w));
                const u32x4 q = *(const LAS u32x4*)(Q + t * ST64 + qd * 32 + i * 16); const LAS float* nvp = sm + 512 + dir * 64 + qd * 16 + i * 8; const f32x4 n0 = *(const LAS f32x4*)nvp, n1 = *(const LAS f32x4*)(nvp + 4);
                qn += (bflo(q.x) * n0.x + bfhi(q.x) * n0.y) + (bflo(q.y) * n0.z + bfhi(q.y) * n0.w) + (bflo(q.z) * n1.x + bfhi(q.z) * n1.y) + (bflo(q.w) * n1.z + bfhi(q.w) * n1.w); }
            den += sd[128 + t] * qn;
            den += dppf<0xB1, 0xf, true>(0.f, den); den += dppf<0x4E, 0xf, true>(0.f, den);
            if (qd == 0) sm[640 + t] = 1.f / fmaxf(fabsf(den), sd[192 + t]); }
        f32x16 acc;
#pragma unroll
        for (int i = 0; i < 16; ++i) acc[i] = 0.f;
        { const int mt = F.wave >> 2, nt = F.wave & 3;
          mm32<64>(acc, Pm + 32 * mt * ST64, ST64, VT + 32 * nt * ST64, ST64, lane);
          mm32<64>(acc, Qs + 32 * mt * ST64, ST64, Cs + 32 * nt * ST64, ST64, lane); }
        LDS_BARRIER();
        float dsc[16];
#pragma unroll
        for (int r = 0; r < 16; ++r) dsc[r] = sm[640 + 32 * (F.wave >> 2) + rowmap(r, lane >> 5)];
#pragma unroll
        for (int r = 0; r < 16; ++r) hs[r] += acc[r] * dsc[r];
        if (dir == 0) LDS_BARRIER();
    }
    gate_load<0>(F, row0, h, gate);
    head_epilogue<0>(F, ng, hs, gate, sm + 768, row0, h);
}

struct HgPrep { float k[16], x[16]; float T[4]; };
__device__ __forceinline__ void hg_zload(Frame& F, int h, int row0, int dir, unsigned (&z)[16]) {
    const int d = F.tid & 127, qtr = F.tid >> 7;
    const bf16* P = (const bf16*)(F.ws + WS_P) + (size_t)(row0 + qtr * 16) * PW + (dir == 0 ? PC_FF : PC_FB) + h * 128 + d;
#pragma unroll
    for (int i = 0; i < 16; ++i) z[i] = P[(size_t)i * PW];
}
struct HgConst { float lb, bf, bb; };
__device__ __forceinline__ HgConst hg_const(Frame& F, CArgs& A, int l, int h) { const int ch = h * 128 + (F.tid & 127); HgConst c; c.lb = 0.f;
    if (l == 1) { const float r0 = A.in[I_HGLB][ch], r1 = A.in[I_HGLB][512 + ch], mx = fmaxf(r0, r1), e0 = __expf(r0 - mx), e1 = __expf(r1 - mx); c.lb = e1 / (e0 + e1); }
    c.bf = A.in[I_HGFB][l * 1024 + ch]; c.bb = A.in[I_HGFB][l * 1024 + 512 + ch]; return c; }
template <int dir>
__device__ __forceinline__ void hg_prep(Frame& F, const HgConst& C, int l, const unsigned (&zr)[16], LAS float* tot, HgPrep& R) {
    const int d = F.tid & 127, qtr = F.tid >> 7;
    const float lb = C.lb, bias = dir == 0 ? C.bf : C.bb, omlb = 1.f - lb;
    float cs = 0.f;
#pragma unroll
    for (int i = 0; i < 16; i += 2) {
        f32x2_t z = (f32x2_t){bf2f((unsigned short)zr[i]), bf2f((unsigned short)zr[i + 1])} + bias;
        z.x = fminf(fmaxf(z.x, -30.f), 30.f); z.y = fminf(fmaxf(z.y, -30.f), 30.f);
        const f32x2_t t = z * (-1.44269504f);
        const f32x2_t ez = {__builtin_amdgcn_exp2f(t.x), __builtin_amdgcn_exp2f(t.y)}, dn = ez + 1.f;
        const f32x2_t sg = {__builtin_amdgcn_rcpf(dn.x), __builtin_amdgcn_rcpf(dn.y)};
        const f32x2_t kk = (ez * sg) * omlb, ff = sg * omlb + lb;
        R.k[i] = kk.x; R.k[i + 1] = kk.y;
        const f32x2_t lf = (f32x2_t){__builtin_amdgcn_logf(ff.x), __builtin_amdgcn_logf(ff.y)} * 0.69314718f;
        if (dir == 0) { cs += lf.x; R.x[i] = cs; cs += lf.y; R.x[i + 1] = cs; } else { R.x[i] = cs; cs += lf.x; R.x[i + 1] = cs; cs += lf.y; } }
    tot[dir * 512 + qtr * 128 + d] = cs;
    LDS_BARRIER();
    float off = 0.f;
#pragma unroll
    for (int q = 0; q < 4; ++q) { R.T[q] = tot[dir * 512 + q * 128 + d]; if (q < qtr) off += R.T[q]; }
#pragma unroll
    for (int i = 0; i < 16; ++i) R.x[i] += off;
}
__device__ __forceinline__ void put16(LAS unsigned char* p, const float (&v)[16]) {
    *(LAS u32x4*)p = (u32x4){pk2(v[0], v[1]), pk2(v[2], v[3]), pk2(v[4], v[5]), pk2(v[6], v[7])};
    *(LAS u32x4*)(p + 16) = (u32x4){pk2(v[8], v[9]), pk2(v[10], v[11]), pk2(v[12], v[13]), pk2(v[14], v[15])};
}
struct HgARaw { VtRaw v; unsigned zf[16], zb[16]; };
__device__ __forceinline__ void touch(HgARaw& R) {
#pragma unroll
    for (int i = 0; i < 8; ++i) touch(R.v.w[i]);
#pragma unroll
    for (int i = 0; i < 16; ++i) { touch(R.zf[i]); touch(R.zb[i]); } }
__device__ __forceinline__ void hg_passA_load(Frame& F, int task, HgARaw& R) {
    const TaskId T = task_id(task);
    vt_load(R.v, (const bf16*)(F.ws + WS_CQI), 1024, T.row0, 512 + T.h * 128, F.tid);
    hg_zload(F, T.h, T.row0, 0, R.zf); hg_zload(F, T.h, T.row0, 1, R.zb);
}
__device__ __forceinline__ void hg_passA_run(Frame& F, CArgs& A, int l, int task, const HgARaw& RW) {
    const TaskId T = task_id(task); const int h = T.h, tc = T.tc, sidf = T.sidf;
    LAS unsigned char* VT = F.lds; LAS unsigned char* KT = F.lds + 18432; LAS float* tot = (LAS float*)(F.lds + 55296);
    const int d = F.tid & 127, qtr = F.tid >> 7;
    const HgConst HC = hg_const(F, A, l, h);
    LDS_BARRIER();
    vt_store(VT, RW.v, F.tid);
    float* GG = (float*)(F.ws + WS_HGG);
    { HgPrep R; hg_prep<0>(F, HC, l, RW.zf, tot, R);
      const float G = (R.T[0] + R.T[1]) + (R.T[2] + R.T[3]);
      if (qtr == 0) GG[(size_t)(sidf * NTC + tc) * 128 + d] = G;
      float t[16];
#pragma unroll
      for (int i = 0; i < 16; i += 2) { const f32x2_t te = ((f32x2_t){R.x[i], R.x[i + 1]} - G) * (-1.44269504f);
          const f32x2_t kv = (f32x2_t){R.k[i], R.k[i + 1]} * (f32x2_t){__builtin_amdgcn_exp2f(te.x), __builtin_amdgcn_exp2f(te.y)}; t[i] = kv.x; t[i + 1] = kv.y; }
      put16(KT + d * ST64 + qtr * 32, t); }
    { HgPrep R; hg_prep<1>(F, HC, l, RW.zb, tot, R);
      const float G = (R.T[0] + R.T[1]) + (R.T[2] + R.T[3]);
      if (qtr == 0) GG[(size_t)((sidf + 1) * NTC + tc) * 128 + d] = G;
      float t[16];
#pragma unroll
      for (int i = 0; i < 16; i += 2) { const f32x2_t te = (f32x2_t){R.x[i], R.x[i + 1]} * 1.44269504f;
          const f32x2_t kv = (f32x2_t){R.k[i], R.k[i + 1]} * (f32x2_t){__builtin_amdgcn_exp2f(te.x), __builtin_amdgcn_exp2f(te.y)}; t[i] = kv.x; t[i + 1] = kv.y; }
      put16(KT + 18432 + d * ST64 + qtr * 32, t); }
    LDS_BARRIER();
    { const int dir = F.wave >> 2, mt = F.wave & 3; bf16* S = (bf16*)(F.ws + WS_HGS) + (size_t)((sidf + dir) * NTC + tc) * 16384;
#pragma unroll
      for (int nt = 0; nt < 4; ++nt) { f32x16 acc;
#pragma unroll
          for (int i = 0; i < 16; ++i) acc[i] = 0.f;
          mm32<64>(acc, VT + 32 * mt * ST64, ST64, KT + dir * 18432 + 32 * nt * ST64, ST64, F.lane);
#pragma unroll
          for (int r = 0; r < 16; ++r) S[(32 * mt + rowmap(r, F.lane >> 5)) * 128 + 32 * nt + (F.lane & 31)] = (bf16)f2bf(acc[r]); } }
}
struct HgCRaw { VtRaw v; unsigned zf[16], q[16]; };
__device__ __forceinline__ void touch(HgCRaw& R) {
#pragma unroll
    for (int i = 0; i < 8; ++i) touch(R.v.w[i]);
#pragma unroll
    for (int i = 0; i < 16; ++i) { touch(R.zf[i]); touch(R.q[i]); } }
__device__ __forceinline__ void hg_passC_load(Frame& F, int task, HgCRaw& R) {
    const TaskId T = task_id(task); const bf16* CQI = (const bf16*)(F.ws + WS_CQI);
    vt_load(R.v, CQI, 1024, T.row0, 512 + T.h * 128, F.tid);
    hg_zload(F, T.h, T.row0, 0, R.zf);
    { const int d = F.tid & 127, qtr = F.tid >> 7;
#pragma unroll
      for (int i = 0; i < 16; ++i) R.q[i] = CQI[(size_t)(T.row0 + qtr * 16 + i) * 1024 + T.h * 128 + d]; }
}
__device__ __forceinline__ void hg_passC_run(Frame& F, CArgs& A, int l, int task, const HgCRaw& RW) {
    const TaskId T = task_id(task); const int h = T.h, tc = T.tc, row0 = T.row0, sidf = T.sidf;
    LAS unsigned char* VT = F.lds; LAS unsigned char* Ss = F.lds + 18432; LAS unsigned char* Qh = F.lds + 53248; LAS unsigned char* Kh = F.lds + 70656;
    LAS unsigned char* Qc = F.lds + 88064; LAS unsigned char* Kc = F.lds + 96768; LAS unsigned char* Qt = F.lds + 105472; LAS unsigned char* Am = F.lds + 122880;
    LAS float* tot = (LAS float*)(F.lds + 132096);
    const int tid = F.tid, lane = F.lane, d = tid & 127, qtr = tid >> 7;
    if (l == DEPTH - 1 && tc < 4) return;
    unsigned gate[16];
    const HgConst HC = hg_const(F, A, l, h);
    unsigned zb[16]; hg_zload(F, h, row0, 1, zb);
    u32x4 sf[4], sb[4]; { const u32x4* sp = (const u32x4*)((const bf16*)(F.ws + WS_HGSB) + (size_t)(sidf * NTC + tc) * 16384 + (tid >> 2) * 128 + (tid & 3) * 32);
#pragma unroll
      for (int j = 0; j < 4; ++j) { sf[j] = sp[j]; sb[j] = sp[j + (size_t)NTC * 16384 * 2 / 16]; } }
    LDS_BARRIER();
    vt_store(VT, RW.v, tid);
    f32x16 acc;
#pragma unroll
    for (int i = 0; i < 16; ++i) acc[i] = 0.f;
#pragma unroll
    for (int dir = 0; dir < 2; ++dir) {
        HgPrep R;
        if (dir == 1) gate_load<1>(F, row0, h, gate);
        if (dir == 0) hg_prep<0>(F, HC, l, RW.zf, tot, R); else hg_prep<1>(F, HC, l, zb, tot, R);
        const float T0 = R.T[0], T1 = R.T[1], T2 = R.T[2], T3 = R.T[3];
        const float sg = dir == 0 ? 1.f : -1.f;
        const float rI = sg * ((qtr >> 1) == 0 ? T0 : (T0 + T1) + T2);
        const float rO = sg * (T0 + T1);
        const float Gall = (T0 + T1) + (T2 + T3);
        const bool isq = dir == 0 ? (qtr >= 2) : (qtr < 2);
        const float cO = __expf(isq ? rI - rO : rO - rI), cT = __expf(dir == 0 ? rI : Gall + rI);
        { const int v = tid >> 2, pc = tid & 3;
#pragma unroll
          for (int j = 0; j < 4; ++j) *(LAS u32x4*)(Ss + v * ST128 + pc * 64 + j * 16) = dir == 0 ? sf[j] : sb[j]; }
#pragma unroll
        for (int i = 0; i < 16; i += 2) {
            const int t = qtr * 16 + i;
            const f32x2_t x = dir == 0 ? (f32x2_t){R.x[i], R.x[i + 1]} : (f32x2_t){-R.x[i], -R.x[i + 1]}, kk = {R.k[i], R.k[i + 1]}, qv = {bf2f((unsigned short)RW.q[i]), bf2f((unsigned short)RW.q[i + 1])};
            const f32x2_t te = (x - rI) * 1.44269504f;
            const f32x2_t eh = {__builtin_amdgcn_exp2f(te.x), __builtin_amdgcn_exp2f(te.y)}, ehr = {__builtin_amdgcn_rcpf(eh.x), __builtin_amdgcn_rcpf(eh.y)};
            const f32x2_t qe = qv * eh, ke = kk * ehr, of = (isq ? qe : ke) * cO, qt = qe * cT;
            const unsigned wq = pk2(qe.x, qe.y), wk = pk2(ke.x, ke.y), wo = pk2(of.x, of.y), wt = pk2(qt.x, qt.y);
            *(LAS unsigned short*)(Qh + t * ST128 + d * 2) = (unsigned short)wq; *(LAS unsigned short*)(Qh + (t + 1) * ST128 + d * 2) = (unsigned short)(wq >> 16);
            *(LAS unsigned short*)(Kh + t * ST128 + d * 2) = (unsigned short)wk; *(LAS unsigned short*)(Kh + (t + 1) * ST128 + d * 2) = (unsigned short)(wk >> 16);
            LAS unsigned char* oc = isq ? Qc : Kc;
            *(LAS unsigned short*)(oc + (t & 31) * ST128 + d * 2) = (unsigned short)wo; *(LAS unsigned short*)(oc + ((t + 1) & 31) * ST128 + d * 2) = (unsigned short)(wo >> 16);
            *(LAS unsigned short*)(Qt + t * ST128 + d * 2) = (unsigned short)wt; *(LAS unsigned short*)(Qt + (t + 1) * ST128 + d * 2) = (unsigned short)(wt >> 16);
        }
        LDS_BARRIER();
        if (F.wave < 4) { f32x16 a;
#pragma unroll
            for (int i = 0; i < 16; ++i) a[i] = 0.f;
            int tt = 0, ts = 0;
            if (F.wave < 2) { tt = ts = F.wave; mm32<128>(a, Qh + 32 * tt * ST128, ST128, Kh + 32 * ts * ST128, ST128, lane);
#pragma unroll
                for (int r = 0; r < 16; ++r) { const int tl = rowmap(r, lane >> 5), sl = lane & 31; const bool ok = dir == 0 ? (sl <= tl) : (sl >= tl); a[r] = ok ? a[r] : 0.f; } }
            else if (F.wave == 2) { tt = dir == 0 ? 1 : 0; ts = 1 - tt; mm32<128>(a, Qc, ST128, Kc, ST128, lane); }
            else { tt = dir == 0 ? 0 : 1; ts = 1 - tt; }
#pragma unroll
            for (int r = 0; r < 16; r += 2) { const unsigned w = pk2(a[r], a[r + 1]); *(LAS unsigned short*)(Am + (32 * tt + rowmap(r, lane >> 5)) * ST64 + (32 * ts + (lane & 31)) * 2) = (unsigned short)w;
                *(LAS unsigned short*)(Am + (32 * tt + rowmap(r + 1, lane >> 5)) * ST64 + (32 * ts + (lane & 31)) * 2) = (unsigned short)(w >> 16); } }
        LDS_BARRIER();
        { const int mt = F.wave >> 2, nt = F.wave & 3;
          mm32<64>(acc, Am + 32 * mt * ST64, ST64, VT + 32 * nt * ST64, ST64, lane);
          mm32<128>(acc, Qt + 32 * mt * ST128, ST128, Ss + 32 * nt * ST128, ST128, lane); }
        if (dir == 0) LDS_BARRIER();
    }
    const float ng = A.in[I_HGNG][l * 512 + h * 128 + 32 * (F.wave & 3) + (lane & 31)];
    head_epilogue<1>(F, ng, acc, gate, (LAS float*)(F.lds + 136192), row0, h);
}
#define TASK_LOOP(RAW, LOADFN, RUNFN, T0, T1) do { int t_ = F.vcu; while (t_ < (T0)) t_ += F.G; RAW cur_; if (t_ < (T1)) { LOADFN(t_ - (T0), cur_); } \
    for (; t_ < (T1); t_ += F.G) { touch(cur_); RAW nxt_; if (t_ + F.G < (T1)) { LOADFN(t_ + F.G - (T0), nxt_); } else nxt_ = cur_; RUNFN(t_ - (T0), cur_); cur_ = nxt_; } } while (0)

__device__ __forceinline__ void transpose_item(const float* W, int ldw, int K, bf16* WT, int k0, int n0, int drow0, LAS float* scr, int lane) {
    const int n4 = (lane & 7) * 4, kr = lane >> 3;
    f32x4 v[8];
#pragma unroll
    for (int i = 0; i < 8; ++i) v[i] = __builtin_nontemporal_load((const f32x4*)(W + (size_t)(k0 + 8 * i + kr) * ldw + n0 + n4));
#pragma unroll
    for (int i = 0; i < 8; ++i) { LAS float* p = scr + (8 * i + kr) * 33 + n4; p[0] = v[i].x; p[1] = v[i].y; p[2] = v[i].z; p[3] = v[i].w; }
    asm volatile("s_waitcnt lgkmcnt(0)" ::: "memory");
    const int c = lane & 7;
#pragma unroll
    for (int j = 0; j < 4; ++j) { const int n = (lane >> 3) + 8 * j; const LAS float* s = scr + (8 * c) * 33 + n;
        u32x4 o; o.x = pk2(s[0 * 33], s[1 * 33]); o.y = pk2(s[2 * 33], s[3 * 33]); o.z = pk2(s[4 * 33], s[5 * 33]); o.w = pk2(s[6 * 33], s[7 * 33]);
        *(u32x4*)(WT + (size_t)(drow0 + n) * K + k0 + 8 * c) = o; }
    asm volatile("s_waitcnt lgkmcnt(0)" ::: "memory");
}
__device__ __forceinline__ void ph_convert(Frame& F, CArgs& A, bool small_only) {
    LAS float* scr = (LAS float*)(F.lds + 32768 + F.wave * 8448);
    const int gw = F.vcu * NWAVES + F.wave, NGW = F.G * NWAVES;
    constexpr int I_IN = DEPTH * 16 * 128, I_OUT = DEPTH * 16 * 32, I_GU = DEPTH * NEXP * 16 * 64, I_DN = DEPTH * NEXP * 16 * 32;
    for (int it = gw; it < (small_only ? I_IN + I_OUT : I_IN + I_OUT + I_GU + I_DN); it += NGW) {
        int r = it;
        if (r < I_IN) { const int l = r / 2048, q = r % 2048, kb = q / 128, nb = q % 128, d0 = nb * 32, n0 = d0 < 1536 ? d0 : d0 + 16;
            transpose_item(A.in[I_WIN] + (size_t)l * D * INW, INW, D, (bf16*)(F.ws + WS_WIN) + (size_t)l * PW * D, kb * 64, n0, d0, scr, F.lane); continue; }
        r -= I_IN;
        if (r < I_OUT) { const int l = r / 512, q = r % 512, kb = q / 32, nb = q % 32;
            transpose_item(A.in[I_WOUT] + (size_t)l * D * D, D, D, (bf16*)(F.ws + WS_WOUT) + (size_t)l * D * D, kb * 64, nb * 32, nb * 32, scr, F.lane); continue; }
        r -= I_OUT;
        if (r < I_GU) { const int m = r / 1024, q = r % 1024, kb = q / 64, nb = q % 64, n0 = nb * 32;
            const int cc = n0 & 1023, d0 = (cc >> 7) * 256 + (n0 >= 1024 ? 128 : 0) + (cc & 127);
            transpose_item(A.in[I_WGU] + (size_t)m * D * 2048, 2048, D, (bf16*)(F.ws + WS_WGU) + (size_t)m * 2048 * D, kb * 64, n0, d0, scr, F.lane); continue; }
        r -= I_GU;
        { const int m = r / 512, q = r % 512, kb = q / 32, nb = q % 32;
            transpose_item(A.in[I_WDN] + (size_t)m * DEXP * D, D, DEXP, (bf16*)(F.ws + WS_WDN) + (size_t)m * D * DEXP, kb * 64, nb * 32, nb * 32, scr, F.lane); }
    }
}


constexpr int CV_NJ = 384;
__device__ __forceinline__ void moe_item_addr(CArgs& A, unsigned char* ws, int item, const float*& W, int& ldw, bf16*& WT, int& k0, int& n0, int& d0) {
    const int l = item / 49152, r = item % 49152;
    if (r < 32768) { const int e = r >> 10, q = r & 1023, kb = q >> 6, nb = q & 63; n0 = nb * 32; const int cc = n0 & 1023; d0 = (cc >> 7) * 256 + (n0 >= 1024 ? 128 : 0) + (cc & 127); k0 = kb * 64;
        W = A.in[I_WGU] + (size_t)(l * NEXP + e) * D * 2048; ldw = 2048; WT = (bf16*)(ws + WS_WGU) + (size_t)(l * NEXP + e) * 2048 * D; }
    else { const int r2 = r - 32768, e = r2 >> 9, q = r2 & 511, kb = q >> 5, nb = q & 31; n0 = nb * 32; d0 = n0; k0 = kb * 64;
        W = A.in[I_WDN] + (size_t)(l * NEXP + e) * DEXP * D; ldw = D; WT = (bf16*)(ws + WS_WDN) + (size_t)(l * NEXP + e) * D * DEXP; }
}
__device__ __forceinline__ void transpose_store(bf16* WT, int K, int k0, int d0, LAS float* scr, const f32x4 (&v)[8], int lane) {
    const int n4 = (lane & 7) * 4, kr = lane >> 3;
#pragma unroll
    for (int i = 0; i < 8; ++i) { LAS float* p = scr + (8 * i + kr) * 33 + n4; p[0] = v[i].x; p[1] = v[i].y; p[2] = v[i].z; p[3] = v[i].w; }
    asm volatile("s_waitcnt lgkmcnt(0)" ::: "memory");
    const int c = lane & 7;
#pragma unroll
    for (int j = 0; j < 4; ++j) { const int n = (lane >> 3) + 8 * j; const LAS float* sp = scr + (8 * c) * 33 + n;
        u32x4 o; o.x = pk2(sp[0 * 33], sp[1 * 33]); o.y = pk2(sp[2 * 33], sp[3 * 33]); o.z = pk2(sp[4 * 33], sp[5 * 33]); o.w = pk2(sp[6 * 33], sp[7 * 33]);
        *(u32x4*)(WT + (size_t)(d0 + n) * K + k0 + 8 * c) = o; }
    asm volatile("s_waitcnt lgkmcnt(0)" ::: "memory");
}
__device__ __forceinline__ void convert_moe_all(unsigned char* ws, LAS unsigned char* lds, CArgs& A, int cw, int nw, int wave, int lane, int it_lo = 0, int it_hi = 49152) {
    LAS float* scr = (LAS float*)(lds + wave * 16640);
    const int n4 = (lane & 15) * 4, kr = lane >> 4;
    for (int it = it_lo + cw; it < it_hi; it += 2 * nw) {
        const float* W[2]; bf16* WT[2]; int ldw[2], k0[2], n0[2], d0[2];
        const bool two = it + nw < it_hi;
#pragma unroll
        for (int u = 0; u < 2; ++u) { const int iu = (u == 1 && two) ? it + nw : it; const int le = iu / 768, r = iu % 768;
            if (r < 512) { const int kb = r >> 5, nb = r & 31; k0[u] = kb * 64; n0[u] = nb * 64; const int cc = n0[u] & 1023; d0[u] = (cc >> 7) * 256 + (n0[u] >= 1024 ? 128 : 0) + (cc & 127);
                W[u] = A.in[I_WGU] + (size_t)le * D * 2048; ldw[u] = 2048; WT[u] = (bf16*)(ws + WS_WGU) + (size_t)le * 2048 * D; }
            else { const int q = r - 512, kb = q >> 4, nb = q & 15; k0[u] = kb * 64; n0[u] = nb * 64; d0[u] = n0[u];
                W[u] = A.in[I_WDN] + (size_t)le * DEXP * D; ldw[u] = D; WT[u] = (bf16*)(ws + WS_WDN) + (size_t)le * D * DEXP; } }
        f32x4 v[2][16];
#pragma unroll
        for (int u = 0; u < 2; ++u)
#pragma unroll
            for (int i = 0; i < 16; ++i) v[u][i] = __builtin_nontemporal_load((const f32x4*)(W[u] + (size_t)(k0[u] + 4 * i + kr) * ldw[u] + n0[u] + n4));
#pragma unroll
        for (int u = 0; u < 2; ++u) { if (u == 1 && !two) break;
#pragma unroll
            for (int i = 0; i < 16; ++i) { LAS float* p = scr + (4 * i + kr) * 65 + n4; p[0] = v[u][i].x; p[1] = v[u][i].y; p[2] = v[u][i].z; p[3] = v[u][i].w; }
            asm volatile("s_waitcnt lgkmcnt(0)" ::: "memory");
            const int c = lane & 7;
#pragma unroll
            for (int j = 0; j < 8; ++j) { const int n = (lane >> 3) + 8 * j; const LAS float* sp = scr + (8 * c) * 65 + n;
                u32x4 o; o.x = pk2(sp[0 * 65], sp[1 * 65]); o.y = pk2(sp[2 * 65], sp[3 * 65]); o.z = pk2(sp[4 * 65], sp[5 * 65]); o.w = pk2(sp[6 * 65], sp[7 * 65]);
                *(u32x4*)(WT[u] + (size_t)(d0[u] + n) * 1024 + k0[u] + 8 * c) = o; }
            asm volatile("s_waitcnt lgkmcnt(0)" ::: "memory"); }
    }
}
__device__ __forceinline__ void convert_moe(unsigned char* ws, LAS unsigned char* lds, CArgs& A, int cw, int wave, int lane, int j0, int j1) {
    LAS float* scr = (LAS float*)(lds + wave * 8448);
    const int n4 = (lane & 7) * 4, kr = lane >> 3;
    for (int j = j0; j < j1; j += 2) {
        const float* W0; const float* W1; bf16* T0; bf16* T1; int l0, l1, ka, kb_, na, nb_, da, db;
        moe_item_addr(A, ws, cw + 256 * j, W0, l0, T0, ka, na, da);
        const bool two = j + 1 < j1; moe_item_addr(A, ws, cw + 256 * (two ? j + 1 : j), W1, l1, T1, kb_, nb_, db);
        f32x4 v0[8], v1[8];
#pragma unroll
        for (int i = 0; i < 8; ++i) v0[i] = __builtin_nontemporal_load((const f32x4*)(W0 + (size_t)(ka + 8 * i + kr) * l0 + na + n4));
#pragma unroll
        for (int i = 0; i < 8; ++i) v1[i] = __builtin_nontemporal_load((const f32x4*)(W1 + (size_t)(kb_ + 8 * i + kr) * l1 + nb_ + n4));
        transpose_store(T0, 1024, ka, da, scr, v0, lane);
        if (two) transpose_store(T1, 1024, kb_, db, scr, v1, lane);
    }
}

#define XB_TMO      128
#define XB_XCNT(j)  (256  + 64 * (j))
#define XB_XSUB(j)  (1280 + 64 * (j))
#define XB_XGEN(j)  (2304 + 64 * (j))
#define XB_TOP      3328
#define XB_TOPGEN   3392
#define XCD_BAR_WORDS 3456
#define XB_SPIN_CAP (1u << 18)
__device__ __forceinline__ unsigned xb_ld(unsigned* p)              { return __hip_atomic_load(p, __ATOMIC_RELAXED, __HIP_MEMORY_SCOPE_AGENT); }
__device__ __forceinline__ unsigned xb_add(unsigned* p, unsigned v) { return __hip_atomic_fetch_add(p, v, __ATOMIC_RELAXED, __HIP_MEMORY_SCOPE_AGENT); }
__device__ __forceinline__ unsigned xb_xcc_id() { return (unsigned)__builtin_amdgcn_s_getreg((3 << 11) | 20) & 0xFu; }
#define XB_SPIN(cond, bar) do { unsigned _sp = 0; while (cond) { __builtin_amdgcn_s_sleep(1); \
    if ((++_sp & 255u) == 0u) { if (xb_ld(&(bar)[XB_TMO])) break; if (_sp > XB_SPIN_CAP) { atomicAdd(&(bar)[XB_TMO], 1u); break; } } } } while (0)
struct XcdBarrier { unsigned* bar; unsigned x; volatile LAS unsigned* st; };
__device__ __forceinline__ XcdBarrier xcd_barrier_post(unsigned* bar, volatile LAS unsigned* st) {
    XcdBarrier b; b.bar = bar; b.x = xb_xcc_id(); b.st = st;
    if (threadIdx.x == 0) (void)xb_add(&bar[XB_XCNT(b.x)], 1u);
    return b;
}
__device__ __forceinline__ void xcd_barrier_complete(unsigned* bar, unsigned x, unsigned& nloc, unsigned& nx) {
    const unsigned G = gridDim.x * gridDim.y * gridDim.z;
    unsigned sum, cnt, mine, sp = 0u;
    for (;;) {
        sum = 0u; cnt = 0u; mine = 0u;
#pragma unroll
        for (unsigned j = 0; j < 16; ++j) { const unsigned c = xb_ld(&bar[XB_XCNT(j)]); sum += c; cnt += (c > 0u) ? 1u : 0u; mine = (j == x) ? c : mine; }
        if (sum == G) break;
        __builtin_amdgcn_s_sleep(1);
        if ((++sp & 255u) == 0u) { if (xb_ld(&bar[XB_TMO])) break; if (sp > XB_SPIN_CAP) { atomicAdd(&bar[XB_TMO], 1u); break; } }
    }
    nloc = mine > 0u ? mine : 1u; nx = cnt > 0u ? cnt : 1u;
}
__device__ __forceinline__ void xcd_barrier(const XcdBarrier& b) {
    asm volatile("s_waitcnt vmcnt(0)" ::: "memory");
    __syncthreads();
    if (threadIdx.x == 0) {
        unsigned* bar = b.bar;
        __builtin_amdgcn_s_waitcnt(0);
        unsigned nloc = b.st[0], nx = b.st[1];
        if (nloc == 0u) { xcd_barrier_complete(bar, b.x, nloc, nx); b.st[0] = nloc; b.st[1] = nx; }
        const unsigned old = xb_add(&bar[XB_XSUB(b.x)], 1u);
        const unsigned gen = old / nloc;
        if (old + 1u == (gen + 1u) * nloc) {
            __builtin_amdgcn_fence(__ATOMIC_RELEASE, "agent");
            asm volatile("s_waitcnt vmcnt(0)" ::: "memory");
            const unsigned og = xb_add(&bar[XB_TOP], 1u);
            const unsigned tg = og / nx;
            if (og + 1u == (tg + 1u) * nx) xb_add(&bar[XB_TOPGEN], 1u);
            else XB_SPIN(xb_ld(&bar[XB_TOPGEN]) == tg, bar);
            __builtin_amdgcn_fence(__ATOMIC_ACQUIRE, "agent");
            xb_add(&bar[XB_XGEN(b.x)], 1u);
            asm volatile("s_waitcnt vmcnt(0)" ::: "memory");
        } else {
            XB_SPIN(xb_ld(&bar[XB_XGEN(b.x)]) == gen, bar);
            __builtin_amdgcn_fence(__ATOMIC_ACQUIRE, "agent");
            asm volatile("s_waitcnt vmcnt(0)" ::: "memory");
        }
    }
    __syncthreads();
}

enum { PH_INIT = 0, PH_NORM1, PH_INPROJ, PH_CONV, PH_SCANA, PH_SCANB, PH_SCANC, PH_HNORM, PH_OUTPROJ, PH_NORM2, PH_LISTS, PH_GU, PH_DOWN, PH_COMBINE, PH_FINAL };

constexpr int NPHASE = 1 + 13 * DEPTH;
template <int ph, int l>
__device__ __forceinline__ void run_phase(LAS unsigned char* lds_raw) {
    int tid_ = threadIdx.x; asm volatile("" : "+v"(tid_));
    CArgs* ap_ = (CArgs*)__builtin_amdgcn_kernarg_segment_ptr(); asm volatile("" : "+s"(ap_));
    CArgs& A_ = *ap_;
    unsigned char* ws_ = A_.ws; asm volatile("" : "+s"(ws_));
    unsigned lb_ = 0u, bx_ = blockIdx.x, gx_ = gridDim.x; asm volatile("" : "+s"(lb_), "+s"(bx_), "+s"(gx_));
    Frame F; F.lds = lds_raw + lb_; F.out = A_.out; F.ws = ws_;
    F.tid = tid_; F.lane = F.tid & 63; F.wave = __builtin_amdgcn_readfirstlane(F.tid >> 6);
    F.G = (int)gx_; { const int bx = (int)bx_; F.vcu = (F.G % 8 == 0) ? (bx % 8) * (F.G / 8) + bx / 8 : bx; }
    constexpr int nrows = (l == DEPTH - 1) ? NLAT : NTOK;
    constexpr bool CVPH = (l == 0) && (ph <= PH_LISTS);
    constexpr int CQ0 = ph == PH_INIT ? 0 : ph == PH_NORM1 ? 25 : ph == PH_INPROJ ? 55 : ph == PH_CONV ? 140 : ph == PH_SCANA ? 165 : ph == PH_SCANB ? 205 : ph == PH_SCANC ? 233 : ph == PH_OUTPROJ ? 313 : ph == PH_NORM2 ? 344 : 378;
    constexpr int CQ1 = ph == PH_INIT ? 25 : ph == PH_NORM1 ? 55 : ph == PH_INPROJ ? 140 : ph == PH_CONV ? 165 : ph == PH_SCANA ? 205 : ph == PH_SCANB ? 233 : ph == PH_SCANC ? 313 : ph == PH_OUTPROJ ? 344 : ph == PH_NORM2 ? 378 : CV_NJ;
    const bool cvgrid = false;
    if (CVPH && cvgrid) {
        if (bx_ >= 224u) { const int cvcu = (int)(bx_ & 7u) * 4 + ((int)(bx_ >> 3) - 28); convert_moe(ws_, F.lds, A_, cvcu * 8 + F.wave, F.wave, F.lane, CQ0, CQ1); return; }
        F.G = 224; F.vcu = (int)(bx_ & 7u) * 28 + (int)(bx_ >> 3); gx_ = 224u;
    }
    switch (ph) {
        case PH_INIT: ph_init(F, A_); ph_convert(F, A_, true); break;
        case PH_INPROJ: {
            const bool cfirst = ((bx_ >> 3) & 1u) == 0u;
            int base, nblk;
            if (F.G == 256 && l == 0) { if (bx_ >= 32u) { const int ix = (int)bx_ - 32; nblk = 74 + (ix < 16 ? 1 : 0); base = ix * 74 + (ix < 16 ? ix : 16); } else { base = 16592 + (int)bx_ * 48; nblk = 48; } }
            else if (F.G == 256) { if (bx_ >= 32u) { base = ((int)bx_ - 32) * 100; nblk = 100; } else { base = 22400 + (int)bx_ * 68; nblk = 68; } }
            else { const int per = (24576 + F.G - 1) / F.G; base = F.vcu * per; nblk = base + per <= 24576 ? per : (base < 24576 ? 24576 - base : 0); }
            base += l * 24576;
            if (cfirst) { convert_moe_all(F.ws, F.lds, A_, F.wave, NWAVES, F.wave, F.lane, base, base + nblk); __syncthreads(); }
            { pg8::Gemm g{(const bf16*)(F.ws + WS_H), (const bf16*)(F.ws + WS_WIN) + (size_t)l * PW * D, D, nullptr, nullptr, 0};
              pg8::StaticOrder S; S.init(NTOK / 256, PW / 256, F.G, (int)bx_); pg8::EpiBf16 E{(bf16*)(F.ws + WS_P), PW};
              pg8::gemm_phase<pg8::EpiBf16, pg8::StaticOrder, true>(F.lds, g, S, E, F.tid); }
            if (!cfirst) { __syncthreads(); convert_moe_all(F.ws, F.lds, A_, F.wave, NWAVES, F.wave, F.lane, base, base + nblk); }
        } break;
        case PH_NORM1: if (l == 0) ph_rows<1, 0>(F, A_, 0, 0, NTOK); break;
        case PH_CONV: ph_conv(F, A_, l); break;
        case PH_SCANA: {
#define LD_(t, R) ml_passA_load(F, t, R)
#define RN_(t, R) ml_passA_run(F, t, R)
            TASK_LOOP(MlARaw, LD_, RN_, 0, 8 * NTC);
#undef LD_
#undef RN_
#define LD_(t, R) hg_passA_load(F, t, R)
#define RN_(t, R) hg_passA_run(F, A_, l, t, R)
            TASK_LOOP(HgARaw, LD_, RN_, 8 * NTC, 16 * NTC);
#undef LD_
#undef RN_
        } break;
        case PH_SCANB: scan_passB(F); break;
        case PH_SCANC: {
#define LD_(t, R) ml_passC_load(F, t, R)
#define RN_(t, R) ml_passC_run(F, A_, l, t, R)
            TASK_LOOP(MlCRaw, LD_, RN_, 0, 8 * NTC);
#undef LD_
#undef RN_
#define LD_(t, R) hg_passC_load(F, t, R)
#define RN_(t, R) hg_passC_run(F, A_, l, t, R)
            TASK_LOOP(HgCRaw, LD_, RN_, 8 * NTC, 16 * NTC);
#undef LD_
#undef RN_
        } break;
        case PH_OUTPROJ: { pg8::Gemm g{(const bf16*)(F.ws + WS_Y), (const bf16*)(F.ws + WS_WOUT) + (size_t)l * D * D, D, nullptr, nullptr, 0};
            pg8::StaticOrder S; S.init(nrows / 256, D / 256, F.G, (int)bx_);
            const float* xs = (const float*)(F.ws + WS_X);
            pg8::EpiResid E{(float*)(F.ws + WS_X), (const float*)(F.ws + WS_MOD) + (size_t)l * 3 * 6144 + 2048, l == 0 ? A_.in[I_X] : xs, l == 0 ? A_.in[I_CTX] : xs + (size_t)NLAT * D};
            pg8::gemm_phase<pg8::EpiResid, pg8::StaticOrder, true>(F.lds, g, S, E, F.tid);
            if (l == 0 && F.G == 256 && bx_ >= 8u) { __syncthreads(); const int base = 18128 + ((int)bx_ - 8) * 26; convert_moe_all(F.ws, F.lds, A_, F.wave, NWAVES, F.wave, F.lane, base, base + 26); } } break;
        case PH_GU: { const int* rt = (const int*)(F.ws + WS_ROUTE); const int ntile = rt[RT_TILEE];
            pg8::Gemm g{(const bf16*)(F.ws + WS_H), (const bf16*)(F.ws + WS_WGU) + (size_t)l * NEXP * 2048 * D, D, rt + RT_LIST, rt + RT_TILEE, (size_t)2048 * D};
            pg8::StaticOrder S; S.init(ntile, 2048 / 256, F.G, (int)bx_);
            pg8::EpiSwiglu E{(bf16*)(F.ws + WS_ACT), A_.in[I_BGU] + (size_t)l * NEXP * 2048, rt + RT_TILEE};
            pg8::gemm_phase<pg8::EpiSwiglu, pg8::StaticOrder, true>(F.lds, g, S, E, F.tid); } break;
        case PH_DOWN: { const int* rt = (const int*)(F.ws + WS_ROUTE); const int ntile = rt[RT_TILEE];
            pg8::Gemm g{(const bf16*)(F.ws + WS_ACT), (const bf16*)(F.ws + WS_WDN) + (size_t)l * NEXP * D * DEXP, DEXP, nullptr, rt + RT_TILEE, (size_t)D * DEXP};
            pg8::StaticOrder S; S.init(ntile, D / 256, F.G, (int)bx_);
            pg8::EpiDown E{(bf16*)(F.ws + WS_YS), A_.in[I_BDN] + (size_t)l * NEXP * D, (const float*)(rt + RT_SGATE), rt + RT_TILEE};
            pg8::gemm_phase<pg8::EpiDown, pg8::StaticOrder, true>(F.lds, g, S, E, F.tid); } break;
        case PH_HNORM: ph_hnorm(F, A_, l, l == DEPTH - 1); break;
        case PH_NORM2: ph_rows<0, 1>(F, A_, l, l, nrows); break;
        case PH_LISTS: ph_lists(F, A_, l, nrows); break;
        case PH_COMBINE: if (l == DEPTH - 1) ph_rows<2, 2>(F, A_, l, 0, NLAT); else ph_rows<2, 0>(F, A_, l, l + 1, NTOK); break;
        default: break;
    }
}
__global__ void __launch_bounds__(NTHR, 2) fwd(Args a) {
    extern __shared__ __attribute__((aligned(16))) unsigned char lds_raw[];
    volatile LAS unsigned* bst = (volatile LAS unsigned*)((LAS unsigned char*)lds_raw + LDS_BYTES - 64);
    if (threadIdx.x < 16) bst[threadIdx.x] = 0u;
    __syncthreads();
    XcdBarrier bar = xcd_barrier_post((unsigned*)(a.ws + WS_CTL) + CW_BAR, bst);
#ifndef TPROBE
#define TPROBE 0
#endif
#ifndef TP0
#define TP0 0
#define TP1 0
#define TP2 0
#define TD0 800
#define TD1 800
#define TD2 800
#endif
    unsigned ta0 = 0u, ta1 = 0u, ta2 = 0u; unsigned long long tprev = 0;
    const bool stamper = TPROBE && blockIdx.x == 0;
    if (stamper) tprev = __builtin_amdgcn_s_memrealtime();
#define RUN(pi, ph, l) do { run_phase<ph, l>((LAS unsigned char*)lds_raw); if ((pi) != NPHASE - 1 || TPROBE) xcd_barrier(bar); \
    if (stamper) { const unsigned long long tn = __builtin_amdgcn_s_memrealtime(); const unsigned dt = (unsigned)(tn - tprev); tprev = tn; \
        if ((ph) == TP0) ta0 += dt; if ((ph) == TP1) ta1 += dt; if ((ph) == TP2) ta2 += dt; } } while (0)
#define LAYER(l) if (l == 0) RUN(1 + 13 * l, PH_NORM1, l); RUN(2 + 13 * l, PH_INPROJ, l); RUN(3 + 13 * l, PH_CONV, l); RUN(4 + 13 * l, PH_SCANA, l); RUN(5 + 13 * l, PH_SCANB, l); RUN(6 + 13 * l, PH_SCANC, l); \
    RUN(8 + 13 * l, PH_OUTPROJ, l); RUN(9 + 13 * l, PH_NORM2, l); RUN(10 + 13 * l, PH_LISTS, l); RUN(11 + 13 * l, PH_GU, l); RUN(12 + 13 * l, PH_DOWN, l); RUN(13 + 13 * l, PH_COMBINE, l)
    RUN(0, PH_INIT, 0);
    LAYER(0);
    LAYER(1);
#undef LAYER
#undef RUN
    if (TPROBE) {
        if (stamper) { const unsigned long long tn = __builtin_amdgcn_s_memrealtime();
            unsigned q0 = (ta0 + TD0 / 2) / TD0, q1 = (ta1 + TD1 / 2) / TD1, q2 = (ta2 + TD2 / 2) / TD2;
            q0 = q0 > 31u ? 31u : q0; q1 = q1 > 31u ? 31u : q1; q2 = q2 > 31u ? 31u : q2;
            const unsigned long long delay = (unsigned long long)(q0 + 32u * q1 + 1024u * q2) * 1600ull;
            while (__builtin_amdgcn_s_memrealtime() - tn < delay) __builtin_amdgcn_s_sleep(8);
        }
    }
}

template <int NB, class Epi>
__global__ void __launch_bounds__(256) naive_gemm(const bf16* A, int lda, const int* gather, const int* tile_e, int M, const float* B, size_t bexp, int ldb, int N, int K, int bshift_from, int bshift, int bgrp, Epi E) {
    __shared__ float As[16][68]; __shared__ float Bs[NB][16][68];
    const int m0 = blockIdx.y * 64, n0 = blockIdx.x * 64, tid = threadIdx.x, tx = tid & 15, ty = tid >> 4;
    int e = 0;
    if (tile_e) { const int nt = tile_e[0]; if (m0 >= nt * 256) return; e = tile_e[8 + (m0 >> 8)]; } else if (m0 >= M) return;
    const float* Bp = B + (size_t)e * bexp + (n0 + (n0 >= bshift_from ? bshift : 0));
    const int ar = tid >> 2, ak = (tid & 3) * 4; const int arow = gather ? gather[m0 + ar] : (m0 + ar);
    const bf16* Ap = A + (size_t)arow * lda + ak;
    const int bk = tid >> 4, bn = (tid & 15) * 4;
    float acc[NB][4][4];
#pragma unroll
    for (int g = 0; g < NB; ++g)
#pragma unroll
        for (int i = 0; i < 4; ++i)
#pragma unroll
            for (int j = 0; j < 4; ++j) acc[g][i][j] = 0.f;
    for (int k0 = 0; k0 < K; k0 += 16) {
        const u32x2 av = *(const u32x2*)(Ap + k0);
        As[ak + 0][ar] = bflo(av.x); As[ak + 1][ar] = bfhi(av.x); As[ak + 2][ar] = bflo(av.y); As[ak + 3][ar] = bfhi(av.y);
#pragma unroll
        for (int g = 0; g < NB; ++g) { const f32x4 bv = *(const f32x4*)(Bp + (size_t)(k0 + bk) * ldb + g * bgrp + bn); *(f32x4*)&Bs[g][bk][bn] = bv; }
        __syncthreads();
#pragma unroll
        for (int k = 0; k < 16; ++k) { const f32x4 a4 = *(const f32x4*)&As[k][ty * 4];
#pragma unroll
            for (int g = 0; g < NB; ++g) { const f32x4 b4 = *(const f32x4*)&Bs[g][k][tx * 4];
#pragma unroll
                for (int i = 0; i < 4; ++i) { acc[g][i][0] += a4[i] * b4[0]; acc[g][i][1] += a4[i] * b4[1]; acc[g][i][2] += a4[i] * b4[2]; acc[g][i][3] += a4[i] * b4[3]; } } }
        __syncthreads();
    }
#pragma unroll
    for (int i = 0; i < 4; ++i)
#pragma unroll
        for (int j = 0; j < 4; ++j) E(m0 + ty * 4 + i, n0 + tx * 4 + j, acc[0][i][j], NB == 2 ? acc[NB - 1][i][j] : 0.f, e);
}
struct EpiP { bf16* P; __device__ void operator()(int r, int c, float v, float, int) const { P[(size_t)r * PW + c] = (bf16)f2bf(v); } };
struct EpiOut { float* X; const float* MOD; __device__ void operator()(int r, int c, float v, float, int) const { X[(size_t)r * D + c] += MOD[mrow_of(r) * 6144 + 2048 + c] * v; } };
struct EpiGU { bf16* ACT; const float* bgu; __device__ void operator()(int r, int c, float g, float li, int e) const {
    g += bgu[(size_t)e * 2048 + c]; li += bgu[(size_t)e * 2048 + 1024 + c]; g = fminf(g, 7.f); li = fminf(fmaxf(li, -7.f), 7.f);
    ACT[(size_t)r * DEXP + c] = (bf16)f2bf(g * sigmoidf_(1.702f * g) * (li + 1.f)); } };
struct EpiDown { bf16* YS; const float* bdn; const float* sgate; __device__ void operator()(int r, int c, float v, float, int e) const { YS[(size_t)r * D + c] = (bf16)f2bf((v + bdn[(size_t)e * D + c]) * sgate[r]); } };

__global__ void __launch_bounds__(128) naive_mlstm(const bf16* CQK, const bf16* P, const float* GATES, float* HF, float* HB) {
    __shared__ float qs[8][64], ks[8][64];
    const int b = blockIdx.x >> 3, h = (blockIdx.x >> 1) & 3, dir = blockIdx.x & 1, tid = threadIdx.x;
    float C[64], n[64], m = 0.f;
#pragma unroll
    for (int d = 0; d < 64; ++d) { C[d] = 0.f; n[d] = 0.f; }
    float* OUT = dir ? HB : HF;
    for (int p0 = 0; p0 < CTX + SEQ; p0 += 8) {
        __syncthreads();
        { const int st = tid >> 4, pc = tid & 15, p = p0 + st; int row;
          if (p < CTX) row = NLAT + b * CTX + (dir ? CTX - 1 - p : p); else { const int q = p - CTX; row = b * SEQ + (dir ? SEQ - 1 - q : q); }
          const u32x4 w = *(const u32x4*)(CQK + (size_t)row * 512 + (pc < 8 ? h * 64 + pc * 8 : 256 + h * 64 + (pc - 8) * 8));
          float* dst = pc < 8 ? &qs[st][pc * 8] : &ks[st][(pc - 8) * 8];
          dst[0] = bflo(w.x); dst[1] = bfhi(w.x); dst[2] = bflo(w.y); dst[3] = bfhi(w.y); dst[4] = bflo(w.z); dst[5] = bfhi(w.z); dst[6] = bflo(w.w); dst[7] = bfhi(w.w); }
        __syncthreads();
        for (int st = 0; st < 8; ++st) {
            const int p = p0 + st; int row;
            if (p < CTX) row = NLAT + b * CTX + (dir ? CTX - 1 - p : p); else { const int q = p - CTX; row = b * SEQ + (dir ? SEQ - 1 - q : q); }
            const float ig = GATES[(size_t)row * 16 + dir * 4 + h], lf = GATES[(size_t)row * 16 + 8 + dir * 4 + h];
            const float v = bf2f(P[(size_t)row * PW + PC_V + h * 128 + tid]);
            const float mn = fmaxf(lf + m, ig), a = __expf(lf + m - mn), w = __expf(ig - mn), wv = w * v; m = mn;
            float num = 0.f, den = 0.f;
#pragma unroll
            for (int d = 0; d < 64; ++d) { const float kd = ks[st][d], qd = qs[st][d]; C[d] = a * C[d] + wv * kd; n[d] = a * n[d] + w * kd; num += C[d] * qd; den += n[d] * qd; }
            OUT[(size_t)row * D + h * 128 + tid] = num / fmaxf(fabsf(den), __expf(-mn));
        }
    }
}
__global__ void __launch_bounds__(128) naive_hgrn(const bf16* CQI, const bf16* P, const float* fb_l, const float* lbraw, int l, float* HF, float* HB) {
    __shared__ float fs[8][128], ks[8][128], qs[8][128];
    const int b = blockIdx.x >> 3, h = (blockIdx.x >> 1) & 3, dir = blockIdx.x & 1, tid = threadIdx.x, ch = h * 128 + tid;
    float S[128];
#pragma unroll
    for (int d = 0; d < 128; ++d) S[d] = 0.f;
    float lb = 0.f;
    if (l == 1) { const float r0 = lbraw[ch], r1 = lbraw[512 + ch], mx = fmaxf(r0, r1), e0 = __expf(r0 - mx), e1 = __expf(r1 - mx); lb = e1 / (e0 + e1); }
    const float bias = fb_l[dir * 512 + ch];
    float* OUT = dir ? HB : HF;
    for (int p0 = 0; p0 < CTX + SEQ; p0 += 8) {
        __syncthreads();
        float vv[8]; int rows[8];
#pragma unroll
        for (int st = 0; st < 8; ++st) { const int p = p0 + st; int row;
            if (p < CTX) row = NLAT + b * CTX + (dir ? CTX - 1 - p : p); else { const int q = p - CTX; row = b * SEQ + (dir ? SEQ - 1 - q : q); }
            rows[st] = row;
            const float z = bf2f(P[(size_t)row * PW + (dir ? PC_FB : PC_FF) + ch]) + bias;
            fs[st][tid] = lb + (1.f - lb) * sigmoidf_(z); ks[st][tid] = (1.f - lb) * sigmoidf_(-z);
            qs[st][tid] = bf2f(CQI[(size_t)row * 1024 + ch]); vv[st] = bf2f(CQI[(size_t)row * 1024 + 512 + ch]); }
        __syncthreads();
#pragma unroll
        for (int st = 0; st < 8; ++st) { float o = 0.f; const float v = vv[st];
#pragma unroll
            for (int d = 0; d < 128; ++d) { S[d] = fs[st][d] * S[d] + ks[st][d] * v; o += qs[st][d] * S[d]; }
            OUT[(size_t)rows[st] * D + 512 + ch] = o; }
    }
}

extern "C" void kernel_launch(void* const* d_in, const int* in_sizes, int n_in, void* d_out, int out_size, void* d_ws, size_t ws_size, hipStream_t stream) {
    static int grid = 0;
    if (grid == 0) {
        if (n_in != 24 || in_sizes[0] != NLAT * D || out_size != NLAT * D || ws_size < WS_END) { fprintf(stderr, "kernel_launch: unexpected shapes n_in %d in0 %d out %d ws %zu (need %zu)\n", n_in, n_in > 0 ? in_sizes[0] : -1, out_size, ws_size, (size_t)WS_END); grid = -1; return; }
        int dev = 0, cus = 0;
        if (hipGetDevice(&dev) != hipSuccess || hipDeviceGetAttribute(&cus, hipDeviceAttributeMultiprocessorCount, dev) != hipSuccess) { grid = -1; return; }
        if (hipFuncSetAttribute((const void*)fwd, hipFuncAttributeMaxDynamicSharedMemorySize, LDS_BYTES) != hipSuccess) { fprintf(stderr, "kernel_launch: hipFuncSetAttribute failed\n"); grid = -1; return; }
        grid = cus;
    }
    if (grid < 0) return;
    (void)hipMemsetAsync((char*)d_ws + WS_CTL, 0, 1 * MiB, stream);
    Args a{};
    for (int i = 0; i < 24; ++i) a.in[i] = (const float*)d_in[i];
    a.out = (float*)d_out; a.ws = (unsigned char*)d_ws; a.ph_lo = 0; a.ph_hi = 0;
    unsigned char* ws = (unsigned char*)d_ws;
    const float* const* in = a.in;
    int* rt = (int*)(ws + WS_ROUTE);
    a.ph_lo = 0; a.ph_hi = NPHASE;
    hipLaunchKernelGGL(fwd, dim3(grid), dim3(NTHR), LDS_BYTES, stream, a);
}
```

```cpp
#include <hip/hip_runtime.h>
#include <cstdio>
#include <cstdint>

#define GAS __attribute__((address_space(1)))
#define LAS __attribute__((address_space(3)))
typedef unsigned short bf16;
typedef float f32x4 __attribute__((ext_vector_type(4)));
typedef unsigned u32x4 __attribute__((ext_vector_type(4)));
typedef unsigned u32x2 __attribute__((ext_vector_type(2)));

constexpr int D = 1024, BATCH = 2, SEQ = 8192, DEPTH = 2, CTX = 256, GRIDW = 64;
constexpr int NLAT = BATCH * SEQ, NCTX = BATCH * CTX, NTOK = NLAT + NCTX;
constexpr int INW = 4112, PW = 4096;
constexpr int PC_QK = 0, PC_V = 512, PC_O = 1024, PC_QI = 1536, PC_FF = 2560, PC_FB = 3072, PC_GO = 3584;
constexpr int NEXP = 32, TOPK = 4, DEXP = 1024;
constexpr int MAXSLOT = (NTOK * TOPK / 256 + NEXP) * 256;
constexpr int MAXTILE = MAXSLOT / 256;
constexpr float EPS = 1e-6f;

constexpr size_t MiB = 1u << 20;
constexpr size_t WS_CTL = 0;
constexpr size_t WS_MOD = 1 * MiB;
constexpr size_t WS_GATES = 2 * MiB;
constexpr size_t WS_ROUTE = 4 * MiB;
constexpr size_t WS_X = 8 * MiB;
constexpr size_t WS_H = 76 * MiB;
constexpr size_t WS_P = 112 * MiB;
constexpr size_t WS_CQK = 246 * MiB;
constexpr size_t WS_CQI = 264 * MiB;
constexpr size_t WS_HF = 300 * MiB;
constexpr size_t WS_HB = 368 * MiB;
constexpr size_t WS_Y = 436 * MiB;
constexpr size_t WS_ACT = 472 * MiB;
constexpr size_t WS_YS = 622 * MiB;
constexpr size_t WS_WIN = 772 * MiB;
constexpr size_t WS_WOUT = 788 * MiB;
constexpr size_t WS_WGU = 792 * MiB;
constexpr size_t WS_WDN = 1048 * MiB;
constexpr size_t WS_MLC = 1176 * MiB;
constexpr size_t WS_MLN = 1246 * MiB;
constexpr size_t WS_MLS = 1247 * MiB;
constexpr size_t WS_HGS = 1248 * MiB;
constexpr size_t WS_HGG = 1388 * MiB;
constexpr size_t WS_MLCB = 1390 * MiB;
constexpr size_t WS_HGSB = 1426 * MiB;
constexpr size_t WS_END = 1496 * MiB;
constexpr int NTC = 132;
constexpr int RT_TOPI = 0;
constexpr int RT_TOPG = RT_TOPI + NTOK * 4;
constexpr int RT_POS = RT_TOPG + NTOK * 4;
constexpr int RT_SLOT = RT_POS + NTOK * 4;
constexpr int RT_LIST = RT_SLOT + NTOK * 4;
constexpr int RT_SGATE = RT_LIST + MAXSLOT;
constexpr int RT_TILEE = RT_SGATE + MAXSLOT;
constexpr int RT_BLKCNT = RT_TILEE + MAXTILE + 8;
constexpr int MAXG = 1024;
constexpr int RT_END = RT_BLKCNT + MAXG * 32;
static_assert((size_t)RT_END * 4 <= 4 * MiB, "route map");
constexpr int CW_CNT = 1024;
constexpr int CW_BAR = 4096;

typedef float f32x2_t __attribute__((ext_vector_type(2)));
typedef __bf16 bf16x2_t __attribute__((ext_vector_type(2)));
__device__ __forceinline__ unsigned pk2(float lo, float hi) { const f32x2_t v = {lo, hi}; return __builtin_bit_cast(unsigned, __builtin_convertvector(v, bf16x2_t)); }
__device__ __forceinline__ unsigned f2bf(float f) { return pk2(f, 0.f) & 0xffffu; }
__device__ __forceinline__ float bf2f(unsigned short b) { return __builtin_bit_cast(float, (unsigned)b << 16); }
__device__ __forceinline__ float bflo(unsigned w) { return __builtin_bit_cast(float, w << 16); }
__device__ __forceinline__ float bfhi(unsigned w) { return __builtin_bit_cast(float, w & 0xffff0000u); }
__device__ __forceinline__ float sigmoidf_(float x) { return 1.f / (1.f + __expf(-x)); }
__device__ __forceinline__ float siluf_(float x) { return x / (1.f + __expf(-x)); }
__device__ __forceinline__ float logsigmoidf_(float x) { return x >= 0.f ? -log1pf(__expf(-x)) : x - log1pf(__expf(x)); }
template <int CTRL, int ROWMASK, bool BOUND0>
__device__ __forceinline__ float dppf(float old, float x) { return __builtin_bit_cast(float, __builtin_amdgcn_update_dpp(__builtin_bit_cast(int, old), __builtin_bit_cast(int, x), CTRL, ROWMASK, 0xf, BOUND0)); }
__device__ __forceinline__ float half_sum_hi(float x) {
    x += dppf<0xB1, 0xf, true>(0.f, x); x += dppf<0x4E, 0xf, true>(0.f, x); x += dppf<0x114, 0xf, true>(0.f, x); x += dppf<0x118, 0xf, true>(0.f, x);
    x += dppf<0x142, 0xa, true>(0.f, x); return x; }
__device__ __forceinline__ float wave_sum(float v) {
    v = half_sum_hi(v); v += dppf<0x143, 0xc, true>(0.f, v); return __builtin_bit_cast(float, __builtin_amdgcn_readlane(__builtin_bit_cast(int, v), 63)); }
__device__ __forceinline__ float wave_incl_sum(float v, int) {
    v += dppf<0x111, 0xf, true>(0.f, v); v += dppf<0x112, 0xf, true>(0.f, v); v += dppf<0x114, 0xf, true>(0.f, v); v += dppf<0x118, 0xf, true>(0.f, v);
    v += dppf<0x142, 0xa, true>(0.f, v); v += dppf<0x143, 0xc, true>(0.f, v); return v; }
__device__ __forceinline__ float wave_incl_max(float v, int) {
    const float NI = -INFINITY;
    v = fmaxf(v, dppf<0x111, 0xf, false>(NI, v)); v = fmaxf(v, dppf<0x112, 0xf, false>(NI, v)); v = fmaxf(v, dppf<0x114, 0xf, false>(NI, v)); v = fmaxf(v, dppf<0x118, 0xf, false>(NI, v));
    v = fmaxf(v, dppf<0x142, 0xa, false>(NI, v)); v = fmaxf(v, dppf<0x143, 0xc, false>(NI, v)); return v; }
__device__ __forceinline__ float wave_max(float v) { v = wave_incl_max(v, 0); return __builtin_bit_cast(float, __builtin_amdgcn_readlane(__builtin_bit_cast(int, v), 63)); }
__device__ __forceinline__ int mrow_of(int r) { return r < NLAT ? (r >> 13) : 2; }

struct Args { const float* in[24]; float* out; unsigned char* ws; int ph_lo, ph_hi; };
typedef const __attribute__((address_space(4))) Args CArgs;

enum { I_X = 0, I_C, I_CTX, I_CCTX, I_WADA, I_BADA, I_N1G, I_WIN, I_MLCONV, I_MLGB, I_MLNG, I_HGCONV, I_HGFB, I_HGLB, I_HGNG, I_WOUT, I_N2G, I_RW, I_RB, I_WGU, I_BGU, I_WDN, I_BDN, I_FG };

constexpr int NWAVES = 8, NTHR = 512;
constexpr int LDS_BYTES = 147456;

struct Frame {
    LAS unsigned char* lds;
    float* out; unsigned char* ws;
    int tid, lane, wave, vcu, G;
};

__device__ __forceinline__ void ph_init(Frame& F, CArgs& A) {
    const int gt = F.vcu * NTHR + F.tid, NG = F.G * NTHR;
    if (gt < 128) ((u32x4*)(F.ws + WS_H + (size_t)NTOK * D * 2))[gt] = (u32x4){0u, 0u, 0u, 0u};
    LAS float* sc = (LAS float*)F.lds;
    LAS float* part = sc + 3 * 1024;
    for (int i = F.tid; i < 3 * 1024; i += NTHR) { const int r = i >> 10, k = i & 1023; const float c = r < 2 ? A.in[I_C][r * 1024 + k] : A.in[I_CCTX][k]; sc[i] = siluf_(c); }
    __syncthreads();
    for (int item = F.vcu; item < DEPTH * 96; item += F.G) {
        const int l = item / 96, j = (item % 96) * 64 + F.lane;
        const float* w = A.in[I_WADA] + (size_t)l * D * 6144 + j;
        float a0 = 0.f, a1 = 0.f, a2 = 0.f;
        for (int k0 = F.wave * 128; k0 < F.wave * 128 + 128; k0 += 32) { float wv[32];
#pragma unroll
            for (int i = 0; i < 32; ++i) wv[i] = w[(size_t)(k0 + i) * 6144];
#pragma unroll
            for (int i = 0; i < 32; ++i) { a0 += sc[k0 + i] * wv[i]; a1 += sc[1024 + k0 + i] * wv[i]; a2 += sc[2048 + k0 + i] * wv[i]; } }
        part[(F.wave * 3 + 0) * 64 + F.lane] = a0; part[(F.wave * 3 + 1) * 64 + F.lane] = a1; part[(F.wave * 3 + 2) * 64 + F.lane] = a2;
        __syncthreads();
        if (F.tid < 192) { const int r = F.tid >> 6, ln = F.tid & 63; float s = 0.f;
#pragma unroll
            for (int w8 = 0; w8 < 8; ++w8) s += part[(w8 * 3 + r) * 64 + ln];
            const int jj = (item % 96) * 64 + ln;
            ((float*)(F.ws + WS_MOD))[(l * 3 + r) * 6144 + jj] = s + A.in[I_BADA][l * 6144 + jj]; }
        __syncthreads();
    }
}

typedef unsigned u32x2v __attribute__((ext_vector_type(2)));
__device__ __forceinline__ float xor32(float send, int lane) { const unsigned u = __builtin_bit_cast(unsigned, send); const u32x2v r = __builtin_amdgcn_permlane32_swap(u, u, false, false);
    return __builtin_bit_cast(float, (lane & 32) ? r.x : r.y); }
__device__ __forceinline__ float xor16(float send, int lane) { const unsigned u = __builtin_bit_cast(unsigned, send); const u32x2v r = __builtin_amdgcn_permlane16_swap(u, u, false, false);
    return __builtin_bit_cast(float, (lane & 16) ? r.x : r.y); }
__device__ __forceinline__ float xor8(float x) { return dppf<0x140, 0xf, true>(0.f, dppf<0x141, 0xf, true>(0.f, x)); }
__device__ __forceinline__ float xor4(float x) { return dppf<0x141, 0xf, true>(0.f, dppf<0x1B, 0xf, true>(0.f, x)); }
__device__ __forceinline__ float xor2(float x) { return dppf<0x4E, 0xf, true>(0.f, x); }
__device__ __forceinline__ float xor1(float x) { return dppf<0xB1, 0xf, true>(0.f, x); }
template <int NV> __device__ __forceinline__ float reduce_scatter(float (&v)[NV], int lane) {
    float a16[16];
    if constexpr (NV == 32) { const bool hi = lane & 32;
#pragma unroll
        for (int i = 0; i < 16; ++i) { const float keep = hi ? v[16 + i] : v[i], send = hi ? v[i] : v[16 + i]; a16[i] = keep + xor32(send, lane); } }
    else {
#pragma unroll
        for (int i = 0; i < 16; ++i) a16[i] = v[i] + xor1(v[i]); }
    float a8[8], a4[4], a2[2];
    { const bool hi = lane & 16;
#pragma unroll
      for (int i = 0; i < 8; ++i) { const float keep = hi ? a16[8 + i] : a16[i], send = hi ? a16[i] : a16[8 + i]; a8[i] = keep + xor16(send, lane); } }
    { const bool hi = lane & 8;
#pragma unroll
      for (int i = 0; i < 4; ++i) { const float keep = hi ? a8[4 + i] : a8[i], send = hi ? a8[i] : a8[4 + i]; a4[i] = keep + xor8(send); } }
    { const bool hi = lane & 4;
#pragma unroll
      for (int i = 0; i < 2; ++i) { const float keep = hi ? a4[2 + i] : a4[i], send = hi ? a4[i] : a4[2 + i]; a2[i] = keep + xor4(send); } }
    float r;
    { const bool hi = lane & 2; const float keep = hi ? a2[1] : a2[0], send = hi ? a2[0] : a2[1]; r = keep + xor2(send); }
    if constexpr (NV == 32) r += xor1(r); else r += xor32(r, lane);
    return r;
}
struct RowIn { f32x4 x[4]; u32x2 y[4][4]; };
template <int SRC>
__device__ __forceinline__ void row_load(Frame& F, CArgs& A, int r, const int (&slot)[4], RowIn& R) {
    const float* src = SRC == 1 ? (r < NLAT ? A.in[I_X] + (size_t)r * D : A.in[I_CTX] + (size_t)(r - NLAT) * D) : (const float*)(F.ws + WS_X) + (size_t)r * D;
    const f32x4* xr = (const f32x4*)src + F.lane;
#pragma unroll
    for (int j = 0; j < 4; ++j) R.x[j] = xr[64 * j];
    if (SRC == 2) {
#pragma unroll
        for (int k = 0; k < 4; ++k) { const u32x2* yp = (const u32x2*)(F.ws + WS_YS + (size_t)slot[k] * D * 2) + F.lane;
#pragma unroll
            for (int j = 0; j < 4; ++j) R.y[k][j] = yp[64 * j]; } }
}
#define LDS_BARRIER() do { asm volatile("s_waitcnt lgkmcnt(0)" ::: "memory"); __builtin_amdgcn_s_barrier(); asm volatile("" ::: "memory"); } while (0)
template <int SRC, int MODE>
__device__ __forceinline__ void ph_rows(Frame& F, CArgs& A, int lsrc, int l, int nrows) {
    constexpr int NV = MODE == 0 ? 16 : 32;
    constexpr int EPW = NV / 8;
    f32x2_t wp[EPW][4][2];
    LAS unsigned* lcnt = (LAS unsigned*)(F.lds + 131072);
    if (MODE == 1) { const float* w = A.in[I_RW] + (size_t)l * D * NEXP + 4 * F.wave; if (F.tid < 32) lcnt[F.tid] = 0u;
#pragma unroll
        for (int j = 0; j < 4; ++j) { f32x4 q[4];
#pragma unroll
            for (int i = 0; i < 4; ++i) q[i] = *(const f32x4*)(w + (size_t)(256 * j + 4 * F.lane + i) * NEXP);
#pragma unroll
            for (int e = 0; e < EPW; ++e) { wp[e][j][0] = (f32x2_t){q[0][e], q[1][e]}; wp[e][j][1] = (f32x2_t){q[2][e], q[3][e]}; } } }
    if (MODE == 0) { const float* w = A.in[I_WIN] + (size_t)l * D * INW + 1536 + 2 * F.wave;
#pragma unroll
        for (int j = 0; j < 4; ++j) { f32x2_t q[4];
#pragma unroll
            for (int i = 0; i < 4; ++i) q[i] = *(const f32x2_t*)(w + (size_t)(256 * j + 4 * F.lane + i) * INW);
#pragma unroll
            for (int e = 0; e < EPW; ++e) { wp[e][j][0] = (f32x2_t){q[0][e], q[1][e]}; wp[e][j][1] = (f32x2_t){q[2][e], q[3][e]}; } } }
    const float* gam = MODE == 0 ? A.in[I_N1G] + l * D : (MODE == 1 ? A.in[I_N2G] + l * D : A.in[I_FG]);
    const float* MOD = (const float*)(F.ws + WS_MOD) + (size_t)l * 3 * 6144;
    const float* MODS = (const float*)(F.ws + WS_MOD) + (size_t)lsrc * 3 * 6144;
    const int* rt = (const int*)(F.ws + WS_ROUTE);
    const int stride = F.G * NWAVES; int r = F.vcu * NWAVES + F.wave;
    RowIn cur; int s1[4] = {0, 0, 0, 0}, s2[4] = {0, 0, 0, 0};
    if (SRC == 2) { if (r < nrows) { const u32x4 q = *(const u32x4*)(rt + RT_SLOT + r * 4); s1[0] = q.x; s1[1] = q.y; s1[2] = q.z; s1[3] = q.w; }
                    if (r + stride < nrows) { const u32x4 q = *(const u32x4*)(rt + RT_SLOT + (r + stride) * 4); s2[0] = q.x; s2[1] = q.y; s2[2] = q.z; s2[3] = q.w; } }
    if (r < nrows) row_load<SRC>(F, A, r, s1, cur);
    f32x4 Aq[4], Sq[4], Gq[4]; int mrp = -1;
    const float rbm = MODE == 1 ? A.in[I_RB][l * NEXP + 4 * F.wave + ((F.lane >> 1) & 3)] : 0.f;
    for (; r < nrows; r += stride) {
        RowIn nxt; int s3[4] = {0, 0, 0, 0};
        { const int mr = mrow_of(r);
          if (mr != mrp) { mrp = mr; const float* mod = MOD + mr * 6144 + (MODE == 0 ? 0 : 3072); const float* g2 = MODS + mr * 6144 + 5 * 1024;
#pragma unroll
              for (int j = 0; j < 4; ++j) { const int c = 256 * j + 4 * F.lane; const f32x4 g = *(const f32x4*)(gam + c);
                  if (MODE != 2) { const f32x4 sh = *(const f32x4*)(mod + c), scl = *(const f32x4*)(mod + 1024 + c); Aq[j] = g * (1.f + scl); Sq[j] = sh; } else { Aq[j] = g; Sq[j] = (f32x4){0.f, 0.f, 0.f, 0.f}; }
                  if (SRC == 2) Gq[j] = *(const f32x4*)(g2 + c); } } }
        if (SRC == 2 && r + 2 * stride < nrows) { const u32x4 q = *(const u32x4*)(rt + RT_SLOT + (r + 2 * stride) * 4); s3[0] = q.x; s3[1] = q.y; s3[2] = q.z; s3[3] = q.w; }
        if (r + stride < nrows) row_load<SRC>(F, A, r + stride, s2, nxt);
        f32x4 v[4];
#pragma unroll
        for (int j = 0; j < 4; ++j) v[j] = cur.x[j];
        if (SRC == 2) {
#pragma unroll
            for (int j = 0; j < 4; ++j) { f32x4 a = (f32x4){0.f, 0.f, 0.f, 0.f};
#pragma unroll
                for (int k = 0; k < 4; ++k) { const u32x2 w = cur.y[k][j]; a += (f32x4){bflo(w.x), bfhi(w.x), bflo(w.y), bfhi(w.y)}; }
                v[j] = v[j] + Gq[j] * a; } }
        if (SRC == 2 && MODE != 2) { f32x4* xo = (f32x4*)((float*)(F.ws + WS_X) + (size_t)r * D) + F.lane;
#pragma unroll
            for (int j = 0; j < 4; ++j) xo[64 * j] = v[j]; }
        float ss = 0.f;
#pragma unroll
        for (int j = 0; j < 4; ++j) ss += (v[j].x * v[j].x + v[j].y * v[j].y) + (v[j].z * v[j].z + v[j].w * v[j].w);
        const float rstd = rsqrtf(wave_sum(ss) * (1.f / D) + EPS);
#pragma unroll
        for (int j = 0; j < 4; ++j) { v[j] = v[j] * rstd * Aq[j]; if (MODE != 2) v[j] = v[j] + Sq[j]; }
        if (MODE == 2) { f32x4* o = (f32x4*)(F.out + (size_t)r * D) + F.lane;
#pragma unroll
            for (int j = 0; j < 4; ++j) o[64 * j] = v[j]; }
        else {
            u32x2* ho = (u32x2*)(F.ws + WS_H + (size_t)r * D * 2) + F.lane;
#pragma unroll
            for (int j = 0; j < 4; ++j) ho[64 * j] = (u32x2){pk2(v[j].x, v[j].y), pk2(v[j].z, v[j].w)};
            LAS f32x4* hb = (LAS f32x4*)F.lds;
            LAS float* lg = (LAS float*)(F.lds + 32768);
#pragma unroll
            for (int j = 0; j < 4; ++j) hb[(F.wave * 4 + j) * 64 + F.lane] = v[j];
            LDS_BARRIER();
            float part[NV];
#pragma unroll
            for (int q = 0; q < 8; ++q) { f32x4 hq[4];
#pragma unroll
                for (int j = 0; j < 4; ++j) hq[j] = hb[(q * 4 + j) * 64 + F.lane];
#pragma unroll
                for (int e = 0; e < EPW; ++e) { f32x2_t a2 = {0.f, 0.f};
#pragma unroll
                    for (int j = 0; j < 4; ++j) { a2 += (f32x2_t){hq[j].x, hq[j].y} * wp[e][j][0]; a2 += (f32x2_t){hq[j].z, hq[j].w} * wp[e][j][1]; }
                    part[q * EPW + e] = a2.x + a2.y; } }
            const float mine = reduce_scatter<NV>(part, F.lane);
            if (MODE == 0) { const int g = (F.lane >> 1) & 15; if ((F.lane & 33) == 0) lg[(g >> 1) * 16 + 2 * F.wave + (g & 1)] = mine; }
            else { const int g = (F.lane >> 1) & 31; if ((F.lane & 1) == 0) lg[(g >> 2) * 32 + 4 * F.wave + (g & 3)] = mine + rbm; }
            LDS_BARRIER();
            if (MODE == 0) {
                if (F.lane < 16) { const int g = F.lane; float val = lg[F.wave * 16 + g] + A.in[I_MLGB][l * 16 + g];
                    if (g >= 8) val = logsigmoidf_(val);
                    ((float*)(F.ws + WS_GATES))[(size_t)r * 16 + g] = val; }
            } else {
                const int e = F.lane & 31; const float my = lg[F.wave * 32 + e]; int rank = 0;
#pragma unroll
                for (int q = 0; q < 8; ++q) { const f32x4 t = *(const LAS f32x4*)(lg + F.wave * 32 + 4 * q);
#pragma unroll
                    for (int c = 0; c < 4; ++c) { const int j = 4 * q + c; rank += (t[c] > my || (t[c] == my && j < e)) ? 1 : 0; } }
                float tv[4]; int ti[4];
#pragma unroll
                for (int p = 0; p < 4; ++p) { const unsigned bal = (unsigned)__ballot(rank == p); const int bi = __ffs((int)bal) - 1;
                    ti[p] = bi; tv[p] = __builtin_bit_cast(float, __builtin_amdgcn_readlane(__builtin_bit_cast(int, my), bi)); }
                const float e1 = __expf(tv[1] - tv[0]), e2 = __expf(tv[2] - tv[0]), e3 = __expf(tv[3] - tv[0]); const float inv = 1.f / (1.f + e1 + e2 + e3);
                if (F.lane == 0) {
                    int* rtw = (int*)(F.ws + WS_ROUTE);
                    const float gs[4] = {inv, e1 * inv, e2 * inv, e3 * inv};
#pragma unroll
                    for (int p = 0; p < 4; ++p) { rtw[RT_TOPI + r * 4 + p] = ti[p]; ((float*)rtw)[RT_TOPG + r * 4 + p] = gs[p]; rtw[RT_POS + r * 4 + p] = (int)__hip_atomic_fetch_add(lcnt + ti[p], 1u, __ATOMIC_RELAXED, __HIP_MEMORY_SCOPE_WORKGROUP); }
                }
            }
        }
        cur = nxt;
#pragma unroll
        for (int k = 0; k < 4; ++k) { s2[k] = s3[k]; }
    }
    if (MODE == 1) { __syncthreads(); if (F.tid < 32) ((int*)(F.ws + WS_ROUTE))[RT_BLKCNT + F.vcu * 32 + F.tid] = (int)lcnt[F.tid]; }
}

__device__ __forceinline__ void ph_lists(Frame& F, CArgs& A, int l, int nrows) {
    LAS int* off = (LAS int*)F.lds;
    LAS int* pre = (LAS int*)(F.lds + 1024);
    int* rt = (int*)(F.ws + WS_ROUTE);
    if (F.tid < 32) { int run = 0; for (int v = 0; v < F.G; ++v) { pre[v * 32 + F.tid] = run; run += rt[RT_BLKCNT + v * 32 + F.tid]; } off[64 + F.tid] = run; }
    __syncthreads();
    if (F.tid == 0) { int o = 0; for (int e = 0; e < NEXP; ++e) { off[e] = o; o += (off[64 + e] + 255) & ~255; } off[32] = o; }
    __syncthreads();
    const int gt = F.vcu * NTHR + F.tid, NG = F.G * NTHR;
    for (int i = gt; i < nrows * 4; i += NG) { const int r = i >> 2, e = rt[RT_TOPI + i], v = (r % (F.G * NWAVES)) / NWAVES, s = off[e] + pre[v * 32 + e] + rt[RT_POS + i];
        rt[RT_SLOT + i] = s; rt[RT_LIST + s] = r; ((float*)rt)[RT_SGATE + s] = ((const float*)rt)[RT_TOPG + i]; }
    const int total = off[32];
    for (int s = gt; s < total; s += NG) { int e = 0;
#pragma unroll 1
        for (int q = 1; q < NEXP; ++q) if (s >= off[q]) e = q;
        if (s - off[e] >= off[64 + e]) { rt[RT_LIST + s] = NTOK; ((float*)rt)[RT_SGATE + s] = 0.f; }
        if ((s & 255) == 0) rt[RT_TILEE + 8 + (s >> 8)] = e; }
    if (gt == 0) rt[RT_TILEE] = total >> 8;
}

__device__ __forceinline__ void ph_conv(Frame& F, CArgs& A, int l) {
    LAS float* cw = (LAS float*)F.lds;
    { const f32x4* wm = (const f32x4*)(A.in[I_MLCONV] + (size_t)l * 9 * 512); const f32x4* wh = (const f32x4*)(A.in[I_HGCONV] + (size_t)l * 9 * 1024);
      f32x4 vm[3], vh[5];
#pragma unroll
      for (int j = 0; j < 3; ++j) { const int i = F.tid + NTHR * j; vm[j] = i < 9 * 128 ? wm[i] : (f32x4){0.f, 0.f, 0.f, 0.f}; }
#pragma unroll
      for (int j = 0; j < 5; ++j) { const int i = F.tid + NTHR * j; vh[j] = i < 9 * 256 ? wh[i] : (f32x4){0.f, 0.f, 0.f, 0.f}; }
#pragma unroll
      for (int j = 0; j < 3; ++j) { const int i = F.tid + NTHR * j; if (i < 9 * 128) *(LAS f32x4*)(cw + (i / 128) * 1536 + (i % 128) * 4) = vm[j]; }
#pragma unroll
      for (int j = 0; j < 5; ++j) { const int i = F.tid + NTHR * j; if (i < 9 * 256) *(LAS f32x4*)(cw + (i / 256) * 1536 + 512 + (i % 256) * 4) = vh[j]; } }
    __syncthreads();
    const bf16* P = (const bf16*)(F.ws + WS_P);
    const int gt = F.vcu * NTHR + F.tid, NG = F.G * NTHR;
    constexpr int NLATQ = BATCH * 128 * 16, NQ = NLATQ + BATCH * 64;
    for (int it = gt; it < NQ * 192; it += NG) {
        const int qd = it / 192, cg = it % 192, c = cg * 8, pc = c < 512 ? PC_QK + c : PC_QI + (c - 512);
        int base, row, x0, nrow, ncol;
        if (qd < NLATQ) { const int b = qd >> 11, y = (qd >> 4) & 127, xq = qd & 15; base = b << 13; row = y; x0 = xq * 4; nrow = 128; ncol = 64; }
        else { const int q = qd - NLATQ, b = q >> 6; base = NLAT + (b << 8); row = 0; x0 = (q & 63) * 4; nrow = 1; ncol = 256; }
        const int r0 = base + row * ncol + x0;
        u32x4 tap[3][6];
#pragma unroll
        for (int dy = 0; dy < 3; ++dy)
#pragma unroll
            for (int j = 0; j < 6; ++j) { const int rr = row + dy - 1, cc = x0 + j - 1; const bool v = rr >= 0 && rr < nrow && cc >= 0 && cc < ncol;
                const u32x4 t = *(const u32x4*)(P + (size_t)(v ? base + rr * ncol + cc : r0) * PW + pc);
                tap[dy][j] = v ? t : (u32x4){0u, 0u, 0u, 0u}; }
        f32x2_t a2[4][4];
#pragma unroll
        for (int o = 0; o < 4; ++o)
#pragma unroll
            for (int i = 0; i < 4; ++i) a2[o][i] = (f32x2_t){0.f, 0.f};
#pragma unroll
        for (int dy = 0; dy < 3; ++dy)
#pragma unroll
            for (int dx = 0; dx < 3; ++dx) { const LAS float* w = cw + (dy * 3 + dx) * 1536 + c; const f32x4 w0 = *(const LAS f32x4*)w, w1 = *(const LAS f32x4*)(w + 4);
                const f32x2_t wa = {w0.x, w0.y}, wb = {w0.z, w0.w}, wc = {w1.x, w1.y}, wd = {w1.z, w1.w};
#pragma unroll
                for (int o = 0; o < 4; ++o) { const u32x4 pv = tap[dy][o + dx];
                    a2[o][0] += (f32x2_t){bflo(pv.x), bfhi(pv.x)} * wa; a2[o][1] += (f32x2_t){bflo(pv.y), bfhi(pv.y)} * wb;
                    a2[o][2] += (f32x2_t){bflo(pv.z), bfhi(pv.z)} * wc; a2[o][3] += (f32x2_t){bflo(pv.w), bfhi(pv.w)} * wd; } }
        float a[4][8];
#pragma unroll
        for (int o = 0; o < 4; ++o)
#pragma unroll
            for (int i = 0; i < 4; ++i) { a[o][2 * i] = a2[o][i].x; a[o][2 * i + 1] = a2[o][i].y; }
        const float sc = c < 256 ? 0.125f : 1.f;
#pragma unroll
        for (int o = 0; o < 4; ++o) {
#pragma unroll
            for (int i = 0; i < 8; ++i) a[o][i] = siluf_(a[o][i]) * sc;
            const u32x4 ov = (u32x4){pk2(a[o][0], a[o][1]), pk2(a[o][2], a[o][3]), pk2(a[o][4], a[o][5]), pk2(a[o][6], a[o][7])};
            if (c < 512) *(u32x4*)(F.ws + WS_CQK + ((size_t)(r0 + o) * 512 + c) * 2) = ov; else *(u32x4*)(F.ws + WS_CQI + ((size_t)(r0 + o) * 1024 + (c - 512)) * 2) = ov; }
    }
}

struct HnIn { f32x4 h[4]; u32x2 g[4]; };
__device__ __forceinline__ void hn_load(Frame& F, int r, HnIn& R) {
    const float* HF = (const float*)(F.ws + WS_HF); const bf16* P = (const bf16*)(F.ws + WS_P);
#pragma unroll
    for (int j = 0; j < 4; ++j) { const int c = 256 * j + 4 * F.lane; R.h[j] = *(const f32x4*)(HF + (size_t)r * D + c); R.g[j] = *(const u32x2*)(P + (size_t)r * PW + (c < 512 ? PC_O + c : PC_GO + (c - 512))); }
}
__device__ __forceinline__ void ph_hnorm(Frame& F, CArgs& A, int l, int nrows_lat_only) {
    const int nrows = nrows_lat_only ? NLAT : NTOK, stride = F.G * NWAVES;
    int r = F.vcu * NWAVES + F.wave; HnIn cur; if (r < nrows) hn_load(F, r, cur);
    for (; r < nrows; r += stride) {
        HnIn nxt; if (r + stride < nrows) hn_load(F, r + stride, nxt); else nxt = cur;
        u32x2* yo = (u32x2*)(F.ws + WS_Y + (size_t)r * D * 2) + F.lane;
#pragma unroll
        for (int j = 0; j < 4; ++j) {
            const int c = 256 * j + 4 * F.lane;
            f32x4 h = cur.h[j];
            float ss = (h.x * h.x + h.y * h.y) + (h.z * h.z + h.w * h.w);
#pragma unroll
            for (int o = 1; o < 32; o <<= 1) ss += __shfl_xor(ss, o);
            const float rstd = rsqrtf(ss * (1.f / 128.f) + EPS);
            const f32x4 g = c < 512 ? *(const f32x4*)(A.in[I_MLNG] + l * 512 + c) : *(const f32x4*)(A.in[I_HGNG] + l * 512 + (c - 512));
            const u32x2 gw = cur.g[j];
            float ga[4] = {bflo(gw.x), bfhi(gw.x), bflo(gw.y), bfhi(gw.y)};
#pragma unroll
            for (int i = 0; i < 4; ++i) ga[i] = c < 512 ? sigmoidf_(ga[i]) : siluf_(ga[i]);
            h = h * rstd * g;
            yo[64 * j] = (u32x2){pk2(h.x * ga[0], h.y * ga[1]), pk2(h.z * ga[2], h.w * ga[3])};
        }
        cur = nxt;
    }
}

namespace pg8 {
typedef short bf16x8 __attribute__((ext_vector_type(8)));
constexpr int BM = 256, BK = 64, HALF = 128, HTB = HALF * BK * 2, STAGE_BYTES = 8 * HTB, NXCD = 8, WGM = 8;
__device__ __forceinline__ int lds_byte(int r, int c) { const int st = (r >> 4) * 2 + (c >> 5), rr = r & 15, cc = c & 31, ob = rr * 64 + cc * 2; return st * 1024 + (ob ^ (((ob >> 9) & 1) << 5)); }
__device__ __forceinline__ void stage_rc(int b, int& R, int& C) { const int st = b / 1024, sb = b % 1024, swz = sb ^ (((sb >> 9) & 1) << 5); R = (st >> 1) * 16 + swz / 64; C = (st & 1) * 32 + (swz % 64) / 2; }
__device__ __forceinline__ int perm32(int rho) { const int n = rho >> 4, i = rho & 15; return 8 * (i >> 2) + 4 * n + (i & 3); }
struct Unit { int pm, pn, e; };
struct Gemm { const bf16* A; const bf16* Bt; int K; const int* gather; const int* tile_e; size_t bexp;   };
struct StaticOrder {
    int nM, nN, nwg, G, c;
    __device__ void init(int nM_, int nN_, int G_, int c_) { nM = nM_; nN = nN_; nwg = nM * nN; G = G_; c = c_; }
    __device__ bool next(int i, Unit& u) const {
        const long L = (long)i * G + c; if (L >= nwg) return false;
        int wgid = (int)L; { const int q = nwg / NXCD, r = nwg % NXCD, xcd = wgid % NXCD, off = wgid / NXCD; wgid = (xcd < r ? xcd * (q + 1) : r * (q + 1) + (xcd - r) * q) + off; }
        const int nig = WGM * nN, gid = wgid / nig, fm = gid * WGM, gsz = (nM - fm) < WGM ? (nM - fm) : WGM;
        u.pm = fm + ((wgid % nig) % gsz); u.pn = (wgid % nig) / gsz; u.e = 0; return true;
    }
};
__device__ __forceinline__ unsigned cvt_pk_bf16(float lo, float hi) { unsigned r; asm volatile("v_cvt_pk_bf16_f32 %0, %1, %2" : "=v"(r) : "v"(lo), "v"(hi)); return r; }

struct EpiBf16 {
    static constexpr bool PERM = true;
    bf16* O; int ldc;
    __device__ __forceinline__ void operator()(const f32x4 (&acc)[2][2][4][2], const Unit& u, int wr, int wc, int fr, int fq) const {
        const int row0 = u.pm * BM + wr * 64 + fr, col0 = u.pn * BM + wc * 32 + 8 * fq;
#pragma unroll
        for (int ai = 0; ai < 2; ++ai)
#pragma unroll
            for (int m = 0; m < 4; ++m) { bf16* rowp = O + (size_t)(row0 + ai * HALF + m * 16) * ldc + col0;
#pragma unroll
                for (int bj = 0; bj < 2; ++bj) { const f32x4 v0 = acc[ai][bj][m][0], v1 = acc[ai][bj][m][1];
                    u32x4 w; w.x = cvt_pk_bf16(v0[0], v0[1]); w.y = cvt_pk_bf16(v0[2], v0[3]); w.z = cvt_pk_bf16(v1[0], v1[1]); w.w = cvt_pk_bf16(v1[2], v1[3]);
                    *(u32x4*)(rowp + bj * HALF) = w; } }
    }
};
struct EpiResid {
    static constexpr bool PERM = false;
    float* X; const float* MODg; const float* Slat; const float* Sctx;
    __device__ __forceinline__ void operator()(const f32x4 (&acc)[2][2][4][2], const Unit& u, int wr, int wc, int fr, int fq) const {
        const int row0 = u.pm * BM + wr * 64 + fr, col0 = u.pn * BM + wc * 32 + 4 * fq;
        const float* gp = MODg + mrow_of(u.pm * BM) * 6144 + col0;
        f32x4 gv[2][2];
#pragma unroll
        for (int bj = 0; bj < 2; ++bj)
#pragma unroll
            for (int n = 0; n < 2; ++n) gv[bj][n] = *(const f32x4*)(gp + bj * HALF + n * 16);
#pragma unroll
        for (int ai = 0; ai < 2; ++ai) {
            f32x4 xv[4][2][2];
#pragma unroll
            for (int m = 0; m < 4; ++m) { const int rr = row0 + ai * HALF + m * 16; const float* rowp = (rr < NLAT ? Slat + (size_t)rr * D : Sctx + (size_t)(rr - NLAT) * D) + col0;
#pragma unroll
                for (int bj = 0; bj < 2; ++bj)
#pragma unroll
                    for (int n = 0; n < 2; ++n) xv[m][bj][n] = *(const f32x4*)(rowp + bj * HALF + n * 16); }
#pragma unroll
            for (int m = 0; m < 4; ++m) { float* rowp = X + (size_t)(row0 + ai * HALF + m * 16) * D + col0;
#pragma unroll
                for (int bj = 0; bj < 2; ++bj)
#pragma unroll
                    for (int n = 0; n < 2; ++n) *(f32x4*)(rowp + bj * HALF + n * 16) = xv[m][bj][n] + gv[bj][n] * acc[ai][bj][m][n]; } }
    }
};
struct EpiSwiglu {
    static constexpr bool PERM = true;
    bf16* ACT; const float* bgu; const int* tile_e;
    __device__ __forceinline__ void operator()(const f32x4 (&acc)[2][2][4][2], const Unit& u, int wr, int wc, int fr, int fq) const {
        const int e = u.e;
        const int row0 = u.pm * BM + wr * 64 + fr, col0 = u.pn * HALF + wc * 32 + 8 * fq;
        const float* bp = bgu + (size_t)e * 2048 + col0;
        const f32x4 bg0 = *(const f32x4*)bp, bg1 = *(const f32x4*)(bp + 4), bl0 = *(const f32x4*)(bp + 1024), bl1 = *(const f32x4*)(bp + 1028);
#pragma unroll
        for (int ai = 0; ai < 2; ++ai)
#pragma unroll
            for (int m = 0; m < 4; ++m) {
                f32x4 g0 = acc[ai][0][m][0] + bg0, g1 = acc[ai][0][m][1] + bg1, l0 = acc[ai][1][m][0] + bl0, l1 = acc[ai][1][m][1] + bl1; float o[8];
#pragma unroll
                for (int i = 0; i < 4; ++i) { g0[i] = fminf(g0[i], 7.f); g1[i] = fminf(g1[i], 7.f); l0[i] = fminf(fmaxf(l0[i], -7.f), 7.f); l1[i] = fminf(fmaxf(l1[i], -7.f), 7.f); }
                const f32x4 t0 = g0 * (-1.702f * 1.44269504f), t1 = g1 * (-1.702f * 1.44269504f);
                f32x4 e0, e1;
#pragma unroll
                for (int i = 0; i < 4; ++i) { e0[i] = __builtin_amdgcn_exp2f(t0[i]); e1[i] = __builtin_amdgcn_exp2f(t1[i]); }
                e0 = e0 + 1.f; e1 = e1 + 1.f;
#pragma unroll
                for (int i = 0; i < 4; ++i) { e0[i] = __builtin_amdgcn_rcpf(e0[i]); e1[i] = __builtin_amdgcn_rcpf(e1[i]); }
                const f32x4 r0 = (g0 * e0) * (l0 + 1.f), r1 = (g1 * e1) * (l1 + 1.f);
#pragma unroll
                for (int i = 0; i < 4; ++i) { o[i] = r0[i]; o[4 + i] = r1[i]; }
                u32x4 w; w.x = cvt_pk_bf16(o[0], o[1]); w.y = cvt_pk_bf16(o[2], o[3]); w.z = cvt_pk_bf16(o[4], o[5]); w.w = cvt_pk_bf16(o[6], o[7]);
                *(u32x4*)(ACT + (size_t)(row0 + ai * HALF + m * 16) * DEXP + col0) = w; }
    }
};
struct EpiDown {
    static constexpr bool PERM = true;
    bf16* YS; const float* bdn; const float* sgate; const int* tile_e;
    __device__ __forceinline__ void operator()(const f32x4 (&acc)[2][2][4][2], const Unit& u, int wr, int wc, int fr, int fq) const {
        const int e = u.e;
        const int row0 = u.pm * BM + wr * 64 + fr, col0 = u.pn * BM + wc * 32 + 8 * fq;
        f32x4 bv[2][2];
#pragma unroll
        for (int bj = 0; bj < 2; ++bj)
#pragma unroll
            for (int n = 0; n < 2; ++n) bv[bj][n] = *(const f32x4*)(bdn + (size_t)e * D + col0 + bj * HALF + 4 * n);
#pragma unroll
        for (int ai = 0; ai < 2; ++ai)
#pragma unroll
            for (int m = 0; m < 4; ++m) { const int row = row0 + ai * HALF + m * 16; const float sg = sgate[row]; bf16* rowp = YS + (size_t)row * D + col0;
#pragma unroll
                for (int bj = 0; bj < 2; ++bj) { const f32x4 v0 = (acc[ai][bj][m][0] + bv[bj][0]) * sg, v1 = (acc[ai][bj][m][1] + bv[bj][1]) * sg;
                    u32x4 w; w.x = cvt_pk_bf16(v0[0], v0[1]); w.y = cvt_pk_bf16(v0[2], v0[3]); w.z = cvt_pk_bf16(v1[0], v1[1]); w.w = cvt_pk_bf16(v1[2], v1[3]);
                    *(u32x4*)(rowp + bj * HALF) = w; } }
    }
};

template <class Epi, class Sched, bool ALIGN_EPI>
__device__ __forceinline__ void gemm_phase(LAS unsigned char* lds, const Gemm g, const Sched& S, const Epi& E, const int tid) {
    const int wid = __builtin_amdgcn_readfirstlane(tid >> 6), lane = tid & 63, wr = wid >> 2, wc = wid & 3, fr = lane & 15, fq = lane >> 4;
    const int K = g.K, nt = K / BK;
    int RA[2]; unsigned cbA[2], voffB[2];
#pragma unroll
    for (int i = 0; i < 2; ++i) { int R, C; stage_rc(tid * 16 + i * 8192, R, C); const int Rb = Epi::PERM ? ((R & ~31) + perm32(R & 31)) : R;
        RA[i] = R; cbA[i] = (unsigned)C * 2u; voffB[i] = (unsigned)(Rb * K + C) * 2u; }
    const size_t kstep = (size_t)(BK * 2);
    const size_t hstep = (size_t)HALF * K * 2;
    const size_t tstep = 2 * hstep;
    const unsigned ldsw = (unsigned)wid * 1024u;
    const int aoff = lds_byte(wr * 64 + fr, fq * 8), boff = lds_byte(wc * 32 + fr, fq * 8);
#define PG8_SA(b, h) (((b) * 2 + (h)) * HTB)
#define PG8_SB(b, h) ((4 + (b) * 2 + (h)) * HTB)
#define PG8_STAGE(bufoff, gbase, voff) do { _Pragma("unroll") for (int _i = 0; _i < 2; ++_i) \
        __builtin_amdgcn_global_load_lds((const unsigned*)((const char*)(gbase) + (voff)[_i]), (LAS unsigned*)(lds + (bufoff) + ldsw + _i * 8192), 16, 0, 0); } while (0)
#define PG8_LDA(dst, b, h) do { _Pragma("unroll") for (int m = 0; m < 4; ++m) _Pragma("unroll") for (int k = 0; k < 2; ++k) dst[m][k] = *(const LAS bf16x8*)(lds + PG8_SA(b, h) + aoff + m * 2048 + k * 1024); } while (0)
#define PG8_LDB(dst, b, h) do { _Pragma("unroll") for (int n = 0; n < 2; ++n) _Pragma("unroll") for (int k = 0; k < 2; ++k) dst[n][k] = *(const LAS bf16x8*)(lds + PG8_SB(b, h) + boff + n * 2048 + k * 1024); } while (0)
#define PG8_MMA(ai, bj, At, Bt) do { __builtin_amdgcn_s_setprio(1); _Pragma("unroll") for (int m = 0; m < 4; ++m) _Pragma("unroll") for (int n = 0; n < 2; ++n) _Pragma("unroll") for (int k = 0; k < 2; ++k) \
        acc[ai][bj][m][n] = __builtin_amdgcn_mfma_f32_16x16x32_bf16(Bt[n][k], At[m][k], acc[ai][bj][m][n], 0, 0, 0); __builtin_amdgcn_s_setprio(0); } while (0)
#define PG8_WAIT_V(n) asm volatile("s_waitcnt vmcnt(" #n ")" ::: "memory")
#define PG8_WAIT_L(n) asm volatile("s_waitcnt lgkmcnt(" #n ")" ::: "memory")
#define PG8_BAR __builtin_amdgcn_s_barrier()
#define PG8_SCHED __builtin_amdgcn_sched_barrier(0)
#define PG8_AOFF(va, u) do { _Pragma("unroll") for (int _h = 0; _h < 2; ++_h) _Pragma("unroll") for (int _i = 0; _i < 2; ++_i) { const int _r = (u).pm * BM + _h * HALF + RA[_i]; \
        const int _row = g.gather ? g.gather[_r] : _r; va[_h][_i] = (unsigned)_row * (unsigned)(K * 2) + cbA[_i]; } } while (0)
#define PG8_BBASE(u) ((u).e = g.tile_e ? g.tile_e[8 + (u).pm] : 0, (const char*)g.Bt + (size_t)(u).e * g.bexp * 2 + (size_t)(u).pn * tstep)
    Unit cur, nxt; int ui = 0;
    if (!S.next(0, cur)) return;
    f32x4 acc[2][2][4][2];
#pragma unroll
    for (int a = 0; a < 2; ++a)
#pragma unroll
        for (int b = 0; b < 2; ++b)
#pragma unroll
            for (int m = 0; m < 4; ++m)
#pragma unroll
                for (int n = 0; n < 2; ++n) acc[a][b][m][n] = (f32x4){0.f, 0.f, 0.f, 0.f};
    bf16x8 At[4][2], B0[2][2], B1[2][2];
    const char* Ab = (const char*)g.A;
    unsigned cva[2][2], nva[2][2];
    PG8_AOFF(cva, cur);
    const char* cB = PG8_BBASE(cur);
    PG8_STAGE(PG8_SB(0, 0), cB, voffB); PG8_STAGE(PG8_SB(0, 1), cB + hstep, voffB); PG8_STAGE(PG8_SA(0, 0), Ab, cva[0]); PG8_STAGE(PG8_SA(0, 1), Ab, cva[1]);
    if (wr == 1) PG8_BAR;
    PG8_WAIT_V(2); PG8_BAR;
    PG8_STAGE(PG8_SB(1, 0), cB + kstep, voffB); PG8_STAGE(PG8_SA(1, 0), Ab + kstep, cva[0]); PG8_STAGE(PG8_SB(1, 1), cB + hstep + kstep, voffB);
    PG8_WAIT_V(6); PG8_BAR;
    for (;;) {
        const bool has_next = S.next(ui + 1, nxt);
        const char* nB = cB;
        if (has_next) { PG8_AOFF(nva, nxt); nB = PG8_BBASE(nxt); }
        else {
#pragma unroll
            for (int h = 0; h < 2; ++h)
#pragma unroll
                for (int i = 0; i < 2; ++i) nva[h][i] = cva[h][i]; }
        for (int t = 0; t < nt; t += 2) {
            const bool last = (t == nt - 2);
            const char* a1 = Ab + (size_t)(t + 1) * kstep;
            const char* a2 = last ? Ab : Ab + (size_t)(t + 2) * kstep; const char* b2 = last ? nB : cB + (size_t)(t + 2) * kstep;
            const char* a3 = a2 + kstep; const char* b3 = b2 + kstep;
            unsigned s2[2][2];
#pragma unroll
            for (int h = 0; h < 2; ++h)
#pragma unroll
                for (int i = 0; i < 2; ++i) s2[h][i] = last ? nva[h][i] : cva[h][i];
            PG8_LDB(B0, 0, 0); PG8_LDB(B1, 0, 1); PG8_SCHED; PG8_LDA(At, 0, 0); PG8_STAGE(PG8_SA(1, 1), a1, cva[1]);
            PG8_WAIT_V(8); PG8_WAIT_L(0); PG8_BAR; PG8_MMA(0, 0, At, B0); PG8_MMA(0, 1, At, B1); PG8_BAR; PG8_SCHED;
            PG8_LDA(At, 0, 1); PG8_STAGE(PG8_SB(0, 0), b2, voffB); PG8_STAGE(PG8_SB(0, 1), b2 + hstep, voffB); PG8_STAGE(PG8_SA(0, 0), a2, s2[0]);
            PG8_WAIT_V(8); PG8_WAIT_L(0); PG8_BAR; PG8_MMA(1, 0, At, B0); PG8_MMA(1, 1, At, B1); PG8_BAR; PG8_SCHED;
            PG8_LDB(B0, 1, 0); PG8_LDB(B1, 1, 1); PG8_SCHED; PG8_LDA(At, 1, 0); PG8_STAGE(PG8_SA(0, 1), a2, s2[1]);
            PG8_WAIT_V(8); PG8_WAIT_L(0); PG8_BAR; PG8_MMA(0, 0, At, B0); PG8_MMA(0, 1, At, B1); PG8_BAR; PG8_SCHED;
            PG8_LDA(At, 1, 1); PG8_STAGE(PG8_SB(1, 0), b3, voffB); PG8_STAGE(PG8_SB(1, 1), b3 + hstep, voffB); PG8_STAGE(PG8_SA(1, 0), a3, s2[0]);
            PG8_WAIT_V(8); PG8_WAIT_L(0); PG8_BAR; PG8_MMA(1, 0, At, B0); PG8_MMA(1, 1, At, B1); PG8_BAR; PG8_SCHED;
        }
        if constexpr (ALIGN_EPI) { if (wr == 0) PG8_BAR; }
        E(acc, cur, wr, wc, fr, fq);
        if (!has_next) break;
#pragma unroll
        for (int a = 0; a < 2; ++a)
#pragma unroll
            for (int b = 0; b < 2; ++b)
#pragma unroll
                for (int m = 0; m < 4; ++m)
#pragma unroll
                    for (int n = 0; n < 2; ++n) acc[a][b][m][n] = (f32x4){0.f, 0.f, 0.f, 0.f};
        cur = nxt; cB = nB; ++ui;
#pragma unroll
        for (int h = 0; h < 2; ++h)
#pragma unroll
            for (int i = 0; i < 2; ++i) cva[h][i] = nva[h][i];
        if constexpr (ALIGN_EPI) { if (wr == 1) PG8_BAR; }
    }
    PG8_WAIT_V(0);
    if constexpr (!ALIGN_EPI) { if (wr == 0) PG8_BAR; }
    PG8_BAR;
#undef PG8_SA
#undef PG8_SB
#undef PG8_STAGE
#undef PG8_LDA
#undef PG8_LDB
#undef PG8_MMA
#undef PG8_WAIT_V
#undef PG8_WAIT_L
#undef PG8_BAR
#undef PG8_SCHED
#undef PG8_AOFF
#undef PG8_BBASE
}
}


typedef short bf16x8_t __attribute__((ext_vector_type(8)));
typedef float f32x16 __attribute__((ext_vector_type(16)));
template <int K>
__device__ __forceinline__ void mm32(f32x16& acc, const LAS unsigned char* A, int sa, const LAS unsigned char* B, int sb, int lane) {
    const LAS unsigned char* ap = A + (lane & 31) * sa + (lane >> 5) * 16;
    const LAS unsigned char* bp = B + (lane & 31) * sb + (lane >> 5) * 16;
#pragma unroll
    for (int k0 = 0; k0 < K / 16; k0 += 4) {
        bf16x8_t a[4], b[4];
#pragma unroll
        for (int k = 0; k < 4; ++k) { a[k] = *(const LAS bf16x8_t*)(ap + (k0 + k) * 32); b[k] = *(const LAS bf16x8_t*)(bp + (k0 + k) * 32); }
#pragma unroll
        for (int k = 0; k < 4; ++k) acc = __builtin_amdgcn_mfma_f32_32x32x16_bf16(a[k], b[k], acc, 0, 0, 0);
    }
}
__device__ __forceinline__ int rowmap(int reg, int hi) { return (reg & 3) + 8 * (reg >> 2) + 4 * hi; }
__device__ __forceinline__ int chunk_row0(int b, int tc) { return tc < 4 ? NLAT + b * CTX + tc * 64 : b * SEQ + (tc - 4) * 64; }
constexpr int ST64 = 144, ST128 = 272;


__device__ __forceinline__ void touch(unsigned& x) { asm volatile("" : "+v"(x)); }
__device__ __forceinline__ void touch(float& x) { asm volatile("" : "+v"(x)); }
__device__ __forceinline__ void touch(u32x4& x) { asm volatile("" : "+v"(x)); }
struct VtRaw { unsigned w[8]; };
__device__ __forceinline__ void vt_load(VtRaw& R, const bf16* src, int pitch, int row0, int col0, int tid) {
    const int cp = tid & 63, tg = tid >> 6;
#pragma unroll
    for (int i = 0; i < 8; ++i) R.w[i] = *(const unsigned*)(src + (size_t)(row0 + tg * 8 + i) * pitch + col0 + 2 * cp);
}
__device__ __forceinline__ void vt_store(LAS unsigned char* VT, const VtRaw& R, int tid) {
    const int cp = tid & 63, tg = tid >> 6; unsigned lo[4], hi[4];
#pragma unroll
    for (int i = 0; i < 4; ++i) { const unsigned w0 = R.w[2 * i], w1 = R.w[2 * i + 1]; lo[i] = (w0 & 0xffffu) | (w1 << 16); hi[i] = (w0 >> 16) | (w1 & 0xffff0000u); }
    *(LAS u32x4*)(VT + (2 * cp) * ST64 + tg * 16) = (u32x4){lo[0], lo[1], lo[2], lo[3]};
    *(LAS u32x4*)(VT + (2 * cp + 1) * ST64 + tg * 16) = (u32x4){hi[0], hi[1], hi[2], hi[3]};
}
struct TaskId { int b, h, tc, row0, sidf; };
__device__ __forceinline__ TaskId task_id(int task) { TaskId t; t.b = task / (4 * NTC); t.h = (task / NTC) & 3; t.tc = task % NTC; t.row0 = chunk_row0(t.b, t.tc); t.sidf = (t.b * 4 + t.h) * 2; return t; }

struct MlARaw { VtRaw v; unsigned kw[4]; float g[4]; };
__device__ __forceinline__ void touch(MlARaw& R) {
#pragma unroll
    for (int i = 0; i < 8; ++i) touch(R.v.w[i]);
#pragma unroll
    for (int i = 0; i < 4; ++i) { touch(R.kw[i]); touch(R.g[i]); } }
__device__ __forceinline__ void ml_passA_load(Frame& F, int task, MlARaw& R) {
    const TaskId T = task_id(task);
    vt_load(R.v, (const bf16*)(F.ws + WS_P), PW, T.row0, PC_V + T.h * 128, F.tid);
    { const int cp = F.tid & 31, tg = F.tid >> 5; const bf16* CQK = (const bf16*)(F.ws + WS_CQK);
#pragma unroll
      for (int i = 0; i < 4; ++i) R.kw[i] = *(const unsigned*)(CQK + (size_t)(T.row0 + tg * 4 + i) * 512 + 256 + T.h * 64 + 2 * cp); }
    if (F.wave == 0) { const float* gp = (const float*)(F.ws + WS_GATES) + (size_t)(T.row0 + F.lane) * 16; R.g[0] = gp[T.h]; R.g[1] = gp[4 + T.h]; R.g[2] = gp[8 + T.h]; R.g[3] = gp[12 + T.h]; }
}
__device__ __forceinline__ void ml_passA_run(Frame& F, int task, const MlARaw& R) {
    const TaskId T = task_id(task); const int tc = T.tc, sidf = T.sidf;
    LAS unsigned char* VT = F.lds; LAS unsigned char* KT = F.lds + 18432;
    LAS float* wts = (LAS float*)(F.lds + 36864);
    float* MLS = (float*)(F.ws + WS_MLS);
    LDS_BARRIER();
    if (F.wave == 0) { const int s = F.lane;
        const float igf = R.g[0], igb = R.g[1], lff = R.g[2], lfb = R.g[3];
        const float pf = wave_incl_sum(lff, s), gf = __builtin_bit_cast(float, __builtin_amdgcn_readlane(__builtin_bit_cast(int, pf), 63)), ef = (gf - pf) + igf, mf = wave_max(ef);
        const float pb = wave_incl_sum(lfb, s), gb = __builtin_bit_cast(float, __builtin_amdgcn_readlane(__builtin_bit_cast(int, pb), 63)), eb = (pb - lfb) + igb, mb = wave_max(eb);
        wts[s] = __expf(ef - mf); wts[64 + s] = __expf(eb - mb);
        if (s == 0) { float* o = MLS + (size_t)(sidf * NTC + tc) * 4; o[0] = gf; o[1] = mf; o = MLS + (size_t)((sidf + 1) * NTC + tc) * 4; o[0] = gb; o[1] = mb; } }
    vt_store(VT, R.v, F.tid);
    LDS_BARRIER();
    { const int cp = F.tid & 31, tg = F.tid >> 5;
#pragma unroll
      for (int dir = 0; dir < 2; ++dir) { float lo[4], hi[4];
#pragma unroll
          for (int i = 0; i < 4; ++i) { const float w = wts[dir * 64 + tg * 4 + i]; lo[i] = bflo(R.kw[i]) * w; hi[i] = bfhi(R.kw[i]) * w; }
          *(LAS u32x2*)(KT + dir * 9216 + (2 * cp) * ST64 + tg * 8) = (u32x2){pk2(lo[0], lo[1]), pk2(lo[2], lo[3])};
          *(LAS u32x2*)(KT + dir * 9216 + (2 * cp + 1) * ST64 + tg * 8) = (u32x2){pk2(hi[0], hi[1]), pk2(hi[2], hi[3])}; } }
    LDS_BARRIER();
    { const int dir = F.wave >> 2, mt = F.wave & 3; bf16* C = (bf16*)(F.ws + WS_MLC) + (size_t)((sidf + dir) * NTC + tc) * 8192;
#pragma unroll
      for (int nt = 0; nt < 2; ++nt) { f32x16 acc;
#pragma unroll
          for (int i = 0; i < 16; ++i) acc[i] = 0.f;
          mm32<64>(acc, VT + 32 * mt * ST64, ST64, KT + dir * 9216 + 32 * nt * ST64, ST64, F.lane);
#pragma unroll
          for (int r = 0; r < 16; ++r) C[(32 * mt + rowmap(r, F.lane >> 5)) * 64 + 32 * nt + (F.lane & 31)] = (bf16)f2bf(acc[r]); } }
    if (F.tid < 128) { const int dir = F.tid >> 6, d = F.tid & 63; const LAS unsigned char* rp = KT + dir * 9216 + d * ST64; float sum = 0.f;
#pragma unroll
        for (int i = 0; i < 8; ++i) { const u32x4 w = *(const LAS u32x4*)(rp + i * 16); sum += (bflo(w.x) + bfhi(w.x)) + (bflo(w.y) + bfhi(w.y)) + (bflo(w.z) + bfhi(w.z)) + (bflo(w.w) + bfhi(w.w)); }
        ((float*)(F.ws + WS_MLN))[(size_t)((sidf + dir) * NTC + tc) * 64 + d] = sum; }
}
__device__ __forceinline__ int tc_seq(int dir, int j) { return dir == 0 ? j : (j < 4 ? 3 - j : 135 - j); }
__device__ __forceinline__ void scan_passB(Frame& F) {
    const float* GG = (const float*)(F.ws + WS_HGG); float* MLS = (float*)(F.ws + WS_MLS);
    const int t = F.tid;
    if (t < 128) {
        for (int item = F.vcu * 128 + t; item < 16 * 2048; item += F.G * 128) {
            const int scan = item >> 11, e = (item & 2047) * 8, dir = scan & 1, d = e & 127;
            const u32x4* base = (const u32x4*)((const bf16*)(F.ws + WS_HGS) + (size_t)scan * NTC * 16384 + e); u32x4* ob = (u32x4*)((bf16*)(F.ws + WS_HGSB) + (size_t)scan * NTC * 16384 + e);
            const f32x4* gb = (const f32x4*)(GG + (size_t)scan * NTC * 128 + d);
            float st[8];
#pragma unroll
            for (int k = 0; k < 8; ++k) st[k] = 0.f;
            for (int j0 = 0; j0 < NTC; j0 += 11) {
                u32x4 dv[11]; f32x4 g0[11], g1[11];
#pragma unroll
                for (int i = 0; i < 11; ++i) { const int tc = tc_seq(dir, j0 + i); dv[i] = base[(size_t)tc * 2048]; g0[i] = gb[tc * 32]; g1[i] = gb[tc * 32 + 1]; }
#pragma unroll
                for (int i = 0; i < 11; ++i) { const int tc = tc_seq(dir, j0 + i);
                    ob[(size_t)tc * 2048] = (u32x4){pk2(st[0], st[1]), pk2(st[2], st[3]), pk2(st[4], st[5]), pk2(st[6], st[7])};
                    const f32x4 ta = g0[i] * 1.44269504f, tb = g1[i] * 1.44269504f;
                    const f32x2_t e0 = {__builtin_amdgcn_exp2f(ta.x), __builtin_amdgcn_exp2f(ta.y)}, e1 = {__builtin_amdgcn_exp2f(ta.z), __builtin_amdgcn_exp2f(ta.w)}, e2 = {__builtin_amdgcn_exp2f(tb.x), __builtin_amdgcn_exp2f(tb.y)}, e3 = {__builtin_amdgcn_exp2f(tb.z), __builtin_amdgcn_exp2f(tb.w)};
                    const f32x2_t s0 = e0 * (f32x2_t){st[0], st[1]} + (f32x2_t){bflo(dv[i].x), bfhi(dv[i].x)}, s1 = e1 * (f32x2_t){st[2], st[3]} + (f32x2_t){bflo(dv[i].y), bfhi(dv[i].y)};
                    const f32x2_t s2 = e2 * (f32x2_t){st[4], st[5]} + (f32x2_t){bflo(dv[i].z), bfhi(dv[i].z)}, s3 = e3 * (f32x2_t){st[6], st[7]} + (f32x2_t){bflo(dv[i].w), bfhi(dv[i].w)};
                    st[0] = s0.x; st[1] = s0.y; st[2] = s1.x; st[3] = s1.y; st[4] = s2.x; st[5] = s2.y; st[6] = s3.x; st[7] = s3.y; }
            }
        }
    } else if (t < 192) {
        for (int item = F.vcu * 64 + (t - 128); item < 16 * 1024; item += F.G * 64) {
            const int scan = item >> 10, e = (item & 1023) * 8, dir = scan & 1;
            const u32x4* cb = (const u32x4*)((const bf16*)(F.ws + WS_MLC) + (size_t)scan * NTC * 8192 + e); u32x4* ob = (u32x4*)((bf16*)(F.ws + WS_MLCB) + (size_t)scan * NTC * 8192 + e);
            float m = 0.f, st[8];
#pragma unroll
            for (int k = 0; k < 8; ++k) st[k] = 0.f;
            for (int j0 = 0; j0 < NTC; j0 += 12) {
                u32x4 dv[12]; float gg[12], ml[12];
#pragma unroll
                for (int i = 0; i < 12; ++i) { const int tc = tc_seq(dir, j0 + i); dv[i] = cb[(size_t)tc * 1024]; const float* sp = MLS + (size_t)(scan * NTC + tc) * 4; gg[i] = sp[0]; ml[i] = sp[1]; }
#pragma unroll
                for (int i = 0; i < 12; ++i) { const int tc = tc_seq(dir, j0 + i);
                    const float mn = fmaxf(gg[i] + m, ml[i]), a = __expf(gg[i] + m - mn), w = __expf(ml[i] - mn);
                    if ((item & 1023) == 0) MLS[(size_t)(scan * NTC + tc) * 4 + 2] = m;
                    ob[(size_t)tc * 1024] = (u32x4){pk2(st[0], st[1]), pk2(st[2], st[3]), pk2(st[4], st[5]), pk2(st[6], st[7])};
                    const f32x2_t s0 = (f32x2_t){st[0], st[1]} * a + (f32x2_t){bflo(dv[i].x), bfhi(dv[i].x)} * w, s1 = (f32x2_t){st[2], st[3]} * a + (f32x2_t){bflo(dv[i].y), bfhi(dv[i].y)} * w;
                    const f32x2_t s2 = (f32x2_t){st[4], st[5]} * a + (f32x2_t){bflo(dv[i].z), bfhi(dv[i].z)} * w, s3 = (f32x2_t){st[6], st[7]} * a + (f32x2_t){bflo(dv[i].w), bfhi(dv[i].w)} * w;
                    st[0] = s0.x; st[1] = s0.y; st[2] = s1.x; st[3] = s1.y; st[4] = s2.x; st[5] = s2.y; st[6] = s3.x; st[7] = s3.y; m = mn; }
            }
        }
    } else if (t < 196) {
        for (int item = F.vcu * 4 + (t - 192); item < 16 * 64; item += F.G * 4) {
            const int scan = item >> 6, e = item & 63, dir = scan & 1; float* nb = (float*)(F.ws + WS_MLN) + (size_t)scan * NTC * 64 + e;
            float m = 0.f, s0 = 0.f;
            for (int j0 = 0; j0 < NTC; j0 += 12) {
                float dv[12];
#pragma unroll
                for (int i = 0; i < 12; ++i) dv[i] = nb[tc_seq(dir, j0 + i) * 64];
#pragma unroll
                for (int i = 0; i < 12; ++i) { const int tc = tc_seq(dir, j0 + i); const float* sp = MLS + (size_t)(scan * NTC + tc) * 4;
                    const float g = sp[0], ml = sp[1], mn = fmaxf(g + m, ml), a = __expf(g + m - mn), w = __expf(ml - mn);
                    nb[tc * 64] = s0; s0 = a * s0 + w * dv[i]; m = mn; }
            }
        }
    }
}
template <int MIX>
__device__ __forceinline__ void gate_load(Frame& F, int row0, int h, unsigned (&gate)[16]) {
    const int mt = F.wave >> 2, nt = F.wave & 3; const bf16* P = (const bf16*)(F.ws + WS_P) + (MIX == 0 ? PC_O : PC_GO) + h * 128 + 32 * nt + (F.lane & 31);
#pragma unroll
    for (int r = 0; r < 16; ++r) gate[r] = P[(size_t)(row0 + 32 * mt + rowmap(r, F.lane >> 5)) * PW];
}
template <int MIX>
__device__ __forceinline__ void head_epilogue(Frame& F, const float ng, const f32x16& hv, const unsigned (&gate)[16], LAS float* part, int row0, int h) {
    const int mt = F.wave >> 2, nt = F.wave & 3, lane = F.lane, hi = lane >> 5;
    float ps[16];
#pragma unroll
    for (int r = 0; r < 16; ++r) ps[r] = hv[r] * hv[r];
#pragma unroll
    for (int r = 0; r < 16; ++r) ps[r] = half_sum_hi(ps[r]);
    if ((lane & 31) == 31) {
#pragma unroll
        for (int r = 0; r < 16; ++r) part[(32 * mt + rowmap(r, hi)) * 4 + nt] = ps[r]; }
    LDS_BARRIER();
    bf16* Y = (bf16*)(F.ws + WS_Y) + (MIX == 0 ? 0 : 512) + h * 128 + 32 * nt + (lane & 31);
#pragma unroll
    for (int r = 0; r < 16; r += 2) { const int t0 = 32 * mt + rowmap(r, hi), t1 = 32 * mt + rowmap(r + 1, hi); const f32x4 p4 = *(const LAS f32x4*)(part + t0 * 4), q4 = *(const LAS f32x4*)(part + t1 * 4);
        const f32x2_t ms = (f32x2_t){(p4.x + p4.y) + (p4.z + p4.w), (q4.x + q4.y) + (q4.z + q4.w)} * (1.f / 128.f) + EPS;
        const f32x2_t rstd = {__builtin_amdgcn_rsqf(ms.x), __builtin_amdgcn_rsqf(ms.y)}, gz = {bf2f((unsigned short)gate[r]), bf2f((unsigned short)gate[r + 1])};
        const f32x2_t te = gz * (-1.44269504f), dn = (f32x2_t){__builtin_amdgcn_exp2f(te.x), __builtin_amdgcn_exp2f(te.y)} + 1.f;
        const f32x2_t sg = {__builtin_amdgcn_rcpf(dn.x), __builtin_amdgcn_rcpf(dn.y)}, gv = MIX == 0 ? sg : gz * sg;
        const f32x2_t y = ((f32x2_t){hv[r], hv[r + 1]} * rstd) * (gv * ng); const unsigned w = pk2(y.x, y.y);
        Y[(size_t)(row0 + t0) * D] = (bf16)w; Y[(size_t)(row0 + t1) * D] = (bf16)(w >> 16); }
}
struct MlCRaw { VtRaw v; u32x4 q, k; u32x4 cf[2]; float g0, g1, ms; };
__device__ __forceinline__ void touch(MlCRaw& R) {
#pragma unroll
    for (int i = 0; i < 8; ++i) touch(R.v.w[i]);
    touch(R.q); touch(R.k); touch(R.cf[0]); touch(R.cf[1]); touch(R.g0); touch(R.g1); touch(R.ms); }
__device__ __forceinline__ void ml_passC_load(Frame& F, int task, MlCRaw& R) {
    const TaskId T = task_id(task); const bf16* CQK = (const bf16*)(F.ws + WS_CQK);
    vt_load(R.v, (const bf16*)(F.ws + WS_P), PW, T.row0, PC_V + T.h * 128, F.tid);
    { const int row = F.tid >> 3, pc = F.tid & 7;
      R.q = *(const u32x4*)(CQK + (size_t)(T.row0 + row) * 512 + T.h * 64 + pc * 8); R.k = *(const u32x4*)(CQK + (size_t)(T.row0 + row) * 512 + 256 + T.h * 64 + pc * 8); }
    { const u32x4* cp = (const u32x4*)((const bf16*)(F.ws + WS_MLCB) + (size_t)(T.sidf * NTC + T.tc) * 8192 + (F.tid >> 2) * 64 + (F.tid & 3) * 16); R.cf[0] = cp[0]; R.cf[1] = cp[1]; }
    R.g0 = 0.f; R.g1 = 0.f; R.ms = 0.f;
    if (F.wave < 2) { const int dir = F.wave; const float* gp = (const float*)(F.ws + WS_GATES) + (size_t)(T.row0 + F.lane) * 16; R.g0 = gp[dir * 4 + T.h]; R.g1 = gp[8 + dir * 4 + T.h];
        R.ms = ((const float*)(F.ws + WS_MLS))[(size_t)((T.sidf + dir) * NTC + T.tc) * 4 + 2]; }
}
__device__ __forceinline__ void ml_passC_run(Frame& F, CArgs& A, int l, int task, const MlCRaw& R) {
    const TaskId T = task_id(task); const int h = T.h, tc = T.tc, row0 = T.row0, sidf = T.sidf;
    if (l == DEPTH - 1 && tc < 4) return;
    unsigned gate[16];
    const float ng = A.in[I_MLNG][l * 512 + h * 128 + 32 * (F.wave & 3) + (F.lane & 31)];
    LAS unsigned char* Q = F.lds; LAS unsigned char* Kn = F.lds + 9216; LAS unsigned char* VT = F.lds + 18432; LAS unsigned char* Cs = F.lds + 36864;
    LAS unsigned char* Pm = F.lds + 55296; LAS unsigned char* Qs = F.lds + 64512;
    LAS float* sm = (LAS float*)(F.lds + 73728);
    const int tid = F.tid, lane = F.lane;
    u32x4 cb[2]; { const u32x4* cp = (const u32x4*)((const bf16*)(F.ws + WS_MLCB) + (size_t)((sidf + 1) * NTC + tc) * 8192 + (tid >> 2) * 64 + (tid & 3) * 16); cb[0] = cp[0]; cb[1] = cp[1]; }
    float nv = 0.f; if (tid < 128) nv = ((const float*)(F.ws + WS_MLN))[(size_t)((sidf + (tid >> 6)) * NTC + tc) * 64 + (tid & 63)];
    LDS_BARRIER();
    { const int row = tid >> 3, pc = tid & 7; *(LAS u32x4*)(Q + row * ST64 + pc * 16) = R.q; *(LAS u32x4*)(Kn + row * ST64 + pc * 16) = R.k; }
    vt_store(VT, R.v, tid);
    if (tid < 128) sm[512 + tid] = nv;
    if (F.wave < 2) { const int dir = F.wave, s = lane; const float ig = R.g0, lf = R.g1, ms = R.ms;
        float bt, u, pm;
        if (dir == 0) { bt = wave_incl_sum(lf, s); u = ig - bt; pm = wave_incl_max(u, s); }
        else { const float pf = wave_incl_sum(lf, s), tot = __builtin_bit_cast(float, __builtin_amdgcn_readlane(__builtin_bit_cast(int, pf), 63)); bt = tot - pf + lf; u = ig - bt;
               float r = __shfl(u, 63 - s); r = wave_incl_max(r, s); pm = __shfl(r, 63 - s); }
        const float M = fmaxf(ms, pm);
        LAS float* o = sm + dir * 256; o[s] = u; o[64 + s] = M; o[128 + s] = __expf(ms - M); o[192 + s] = __expf(-(bt + M)); }
    LDS_BARRIER();
    f32x16 qk;
#pragma unroll
    for (int i = 0; i < 16; ++i) qk[i] = 0.f;
    if (F.wave < 4) mm32<64>(qk, Q + 32 * (F.wave >> 1) * ST64, ST64, Kn + 32 * (F.wave & 1) * ST64, ST64, lane);
    f32x16 hs;
#pragma unroll
    for (int i = 0; i < 16; ++i) hs[i] = 0.f;
#pragma unroll 1
    for (int dir = 0; dir < 2; ++dir) {
        const LAS float* sd = sm + dir * 256;
        { const int v = tid >> 2, pc = tid & 3; *(LAS u32x4*)(Cs + v * ST64 + pc * 32) = dir == 0 ? R.cf[0] : cb[0]; *(LAS u32x4*)(Cs + v * ST64 + pc * 32 + 16) = dir == 0 ? R.cf[1] : cb[1]; }
        { const int row = tid >> 3, pc = tid & 7; const u32x4 q = R.q; const float w = sd[128 + row];
          *(LAS u32x4*)(Qs + row * ST64 + pc * 16) = (u32x4){pk2(bflo(q.x) * w, bfhi(q.x) * w), pk2(bflo(q.y) * w, bfhi(q.y) * w), pk2(bflo(q.z) * w, bfhi(q.z) * w), pk2(bflo(q.w) * w, bfhi(q.w) * w)}; }
        if (F.wave < 4) { const int s = 32 * (F.wave & 1) + (lane & 31); const float us = sd[s]; float Mt[16];
#pragma unroll
            for (int r = 0; r < 16; ++r) Mt[r] = sd[64 + 32 * (F.wave >> 1) + rowmap(r, lane >> 5)];
#pragma unroll
            for (int r = 0; r < 16; r += 2) { const int t0 = 32 * (F.wave >> 1) + rowmap(r, lane >> 5), t1 = 32 * (F.wave >> 1) + rowmap(r + 1, lane >> 5);
                const bool ok0 = dir == 0 ? (s <= t0) : (s >= t0), ok1 = dir == 0 ? (s <= t1) : (s >= t1);
                f32x2_t ex = (f32x2_t){us - Mt[r], us - Mt[r + 1]}; ex.x = fminf(ex.x, 0.f); ex.y = fminf(ex.y, 0.f); ex = ex * 1.44269504f;
                const f32x2_t p = (f32x2_t){qk[r], qk[r + 1]} * (f32x2_t){__builtin_amdgcn_exp2f(ex.x), __builtin_amdgcn_exp2f(ex.y)}; const unsigned w = pk2(ok0 ? p.x : 0.f, ok1 ? p.y : 0.f);
                *(LAS unsigned short*)(Pm + t0 * ST64 + s * 2) = (unsigned short)w; *(LAS unsigned short*)(Pm + t1 * ST64 + s * 2) = (unsigned short)(w >> 16); } }
        LDS_BARRIER();
        if (tid < 256) { const int t = tid >> 2, qd = tid & 3; float den = 0.f, qn = 0.f;
#pragma unroll
            for (int i = 0; i < 2; ++i) { const u32x4 w = *(const LAS u32x4*)(Pm + t * ST64 + qd * 32 + i * 16); den += (bflo(w.x) + bfhi(w.x)) + (bflo(w.y) + bfhi(w.y)) + (bflo(w.z) + bfhi(w.z)) + (bflo(w.w) + bfhi(w.w));
                const u32x4 q = *(const LAS u32x4*)(Q + t * ST64 + qd * 32 + i * 16); const LAS float* nvp = sm + 512 + dir * 64 + qd * 16 + i * 8; const f32x4 n0 = *(const LAS f32x4*)nvp, n1 = *(const LAS f32x4*)(nvp + 4);
                qn += (bflo(q.x) * n0.x + bfhi(q.x) * n0.y) + (bflo(q.y) * n0.z + bfhi(q.y) * n0.w) + (bflo(q.z) * n1.x + bfhi(q.z) * n1.y) + (bflo(q.w) * n1.z + bfhi(q.w) * n1.w); }
            den += sd[128 + t] * qn;
            den += dppf<0xB1, 0xf, true>(0.f, den); den += dppf<0x4E, 0xf, true>(0.f, den);
            if (qd == 0) sm[640 + t] = 1.f / fmaxf(fabsf(den), sd[192 + t]); }
        f32x16 acc;
#pragma unroll
        for (int i = 0; i < 16; ++i) acc[i] = 0.f;
        { const int mt = F.wave >> 2, nt = F.wave & 3;
          mm32<64>(acc, Pm + 32 * mt * ST64, ST64, VT + 32 * nt * ST64, ST64, lane);
          mm32<64>(acc, Qs + 32 * mt * ST64, ST64, Cs + 32 * nt * ST64, ST64, lane); }
        LDS_BARRIER();
        float dsc[16];
#pragma unroll
        for (int r = 0; r < 16; ++r) dsc[r] = sm[640 + 32 * (F.wave >> 2) + rowmap(r, lane >> 5)];
#pragma unroll
        for (int r = 0; r < 16; ++r) hs[r] += acc[r] * dsc[r];
        if (dir == 0) LDS_BARRIER();
    }
    gate_load<0>(F, row0, h, gate);
    head_epilogue<0>(F, ng, hs, gate, sm + 768, row0, h);
}

struct HgPrep { float k[16], x[16]; float T[4]; };
__device__ __forceinline__ void hg_zload(Frame& F, int h, int row0, int dir, unsigned (&z)[16]) {
    const int d = F.tid & 127, qtr = F.tid >> 7;
    const bf16* P = (const bf16*)(F.ws + WS_P) + (size_t)(row0 + qtr * 16) * PW + (dir == 0 ? PC_FF : PC_FB) + h * 128 + d;
#pragma unroll
    for (int i = 0; i < 16; ++i) z[i] = P[(size_t)i * PW];
}
struct HgConst { float lb, bf, bb; };
__device__ __forceinline__ HgConst hg_const(Frame& F, CArgs& A, int l, int h) { const int ch = h * 128 + (F.tid & 127); HgConst c; c.lb = 0.f;
    if (l == 1) { const float r0 = A.in[I_HGLB][ch], r1 = A.in[I_HGLB][512 + ch], mx = fmaxf(r0, r1), e0 = __expf(r0 - mx), e1 = __expf(r1 - mx); c.lb = e1 / (e0 + e1); }
    c.bf = A.in[I_HGFB][l * 1024 + ch]; c.bb = A.in[I_HGFB][l * 1024 + 512 + ch]; return c; }
template <int dir>
__device__ __forceinline__ void hg_prep(Frame& F, const HgConst& C, int l, const unsigned (&zr)[16], LAS float* tot, HgPrep& R) {
    const int d = F.tid & 127, qtr = F.tid >> 7;
    const float lb = C.lb, bias = dir == 0 ? C.bf : C.bb, omlb = 1.f - lb;
    float cs = 0.f;
#pragma unroll
    for (int i = 0; i < 16; i += 2) {
        f32x2_t z = (f32x2_t){bf2f((unsigned short)zr[i]), bf2f((unsigned short)zr[i + 1])} + bias;
        z.x = fminf(fmaxf(z.x, -30.f), 30.f); z.y = fminf(fmaxf(z.y, -30.f), 30.f);
        const f32x2_t t = z * (-1.44269504f);
        const f32x2_t ez = {__builtin_amdgcn_exp2f(t.x), __builtin_amdgcn_exp2f(t.y)}, dn = ez + 1.f;
        const f32x2_t sg = {__builtin_amdgcn_rcpf(dn.x), __builtin_amdgcn_rcpf(dn.y)};
        const f32x2_t kk = (ez * sg) * omlb, ff = sg * omlb + lb;
        R.k[i] = kk.x; R.k[i + 1] = kk.y;
        const f32x2_t lf = (f32x2_t){__builtin_amdgcn_logf(ff.x), __builtin_amdgcn_logf(ff.y)} * 0.69314718f;
        if (dir == 0) { cs += lf.x; R.x[i] = cs; cs += lf.y; R.x[i + 1] = cs; } else { R.x[i] = cs; cs += lf.x; R.x[i + 1] = cs; cs += lf.y; } }
    tot[dir * 512 + qtr * 128 + d] = cs;
    LDS_BARRIER();
    float off = 0.f;
#pragma unroll
    for (int q = 0; q < 4; ++q) { R.T[q] = tot[dir * 512 + q * 128 + d]; if (q < qtr) off += R.T[q]; }
#pragma unroll
    for (int i = 0; i < 16; ++i) R.x[i] += off;
}
__device__ __forceinline__ void put16(LAS unsigned char* p, const float (&v)[16]) {
    *(LAS u32x4*)p = (u32x4){pk2(v[0], v[1]), pk2(v[2], v[3]), pk2(v[4], v[5]), pk2(v[6], v[7])};
    *(LAS u32x4*)(p + 16) = (u32x4){pk2(v[8], v[9]), pk2(v[10], v[11]), pk2(v[12], v[13]), pk2(v[14], v[15])};
}
struct HgARaw { VtRaw v; unsigned zf[16], zb[16]; };
__device__ __forceinline__ void touch(HgARaw& R) {
#pragma unroll
    for (int i = 0; i < 8; ++i) touch(R.v.w[i]);
#pragma unroll
    for (int i = 0; i < 16; ++i) { touch(R.zf[i]); touch(R.zb[i]); } }
__device__ __forceinline__ void hg_passA_load(Frame& F, int task, HgARaw& R) {
    const TaskId T = task_id(task);
    vt_load(R.v, (const bf16*)(F.ws + WS_CQI), 1024, T.row0, 512 + T.h * 128, F.tid);
    hg_zload(F, T.h, T.row0, 0, R.zf); hg_zload(F, T.h, T.row0, 1, R.zb);
}
__device__ __forceinline__ void hg_passA_run(Frame& F, CArgs& A, int l, int task, const HgARaw& RW) {
    const TaskId T = task_id(task); const int h = T.h, tc = T.tc, sidf = T.sidf;
    LAS unsigned char* VT = F.lds; LAS unsigned char* KT = F.lds + 18432; LAS float* tot = (LAS float*)(F.lds + 55296);
    const int d = F.tid & 127, qtr = F.tid >> 7;
    const HgConst HC = hg_const(F, A, l, h);
    LDS_BARRIER();
    vt_store(VT, RW.v, F.tid);
    float* GG = (float*)(F.ws + WS_HGG);
    { HgPrep R; hg_prep<0>(F, HC, l, RW.zf, tot, R);
      const float G = (R.T[0] + R.T[1]) + (R.T[2] + R.T[3]);
      if (qtr == 0) GG[(size_t)(sidf * NTC + tc) * 128 + d] = G;
      float t[16];
#pragma unroll
      for (int i = 0; i < 16; i += 2) { const f32x2_t te = ((f32x2_t){R.x[i], R.x[i + 1]} - G) * (-1.44269504f);
          const f32x2_t kv = (f32x2_t){R.k[i], R.k[i + 1]} * (f32x2_t){__builtin_amdgcn_exp2f(te.x), __builtin_amdgcn_exp2f(te.y)}; t[i] = kv.x; t[i + 1] = kv.y; }
      put16(KT + d * ST64 + qtr * 32, t); }
    { HgPrep R; hg_prep<1>(F, HC, l, RW.zb, tot, R);
      const float G = (R.T[0] + R.T[1]) + (R.T[2] + R.T[3]);
      if (qtr == 0) GG[(size_t)((sidf + 1) * NTC + tc) * 128 + d] = G;
      float t[16];
#pragma unroll
      for (int i = 0; i < 16; i += 2) { const f32x2_t te = (f32x2_t){R.x[i], R.x[i + 1]} * 1.44269504f;
          const f32x2_t kv = (f32x2_t){R.k[i], R.k[i + 1]} * (f32x2_t){__builtin_amdgcn_exp2f(te.x), __builtin_amdgcn_exp2f(te.y)}; t[i] = kv.x; t[i + 1] = kv.y; }
      put16(KT + 18432 + d * ST64 + qtr * 32, t); }
    LDS_BARRIER();
    { const int dir = F.wave >> 2, mt = F.wave & 3; bf16* S = (bf16*)(F.ws + WS_HGS) + (size_t)((sidf + dir) * NTC + tc) * 16384;
#pragma unroll
      for (int nt = 0; nt < 4; ++nt) { f32x16 acc;
#pragma unroll
          for (int i = 0; i < 16; ++i) acc[i] = 0.f;
          mm32<64>(acc, VT + 32 * mt * ST64, ST64, KT + dir * 18432 + 32 * nt * ST64, ST64, F.lane);
#pragma unroll
          for (int r = 0; r < 16; ++r) S[(32 * mt + rowmap(r, F.lane >> 5)) * 128 + 32 * nt + (F.lane & 31)] = (bf16)f2bf(acc[r]); } }
}
struct HgCRaw { VtRaw v; unsigned zf[16], q[16]; };
__device__ __forceinline__ void touch(HgCRaw& R) {
#pragma unroll
    for (int i = 0; i < 8; ++i) touch(R.v.w[i]);
#pragma unroll
    for (int i = 0; i < 16; ++i) { touch(R.zf[i]); touch(R.q[i]); } }
__device__ __forceinline__ void hg_passC_load(Frame& F, int task, HgCRaw& R) {
    const TaskId T = task_id(task); const bf16* CQI = (const bf16*)(F.ws + WS_CQI);
    vt_load(R.v, CQI, 1024, T.row0, 512 + T.h * 128, F.tid);
    hg_zload(F, T.h, T.row0, 0, R.zf);
    { const int d = F.tid & 127, qtr = F.tid >> 7;
#pragma unroll
      for (int i = 0; i < 16; ++i) R.q[i] = CQI[(size_t)(T.row0 + qtr * 16 + i) * 1024 + T.h * 128 + d]; }
}
__device__ __forceinline__ void hg_passC_run(Frame& F, CArgs& A, int l, int task, const HgCRaw& RW) {
    const TaskId T = task_id(task); const int h = T.h, tc = T.tc, row0 = T.row0, sidf = T.sidf;
    LAS unsigned char* VT = F.lds; LAS unsigned char* Ss = F.lds + 18432; LAS unsigned char* Qh = F.lds + 53248; LAS unsigned char* Kh = F.lds + 70656;
    LAS unsigned char* Qc = F.lds + 88064; LAS unsigned char* Kc = F.lds + 96768; LAS unsigned char* Qt = F.lds + 105472; LAS unsigned char* Am = F.lds + 122880;
    LAS float* tot = (LAS float*)(F.lds + 132096);
    const int tid = F.tid, lane = F.lane, d = tid & 127, qtr = tid >> 7;
    if (l == DEPTH - 1 && tc < 4) return;
    unsigned gate[16];
    const HgConst HC = hg_const(F, A, l, h);
    unsigned zb[16]; hg_zload(F, h, row0, 1, zb);
    u32x4 sf[4], sb[4]; { const u32x4* sp = (const u32x4*)((const bf16*)(F.ws + WS_HGSB) + (size_t)(sidf * NTC + tc) * 16384 + (tid >> 2) * 128 + (tid & 3) * 32);
#pragma unroll
      for (int j = 0; j < 4; ++j) { sf[j] = sp[j]; sb[j] = sp[j + (size_t)NTC * 16384 * 2 / 16]; } }
    LDS_BARRIER();
    vt_store(VT, RW.v, tid);
    f32x16 acc;
#pragma unroll
    for (int i = 0; i < 16; ++i) acc[i] = 0.f;
#pragma unroll
    for (int dir = 0; dir < 2; ++dir) {
        HgPrep R;
        if (dir == 1) gate_load<1>(F, row0, h, gate);
        if (dir == 0) hg_prep<0>(F, HC, l, RW.zf, tot, R); else hg_prep<1>(F, HC, l, zb, tot, R);
        const float T0 = R.T[0], T1 = R.T[1], T2 = R.T[2], T3 = R.T[3];
        const float sg = dir == 0 ? 1.f : -1.f;
        const float rI = sg * ((qtr >> 1) == 0 ? T0 : (T0 + T1) + T2);
        const float rO = sg * (T0 + T1);
        const float Gall = (T0 + T1) + (T2 + T3);
        const bool isq = dir == 0 ? (qtr >= 2) : (qtr < 2);
        const float cO = __expf(isq ? rI - rO : rO - rI), cT = __expf(dir == 0 ? rI : Gall + rI);
        { const int v = tid >> 2, pc = tid & 3;
#pragma unroll
          for (int j = 0; j < 4; ++j) *(LAS u32x4*)(Ss + v * ST128 + pc * 64 + j * 16) = dir == 0 ? sf[j] : sb[j]; }
#pragma unroll
        for (int i = 0; i < 16; i += 2) {
            const int t = qtr * 16 + i;
            const f32x2_t x = dir == 0 ? (f32x2_t){R.x[i], R.x[i + 1]} : (f32x2_t){-R.x[i], -R.x[i + 1]}, kk = {R.k[i], R.k[i + 1]}, qv = {bf2f((unsigned short)RW.q[i]), bf2f((unsigned short)RW.q[i + 1])};
            const f32x2_t te = (x - rI) * 1.44269504f;
            const f32x2_t eh = {__builtin_amdgcn_exp2f(te.x), __builtin_amdgcn_exp2f(te.y)}, ehr = {__builtin_amdgcn_rcpf(eh.x), __builtin_amdgcn_rcpf(eh.y)};
            const f32x2_t qe = qv * eh, ke = kk * ehr, of = (isq ? qe : ke) * cO, qt = qe * cT;
            const unsigned wq = pk2(qe.x, qe.y), wk = pk2(ke.x, ke.y), wo = pk2(of.x, of.y), wt = pk2(qt.x, qt.y);
            *(LAS unsigned short*)(Qh + t * ST128 + d * 2) = (unsigned short)wq; *(LAS unsigned short*)(Qh + (t + 1) * ST128 + d * 2) = (unsigned short)(wq >> 16);
            *(LAS unsigned short*)(Kh + t * ST128 + d * 2) = (unsigned short)wk; *(LAS unsigned short*)(Kh + (t + 1) * ST128 + d * 2) = (unsigned short)(wk >> 16);
            LAS unsigned char* oc = isq ? Qc : Kc;
            *(LAS unsigned short*)(oc + (t & 31) * ST128 + d * 2) = (unsigned short)wo; *(LAS unsigned short*)(oc + ((t + 1) & 31) * ST128 + d * 2) = (unsigned short)(wo >> 16);
            *(LAS unsigned short*)(Qt + t * ST128 + d * 2) = (unsigned short)wt; *(LAS unsigned short*)(Qt + (t + 1) * ST128 + d * 2) = (unsigned short)(wt >> 16);
        }
        LDS_BARRIER();
        if (F.wave < 4) { f32x16 a;
#pragma unroll
            for (int i = 0; i < 16; ++i) a[i] = 0.f;
            int tt = 0, ts = 0;
            if (F.wave < 2) { tt = ts = F.wave; mm32<128>(a, Qh + 32 * tt * ST128, ST128, Kh + 32 * ts * ST128, ST128, lane);
#pragma unroll
                for (int r = 0; r < 16; ++r) { const int tl = rowmap(r, lane >> 5), sl = lane & 31; const bool ok = dir == 0 ? (sl <= tl) : (sl >= tl); a[r] = ok ? a[r] : 0.f; } }
            else if (F.wave == 2) { tt = dir == 0 ? 1 : 0; ts = 1 - tt; mm32<128>(a, Qc, ST128, Kc, ST128, lane); }
            else { tt = dir == 0 ? 0 : 1; ts = 1 - tt; }
#pragma unroll
            for (int r = 0; r < 16; r += 2) { const unsigned w = pk2(a[r], a[r + 1]); *(LAS unsigned short*)(Am + (32 * tt + rowmap(r, lane >> 5)) * ST64 + (32 * ts + (lane & 31)) * 2) = (unsigned short)w;
                *(LAS unsigned short*)(Am + (32 * tt + rowmap(r + 1, lane >> 5)) * ST64 + (32 * ts + (lane & 31)) * 2) = (unsigned short)(w >> 16); } }
        LDS_BARRIER();
        { const int mt = F.wave >> 2, nt = F.wave & 3;
          mm32<64>(acc, Am + 32 * mt * ST64, ST64, VT + 32 * nt * ST64, ST64, lane);
          mm32<128>(acc, Qt + 32 * mt * ST128, ST128, Ss + 32 * nt * ST128, ST128, lane); }
        if (dir == 0) LDS_BARRIER();
    }
    const float ng = A.in[I_HGNG][l * 512 + h * 128 + 32 * (F.wave & 3) + (lane & 31)];
    head_epilogue<1>(F, ng, acc, gate, (LAS float*)(F.lds + 136192), row0, h);
}
#define TASK_LOOP(RAW, LOADFN, RUNFN, T0, T1) do { int t_ = F.vcu; while (t_ < (T0)) t_ += F.G; RAW cur_; if (t_ < (T1)) { LOADFN(t_ - (T0), cur_); } \
    for (; t_ < (T1); t_ += F.G) { touch(cur_); RAW nxt_; if (t_ + F.G < (T1)) { LOADFN(t_ + F.G - (T0), nxt_); } else nxt_ = cur_; RUNFN(t_ - (T0), cur_); cur_ = nxt_; } } while (0)

__device__ __forceinline__ void transpose_item(const float* W, int ldw, int K, bf16* WT, int k0, int n0, int drow0, LAS float* scr, int lane) {
    const int n4 = (lane & 7) * 4, kr = lane >> 3;
    f32x4 v[8];
#pragma unroll
    for (int i = 0; i < 8; ++i) v[i] = __builtin_nontemporal_load((const f32x4*)(W + (size_t)(k0 + 8 * i + kr) * ldw + n0 + n4));
#pragma unroll
    for (int i = 0; i < 8; ++i) { LAS float* p = scr + (8 * i + kr) * 33 + n4; p[0] = v[i].x; p[1] = v[i].y; p[2] = v[i].z; p[3] = v[i].w; }
    asm volatile("s_waitcnt lgkmcnt(0)" ::: "memory");
    const int c = lane & 7;
#pragma unroll
    for (int j = 0; j < 4; ++j) { const int n = (lane >> 3) + 8 * j; const LAS float* s = scr + (8 * c) * 33 + n;
        u32x4 o; o.x = pk2(s[0 * 33], s[1 * 33]); o.y = pk2(s[2 * 33], s[3 * 33]); o.z = pk2(s[4 * 33], s[5 * 33]); o.w = pk2(s[6 * 33], s[7 * 33]);
        *(u32x4*)(WT + (size_t)(drow0 + n) * K + k0 + 8 * c) = o; }
    asm volatile("s_waitcnt lgkmcnt(0)" ::: "memory");
}
__device__ __forceinline__ void ph_convert(Frame& F, CArgs& A, bool small_only) {
    LAS float* scr = (LAS float*)(F.lds + 32768 + F.wave * 8448);
    const int gw = F.vcu * NWAVES + F.wave, NGW = F.G * NWAVES;
    constexpr int I_IN = DEPTH * 16 * 128, I_OUT = DEPTH * 16 * 32, I_GU = DEPTH * NEXP * 16 * 64, I_DN = DEPTH * NEXP * 16 * 32;
    for (int it = gw; it < (small_only ? I_IN + I_OUT : I_IN + I_OUT + I_GU + I_DN); it += NGW) {
        int r = it;
        if (r < I_IN) { const int l = r / 2048, q = r % 2048, kb = q / 128, nb = q % 128, d0 = nb * 32, n0 = d0 < 1536 ? d0 : d0 + 16;
            transpose_item(A.in[I_WIN] + (size_t)l * D * INW, INW, D, (bf16*)(F.ws + WS_WIN) + (size_t)l * PW * D, kb * 64, n0, d0, scr, F.lane); continue; }
        r -= I_IN;
        if (r < I_OUT) { const int l = r / 512, q = r % 512, kb = q / 32, nb = q % 32;
            transpose_item(A.in[I_WOUT] + (size_t)l * D * D, D, D, (bf16*)(F.ws + WS_WOUT) + (size_t)l * D * D, kb * 64, nb * 32, nb * 32, scr, F.lane); continue; }
        r -= I_OUT;
        if (r < I_GU) { const int m = r / 1024, q = r % 1024, kb = q / 64, nb = q % 64, n0 = nb * 32;
            const int cc = n0 & 1023, d0 = (cc >> 7) * 256 + (n0 >= 1024 ? 128 : 0) + (cc & 127);
            transpose_item(A.in[I_WGU] + (size_t)m * D * 2048, 2048, D, (bf16*)(F.ws + WS_WGU) + (size_t)m * 2048 * D, kb * 64, n0, d0, scr, F.lane); continue; }
        r -= I_GU;
        { const int m = r / 512, q = r % 512, kb = q / 32, nb = q % 32;
            transpose_item(A.in[I_WDN] + (size_t)m * DEXP * D, D, DEXP, (bf16*)(F.ws + WS_WDN) + (size_t)m * D * DEXP, kb * 64, nb * 32, nb * 32, scr, F.lane); }
    }
}


constexpr int CV_NJ = 384;
__device__ __forceinline__ void moe_item_addr(CArgs& A, unsigned char* ws, int item, const float*& W, int& ldw, bf16*& WT, int& k0, int& n0, int& d0) {
    const int l = item / 49152, r = item % 49152;
    if (r < 32768) { const int e = r >> 10, q = r & 1023, kb = q >> 6, nb = q & 63; n0 = nb * 32; const int cc = n0 & 1023; d0 = (cc >> 7) * 256 + (n0 >= 1024 ? 128 : 0) + (cc & 127); k0 = kb * 64;
        W = A.in[I_WGU] + (size_t)(l * NEXP + e) * D * 2048; ldw = 2048; WT = (bf16*)(ws + WS_WGU) + (size_t)(l * NEXP + e) * 2048 * D; }
    else { const int r2 = r - 32768, e = r2 >> 9, q = r2 & 511, kb = q >> 5, nb = q & 31; n0 = nb * 32; d0 = n0; k0 = kb * 64;
        W = A.in[I_WDN] + (size_t)(l * NEXP + e) * DEXP * D; ldw = D; WT = (bf16*)(ws + WS_WDN) + (size_t)(l * NEXP + e) * D * DEXP; }
}
__device__ __forceinline__ void transpose_store(bf16* WT, int K, int k0, int d0, LAS float* scr, const f32x4 (&v)[8], int lane) {
    const int n4 = (lane & 7) * 4, kr = lane >> 3;
#pragma unroll
    for (int i = 0; i < 8; ++i) { LAS float* p = scr + (8 * i + kr) * 33 + n4; p[0] = v[i].x; p[1] = v[i].y; p[2] = v[i].z; p[3] = v[i].w; }
    asm volatile("s_waitcnt lgkmcnt(0)" ::: "memory");
    const int c = lane & 7;
#pragma unroll
    for (int j = 0; j < 4; ++j) { const int n = (lane >> 3) + 8 * j; const LAS float* sp = scr + (8 * c) * 33 + n;
        u32x4 o; o.x = pk2(sp[0 * 33], sp[1 * 33]); o.y = pk2(sp[2 * 33], sp[3 * 33]); o.z = pk2(sp[4 * 33], sp[5 * 33]); o.w = pk2(sp[6 * 33], sp[7 * 33]);
        *(u32x4*)(WT + (size_t)(d0 + n) * K + k0 + 8 * c) = o; }
    asm volatile("s_waitcnt lgkmcnt(0)" ::: "memory");
}
__device__ __forceinline__ void convert_moe_all(unsigned char* ws, LAS unsigned char* lds, CArgs& A, int cw, int nw, int wave, int lane, int it_lo = 0, int it_hi = 49152) {
    LAS float* scr = (LAS float*)(lds + wave * 16640);
    const int n4 = (lane & 15) * 4, kr = lane >> 4;
    for (int it = it_lo + cw; it < it_hi; it += 2 * nw) {
        const float* W[2]; bf16* WT[2]; int ldw[2], k0[2], n0[2], d0[2];
        const bool two = it + nw < it_hi;
#pragma unroll
        for (int u = 0; u < 2; ++u) { const int iu = (u == 1 && two) ? it + nw : it; const int le = iu / 768, r = iu % 768;
            if (r < 512) { const int kb = r >> 5, nb = r & 31; k0[u] = kb * 64; n0[u] = nb * 64; const int cc = n0[u] & 1023; d0[u] = (cc >> 7) * 256 + (n0[u] >= 1024 ? 128 : 0) + (cc & 127);
                W[u] = A.in[I_WGU] + (size_t)le * D * 2048; ldw[u] = 2048; WT[u] = (bf16*)(ws + WS_WGU) + (size_t)le * 2048 * D; }
            else { const int q = r - 512, kb = q >> 4, nb = q & 15; k0[u] = kb * 64; n0[u] = nb * 64; d0[u] = n0[u];
                W[u] = A.in[I_WDN] + (size_t)le * DEXP * D; ldw[u] = D; WT[u] = (bf16*)(ws + WS_WDN) + (size_t)le * D * DEXP; } }
        f32x4 v[2][16];
#pragma unroll
        for (int u = 0; u < 2; ++u)
#pragma unroll
            for (int i = 0; i < 16; ++i) v[u][i] = __builtin_nontemporal_load((const f32x4*)(W[u] + (size_t)(k0[u] + 4 * i + kr) * ldw[u] + n0[u] + n4));
#pragma unroll
        for (int u = 0; u < 2; ++u) { if (u == 1 && !two) break;
#pragma unroll
            for (int i = 0; i < 16; ++i) { LAS float* p = scr + (4 * i + kr) * 65 + n4; p[0] = v[u][i].x; p[1] = v[u][i].y; p[2] = v[u][i].z; p[3] = v[u][i].w; }
            asm volatile("s_waitcnt lgkmcnt(0)" ::: "memory");
            const int c = lane & 7;
#pragma unroll
            for (int j = 0; j < 8; ++j) { const int n = (lane >> 3) + 8 * j; const LAS float* sp = scr + (8 * c) * 65 + n;
                u32x4 o; o.x = pk2(sp[0 * 65], sp[1 * 65]); o.y = pk2(sp[2 * 65], sp[3 * 65]); o.z = pk2(sp[4 * 65], sp[5 * 65]); o.w = pk2(sp[6 * 65], sp[7 * 65]);
                *(u32x4*)(WT[u] + (size_t)(d0[u] + n) * 1024 + k0[u] + 8 * c) = o; }
            asm volatile("s_waitcnt lgkmcnt(0)" ::: "memory"); }
    }
}
__device__ __forceinline__ void convert_moe(unsigned char* ws, LAS unsigned char* lds, CArgs& A, int cw, int wave, int lane, int j0, int j1) {
    LAS float* scr = (LAS float*)(lds + wave * 8448);
    const int n4 = (lane & 7) * 4, kr = lane >> 3;
    for (int j = j0; j < j1; j += 2) {
        const float* W0; const float* W1; bf16* T0; bf16* T1; int l0, l1, ka, kb_, na, nb_, da, db;
        moe_item_addr(A, ws, cw + 256 * j, W0, l0, T0, ka, na, da);
        const bool two = j + 1 < j1; moe_item_addr(A, ws, cw + 256 * (two ? j + 1 : j), W1, l1, T1, kb_, nb_, db);
        f32x4 v0[8], v1[8];
#pragma unroll
        for (int i = 0; i < 8; ++i) v0[i] = __builtin_nontemporal_load((const f32x4*)(W0 + (size_t)(ka + 8 * i + kr) * l0 + na + n4));
#pragma unroll
        for (int i = 0; i < 8; ++i) v1[i] = __builtin_nontemporal_load((const f32x4*)(W1 + (size_t)(kb_ + 8 * i + kr) * l1 + nb_ + n4));
        transpose_store(T0, 1024, ka, da, scr, v0, lane);
        if (two) transpose_store(T1, 1024, kb_, db, scr, v1, lane);
    }
}

#define XB_TMO      128
#define XB_XCNT(j)  (256  + 64 * (j))
#define XB_XSUB(j)  (1280 + 64 * (j))
#define XB_XGEN(j)  (2304 + 64 * (j))
#define XB_TOP      3328
#define XB_TOPGEN   3392
#define XCD_BAR_WORDS 3456
#define XB_SPIN_CAP (1u << 18)
__device__ __forceinline__ unsigned xb_ld(unsigned* p)              { return __hip_atomic_load(p, __ATOMIC_RELAXED, __HIP_MEMORY_SCOPE_AGENT); }
__device__ __forceinline__ unsigned xb_add(unsigned* p, unsigned v) { return __hip_atomic_fetch_add(p, v, __ATOMIC_RELAXED, __HIP_MEMORY_SCOPE_AGENT); }
__device__ __forceinline__ unsigned xb_xcc_id() { return (unsigned)__builtin_amdgcn_s_getreg((3 << 11) | 20) & 0xFu; }
#define XB_SPIN(cond, bar) do { unsigned _sp = 0; while (cond) { __builtin_amdgcn_s_sleep(1); \
    if ((++_sp & 255u) == 0u) { if (xb_ld(&(bar)[XB_TMO])) break; if (_sp > XB_SPIN_CAP) { atomicAdd(&(bar)[XB_TMO], 1u); break; } } } } while (0)
struct XcdBarrier { unsigned* bar; unsigned x; volatile LAS unsigned* st; };
__device__ __forceinline__ XcdBarrier xcd_barrier_post(unsigned* bar, volatile LAS unsigned* st) {
    XcdBarrier b; b.bar = bar; b.x = xb_xcc_id(); b.st = st;
    if (threadIdx.x == 0) (void)xb_add(&bar[XB_XCNT(b.x)], 1u);
    return b;
}
__device__ __forceinline__ void xcd_barrier_complete(unsigned* bar, unsigned x, unsigned& nloc, unsigned& nx) {
    const unsigned G = gridDim.x * gridDim.y * gridDim.z;
    unsigned sum, cnt, mine, sp = 0u;
    for (;;) {
        sum = 0u; cnt = 0u; mine = 0u;
#pragma unroll
        for (unsigned j = 0; j < 16; ++j) { const unsigned c = xb_ld(&bar[XB_XCNT(j)]); sum += c; cnt += (c > 0u) ? 1u : 0u; mine = (j == x) ? c : mine; }
        if (sum == G) break;
        __builtin_amdgcn_s_sleep(1);
        if ((++sp & 255u) == 0u) { if (xb_ld(&bar[XB_TMO])) break; if (sp > XB_SPIN_CAP) { atomicAdd(&bar[XB_TMO], 1u); break; } }
    }
    nloc = mine > 0u ? mine : 1u; nx = cnt > 0u ? cnt : 1u;
}
__device__ __forceinline__ void xcd_barrier(const XcdBarrier& b) {
    asm volatile("s_waitcnt vmcnt(0)" ::: "memory");
    __syncthreads();
    if (threadIdx.x == 0) {
        unsigned* bar = b.bar;
        __builtin_amdgcn_s_waitcnt(0);
        unsigned nloc = b.st[0], nx = b.st[1];
        if (nloc == 0u) { xcd_barrier_complete(bar, b.x, nloc, nx); b.st[0] = nloc; b.st[1] = nx; }
        const unsigned old = xb_add(&bar[XB_XSUB(b.x)], 1u);
        const unsigned gen = old / nloc;
        if (old + 1u == (gen + 1u) * nloc) {
            __builtin_amdgcn_fence(__ATOMIC_RELEASE, "agent");
            asm volatile("s_waitcnt vmcnt(0)" ::: "memory");
            const unsigned og = xb_add(&bar[XB_TOP], 1u);
            const unsigned tg = og / nx;
            if (og + 1u == (tg + 1u) * nx) xb_add(&bar[XB_TOPGEN], 1u);
            else XB_SPIN(xb_ld(&bar[XB_TOPGEN]) == tg, bar);
            __builtin_amdgcn_fence(__ATOMIC_ACQUIRE, "agent");
            xb_add(&bar[XB_XGEN(b.x)], 1u);
            asm volatile("s_waitcnt vmcnt(0)" ::: "memory");
        } else {
            XB_SPIN(xb_ld(&bar[XB_XGEN(b.x)]) == gen, bar);
            __builtin_amdgcn_fence(__ATOMIC_ACQUIRE, "agent");
            asm volatile("s_waitcnt vmcnt(0)" ::: "memory");
        }
    }
    __syncthreads();
}

enum { PH_INIT = 0, PH_NORM1, PH_INPROJ, PH_CONV, PH_SCANA, PH_SCANB, PH_SCANC, PH_HNORM, PH_OUTPROJ, PH_NORM2, PH_LISTS, PH_GU, PH_DOWN, PH_COMBINE, PH_FINAL };

constexpr int NPHASE = 1 + 13 * DEPTH;
template <int ph, int l>
__device__ __forceinline__ void run_phase(LAS unsigned char* lds_raw) {
    int tid_ = threadIdx.x; asm volatile("" : "+v"(tid_));
    CArgs* ap_ = (CArgs*)__builtin_amdgcn_kernarg_segment_ptr(); asm volatile("" : "+s"(ap_));
    CArgs& A_ = *ap_;
    unsigned char* ws_ = A_.ws; asm volatile("" : "+s"(ws_));
    unsigned lb_ = 0u, bx_ = blockIdx.x, gx_ = gridDim.x; asm volatile("" : "+s"(lb_), "+s"(bx_), "+s"(gx_));
    Frame F; F.lds = lds_raw + lb_; F.out = A_.out; F.ws = ws_;
    F.tid = tid_; F.lane = F.tid & 63; F.wave = __builtin_amdgcn_readfirstlane(F.tid >> 6);
    F.G = (int)gx_; { const int bx = (int)bx_; F.vcu = (F.G % 8 == 0) ? (bx % 8) * (F.G / 8) + bx / 8 : bx; }
    constexpr int nrows = (l == DEPTH - 1) ? NLAT : NTOK;
    constexpr bool CVPH = (l == 0) && (ph <= PH_LISTS);
    constexpr int CQ0 = ph == PH_INIT ? 0 : ph == PH_NORM1 ? 25 : ph == PH_INPROJ ? 55 : ph == PH_CONV ? 140 : ph == PH_SCANA ? 165 : ph == PH_SCANB ? 205 : ph == PH_SCANC ? 233 : ph == PH_OUTPROJ ? 313 : ph == PH_NORM2 ? 344 : 378;
    constexpr int CQ1 = ph == PH_INIT ? 25 : ph == PH_NORM1 ? 55 : ph == PH_INPROJ ? 140 : ph == PH_CONV ? 165 : ph == PH_SCANA ? 205 : ph == PH_SCANB ? 233 : ph == PH_SCANC ? 313 : ph == PH_OUTPROJ ? 344 : ph == PH_NORM2 ? 378 : CV_NJ;
    const bool cvgrid = false;
    if (CVPH && cvgrid) {
        if (bx_ >= 224u) { const int cvcu = (int)(bx_ & 7u) * 4 + ((int)(bx_ >> 3) - 28); convert_moe(ws_, F.lds, A_, cvcu * 8 + F.wave, F.wave, F.lane, CQ0, CQ1); return; }
        F.G = 224; F.vcu = (int)(bx_ & 7u) * 28 + (int)(bx_ >> 3); gx_ = 224u;
    }
    switch (ph) {
        case PH_INIT: ph_init(F, A_); ph_convert(F, A_, true); break;
        case PH_INPROJ: {
            const bool cfirst = ((bx_ >> 3) & 1u) == 0u;
            int base, nblk;
            if (F.G == 256 && l == 0) { if (bx_ >= 32u) { const int ix = (int)bx_ - 32; nblk = 74 + (ix < 16 ? 1 : 0); base = ix * 74 + (ix < 16 ? ix : 16); } else { base = 16592 + (int)bx_ * 48; nblk = 48; } }
            else if (F.G == 256) { if (bx_ >= 32u) { base = ((int)bx_ - 32) * 100; nblk = 100; } else { base = 22400 + (int)bx_ * 68; nblk = 68; } }
            else { const int per = (24576 + F.G - 1) / F.G; base = F.vcu * per; nblk = base + per <= 24576 ? per : (base < 24576 ? 24576 - base : 0); }
            base += l * 24576;
            if (cfirst) { convert_moe_all(F.ws, F.lds, A_, F.wave, NWAVES, F.wave, F.lane, base, base + nblk); __syncthreads(); }
            { pg8::Gemm g{(const bf16*)(F.ws + WS_H), (const bf16*)(F.ws + WS_WIN) + (size_t)l * PW * D, D, nullptr, nullptr, 0};
              pg8::StaticOrder S; S.init(NTOK / 256, PW / 256, F.G, (int)bx_); pg8::EpiBf16 E{(bf16*)(F.ws + WS_P), PW};
              pg8::gemm_phase<pg8::EpiBf16, pg8::StaticOrder, true>(F.lds, g, S, E, F.tid); }
            if (!cfirst) { __syncthreads(); convert_moe_all(F.ws, F.lds, A_, F.wave, NWAVES, F.wave, F.lane, base, base + nblk); }
        } break;
        case PH_NORM1: if (l == 0) ph_rows<1, 0>(F, A_, 0, 0, NTOK); break;
        case PH_CONV: ph_conv(F, A_, l); break;
        case PH_SCANA: {
#define LD_(t, R) ml_passA_load(F, t, R)
#define RN_(t, R) ml_passA_run(F, t, R)
            TASK_LOOP(MlARaw, LD_, RN_, 0, 8 * NTC);
#undef LD_
#undef RN_
#define LD_(t, R) hg_passA_load(F, t, R)
#define RN_(t, R) hg_passA_run(F, A_, l, t, R)
            TASK_LOOP(HgARaw, LD_, RN_, 8 * NTC, 16 * NTC);
#undef LD_
#undef RN_
        } break;
        case PH_SCANB: scan_passB(F); break;
        case PH_SCANC: {
#define LD_(t, R) ml_passC_load(F, t, R)
#define RN_(t, R) ml_passC_run(F, A_, l, t, R)
            TASK_LOOP(MlCRaw, LD_, RN_, 0, 8 * NTC);
#undef LD_
#undef RN_
#define LD_(t, R) hg_passC_load(F, t, R)
#define RN_(t, R) hg_passC_run(F, A_, l, t, R)
            TASK_LOOP(HgCRaw, LD_, RN_, 8 * NTC, 16 * NTC);
#undef LD_
#undef RN_
        } break;
        case PH_OUTPROJ: { pg8::Gemm g{(const bf16*)(F.ws + WS_Y), (const bf16*)(F.ws + WS_WOUT) + (size_t)l * D * D, D, nullptr, nullptr, 0};
            pg8::StaticOrder S; S.init(nrows / 256, D / 256, F.G, (int)bx_);
            const float* xs = (const float*)(F.ws + WS_X);
            pg8::EpiResid E{(float*)(F.ws + WS_X), (const float*)(F.ws + WS_MOD) + (size_t)l * 3 * 6144 + 2048, l == 0 ? A_.in[I_X] : xs, l == 0 ? A_.in[I_CTX] : xs + (size_t)NLAT * D};
            pg8::gemm_phase<pg8::EpiResid, pg8::StaticOrder, true>(F.lds, g, S, E, F.tid);
            if (l == 0 && F.G == 256 && bx_ >= 8u) { __syncthreads(); const int base = 18128 + ((int)bx_ - 8) * 26; convert_moe_all(F.ws, F.lds, A_, F.wave, NWAVES, F.wave, F.lane, base, base + 26); } } break;
        case PH_GU: { const int* rt = (const int*)(F.ws + WS_ROUTE); const int ntile = rt[RT_TILEE];
            pg8::Gemm g{(const bf16*)(F.ws + WS_H), (const bf16*)(F.ws + WS_WGU) + (size_t)l * NEXP * 2048 * D, D, rt + RT_LIST, rt + RT_TILEE, (size_t)2048 * D};
            pg8::StaticOrder S; S.init(ntile, 2048 / 256, F.G, (int)bx_);
            pg8::EpiSwiglu E{(bf16*)(F.ws + WS_ACT), A_.in[I_BGU] + (size_t)l * NEXP * 2048, rt + RT_TILEE};
            pg8::gemm_phase<pg8::EpiSwiglu, pg8::StaticOrder, true>(F.lds, g, S, E, F.tid); } break;
        case PH_DOWN: { const int* rt = (const int*)(F.ws + WS_ROUTE); const int ntile = rt[RT_TILEE];
            pg8::Gemm g{(const bf16*)(F.ws + WS_ACT), (const bf16*)(F.ws + WS_WDN) + (size_t)l * NEXP * D * DEXP, DEXP, nullptr, rt + RT_TILEE, (size_t)D * DEXP};
            pg8::StaticOrder S; S.init(ntile, D / 256, F.G, (int)bx_);
            pg8::EpiDown E{(bf16*)(F.ws + WS_YS), A_.in[I_BDN] + (size_t)l * NEXP * D, (const float*)(rt + RT_SGATE), rt + RT_TILEE};
            pg8::gemm_phase<pg8::EpiDown, pg8::StaticOrder, true>(F.lds, g, S, E, F.tid); } break;
        case PH_HNORM: ph_hnorm(F, A_, l, l == DEPTH - 1); break;
        case PH_NORM2: ph_rows<0, 1>(F, A_, l, l, nrows); break;
        case PH_LISTS: ph_lists(F, A_, l, nrows); break;
        case PH_COMBINE: if (l == DEPTH - 1) ph_rows<2, 2>(F, A_, l, 0, NLAT); else ph_rows<2, 0>(F, A_, l, l + 1, NTOK); break;
        default: break;
    }
}
__global__ void __launch_bounds__(NTHR, 2) fwd(Args a) {
    extern __shared__ __attribute__((aligned(16))) unsigned char lds_raw[];
    volatile LAS unsigned* bst = (volatile LAS unsigned*)((LAS unsigned char*)lds_raw + LDS_BYTES - 64);
    if (threadIdx.x < 16) bst[threadIdx.x] = 0u;
    __syncthreads();
    XcdBarrier bar = xcd_barrier_post((unsigned*)(a.ws + WS_CTL) + CW_BAR, bst);
#ifndef TPROBE
#define TPROBE 0
#endif
#ifndef TP0
#define TP0 0
#define TP1 0
#define TP2 0
#define TD0 800
#define TD1 800
#define TD2 800
#endif
    unsigned ta0 = 0u, ta1 = 0u, ta2 = 0u; unsigned long long tprev = 0;
    const bool stamper = TPROBE && blockIdx.x == 0;
    if (stamper) tprev = __builtin_amdgcn_s_memrealtime();
#define RUN(pi, ph, l) do { run_phase<ph, l>((LAS unsigned char*)lds_raw); if ((pi) != NPHASE - 1 || TPROBE) xcd_barrier(bar); \
    if (stamper) { const unsigned long long tn = __builtin_amdgcn_s_memrealtime(); const unsigned dt = (unsigned)(tn - tprev); tprev = tn; \
        if ((ph) == TP0) ta0 += dt; if ((ph) == TP1) ta1 += dt; if ((ph) == TP2) ta2 += dt; } } while (0)
#define LAYER(l) if (l == 0) RUN(1 + 13 * l, PH_NORM1, l); RUN(2 + 13 * l, PH_INPROJ, l); RUN(3 + 13 * l, PH_CONV, l); RUN(4 + 13 * l, PH_SCANA, l); RUN(5 + 13 * l, PH_SCANB, l); RUN(6 + 13 * l, PH_SCANC, l); \
    RUN(8 + 13 * l, PH_OUTPROJ, l); RUN(9 + 13 * l, PH_NORM2, l); RUN(10 + 13 * l, PH_LISTS, l); RUN(11 + 13 * l, PH_GU, l); RUN(12 + 13 * l, PH_DOWN, l); RUN(13 + 13 * l, PH_COMBINE, l)
    RUN(0, PH_INIT, 0);
    LAYER(0);
    LAYER(1);
#undef LAYER
#undef RUN
    if (TPROBE) {
        if (stamper) { const unsigned long long tn = __builtin_amdgcn_s_memrealtime();
            unsigned q0 = (ta0 + TD0 / 2) / TD0, q1 = (ta1 + TD1 / 2) / TD1, q2 = (ta2 + TD2 / 2) / TD2;
            q0 = q0 > 31u ? 31u : q0; q1 = q1 > 31u ? 31u : q1; q2 = q2 > 31u ? 31u : q2;
            const unsigned long long delay = (unsigned long long)(q0 + 32u * q1 + 1024u * q2) * 1600ull;
            while (__builtin_amdgcn_s_memrealtime() - tn < delay) __builtin_amdgcn_s_sleep(8);
        }
    }
}

template <int NB, class Epi>
__global__ void __launch_bounds__(256) naive_gemm(const bf16* A, int lda, const int* gather, const int* tile_e, int M, const float* B, size_t bexp, int ldb, int N, int K, int bshift_from, int bshift, int bgrp, Epi E) {
    __shared__ float As[16][68]; __shared__ float Bs[NB][16][68];
    const int m0 = blockIdx.y * 64, n0 = blockIdx.x * 64, tid = threadIdx.x, tx = tid & 15, ty = tid >> 4;
    int e = 0;
    if (tile_e) { const int nt = tile_e[0]; if (m0 >= nt * 256) return; e = tile_e[8 + (m0 >> 8)]; } else if (m0 >= M) return;
    const float* Bp = B + (size_t)e * bexp + (n0 + (n0 >= bshift_from ? bshift : 0));
    const int ar = tid >> 2, ak = (tid & 3) * 4; const int arow = gather ? gather[m0 + ar] : (m0 + ar);
    const bf16* Ap = A + (size_t)arow * lda + ak;
    const int bk = tid >> 4, bn = (tid & 15) * 4;
    float acc[NB][4][4];
#pragma unroll
    for (int g = 0; g < NB; ++g)
#pragma unroll
        for (int i = 0; i < 4; ++i)
#pragma unroll
            for (int j = 0; j < 4; ++j) acc[g][i][j] = 0.f;
    for (int k0 = 0; k0 < K; k0 += 16) {
        const u32x2 av = *(const u32x2*)(Ap + k0);
        As[ak + 0][ar] = bflo(av.x); As[ak + 1][ar] = bfhi(av.x); As[ak + 2][ar] = bflo(av.y); As[ak + 3][ar] = bfhi(av.y);
#pragma unroll
        for (int g = 0; g < NB; ++g) { const f32x4 bv = *(const f32x4*)(Bp + (size_t)(k0 + bk) * ldb + g * bgrp + bn); *(f32x4*)&Bs[g][bk][bn] = bv; }
        __syncthreads();
#pragma unroll
        for (int k = 0; k < 16; ++k) { const f32x4 a4 = *(const f32x4*)&As[k][ty * 4];
#pragma unroll
            for (int g = 0; g < NB; ++g) { const f32x4 b4 = *(const f32x4*)&Bs[g][k][tx * 4];
#pragma unroll
                for (int i = 0; i < 4; ++i) { acc[g][i][0] += a4[i] * b4[0]; acc[g][i][1] += a4[i] * b4[1]; acc[g][i][2] += a4[i] * b4[2]; acc[g][i][3] += a4[i] * b4[3]; } } }
        __syncthreads();
    }
#pragma unroll
    for (int i = 0; i < 4; ++i)
#pragma unroll
        for (int j = 0; j < 4; ++j) E(m0 + ty * 4 + i, n0 + tx * 4 + j, acc[0][i][j], NB == 2 ? acc[NB - 1][i][j] : 0.f, e);
}
struct EpiP { bf16* P; __device__ void operator()(int r, int c, float v, float, int) const { P[(size_t)r * PW + c] = (bf16)f2bf(v); } };
struct EpiOut { float* X; const float* MOD; __device__ void operator()(int r, int c, float v, float, int) const { X[(size_t)r * D + c] += MOD[mrow_of(r) * 6144 + 2048 + c] * v; } };
struct EpiGU { bf16* ACT; const float* bgu; __device__ void operator()(int r, int c, float g, float li, int e) const {
    g += bgu[(size_t)e * 2048 + c]; li += bgu[(size_t)e * 2048 + 1024 + c]; g = fminf(g, 7.f); li = fminf(fmaxf(li, -7.f), 7.f);
    ACT[(size_t)r * DEXP + c] = (bf16)f2bf(g * sigmoidf_(1.702f * g) * (li + 1.f)); } };
struct EpiDown { bf16* YS; const float* bdn; const float* sgate; __device__ void operator()(int r, int c, float v, float, int e) const { YS[(size_t)r * D + c] = (bf16)f2bf((v + bdn[(size_t)e * D + c]) * sgate[r]); } };

__global__ void __launch_bounds__(128) naive_mlstm(const bf16* CQK, const bf16* P, const float* GATES, float* HF, float* HB) {
    __shared__ float qs[8][64], ks[8][64];
    const int b = blockIdx.x >> 3, h = (blockIdx.x >> 1) & 3, dir = blockIdx.x & 1, tid = threadIdx.x;
    float C[64], n[64], m = 0.f;
#pragma unroll
    for (int d = 0; d < 64; ++d) { C[d] = 0.f; n[d] = 0.f; }
    float* OUT = dir ? HB : HF;
    for (int p0 = 0; p0 < CTX + SEQ; p0 += 8) {
        __syncthreads();
        { const int st = tid >> 4, pc = tid & 15, p = p0 + st; int row;
          if (p < CTX) row = NLAT + b * CTX + (dir ? CTX - 1 - p : p); else { const int q = p - CTX; row = b * SEQ + (dir ? SEQ - 1 - q : q); }
          const u32x4 w = *(const u32x4*)(CQK + (size_t)row * 512 + (pc < 8 ? h * 64 + pc * 8 : 256 + h * 64 + (pc - 8) * 8));
          float* dst = pc < 8 ? &qs[st][pc * 8] : &ks[st][(pc - 8) * 8];
          dst[0] = bflo(w.x); dst[1] = bfhi(w.x); dst[2] = bflo(w.y); dst[3] = bfhi(w.y); dst[4] = bflo(w.z); dst[5] = bfhi(w.z); dst[6] = bflo(w.w); dst[7] = bfhi(w.w); }
        __syncthreads();
        for (int st = 0; st < 8; ++st) {
            const int p = p0 + st; int row;
            if (p < CTX) row = NLAT + b * CTX + (dir ? CTX - 1 - p : p); else { const int q = p - CTX; row = b * SEQ + (dir ? SEQ - 1 - q : q); }
            const float ig = GATES[(size_t)row * 16 + dir * 4 + h], lf = GATES[(size_t)row * 16 + 8 + dir * 4 + h];
            const float v = bf2f(P[(size_t)row * PW + PC_V + h * 128 + tid]);
            const float mn = fmaxf(lf + m, ig), a = __expf(lf + m - mn), w = __expf(ig - mn), wv = w * v; m = mn;
            float num = 0.f, den = 0.f;
#pragma unroll
            for (int d = 0; d < 64; ++d) { const float kd = ks[st][d], qd = qs[st][d]; C[d] = a * C[d] + wv * kd; n[d] = a * n[d] + w * kd; num += C[d] * qd; den += n[d] * qd; }
            OUT[(size_t)row * D + h * 128 + tid] = num / fmaxf(fabsf(den), __expf(-mn));
        }
    }
}
__global__ void __launch_bounds__(128) naive_hgrn(const bf16* CQI, const bf16* P, const float* fb_l, const float* lbraw, int l, float* HF, float* HB) {
    __shared__ float fs[8][128], ks[8][128], qs[8][128];
    const int b = blockIdx.x >> 3, h = (blockIdx.x >> 1) & 3, dir = blockIdx.x & 1, tid = threadIdx.x, ch = h * 128 + tid;
    float S[128];
#pragma unroll
    for (int d = 0; d < 128; ++d) S[d] = 0.f;
    float lb = 0.f;
    if (l == 1) { const float r0 = lbraw[ch], r1 = lbraw[512 + ch], mx = fmaxf(r0, r1), e0 = __expf(r0 - mx), e1 = __expf(r1 - mx); lb = e1 / (e0 + e1); }
    const float bias = fb_l[dir * 512 + ch];
    float* OUT = dir ? HB : HF;
    for (int p0 = 0; p0 < CTX + SEQ; p0 += 8) {
        __syncthreads();
        float vv[8]; int rows[8];
#pragma unroll
        for (int st = 0; st < 8; ++st) { const int p = p0 + st; int row;
            if (p < CTX) row = NLAT + b * CTX + (dir ? CTX - 1 - p : p); else { const int q = p - CTX; row = b * SEQ + (dir ? SEQ - 1 - q : q); }
            rows[st] = row;
            const float z = bf2f(P[(size_t)row * PW + (dir ? PC_FB : PC_FF) + ch]) + bias;
            fs[st][tid] = lb + (1.f - lb) * sigmoidf_(z); ks[st][tid] = (1.f - lb) * sigmoidf_(-z);
            qs[st][tid] = bf2f(CQI[(size_t)row * 1024 + ch]); vv[st] = bf2f(CQI[(size_t)row * 1024 + 512 + ch]); }
        __syncthreads();
#pragma unroll
        for (int st = 0; st < 8; ++st) { float o = 0.f; const float v = vv[st];
#pragma unroll
            for (int d = 0; d < 128; ++d) { S[d] = fs[st][d] * S[d] + ks[st][d] * v; o += qs[st][d] * S[d]; }
            OUT[(size_t)rows[st] * D + 512 + ch] = o; }
    }
}

extern "C" void kernel_launch(void* const* d_in, const int* in_sizes, int n_in, void* d_out, int out_size, void* d_ws, size_t ws_size, hipStream_t stream) {
    static int grid = 0;
    if (grid == 0) {
        if (n_in != 24 || in_sizes[0] != NLAT * D || out_size != NLAT * D || ws_size < WS_END) { fprintf(stderr, "kernel_launch: unexpected shapes n_in %d in0 %d out %d ws %zu (need %zu)\n", n_in, n_in > 0 ? in_sizes[0] : -1, out_size, ws_size, (size_t)WS_END); grid = -1; return; }
        int dev = 0, cus = 0;
        if (hipGetDevice(&dev) != hipSuccess || hipDeviceGetAttribute(&cus, hipDeviceAttributeMultiprocessorCount, dev) != hipSuccess) { grid = -1; return; }
        if (hipFuncSetAttribute((const void*)fwd, hipFuncAttributeMaxDynamicSharedMemorySize, LDS_BYTES) != hipSuccess) { fprintf(stderr, "kernel_launch: hipFuncSetAttribute failed\n"); grid = -1; return; }
        grid = cus;
    }
    if (grid < 0) return;
    (void)hipMemsetAsync((char*)d_ws + WS_CTL, 0, 1 * MiB, stream);
    Args a{};
    for (int i = 0; i < 24; ++i) a.in[i] = (const float*)d_in[i];
    a.out = (float*)d_out; a.ws = (unsigned char*)d_ws; a.ph_lo = 0; a.ph_hi = 0;
    unsigned char* ws = (unsigned char*)d_ws;
    const float* const* in = a.in;
    int* rt = (int*)(ws + WS_ROUTE);
    a.ph_lo = 0; a.ph_hi = NPHASE;
    hipLaunchKernelGGL(fwd, dim3(grid), dim3(NTHR), LDS_BYTES, stream, a);
}
```

```cpp
#include <hip/hip_runtime.h>
#include <cstdio>
#include <cstdint>

#define GAS __attribute__((address_space(1)))
#define LAS __attribute__((address_space(3)))
typedef unsigned short bf16;
typedef float f32x4 __attribute__((ext_vector_type(4)));
typedef unsigned u32x4 __attribute__((ext_vector_type(4)));
typedef unsigned u32x2 __attribute__((ext_vector_type(2)));

constexpr int D = 1024, BATCH = 2, SEQ = 8192, DEPTH = 2, CTX = 256, GRIDW = 64;
constexpr int NLAT = BATCH * SEQ, NCTX = BATCH * CTX, NTOK = NLAT + NCTX;
constexpr int INW = 4112, PW = 4096;
constexpr int PC_QK = 0, PC_V = 512, PC_O = 1024, PC_QI = 1536, PC_FF = 2560, PC_FB = 3072, PC_GO = 3584;
constexpr int NEXP = 32, TOPK = 4, DEXP = 1024;
constexpr int MAXSLOT = (NTOK * TOPK / 256 + NEXP) * 256;
constexpr int MAXTILE = MAXSLOT / 256;
constexpr float EPS = 1e-6f;

constexpr size_t MiB = 1u << 20;
constexpr size_t WS_CTL = 0;
constexpr size_t WS_MOD = 1 * MiB;
constexpr size_t WS_GATES = 2 * MiB;
constexpr size_t WS_ROUTE = 4 * MiB;
constexpr size_t WS_X = 8 * MiB;
constexpr size_t WS_H = 76 * MiB;
constexpr size_t WS_P = 112 * MiB;
constexpr size_t WS_CQK = 246 * MiB;
constexpr size_t WS_CQI = 264 * MiB;
constexpr size_t WS_HF = 300 * MiB;
constexpr size_t WS_HB = 368 * MiB;
constexpr size_t WS_Y = 436 * MiB;
constexpr size_t WS_ACT = 472 * MiB;
constexpr size_t WS_YS = 622 * MiB;
constexpr size_t WS_WIN = 772 * MiB;
constexpr size_t WS_WOUT = 788 * MiB;
constexpr size_t WS_WGU = 792 * MiB;
constexpr size_t WS_WDN = 1048 * MiB;
constexpr size_t WS_MLC = 1176 * MiB;
constexpr size_t WS_MLN = 1246 * MiB;
constexpr size_t WS_MLS = 1247 * MiB;
constexpr size_t WS_HGS = 1248 * MiB;
constexpr size_t WS_HGG = 1388 * MiB;
constexpr size_t WS_MLCB = 1390 * MiB;
constexpr size_t WS_HGSB = 1426 * MiB;
constexpr size_t WS_END = 1496 * MiB;
constexpr int NTC = 132;
constexpr int RT_TOPI = 0;
constexpr int RT_TOPG = RT_TOPI + NTOK * 4;
constexpr int RT_POS = RT_TOPG + NTOK * 4;
constexpr int RT_SLOT = RT_POS + NTOK * 4;
constexpr int RT_LIST = RT_SLOT + NTOK * 4;
constexpr int RT_SGATE = RT_LIST + MAXSLOT;
constexpr int RT_TILEE = RT_SGATE + MAXSLOT;
constexpr int RT_BLKCNT = RT_TILEE + MAXTILE + 8;
constexpr int MAXG = 1024;
constexpr int RT_END = RT_BLKCNT + MAXG * 32;
static_assert((size_t)RT_END * 4 <= 4 * MiB, "route map");
constexpr int CW_CNT = 1024;
constexpr int CW_BAR = 4096;

typedef float f32x2_t __attribute__((ext_vector_type(2)));
typedef __bf16 bf16x2_t __attribute__((ext_vector_type(2)));
__device__ __forceinline__ unsigned pk2(float lo, float hi) { const f32x2_t v = {lo, hi}; return __builtin_bit_cast(unsigned, __builtin_convertvector(v, bf16x2_t)); }
__device__ __forceinline__ unsigned f2bf(float f) { return pk2(f, 0.f) & 0xffffu; }
__device__ __forceinline__ float bf2f(unsigned short b) { return __builtin_bit_cast(float, (unsigned)b << 16); }
__device__ __forceinline__ float bflo(unsigned w) { return __builtin_bit_cast(float, w << 16); }
__device__ __forceinline__ float bfhi(unsigned w) { return __builtin_bit_cast(float, w & 0xffff0000u); }
__device__ __forceinline__ float sigmoidf_(float x) { return 1.f / (1.f + __expf(-x)); }
__device__ __forceinline__ float siluf_(float x) { return x / (1.f + __expf(-x)); }
__device__ __forceinline__ float logsigmoidf_(float x) { return x >= 0.f ? -log1pf(__expf(-x)) : x - log1pf(__expf(x)); }
template <int CTRL, int ROWMASK, bool BOUND0>
__device__ __forceinline__ float dppf(float old, float x) { return __builtin_bit_cast(float, __builtin_amdgcn_update_dpp(__builtin_bit_cast(int, old), __builtin_bit_cast(int, x), CTRL, ROWMASK, 0xf, BOUND0)); }
__device__ __forceinline__ float half_sum_hi(float x) {
    x += dppf<0xB1, 0xf, true>(0.f, x); x += dppf<0x4E, 0xf, true>(0.f, x); x += dppf<0x114, 0xf, true>(0.f, x); x += dppf<0x118, 0xf, true>(0.f, x);
    x += dppf<0x142, 0xa, true>(0.f, x); return x; }
__device__ __forceinline__ float wave_sum(float v) {
    v = half_sum_hi(v); v += dppf<0x143, 0xc, true>(0.f, v); return __builtin_bit_cast(float, __builtin_amdgcn_readlane(__builtin_bit_cast(int, v), 63)); }
__device__ __forceinline__ float wave_incl_sum(float v, int) {
    v += dppf<0x111, 0xf, true>(0.f, v); v += dppf<0x112, 0xf, true>(0.f, v); v += dppf<0x114, 0xf, true>(0.f, v); v += dppf<0x118, 0xf, true>(0.f, v);
    v += dppf<0x142, 0xa, true>(0.f, v); v += dppf<0x143, 0xc, true>(0.f, v); return v; }
__device__ __forceinline__ float wave_incl_max(float v, int) {
    const float NI = -INFINITY;
    v = fmaxf(v, dppf<0x111, 0xf, false>(NI, v)); v = fmaxf(v, dppf<0x112, 0xf, false>(NI, v)); v = fmaxf(v, dppf<0x114, 0xf, false>(NI, v)); v = fmaxf(v, dppf<0x118, 0xf, false>(NI, v));
    v = fmaxf(v, dppf<0x142, 0xa, false>(NI, v)); v = fmaxf(v, dppf<0x143, 0xc, false>(NI, v)); return v; }
__device__ __forceinline__ float wave_max(float v) { v = wave_incl_max(v, 0); return __builtin_bit_cast(float, __builtin_amdgcn_readlane(__builtin_bit_cast(int, v), 63)); }
__device__ __forceinline__ int mrow_of(int r) { return r < NLAT ? (r >> 13) : 2; }

struct Args { const float* in[24]; float* out; unsigned char* ws; int ph_lo, ph_hi; };
typedef const __attribute__((address_space(4))) Args CArgs;

enum { I_X = 0, I_C, I_CTX, I_CCTX, I_WADA, I_BADA, I_N1G, I_WIN, I_MLCONV, I_MLGB, I_MLNG, I_HGCONV, I_HGFB, I_HGLB, I_HGNG, I_WOUT, I_N2G, I_RW, I_RB, I_WGU, I_BGU, I_WDN, I_BDN, I_FG };

constexpr int NWAVES = 8, NTHR = 512;
constexpr int LDS_BYTES = 147456;

struct Frame {
    LAS unsigned char* lds;
    float* out; unsigned char* ws;
    int tid, lane, wave, vcu, G;
};

__device__ __forceinline__ void ph_init(Frame& F, CArgs& A) {
    const int gt = F.vcu * NTHR + F.tid, NG = F.G * NTHR;
    if (gt < 128) ((u32x4*)(F.ws + WS_H + (size_t)NTOK * D * 2))[gt] = (u32x4){0u, 0u, 0u, 0u};
    LAS float* sc = (LAS float*)F.lds;
    LAS float* part = sc + 3 * 1024;
    for (int i = F.tid; i < 3 * 1024; i += NTHR) { const int r = i >> 10, k = i & 1023; const float c = r < 2 ? A.in[I_C][r * 1024 + k] : A.in[I_CCTX][k]; sc[i] = siluf_(c); }
    __syncthreads();
    for (int item = F.vcu; item < DEPTH * 96; item += F.G) {
        const int l = item / 96, j = (item % 96) * 64 + F.lane;
        const float* w = A.in[I_WADA] + (size_t)l * D * 6144 + j;
        float a0 = 0.f, a1 = 0.f, a2 = 0.f;
        for (int k0 = F.wave * 128; k0 < F.wave * 128 + 128; k0 += 32) { float wv[32];
#pragma unroll
            for (int i = 0; i < 32; ++i) wv[i] = w[(size_t)(k0 + i) * 6144];
#pragma unroll
            for (int i = 0; i < 32; ++i) { a0 += sc[k0 + i] * wv[i]; a1 += sc[1024 + k0 + i] * wv[i]; a2 += sc[2048 + k0 + i] * wv[i]; } }
        part[(F.wave * 3 + 0) * 64 + F.lane] = a0; part[(F.wave * 3 + 1) * 64 + F.lane] = a1; part[(F.wave * 3 + 2) * 64 + F.lane] = a2;
        __syncthreads();
        if (F.tid < 192) { const int r = F.tid >> 6, ln = F.tid & 63; float s = 0.f;
#pragma unroll
            for (int w8 = 0; w8 < 8; ++w8) s += part[(w8 * 3 + r) * 64 + ln];
            const int jj = (item % 96) * 64 + ln;
            ((float*)(F.ws + WS_MOD))[(l * 3 + r) * 6144 + jj] = s + A.in[I_BADA][l * 6144 + jj]; }
        __syncthreads();
    }
}

typedef unsigned u32x2v __attribute__((ext_vector_type(2)));
__device__ __forceinline__ float xor32(float send, int lane) { const unsigned u = __builtin_bit_cast(unsigned, send); const u32x2v r = __builtin_amdgcn_permlane32_swap(u, u, false, false);
    return __builtin_bit_cast(float, (lane & 32) ? r.x : r.y); }
__device__ __forceinline__ float xor16(float send, int lane) { const unsigned u = __builtin_bit_cast(unsigned, send); const u32x2v r = __builtin_amdgcn_permlane16_swap(u, u, false, false);
    return __builtin_bit_cast(float, (lane & 16) ? r.x : r.y); }
__device__ __forceinline__ float xor8(float x) { return dppf<0x140, 0xf, true>(0.f, dppf<0x141, 0xf, true>(0.f, x)); }
__device__ __forceinline__ float xor4(float x) { return dppf<0x141, 0xf, true>(0.f, dppf<0x1B, 0xf, true>(0.f, x)); }
__device__ __forceinline__ float xor2(float x) { return dppf<0x4E, 0xf, true>(0.f, x); }
__device__ __forceinline__ float xor1(float x) { return dppf<0xB1, 0xf, true>(0.f, x); }
template <int NV> __device__ __forceinline__ float reduce_scatter(float (&v)[NV], int lane) {
    float a16[16];
    if constexpr (NV == 32) { const bool hi = lane & 32;
#pragma unroll
        for (int i = 0; i < 16; ++i) { const float keep = hi ? v[16 + i] : v[i], send = hi ? v[i] : v[16 + i]; a16[i] = keep + xor32(send, lane); } }
    else {
#pragma unroll
        for (int i = 0; i < 16; ++i) a16[i] = v[i] + xor1(v[i]); }
    float a8[8], a4[4], a2[2];
    { const bool hi = lane & 16;
#pragma unroll
      for (int i = 0; i < 8; ++i) { const float keep = hi ? a16[8 + i] : a16[i], send = hi ? a16[i] : a16[8 + i]; a8[i] = keep + xor16(send, lane); } }
    { const bool hi = lane & 8;
#pragma unroll
      for (int i = 0; i < 4; ++i) { const float keep = hi ? a8[4 + i] : a8[i], send = hi ? a8[i] : a8[4 + i]; a4[i] = keep + xor8(send); } }
    { const bool hi = lane & 4;
#pragma unroll
      for (int i = 0; i < 2; ++i) { const float keep = hi ? a4[2 + i] : a4[i], send = hi ? a4[i] : a4[2 + i]; a2[i] = keep + xor4(send); } }
    float r;
    { const bool hi = lane & 2; const float keep = hi ? a2[1] : a2[0], send = hi ? a2[0] : a2[1]; r = keep + xor2(send); }
    if constexpr (NV == 32) r += xor1(r); else r += xor32(r, lane);
    return r;
}
struct RowIn { f32x4 x[4]; u32x2 y[4][4]; };
template <int SRC>
__device__ __forceinline__ void row_load(Frame& F, CArgs& A, int r, const int (&slot)[4], RowIn& R) {
    const float* src = SRC == 1 ? (r < NLAT ? A.in[I_X] + (size_t)r * D : A.in[I_CTX] + (size_t)(r - NLAT) * D) : (const float*)(F.ws + WS_X) + (size_t)r * D;
    const f32x4* xr = (const f32x4*)src + F.lane;
#pragma unroll
    for (int j = 0; j < 4; ++j) R.x[j] = xr[64 * j];
    if (SRC == 2) {
#pragma unroll
        for (int k = 0; k < 4; ++k) { const u32x2* yp = (const u32x2*)(F.ws + WS_YS + (size_t)slot[k] * D * 2) + F.lane;
#pragma unroll
            for (int j = 0; j < 4; ++j) R.y[k][j] = yp[64 * j]; } }
}
#define LDS_BARRIER() do { asm volatile("s_waitcnt lgkmcnt(0)" ::: "memory"); __builtin_amdgcn_s_barrier(); asm volatile("" ::: "memory"); } while (0)
template <int SRC, int MODE>
__device__ __forceinline__ void ph_rows(Frame& F, CArgs& A, int lsrc, int l, int nrows) {
    constexpr int NV = MODE == 0 ? 16 : 32;
    constexpr int EPW = NV / 8;
    f32x2_t wp[EPW][4][2];
    LAS unsigned* lcnt = (LAS unsigned*)(F.lds + 131072);
    if (MODE == 1) { const float* w = A.in[I_RW] + (size_t)l * D * NEXP + 4 * F.wave; if (F.tid < 32) lcnt[F.tid] = 0u;
#pragma unroll
        for (int j = 0; j < 4; ++j) { f32x4 q[4];
#pragma unroll
            for (int i = 0; i < 4; ++i) q[i] = *(const f32x4*)(w + (size_t)(256 * j + 4 * F.lane + i) * NEXP);
#pragma unroll
            for (int e = 0; e < EPW; ++e) { wp[e][j][0] = (f32x2_t){q[0][e], q[1][e]}; wp[e][j][1] = (f32x2_t){q[2][e], q[3][e]}; } } }
    if (MODE == 0) { const float* w = A.in[I_WIN] + (size_t)l * D * INW + 1536 + 2 * F.wave;
#pragma unroll
        for (int j = 0; j < 4; ++j) { f32x2_t q[4];
#pragma unroll
            for (int i = 0; i < 4; ++i) q[i] = *(const f32x2_t*)(w + (size_t)(256 * j + 4 * F.lane + i) * INW);
#pragma unroll
            for (int e = 0; e < EPW; ++e) { wp[e][j][0] = (f32x2_t){q[0][e], q[1][e]}; wp[e][j][1] = (f32x2_t){q[2][e], q[3][e]}; } } }
    const float* gam = MODE == 0 ? A.in[I_N1G] + l * D : (MODE == 1 ? A.in[I_N2G] + l * D : A.in[I_FG]);
    const float* MOD = (const float*)(F.ws + WS_MOD) + (size_t)l * 3 * 6144;
    const float* MODS = (const float*)(F.ws + WS_MOD) + (size_t)lsrc * 3 * 6144;
    const int* rt = (const int*)(F.ws + WS_ROUTE);
    const int stride = F.G * NWAVES; int r = F.vcu * NWAVES + F.wave;
    RowIn cur; int s1[4] = {0, 0, 0, 0}, s2[4] = {0, 0, 0, 0};
    if (SRC == 2) { if (r < nrows) { const u32x4 q = *(const u32x4*)(rt + RT_SLOT + r * 4); s1[0] = q.x; s1[1] = q.y; s1[2] = q.z; s1[3] = q.w; }
                    if (r + stride < nrows) { const u32x4 q = *(const u32x4*)(rt + RT_SLOT + (r + stride) * 4); s2[0] = q.x; s2[1] = q.y; s2[2] = q.z; s2[3] = q.w; } }
    if (r < nrows) row_load<SRC>(F, A, r, s1, cur);
    f32x4 Aq[4], Sq[4], Gq[4]; int mrp = -1;
    const float rbm = MODE == 1 ? A.in[I_RB][l * NEXP + 4 * F.wave + ((F.lane >> 1) & 3)] : 0.f;
    for (; r < nrows; r += stride) {
        RowIn nxt; int s3[4] = {0, 0, 0, 0};
        { const int mr = mrow_of(r);
          if (mr != mrp) { mrp = mr; const float* mod = MOD + mr * 6144 + (MODE == 0 ? 0 : 3072); const float* g2 = MODS + mr * 6144 + 5 * 1024;
#pragma unroll
              for (int j = 0; j < 4; ++j) { const int c = 256 * j + 4 * F.lane; const f32x4 g = *(const f32x4*)(gam + c);
                  if (MODE != 2) { const f32x4 sh = *(const f32x4*)(mod + c), scl = *(const f32x4*)(mod + 1024 + c); Aq[j] = g * (1.f + scl); Sq[j] = sh; } else { Aq[j] = g; Sq[j] = (f32x4){0.f, 0.f, 0.f, 0.f}; }
                  if (SRC == 2) Gq[j] = *(const f32x4*)(g2 + c); } } }
        if (SRC == 2 && r + 2 * stride < nrows) { const u32x4 q = *(const u32x4*)(rt + RT_SLOT + (r + 2 * stride) * 4); s3[0] = q.x; s3[1] = q.y; s3[2] = q.z; s3[3] = q.w; }
        if (r + stride < nrows) row_load<SRC>(F, A, r + stride, s2, nxt);
        f32x4 v[4];
#pragma unroll
        for (int j = 0; j < 4; ++j) v[j] = cur.x[j];
        if (SRC == 2) {
#pragma unroll
            for (int j = 0; j < 4; ++j) { f32x4 a = (f32x4){0.f, 0.f, 0.f, 0.f};
#pragma unroll
                for (int k = 0; k < 4; ++k) { const u32x2 w = cur.y[k][j]; a += (f32x4){bflo(w.x), bfhi(w.x), bflo(w.y), bfhi(w.y)}; }
                v[j] = v[j] + Gq[j] * a; } }
        if (SRC == 2 && MODE != 2) { f32x4* xo = (f32x4*)((float*)(F.ws + WS_X) + (size_t)r * D) + F.lane;
#pragma unroll
            for (int j = 0; j < 4; ++j) xo[64 * j] = v[j]; }
        float ss = 0.f;
#pragma unroll
        for (int j = 0; j < 4; ++j) ss += (v[j].x * v[j].x + v[j].y * v[j].y) + (v[j].z * v[j].z + v[j].w * v[j].w);
        const float rstd = rsqrtf(wave_sum(ss) * (1.f / D) + EPS);
#pragma unroll
        for (int j = 0; j < 4; ++j) { v[j] = v[j] * rstd * Aq[j]; if (MODE != 2) v[j] = v[j] + Sq[j]; }
        if (MODE == 2) { f32x4* o = (f32x4*)(F.out + (size_t)r * D) + F.lane;
#pragma unroll
            for (int j = 0; j < 4; ++j) o[64 * j] = v[j]; }
        else {
            u32x2* ho = (u32x2*)(F.ws + WS_H + (size_t)r * D * 2) + F.lane;
#pragma unroll
            for (int j = 0; j < 4; ++j) ho[64 * j] = (u32x2){pk2(v[j].x, v[j].y), pk2(v[j].z, v[j].w)};
            LAS f32x4* hb = (LAS f32x4*)F.lds;
            LAS float* lg = (LAS float*)(F.lds + 32768);
#pragma unroll
            for (int j = 0; j < 4; ++j) hb[(F.wave * 4 + j) * 64 + F.lane] = v[j];
            LDS_BARRIER();
            float part[NV];
#pragma unroll
            for (int q = 0; q < 8; ++q) { f32x4 hq[4];
#pragma unroll
                for (int j = 0; j < 4; ++j) hq[j] = hb[(q * 4 + j) * 64 + F.lane];
#pragma unroll
                for (int e = 0; e < EPW; ++e) { f32x2_t a2 = {0.f, 0.f};
#pragma unroll
                    for (int j = 0; j < 4; ++j) { a2 += (f32x2_t){hq[j].x, hq[j].y} * wp[e][j][0]; a2 += (f32x2_t){hq[j].z, hq[j].w} * wp[e][j][1]; }
                    part[q * EPW + e] = a2.x + a2.y; } }
            const float mine = reduce_scatter<NV>(part, F.lane);
            if (MODE == 0) { const int g = (F.lane >> 1) & 15; if ((F.lane & 33) == 0) lg[(g >> 1) * 16 + 2 * F.wave + (g & 1)] = mine; }
            else { const int g = (F.lane >> 1) & 31; if ((F.lane & 1) == 0) lg[(g >> 2) * 32 + 4 * F.wave + (g & 3)] = mine + rbm; }
            LDS_BARRIER();
            if (MODE == 0) {
                if (F.lane < 16) { const int g = F.lane; float val = lg[F.wave * 16 + g] + A.in[I_MLGB][l * 16 + g];
                    if (g >= 8) val = logsigmoidf_(val);
                    ((float*)(F.ws + WS_GATES))[(size_t)r * 16 + g] = val; }
            } else {
                const int e = F.lane & 31; const float my = lg[F.wave * 32 + e]; int rank = 0;
#pragma unroll
                for (int q = 0; q < 8; ++q) { const f32x4 t = *(const LAS f32x4*)(lg + F.wave * 32 + 4 * q);
#pragma unroll
                    for (int c = 0; c < 4; ++c) { const int j = 4 * q + c; rank += (t[c] > my || (t[c] == my && j < e)) ? 1 : 0; } }
                float tv[4]; int ti[4];
#pragma unroll
                for (int p = 0; p < 4; ++p) { const unsigned bal = (unsigned)__ballot(rank == p); const int bi = __ffs((int)bal) - 1;
                    ti[p] = bi; tv[p] = __builtin_bit_cast(float, __builtin_amdgcn_readlane(__builtin_bit_cast(int, my), bi)); }
                const float e1 = __expf(tv[1] - tv[0]), e2 = __expf(tv[2] - tv[0]), e3 = __expf(tv[3] - tv[0]); const float inv = 1.f / (1.f + e1 + e2 + e3);
                if (F.lane < 4) {
                    int* rtw = (int*)(F.ws + WS_ROUTE); const int p = F.lane;
                    const int tip = p == 0 ? ti[0] : (p == 1 ? ti[1] : (p == 2 ? ti[2] : ti[3]));
                    const float gp = (p == 0 ? 1.f : (p == 1 ? e1 : (p == 2 ? e2 : e3))) * inv;
                    rtw[RT_TOPI + r * 4 + p] = tip; ((float*)rtw)[RT_TOPG + r * 4 + p] = gp; rtw[RT_POS + r * 4 + p] = (int)__hip_atomic_fetch_add(lcnt + tip, 1u, __ATOMIC_RELAXED, __HIP_MEMORY_SCOPE_WORKGROUP);
                }
            }
        }
        cur = nxt;
#pragma unroll
        for (int k = 0; k < 4; ++k) { s2[k] = s3[k]; }
    }
    if (MODE == 1) { __syncthreads(); if (F.tid < 32) ((int*)(F.ws + WS_ROUTE))[RT_BLKCNT + F.vcu * 32 + F.tid] = (int)lcnt[F.tid]; }
}

__device__ __forceinline__ void ph_lists(Frame& F, CArgs& A, int l, int nrows) {
    LAS int* off = (LAS int*)F.lds;
    LAS int* pre = (LAS int*)(F.lds + 1024);
    int* rt = (int*)(F.ws + WS_ROUTE);
    { LAS int* gsum = (LAS int*)(F.lds + 1024 + 65536);
      const int e = F.tid & 31, grp = F.tid >> 5, per = (F.G + 15) >> 4, v0 = grp * per, v1 = min(v0 + per, F.G);
      int run = 0; for (int v = v0; v < v1; ++v) { pre[v * 32 + e] = run; run += rt[RT_BLKCNT + v * 32 + e]; }
      gsum[grp * 32 + e] = run;
      __syncthreads();
      int base = 0, tot = 0;
#pragma unroll
      for (int g = 0; g < 16; ++g) { const int t = gsum[g * 32 + e]; base += g < grp ? t : 0; tot += t; }
      for (int v = v0; v < v1; ++v) pre[v * 32 + e] += base;
      if (grp == 0) off[64 + e] = tot; }
    __syncthreads();
    if (F.tid == 0) { int o = 0; for (int e = 0; e < NEXP; ++e) { off[e] = o; o += (off[64 + e] + 255) & ~255; } off[32] = o; }
    __syncthreads();
    const int gt = F.vcu * NTHR + F.tid, NG = F.G * NTHR;
    for (int i = gt; i < nrows * 4; i += NG) { const int r = i >> 2, e = rt[RT_TOPI + i], v = (r % (F.G * NWAVES)) / NWAVES, s = off[e] + pre[v * 32 + e] + rt[RT_POS + i];
        rt[RT_SLOT + i] = s; rt[RT_LIST + s] = r; ((float*)rt)[RT_SGATE + s] = ((const float*)rt)[RT_TOPG + i]; }
    const int total = off[32];
    for (int s = gt; s < total; s += NG) { int e = 0;
#pragma unroll 1
        for (int q = 1; q < NEXP; ++q) if (s >= off[q]) e = q;
        if (s - off[e] >= off[64 + e]) { rt[RT_LIST + s] = NTOK; ((float*)rt)[RT_SGATE + s] = 0.f; }
        if ((s & 255) == 0) rt[RT_TILEE + 8 + (s >> 8)] = e; }
    if (gt == 0) rt[RT_TILEE] = total >> 8;
}

__device__ __forceinline__ void ph_conv(Frame& F, CArgs& A, int l) {
    LAS float* cw = (LAS float*)F.lds;
    { const f32x4* wm = (const f32x4*)(A.in[I_MLCONV] + (size_t)l * 9 * 512); const f32x4* wh = (const f32x4*)(A.in[I_HGCONV] + (size_t)l * 9 * 1024);
      f32x4 vm[3], vh[5];
#pragma unroll
      for (int j = 0; j < 3; ++j) { const int i = F.tid + NTHR * j; vm[j] = i < 9 * 128 ? wm[i] : (f32x4){0.f, 0.f, 0.f, 0.f}; }
#pragma unroll
      for (int j = 0; j < 5; ++j) { const int i = F.tid + NTHR * j; vh[j] = i < 9 * 256 ? wh[i] : (f32x4){0.f, 0.f, 0.f, 0.f}; }
#pragma unroll
      for (int j = 0; j < 3; ++j) { const int i = F.tid + NTHR * j; if (i < 9 * 128) *(LAS f32x4*)(cw + (i / 128) * 1536 + (i % 128) * 4) = vm[j]; }
#pragma unroll
      for (int j = 0; j < 5; ++j) { const int i = F.tid + NTHR * j; if (i < 9 * 256) *(LAS f32x4*)(cw + (i / 256) * 1536 + 512 + (i % 256) * 4) = vh[j]; } }
    __syncthreads();
    const bf16* P = (const bf16*)(F.ws + WS_P);
    const int gt = F.vcu * NTHR + F.tid, NG = F.G * NTHR;
    constexpr int NLATQ = BATCH * 128 * 16, NQ = NLATQ + BATCH * 64;
    for (int it = gt; it < NQ * 192; it += NG) {
        const int qd = it / 192, cg = it % 192, c = cg * 8, pc = c < 512 ? PC_QK + c : PC_QI + (c - 512);
        int base, row, x0, nrow, ncol;
        if (qd < NLATQ) { const int b = qd >> 11, y = (qd >> 4) & 127, xq = qd & 15; base = b << 13; row = y; x0 = xq * 4; nrow = 128; ncol = 64; }
        else { const int q = qd - NLATQ, b = q >> 6; base = NLAT + (b << 8); row = 0; x0 = (q & 63) * 4; nrow = 1; ncol = 256; }
        const int r0 = base + row * ncol + x0;
        u32x4 tap[3][6];
#pragma unroll
        for (int dy = 0; dy < 3; ++dy)
#pragma unroll
            for (int j = 0; j < 6; ++j) { const int rr = row + dy - 1, cc = x0 + j - 1; const bool v = rr >= 0 && rr < nrow && cc >= 0 && cc < ncol;
                const u32x4 t = *(const u32x4*)(P + (size_t)(v ? base + rr * ncol + cc : r0) * PW + pc);
                tap[dy][j] = v ? t : (u32x4){0u, 0u, 0u, 0u}; }
        f32x2_t a2[4][4];
#pragma unroll
        for (int o = 0; o < 4; ++o)
#pragma unroll
            for (int i = 0; i < 4; ++i) a2[o][i] = (f32x2_t){0.f, 0.f};
#pragma unroll
        for (int dy = 0; dy < 3; ++dy)
#pragma unroll
            for (int dx = 0; dx < 3; ++dx) { const LAS float* w = cw + (dy * 3 + dx) * 1536 + c; const f32x4 w0 = *(const LAS f32x4*)w, w1 = *(const LAS f32x4*)(w + 4);
                const f32x2_t wa = {w0.x, w0.y}, wb = {w0.z, w0.w}, wc = {w1.x, w1.y}, wd = {w1.z, w1.w};
#pragma unroll
                for (int o = 0; o < 4; ++o) { const u32x4 pv = tap[dy][o + dx];
                    a2[o][0] += (f32x2_t){bflo(pv.x), bfhi(pv.x)} * wa; a2[o][1] += (f32x2_t){bflo(pv.y), bfhi(pv.y)} * wb;
                    a2[o][2] += (f32x2_t){bflo(pv.z), bfhi(pv.z)} * wc; a2[o][3] += (f32x2_t){bflo(pv.w), bfhi(pv.w)} * wd; } }
        float a[4][8];
#pragma unroll
        for (int o = 0; o < 4; ++o)
#pragma unroll
            for (int i = 0; i < 4; ++i) { a[o][2 * i] = a2[o][i].x; a[o][2 * i + 1] = a2[o][i].y; }
        const float sc = c < 256 ? 0.125f : 1.f;
#pragma unroll
        for (int o = 0; o < 4; ++o) {
#pragma unroll
            for (int i = 0; i < 8; ++i) a[o][i] = siluf_(a[o][i]) * sc;
            const u32x4 ov = (u32x4){pk2(a[o][0], a[o][1]), pk2(a[o][2], a[o][3]), pk2(a[o][4], a[o][5]), pk2(a[o][6], a[o][7])};
            if (c < 512) *(u32x4*)(F.ws + WS_CQK + ((size_t)(r0 + o) * 512 + c) * 2) = ov; else *(u32x4*)(F.ws + WS_CQI + ((size_t)(r0 + o) * 1024 + (c - 512)) * 2) = ov; }
    }
}

struct HnIn { f32x4 h[4]; u32x2 g[4]; };
__device__ __forceinline__ void hn_load(Frame& F, int r, HnIn& R) {
    const float* HF = (const float*)(F.ws + WS_HF); const bf16* P = (const bf16*)(F.ws + WS_P);
#pragma unroll
    for (int j = 0; j < 4; ++j) { const int c = 256 * j + 4 * F.lane; R.h[j] = *(const f32x4*)(HF + (size_t)r * D + c); R.g[j] = *(const u32x2*)(P + (size_t)r * PW + (c < 512 ? PC_O + c : PC_GO + (c - 512))); }
}
__device__ __forceinline__ void ph_hnorm(Frame& F, CArgs& A, int l, int nrows_lat_only) {
    const int nrows = nrows_lat_only ? NLAT : NTOK, stride = F.G * NWAVES;
    int r = F.vcu * NWAVES + F.wave; HnIn cur; if (r < nrows) hn_load(F, r, cur);
    for (; r < nrows; r += stride) {
        HnIn nxt; if (r + stride < nrows) hn_load(F, r + stride, nxt); else nxt = cur;
        u32x2* yo = (u32x2*)(F.ws + WS_Y + (size_t)r * D * 2) + F.lane;
#pragma unroll
        for (int j = 0; j < 4; ++j) {
            const int c = 256 * j + 4 * F.lane;
            f32x4 h = cur.h[j];
            float ss = (h.x * h.x + h.y * h.y) + (h.z * h.z + h.w * h.w);
#pragma unroll
            for (int o = 1; o < 32; o <<= 1) ss += __shfl_xor(ss, o);
            const float rstd = rsqrtf(ss * (1.f / 128.f) + EPS);
            const f32x4 g = c < 512 ? *(const f32x4*)(A.in[I_MLNG] + l * 512 + c) : *(const f32x4*)(A.in[I_HGNG] + l * 512 + (c - 512));
            const u32x2 gw = cur.g[j];
            float ga[4] = {bflo(gw.x), bfhi(gw.x), bflo(gw.y), bfhi(gw.y)};
#pragma unroll
            for (int i = 0; i < 4; ++i) ga[i] = c < 512 ? sigmoidf_(ga[i]) : siluf_(ga[i]);
            h = h * rstd * g;
            yo[64 * j] = (u32x2){pk2(h.x * ga[0], h.y * ga[1]), pk2(h.z * ga[2], h.w * ga[3])};
        }
        cur = nxt;
    }
}

namespace pg8 {
typedef short bf16x8 __attribute__((ext_vector_type(8)));
constexpr int BM = 256, BK = 64, HALF = 128, HTB = HALF * BK * 2, STAGE_BYTES = 8 * HTB, NXCD = 8, WGM = 8;
__device__ __forceinline__ int lds_byte(int r, int c) { const int st = (r >> 4) * 2 + (c >> 5), rr = r & 15, cc = c & 31, ob = rr * 64 + cc * 2; return st * 1024 + (ob ^ (((ob >> 9) & 1) << 5)); }
__device__ __forceinline__ void stage_rc(int b, int& R, int& C) { const int st = b / 1024, sb = b % 1024, swz = sb ^ (((sb >> 9) & 1) << 5); R = (st >> 1) * 16 + swz / 64; C = (st & 1) * 32 + (swz % 64) / 2; }
__device__ __forceinline__ int perm32(int rho) { const int n = rho >> 4, i = rho & 15; return 8 * (i >> 2) + 4 * n + (i & 3); }
struct Unit { int pm, pn, e; };
struct Gemm { const bf16* A; const bf16* Bt; int K; const int* gather; const int* tile_e; size_t bexp;   };
struct StaticOrder {
    int nM, nN, nwg, G, c;
    __device__ void init(int nM_, int nN_, int G_, int c_) { nM = nM_; nN = nN_; nwg = nM * nN; G = G_; c = c_; }
    __device__ bool next(int i, Unit& u) const {
        const long L = (long)i * G + c; if (L >= nwg) return false;
        int wgid = (int)L; { const int q = nwg / NXCD, r = nwg % NXCD, xcd = wgid % NXCD, off = wgid / NXCD; wgid = (xcd < r ? xcd * (q + 1) : r * (q + 1) + (xcd - r) * q) + off; }
        const int nig = WGM * nN, gid = wgid / nig, fm = gid * WGM, gsz = (nM - fm) < WGM ? (nM - fm) : WGM;
        u.pm = fm + ((wgid % nig) % gsz); u.pn = (wgid % nig) / gsz; u.e = 0; return true;
    }
};
__device__ __forceinline__ unsigned cvt_pk_bf16(float lo, float hi) { unsigned r; asm volatile("v_cvt_pk_bf16_f32 %0, %1, %2" : "=v"(r) : "v"(lo), "v"(hi)); return r; }

struct EpiBf16 {
    static constexpr bool PERM = true;
    bf16* O; int ldc;
    __device__ __forceinline__ void operator()(const f32x4 (&acc)[2][2][4][2], const Unit& u, int wr, int wc, int fr, int fq) const {
        const int row0 = u.pm * BM + wr * 64 + fr, col0 = u.pn * BM + wc * 32 + 8 * fq;
#pragma unroll
        for (int ai = 0; ai < 2; ++ai)
#pragma unroll
            for (int m = 0; m < 4; ++m) { bf16* rowp = O + (size_t)(row0 + ai * HALF + m * 16) * ldc + col0;
#pragma unroll
                for (int bj = 0; bj < 2; ++bj) { const f32x4 v0 = acc[ai][bj][m][0], v1 = acc[ai][bj][m][1];
                    u32x4 w; w.x = cvt_pk_bf16(v0[0], v0[1]); w.y = cvt_pk_bf16(v0[2], v0[3]); w.z = cvt_pk_bf16(v1[0], v1[1]); w.w = cvt_pk_bf16(v1[2], v1[3]);
                    *(u32x4*)(rowp + bj * HALF) = w; } }
    }
};
struct EpiResid {
    static constexpr bool PERM = false;
    float* X; const float* MODg; const float* Slat; const float* Sctx;
    __device__ __forceinline__ void operator()(const f32x4 (&acc)[2][2][4][2], const Unit& u, int wr, int wc, int fr, int fq) const {
        const int row0 = u.pm * BM + wr * 64 + fr, col0 = u.pn * BM + wc * 32 + 4 * fq;
        const float* gp = MODg + mrow_of(u.pm * BM) * 6144 + col0;
        f32x4 gv[2][2];
#pragma unroll
        for (int bj = 0; bj < 2; ++bj)
#pragma unroll
            for (int n = 0; n < 2; ++n) gv[bj][n] = *(const f32x4*)(gp + bj * HALF + n * 16);
#pragma unroll
        for (int ai = 0; ai < 2; ++ai) {
            f32x4 xv[4][2][2];
#pragma unroll
            for (int m = 0; m < 4; ++m) { const int rr = row0 + ai * HALF + m * 16; const float* rowp = (rr < NLAT ? Slat + (size_t)rr * D : Sctx + (size_t)(rr - NLAT) * D) + col0;
#pragma unroll
                for (int bj = 0; bj < 2; ++bj)
#pragma unroll
                    for (int n = 0; n < 2; ++n) xv[m][bj][n] = *(const f32x4*)(rowp + bj * HALF + n * 16); }
#pragma unroll
            for (int m = 0; m < 4; ++m) { float* rowp = X + (size_t)(row0 + ai * HALF + m * 16) * D + col0;
#pragma unroll
                for (int bj = 0; bj < 2; ++bj)
#pragma unroll
                    for (int n = 0; n < 2; ++n) *(f32x4*)(rowp + bj * HALF + n * 16) = xv[m][bj][n] + gv[bj][n] * acc[ai][bj][m][n]; } }
    }
};
struct EpiSwiglu {
    static constexpr bool PERM = true;
    bf16* ACT; const float* bgu; const int* tile_e;
    __device__ __forceinline__ void operator()(const f32x4 (&acc)[2][2][4][2], const Unit& u, int wr, int wc, int fr, int fq) const {
        const int e = u.e;
        const int row0 = u.pm * BM + wr * 64 + fr, col0 = u.pn * HALF + wc * 32 + 8 * fq;
        const float* bp = bgu + (size_t)e * 2048 + col0;
        const f32x4 bg0 = *(const f32x4*)bp, bg1 = *(const f32x4*)(bp + 4), bl0 = *(const f32x4*)(bp + 1024), bl1 = *(const f32x4*)(bp + 1028);
#pragma unroll
        for (int ai = 0; ai < 2; ++ai)
#pragma unroll
            for (int m = 0; m < 4; ++m) {
                f32x4 g0 = acc[ai][0][m][0] + bg0, g1 = acc[ai][0][m][1] + bg1, l0 = acc[ai][1][m][0] + bl0, l1 = acc[ai][1][m][1] + bl1; float o[8];
#pragma unroll
                for (int i = 0; i < 4; ++i) { g0[i] = fminf(g0[i], 7.f); g1[i] = fminf(g1[i], 7.f); l0[i] = fminf(fmaxf(l0[i], -7.f), 7.f); l1[i] = fminf(fmaxf(l1[i], -7.f), 7.f); }
                const f32x4 t0 = g0 * (-1.702f * 1.44269504f), t1 = g1 * (-1.702f * 1.44269504f);
                f32x4 e0, e1;
#pragma unroll
                for (int i = 0; i < 4; ++i) { e0[i] = __builtin_amdgcn_exp2f(t0[i]); e1[i] = __builtin_amdgcn_exp2f(t1[i]); }
                e0 = e0 + 1.f; e1 = e1 + 1.f;
#pragma unroll
                for (int i = 0; i < 4; ++i) { e0[i] = __builtin_amdgcn_rcpf(e0[i]); e1[i] = __builtin_amdgcn_rcpf(e1[i]); }
                const f32x4 r0 = (g0 * e0) * (l0 + 1.f), r1 = (g1 * e1) * (l1 + 1.f);
#pragma unroll
                for (int i = 0; i < 4; ++i) { o[i] = r0[i]; o[4 + i] = r1[i]; }
                u32x4 w; w.x = cvt_pk_bf16(o[0], o[1]); w.y = cvt_pk_bf16(o[2], o[3]); w.z = cvt_pk_bf16(o[4], o[5]); w.w = cvt_pk_bf16(o[6], o[7]);
                *(u32x4*)(ACT + (size_t)(row0 + ai * HALF + m * 16) * DEXP + col0) = w; }
    }
};
struct EpiDown {
    static constexpr bool PERM = true;
    bf16* YS; const float* bdn; const float* sgate; const int* tile_e;
    __device__ __forceinline__ void operator()(const f32x4 (&acc)[2][2][4][2], const Unit& u, int wr, int wc, int fr, int fq) const {
        const int e = u.e;
        const int row0 = u.pm * BM + wr * 64 + fr, col0 = u.pn * BM + wc * 32 + 8 * fq;
        f32x4 bv[2][2];
#pragma unroll
        for (int bj = 0; bj < 2; ++bj)
#pragma unroll
            for (int n = 0; n < 2; ++n) bv[bj][n] = *(const f32x4*)(bdn + (size_t)e * D + col0 + bj * HALF + 4 * n);
#pragma unroll
        for (int ai = 0; ai < 2; ++ai)
#pragma unroll
            for (int m = 0; m < 4; ++m) { const int row = row0 + ai * HALF + m * 16; const float sg = sgate[row]; bf16* rowp = YS + (size_t)row * D + col0;
#pragma unroll
                for (int bj = 0; bj < 2; ++bj) { const f32x4 v0 = (acc[ai][bj][m][0] + bv[bj][0]) * sg, v1 = (acc[ai][bj][m][1] + bv[bj][1]) * sg;
                    u32x4 w; w.x = cvt_pk_bf16(v0[0], v0[1]); w.y = cvt_pk_bf16(v0[2], v0[3]); w.z = cvt_pk_bf16(v1[0], v1[1]); w.w = cvt_pk_bf16(v1[2], v1[3]);
                    *(u32x4*)(rowp + bj * HALF) = w; } }
    }
};

template <class Epi, class Sched, bool ALIGN_EPI>
__device__ __forceinline__ void gemm_phase(LAS unsigned char* lds, const Gemm g, const Sched& S, const Epi& E, const int tid) {
    const int wid = __builtin_amdgcn_readfirstlane(tid >> 6), lane = tid & 63, wr = wid >> 2, wc = wid & 3, fr = lane & 15, fq = lane >> 4;
    const int K = g.K, nt = K / BK;
    int RA[2]; unsigned cbA[2], voffB[2];
#pragma unroll
    for (int i = 0; i < 2; ++i) { int R, C; stage_rc(tid * 16 + i * 8192, R, C); const int Rb = Epi::PERM ? ((R & ~31) + perm32(R & 31)) : R;
        RA[i] = R; cbA[i] = (unsigned)C * 2u; voffB[i] = (unsigned)(Rb * K + C) * 2u; }
    const size_t kstep = (size_t)(BK * 2);
    const size_t hstep = (size_t)HALF * K * 2;
    const size_t tstep = 2 * hstep;
    const unsigned ldsw = (unsigned)wid * 1024u;
    const int aoff = lds_byte(wr * 64 + fr, fq * 8), boff = lds_byte(wc * 32 + fr, fq * 8);
#define PG8_SA(b, h) (((b) * 2 + (h)) * HTB)
#define PG8_SB(b, h) ((4 + (b) * 2 + (h)) * HTB)
#define PG8_STAGE(bufoff, gbase, voff) do { _Pragma("unroll") for (int _i = 0; _i < 2; ++_i) \
        __builtin_amdgcn_global_load_lds((const unsigned*)((const char*)(gbase) + (voff)[_i]), (LAS unsigned*)(lds + (bufoff) + ldsw + _i * 8192), 16, 0, 0); } while (0)
#define PG8_LDA(dst, b, h) do { _Pragma("unroll") for (int m = 0; m < 4; ++m) _Pragma("unroll") for (int k = 0; k < 2; ++k) dst[m][k] = *(const LAS bf16x8*)(lds + PG8_SA(b, h) + aoff + m * 2048 + k * 1024); } while (0)
#define PG8_LDB(dst, b, h) do { _Pragma("unroll") for (int n = 0; n < 2; ++n) _Pragma("unroll") for (int k = 0; k < 2; ++k) dst[n][k] = *(const LAS bf16x8*)(lds + PG8_SB(b, h) + boff + n * 2048 + k * 1024); } while (0)
#define PG8_MMA(ai, bj, At, Bt) do { __builtin_amdgcn_s_setprio(1); _Pragma("unroll") for (int m = 0; m < 4; ++m) _Pragma("unroll") for (int n = 0; n < 2; ++n) _Pragma("unroll") for (int k = 0; k < 2; ++k) \
        acc[ai][bj][m][n] = __builtin_amdgcn_mfma_f32_16x16x32_bf16(Bt[n][k], At[m][k], acc[ai][bj][m][n], 0, 0, 0); __builtin_amdgcn_s_setprio(0); } while (0)
#define PG8_WAIT_V(n) asm volatile("s_waitcnt vmcnt(" #n ")" ::: "memory")
#define PG8_WAIT_L(n) asm volatile("s_waitcnt lgkmcnt(" #n ")" ::: "memory")
#define PG8_BAR __builtin_amdgcn_s_barrier()
#define PG8_SCHED __builtin_amdgcn_sched_barrier(0)
#define PG8_AOFF(va, u) do { _Pragma("unroll") for (int _h = 0; _h < 2; ++_h) _Pragma("unroll") for (int _i = 0; _i < 2; ++_i) { const int _r = (u).pm * BM + _h * HALF + RA[_i]; \
        const int _row = g.gather ? g.gather[_r] : _r; va[_h][_i] = (unsigned)_row * (unsigned)(K * 2) + cbA[_i]; } } while (0)
#define PG8_BBASE(u) ((u).e = g.tile_e ? g.tile_e[8 + (u).pm] : 0, (const char*)g.Bt + (size_t)(u).e * g.bexp * 2 + (size_t)(u).pn * tstep)
    Unit cur, nxt; int ui = 0;
    if (!S.next(0, cur)) return;
    f32x4 acc[2][2][4][2];
#pragma unroll
    for (int a = 0; a < 2; ++a)
#pragma unroll
        for (int b = 0; b < 2; ++b)
#pragma unroll
            for (int m = 0; m < 4; ++m)
#pragma unroll
                for (int n = 0; n < 2; ++n) acc[a][b][m][n] = (f32x4){0.f, 0.f, 0.f, 0.f};
    bf16x8 At[4][2], B0[2][2], B1[2][2];
    const char* Ab = (const char*)g.A;
    unsigned cva[2][2], nva[2][2];
    PG8_AOFF(cva, cur);
    const char* cB = PG8_BBASE(cur);
    PG8_STAGE(PG8_SB(0, 0), cB, voffB); PG8_STAGE(PG8_SB(0, 1), cB + hstep, voffB); PG8_STAGE(PG8_SA(0, 0), Ab, cva[0]); PG8_STAGE(PG8_SA(0, 1), Ab, cva[1]);
    if (wr == 1) PG8_BAR;
    PG8_WAIT_V(2); PG8_BAR;
    PG8_STAGE(PG8_SB(1, 0), cB + kstep, voffB); PG8_STAGE(PG8_SA(1, 0), Ab + kstep, cva[0]); PG8_STAGE(PG8_SB(1, 1), cB + hstep + kstep, voffB);
    PG8_WAIT_V(6); PG8_BAR;
    for (;;) {
        const bool has_next = S.next(ui + 1, nxt);
        const char* nB = cB;
        if (has_next) { PG8_AOFF(nva, nxt); nB = PG8_BBASE(nxt); }
        else {
#pragma unroll
            for (int h = 0; h < 2; ++h)
#pragma unroll
                for (int i = 0; i < 2; ++i) nva[h][i] = cva[h][i]; }
        for (int t = 0; t < nt; t += 2) {
            const bool last = (t == nt - 2);
            const char* a1 = Ab + (size_t)(t + 1) * kstep;
            const char* a2 = last ? Ab : Ab + (size_t)(t + 2) * kstep; const char* b2 = last ? nB : cB + (size_t)(t + 2) * kstep;
            const char* a3 = a2 + kstep; const char* b3 = b2 + kstep;
            unsigned s2[2][2];
#pragma unroll
            for (int h = 0; h < 2; ++h)
#pragma unroll
                for (int i = 0; i < 2; ++i) s2[h][i] = last ? nva[h][i] : cva[h][i];
            PG8_LDB(B0, 0, 0); PG8_LDB(B1, 0, 1); PG8_SCHED; PG8_LDA(At, 0, 0); PG8_STAGE(PG8_SA(1, 1), a1, cva[1]);
            PG8_WAIT_V(8); PG8_WAIT_L(0); PG8_BAR; PG8_MMA(0, 0, At, B0); PG8_MMA(0, 1, At, B1); PG8_BAR; PG8_SCHED;
            PG8_LDA(At, 0, 1); PG8_STAGE(PG8_SB(0, 0), b2, voffB); PG8_STAGE(PG8_SB(0, 1), b2 + hstep, voffB); PG8_STAGE(PG8_SA(0, 0), a2, s2[0]);
            PG8_WAIT_V(8); PG8_WAIT_L(0); PG8_BAR; PG8_MMA(1, 0, At, B0); PG8_MMA(1, 1, At, B1); PG8_BAR; PG8_SCHED;
            PG8_LDB(B0, 1, 0); PG8_LDB(B1, 1, 1); PG8_SCHED; PG8_LDA(At, 1, 0); PG8_STAGE(PG8_SA(0, 1), a2, s2[1]);
            PG8_WAIT_V(8); PG8_WAIT_L(0); PG8_BAR; PG8_MMA(0, 0, At, B0); PG8_MMA(0, 1, At, B1); PG8_BAR; PG8_SCHED;
            PG8_LDA(At, 1, 1); PG8_STAGE(PG8_SB(1, 0), b3, voffB); PG8_STAGE(PG8_SB(1, 1), b3 + hstep, voffB); PG8_STAGE(PG8_SA(1, 0), a3, s2[0]);
            PG8_WAIT_V(8); PG8_WAIT_L(0); PG8_BAR; PG8_MMA(1, 0, At, B0); PG8_MMA(1, 1, At, B1); PG8_BAR; PG8_SCHED;
        }
        if constexpr (ALIGN_EPI) { if (wr == 0) PG8_BAR; }
        E(acc, cur, wr, wc, fr, fq);
        if (!has_next) break;
#pragma unroll
        for (int a = 0; a < 2; ++a)
#pragma unroll
            for (int b = 0; b < 2; ++b)
#pragma unroll
                for (int m = 0; m < 4; ++m)
#pragma unroll
                    for (int n = 0; n < 2; ++n) acc[a][b][m][n] = (f32x4){0.f, 0.f, 0.f, 0.f};
        cur = nxt; cB = nB; ++ui;
#pragma unroll
        for (int h = 0; h < 2; ++h)
#pragma unroll
            for (int i = 0; i < 2; ++i) cva[h][i] = nva[h][i];
        if constexpr (ALIGN_EPI) { if (wr == 1) PG8_BAR; }
    }
    PG8_WAIT_V(0);
    if constexpr (!ALIGN_EPI) { if (wr == 0) PG8_BAR; }
    PG8_BAR;
#undef PG8_SA
#undef PG8_SB
#undef PG8_STAGE
#undef PG8_LDA
#undef PG8_LDB
#undef PG8_MMA
#undef PG8_WAIT_V
#undef PG8_WAIT_L
#undef PG8_BAR
#undef PG8_SCHED
#undef PG8_AOFF
#undef PG8_BBASE
}
}


typedef short bf16x8_t __attribute__((ext_vector_type(8)));
typedef float f32x16 __attribute__((ext_vector_type(16)));
template <int K>
__device__ __forceinline__ void mm32(f32x16& acc, const LAS unsigned char* A, int sa, const LAS unsigned char* B, int sb, int lane) {
    const LAS unsigned char* ap = A + (lane & 31) * sa + (lane >> 5) * 16;
    const LAS unsigned char* bp = B + (lane & 31) * sb + (lane >> 5) * 16;
#pragma unroll
    for (int k0 = 0; k0 < K / 16; k0 += 4) {
        bf16x8_t a[4], b[4];
#pragma unroll
        for (int k = 0; k < 4; ++k) { a[k] = *(const LAS bf16x8_t*)(ap + (k0 + k) * 32); b[k] = *(const LAS bf16x8_t*)(bp + (k0 + k) * 32); }
#pragma unroll
        for (int k = 0; k < 4; ++k) acc = __builtin_amdgcn_mfma_f32_32x32x16_bf16(a[k], b[k], acc, 0, 0, 0);
    }
}
__device__ __forceinline__ int rowmap(int reg, int hi) { return (reg & 3) + 8 * (reg >> 2) + 4 * hi; }
__device__ __forceinline__ int chunk_row0(int b, int tc) { return tc < 4 ? NLAT + b * CTX + tc * 64 : b * SEQ + (tc - 4) * 64; }
constexpr int ST64 = 144, ST128 = 272;


__device__ __forceinline__ void touch(unsigned& x) { asm volatile("" : "+v"(x)); }
__device__ __forceinline__ void touch(float& x) { asm volatile("" : "+v"(x)); }
__device__ __forceinline__ void touch(u32x4& x) { asm volatile("" : "+v"(x)); }
struct VtRaw { unsigned w[8]; };
__device__ __forceinline__ void vt_load(VtRaw& R, const bf16* src, int pitch, int row0, int col0, int tid) {
    const int cp = tid & 63, tg = tid >> 6;
#pragma unroll
    for (int i = 0; i < 8; ++i) R.w[i] = *(const unsigned*)(src + (size_t)(row0 + tg * 8 + i) * pitch + col0 + 2 * cp);
}
__device__ __forceinline__ void vt_store(LAS unsigned char* VT, const VtRaw& R, int tid) {
    const int cp = tid & 63, tg = tid >> 6; unsigned lo[4], hi[4];
#pragma unroll
    for (int i = 0; i < 4; ++i) { const unsigned w0 = R.w[2 * i], w1 = R.w[2 * i + 1]; lo[i] = (w0 & 0xffffu) | (w1 << 16); hi[i] = (w0 >> 16) | (w1 & 0xffff0000u); }
    *(LAS u32x4*)(VT + (2 * cp) * ST64 + tg * 16) = (u32x4){lo[0], lo[1], lo[2], lo[3]};
    *(LAS u32x4*)(VT + (2 * cp + 1) * ST64 + tg * 16) = (u32x4){hi[0], hi[1], hi[2], hi[3]};
}
struct TaskId { int b, h, tc, row0, sidf; };
__device__ __forceinline__ TaskId task_id(int task) { TaskId t; t.b = task / (4 * NTC); t.h = (task / NTC) & 3; t.tc = task % NTC; t.row0 = chunk_row0(t.b, t.tc); t.sidf = (t.b * 4 + t.h) * 2; return t; }

struct MlARaw { VtRaw v; unsigned kw[4]; float g[4]; };
__device__ __forceinline__ void touch(MlARaw& R) {
#pragma unroll
    for (int i = 0; i < 8; ++i) touch(R.v.w[i]);
#pragma unroll
    for (int i = 0; i < 4; ++i) { touch(R.kw[i]); touch(R.g[i]); } }
__device__ __forceinline__ void ml_passA_load(Frame& F, int task, MlARaw& R) {
    const TaskId T = task_id(task);
    vt_load(R.v, (const bf16*)(F.ws + WS_P), PW, T.row0, PC_V + T.h * 128, F.tid);
    { const int cp = F.tid & 31, tg = F.tid >> 5; const bf16* CQK = (const bf16*)(F.ws + WS_CQK);
#pragma unroll
      for (int i = 0; i < 4; ++i) R.kw[i] = *(const unsigned*)(CQK + (size_t)(T.row0 + tg * 4 + i) * 512 + 256 + T.h * 64 + 2 * cp); }
    if (F.wave == 0) { const float* gp = (const float*)(F.ws + WS_GATES) + (size_t)(T.row0 + F.lane) * 16; R.g[0] = gp[T.h]; R.g[1] = gp[4 + T.h]; R.g[2] = gp[8 + T.h]; R.g[3] = gp[12 + T.h]; }
}
__device__ __forceinline__ void ml_passA_run(Frame& F, int task, const MlARaw& R) {
    const TaskId T = task_id(task); const int tc = T.tc, sidf = T.sidf;
    LAS unsigned char* VT = F.lds; LAS unsigned char* KT = F.lds + 18432;
    LAS float* wts = (LAS float*)(F.lds + 36864);
    float* MLS = (float*)(F.ws + WS_MLS);
    LDS_BARRIER();
    if (F.wave == 0) { const int s = F.lane;
        const float igf = R.g[0], igb = R.g[1], lff = R.g[2], lfb = R.g[3];
        const float pf = wave_incl_sum(lff, s), gf = __builtin_bit_cast(float, __builtin_amdgcn_readlane(__builtin_bit_cast(int, pf), 63)), ef = (gf - pf) + igf, mf = wave_max(ef);
        const float pb = wave_incl_sum(lfb, s), gb = __builtin_bit_cast(float, __builtin_amdgcn_readlane(__builtin_bit_cast(int, pb), 63)), eb = (pb - lfb) + igb, mb = wave_max(eb);
        wts[s] = __expf(ef - mf); wts[64 + s] = __expf(eb - mb);
        if (s == 0) { float* o = MLS + (size_t)(sidf * NTC + tc) * 4; o[0] = gf; o[1] = mf; o = MLS + (size_t)((sidf + 1) * NTC + tc) * 4; o[0] = gb; o[1] = mb; } }
    vt_store(VT, R.v, F.tid);
    LDS_BARRIER();
    { const int cp = F.tid & 31, tg = F.tid >> 5;
#pragma unroll
      for (int dir = 0; dir < 2; ++dir) { float lo[4], hi[4];
#pragma unroll
          for (int i = 0; i < 4; ++i) { const float w = wts[dir * 64 + tg * 4 + i]; lo[i] = bflo(R.kw[i]) * w; hi[i] = bfhi(R.kw[i]) * w; }
          *(LAS u32x2*)(KT + dir * 9216 + (2 * cp) * ST64 + tg * 8) = (u32x2){pk2(lo[0], lo[1]), pk2(lo[2], lo[3])};
          *(LAS u32x2*)(KT + dir * 9216 + (2 * cp + 1) * ST64 + tg * 8) = (u32x2){pk2(hi[0], hi[1]), pk2(hi[2], hi[3])}; } }
    LDS_BARRIER();
    { const int dir = F.wave >> 2, mt = F.wave & 3; bf16* C = (bf16*)(F.ws + WS_MLC) + (size_t)((sidf + dir) * NTC + tc) * 8192;
#pragma unroll
      for (int nt = 0; nt < 2; ++nt) { f32x16 acc;
#pragma unroll
          for (int i = 0; i < 16; ++i) acc[i] = 0.f;
          mm32<64>(acc, VT + 32 * mt * ST64, ST64, KT + dir * 9216 + 32 * nt * ST64, ST64, F.lane);
#pragma unroll
          for (int r = 0; r < 16; ++r) C[(32 * mt + rowmap(r, F.lane >> 5)) * 64 + 32 * nt + (F.lane & 31)] = (bf16)f2bf(acc[r]); } }
    if (F.tid < 128) { const int dir = F.tid >> 6, d = F.tid & 63; const LAS unsigned char* rp = KT + dir * 9216 + d * ST64; float sum = 0.f;
#pragma unroll
        for (int i = 0; i < 8; ++i) { const u32x4 w = *(const LAS u32x4*)(rp + i * 16); sum += (bflo(w.x) + bfhi(w.x)) + (bflo(w.y) + bfhi(w.y)) + (bflo(w.z) + bfhi(w.z)) + (bflo(w.w) + bfhi(w.w)); }
        ((float*)(F.ws + WS_MLN))[(size_t)((sidf + dir) * NTC + tc) * 64 + d] = sum; }
}
__device__ __forceinline__ int tc_seq(int dir, int j) { return dir == 0 ? j : (j < 4 ? 3 - j : 135 - j); }
__device__ __forceinline__ void scan_passB(Frame& F) {
    const float* GG = (const float*)(F.ws + WS_HGG); float* MLS = (float*)(F.ws + WS_MLS);
    const int t = F.tid;
    if (t < 128) {
        for (int item = F.vcu * 128 + t; item < 16 * 2048; item += F.G * 128) {
            const int scan = item >> 11, e = (item & 2047) * 8, dir = scan & 1, d = e & 127;
            const u32x4* base = (const u32x4*)((const bf16*)(F.ws + WS_HGS) + (size_t)scan * NTC * 16384 + e); u32x4* ob = (u32x4*)((bf16*)(F.ws + WS_HGSB) + (size_t)scan * NTC * 16384 + e);
            const f32x4* gb = (const f32x4*)(GG + (size_t)scan * NTC * 128 + d);
            float st[8];
#pragma unroll
            for (int k = 0; k < 8; ++k) st[k] = 0.f;
            for (int j0 = 0; j0 < NTC; j0 += 11) {
                u32x4 dv[11]; f32x4 g0[11], g1[11];
#pragma unroll
                for (int i = 0; i < 11; ++i) { const int tc = tc_seq(dir, j0 + i); dv[i] = base[(size_t)tc * 2048]; g0[i] = gb[tc * 32]; g1[i] = gb[tc * 32 + 1]; }
#pragma unroll
                for (int i = 0; i < 11; ++i) { const int tc = tc_seq(dir, j0 + i);
                    ob[(size_t)tc * 2048] = (u32x4){pk2(st[0], st[1]), pk2(st[2], st[3]), pk2(st[4], st[5]), pk2(st[6], st[7])};
                    const f32x4 ta = g0[i] * 1.44269504f, tb = g1[i] * 1.44269504f;
                    const f32x2_t e0 = {__builtin_amdgcn_exp2f(ta.x), __builtin_amdgcn_exp2f(ta.y)}, e1 = {__builtin_amdgcn_exp2f(ta.z), __builtin_amdgcn_exp2f(ta.w)}, e2 = {__builtin_amdgcn_exp2f(tb.x), __builtin_amdgcn_exp2f(tb.y)}, e3 = {__builtin_amdgcn_exp2f(tb.z), __builtin_amdgcn_exp2f(tb.w)};
                    const f32x2_t s0 = e0 * (f32x2_t){st[0], st[1]} + (f32x2_t){bflo(dv[i].x), bfhi(dv[i].x)}, s1 = e1 * (f32x2_t){st[2], st[3]} + (f32x2_t){bflo(dv[i].y), bfhi(dv[i].y)};
                    const f32x2_t s2 = e2 * (f32x2_t){st[4], st[5]} + (f32x2_t){bflo(dv[i].z), bfhi(dv[i].z)}, s3 = e3 * (f32x2_t){st[6], st[7]} + (f32x2_t){bflo(dv[i].w), bfhi(dv[i].w)};
                    st[0] = s0.x; st[1] = s0.y; st[2] = s1.x; st[3] = s1.y; st[4] = s2.x; st[5] = s2.y; st[6] = s3.x; st[7] = s3.y; }
            }
        }
    } else if (t < 192) {
        for (int item = F.vcu * 64 + (t - 128); item < 16 * 1024; item += F.G * 64) {
            const int scan = item >> 10, e = (item & 1023) * 8, dir = scan & 1;
            const u32x4* cb = (const u32x4*)((const bf16*)(F.ws + WS_MLC) + (size_t)scan * NTC * 8192 + e); u32x4* ob = (u32x4*)((bf16*)(F.ws + WS_MLCB) + (size_t)scan * NTC * 8192 + e);
            float m = 0.f, st[8];
#pragma unroll
            for (int k = 0; k < 8; ++k) st[k] = 0.f;
            for (int j0 = 0; j0 < NTC; j0 += 12) {
                u32x4 dv[12]; float gg[12], ml[12];
#pragma unroll
                for (int i = 0; i < 12; ++i) { const int tc = tc_seq(dir, j0 + i); dv[i] = cb[(size_t)tc * 1024]; const float* sp = MLS + (size_t)(scan * NTC + tc) * 4; gg[i] = sp[0]; ml[i] = sp[1]; }
#pragma unroll
                for (int i = 0; i < 12; ++i) { const int tc = tc_seq(dir, j0 + i);
                    const float mn = fmaxf(gg[i] + m, ml[i]), a = __expf(gg[i] + m - mn), w = __expf(ml[i] - mn);
                    if ((item & 1023) == 0) MLS[(size_t)(scan * NTC + tc) * 4 + 2] = m;
                    ob[(size_t)tc * 1024] = (u32x4){pk2(st[0], st[1]), pk2(st[2], st[3]), pk2(st[4], st[5]), pk2(st[6], st[7])};
                    const f32x2_t s0 = (f32x2_t){st[0], st[1]} * a + (f32x2_t){bflo(dv[i].x), bfhi(dv[i].x)} * w, s1 = (f32x2_t){st[2], st[3]} * a + (f32x2_t){bflo(dv[i].y), bfhi(dv[i].y)} * w;
                    const f32x2_t s2 = (f32x2_t){st[4], st[5]} * a + (f32x2_t){bflo(dv[i].z), bfhi(dv[i].z)} * w, s3 = (f32x2_t){st[6], st[7]} * a + (f32x2_t){bflo(dv[i].w), bfhi(dv[i].w)} * w;
                    st[0] = s0.x; st[1] = s0.y; st[2] = s1.x; st[3] = s1.y; st[4] = s2.x; st[5] = s2.y; st[6] = s3.x; st[7] = s3.y; m = mn; }
            }
        }
    } else if (t < 196) {
        for (int item = F.vcu * 4 + (t - 192); item < 16 * 64; item += F.G * 4) {
            const int scan = item >> 6, e = item & 63, dir = scan & 1; float* nb = (float*)(F.ws + WS_MLN) + (size_t)scan * NTC * 64 + e;
            float m = 0.f, s0 = 0.f;
            for (int j0 = 0; j0 < NTC; j0 += 12) {
                float dv[12];
#pragma unroll
                for (int i = 0; i < 12; ++i) dv[i] = nb[tc_seq(dir, j0 + i) * 64];
#pragma unroll
                for (int i = 0; i < 12; ++i) { const int tc = tc_seq(dir, j0 + i); const float* sp = MLS + (size_t)(scan * NTC + tc) * 4;
                    const float g = sp[0], ml = sp[1], mn = fmaxf(g + m, ml), a = __expf(g + m - mn), w = __expf(ml - mn);
                    nb[tc * 64] = s0; s0 = a * s0 + w * dv[i]; m = mn; }
            }
        }
    }
}
template <int MIX>
__device__ __forceinline__ void gate_load(Frame& F, int row0, int h, unsigned (&gate)[16]) {
    const int mt = F.wave >> 2, nt = F.wave & 3; const bf16* P = (const bf16*)(F.ws + WS_P) + (MIX == 0 ? PC_O : PC_GO) + h * 128 + 32 * nt + (F.lane & 31);
#pragma unroll
    for (int r = 0; r < 16; ++r) gate[r] = P[(size_t)(row0 + 32 * mt + rowmap(r, F.lane >> 5)) * PW];
}
template <int MIX>
__device__ __forceinline__ void head_epilogue(Frame& F, const float ng, const f32x16& hv, const unsigned (&gate)[16], LAS float* part, int row0, int h) {
    const int mt = F.wave >> 2, nt = F.wave & 3, lane = F.lane, hi = lane >> 5;
    float ps[16];
#pragma unroll
    for (int r = 0; r < 16; ++r) ps[r] = hv[r] * hv[r];
#pragma unroll
    for (int r = 0; r < 16; ++r) ps[r] = half_sum_hi(ps[r]);
    if ((lane & 31) == 31) {
#pragma unroll
        for (int r = 0; r < 16; ++r) part[(32 * mt + rowmap(r, hi)) * 4 + nt] = ps[r]; }
    LDS_BARRIER();
    bf16* Y = (bf16*)(F.ws + WS_Y) + (MIX == 0 ? 0 : 512) + h * 128 + 32 * nt + (lane & 31);
#pragma unroll
    for (int r = 0; r < 16; r += 2) { const int t0 = 32 * mt + rowmap(r, hi), t1 = 32 * mt + rowmap(r + 1, hi); const f32x4 p4 = *(const LAS f32x4*)(part + t0 * 4), q4 = *(const LAS f32x4*)(part + t1 * 4);
        const f32x2_t ms = (f32x2_t){(p4.x + p4.y) + (p4.z + p4.w), (q4.x + q4.y) + (q4.z + q4.w)} * (1.f / 128.f) + EPS;
        const f32x2_t rstd = {__builtin_amdgcn_rsqf(ms.x), __builtin_amdgcn_rsqf(ms.y)}, gz = {bf2f((unsigned short)gate[r]), bf2f((unsigned short)gate[r + 1])};
        const f32x2_t te = gz * (-1.44269504f), dn = (f32x2_t){__builtin_amdgcn_exp2f(te.x), __builtin_amdgcn_exp2f(te.y)} + 1.f;
        const f32x2_t sg = {__builtin_amdgcn_rcpf(dn.x), __builtin_amdgcn_rcpf(dn.y)}, gv = MIX == 0 ? sg : gz * sg;
        const f32x2_t y = ((f32x2_t){hv[r], hv[r + 1]} * rstd) * (gv * ng); const unsigned w = pk2(y.x, y.y);
        Y[(size_t)(row0 + t0) * D] = (bf16)w; Y[(size_t)(row0 + t1) * D] = (bf16)(w >> 16); }
}
struct MlCRaw { VtRaw v; u32x4 q, k; u32x4 cf[2]; float g0, g1, ms; };
__device__ __forceinline__ void touch(MlCRaw& R) {
#pragma unroll
    for (int i = 0; i < 8; ++i) touch(R.v.w[i]);
    touch(R.q); touch(R.k); touch(R.cf[0]); touch(R.cf[1]); touch(R.g0); touch(R.g1); touch(R.ms); }
__device__ __forceinline__ void ml_passC_load(Frame& F, int task, MlCRaw& R) {
    const TaskId T = task_id(task); const bf16* CQK = (const bf16*)(F.ws + WS_CQK);
    vt_load(R.v, (const bf16*)(F.ws + WS_P), PW, T.row0, PC_V + T.h * 128, F.tid);
    { const int row = F.tid >> 3, pc = F.tid & 7;
      R.q = *(const u32x4*)(CQK + (size_t)(T.row0 + row) * 512 + T.h * 64 + pc * 8); R.k = *(const u32x4*)(CQK + (size_t)(T.row0 + row) * 512 + 256 + T.h * 64 + pc * 8); }
    { const u32x4* cp = (const u32x4*)((const bf16*)(F.ws + WS_MLCB) + (size_t)(T.sidf * NTC + T.tc) * 8192 + (F.tid >> 2) * 64 + (F.tid & 3) * 16); R.cf[0] = cp[0]; R.cf[1] = cp[1]; }
    R.g0 = 0.f; R.g1 = 0.f; R.ms = 0.f;
    if (F.wave < 2) { const int dir = F.wave; const float* gp = (const float*)(F.ws + WS_GATES) + (size_t)(T.row0 + F.lane) * 16; R.g0 = gp[dir * 4 + T.h]; R.g1 = gp[8 + dir * 4 + T.h];
        R.ms = ((const float*)(F.ws + WS_MLS))[(size_t)((T.sidf + dir) * NTC + T.tc) * 4 + 2]; }
}
__device__ __forceinline__ void ml_passC_run(Frame& F, CArgs& A, int l, int task, const MlCRaw& R) {
    const TaskId T = task_id(task); const int h = T.h, tc = T.tc, row0 = T.row0, sidf = T.sidf;
    if (l == DEPTH - 1 && tc < 4) return;
    unsigned gate[16];
    const float ng = A.in[I_MLNG][l * 512 + h * 128 + 32 * (F.wave & 3) + (F.lane & 31)];
    LAS unsigned char* Q = F.lds; LAS unsigned char* Kn = F.lds + 9216; LAS unsigned char* VT = F.lds + 18432; LAS unsigned char* Cs = F.lds + 36864;
    LAS unsigned char* Pm = F.lds + 55296; LAS unsigned char* Qs = F.lds + 64512;
    LAS float* sm = (LAS float*)(F.lds + 73728);
    const int tid = F.tid, lane = F.lane;
    u32x4 cb[2]; { const u32x4* cp = (const u32x4*)((const bf16*)(F.ws + WS_MLCB) + (size_t)((sidf + 1) * NTC + tc) * 8192 + (tid >> 2) * 64 + (tid & 3) * 16); cb[0] = cp[0]; cb[1] = cp[1]; }
    float nv = 0.f; if (tid < 128) nv = ((const float*)(F.ws + WS_MLN))[(size_t)((sidf + (tid >> 6)) * NTC + tc) * 64 + (tid & 63)];
    LDS_BARRIER();
    { const int row = tid >> 3, pc = tid & 7; *(LAS u32x4*)(Q + row * ST64 + pc * 16) = R.q; *(LAS u32x4*)(Kn + row * ST64 + pc * 16) = R.k; }
    vt_store(VT, R.v, tid);
    if (tid < 128) sm[512 + tid] = nv;
    if (F.wave < 2) { const int dir = F.wave, s = lane; const float ig = R.g0, lf = R.g1, ms = R.ms;
        float bt, u, pm;
        if (dir == 0) { bt = wave_incl_sum(lf, s); u = ig - bt; pm = wave_incl_max(u, s); }
        else { const float pf = wave_incl_sum(lf, s), tot = __builtin_bit_cast(float, __builtin_amdgcn_readlane(__builtin_bit_cast(int, pf), 63)); bt = tot - pf + lf; u = ig - bt;
               float r = __shfl(u, 63 - s); r = wave_incl_max(r, s); pm = __shfl(r, 63 - s); }
        const float M = fmaxf(ms, pm);
        LAS float* o = sm + dir * 256; o[s] = u; o[64 + s] = M; o[128 + s] = __expf(ms - M); o[192 + s] = __expf(-(bt + M)); }
    LDS_BARRIER();
    f32x16 qk;
#pragma unroll
    for (int i = 0; i < 16; ++i) qk[i] = 0.f;
    if (F.wave < 4) mm32<64>(qk, Q + 32 * (F.wave >> 1) * ST64, ST64, Kn + 32 * (F.wave & 1) * ST64, ST64, lane);
    f32x16 hs;
#pragma unroll
    for (int i = 0; i < 16; ++i) hs[i] = 0.f;
#pragma unroll 1
    for (int dir = 0; dir < 2; ++dir) {
        const LAS float* sd = sm + dir * 256;
        { const int v = tid >> 2, pc = tid & 3; *(LAS u32x4*)(Cs + v * ST64 + pc * 32) = dir == 0 ? R.cf[0] : cb[0]; *(LAS u32x4*)(Cs + v * ST64 + pc * 32 + 16) = dir == 0 ? R.cf[1] : cb[1]; }
        { const int row = tid >> 3, pc = tid & 7; const u32x4 q = R.q; const float w = sd[128 + row];
          *(LAS u32x4*)(Qs + row * ST64 + pc * 16) = (u32x4){pk2(bflo(q.x) * w, bfhi(q.x) * w), pk2(bflo(q.y) * w, bfhi(q.y) * w), pk2(bflo(q.z) * w, bfhi(q.z) * w), pk2(bflo(q.w) * w, bfhi(q.w) * w)}; }
        if (F.wave < 4) { const int s = 32 * (F.wave & 1) + (lane & 31); const float us = sd[s]; float Mt[16];
#pragma unroll
            for (int r = 0; r < 16; ++r) Mt[r] = sd[64 + 32 * (F.wave >> 1) + rowmap(r, lane >> 5)];
#pragma unroll
            for (int r = 0; r < 16; r += 2) { const int t0 = 32 * (F.wave >> 1) + rowmap(r, lane >> 5), t1 = 32 * (F.wave >> 1) + rowmap(r + 1, lane >> 5);
                const bool ok0 = dir == 0 ? (s <= t0) : (s >= t0), ok1 = dir == 0 ? (s <= t1) : (s >= t1);
                f32x2_t ex = (f32x2_t){us - Mt[r], us - Mt[r + 1]}; ex.x = fminf(ex.x, 0.f); ex.y = fminf(ex.y, 0.f); ex = ex * 1.44269504f;
                const f32x2_t p = (f32x2_t){qk[r], qk[r + 1]} * (f32x2_t){__builtin_amdgcn_exp2f(ex.x), __builtin_amdgcn_exp2f(ex.y)}; const unsigned w = pk2(ok0 ? p.x : 0.f, ok1 ? p.y : 0.f);
                *(LAS unsigned short*)(Pm + t0 * ST64 + s * 2) = (unsigned short)w; *(LAS unsigned short*)(Pm + t1 * ST64 + s * 2) = (unsigned short)(w >> 16); } }
        LDS_BARRIER();
        if (tid < 256) { const int t = tid >> 2, qd = tid & 3; float den = 0.f, qn = 0.f;
#pragma unroll
            for (int i = 0; i < 2; ++i) { const u32x4 w = *(const LAS u32x4*)(Pm + t * ST64 + qd * 32 + i * 16); den += (bflo(w.x) + bfhi(w.x)) + (bflo(w.y) + bfhi(w.y)) + (bflo(w.z) + bfhi(w.z)) + (bflo(w.w) + bfhi(w.w));
                const u32x4 q = *(const LAS u32x4*)(Q + t * ST64 + qd * 32 + i * 16); const LAS float* nvp = sm + 512 + dir * 64 + qd * 16 + i * 8; const f32x4 n0 = *(const LAS f32x4*)nvp, n1 = *(const LAS f32x4*)(nvp + 4);
                qn += (bflo(q.x) * n0.x + bfhi(q.x) * n0.y) + (bflo(q.y) * n0.z + bfhi(q.y) * n0.w) + (bflo(q.z) * n1.x + bfhi(q.z) * n1.y) + (bflo(q.w) * n1.z + bfhi(q.w) * n1.w); }
            den += sd[128 + t] * qn;
            den += dppf<0xB1, 0xf, true>(0.f, den); den += dppf<0x4E, 0xf, true>(0.f, den);
            if (qd == 0) sm[640 + t] = 1.f / fmaxf(fabsf(den), sd[192 + t]); }
        f32x16 acc;
#pragma unroll
        for (int i = 0; i < 16; ++i) acc[i] = 0.f;
        { const int mt = F.wave >> 2, nt = F.wave & 3;
          mm32<64>(acc, Pm + 32 * mt * ST64, ST64, VT + 32 * nt * ST64, ST64, lane);
          mm32<64>(acc, Qs + 32 * mt * ST64, ST64, Cs + 32 * nt * ST64, ST64, lane); }
        LDS_BARRIER();
        float dsc[16];
#pragma unroll
        for (int r = 0; r < 16; ++r) dsc[r] = sm[640 + 32 * (F.wave >> 2) + rowmap(r, lane >> 5)];
#pragma unroll
        for (int r = 0; r < 16; ++r) hs[r] += acc[r] * dsc[r];
        if (dir == 0) LDS_BARRIER();
    }
    gate_load<0>(F, row0, h, gate);
    head_epilogue<0>(F, ng, hs, gate, sm + 768, row0, h);
}

struct HgPrep { float k[16], x[16]; float T[4]; };
__device__ __forceinline__ void hg_zload(Frame& F, int h, int row0, int dir, unsigned (&z)[16]) {
    const int d = F.tid & 127, qtr = F.tid >> 7;
    const bf16* P = (const bf16*)(F.ws + WS_P) + (size_t)(row0 + qtr * 16) * PW + (dir == 0 ? PC_FF : PC_FB) + h * 128 + d;
#pragma unroll
    for (int i = 0; i < 16; ++i) z[i] = P[(size_t)i * PW];
}
struct HgConst { float lb, bf, bb; };
__device__ __forceinline__ HgConst hg_const(Frame& F, CArgs& A, int l, int h) { const int ch = h * 128 + (F.tid & 127); HgConst c; c.lb = 0.f;
    if (l == 1) { const float r0 = A.in[I_HGLB][ch], r1 = A.in[I_HGLB][512 + ch], mx = fmaxf(r0, r1), e0 = __expf(r0 - mx), e1 = __expf(r1 - mx); c.lb = e1 / (e0 + e1); }
    c.bf = A.in[I_HGFB][l * 1024 + ch]; c.bb = A.in[I_HGFB][l * 1024 + 512 + ch]; return c; }
template <int dir>
__device__ __forceinline__ void hg_prep(Frame& F, const HgConst& C, int l, const unsigned (&zr)[16], LAS float* tot, HgPrep& R) {
    const int d = F.tid & 127, qtr = F.tid >> 7;
    const float lb = C.lb, bias = dir == 0 ? C.bf : C.bb, omlb = 1.f - lb;
    float cs = 0.f;
#pragma unroll
    for (int i = 0; i < 16; i += 2) {
        f32x2_t z = (f32x2_t){bf2f((unsigned short)zr[i]), bf2f((unsigned short)zr[i + 1])} + bias;
        z.x = fminf(fmaxf(z.x, -30.f), 30.f); z.y = fminf(fmaxf(z.y, -30.f), 30.f);
        const f32x2_t t = z * (-1.44269504f);
        const f32x2_t ez = {__builtin_amdgcn_exp2f(t.x), __builtin_amdgcn_exp2f(t.y)}, dn = ez + 1.f;
        const f32x2_t sg = {__builtin_amdgcn_rcpf(dn.x), __builtin_amdgcn_rcpf(dn.y)};
        const f32x2_t kk = (ez * sg) * omlb, ff = sg * omlb + lb;
        R.k[i] = kk.x; R.k[i + 1] = kk.y;
        const f32x2_t lf = (f32x2_t){__builtin_amdgcn_logf(ff.x), __builtin_amdgcn_logf(ff.y)} * 0.69314718f;
        if (dir == 0) { cs += lf.x; R.x[i] = cs; cs += lf.y; R.x[i + 1] = cs; } else { R.x[i] = cs; cs += lf.x; R.x[i + 1] = cs; cs += lf.y; } }
    tot[dir * 512 + qtr * 128 + d] = cs;
    LDS_BARRIER();
    float off = 0.f;
#pragma unroll
    for (int q = 0; q < 4; ++q) { R.T[q] = tot[dir * 512 + q * 128 + d]; if (q < qtr) off += R.T[q]; }
#pragma unroll
    for (int i = 0; i < 16; ++i) R.x[i] += off;
}
__device__ __forceinline__ void put16(LAS unsigned char* p, const float (&v)[16]) {
    *(LAS u32x4*)p = (u32x4){pk2(v[0], v[1]), pk2(v[2], v[3]), pk2(v[4], v[5]), pk2(v[6], v[7])};
    *(LAS u32x4*)(p + 16) = (u32x4){pk2(v[8], v[9]), pk2(v[10], v[11]), pk2(v[12], v[13]), pk2(v[14], v[15])};
}
struct HgARaw { VtRaw v; unsigned zf[16], zb[16]; };
__device__ __forceinline__ void touch(HgARaw& R) {
#pragma unroll
    for (int i = 0; i < 8; ++i) touch(R.v.w[i]);
#pragma unroll
    for (int i = 0; i < 16; ++i) { touch(R.zf[i]); touch(R.zb[i]); } }
__device__ __forceinline__ void hg_passA_load(Frame& F, int task, HgARaw& R) {
    const TaskId T = task_id(task);
    vt_load(R.v, (const bf16*)(F.ws + WS_CQI), 1024, T.row0, 512 + T.h * 128, F.tid);
    hg_zload(F, T.h, T.row0, 0, R.zf); hg_zload(F, T.h, T.row0, 1, R.zb);
}
__device__ __forceinline__ void hg_passA_run(Frame& F, CArgs& A, int l, int task, const HgARaw& RW) {
    const TaskId T = task_id(task); const int h = T.h, tc = T.tc, sidf = T.sidf;
    LAS unsigned char* VT = F.lds; LAS unsigned char* KT = F.lds + 18432; LAS float* tot = (LAS float*)(F.lds + 55296);
    const int d = F.tid & 127, qtr = F.tid >> 7;
    const HgConst HC = hg_const(F, A, l, h);
    LDS_BARRIER();
    vt_store(VT, RW.v, F.tid);
    float* GG = (float*)(F.ws + WS_HGG);
    { HgPrep R; hg_prep<0>(F, HC, l, RW.zf, tot, R);
      const float G = (R.T[0] + R.T[1]) + (R.T[2] + R.T[3]);
      if (qtr == 0) GG[(size_t)(sidf * NTC + tc) * 128 + d] = G;
      float t[16];
#pragma unroll
      for (int i = 0; i < 16; i += 2) { const f32x2_t te = ((f32x2_t){R.x[i], R.x[i + 1]} - G) * (-1.44269504f);
          const f32x2_t kv = (f32x2_t){R.k[i], R.k[i + 1]} * (f32x2_t){__builtin_amdgcn_exp2f(te.x), __builtin_amdgcn_exp2f(te.y)}; t[i] = kv.x; t[i + 1] = kv.y; }
      put16(KT + d * ST64 + qtr * 32, t); }
    { HgPrep R; hg_prep<1>(F, HC, l, RW.zb, tot, R);
      const float G = (R.T[0] + R.T[1]) + (R.T[2] + R.T[3]);
      if (qtr == 0) GG[(size_t)((sidf + 1) * NTC + tc) * 128 + d] = G;
      float t[16];
#pragma unroll
      for (int i = 0; i < 16; i += 2) { const f32x2_t te = (f32x2_t){R.x[i], R.x[i + 1]} * 1.44269504f;
          const f32x2_t kv = (f32x2_t){R.k[i], R.k[i + 1]} * (f32x2_t){__builtin_amdgcn_exp2f(te.x), __builtin_amdgcn_exp2f(te.y)}; t[i] = kv.x; t[i + 1] = kv.y; }
      put16(KT + 18432 + d * ST64 + qtr * 32, t); }
    LDS_BARRIER();
    { const int dir = F.wave >> 2, mt = F.wave & 3; bf16* S = (bf16*)(F.ws + WS_HGS) + (size_t)((sidf + dir) * NTC + tc) * 16384;
#pragma unroll
      for (int nt = 0; nt < 4; ++nt) { f32x16 acc;
#pragma unroll
          for (int i = 0; i < 16; ++i) acc[i] = 0.f;
          mm32<64>(acc, VT + 32 * mt * ST64, ST64, KT + dir * 18432 + 32 * nt * ST64, ST64, F.lane);
#pragma unroll
          for (int r = 0; r < 16; ++r) S[(32 * mt + rowmap(r, F.lane >> 5)) * 128 + 32 * nt + (F.lane & 31)] = (bf16)f2bf(acc[r]); } }
}
struct HgCRaw { VtRaw v; unsigned zf[16], q[16]; };
__device__ __forceinline__ void touch(HgCRaw& R) {
#pragma unroll
    for (int i = 0; i < 8; ++i) touch(R.v.w[i]);
#pragma unroll
    for (int i = 0; i < 16; ++i) { touch(R.zf[i]); touch(R.q[i]); } }
__device__ __forceinline__ void hg_passC_load(Frame& F, int task, HgCRaw& R) {
    const TaskId T = task_id(task); const bf16* CQI = (const bf16*)(F.ws + WS_CQI);
    vt_load(R.v, CQI, 1024, T.row0, 512 + T.h * 128, F.tid);
    hg_zload(F, T.h, T.row0, 0, R.zf);
    { const int d = F.tid & 127, qtr = F.tid >> 7;
#pragma unroll
      for (int i = 0; i < 16; ++i) R.q[i] = CQI[(size_t)(T.row0 + qtr * 16 + i) * 1024 + T.h * 128 + d]; }
}
__device__ __forceinline__ void hg_passC_run(Frame& F, CArgs& A, int l, int task, const HgCRaw& RW) {
    const TaskId T = task_id(task); const int h = T.h, tc = T.tc, row0 = T.row0, sidf = T.sidf;
    LAS unsigned char* VT = F.lds; LAS unsigned char* Ss = F.lds + 18432; LAS unsigned char* Qh = F.lds + 53248; LAS unsigned char* Kh = F.lds + 70656;
    LAS unsigned char* Qc = F.lds + 88064; LAS unsigned char* Kc = F.lds + 96768; LAS unsigned char* Qt = F.lds + 105472; LAS unsigned char* Am = F.lds + 122880;
    LAS float* tot = (LAS float*)(F.lds + 132096);
    const int tid = F.tid, lane = F.lane, d = tid & 127, qtr = tid >> 7;
    if (l == DEPTH - 1 && tc < 4) return;
    unsigned gate[16];
    const HgConst HC = hg_const(F, A, l, h);
    unsigned zb[16]; hg_zload(F, h, row0, 1, zb);
    u32x4 sf[4], sb[4]; { const u32x4* sp = (const u32x4*)((const bf16*)(F.ws + WS_HGSB) + (size_t)(sidf * NTC + tc) * 16384 + (tid >> 2) * 128 + (tid & 3) * 32);
#pragma unroll
      for (int j = 0; j < 4; ++j) { sf[j] = sp[j]; sb[j] = sp[j + (size_t)NTC * 16384 * 2 / 16]; } }
    LDS_BARRIER();
    vt_store(VT, RW.v, tid);
    f32x16 acc;
#pragma unroll
    for (int i = 0; i < 16; ++i) acc[i] = 0.f;
#pragma unroll
    for (int dir = 0; dir < 2; ++dir) {
        HgPrep R;
        if (dir == 1) gate_load<1>(F, row0, h, gate);
        if (dir == 0) hg_prep<0>(F, HC, l, RW.zf, tot, R); else hg_prep<1>(F, HC, l, zb, tot, R);
        const float T0 = R.T[0], T1 = R.T[1], T2 = R.T[2], T3 = R.T[3];
        const float sg = dir == 0 ? 1.f : -1.f;
        const float rI = sg * ((qtr >> 1) == 0 ? T0 : (T0 + T1) + T2);
        const float rO = sg * (T0 + T1);
        const float Gall = (T0 + T1) + (T2 + T3);
        const bool isq = dir == 0 ? (qtr >= 2) : (qtr < 2);
        const float cO = __expf(isq ? rI - rO : rO - rI), cT = __expf(dir == 0 ? rI : Gall + rI);
        { const int v = tid >> 2, pc = tid & 3;
#pragma unroll
          for (int j = 0; j < 4; ++j) *(LAS u32x4*)(Ss + v * ST128 + pc * 64 + j * 16) = dir == 0 ? sf[j] : sb[j]; }
#pragma unroll
        for (int i = 0; i < 16; i += 2) {
            const int t = qtr * 16 + i;
            const f32x2_t x = dir == 0 ? (f32x2_t){R.x[i], R.x[i + 1]} : (f32x2_t){-R.x[i], -R.x[i + 1]}, kk = {R.k[i], R.k[i + 1]}, qv = {bf2f((unsigned short)RW.q[i]), bf2f((unsigned short)RW.q[i + 1])};
            const f32x2_t te = (x - rI) * 1.44269504f;
            const f32x2_t eh = {__builtin_amdgcn_exp2f(te.x), __builtin_amdgcn_exp2f(te.y)}, ehr = {__builtin_amdgcn_rcpf(eh.x), __builtin_amdgcn_rcpf(eh.y)};
            const f32x2_t qe = qv * eh, ke = kk * ehr, of = (isq ? qe : ke) * cO, qt = qe * cT;
            const unsigned wq = pk2(qe.x, qe.y), wk = pk2(ke.x, ke.y), wo = pk2(of.x, of.y), wt = pk2(qt.x, qt.y);
            *(LAS unsigned short*)(Qh + t * ST128 + d * 2) = (unsigned short)wq; *(LAS unsigned short*)(Qh + (t + 1) * ST128 + d * 2) = (unsigned short)(wq >> 16);
            *(LAS unsigned short*)(Kh + t * ST128 + d * 2) = (unsigned short)wk; *(LAS unsigned short*)(Kh + (t + 1) * ST128 + d * 2) = (unsigned short)(wk >> 16);
            LAS unsigned char* oc = isq ? Qc : Kc;
            *(LAS unsigned short*)(oc + (t & 31) * ST128 + d * 2) = (unsigned short)wo; *(LAS unsigned short*)(oc + ((t + 1) & 31) * ST128 + d * 2) = (unsigned short)(wo >> 16);
            *(LAS unsigned short*)(Qt + t * ST128 + d * 2) = (unsigned short)wt; *(LAS unsigned short*)(Qt + (t + 1) * ST128 + d * 2) = (unsigned short)(wt >> 16);
        }
        LDS_BARRIER();
        if (F.wave < 4) { f32x16 a;
#pragma unroll
            for (int i = 0; i < 16; ++i) a[i] = 0.f;
            int tt = 0, ts = 0;
            if (F.wave < 2) { tt = ts = F.wave; mm32<128>(a, Qh + 32 * tt * ST128, ST128, Kh + 32 * ts * ST128, ST128, lane);
#pragma unroll
                for (int r = 0; r < 16; ++r) { const int tl = rowmap(r, lane >> 5), sl = lane & 31; const bool ok = dir == 0 ? (sl <= tl) : (sl >= tl); a[r] = ok ? a[r] : 0.f; } }
            else if (F.wave == 2) { tt = dir == 0 ? 1 : 0; ts = 1 - tt; mm32<128>(a, Qc, ST128, Kc, ST128, lane); }
            else { tt = dir == 0 ? 0 : 1; ts = 1 - tt; }
#pragma unroll
            for (int r = 0; r < 16; r += 2) { const unsigned w = pk2(a[r], a[r + 1]); *(LAS unsigned short*)(Am + (32 * tt + rowmap(r, lane >> 5)) * ST64 + (32 * ts + (lane & 31)) * 2) = (unsigned short)w;
                *(LAS unsigned short*)(Am + (32 * tt + rowmap(r + 1, lane >> 5)) * ST64 + (32 * ts + (lane & 31)) * 2) = (unsigned short)(w >> 16); } }
        LDS_BARRIER();
        { const int mt = F.wave >> 2, nt = F.wave & 3;
          mm32<64>(acc, Am + 32 * mt * ST64, ST64, VT + 32 * nt * ST64, ST64, lane);
          mm32<128>(acc, Qt + 32 * mt * ST128, ST128, Ss + 32 * nt * ST128, ST128, lane); }
        if (dir == 0) LDS_BARRIER();
    }
    const float ng = A.in[I_HGNG][l * 512 + h * 128 + 32 * (F.wave & 3) + (lane & 31)];
    head_epilogue<1>(F, ng, acc, gate, (LAS float*)(F.lds + 136192), row0, h);
}
#define TASK_LOOP(RAW, LOADFN, RUNFN, T0, T1) do { int t_ = F.vcu; while (t_ < (T0)) t_ += F.G; RAW cur_; if (t_ < (T1)) { LOADFN(t_ - (T0), cur_); } \
    for (; t_ < (T1); t_ += F.G) { touch(cur_); RAW nxt_; if (t_ + F.G < (T1)) { LOADFN(t_ + F.G - (T0), nxt_); } else nxt_ = cur_; RUNFN(t_ - (T0), cur_); cur_ = nxt_; } } while (0)

__device__ __forceinline__ void transpose_item(const float* W, int ldw, int K, bf16* WT, int k0, int n0, int drow0, LAS float* scr, int lane) {
    const int n4 = (lane & 7) * 4, kr = lane >> 3;
    f32x4 v[8];
#pragma unroll
    for (int i = 0; i < 8; ++i) v[i] = __builtin_nontemporal_load((const f32x4*)(W + (size_t)(k0 + 8 * i + kr) * ldw + n0 + n4));
#pragma unroll
    for (int i = 0; i < 8; ++i) { LAS float* p = scr + (8 * i + kr) * 33 + n4; p[0] = v[i].x; p[1] = v[i].y; p[2] = v[i].z; p[3] = v[i].w; }
    asm volatile("s_waitcnt lgkmcnt(0)" ::: "memory");
    const int c = lane & 7;
#pragma unroll
    for (int j = 0; j < 4; ++j) { const int n = (lane >> 3) + 8 * j; const LAS float* s = scr + (8 * c) * 33 + n;
        u32x4 o; o.x = pk2(s[0 * 33], s[1 * 33]); o.y = pk2(s[2 * 33], s[3 * 33]); o.z = pk2(s[4 * 33], s[5 * 33]); o.w = pk2(s[6 * 33], s[7 * 33]);
        *(u32x4*)(WT + (size_t)(drow0 + n) * K + k0 + 8 * c) = o; }
    asm volatile("s_waitcnt lgkmcnt(0)" ::: "memory");
}
__device__ __forceinline__ void ph_convert(Frame& F, CArgs& A, bool small_only) {
    LAS float* scr = (LAS float*)(F.lds + 32768 + F.wave * 8448);
    const int gw = F.vcu * NWAVES + F.wave, NGW = F.G * NWAVES;
    constexpr int I_IN = DEPTH * 16 * 128, I_OUT = DEPTH * 16 * 32, I_GU = DEPTH * NEXP * 16 * 64, I_DN = DEPTH * NEXP * 16 * 32;
    for (int it = gw; it < (small_only ? I_IN + I_OUT : I_IN + I_OUT + I_GU + I_DN); it += NGW) {
        int r = it;
        if (r < I_IN) { const int l = r / 2048, q = r % 2048, kb = q / 128, nb = q % 128, d0 = nb * 32, n0 = d0 < 1536 ? d0 : d0 + 16;
            transpose_item(A.in[I_WIN] + (size_t)l * D * INW, INW, D, (bf16*)(F.ws + WS_WIN) + (size_t)l * PW * D, kb * 64, n0, d0, scr, F.lane); continue; }
        r -= I_IN;
        if (r < I_OUT) { const int l = r / 512, q = r % 512, kb = q / 32, nb = q % 32;
            transpose_item(A.in[I_WOUT] + (size_t)l * D * D, D, D, (bf16*)(F.ws + WS_WOUT) + (size_t)l * D * D, kb * 64, nb * 32, nb * 32, scr, F.lane); continue; }
        r -= I_OUT;
        if (r < I_GU) { const int m = r / 1024, q = r % 1024, kb = q / 64, nb = q % 64, n0 = nb * 32;
            const int cc = n0 & 1023, d0 = (cc >> 7) * 256 + (n0 >= 1024 ? 128 : 0) + (cc & 127);
            transpose_item(A.in[I_WGU] + (size_t)m * D * 2048, 2048, D, (bf16*)(F.ws + WS_WGU) + (size_t)m * 2048 * D, kb * 64, n0, d0, scr, F.lane); continue; }
        r -= I_GU;
        { const int m = r / 512, q = r % 512, kb = q / 32, nb = q % 32;
            transpose_item(A.in[I_WDN] + (size_t)m * DEXP * D, D, DEXP, (bf16*)(F.ws + WS_WDN) + (size_t)m * D * DEXP, kb * 64, nb * 32, nb * 32, scr, F.lane); }
    }
}


constexpr int CV_NJ = 384;
__device__ __forceinline__ void moe_item_addr(CArgs& A, unsigned char* ws, int item, const float*& W, int& ldw, bf16*& WT, int& k0, int& n0, int& d0) {
    const int l = item / 49152, r = item % 49152;
    if (r < 32768) { const int e = r >> 10, q = r & 1023, kb = q >> 6, nb = q & 63; n0 = nb * 32; const int cc = n0 & 1023; d0 = (cc >> 7) * 256 + (n0 >= 1024 ? 128 : 0) + (cc & 127); k0 = kb * 64;
        W = A.in[I_WGU] + (size_t)(l * NEXP + e) * D * 2048; ldw = 2048; WT = (bf16*)(ws + WS_WGU) + (size_t)(l * NEXP + e) * 2048 * D; }
    else { const int r2 = r - 32768, e = r2 >> 9, q = r2 & 511, kb = q >> 5, nb = q & 31; n0 = nb * 32; d0 = n0; k0 = kb * 64;
        W = A.in[I_WDN] + (size_t)(l * NEXP + e) * DEXP * D; ldw = D; WT = (bf16*)(ws + WS_WDN) + (size_t)(l * NEXP + e) * D * DEXP; }
}
__device__ __forceinline__ void transpose_store(bf16* WT, int K, int k0, int d0, LAS float* scr, const f32x4 (&v)[8], int lane) {
    const int n4 = (lane & 7) * 4, kr = lane >> 3;
#pragma unroll
    for (int i = 0; i < 8; ++i) { LAS float* p = scr + (8 * i + kr) * 33 + n4; p[0] = v[i].x; p[1] = v[i].y; p[2] = v[i].z; p[3] = v[i].w; }
    asm volatile("s_waitcnt lgkmcnt(0)" ::: "memory");
    const int c = lane & 7;
#pragma unroll
    for (int j = 0; j < 4; ++j) { const int n = (lane >> 3) + 8 * j; const LAS float* sp = scr + (8 * c) * 33 + n;
        u32x4 o; o.x = pk2(sp[0 * 33], sp[1 * 33]); o.y = pk2(sp[2 * 33], sp[3 * 33]); o.z = pk2(sp[4 * 33], sp[5 * 33]); o.w = pk2(sp[6 * 33], sp[7 * 33]);
        *(u32x4*)(WT + (size_t)(d0 + n) * K + k0 + 8 * c) = o; }
    asm volatile("s_waitcnt lgkmcnt(0)" ::: "memory");
}
__device__ __forceinline__ void convert_moe_all(unsigned char* ws, LAS unsigned char* lds, CArgs& A, int cw, int nw, int wave, int lane, int it_lo = 0, int it_hi = 49152) {
    LAS float* scr = (LAS float*)(lds + wave * 16640);
    const int n4 = (lane & 15) * 4, kr = lane >> 4;
    for (int it = it_lo + cw; it < it_hi; it += 2 * nw) {
        const float* W[2]; bf16* WT[2]; int ldw[2], k0[2], n0[2], d0[2];
        const bool two = it + nw < it_hi;
#pragma unroll
        for (int u = 0; u < 2; ++u) { const int iu = (u == 1 && two) ? it + nw : it; const int le = iu / 768, r = iu % 768;
            if (r < 512) { const int kb = r >> 5, nb = r & 31; k0[u] = kb * 64; n0[u] = nb * 64; const int cc = n0[u] & 1023; d0[u] = (cc >> 7) * 256 + (n0[u] >= 1024 ? 128 : 0) + (cc & 127);
                W[u] = A.in[I_WGU] + (size_t)le * D * 2048; ldw[u] = 2048; WT[u] = (bf16*)(ws + WS_WGU) + (size_t)le * 2048 * D; }
            else { const int q = r - 512, kb = q >> 4, nb = q & 15; k0[u] = kb * 64; n0[u] = nb * 64; d0[u] = n0[u];
                W[u] = A.in[I_WDN] + (size_t)le * DEXP * D; ldw[u] = D; WT[u] = (bf16*)(ws + WS_WDN) + (size_t)le * D * DEXP; } }
        f32x4 v[2][16];
#pragma unroll
        for (int u = 0; u < 2; ++u)
#pragma unroll
            for (int i = 0; i < 16; ++i) v[u][i] = __builtin_nontemporal_load((const f32x4*)(W[u] + (size_t)(k0[u] + 4 * i + kr) * ldw[u] + n0[u] + n4));
#pragma unroll
        for (int u = 0; u < 2; ++u) { if (u == 1 && !two) break;
#pragma unroll
            for (int i = 0; i < 16; ++i) { LAS float* p = scr + (4 * i + kr) * 65 + n4; p[0] = v[u][i].x; p[1] = v[u][i].y; p[2] = v[u][i].z; p[3] = v[u][i].w; }
            asm volatile("s_waitcnt lgkmcnt(0)" ::: "memory");
            const int c = lane & 7;
#pragma unroll
            for (int j = 0; j < 8; ++j) { const int n = (lane >> 3) + 8 * j; const LAS float* sp = scr + (8 * c) * 65 + n;
                u32x4 o; o.x = pk2(sp[0 * 65], sp[1 * 65]); o.y = pk2(sp[2 * 65], sp[3 * 65]); o.z = pk2(sp[4 * 65], sp[5 * 65]); o.w = pk2(sp[6 * 65], sp[7 * 65]);
                *(u32x4*)(WT[u] + (size_t)(d0[u] + n) * 1024 + k0[u] + 8 * c) = o; }
            asm volatile("s_waitcnt lgkmcnt(0)" ::: "memory"); }
    }
}
__device__ __forceinline__ void convert_moe(unsigned char* ws, LAS unsigned char* lds, CArgs& A, int cw, int wave, int lane, int j0, int j1) {
    LAS float* scr = (LAS float*)(lds + wave * 8448);
    const int n4 = (lane & 7) * 4, kr = lane >> 3;
    for (int j = j0; j < j1; j += 2) {
        const float* W0; const float* W1; bf16* T0; bf16* T1; int l0, l1, ka, kb_, na, nb_, da, db;
        moe_item_addr(A, ws, cw + 256 * j, W0, l0, T0, ka, na, da);
        const bool two = j + 1 < j1; moe_item_addr(A, ws, cw + 256 * (two ? j + 1 : j), W1, l1, T1, kb_, nb_, db);
        f32x4 v0[8], v1[8];
#pragma unroll
        for (int i = 0; i < 8; ++i) v0[i] = __builtin_nontemporal_load((const f32x4*)(W0 + (size_t)(ka + 8 * i + kr) * l0 + na + n4));
#pragma unroll
        for (int i = 0; i < 8; ++i) v1[i] = __builtin_nontemporal_load((const f32x4*)(W1 + (size_t)(kb_ + 8 * i + kr) * l1 + nb_ + n4));
        transpose_store(T0, 1024, ka, da, scr, v0, lane);
        if (two) transpose_store(T1, 1024, kb_, db, scr, v1, lane);
    }
}

#define XB_TMO      128
#define XB_XCNT(j)  (256  + 64 * (j))
#define XB_XSUB(j)  (1280 + 64 * (j))
#define XB_XGEN(j)  (2304 + 64 * (j))
#define XB_TOP      3328
#define XB_TOPGEN   3392
#define XCD_BAR_WORDS 3456
#define XB_SPIN_CAP (1u << 18)
__device__ __forceinline__ unsigned xb_ld(unsigned* p)              { return __hip_atomic_load(p, __ATOMIC_RELAXED, __HIP_MEMORY_SCOPE_AGENT); }
__device__ __forceinline__ unsigned xb_add(unsigned* p, unsigned v) { return __hip_atomic_fetch_add(p, v, __ATOMIC_RELAXED, __HIP_MEMORY_SCOPE_AGENT); }
__device__ __forceinline__ unsigned xb_xcc_id() { return (unsigned)__builtin_amdgcn_s_getreg((3 << 11) | 20) & 0xFu; }
#define XB_SPIN(cond, bar) do { unsigned _sp = 0; while (cond) { __builtin_amdgcn_s_sleep(1); \
    if ((++_sp & 255u) == 0u) { if (xb_ld(&(bar)[XB_TMO])) break; if (_sp > XB_SPIN_CAP) { atomicAdd(&(bar)[XB_TMO], 1u); break; } } } } while (0)
struct XcdBarrier { unsigned* bar; unsigned x; volatile LAS unsigned* st; };
__device__ __forceinline__ XcdBarrier xcd_barrier_post(unsigned* bar, volatile LAS unsigned* st) {
    XcdBarrier b; b.bar = bar; b.x = xb_xcc_id(); b.st = st;
    if (threadIdx.x == 0) (void)xb_add(&bar[XB_XCNT(b.x)], 1u);
    return b;
}
__device__ __forceinline__ void xcd_barrier_complete(unsigned* bar, unsigned x, unsigned& nloc, unsigned& nx) {
    const unsigned G = gridDim.x * gridDim.y * gridDim.z;
    unsigned sum, cnt, mine, sp = 0u;
    for (;;) {
        sum = 0u; cnt = 0u; mine = 0u;
#pragma unroll
        for (unsigned j = 0; j < 16; ++j) { const unsigned c = xb_ld(&bar[XB_XCNT(j)]); sum += c; cnt += (c > 0u) ? 1u : 0u; mine = (j == x) ? c : mine; }
        if (sum == G) break;
        __builtin_amdgcn_s_sleep(1);
        if ((++sp & 255u) == 0u) { if (xb_ld(&bar[XB_TMO])) break; if (sp > XB_SPIN_CAP) { atomicAdd(&bar[XB_TMO], 1u); break; } }
    }
    nloc = mine > 0u ? mine : 1u; nx = cnt > 0u ? cnt : 1u;
}
__device__ __forceinline__ void xcd_barrier(const XcdBarrier& b) {
    asm volatile("s_waitcnt vmcnt(0)" ::: "memory");
    __syncthreads();
    if (threadIdx.x == 0) {
        unsigned* bar = b.bar;
        __builtin_amdgcn_s_waitcnt(0);
        unsigned nloc = b.st[0], nx = b.st[1];
        if (nloc == 0u) { xcd_barrier_complete(bar, b.x, nloc, nx); b.st[0] = nloc; b.st[1] = nx; }
        const unsigned old = xb_add(&bar[XB_XSUB(b.x)], 1u);
        const unsigned gen = old / nloc;
        if (old + 1u == (gen + 1u) * nloc) {
            __builtin_amdgcn_fence(__ATOMIC_RELEASE, "agent");
            asm volatile("s_waitcnt vmcnt(0)" ::: "memory");
            const unsigned og = xb_add(&bar[XB_TOP], 1u);
            const unsigned tg = og / nx;
            if (og + 1u == (tg + 1u) * nx) xb_add(&bar[XB_TOPGEN], 1u);
            else XB_SPIN(xb_ld(&bar[XB_TOPGEN]) == tg, bar);
            __builtin_amdgcn_fence(__ATOMIC_ACQUIRE, "agent");
            xb_add(&bar[XB_XGEN(b.x)], 1u);
            asm volatile("s_waitcnt vmcnt(0)" ::: "memory");
        } else {
            XB_SPIN(xb_ld(&bar[XB_XGEN(b.x)]) == gen, bar);
            __builtin_amdgcn_fence(__ATOMIC_ACQUIRE, "agent");
            asm volatile("s_waitcnt vmcnt(0)" ::: "memory");
        }
    }
    __syncthreads();
}

enum { PH_INIT = 0, PH_NORM1, PH_INPROJ, PH_CONV, PH_SCANA, PH_SCANB, PH_SCANC, PH_HNORM, PH_OUTPROJ, PH_NORM2, PH_LISTS, PH_GU, PH_DOWN, PH_COMBINE, PH_FINAL };

constexpr int NPHASE = 1 + 13 * DEPTH;
template <int ph, int l>
__device__ __forceinline__ void run_phase(LAS unsigned char* lds_raw) {
    int tid_ = threadIdx.x; asm volatile("" : "+v"(tid_));
    CArgs* ap_ = (CArgs*)__builtin_amdgcn_kernarg_segment_ptr(); asm volatile("" : "+s"(ap_));
    CArgs& A_ = *ap_;
    unsigned char* ws_ = A_.ws; asm volatile("" : "+s"(ws_));
    unsigned lb_ = 0u, bx_ = blockIdx.x, gx_ = gridDim.x; asm volatile("" : "+s"(lb_), "+s"(bx_), "+s"(gx_));
    Frame F; F.lds = lds_raw + lb_; F.out = A_.out; F.ws = ws_;
    F.tid = tid_; F.lane = F.tid & 63; F.wave = __builtin_amdgcn_readfirstlane(F.tid >> 6);
    F.G = (int)gx_; { const int bx = (int)bx_; F.vcu = (F.G % 8 == 0) ? (bx % 8) * (F.G / 8) + bx / 8 : bx; }
    constexpr int nrows = (l == DEPTH - 1) ? NLAT : NTOK;
    constexpr bool CVPH = (l == 0) && (ph <= PH_LISTS);
    constexpr int CQ0 = ph == PH_INIT ? 0 : ph == PH_NORM1 ? 25 : ph == PH_INPROJ ? 55 : ph == PH_CONV ? 140 : ph == PH_SCANA ? 165 : ph == PH_SCANB ? 205 : ph == PH_SCANC ? 233 : ph == PH_OUTPROJ ? 313 : ph == PH_NORM2 ? 344 : 378;
    constexpr int CQ1 = ph == PH_INIT ? 25 : ph == PH_NORM1 ? 55 : ph == PH_INPROJ ? 140 : ph == PH_CONV ? 165 : ph == PH_SCANA ? 205 : ph == PH_SCANB ? 233 : ph == PH_SCANC ? 313 : ph == PH_OUTPROJ ? 344 : ph == PH_NORM2 ? 378 : CV_NJ;
    const bool cvgrid = false;
    if (CVPH && cvgrid) {
        if (bx_ >= 224u) { const int cvcu = (int)(bx_ & 7u) * 4 + ((int)(bx_ >> 3) - 28); convert_moe(ws_, F.lds, A_, cvcu * 8 + F.wave, F.wave, F.lane, CQ0, CQ1); return; }
        F.G = 224; F.vcu = (int)(bx_ & 7u) * 28 + (int)(bx_ >> 3); gx_ = 224u;
    }
    switch (ph) {
        case PH_INIT: ph_init(F, A_); ph_convert(F, A_, true); break;
        case PH_INPROJ: {
            const bool cfirst = ((bx_ >> 3) & 1u) == 0u;
            int base, nblk;
            if (F.G == 256 && l == 0) { if (bx_ >= 32u) { const int ix = (int)bx_ - 32; nblk = 74 + (ix < 16 ? 1 : 0); base = ix * 74 + (ix < 16 ? ix : 16); } else { base = 16592 + (int)bx_ * 48; nblk = 48; } }
            else if (F.G == 256) { if (bx_ >= 32u) { base = ((int)bx_ - 32) * 100; nblk = 100; } else { base = 22400 + (int)bx_ * 68; nblk = 68; } }
            else { const int per = (24576 + F.G - 1) / F.G; base = F.vcu * per; nblk = base + per <= 24576 ? per : (base < 24576 ? 24576 - base : 0); }
            base += l * 24576;
            if (cfirst) { convert_moe_all(F.ws, F.lds, A_, F.wave, NWAVES, F.wave, F.lane, base, base + nblk); __syncthreads(); }
            { pg8::Gemm g{(const bf16*)(F.ws + WS_H), (const bf16*)(F.ws + WS_WIN) + (size_t)l * PW * D, D, nullptr, nullptr, 0};
              pg8::StaticOrder S; S.init(NTOK / 256, PW / 256, F.G, (int)bx_); pg8::EpiBf16 E{(bf16*)(F.ws + WS_P), PW};
              pg8::gemm_phase<pg8::EpiBf16, pg8::StaticOrder, true>(F.lds, g, S, E, F.tid); }
            if (!cfirst) { __syncthreads(); convert_moe_all(F.ws, F.lds, A_, F.wave, NWAVES, F.wave, F.lane, base, base + nblk); }
        } break;
        case PH_NORM1: if (l == 0) ph_rows<1, 0>(F, A_, 0, 0, NTOK); break;
        case PH_CONV: ph_conv(F, A_, l); break;
        case PH_SCANA: {
#define LD_(t, R) ml_passA_load(F, t, R)
#define RN_(t, R) ml_passA_run(F, t, R)
            TASK_LOOP(MlARaw, LD_, RN_, 0, 8 * NTC);
#undef LD_
#undef RN_
#define LD_(t, R) hg_passA_load(F, t, R)
#define RN_(t, R) hg_passA_run(F, A_, l, t, R)
            TASK_LOOP(HgARaw, LD_, RN_, 8 * NTC, 16 * NTC);
#undef LD_
#undef RN_
        } break;
        case PH_SCANB: scan_passB(F); break;
        case PH_SCANC: {
#define LD_(t, R) ml_passC_load(F, t, R)
#define RN_(t, R) ml_passC_run(F, A_, l, t, R)
            TASK_LOOP(MlCRaw, LD_, RN_, 0, 8 * NTC);
#undef LD_
#undef RN_
#define LD_(t, R) hg_passC_load(F, t, R)
#define RN_(t, R) hg_passC_run(F, A_, l, t, R)
            TASK_LOOP(HgCRaw, LD_, RN_, 8 * NTC, 16 * NTC);
#undef LD_
#undef RN_
        } break;
        case PH_OUTPROJ: { pg8::Gemm g{(const bf16*)(F.ws + WS_Y), (const bf16*)(F.ws + WS_WOUT) + (size_t)l * D * D, D, nullptr, nullptr, 0};
            pg8::StaticOrder S; S.init(nrows / 256, D / 256, F.G, (int)bx_);
            const float* xs = (const float*)(F.ws + WS_X);
            pg8::EpiResid E{(float*)(F.ws + WS_X), (const float*)(F.ws + WS_MOD) + (size_t)l * 3 * 6144 + 2048, l == 0 ? A_.in[I_X] : xs, l == 0 ? A_.in[I_CTX] : xs + (size_t)NLAT * D};
            pg8::gemm_phase<pg8::EpiResid, pg8::StaticOrder, true>(F.lds, g, S, E, F.tid);
            if (l == 0 && F.G == 256 && bx_ >= 8u) { __syncthreads(); const int base = 18128 + ((int)bx_ - 8) * 26; convert_moe_all(F.ws, F.lds, A_, F.wave, NWAVES, F.wave, F.lane, base, base + 26); } } break;
        case PH_GU: { const int* rt = (const int*)(F.ws + WS_ROUTE); const int ntile = rt[RT_TILEE];
            pg8::Gemm g{(const bf16*)(F.ws + WS_H), (const bf16*)(F.ws + WS_WGU) + (size_t)l * NEXP * 2048 * D, D, rt + RT_LIST, rt + RT_TILEE, (size_t)2048 * D};
            pg8::StaticOrder S; S.init(ntile, 2048 / 256, F.G, (int)bx_);
            pg8::EpiSwiglu E{(bf16*)(F.ws + WS_ACT), A_.in[I_BGU] + (size_t)l * NEXP * 2048, rt + RT_TILEE};
            pg8::gemm_phase<pg8::EpiSwiglu, pg8::StaticOrder, true>(F.lds, g, S, E, F.tid); } break;
        case PH_DOWN: { const int* rt = (const int*)(F.ws + WS_ROUTE); const int ntile = rt[RT_TILEE];
            pg8::Gemm g{(const bf16*)(F.ws + WS_ACT), (const bf16*)(F.ws + WS_WDN) + (size_t)l * NEXP * D * DEXP, DEXP, nullptr, rt + RT_TILEE, (size_t)D * DEXP};
            pg8::StaticOrder S; S.init(ntile, D / 256, F.G, (int)bx_);
            pg8::EpiDown E{(bf16*)(F.ws + WS_YS), A_.in[I_BDN] + (size_t)l * NEXP * D, (const float*)(rt + RT_SGATE), rt + RT_TILEE};
            pg8::gemm_phase<pg8::EpiDown, pg8::StaticOrder, true>(F.lds, g, S, E, F.tid); } break;
        case PH_HNORM: ph_hnorm(F, A_, l, l == DEPTH - 1); break;
        case PH_NORM2: ph_rows<0, 1>(F, A_, l, l, nrows); break;
        case PH_LISTS: ph_lists(F, A_, l, nrows); break;
        case PH_COMBINE: if (l == DEPTH - 1) ph_rows<2, 2>(F, A_, l, 0, NLAT); else ph_rows<2, 0>(F, A_, l, l + 1, NTOK); break;
        default: break;
    }
}
__global__ void __launch_bounds__(NTHR, 2) fwd(Args a) {
    extern __shared__ __attribute__((aligned(16))) unsigned char lds_raw[];
    volatile LAS unsigned* bst = (volatile LAS unsigned*)((LAS unsigned char*)lds_raw + LDS_BYTES - 64);
    if (threadIdx.x < 16) bst[threadIdx.x] = 0u;
    __syncthreads();
    XcdBarrier bar = xcd_barrier_post((unsigned*)(a.ws + WS_CTL) + CW_BAR, bst);
#ifndef TPROBE
#define TPROBE 0
#endif
#ifndef TP0
#define TP0 0
#define TP1 0
#define TP2 0
#define TD0 800
#define TD1 800
#define TD2 800
#endif
    unsigned ta0 = 0u, ta1 = 0u, ta2 = 0u; unsigned long long tprev = 0;
    const bool stamper = TPROBE && blockIdx.x == 0;
    if (stamper) tprev = __builtin_amdgcn_s_memrealtime();
#define RUN(pi, ph, l) do { run_phase<ph, l>((LAS unsigned char*)lds_raw); if ((pi) != NPHASE - 1 || TPROBE) xcd_barrier(bar); \
    if (stamper) { const unsigned long long tn = __builtin_amdgcn_s_memrealtime(); const unsigned dt = (unsigned)(tn - tprev); tprev = tn; \
        if ((ph) == TP0) ta0 += dt; if ((ph) == TP1) ta1 += dt; if ((ph) == TP2) ta2 += dt; } } while (0)
#define LAYER(l) if (l == 0) RUN(1 + 13 * l, PH_NORM1, l); RUN(2 + 13 * l, PH_INPROJ, l); RUN(3 + 13 * l, PH_CONV, l); RUN(4 + 13 * l, PH_SCANA, l); RUN(5 + 13 * l, PH_SCANB, l); RUN(6 + 13 * l, PH_SCANC, l); \
    RUN(8 + 13 * l, PH_OUTPROJ, l); RUN(9 + 13 * l, PH_NORM2, l); RUN(10 + 13 * l, PH_LISTS, l); RUN(11 + 13 * l, PH_GU, l); RUN(12 + 13 * l, PH_DOWN, l); RUN(13 + 13 * l, PH_COMBINE, l)
    RUN(0, PH_INIT, 0);
    LAYER(0);
    LAYER(1);
#undef LAYER
#undef RUN
    if (TPROBE) {
        if (stamper) { const unsigned long long tn = __builtin_amdgcn_s_memrealtime();
            unsigned q0 = (ta0 + TD0 / 2) / TD0, q1 = (ta1 + TD1 / 2) / TD1, q2 = (ta2 + TD2 / 2) / TD2;
            q0 = q0 > 31u ? 31u : q0; q1 = q1 > 31u ? 31u : q1; q2 = q2 > 31u ? 31u : q2;
            const unsigned long long delay = (unsigned long long)(q0 + 32u * q1 + 1024u * q2) * 1600ull;
            while (__builtin_amdgcn_s_memrealtime() - tn < delay) __builtin_amdgcn_s_sleep(8);
        }
    }
}

template <int NB, class Epi>
__global__ void __launch_bounds__(256) naive_gemm(const bf16* A, int lda, const int* gather, const int* tile_e, int M, const float* B, size_t bexp, int ldb, int N, int K, int bshift_from, int bshift, int bgrp, Epi E) {
    __shared__ float As[16][68]; __shared__ float Bs[NB][16][68];
    const int m0 = blockIdx.y * 64, n0 = blockIdx.x * 64, tid = threadIdx.x, tx = tid & 15, ty = tid >> 4;
    int e = 0;
    if (tile_e) { const int nt = tile_e[0]; if (m0 >= nt * 256) return; e = tile_e[8 + (m0 >> 8)]; } else if (m0 >= M) return;
    const float* Bp = B + (size_t)e * bexp + (n0 + (n0 >= bshift_from ? bshift : 0));
    const int ar = tid >> 2, ak = (tid & 3) * 4; const int arow = gather ? gather[m0 + ar] : (m0 + ar);
    const bf16* Ap = A + (size_t)arow * lda + ak;
    const int bk = tid >> 4, bn = (tid & 15) * 4;
    float acc[NB][4][4];
#pragma unroll
    for (int g = 0; g < NB; ++g)
#pragma unroll
        for (int i = 0; i < 4; ++i)
#pragma unroll
            for (int j = 0; j < 4; ++j) acc[g][i][j] = 0.f;
    for (int k0 = 0; k0 < K; k0 += 16) {
        const u32x2 av = *(const u32x2*)(Ap + k0);
        As[ak + 0][ar] = bflo(av.x); As[ak + 1][ar] = bfhi(av.x); As[ak + 2][ar] = bflo(av.y); As[ak + 3][ar] = bfhi(av.y);
#pragma unroll
        for (int g = 0; g < NB; ++g) { const f32x4 bv = *(const f32x4*)(Bp + (size_t)(k0 + bk) * ldb + g * bgrp + bn); *(f32x4*)&Bs[g][bk][bn] = bv; }
        __syncthreads();
#pragma unroll
        for (int k = 0; k < 16; ++k) { const f32x4 a4 = *(const f32x4*)&As[k][ty * 4];
#pragma unroll
            for (int g = 0; g < NB; ++g) { const f32x4 b4 = *(const f32x4*)&Bs[g][k][tx * 4];
#pragma unroll
                for (int i = 0; i < 4; ++i) { acc[g][i][0] += a4[i] * b4[0]; acc[g][i][1] += a4[i] * b4[1]; acc[g][i][2] += a4[i] * b4[2]; acc[g][i][3] += a4[i] * b4[3]; } } }
        __syncthreads();
    }
#pragma unroll
    for (int i = 0; i < 4; ++i)
#pragma unroll
        for (int j = 0; j < 4; ++j) E(m0 + ty * 4 + i, n0 + tx * 4 + j, acc[0][i][j], NB == 2 ? acc[NB - 1][i][j] : 0.f, e);
}
struct EpiP { bf16* P; __device__ void operator()(int r, int c, float v, float, int) const { P[(size_t)r * PW + c] = (bf16)f2bf(v); } };
struct EpiOut { float* X; const float* MOD; __device__ void operator()(int r, int c, float v, float, int) const { X[(size_t)r * D + c] += MOD[mrow_of(r) * 6144 + 2048 + c] * v; } };
struct EpiGU { bf16* ACT; const float* bgu; __device__ void operator()(int r, int c, float g, float li, int e) const {
    g += bgu[(size_t)e * 2048 + c]; li += bgu[(size_t)e * 2048 + 1024 + c]; g = fminf(g, 7.f); li = fminf(fmaxf(li, -7.f), 7.f);
    ACT[(size_t)r * DEXP + c] = (bf16)f2bf(g * sigmoidf_(1.702f * g) * (li + 1.f)); } };
struct EpiDown { bf16* YS; const float* bdn; const float* sgate; __device__ void operator()(int r, int c, float v, float, int e) const { YS[(size_t)r * D + c] = (bf16)f2bf((v + bdn[(size_t)e * D + c]) * sgate[r]); } };

__global__ void __launch_bounds__(128) naive_mlstm(const bf16* CQK, const bf16* P, const float* GATES, float* HF, float* HB) {
    __shared__ float qs[8][64], ks[8][64];
    const int b = blockIdx.x >> 3, h = (blockIdx.x >> 1) & 3, dir = blockIdx.x & 1, tid = threadIdx.x;
    float C[64], n[64], m = 0.f;
#pragma unroll
    for (int d = 0; d < 64; ++d) { C[d] = 0.f; n[d] = 0.f; }
    float* OUT = dir ? HB : HF;
    for (int p0 = 0; p0 < CTX + SEQ; p0 += 8) {
        __syncthreads();
        { const int st = tid >> 4, pc = tid & 15, p = p0 + st; int row;
          if (p < CTX) row = NLAT + b * CTX + (dir ? CTX - 1 - p : p); else { const int q = p - CTX; row = b * SEQ + (dir ? SEQ - 1 - q : q); }
          const u32x4 w = *(const u32x4*)(CQK + (size_t)row * 512 + (pc < 8 ? h * 64 + pc * 8 : 256 + h * 64 + (pc - 8) * 8));
          float* dst = pc < 8 ? &qs[st][pc * 8] : &ks[st][(pc - 8) * 8];
          dst[0] = bflo(w.x); dst[1] = bfhi(w.x); dst[2] = bflo(w.y); dst[3] = bfhi(w.y); dst[4] = bflo(w.z); dst[5] = bfhi(w.z); dst[6] = bflo(w.w); dst[7] = bfhi(w.w); }
        __syncthreads();
        for (int st = 0; st < 8; ++st) {
            const int p = p0 + st; int row;
            if (p < CTX) row = NLAT + b * CTX + (dir ? CTX - 1 - p : p); else { const int q = p - CTX; row = b * SEQ + (dir ? SEQ - 1 - q : q); }
            const float ig = GATES[(size_t)row * 16 + dir * 4 + h], lf = GATES[(size_t)row * 16 + 8 + dir * 4 + h];
            const float v = bf2f(P[(size_t)row * PW + PC_V + h * 128 + tid]);
            const float mn = fmaxf(lf + m, ig), a = __expf(lf + m - mn), w = __expf(ig - mn), wv = w * v; m = mn;
            float num = 0.f, den = 0.f;
#pragma unroll
            for (int d = 0; d < 64; ++d) { const float kd = ks[st][d], qd = qs[st][d]; C[d] = a * C[d] + wv * kd; n[d] = a * n[d] + w * kd; num += C[d] * qd; den += n[d] * qd; }
            OUT[(size_t)row * D + h * 128 + tid] = num / fmaxf(fabsf(den), __expf(-mn));
        }
    }
}
__global__ void __launch_bounds__(128) naive_hgrn(const bf16* CQI, const bf16* P, const float* fb_l, const float* lbraw, int l, float* HF, float* HB) {
    __shared__ float fs[8][128], ks[8][128], qs[8][128];
    const int b = blockIdx.x >> 3, h = (blockIdx.x >> 1) & 3, dir = blockIdx.x & 1, tid = threadIdx.x, ch = h * 128 + tid;
    float S[128];
#pragma unroll
    for (int d = 0; d < 128; ++d) S[d] = 0.f;
    float lb = 0.f;
    if (l == 1) { const float r0 = lbraw[ch], r1 = lbraw[512 + ch], mx = fmaxf(r0, r1), e0 = __expf(r0 - mx), e1 = __expf(r1 - mx); lb = e1 / (e0 + e1); }
    const float bias = fb_l[dir * 512 + ch];
    float* OUT = dir ? HB : HF;
    for (int p0 = 0; p0 < CTX + SEQ; p0 += 8) {
        __syncthreads();
        float vv[8]; int rows[8];
#pragma unroll
        for (int st = 0; st < 8; ++st) { const int p = p0 + st; int row;
            if (p < CTX) row = NLAT + b * CTX + (dir ? CTX - 1 - p : p); else { const int q = p - CTX; row = b * SEQ + (dir ? SEQ - 1 - q : q); }
            rows[st] = row;
            const float z = bf2f(P[(size_t)row * PW + (dir ? PC_FB : PC_FF) + ch]) + bias;
            fs[st][tid] = lb + (1.f - lb) * sigmoidf_(z); ks[st][tid] = (1.f - lb) * sigmoidf_(-z);
            qs[st][tid] = bf2f(CQI[(size_t)row * 1024 + ch]); vv[st] = bf2f(CQI[(size_t)row * 1024 + 512 + ch]); }
        __syncthreads();
#pragma unroll
        for (int st = 0; st < 8; ++st) { float o = 0.f; const float v = vv[st];
#pragma unroll
            for (int d = 0; d < 128; ++d) { S[d] = fs[st][d] * S[d] + ks[st][d] * v; o += qs[st][d] * S[d]; }
            OUT[(size_t)rows[st] * D + 512 + ch] = o; }
    }
}

extern "C" void kernel_launch(void* const* d_in, const int* in_sizes, int n_in, void* d_out, int out_size, void* d_ws, size_t ws_size, hipStream_t stream) {
    static int grid = 0;
    if (grid == 0) {
        if (n_in != 24 || in_sizes[0] != NLAT * D || out_size != NLAT * D || ws_size < WS_END) { fprintf(stderr, "kernel_launch: unexpected shapes n_in %d in0 %d out %d ws %zu (need %zu)\n", n_in, n_in > 0 ? in_sizes[0] : -1, out_size, ws_size, (size_t)WS_END); grid = -1; return; }
        int dev = 0, cus = 0;
        if (hipGetDevice(&dev) != hipSuccess || hipDeviceGetAttribute(&cus, hipDeviceAttributeMultiprocessorCount, dev) != hipSuccess) { grid = -1; return; }
        if (hipFuncSetAttribute((const void*)fwd, hipFuncAttributeMaxDynamicSharedMemorySize, LDS_BYTES) != hipSuccess) { fprintf(stderr, "kernel_launch: hipFuncSetAttribute failed\n"); grid = -1; return; }
        grid = cus;
    }
    if (grid < 0) return;
    (void)hipMemsetAsync((char*)d_ws + WS_CTL, 0, 1 * MiB, stream);
    Args a{};
    for (int i = 0; i < 24; ++i) a.in[i] = (const float*)d_in[i];
    a.out = (float*)d_out; a.ws = (unsigned char*)d_ws; a.ph_lo = 0; a.ph_hi = 0;
    unsigned char* ws = (unsigned char*)d_ws;
    const float* const* in = a.in;
    int* rt = (int*)(ws + WS_ROUTE);
    a.ph_lo = 0; a.ph_hi = NPHASE;
    hipLaunchKernelGGL(fwd, dim3(grid), dim3(NTHR), LDS_BYTES, stream, a);
}
```

```cpp
#include <hip/hip_runtime.h>
#include <cstdio>
#include <cstdint>

#define GAS __attribute__((address_space(1)))
#define LAS __attribute__((address_space(3)))
typedef unsigned short bf16;
typedef float f32x4 __attribute__((ext_vector_type(4)));
typedef unsigned u32x4 __attribute__((ext_vector_type(4)));
typedef unsigned u32x2 __attribute__((ext_vector_type(2)));

constexpr int D = 1024, BATCH = 2, SEQ = 8192, DEPTH = 2, CTX = 256, GRIDW = 64;
constexpr int NLAT = BATCH * SEQ, NCTX = BATCH * CTX, NTOK = NLAT + NCTX;
constexpr int INW = 4112, PW = 4096;
constexpr int PC_QK = 0, PC_V = 512, PC_O = 1024, PC_QI = 1536, PC_FF = 2560, PC_FB = 3072, PC_GO = 3584;
constexpr int NEXP = 32, TOPK = 4, DEXP = 1024;
constexpr int MAXSLOT = (NTOK * TOPK / 256 + NEXP) * 256;
constexpr int MAXTILE = MAXSLOT / 256;
constexpr float EPS = 1e-6f;

constexpr size_t MiB = 1u << 20;
constexpr size_t WS_CTL = 0;
constexpr size_t WS_MOD = 1 * MiB;
constexpr size_t WS_GATES = 2 * MiB;
constexpr size_t WS_ROUTE = 4 * MiB;
constexpr size_t WS_X = 8 * MiB;
constexpr size_t WS_H = 76 * MiB;
constexpr size_t WS_P = 112 * MiB;
constexpr size_t WS_CQK = 246 * MiB;
constexpr size_t WS_CQI = 264 * MiB;
constexpr size_t WS_HF = 300 * MiB;
constexpr size_t WS_HB = 368 * MiB;
constexpr size_t WS_Y = 436 * MiB;
constexpr size_t WS_ACT = 472 * MiB;
constexpr size_t WS_YS = 622 * MiB;
constexpr size_t WS_WIN = 772 * MiB;
constexpr size_t WS_WOUT = 788 * MiB;
constexpr size_t WS_WGU = 792 * MiB;
constexpr size_t WS_WDN = 1048 * MiB;
constexpr size_t WS_MLC = 1176 * MiB;
constexpr size_t WS_MLN = 1246 * MiB;
constexpr size_t WS_MLS = 1247 * MiB;
constexpr size_t WS_HGS = 1248 * MiB;
constexpr size_t WS_HGG = 1388 * MiB;
constexpr size_t WS_MLCB = 1390 * MiB;
constexpr size_t WS_HGSB = 1426 * MiB;
constexpr size_t WS_END = 1496 * MiB;
constexpr int NTC = 132;
constexpr int RT_TOPI = 0;
constexpr int RT_TOPG = RT_TOPI + NTOK * 4;
constexpr int RT_POS = RT_TOPG + NTOK * 4;
constexpr int RT_SLOT = RT_POS + NTOK * 4;
constexpr int RT_LIST = RT_SLOT + NTOK * 4;
constexpr int RT_SGATE = RT_LIST + MAXSLOT;
constexpr int RT_TILEE = RT_SGATE + MAXSLOT;
constexpr int RT_BLKCNT = RT_TILEE + MAXTILE + 8;
constexpr int MAXG = 1024;
constexpr int RT_END = RT_BLKCNT + MAXG * 32;
static_assert((size_t)RT_END * 4 <= 4 * MiB, "route map");
constexpr int CW_CNT = 1024;
constexpr int CW_BAR = 4096;

typedef float f32x2_t __attribute__((ext_vector_type(2)));
typedef __bf16 bf16x2_t __attribute__((ext_vector_type(2)));
__device__ __forceinline__ unsigned pk2(float lo, float hi) { const f32x2_t v = {lo, hi}; return __builtin_bit_cast(unsigned, __builtin_convertvector(v, bf16x2_t)); }
__device__ __forceinline__ unsigned f2bf(float f) { return pk2(f, 0.f) & 0xffffu; }
__device__ __forceinline__ float bf2f(unsigned short b) { return __builtin_bit_cast(float, (unsigned)b << 16); }
__device__ __forceinline__ float bflo(unsigned w) { return __builtin_bit_cast(float, w << 16); }
__device__ __forceinline__ float bfhi(unsigned w) { return __builtin_bit_cast(float, w & 0xffff0000u); }
__device__ __forceinline__ float sigmoidf_(float x) { return 1.f / (1.f + __expf(-x)); }
__device__ __forceinline__ float siluf_(float x) { return x / (1.f + __expf(-x)); }
__device__ __forceinline__ float logsigmoidf_(float x) { return x >= 0.f ? -log1pf(__expf(-x)) : x - log1pf(__expf(x)); }
template <int CTRL, int ROWMASK, bool BOUND0>
__device__ __forceinline__ float dppf(float old, float x) { return __builtin_bit_cast(float, __builtin_amdgcn_update_dpp(__builtin_bit_cast(int, old), __builtin_bit_cast(int, x), CTRL, ROWMASK, 0xf, BOUND0)); }
__device__ __forceinline__ float half_sum_hi(float x) {
    x += dppf<0xB1, 0xf, true>(0.f, x); x += dppf<0x4E, 0xf, true>(0.f, x); x += dppf<0x114, 0xf, true>(0.f, x); x += dppf<0x118, 0xf, true>(0.f, x);
    x += dppf<0x142, 0xa, true>(0.f, x); return x; }
__device__ __forceinline__ float wave_sum(float v) {
    v = half_sum_hi(v); v += dppf<0x143, 0xc, true>(0.f, v); return __builtin_bit_cast(float, __builtin_amdgcn_readlane(__builtin_bit_cast(int, v), 63)); }
__device__ __forceinline__ float wave_incl_sum(float v, int) {
    v += dppf<0x111, 0xf, true>(0.f, v); v += dppf<0x112, 0xf, true>(0.f, v); v += dppf<0x114, 0xf, true>(0.f, v); v += dppf<0x118, 0xf, true>(0.f, v);
    v += dppf<0x142, 0xa, true>(0.f, v); v += dppf<0x143, 0xc, true>(0.f, v); return v; }
__device__ __forceinline__ float wave_incl_max(float v, int) {
    const float NI = -INFINITY;
    v = fmaxf(v, dppf<0x111, 0xf, false>(NI, v)); v = fmaxf(v, dppf<0x112, 0xf, false>(NI, v)); v = fmaxf(v, dppf<0x114, 0xf, false>(NI, v)); v = fmaxf(v, dppf<0x118, 0xf, false>(NI, v));
    v = fmaxf(v, dppf<0x142, 0xa, false>(NI, v)); v = fmaxf(v, dppf<0x143, 0xc, false>(NI, v)); return v; }
__device__ __forceinline__ float wave_max(float v) { v = wave_incl_max(v, 0); return __builtin_bit_cast(float, __builtin_amdgcn_readlane(__builtin_bit_cast(int, v), 63)); }
__device__ __forceinline__ int mrow_of(int r) { return r < NLAT ? (r >> 13) : 2; }

struct Args { const float* in[24]; float* out; unsigned char* ws; int ph_lo, ph_hi; };
typedef const __attribute__((address_space(4))) Args CArgs;

enum { I_X = 0, I_C, I_CTX, I_CCTX, I_WADA, I_BADA, I_N1G, I_WIN, I_MLCONV, I_MLGB, I_MLNG, I_HGCONV, I_HGFB, I_HGLB, I_HGNG, I_WOUT, I_N2G, I_RW, I_RB, I_WGU, I_BGU, I_WDN, I_BDN, I_FG };

constexpr int NWAVES = 8, NTHR = 512;
constexpr int LDS_BYTES = 147456;

struct Frame {
    LAS unsigned char* lds;
    float* out; unsigned char* ws;
    int tid, lane, wave, vcu, G;
};

__device__ __forceinline__ void ph_init(Frame& F, CArgs& A) {
    const int gt = F.vcu * NTHR + F.tid, NG = F.G * NTHR;
    if (gt < 128) ((u32x4*)(F.ws + WS_H + (size_t)NTOK * D * 2))[gt] = (u32x4){0u, 0u, 0u, 0u};
    LAS float* sc = (LAS float*)F.lds;
    LAS float* part = sc + 3 * 1024;
    for (int i = F.tid; i < 3 * 1024; i += NTHR) { const int r = i >> 10, k = i & 1023; const float c = r < 2 ? A.in[I_C][r * 1024 + k] : A.in[I_CCTX][k]; sc[i] = siluf_(c); }
    __syncthreads();
    for (int item = F.vcu; item < DEPTH * 96; item += F.G) {
        const int l = item / 96, j = (item % 96) * 64 + F.lane;
        const float* w = A.in[I_WADA] + (size_t)l * D * 6144 + j;
        float a0 = 0.f, a1 = 0.f, a2 = 0.f;
        for (int k0 = F.wave * 128; k0 < F.wave * 128 + 128; k0 += 32) { float wv[32];
#pragma unroll
            for (int i = 0; i < 32; ++i) wv[i] = w[(size_t)(k0 + i) * 6144];
#pragma unroll
            for (int i = 0; i < 32; ++i) { a0 += sc[k0 + i] * wv[i]; a1 += sc[1024 + k0 + i] * wv[i]; a2 += sc[2048 + k0 + i] * wv[i]; } }
        part[(F.wave * 3 + 0) * 64 + F.lane] = a0; part[(F.wave * 3 + 1) * 64 + F.lane] = a1; part[(F.wave * 3 + 2) * 64 + F.lane] = a2;
        __syncthreads();
        if (F.tid < 192) { const int r = F.tid >> 6, ln = F.tid & 63; float s = 0.f;
#pragma unroll
            for (int w8 = 0; w8 < 8; ++w8) s += part[(w8 * 3 + r) * 64 + ln];
            const int jj = (item % 96) * 64 + ln;
            ((float*)(F.ws + WS_MOD))[(l * 3 + r) * 6144 + jj] = s + A.in[I_BADA][l * 6144 + jj]; }
        __syncthreads();
    }
}

typedef unsigned u32x2v __attribute__((ext_vector_type(2)));
__device__ __forceinline__ float xor32(float send, int lane) { const unsigned u = __builtin_bit_cast(unsigned, send); const u32x2v r = __builtin_amdgcn_permlane32_swap(u, u, false, false);
    return __builtin_bit_cast(float, (lane & 32) ? r.x : r.y); }
__device__ __forceinline__ float xor16(float send, int lane) { const unsigned u = __builtin_bit_cast(unsigned, send); const u32x2v r = __builtin_amdgcn_permlane16_swap(u, u, false, false);
    return __builtin_bit_cast(float, (lane & 16) ? r.x : r.y); }
__device__ __forceinline__ float xor8(float x) { return dppf<0x140, 0xf, true>(0.f, dppf<0x141, 0xf, true>(0.f, x)); }
__device__ __forceinline__ float xor4(float x) { return dppf<0x141, 0xf, true>(0.f, dppf<0x1B, 0xf, true>(0.f, x)); }
__device__ __forceinline__ float xor2(float x) { return dppf<0x4E, 0xf, true>(0.f, x); }
__device__ __forceinline__ float xor1(float x) { return dppf<0xB1, 0xf, true>(0.f, x); }
template <int NV> __device__ __forceinline__ float reduce_scatter(float (&v)[NV], int lane) {
    float a16[16];
    if constexpr (NV == 32) { const bool hi = lane & 32;
#pragma unroll
        for (int i = 0; i < 16; ++i) { const float keep = hi ? v[16 + i] : v[i], send = hi ? v[i] : v[16 + i]; a16[i] = keep + xor32(send, lane); } }
    else {
#pragma unroll
        for (int i = 0; i < 16; ++i) a16[i] = v[i] + xor1(v[i]); }
    float a8[8], a4[4], a2[2];
    { const bool hi = lane & 16;
#pragma unroll
      for (int i = 0; i < 8; ++i) { const float keep = hi ? a16[8 + i] : a16[i], send = hi ? a16[i] : a16[8 + i]; a8[i] = keep + xor16(send, lane); } }
    { const bool hi = lane & 8;
#pragma unroll
      for (int i = 0; i < 4; ++i) { const float keep = hi ? a8[4 + i] : a8[i], send = hi ? a8[i] : a8[4 + i]; a4[i] = keep + xor8(send); } }
    { const bool hi = lane & 4;
#pragma unroll
      for (int i = 0; i < 2; ++i) { const float keep = hi ? a4[2 + i] : a4[i], send = hi ? a4[i] : a4[2 + i]; a2[i] = keep + xor4(send); } }
    float r;
    { const bool hi = lane & 2; const float keep = hi ? a2[1] : a2[0], send = hi ? a2[0] : a2[1]; r = keep + xor2(send); }
    if constexpr (NV == 32) r += xor1(r); else r += xor32(r, lane);
    return r;
}
struct RowIn { f32x4 x[4]; u32x2 y[4][4]; };
template <int SRC>
__device__ __forceinline__ void row_load(Frame& F, CArgs& A, int r, const int (&slot)[4], RowIn& R) {
    const float* src = SRC == 1 ? (r < NLAT ? A.in[I_X] + (size_t)r * D : A.in[I_CTX] + (size_t)(r - NLAT) * D) : (const float*)(F.ws + WS_X) + (size_t)r * D;
    const f32x4* xr = (const f32x4*)src + F.lane;
#pragma unroll
    for (int j = 0; j < 4; ++j) R.x[j] = xr[64 * j];
    if (SRC == 2) {
#pragma unroll
        for (int k = 0; k < 4; ++k) { const u32x2* yp = (const u32x2*)(F.ws + WS_YS + (size_t)slot[k] * D * 2) + F.lane;
#pragma unroll
            for (int j = 0; j < 4; ++j) R.y[k][j] = yp[64 * j]; } }
}
#define LDS_BARRIER() do { asm volatile("s_waitcnt lgkmcnt(0)" ::: "memory"); __builtin_amdgcn_s_barrier(); asm volatile("" ::: "memory"); } while (0)
template <int SRC, int MODE>
__device__ __forceinline__ void ph_rows(Frame& F, CArgs& A, int lsrc, int l, int nrows) {
    constexpr int NV = MODE == 0 ? 16 : 32;
    constexpr int EPW = NV / 8;
    f32x2_t wp[EPW][4][2];
    LAS unsigned* lcnt = (LAS unsigned*)(F.lds + 131072);
    if (MODE == 1) { const float* w = A.in[I_RW] + (size_t)l * D * NEXP + 4 * F.wave; if (F.tid < 32) lcnt[F.tid] = 0u;
#pragma unroll
        for (int j = 0; j < 4; ++j) { f32x4 q[4];
#pragma unroll
            for (int i = 0; i < 4; ++i) q[i] = *(const f32x4*)(w + (size_t)(256 * j + 4 * F.lane + i) * NEXP);
#pragma unroll
            for (int e = 0; e < EPW; ++e) { wp[e][j][0] = (f32x2_t){q[0][e], q[1][e]}; wp[e][j][1] = (f32x2_t){q[2][e], q[3][e]}; } } }
    if (MODE == 0) { const float* w = A.in[I_WIN] + (size_t)l * D * INW + 1536 + 2 * F.wave;
#pragma unroll
        for (int j = 0; j < 4; ++j) { f32x2_t q[4];
#pragma unroll
            for (int i = 0; i < 4; ++i) q[i] = *(const f32x2_t*)(w + (size_t)(256 * j + 4 * F.lane + i) * INW);
#pragma unroll
            for (int e = 0; e < EPW; ++e) { wp[e][j][0] = (f32x2_t){q[0][e], q[1][e]}; wp[e][j][1] = (f32x2_t){q[2][e], q[3][e]}; } } }
    const float* gam = MODE == 0 ? A.in[I_N1G] + l * D : (MODE == 1 ? A.in[I_N2G] + l * D : A.in[I_FG]);
    const float* MOD = (const float*)(F.ws + WS_MOD) + (size_t)l * 3 * 6144;
    const float* MODS = (const float*)(F.ws + WS_MOD) + (size_t)lsrc * 3 * 6144;
    const int* rt = (const int*)(F.ws + WS_ROUTE);
    const int stride = F.G * NWAVES; int r = F.vcu * NWAVES + F.wave;
    RowIn cur; int s1[4] = {0, 0, 0, 0}, s2[4] = {0, 0, 0, 0};
    if (SRC == 2) { if (r < nrows) { const u32x4 q = *(const u32x4*)(rt + RT_SLOT + r * 4); s1[0] = q.x; s1[1] = q.y; s1[2] = q.z; s1[3] = q.w; }
                    if (r + stride < nrows) { const u32x4 q = *(const u32x4*)(rt + RT_SLOT + (r + stride) * 4); s2[0] = q.x; s2[1] = q.y; s2[2] = q.z; s2[3] = q.w; } }
    if (r < nrows) row_load<SRC>(F, A, r, s1, cur);
    f32x4 Aq[4], Sq[4], Gq[4]; int mrp = -1;
    const float rbm = MODE == 1 ? A.in[I_RB][l * NEXP + 4 * F.wave + ((F.lane >> 1) & 3)] : 0.f;
    for (; r < nrows; r += stride) {
        RowIn nxt; int s3[4] = {0, 0, 0, 0};
        { const int mr = mrow_of(r);
          if (mr != mrp) { mrp = mr; const float* mod = MOD + mr * 6144 + (MODE == 0 ? 0 : 3072); const float* g2 = MODS + mr * 6144 + 5 * 1024;
#pragma unroll
              for (int j = 0; j < 4; ++j) { const int c = 256 * j + 4 * F.lane; const f32x4 g = *(const f32x4*)(gam + c);
                  if (MODE != 2) { const f32x4 sh = *(const f32x4*)(mod + c), scl = *(const f32x4*)(mod + 1024 + c); Aq[j] = g * (1.f + scl); Sq[j] = sh; } else { Aq[j] = g; Sq[j] = (f32x4){0.f, 0.f, 0.f, 0.f}; }
                  if (SRC == 2) Gq[j] = *(const f32x4*)(g2 + c); } } }
        if (SRC == 2 && r + 2 * stride < nrows) { const u32x4 q = *(const u32x4*)(rt + RT_SLOT + (r + 2 * stride) * 4); s3[0] = q.x; s3[1] = q.y; s3[2] = q.z; s3[3] = q.w; }
        if (r + stride < nrows) row_load<SRC>(F, A, r + stride, s2, nxt);
        f32x4 v[4];
#pragma unroll
        for (int j = 0; j < 4; ++j) v[j] = cur.x[j];
        if (SRC == 2) {
#pragma unroll
            for (int j = 0; j < 4; ++j) { f32x4 a = (f32x4){0.f, 0.f, 0.f, 0.f};
#pragma unroll
                for (int k = 0; k < 4; ++k) { const u32x2 w = cur.y[k][j]; a += (f32x4){bflo(w.x), bfhi(w.x), bflo(w.y), bfhi(w.y)}; }
                v[j] = v[j] + Gq[j] * a; } }
        if (SRC == 2 && MODE != 2) { f32x4* xo = (f32x4*)((float*)(F.ws + WS_X) + (size_t)r * D) + F.lane;
#pragma unroll
            for (int j = 0; j < 4; ++j) xo[64 * j] = v[j]; }
        float ss = 0.f;
#pragma unroll
        for (int j = 0; j < 4; ++j) ss += (v[j].x * v[j].x + v[j].y * v[j].y) + (v[j].z * v[j].z + v[j].w * v[j].w);
        const float rstd = rsqrtf(wave_sum(ss) * (1.f / D) + EPS);
#pragma unroll
        for (int j = 0; j < 4; ++j) { v[j] = v[j] * rstd * Aq[j]; if (MODE != 2) v[j] = v[j] + Sq[j]; }
        if (MODE == 2) { f32x4* o = (f32x4*)(F.out + (size_t)r * D) + F.lane;
#pragma unroll
            for (int j = 0; j < 4; ++j) o[64 * j] = v[j]; }
        else {
            u32x2* ho = (u32x2*)(F.ws + WS_H + (size_t)r * D * 2) + F.lane;
#pragma unroll
            for (int j = 0; j < 4; ++j) ho[64 * j] = (u32x2){pk2(v[j].x, v[j].y), pk2(v[j].z, v[j].w)};
            LAS f32x4* hb = (LAS f32x4*)F.lds;
            LAS float* lg = (LAS float*)(F.lds + 32768);
#pragma unroll
            for (int j = 0; j < 4; ++j) hb[(F.wave * 4 + j) * 64 + F.lane] = v[j];
            LDS_BARRIER();
            float part[NV];
#pragma unroll
            for (int q = 0; q < 8; ++q) { f32x4 hq[4];
#pragma unroll
                for (int j = 0; j < 4; ++j) hq[j] = hb[(q * 4 + j) * 64 + F.lane];
#pragma unroll
                for (int e = 0; e < EPW; ++e) { f32x2_t a2 = {0.f, 0.f};
#pragma unroll
                    for (int j = 0; j < 4; ++j) { a2 += (f32x2_t){hq[j].x, hq[j].y} * wp[e][j][0]; a2 += (f32x2_t){hq[j].z, hq[j].w} * wp[e][j][1]; }
                    part[q * EPW + e] = a2.x + a2.y; } }
            const float mine = reduce_scatter<NV>(part, F.lane);
            if (MODE == 0) { const int g = (F.lane >> 1) & 15; if ((F.lane & 33) == 0) lg[(g >> 1) * 16 + 2 * F.wave + (g & 1)] = mine; }
            else { const int g = (F.lane >> 1) & 31; if ((F.lane & 1) == 0) lg[(g >> 2) * 32 + 4 * F.wave + (g & 3)] = mine + rbm; }
            LDS_BARRIER();
            if (MODE == 0) {
                if (F.lane < 16) { const int g = F.lane; float val = lg[F.wave * 16 + g] + A.in[I_MLGB][l * 16 + g];
                    if (g >= 8) val = logsigmoidf_(val);
                    ((float*)(F.ws + WS_GATES))[(size_t)r * 16 + g] = val; }
            } else {
                const int e = F.lane & 31; const float my = lg[F.wave * 32 + e]; int rank = 0;
#pragma unroll
                for (int q = 0; q < 8; ++q) { const f32x4 t = *(const LAS f32x4*)(lg + F.wave * 32 + 4 * q);
#pragma unroll
                    for (int c = 0; c < 4; ++c) { const int j = 4 * q + c; rank += (t[c] > my || (t[c] == my && j < e)) ? 1 : 0; } }
                float tv[4]; int ti[4];
#pragma unroll
                for (int p = 0; p < 4; ++p) { const unsigned bal = (unsigned)__ballot(rank == p); const int bi = __ffs((int)bal) - 1;
                    ti[p] = bi; tv[p] = __builtin_bit_cast(float, __builtin_amdgcn_readlane(__builtin_bit_cast(int, my), bi)); }
                const float e1 = __expf(tv[1] - tv[0]), e2 = __expf(tv[2] - tv[0]), e3 = __expf(tv[3] - tv[0]); const float inv = 1.f / (1.f + e1 + e2 + e3);
                if (F.lane < 4) {
                    int* rtw = (int*)(F.ws + WS_ROUTE); const int p = F.lane;
                    const int tip = p == 0 ? ti[0] : (p == 1 ? ti[1] : (p == 2 ? ti[2] : ti[3]));
                    const float gp = (p == 0 ? 1.f : (p == 1 ? e1 : (p == 2 ? e2 : e3))) * inv;
                    rtw[RT_TOPI + r * 4 + p] = tip; ((float*)rtw)[RT_TOPG + r * 4 + p] = gp; rtw[RT_POS + r * 4 + p] = (int)__hip_atomic_fetch_add(lcnt + tip, 1u, __ATOMIC_RELAXED, __HIP_MEMORY_SCOPE_WORKGROUP);
                }
            }
        }
        cur = nxt;
#pragma unroll
        for (int k = 0; k < 4; ++k) { s2[k] = s3[k]; }
    }
    if (MODE == 1) { __syncthreads(); if (F.tid < 32) ((int*)(F.ws + WS_ROUTE))[RT_BLKCNT + F.vcu * 32 + F.tid] = (int)lcnt[F.tid]; }
}

__device__ __forceinline__ void ph_lists(Frame& F, CArgs& A, int l, int nrows) {
    LAS int* off = (LAS int*)F.lds;
    LAS int* pre = (LAS int*)(F.lds + 1024);
    int* rt = (int*)(F.ws + WS_ROUTE);
    { LAS int* gsum = (LAS int*)(F.lds + 1024 + 65536);
      const int e = F.tid & 31, grp = F.tid >> 5, per = (F.G + 15) >> 4, v0 = grp * per, v1 = min(v0 + per, F.G);
      int run = 0;
      for (int vb = v0; vb < v1; vb += 16) { int c[16];
#pragma unroll
          for (int i = 0; i < 16; ++i) c[i] = vb + i < v1 ? rt[RT_BLKCNT + (vb + i) * 32 + e] : 0;
#pragma unroll
          for (int i = 0; i < 16; ++i) { if (vb + i < v1) pre[(vb + i) * 32 + e] = run; run += c[i]; } }
      gsum[grp * 32 + e] = run;
      __syncthreads();
      int base = 0, tot = 0;
#pragma unroll
      for (int g = 0; g < 16; ++g) { const int t = gsum[g * 32 + e]; base += g < grp ? t : 0; tot += t; }
      for (int v = v0; v < v1; ++v) pre[v * 32 + e] += base;
      if (grp == 0) off[64 + e] = tot; }
    __syncthreads();
    if (F.wave == 0) { const int pc = F.lane < 32 ? (off[64 + F.lane] + 255) & ~255 : 0;
        const int inc = (int)wave_incl_sum((float)(pc >> 8), F.lane) << 8;
        if (F.lane < 32) off[F.lane] = inc - pc; if (F.lane == 31) off[32] = inc; }
    __syncthreads();
    const int gt = F.vcu * NTHR + F.tid, NG = F.G * NTHR;
    for (int i = gt; i < nrows * 4; i += NG) { const int r = i >> 2, e = rt[RT_TOPI + i], v = (r % (F.G * NWAVES)) / NWAVES, s = off[e] + pre[v * 32 + e] + rt[RT_POS + i];
        rt[RT_SLOT + i] = s; rt[RT_LIST + s] = r; ((float*)rt)[RT_SGATE + s] = ((const float*)rt)[RT_TOPG + i]; }
    const int total = off[32];
    for (int s = gt; s < total; s += NG) { int e = 0;
#pragma unroll 1
        for (int q = 1; q < NEXP; ++q) if (s >= off[q]) e = q;
        if (s - off[e] >= off[64 + e]) { rt[RT_LIST + s] = NTOK; ((float*)rt)[RT_SGATE + s] = 0.f; }
        if ((s & 255) == 0) rt[RT_TILEE + 8 + (s >> 8)] = e; }
    if (gt == 0) rt[RT_TILEE] = total >> 8;
}

__device__ __forceinline__ void ph_conv(Frame& F, CArgs& A, int l) {
    LAS float* cw = (LAS float*)F.lds;
    { const f32x4* wm = (const f32x4*)(A.in[I_MLCONV] + (size_t)l * 9 * 512); const f32x4* wh = (const f32x4*)(A.in[I_HGCONV] + (size_t)l * 9 * 1024);
      f32x4 vm[3], vh[5];
#pragma unroll
      for (int j = 0; j < 3; ++j) { const int i = F.tid + NTHR * j; vm[j] = i < 9 * 128 ? wm[i] : (f32x4){0.f, 0.f, 0.f, 0.f}; }
#pragma unroll
      for (int j = 0; j < 5; ++j) { const int i = F.tid + NTHR * j; vh[j] = i < 9 * 256 ? wh[i] : (f32x4){0.f, 0.f, 0.f, 0.f}; }
#pragma unroll
      for (int j = 0; j < 3; ++j) { const int i = F.tid + NTHR * j; if (i < 9 * 128) *(LAS f32x4*)(cw + (i / 128) * 1536 + (i % 128) * 4) = vm[j]; }
#pragma unroll
      for (int j = 0; j < 5; ++j) { const int i = F.tid + NTHR * j; if (i < 9 * 256) *(LAS f32x4*)(cw + (i / 256) * 1536 + 512 + (i % 256) * 4) = vh[j]; } }
    __syncthreads();
    const bf16* P = (const bf16*)(F.ws + WS_P);
    const int gt = F.vcu * NTHR + F.tid, NG = F.G * NTHR;
    constexpr int NLATQ = BATCH * 128 * 16, NQ = NLATQ + BATCH * 64;
    for (int it = gt; it < NQ * 192; it += NG) {
        const int qd = it / 192, cg = it % 192, c = cg * 8, pc = c < 512 ? PC_QK + c : PC_QI + (c - 512);
        int base, row, x0, nrow, ncol;
        if (qd < NLATQ) { const int b = qd >> 11, y = (qd >> 4) & 127, xq = qd & 15; base = b << 13; row = y; x0 = xq * 4; nrow = 128; ncol = 64; }
        else { const int q = qd - NLATQ, b = q >> 6; base = NLAT + (b << 8); row = 0; x0 = (q & 63) * 4; nrow = 1; ncol = 256; }
        const int r0 = base + row * ncol + x0;
        u32x4 tap[3][6];
#pragma unroll
        for (int dy = 0; dy < 3; ++dy)
#pragma unroll
            for (int j = 0; j < 6; ++j) { const int rr = row + dy - 1, cc = x0 + j - 1; const bool v = rr >= 0 && rr < nrow && cc >= 0 && cc < ncol;
                const u32x4 t = *(const u32x4*)(P + (size_t)(v ? base + rr * ncol + cc : r0) * PW + pc);
                tap[dy][j] = v ? t : (u32x4){0u, 0u, 0u, 0u}; }
        f32x2_t a2[4][4];
#pragma unroll
        for (int o = 0; o < 4; ++o)
#pragma unroll
            for (int i = 0; i < 4; ++i) a2[o][i] = (f32x2_t){0.f, 0.f};
#pragma unroll
        for (int dy = 0; dy < 3; ++dy)
#pragma unroll
            for (int dx = 0; dx < 3; ++dx) { const LAS float* w = cw + (dy * 3 + dx) * 1536 + c; const f32x4 w0 = *(const LAS f32x4*)w, w1 = *(const LAS f32x4*)(w + 4);
                const f32x2_t wa = {w0.x, w0.y}, wb = {w0.z, w0.w}, wc = {w1.x, w1.y}, wd = {w1.z, w1.w};
#pragma unroll
                for (int o = 0; o < 4; ++o) { const u32x4 pv = tap[dy][o + dx];
                    a2[o][0] += (f32x2_t){bflo(pv.x), bfhi(pv.x)} * wa; a2[o][1] += (f32x2_t){bflo(pv.y), bfhi(pv.y)} * wb;
                    a2[o][2] += (f32x2_t){bflo(pv.z), bfhi(pv.z)} * wc; a2[o][3] += (f32x2_t){bflo(pv.w), bfhi(pv.w)} * wd; } }
        const float sc = c < 256 ? 0.125f : 1.f;
#pragma unroll
        for (int o = 0; o < 4; ++o) { unsigned ow[4];
#pragma unroll
            for (int i = 0; i < 4; ++i) { const f32x2_t x = a2[o][i], t = x * (-1.44269504f), dn = (f32x2_t){__builtin_amdgcn_exp2f(t.x), __builtin_amdgcn_exp2f(t.y)} + 1.f;
                const f32x2_t y = (x * sc) * (f32x2_t){__builtin_amdgcn_rcpf(dn.x), __builtin_amdgcn_rcpf(dn.y)}; ow[i] = pk2(y.x, y.y); }
            const u32x4 ov = (u32x4){ow[0], ow[1], ow[2], ow[3]};
            if (c < 512) *(u32x4*)(F.ws + WS_CQK + ((size_t)(r0 + o) * 512 + c) * 2) = ov; else *(u32x4*)(F.ws + WS_CQI + ((size_t)(r0 + o) * 1024 + (c - 512)) * 2) = ov; }
    }
}

struct HnIn { f32x4 h[4]; u32x2 g[4]; };
__device__ __forceinline__ void hn_load(Frame& F, int r, HnIn& R) {
    const float* HF = (const float*)(F.ws + WS_HF); const bf16* P = (const bf16*)(F.ws + WS_P);
#pragma unroll
    for (int j = 0; j < 4; ++j) { const int c = 256 * j + 4 * F.lane; R.h[j] = *(const f32x4*)(HF + (size_t)r * D + c); R.g[j] = *(const u32x2*)(P + (size_t)r * PW + (c < 512 ? PC_O + c : PC_GO + (c - 512))); }
}
__device__ __forceinline__ void ph_hnorm(Frame& F, CArgs& A, int l, int nrows_lat_only) {
    const int nrows = nrows_lat_only ? NLAT : NTOK, stride = F.G * NWAVES;
    int r = F.vcu * NWAVES + F.wave; HnIn cur; if (r < nrows) hn_load(F, r, cur);
    for (; r < nrows; r += stride) {
        HnIn nxt; if (r + stride < nrows) hn_load(F, r + stride, nxt); else nxt = cur;
        u32x2* yo = (u32x2*)(F.ws + WS_Y + (size_t)r * D * 2) + F.lane;
#pragma unroll
        for (int j = 0; j < 4; ++j) {
            const int c = 256 * j + 4 * F.lane;
            f32x4 h = cur.h[j];
            float ss = (h.x * h.x + h.y * h.y) + (h.z * h.z + h.w * h.w);
#pragma unroll
            for (int o = 1; o < 32; o <<= 1) ss += __shfl_xor(ss, o);
            const float rstd = rsqrtf(ss * (1.f / 128.f) + EPS);
            const f32x4 g = c < 512 ? *(const f32x4*)(A.in[I_MLNG] + l * 512 + c) : *(const f32x4*)(A.in[I_HGNG] + l * 512 + (c - 512));
            const u32x2 gw = cur.g[j];
            float ga[4] = {bflo(gw.x), bfhi(gw.x), bflo(gw.y), bfhi(gw.y)};
#pragma unroll
            for (int i = 0; i < 4; ++i) ga[i] = c < 512 ? sigmoidf_(ga[i]) : siluf_(ga[i]);
            h = h * rstd * g;
            yo[64 * j] = (u32x2){pk2(h.x * ga[0], h.y * ga[1]), pk2(h.z * ga[2], h.w * ga[3])};
        }
        cur = nxt;
    }
}

namespace pg8 {
typedef short bf16x8 __attribute__((ext_vector_type(8)));
constexpr int BM = 256, BK = 64, HALF = 128, HTB = HALF * BK * 2, STAGE_BYTES = 8 * HTB, NXCD = 8, WGM = 8;
__device__ __forceinline__ int lds_byte(int r, int c) { const int st = (r >> 4) * 2 + (c >> 5), rr = r & 15, cc = c & 31, ob = rr * 64 + cc * 2; return st * 1024 + (ob ^ (((ob >> 9) & 1) << 5)); }
__device__ __forceinline__ void stage_rc(int b, int& R, int& C) { const int st = b / 1024, sb = b % 1024, swz = sb ^ (((sb >> 9) & 1) << 5); R = (st >> 1) * 16 + swz / 64; C = (st & 1) * 32 + (swz % 64) / 2; }
__device__ __forceinline__ int perm32(int rho) { const int n = rho >> 4, i = rho & 15; return 8 * (i >> 2) + 4 * n + (i & 3); }
struct Unit { int pm, pn, e; };
struct Gemm { const bf16* A; const bf16* Bt; int K; const int* gather; const int* tile_e; size_t bexp;   };
struct StaticOrder {
    int nM, nN, nwg, G, c;
    __device__ void init(int nM_, int nN_, int G_, int c_) { nM = nM_; nN = nN_; nwg = nM * nN; G = G_; c = c_; }
    __device__ bool next(int i, Unit& u) const {
        const long L = (long)i * G + c; if (L >= nwg) return false;
        int wgid = (int)L; { const int q = nwg / NXCD, r = nwg % NXCD, xcd = wgid % NXCD, off = wgid / NXCD; wgid = (xcd < r ? xcd * (q + 1) : r * (q + 1) + (xcd - r) * q) + off; }
        const int nig = WGM * nN, gid = wgid / nig, fm = gid * WGM, gsz = (nM - fm) < WGM ? (nM - fm) : WGM;
        u.pm = fm + ((wgid % nig) % gsz); u.pn = (wgid % nig) / gsz; u.e = 0; return true;
    }
};
__device__ __forceinline__ unsigned cvt_pk_bf16(float lo, float hi) { unsigned r; asm volatile("v_cvt_pk_bf16_f32 %0, %1, %2" : "=v"(r) : "v"(lo), "v"(hi)); return r; }

struct EpiBf16 {
    static constexpr bool PERM = true;
    bf16* O; int ldc;
    __device__ __forceinline__ void operator()(const f32x4 (&acc)[2][2][4][2], const Unit& u, int wr, int wc, int fr, int fq) const {
        const int row0 = u.pm * BM + wr * 64 + fr, col0 = u.pn * BM + wc * 32 + 8 * fq;
#pragma unroll
        for (int ai = 0; ai < 2; ++ai)
#pragma unroll
            for (int m = 0; m < 4; ++m) { bf16* rowp = O + (size_t)(row0 + ai * HALF + m * 16) * ldc + col0;
#pragma unroll
                for (int bj = 0; bj < 2; ++bj) { const f32x4 v0 = acc[ai][bj][m][0], v1 = acc[ai][bj][m][1];
                    u32x4 w; w.x = cvt_pk_bf16(v0[0], v0[1]); w.y = cvt_pk_bf16(v0[2], v0[3]); w.z = cvt_pk_bf16(v1[0], v1[1]); w.w = cvt_pk_bf16(v1[2], v1[3]);
                    *(u32x4*)(rowp + bj * HALF) = w; } }
    }
};
struct EpiResid {
    static constexpr bool PERM = false;
    float* X; const float* MODg; const float* Slat; const float* Sctx;
    __device__ __forceinline__ void operator()(const f32x4 (&acc)[2][2][4][2], const Unit& u, int wr, int wc, int fr, int fq) const {
        const int row0 = u.pm * BM + wr * 64 + fr, col0 = u.pn * BM + wc * 32 + 4 * fq;
        const float* gp = MODg + mrow_of(u.pm * BM) * 6144 + col0;
        f32x4 gv[2][2];
#pragma unroll
        for (int bj = 0; bj < 2; ++bj)
#pragma unroll
            for (int n = 0; n < 2; ++n) gv[bj][n] = *(const f32x4*)(gp + bj * HALF + n * 16);
#pragma unroll
        for (int ai = 0; ai < 2; ++ai) {
            f32x4 xv[4][2][2];
#pragma unroll
            for (int m = 0; m < 4; ++m) { const int rr = row0 + ai * HALF + m * 16; const float* rowp = (rr < NLAT ? Slat + (size_t)rr * D : Sctx + (size_t)(rr - NLAT) * D) + col0;
#pragma unroll
                for (int bj = 0; bj < 2; ++bj)
#pragma unroll
                    for (int n = 0; n < 2; ++n) xv[m][bj][n] = *(const f32x4*)(rowp + bj * HALF + n * 16); }
#pragma unroll
            for (int m = 0; m < 4; ++m) { float* rowp = X + (size_t)(row0 + ai * HALF + m * 16) * D + col0;
#pragma unroll
                for (int bj = 0; bj < 2; ++bj)
#pragma unroll
                    for (int n = 0; n < 2; ++n) *(f32x4*)(rowp + bj * HALF + n * 16) = xv[m][bj][n] + gv[bj][n] * acc[ai][bj][m][n]; } }
    }
};
struct EpiSwiglu {
    static constexpr bool PERM = true;
    bf16* ACT; const float* bgu; const int* tile_e;
    __device__ __forceinline__ void operator()(const f32x4 (&acc)[2][2][4][2], const Unit& u, int wr, int wc, int fr, int fq) const {
        const int e = u.e;
        const int row0 = u.pm * BM + wr * 64 + fr, col0 = u.pn * HALF + wc * 32 + 8 * fq;
        const float* bp = bgu + (size_t)e * 2048 + col0;
        const f32x4 bg0 = *(const f32x4*)bp, bg1 = *(const f32x4*)(bp + 4), bl0 = *(const f32x4*)(bp + 1024), bl1 = *(const f32x4*)(bp + 1028);
#pragma unroll
        for (int ai = 0; ai < 2; ++ai)
#pragma unroll
            for (int m = 0; m < 4; ++m) {
                f32x4 g0 = acc[ai][0][m][0] + bg0, g1 = acc[ai][0][m][1] + bg1, l0 = acc[ai][1][m][0] + bl0, l1 = acc[ai][1][m][1] + bl1; float o[8];
#pragma unroll
                for (int i = 0; i < 4; ++i) { g0[i] = fminf(g0[i], 7.f); g1[i] = fminf(g1[i], 7.f); l0[i] = fminf(fmaxf(l0[i], -7.f), 7.f); l1[i] = fminf(fmaxf(l1[i], -7.f), 7.f); }
                const f32x4 t0 = g0 * (-1.702f * 1.44269504f), t1 = g1 * (-1.702f * 1.44269504f);
                f32x4 e0, e1;
#pragma unroll
                for (int i = 0; i < 4; ++i) { e0[i] = __builtin_amdgcn_exp2f(t0[i]); e1[i] = __builtin_amdgcn_exp2f(t1[i]); }
                e0 = e0 + 1.f; e1 = e1 + 1.f;
#pragma unroll
                for (int i = 0; i < 4; ++i) { e0[i] = __builtin_amdgcn_rcpf(e0[i]); e1[i] = __builtin_amdgcn_rcpf(e1[i]); }
                const f32x4 r0 = (g0 * e0) * (l0 + 1.f), r1 = (g1 * e1) * (l1 + 1.f);
#pragma unroll
                for (int i = 0; i < 4; ++i) { o[i] = r0[i]; o[4 + i] = r1[i]; }
                u32x4 w; w.x = cvt_pk_bf16(o[0], o[1]); w.y = cvt_pk_bf16(o[2], o[3]); w.z = cvt_pk_bf16(o[4], o[5]); w.w = cvt_pk_bf16(o[6], o[7]);
                *(u32x4*)(ACT + (size_t)(row0 + ai * HALF + m * 16) * DEXP + col0) = w; }
    }
};
struct EpiDown {
    static constexpr bool PERM = true;
    bf16* YS; const float* bdn; const float* sgate; const int* tile_e;
    __device__ __forceinline__ void operator()(const f32x4 (&acc)[2][2][4][2], const Unit& u, int wr, int wc, int fr, int fq) const {
        const int e = u.e;
        const int row0 = u.pm * BM + wr * 64 + fr, col0 = u.pn * BM + wc * 32 + 8 * fq;
        f32x4 bv[2][2];
#pragma unroll
        for (int bj = 0; bj < 2; ++bj)
#pragma unroll
            for (int n = 0; n < 2; ++n) bv[bj][n] = *(const f32x4*)(bdn + (size_t)e * D + col0 + bj * HALF + 4 * n);
#pragma unroll
        for (int ai = 0; ai < 2; ++ai)
#pragma unroll
            for (int m = 0; m < 4; ++m) { const int row = row0 + ai * HALF + m * 16; const float sg = sgate[row]; bf16* rowp = YS + (size_t)row * D + col0;
#pragma unroll
                for (int bj = 0; bj < 2; ++bj) { const f32x4 v0 = (acc[ai][bj][m][0] + bv[bj][0]) * sg, v1 = (acc[ai][bj][m][1] + bv[bj][1]) * sg;
                    u32x4 w; w.x = cvt_pk_bf16(v0[0], v0[1]); w.y = cvt_pk_bf16(v0[2], v0[3]); w.z = cvt_pk_bf16(v1[0], v1[1]); w.w = cvt_pk_bf16(v1[2], v1[3]);
                    *(u32x4*)(rowp + bj * HALF) = w; } }
    }
};

template <class Epi, class Sched, bool ALIGN_EPI>
__device__ __forceinline__ void gemm_phase(LAS unsigned char* lds, const Gemm g, const Sched& S, const Epi& E, const int tid) {
    const int wid = __builtin_amdgcn_readfirstlane(tid >> 6), lane = tid & 63, wr = wid >> 2, wc = wid & 3, fr = lane & 15, fq = lane >> 4;
    const int K = g.K, nt = K / BK;
    int RA[2]; unsigned cbA[2], voffB[2];
#pragma unroll
    for (int i = 0; i < 2; ++i) { int R, C; stage_rc(tid * 16 + i * 8192, R, C); const int Rb = Epi::PERM ? ((R & ~31) + perm32(R & 31)) : R;
        RA[i] = R; cbA[i] = (unsigned)C * 2u; voffB[i] = (unsigned)(Rb * K + C) * 2u; }
    const size_t kstep = (size_t)(BK * 2);
    const size_t hstep = (size_t)HALF * K * 2;
    const size_t tstep = 2 * hstep;
    const unsigned ldsw = (unsigned)wid * 1024u;
    const int aoff = lds_byte(wr * 64 + fr, fq * 8), boff = lds_byte(wc * 32 + fr, fq * 8);
#define PG8_SA(b, h) (((b) * 2 + (h)) * HTB)
#define PG8_SB(b, h) ((4 + (b) * 2 + (h)) * HTB)
#define PG8_STAGE(bufoff, gbase, voff) do { _Pragma("unroll") for (int _i = 0; _i < 2; ++_i) \
        __builtin_amdgcn_global_load_lds((const unsigned*)((const char*)(gbase) + (voff)[_i]), (LAS unsigned*)(lds + (bufoff) + ldsw + _i * 8192), 16, 0, 0); } while (0)
#define PG8_LDA(dst, b, h) do { _Pragma("unroll") for (int m = 0; m < 4; ++m) _Pragma("unroll") for (int k = 0; k < 2; ++k) dst[m][k] = *(const LAS bf16x8*)(lds + PG8_SA(b, h) + aoff + m * 2048 + k * 1024); } while (0)
#define PG8_LDB(dst, b, h) do { _Pragma("unroll") for (int n = 0; n < 2; ++n) _Pragma("unroll") for (int k = 0; k < 2; ++k) dst[n][k] = *(const LAS bf16x8*)(lds + PG8_SB(b, h) + boff + n * 2048 + k * 1024); } while (0)
#define PG8_MMA(ai, bj, At, Bt) do { __builtin_amdgcn_s_setprio(1); _Pragma("unroll") for (int m = 0; m < 4; ++m) _Pragma("unroll") for (int n = 0; n < 2; ++n) _Pragma("unroll") for (int k = 0; k < 2; ++k) \
        acc[ai][bj][m][n] = __builtin_amdgcn_mfma_f32_16x16x32_bf16(Bt[n][k], At[m][k], acc[ai][bj][m][n], 0, 0, 0); __builtin_amdgcn_s_setprio(0); } while (0)
#define PG8_WAIT_V(n) asm volatile("s_waitcnt vmcnt(" #n ")" ::: "memory")
#define PG8_WAIT_L(n) asm volatile("s_waitcnt lgkmcnt(" #n ")" ::: "memory")
#define PG8_BAR __builtin_amdgcn_s_barrier()
#define PG8_SCHED __builtin_amdgcn_sched_barrier(0)
#define PG8_AOFF(va, u) do { _Pragma("unroll") for (int _h = 0; _h < 2; ++_h) _Pragma("unroll") for (int _i = 0; _i < 2; ++_i) { const int _r = (u).pm * BM + _h * HALF + RA[_i]; \
        const int _row = g.gather ? g.gather[_r] : _r; va[_h][_i] = (unsigned)_row * (unsigned)(K * 2) + cbA[_i]; } } while (0)
#define PG8_BBASE(u) ((u).e = g.tile_e ? g.tile_e[8 + (u).pm] : 0, (const char*)g.Bt + (size_t)(u).e * g.bexp * 2 + (size_t)(u).pn * tstep)
    Unit cur, nxt; int ui = 0;
    if (!S.next(0, cur)) return;
    f32x4 acc[2][2][4][2];
#pragma unroll
    for (int a = 0; a < 2; ++a)
#pragma unroll
        for (int b = 0; b < 2; ++b)
#pragma unroll
            for (int m = 0; m < 4; ++m)
#pragma unroll
                for (int n = 0; n < 2; ++n) acc[a][b][m][n] = (f32x4){0.f, 0.f, 0.f, 0.f};
    bf16x8 At[4][2], B0[2][2], B1[2][2];
    const char* Ab = (const char*)g.A;
    unsigned cva[2][2], nva[2][2];
    PG8_AOFF(cva, cur);
    const char* cB = PG8_BBASE(cur);
    PG8_STAGE(PG8_SB(0, 0), cB, voffB); PG8_STAGE(PG8_SB(0, 1), cB + hstep, voffB); PG8_STAGE(PG8_SA(0, 0), Ab, cva[0]); PG8_STAGE(PG8_SA(0, 1), Ab, cva[1]);
    if (wr == 1) PG8_BAR;
    PG8_WAIT_V(2); PG8_BAR;
    PG8_STAGE(PG8_SB(1, 0), cB + kstep, voffB); PG8_STAGE(PG8_SA(1, 0), Ab + kstep, cva[0]); PG8_STAGE(PG8_SB(1, 1), cB + hstep + kstep, voffB);
    PG8_WAIT_V(6); PG8_BAR;
    for (;;) {
        const bool has_next = S.next(ui + 1, nxt);
        const char* nB = cB;
        if (has_next) { PG8_AOFF(nva, nxt); nB = PG8_BBASE(nxt); }
        else {
#pragma unroll
            for (int h = 0; h < 2; ++h)
#pragma unroll
                for (int i = 0; i < 2; ++i) nva[h][i] = cva[h][i]; }
        for (int t = 0; t < nt; t += 2) {
            const bool last = (t == nt - 2);
            const char* a1 = Ab + (size_t)(t + 1) * kstep;
            const char* a2 = last ? Ab : Ab + (size_t)(t + 2) * kstep; const char* b2 = last ? nB : cB + (size_t)(t + 2) * kstep;
            const char* a3 = a2 + kstep; const char* b3 = b2 + kstep;
            unsigned s2[2][2];
#pragma unroll
            for (int h = 0; h < 2; ++h)
#pragma unroll
                for (int i = 0; i < 2; ++i) s2[h][i] = last ? nva[h][i] : cva[h][i];
            PG8_LDB(B0, 0, 0); PG8_LDB(B1, 0, 1); PG8_SCHED; PG8_LDA(At, 0, 0); PG8_STAGE(PG8_SA(1, 1), a1, cva[1]);
            PG8_WAIT_V(8); PG8_WAIT_L(0); PG8_BAR; PG8_MMA(0, 0, At, B0); PG8_MMA(0, 1, At, B1); PG8_BAR; PG8_SCHED;
            PG8_LDA(At, 0, 1); PG8_STAGE(PG8_SB(0, 0), b2, voffB); PG8_STAGE(PG8_SB(0, 1), b2 + hstep, voffB); PG8_STAGE(PG8_SA(0, 0), a2, s2[0]);
            PG8_WAIT_V(8); PG8_WAIT_L(0); PG8_BAR; PG8_MMA(1, 0, At, B0); PG8_MMA(1, 1, At, B1); PG8_BAR; PG8_SCHED;
            PG8_LDB(B0, 1, 0); PG8_LDB(B1, 1, 1); PG8_SCHED; PG8_LDA(At, 1, 0); PG8_STAGE(PG8_SA(0, 1), a2, s2[1]);
            PG8_WAIT_V(8); PG8_WAIT_L(0); PG8_BAR; PG8_MMA(0, 0, At, B0); PG8_MMA(0, 1, At, B1); PG8_BAR; PG8_SCHED;
            PG8_LDA(At, 1, 1); PG8_STAGE(PG8_SB(1, 0), b3, voffB); PG8_STAGE(PG8_SB(1, 1), b3 + hstep, voffB); PG8_STAGE(PG8_SA(1, 0), a3, s2[0]);
            PG8_WAIT_V(8); PG8_WAIT_L(0); PG8_BAR; PG8_MMA(1, 0, At, B0); PG8_MMA(1, 1, At, B1); PG8_BAR; PG8_SCHED;
        }
        if constexpr (ALIGN_EPI) { if (wr == 0) PG8_BAR; }
        E(acc, cur, wr, wc, fr, fq);
        if (!has_next) break;
#pragma unroll
        for (int a = 0; a < 2; ++a)
#pragma unroll
            for (int b = 0; b < 2; ++b)
#pragma unroll
                for (int m = 0; m < 4; ++m)
#pragma unroll
                    for (int n = 0; n < 2; ++n) acc[a][b][m][n] = (f32x4){0.f, 0.f, 0.f, 0.f};
        cur = nxt; cB = nB; ++ui;
#pragma unroll
        for (int h = 0; h < 2; ++h)
#pragma unroll
            for (int i = 0; i < 2; ++i) cva[h][i] = nva[h][i];
        if constexpr (ALIGN_EPI) { if (wr == 1) PG8_BAR; }
    }
    PG8_WAIT_V(0);
    if constexpr (!ALIGN_EPI) { if (wr == 0) PG8_BAR; }
    PG8_BAR;
#undef PG8_SA
#undef PG8_SB
#undef PG8_STAGE
#undef PG8_LDA
#undef PG8_LDB
#undef PG8_MMA
#undef PG8_WAIT_V
#undef PG8_WAIT_L
#undef PG8_BAR
#undef PG8_SCHED
#undef PG8_AOFF
#undef PG8_BBASE
}
}


typedef short bf16x8_t __attribute__((ext_vector_type(8)));
typedef float f32x16 __attribute__((ext_vector_type(16)));
template <int K>
__device__ __forceinline__ void mm32(f32x16& acc, const LAS unsigned char* A, int sa, const LAS unsigned char* B, int sb, int lane) {
    const LAS unsigned char* ap = A + (lane & 31) * sa + (lane >> 5) * 16;
    const LAS unsigned char* bp = B + (lane & 31) * sb + (lane >> 5) * 16;
#pragma unroll
    for (int k0 = 0; k0 < K / 16; k0 += 4) {
        bf16x8_t a[4], b[4];
#pragma unroll
        for (int k = 0; k < 4; ++k) { a[k] = *(const LAS bf16x8_t*)(ap + (k0 + k) * 32); b[k] = *(const LAS bf16x8_t*)(bp + (k0 + k) * 32); }
#pragma unroll
        for (int k = 0; k < 4; ++k) acc = __builtin_amdgcn_mfma_f32_32x32x16_bf16(a[k], b[k], acc, 0, 0, 0);
    }
}
__device__ __forceinline__ int rowmap(int reg, int hi) { return (reg & 3) + 8 * (reg >> 2) + 4 * hi; }
__device__ __forceinline__ int chunk_row0(int b, int tc) { return tc < 4 ? NLAT + b * CTX + tc * 64 : b * SEQ + (tc - 4) * 64; }
constexpr int ST64 = 144, ST128 = 272;


__device__ __forceinline__ void touch(unsigned& x) { asm volatile("" : "+v"(x)); }
__device__ __forceinline__ void touch(float& x) { asm volatile("" : "+v"(x)); }
__device__ __forceinline__ void touch(u32x4& x) { asm volatile("" : "+v"(x)); }
struct VtRaw { unsigned w[8]; };
__device__ __forceinline__ void vt_load(VtRaw& R, const bf16* src, int pitch, int row0, int col0, int tid) {
    const int cp = tid & 63, tg = tid >> 6;
#pragma unroll
    for (int i = 0; i < 8; ++i) R.w[i] = *(const unsigned*)(src + (size_t)(row0 + tg * 8 + i) * pitch + col0 + 2 * cp);
}
__device__ __forceinline__ void vt_store(LAS unsigned char* VT, const VtRaw& R, int tid) {
    const int cp = tid & 63, tg = tid >> 6; unsigned lo[4], hi[4];
#pragma unroll
    for (int i = 0; i < 4; ++i) { const unsigned w0 = R.w[2 * i], w1 = R.w[2 * i + 1]; lo[i] = (w0 & 0xffffu) | (w1 << 16); hi[i] = (w0 >> 16) | (w1 & 0xffff0000u); }
    *(LAS u32x4*)(VT + (2 * cp) * ST64 + tg * 16) = (u32x4){lo[0], lo[1], lo[2], lo[3]};
    *(LAS u32x4*)(VT + (2 * cp + 1) * ST64 + tg * 16) = (u32x4){hi[0], hi[1], hi[2], hi[3]};
}
struct TaskId { int b, h, tc, row0, sidf; };
__device__ __forceinline__ TaskId task_id(int task) { TaskId t; t.b = task / (4 * NTC); t.h = (task / NTC) & 3; t.tc = task % NTC; t.row0 = chunk_row0(t.b, t.tc); t.sidf = (t.b * 4 + t.h) * 2; return t; }

struct MlARaw { VtRaw v; unsigned kw[4]; float g[4]; };
__device__ __forceinline__ void touch(MlARaw& R) {
#pragma unroll
    for (int i = 0; i < 8; ++i) touch(R.v.w[i]);
#pragma unroll
    for (int i = 0; i < 4; ++i) { touch(R.kw[i]); touch(R.g[i]); } }
__device__ __forceinline__ void ml_passA_load(Frame& F, int task, MlARaw& R) {
    const TaskId T = task_id(task);
    vt_load(R.v, (const bf16*)(F.ws + WS_P), PW, T.row0, PC_V + T.h * 128, F.tid);
    { const int cp = F.tid & 31, tg = F.tid >> 5; const bf16* CQK = (const bf16*)(F.ws + WS_CQK);
#pragma unroll
      for (int i = 0; i < 4; ++i) R.kw[i] = *(const unsigned*)(CQK + (size_t)(T.row0 + tg * 4 + i) * 512 + 256 + T.h * 64 + 2 * cp); }
    if (F.wave == 0) { const float* gp = (const float*)(F.ws + WS_GATES) + (size_t)(T.row0 + F.lane) * 16; R.g[0] = gp[T.h]; R.g[1] = gp[4 + T.h]; R.g[2] = gp[8 + T.h]; R.g[3] = gp[12 + T.h]; }
}
__device__ __forceinline__ void ml_passA_run(Frame& F, int task, const MlARaw& R) {
    const TaskId T = task_id(task); const int tc = T.tc, sidf = T.sidf;
    LAS unsigned char* VT = F.lds; LAS unsigned char* KT = F.lds + 18432;
    LAS float* wts = (LAS float*)(F.lds + 36864);
    float* MLS = (float*)(F.ws + WS_MLS);
    LDS_BARRIER();
    if (F.wave == 0) { const int s = F.lane;
        const float igf = R.g[0], igb = R.g[1], lff = R.g[2], lfb = R.g[3];
        const float pf = wave_incl_sum(lff, s), gf = __builtin_bit_cast(float, __builtin_amdgcn_readlane(__builtin_bit_cast(int, pf), 63)), ef = (gf - pf) + igf, mf = wave_max(ef);
        const float pb = wave_incl_sum(lfb, s), gb = __builtin_bit_cast(float, __builtin_amdgcn_readlane(__builtin_bit_cast(int, pb), 63)), eb = (pb - lfb) + igb, mb = wave_max(eb);
        wts[s] = __expf(ef - mf); wts[64 + s] = __expf(eb - mb);
        if (s == 0) { float* o = MLS + (size_t)(sidf * NTC + tc) * 4; o[0] = gf; o[1] = mf; o = MLS + (size_t)((sidf + 1) * NTC + tc) * 4; o[0] = gb; o[1] = mb; } }
    vt_store(VT, R.v, F.tid);
    LDS_BARRIER();
    { const int cp = F.tid & 31, tg = F.tid >> 5;
#pragma unroll
      for (int dir = 0; dir < 2; ++dir) { float lo[4], hi[4];
#pragma unroll
          for (int i = 0; i < 4; ++i) { const float w = wts[dir * 64 + tg * 4 + i]; lo[i] = bflo(R.kw[i]) * w; hi[i] = bfhi(R.kw[i]) * w; }
          *(LAS u32x2*)(KT + dir * 9216 + (2 * cp) * ST64 + tg * 8) = (u32x2){pk2(lo[0], lo[1]), pk2(lo[2], lo[3])};
          *(LAS u32x2*)(KT + dir * 9216 + (2 * cp + 1) * ST64 + tg * 8) = (u32x2){pk2(hi[0], hi[1]), pk2(hi[2], hi[3])}; } }
    LDS_BARRIER();
    { const int dir = F.wave >> 2, mt = F.wave & 3; bf16* C = (bf16*)(F.ws + WS_MLC) + (size_t)((sidf + dir) * NTC + tc) * 8192;
#pragma unroll
      for (int nt = 0; nt < 2; ++nt) { f32x16 acc;
#pragma unroll
          for (int i = 0; i < 16; ++i) acc[i] = 0.f;
          mm32<64>(acc, VT + 32 * mt * ST64, ST64, KT + dir * 9216 + 32 * nt * ST64, ST64, F.lane);
#pragma unroll
          for (int r = 0; r < 16; ++r) C[(32 * mt + rowmap(r, F.lane >> 5)) * 64 + 32 * nt + (F.lane & 31)] = (bf16)f2bf(acc[r]); } }
    if (F.tid < 128) { const int dir = F.tid >> 6, d = F.tid & 63; const LAS unsigned char* rp = KT + dir * 9216 + d * ST64; float sum = 0.f;
#pragma unroll
        for (int i = 0; i < 8; ++i) { const u32x4 w = *(const LAS u32x4*)(rp + i * 16); sum += (bflo(w.x) + bfhi(w.x)) + (bflo(w.y) + bfhi(w.y)) + (bflo(w.z) + bfhi(w.z)) + (bflo(w.w) + bfhi(w.w)); }
        ((float*)(F.ws + WS_MLN))[(size_t)((sidf + dir) * NTC + tc) * 64 + d] = sum; }
}
__device__ __forceinline__ int tc_seq(int dir, int j) { return dir == 0 ? j : (j < 4 ? 3 - j : 135 - j); }
__device__ __forceinline__ void scan_passB(Frame& F) {
    const float* GG = (const float*)(F.ws + WS_HGG); float* MLS = (float*)(F.ws + WS_MLS);
    const int t = F.tid;
    if (t < 128) {
        for (int item = F.vcu * 128 + t; item < 16 * 2048; item += F.G * 128) {
            const int scan = item >> 11, e = (item & 2047) * 8, dir = scan & 1, d = e & 127;
            const u32x4* base = (const u32x4*)((const bf16*)(F.ws + WS_HGS) + (size_t)scan * NTC * 16384 + e); u32x4* ob = (u32x4*)((bf16*)(F.ws + WS_HGSB) + (size_t)scan * NTC * 16384 + e);
            const f32x4* gb = (const f32x4*)(GG + (size_t)scan * NTC * 128 + d);
            float st[8];
#pragma unroll
            for (int k = 0; k < 8; ++k) st[k] = 0.f;
            for (int j0 = 0; j0 < NTC; j0 += 11) {
                u32x4 dv[11]; f32x4 g0[11], g1[11];
#pragma unroll
                for (int i = 0; i < 11; ++i) { const int tc = tc_seq(dir, j0 + i); dv[i] = base[(size_t)tc * 2048]; g0[i] = gb[tc * 32]; g1[i] = gb[tc * 32 + 1]; }
#pragma unroll
                for (int i = 0; i < 11; ++i) { const int tc = tc_seq(dir, j0 + i);
                    ob[(size_t)tc * 2048] = (u32x4){pk2(st[0], st[1]), pk2(st[2], st[3]), pk2(st[4], st[5]), pk2(st[6], st[7])};
                    const f32x4 ta = g0[i] * 1.44269504f, tb = g1[i] * 1.44269504f;
                    const f32x2_t e0 = {__builtin_amdgcn_exp2f(ta.x), __builtin_amdgcn_exp2f(ta.y)}, e1 = {__builtin_amdgcn_exp2f(ta.z), __builtin_amdgcn_exp2f(ta.w)}, e2 = {__builtin_amdgcn_exp2f(tb.x), __builtin_amdgcn_exp2f(tb.y)}, e3 = {__builtin_amdgcn_exp2f(tb.z), __builtin_amdgcn_exp2f(tb.w)};
                    const f32x2_t s0 = e0 * (f32x2_t){st[0], st[1]} + (f32x2_t){bflo(dv[i].x), bfhi(dv[i].x)}, s1 = e1 * (f32x2_t){st[2], st[3]} + (f32x2_t){bflo(dv[i].y), bfhi(dv[i].y)};
                    const f32x2_t s2 = e2 * (f32x2_t){st[4], st[5]} + (f32x2_t){bflo(dv[i].z), bfhi(dv[i].z)}, s3 = e3 * (f32x2_t){st[6], st[7]} + (f32x2_t){bflo(dv[i].w), bfhi(dv[i].w)};
                    st[0] = s0.x; st[1] = s0.y; st[2] = s1.x; st[3] = s1.y; st[4] = s2.x; st[5] = s2.y; st[6] = s3.x; st[7] = s3.y; }
            }
        }
    } else if (t < 192) {
        for (int item = F.vcu * 64 + (t - 128); item < 16 * 1024; item += F.G * 64) {
            const int scan = item >> 10, e = (item & 1023) * 8, dir = scan & 1;
            const u32x4* cb = (const u32x4*)((const bf16*)(F.ws + WS_MLC) + (size_t)scan * NTC * 8192 + e); u32x4* ob = (u32x4*)((bf16*)(F.ws + WS_MLCB) + (size_t)scan * NTC * 8192 + e);
            float m = 0.f, st[8];
#pragma unroll
            for (int k = 0; k < 8; ++k) st[k] = 0.f;
            for (int j0 = 0; j0 < NTC; j0 += 12) {
                u32x4 dv[12]; float gg[12], ml[12];
#pragma unroll
                for (int i = 0; i < 12; ++i) { const int tc = tc_seq(dir, j0 + i); dv[i] = cb[(size_t)tc * 1024]; const float* sp = MLS + (size_t)(scan * NTC + tc) * 4; gg[i] = sp[0]; ml[i] = sp[1]; }
#pragma unroll
                for (int i = 0; i < 12; ++i) { const int tc = tc_seq(dir, j0 + i);
                    const float mn = fmaxf(gg[i] + m, ml[i]), a = __expf(gg[i] + m - mn), w = __expf(ml[i] - mn);
                    if ((item & 1023) == 0) MLS[(size_t)(scan * NTC + tc) * 4 + 2] = m;
                    ob[(size_t)tc * 1024] = (u32x4){pk2(st[0], st[1]), pk2(st[2], st[3]), pk2(st[4], st[5]), pk2(st[6], st[7])};
                    const f32x2_t s0 = (f32x2_t){st[0], st[1]} * a + (f32x2_t){bflo(dv[i].x), bfhi(dv[i].x)} * w, s1 = (f32x2_t){st[2], st[3]} * a + (f32x2_t){bflo(dv[i].y), bfhi(dv[i].y)} * w;
                    const f32x2_t s2 = (f32x2_t){st[4], st[5]} * a + (f32x2_t){bflo(dv[i].z), bfhi(dv[i].z)} * w, s3 = (f32x2_t){st[6], st[7]} * a + (f32x2_t){bflo(dv[i].w), bfhi(dv[i].w)} * w;
                    st[0] = s0.x; st[1] = s0.y; st[2] = s1.x; st[3] = s1.y; st[4] = s2.x; st[5] = s2.y; st[6] = s3.x; st[7] = s3.y; m = mn; }
            }
        }
    } else if (t < 196) {
        for (int item = F.vcu * 4 + (t - 192); item < 16 * 64; item += F.G * 4) {
            const int scan = item >> 6, e = item & 63, dir = scan & 1; float* nb = (float*)(F.ws + WS_MLN) + (size_t)scan * NTC * 64 + e;
            float m = 0.f, s0 = 0.f;
            for (int j0 = 0; j0 < NTC; j0 += 12) {
                float dv[12];
#pragma unroll
                for (int i = 0; i < 12; ++i) dv[i] = nb[tc_seq(dir, j0 + i) * 64];
#pragma unroll
                for (int i = 0; i < 12; ++i) { const int tc = tc_seq(dir, j0 + i); const float* sp = MLS + (size_t)(scan * NTC + tc) * 4;
                    const float g = sp[0], ml = sp[1], mn = fmaxf(g + m, ml), a = __expf(g + m - mn), w = __expf(ml - mn);
                    nb[tc * 64] = s0; s0 = a * s0 + w * dv[i]; m = mn; }
            }
        }
    }
}
template <int MIX>
__device__ __forceinline__ void gate_load(Frame& F, int row0, int h, unsigned (&gate)[16]) {
    const int mt = F.wave >> 2, nt = F.wave & 3; const bf16* P = (const bf16*)(F.ws + WS_P) + (MIX == 0 ? PC_O : PC_GO) + h * 128 + 32 * nt + (F.lane & 31);
#pragma unroll
    for (int r = 0; r < 16; ++r) gate[r] = P[(size_t)(row0 + 32 * mt + rowmap(r, F.lane >> 5)) * PW];
}
template <int MIX>
__device__ __forceinline__ void head_epilogue(Frame& F, const float ng, const f32x16& hv, const unsigned (&gate)[16], LAS float* part, int row0, int h) {
    const int mt = F.wave >> 2, nt = F.wave & 3, lane = F.lane, hi = lane >> 5;
    float ps[16];
#pragma unroll
    for (int r = 0; r < 16; ++r) ps[r] = hv[r] * hv[r];
#pragma unroll
    for (int r = 0; r < 16; ++r) ps[r] = half_sum_hi(ps[r]);
    if ((lane & 31) == 31) {
#pragma unroll
        for (int r = 0; r < 16; ++r) part[(32 * mt + rowmap(r, hi)) * 4 + nt] = ps[r]; }
    LDS_BARRIER();
    bf16* Y = (bf16*)(F.ws + WS_Y) + (MIX == 0 ? 0 : 512) + h * 128 + 32 * nt + (lane & 31);
#pragma unroll
    for (int r = 0; r < 16; r += 2) { const int t0 = 32 * mt + rowmap(r, hi), t1 = 32 * mt + rowmap(r + 1, hi); const f32x4 p4 = *(const LAS f32x4*)(part + t0 * 4), q4 = *(const LAS f32x4*)(part + t1 * 4);
        const f32x2_t ms = (f32x2_t){(p4.x + p4.y) + (p4.z + p4.w), (q4.x + q4.y) + (q4.z + q4.w)} * (1.f / 128.f) + EPS;
        const f32x2_t rstd = {__builtin_amdgcn_rsqf(ms.x), __builtin_amdgcn_rsqf(ms.y)}, gz = {bf2f((unsigned short)gate[r]), bf2f((unsigned short)gate[r + 1])};
        const f32x2_t te = gz * (-1.44269504f), dn = (f32x2_t){__builtin_amdgcn_exp2f(te.x), __builtin_amdgcn_exp2f(te.y)} + 1.f;
        const f32x2_t sg = {__builtin_amdgcn_rcpf(dn.x), __builtin_amdgcn_rcpf(dn.y)}, gv = MIX == 0 ? sg : gz * sg;
        const f32x2_t y = ((f32x2_t){hv[r], hv[r + 1]} * rstd) * (gv * ng); const unsigned w = pk2(y.x, y.y);
        Y[(size_t)(row0 + t0) * D] = (bf16)w; Y[(size_t)(row0 + t1) * D] = (bf16)(w >> 16); }
}
struct MlCRaw { VtRaw v; u32x4 q, k; u32x4 cf[2]; float g0, g1, ms; };
__device__ __forceinline__ void touch(MlCRaw& R) {
#pragma unroll
    for (int i = 0; i < 8; ++i) touch(R.v.w[i]);
    touch(R.q); touch(R.k); touch(R.cf[0]); touch(R.cf[1]); touch(R.g0); touch(R.g1); touch(R.ms); }
__device__ __forceinline__ void ml_passC_load(Frame& F, int task, MlCRaw& R) {
    const TaskId T = task_id(task); const bf16* CQK = (const bf16*)(F.ws + WS_CQK);
    vt_load(R.v, (const bf16*)(F.ws + WS_P), PW, T.row0, PC_V + T.h * 128, F.tid);
    { const int row = F.tid >> 3, pc = F.tid & 7;
      R.q = *(const u32x4*)(CQK + (size_t)(T.row0 + row) * 512 + T.h * 64 + pc * 8); R.k = *(const u32x4*)(CQK + (size_t)(T.row0 + row) * 512 + 256 + T.h * 64 + pc * 8); }
    { const u32x4* cp = (const u32x4*)((const bf16*)(F.ws + WS_MLCB) + (size_t)(T.sidf * NTC + T.tc) * 8192 + (F.tid >> 2) * 64 + (F.tid & 3) * 16); R.cf[0] = cp[0]; R.cf[1] = cp[1]; }
    R.g0 = 0.f; R.g1 = 0.f; R.ms = 0.f;
    if (F.wave < 2) { const int dir = F.wave; const float* gp = (const float*)(F.ws + WS_GATES) + (size_t)(T.row0 + F.lane) * 16; R.g0 = gp[dir * 4 + T.h]; R.g1 = gp[8 + dir * 4 + T.h];
        R.ms = ((const float*)(F.ws + WS_MLS))[(size_t)((T.sidf + dir) * NTC + T.tc) * 4 + 2]; }
}
__device__ __forceinline__ void ml_passC_run(Frame& F, CArgs& A, int l, int task, const MlCRaw& R) {
    const TaskId T = task_id(task); const int h = T.h, tc = T.tc, row0 = T.row0, sidf = T.sidf;
    if (l == DEPTH - 1 && tc < 4) return;
    unsigned gate[16];
    const float ng = A.in[I_MLNG][l * 512 + h * 128 + 32 * (F.wave & 3) + (F.lane & 31)];
    LAS unsigned char* Q = F.lds; LAS unsigned char* Kn = F.lds + 9216; LAS unsigned char* VT = F.lds + 18432; LAS unsigned char* Cs = F.lds + 36864;
    LAS unsigned char* Pm = F.lds + 55296; LAS unsigned char* Qs = F.lds + 64512;
    LAS float* sm = (LAS float*)(F.lds + 73728);
    const int tid = F.tid, lane = F.lane;
    u32x4 cb[2]; { const u32x4* cp = (const u32x4*)((const bf16*)(F.ws + WS_MLCB) + (size_t)((sidf + 1) * NTC + tc) * 8192 + (tid >> 2) * 64 + (tid & 3) * 16); cb[0] = cp[0]; cb[1] = cp[1]; }
    float nv = 0.f; if (tid < 128) nv = ((const float*)(F.ws + WS_MLN))[(size_t)((sidf + (tid >> 6)) * NTC + tc) * 64 + (tid & 63)];
    LDS_BARRIER();
    { const int row = tid >> 3, pc = tid & 7; *(LAS u32x4*)(Q + row * ST64 + pc * 16) = R.q; *(LAS u32x4*)(Kn + row * ST64 + pc * 16) = R.k; }
    vt_store(VT, R.v, tid);
    if (tid < 128) sm[512 + tid] = nv;
    if (F.wave < 2) { const int dir = F.wave, s = lane; const float ig = R.g0, lf = R.g1, ms = R.ms;
        float bt, u, pm;
        if (dir == 0) { bt = wave_incl_sum(lf, s); u = ig - bt; pm = wave_incl_max(u, s); }
        else { const float pf = wave_incl_sum(lf, s), tot = __builtin_bit_cast(float, __builtin_amdgcn_readlane(__builtin_bit_cast(int, pf), 63)); bt = tot - pf + lf; u = ig - bt;
               float r = __shfl(u, 63 - s); r = wave_incl_max(r, s); pm = __shfl(r, 63 - s); }
        const float M = fmaxf(ms, pm);
        LAS float* o = sm + dir * 256; o[s] = u; o[64 + s] = M; o[128 + s] = __expf(ms - M); o[192 + s] = __expf(-(bt + M)); }
    LDS_BARRIER();
    f32x16 qk;
#pragma unroll
    for (int i = 0; i < 16; ++i) qk[i] = 0.f;
    if (F.wave < 4) mm32<64>(qk, Q + 32 * (F.wave >> 1) * ST64, ST64, Kn + 32 * (F.wave & 1) * ST64, ST64, lane);
    f32x16 hs;
#pragma unroll
    for (int i = 0; i < 16; ++i) hs[i] = 0.f;
#pragma unroll 1
    for (int dir = 0; dir < 2; ++dir) {
        const LAS float* sd = sm + dir * 256;
        { const int v = tid >> 2, pc = tid & 3; *(LAS u32x4*)(Cs + v * ST64 + pc * 32) = dir == 0 ? R.cf[0] : cb[0]; *(LAS u32x4*)(Cs + v * ST64 + pc * 32 + 16) = dir == 0 ? R.cf[1] : cb[1]; }
        { const int row = tid >> 3, pc = tid & 7; const u32x4 q = R.q; const float w = sd[128 + row];
          *(LAS u32x4*)(Qs + row * ST64 + pc * 16) = (u32x4){pk2(bflo(q.x) * w, bfhi(q.x) * w), pk2(bflo(q.y) * w, bfhi(q.y) * w), pk2(bflo(q.z) * w, bfhi(q.z) * w), pk2(bflo(q.w) * w, bfhi(q.w) * w)}; }
        if (F.wave < 4) { const int s = 32 * (F.wave & 1) + (lane & 31); const float us = sd[s]; float Mt[16];
#pragma unroll
            for (int r = 0; r < 16; ++r) Mt[r] = sd[64 + 32 * (F.wave >> 1) + rowmap(r, lane >> 5)];
#pragma unroll
            for (int r = 0; r < 16; r += 2) { const int t0 = 32 * (F.wave >> 1) + rowmap(r, lane >> 5), t1 = 32 * (F.wave >> 1) + rowmap(r + 1, lane >> 5);
                const bool ok0 = dir == 0 ? (s <= t0) : (s >= t0), ok1 = dir == 0 ? (s <= t1) : (s >= t1);
                f32x2_t ex = (f32x2_t){us - Mt[r], us - Mt[r + 1]}; ex.x = fminf(ex.x, 0.f); ex.y = fminf(ex.y, 0.f); ex = ex * 1.44269504f;
                const f32x2_t p = (f32x2_t){qk[r], qk[r + 1]} * (f32x2_t){__builtin_amdgcn_exp2f(ex.x), __builtin_amdgcn_exp2f(ex.y)}; const unsigned w = pk2(ok0 ? p.x : 0.f, ok1 ? p.y : 0.f);
                *(LAS unsigned short*)(Pm + t0 * ST64 + s * 2) = (unsigned short)w; *(LAS unsigned short*)(Pm + t1 * ST64 + s * 2) = (unsigned short)(w >> 16); } }
        LDS_BARRIER();
        if (tid < 256) { const int t = tid >> 2, qd = tid & 3; float den = 0.f, qn = 0.f;
#pragma unroll
            for (int i = 0; i < 2; ++i) { const u32x4 w = *(const LAS u32x4*)(Pm + t * ST64 + qd * 32 + i * 16); den += (bflo(w.x) + bfhi(w.x)) + (bflo(w.y) + bfhi(w.y)) + (bflo(w.z) + bfhi(w.z)) + (bflo(w.w) + bfhi(w.w));
                const u32x4 q = *(const LAS u32x4*)(Q + t * ST64 + qd * 32 + i * 16); const LAS float* nvp = sm + 512 + dir * 64 + qd * 16 + i * 8; const f32x4 n0 = *(const LAS f32x4*)nvp, n1 = *(const LAS f32x4*)(nvp + 4);
                qn += (bflo(q.x) * n0.x + bfhi(q.x) * n0.y) + (bflo(q.y) * n0.z + bfhi(q.y) * n0.w) + (bflo(q.z) * n1.x + bfhi(q.z) * n1.y) + (bflo(q.w) * n1.z + bfhi(q.w) * n1.w); }
            den += sd[128 + t] * qn;
            den += dppf<0xB1, 0xf, true>(0.f, den); den += dppf<0x4E, 0xf, true>(0.f, den);
            if (qd == 0) sm[640 + t] = 1.f / fmaxf(fabsf(den), sd[192 + t]); }
        f32x16 acc;
#pragma unroll
        for (int i = 0; i < 16; ++i) acc[i] = 0.f;
        { const int mt = F.wave >> 2, nt = F.wave & 3;
          mm32<64>(acc, Pm + 32 * mt * ST64, ST64, VT + 32 * nt * ST64, ST64, lane);
          mm32<64>(acc, Qs + 32 * mt * ST64, ST64, Cs + 32 * nt * ST64, ST64, lane); }
        LDS_BARRIER();
        float dsc[16];
#pragma unroll
        for (int r = 0; r < 16; ++r) dsc[r] = sm[640 + 32 * (F.wave >> 2) + rowmap(r, lane >> 5)];
#pragma unroll
        for (int r = 0; r < 16; ++r) hs[r] += acc[r] * dsc[r];
        if (dir == 0) LDS_BARRIER();
    }
    gate_load<0>(F, row0, h, gate);
    head_epilogue<0>(F, ng, hs, gate, sm + 768, row0, h);
}

struct HgPrep { float k[16], x[16]; float T[4]; };
__device__ __forceinline__ void hg_zload(Frame& F, int h, int row0, int dir, unsigned (&z)[16]) {
    const int d = F.tid & 127, qtr = F.tid >> 7;
    const bf16* P = (const bf16*)(F.ws + WS_P) + (size_t)(row0 + qtr * 16) * PW + (dir == 0 ? PC_FF : PC_FB) + h * 128 + d;
#pragma unroll
    for (int i = 0; i < 16; ++i) z[i] = P[(size_t)i * PW];
}
struct HgConst { float lb, bf, bb; };
__device__ __forceinline__ HgConst hg_const(Frame& F, CArgs& A, int l, int h) { const int ch = h * 128 + (F.tid & 127); HgConst c; c.lb = 0.f;
    if (l == 1) { const float r0 = A.in[I_HGLB][ch], r1 = A.in[I_HGLB][512 + ch], mx = fmaxf(r0, r1), e0 = __expf(r0 - mx), e1 = __expf(r1 - mx); c.lb = e1 / (e0 + e1); }
    c.bf = A.in[I_HGFB][l * 1024 + ch]; c.bb = A.in[I_HGFB][l * 1024 + 512 + ch]; return c; }
template <int dir>
__device__ __forceinline__ void hg_prep(Frame& F, const HgConst& C, int l, const unsigned (&zr)[16], LAS float* tot, HgPrep& R) {
    const int d = F.tid & 127, qtr = F.tid >> 7;
    const float lb = C.lb, bias = dir == 0 ? C.bf : C.bb, omlb = 1.f - lb;
    float cs = 0.f;
#pragma unroll
    for (int i = 0; i < 16; i += 2) {
        f32x2_t z = (f32x2_t){bf2f((unsigned short)zr[i]), bf2f((unsigned short)zr[i + 1])} + bias;
        z.x = fminf(fmaxf(z.x, -30.f), 30.f); z.y = fminf(fmaxf(z.y, -30.f), 30.f);
        const f32x2_t t = z * (-1.44269504f);
        const f32x2_t ez = {__builtin_amdgcn_exp2f(t.x), __builtin_amdgcn_exp2f(t.y)}, dn = ez + 1.f;
        const f32x2_t sg = {__builtin_amdgcn_rcpf(dn.x), __builtin_amdgcn_rcpf(dn.y)};
        const f32x2_t kk = (ez * sg) * omlb, ff = sg * omlb + lb;
        R.k[i] = kk.x; R.k[i + 1] = kk.y;
        const f32x2_t lf = (f32x2_t){__builtin_amdgcn_logf(ff.x), __builtin_amdgcn_logf(ff.y)} * 0.69314718f;
        if (dir == 0) { cs += lf.x; R.x[i] = cs; cs += lf.y; R.x[i + 1] = cs; } else { R.x[i] = cs; cs += lf.x; R.x[i + 1] = cs; cs += lf.y; } }
    tot[dir * 512 + qtr * 128 + d] = cs;
    LDS_BARRIER();
    float off = 0.f;
#pragma unroll
    for (int q = 0; q < 4; ++q) { R.T[q] = tot[dir * 512 + q * 128 + d]; if (q < qtr) off += R.T[q]; }
#pragma unroll
    for (int i = 0; i < 16; ++i) R.x[i] += off;
}
__device__ __forceinline__ void put16(LAS unsigned char* p, const float (&v)[16]) {
    *(LAS u32x4*)p = (u32x4){pk2(v[0], v[1]), pk2(v[2], v[3]), pk2(v[4], v[5]), pk2(v[6], v[7])};
    *(LAS u32x4*)(p + 16) = (u32x4){pk2(v[8], v[9]), pk2(v[10], v[11]), pk2(v[12], v[13]), pk2(v[14], v[15])};
}
struct HgARaw { VtRaw v; unsigned zf[16], zb[16]; };
__device__ __forceinline__ void touch(HgARaw& R) {
#pragma unroll
    for (int i = 0; i < 8; ++i) touch(R.v.w[i]);
#pragma unroll
    for (int i = 0; i < 16; ++i) { touch(R.zf[i]); touch(R.zb[i]); } }
__device__ __forceinline__ void hg_passA_load(Frame& F, int task, HgARaw& R) {
    const TaskId T = task_id(task);
    vt_load(R.v, (const bf16*)(F.ws + WS_CQI), 1024, T.row0, 512 + T.h * 128, F.tid);
    hg_zload(F, T.h, T.row0, 0, R.zf); hg_zload(F, T.h, T.row0, 1, R.zb);
}
__device__ __forceinline__ void hg_passA_run(Frame& F, CArgs& A, int l, int task, const HgARaw& RW) {
    const TaskId T = task_id(task); const int h = T.h, tc = T.tc, sidf = T.sidf;
    LAS unsigned char* VT = F.lds; LAS unsigned char* KT = F.lds + 18432; LAS float* tot = (LAS float*)(F.lds + 55296);
    const int d = F.tid & 127, qtr = F.tid >> 7;
    const HgConst HC = hg_const(F, A, l, h);
    LDS_BARRIER();
    vt_store(VT, RW.v, F.tid);
    float* GG = (float*)(F.ws + WS_HGG);
    { HgPrep R; hg_prep<0>(F, HC, l, RW.zf, tot, R);
      const float G = (R.T[0] + R.T[1]) + (R.T[2] + R.T[3]);
      if (qtr == 0) GG[(size_t)(sidf * NTC + tc) * 128 + d] = G;
      float t[16];
#pragma unroll
      for (int i = 0; i < 16; i += 2) { const f32x2_t te = ((f32x2_t){R.x[i], R.x[i + 1]} - G) * (-1.44269504f);
          const f32x2_t kv = (f32x2_t){R.k[i], R.k[i + 1]} * (f32x2_t){__builtin_amdgcn_exp2f(te.x), __builtin_amdgcn_exp2f(te.y)}; t[i] = kv.x; t[i + 1] = kv.y; }
      put16(KT + d * ST64 + qtr * 32, t); }
    { HgPrep R; hg_prep<1>(F, HC, l, RW.zb, tot, R);
      const float G = (R.T[0] + R.T[1]) + (R.T[2] + R.T[3]);
      if (qtr == 0) GG[(size_t)((sidf + 1) * NTC + tc) * 128 + d] = G;
      float t[16];
#pragma unroll
      for (int i = 0; i < 16; i += 2) { const f32x2_t te = (f32x2_t){R.x[i], R.x[i + 1]} * 1.44269504f;
          const f32x2_t kv = (f32x2_t){R.k[i], R.k[i + 1]} * (f32x2_t){__builtin_amdgcn_exp2f(te.x), __builtin_amdgcn_exp2f(te.y)}; t[i] = kv.x; t[i + 1] = kv.y; }
      put16(KT + 18432 + d * ST64 + qtr * 32, t); }
    LDS_BARRIER();
    { const int dir = F.wave >> 2, mt = F.wave & 3; bf16* S = (bf16*)(F.ws + WS_HGS) + (size_t)((sidf + dir) * NTC + tc) * 16384;
#pragma unroll
      for (int nt = 0; nt < 4; ++nt) { f32x16 acc;
#pragma unroll
          for (int i = 0; i < 16; ++i) acc[i] = 0.f;
          mm32<64>(acc, VT + 32 * mt * ST64, ST64, KT + dir * 18432 + 32 * nt * ST64, ST64, F.lane);
#pragma unroll
          for (int r = 0; r < 16; ++r) S[(32 * mt + rowmap(r, F.lane >> 5)) * 128 + 32 * nt + (F.lane & 31)] = (bf16)f2bf(acc[r]); } }
}
struct HgCRaw { VtRaw v; unsigned zf[16], q[16]; };
__device__ __forceinline__ void touch(HgCRaw& R) {
#pragma unroll
    for (int i = 0; i < 8; ++i) touch(R.v.w[i]);
#pragma unroll
    for (int i = 0; i < 16; ++i) { touch(R.zf[i]); touch(R.q[i]); } }
__device__ __forceinline__ void hg_passC_load(Frame& F, int task, HgCRaw& R) {
    const TaskId T = task_id(task); const bf16* CQI = (const bf16*)(F.ws + WS_CQI);
    vt_load(R.v, CQI, 1024, T.row0, 512 + T.h * 128, F.tid);
    hg_zload(F, T.h, T.row0, 0, R.zf);
    { const int d = F.tid & 127, qtr = F.tid >> 7;
#pragma unroll
      for (int i = 0; i < 16; ++i) R.q[i] = CQI[(size_t)(T.row0 + qtr * 16 + i) * 1024 + T.h * 128 + d]; }
}
__device__ __forceinline__ void hg_passC_run(Frame& F, CArgs& A, int l, int task, const HgCRaw& RW) {
    const TaskId T = task_id(task); const int h = T.h, tc = T.tc, row0 = T.row0, sidf = T.sidf;
    LAS unsigned char* VT = F.lds; LAS unsigned char* Ss = F.lds + 18432; LAS unsigned char* Qh = F.lds + 53248; LAS unsigned char* Kh = F.lds + 70656;
    LAS unsigned char* Qc = F.lds + 88064; LAS unsigned char* Kc = F.lds + 96768; LAS unsigned char* Qt = F.lds + 105472; LAS unsigned char* Am = F.lds + 122880;
    LAS float* tot = (LAS float*)(F.lds + 132096);
    const int tid = F.tid, lane = F.lane, d = tid & 127, qtr = tid >> 7;
    if (l == DEPTH - 1 && tc < 4) return;
    unsigned gate[16];
    const HgConst HC = hg_const(F, A, l, h);
    unsigned zb[16]; hg_zload(F, h, row0, 1, zb);
    u32x4 sf[4], sb[4]; { const u32x4* sp = (const u32x4*)((const bf16*)(F.ws + WS_HGSB) + (size_t)(sidf * NTC + tc) * 16384 + (tid >> 2) * 128 + (tid & 3) * 32);
#pragma unroll
      for (int j = 0; j < 4; ++j) { sf[j] = sp[j]; sb[j] = sp[j + (size_t)NTC * 16384 * 2 / 16]; } }
    LDS_BARRIER();
    vt_store(VT, RW.v, tid);
    f32x16 acc;
#pragma unroll
    for (int i = 0; i < 16; ++i) acc[i] = 0.f;
#pragma unroll
    for (int dir = 0; dir < 2; ++dir) {
        HgPrep R;
        if (dir == 1) gate_load<1>(F, row0, h, gate);
        if (dir == 0) hg_prep<0>(F, HC, l, RW.zf, tot, R); else hg_prep<1>(F, HC, l, zb, tot, R);
        const float T0 = R.T[0], T1 = R.T[1], T2 = R.T[2], T3 = R.T[3];
        const float sg = dir == 0 ? 1.f : -1.f;
        const float rI = sg * ((qtr >> 1) == 0 ? T0 : (T0 + T1) + T2);
        const float rO = sg * (T0 + T1);
        const float Gall = (T0 + T1) + (T2 + T3);
        const bool isq = dir == 0 ? (qtr >= 2) : (qtr < 2);
        const float cO = __expf(isq ? rI - rO : rO - rI), cT = __expf(dir == 0 ? rI : Gall + rI);
        { const int v = tid >> 2, pc = tid & 3;
#pragma unroll
          for (int j = 0; j < 4; ++j) *(LAS u32x4*)(Ss + v * ST128 + pc * 64 + j * 16) = dir == 0 ? sf[j] : sb[j]; }
#pragma unroll
        for (int i = 0; i < 16; i += 2) {
            const int t = qtr * 16 + i;
            const f32x2_t x = dir == 0 ? (f32x2_t){R.x[i], R.x[i + 1]} : (f32x2_t){-R.x[i], -R.x[i + 1]}, kk = {R.k[i], R.k[i + 1]}, qv = {bf2f((unsigned short)RW.q[i]), bf2f((unsigned short)RW.q[i + 1])};
            const f32x2_t te = (x - rI) * 1.44269504f;
            const f32x2_t eh = {__builtin_amdgcn_exp2f(te.x), __builtin_amdgcn_exp2f(te.y)}, ehr = {__builtin_amdgcn_rcpf(eh.x), __builtin_amdgcn_rcpf(eh.y)};
            const f32x2_t qe = qv * eh, ke = kk * ehr, of = (isq ? qe : ke) * cO, qt = qe * cT;
            const unsigned wq = pk2(qe.x, qe.y), wk = pk2(ke.x, ke.y), wo = pk2(of.x, of.y), wt = pk2(qt.x, qt.y);
            *(LAS unsigned short*)(Qh + t * ST128 + d * 2) = (unsigned short)wq; *(LAS unsigned short*)(Qh + (t + 1) * ST128 + d * 2) = (unsigned short)(wq >> 16);
            *(LAS unsigned short*)(Kh + t * ST128 + d * 2) = (unsigned short)wk; *(LAS unsigned short*)(Kh + (t + 1) * ST128 + d * 2) = (unsigned short)(wk >> 16);
            LAS unsigned char* oc = isq ? Qc : Kc;
            *(LAS unsigned short*)(oc + (t & 31) * ST128 + d * 2) = (unsigned short)wo; *(LAS unsigned short*)(oc + ((t + 1) & 31) * ST128 + d * 2) = (unsigned short)(wo >> 16);
            *(LAS unsigned short*)(Qt + t * ST128 + d * 2) = (unsigned short)wt; *(LAS unsigned short*)(Qt + (t + 1) * ST128 + d * 2) = (unsigned short)(wt >> 16);
        }
        LDS_BARRIER();
        if (F.wave < 4) { f32x16 a;
#pragma unroll
            for (int i = 0; i < 16; ++i) a[i] = 0.f;
            int tt = 0, ts = 0;
            if (F.wave < 2) { tt = ts = F.wave; mm32<128>(a, Qh + 32 * tt * ST128, ST128, Kh + 32 * ts * ST128, ST128, lane);
#pragma unroll
                for (int r = 0; r < 16; ++r) { const int tl = rowmap(r, lane >> 5), sl = lane & 31; const bool ok = dir == 0 ? (sl <= tl) : (sl >= tl); a[r] = ok ? a[r] : 0.f; } }
            else if (F.wave == 2) { tt = dir == 0 ? 1 : 0; ts = 1 - tt; mm32<128>(a, Qc, ST128, Kc, ST128, lane); }
            else { tt = dir == 0 ? 0 : 1; ts = 1 - tt; }
#pragma unroll
            for (int r = 0; r < 16; r += 2) { const unsigned w = pk2(a[r], a[r + 1]); *(LAS unsigned short*)(Am + (32 * tt + rowmap(r, lane >> 5)) * ST64 + (32 * ts + (lane & 31)) * 2) = (unsigned short)w;
                *(LAS unsigned short*)(Am + (32 * tt + rowmap(r + 1, lane >> 5)) * ST64 + (32 * ts + (lane & 31)) * 2) = (unsigned short)(w >> 16); } }
        LDS_BARRIER();
        { const int mt = F.wave >> 2, nt = F.wave & 3;
          mm32<64>(acc, Am + 32 * mt * ST64, ST64, VT + 32 * nt * ST64, ST64, lane);
          mm32<128>(acc, Qt + 32 * mt * ST128, ST128, Ss + 32 * nt * ST128, ST128, lane); }
        if (dir == 0) LDS_BARRIER();
    }
    const float ng = A.in[I_HGNG][l * 512 + h * 128 + 32 * (F.wave & 3) + (lane & 31)];
    head_epilogue<1>(F, ng, acc, gate, (LAS float*)(F.lds + 136192), row0, h);
}
#define TASK_LOOP(RAW, LOADFN, RUNFN, T0, T1) do { int t_ = F.vcu; while (t_ < (T0)) t_ += F.G; RAW cur_; if (t_ < (T1)) { LOADFN(t_ - (T0), cur_); } \
    for (; t_ < (T1); t_ += F.G) { touch(cur_); RAW nxt_; if (t_ + F.G < (T1)) { LOADFN(t_ + F.G - (T0), nxt_); } else nxt_ = cur_; RUNFN(t_ - (T0), cur_); cur_ = nxt_; } } while (0)

__device__ __forceinline__ void transpose_item(const float* W, int ldw, int K, bf16* WT, int k0, int n0, int drow0, LAS float* scr, int lane) {
    const int n4 = (lane & 7) * 4, kr = lane >> 3;
    f32x4 v[8];
#pragma unroll
    for (int i = 0; i < 8; ++i) v[i] = __builtin_nontemporal_load((const f32x4*)(W + (size_t)(k0 + 8 * i + kr) * ldw + n0 + n4));
#pragma unroll
    for (int i = 0; i < 8; ++i) { LAS float* p = scr + (8 * i + kr) * 33 + n4; p[0] = v[i].x; p[1] = v[i].y; p[2] = v[i].z; p[3] = v[i].w; }
    asm volatile("s_waitcnt lgkmcnt(0)" ::: "memory");
    const int c = lane & 7;
#pragma unroll
    for (int j = 0; j < 4; ++j) { const int n = (lane >> 3) + 8 * j; const LAS float* s = scr + (8 * c) * 33 + n;
        u32x4 o; o.x = pk2(s[0 * 33], s[1 * 33]); o.y = pk2(s[2 * 33], s[3 * 33]); o.z = pk2(s[4 * 33], s[5 * 33]); o.w = pk2(s[6 * 33], s[7 * 33]);
        *(u32x4*)(WT + (size_t)(drow0 + n) * K + k0 + 8 * c) = o; }
    asm volatile("s_waitcnt lgkmcnt(0)" ::: "memory");
}
__device__ __forceinline__ void ph_convert(Frame& F, CArgs& A, bool small_only) {
    LAS float* scr = (LAS float*)(F.lds + 32768 + F.wave * 8448);
    const int gw = F.vcu * NWAVES + F.wave, NGW = F.G * NWAVES;
    constexpr int I_IN = DEPTH * 16 * 128, I_OUT = DEPTH * 16 * 32, I_GU = DEPTH * NEXP * 16 * 64, I_DN = DEPTH * NEXP * 16 * 32;
    for (int it = gw; it < (small_only ? I_IN + I_OUT : I_IN + I_OUT + I_GU + I_DN); it += NGW) {
        int r = it;
        if (r < I_IN) { const int l = r / 2048, q = r % 2048, kb = q / 128, nb = q % 128, d0 = nb * 32, n0 = d0 < 1536 ? d0 : d0 + 16;
            transpose_item(A.in[I_WIN] + (size_t)l * D * INW, INW, D, (bf16*)(F.ws + WS_WIN) + (size_t)l * PW * D, kb * 64, n0, d0, scr, F.lane); continue; }
        r -= I_IN;
        if (r < I_OUT) { const int l = r / 512, q = r % 512, kb = q / 32, nb = q % 32;
            transpose_item(A.in[I_WOUT] + (size_t)l * D * D, D, D, (bf16*)(F.ws + WS_WOUT) + (size_t)l * D * D, kb * 64, nb * 32, nb * 32, scr, F.lane); continue; }
        r -= I_OUT;
        if (r < I_GU) { const int m = r / 1024, q = r % 1024, kb = q / 64, nb = q % 64, n0 = nb * 32;
            const int cc = n0 & 1023, d0 = (cc >> 7) * 256 + (n0 >= 1024 ? 128 : 0) + (cc & 127);
            transpose_item(A.in[I_WGU] + (size_t)m * D * 2048, 2048, D, (bf16*)(F.ws + WS_WGU) + (size_t)m * 2048 * D, kb * 64, n0, d0, scr, F.lane); continue; }
        r -= I_GU;
        { const int m = r / 512, q = r % 512, kb = q / 32, nb = q % 32;
            transpose_item(A.in[I_WDN] + (size_t)m * DEXP * D, D, DEXP, (bf16*)(F.ws + WS_WDN) + (size_t)m * D * DEXP, kb * 64, nb * 32, nb * 32, scr, F.lane); }
    }
}


constexpr int CV_NJ = 384;
__device__ __forceinline__ void moe_item_addr(CArgs& A, unsigned char* ws, int item, const float*& W, int& ldw, bf16*& WT, int& k0, int& n0, int& d0) {
    const int l = item / 49152, r = item % 49152;
    if (r < 32768) { const int e = r >> 10, q = r & 1023, kb = q >> 6, nb = q & 63; n0 = nb * 32; const int cc = n0 & 1023; d0 = (cc >> 7) * 256 + (n0 >= 1024 ? 128 : 0) + (cc & 127); k0 = kb * 64;
        W = A.in[I_WGU] + (size_t)(l * NEXP + e) * D * 2048; ldw = 2048; WT = (bf16*)(ws + WS_WGU) + (size_t)(l * NEXP + e) * 2048 * D; }
    else { const int r2 = r - 32768, e = r2 >> 9, q = r2 & 511, kb = q >> 5, nb = q & 31; n0 = nb * 32; d0 = n0; k0 = kb * 64;
        W = A.in[I_WDN] + (size_t)(l * NEXP + e) * DEXP * D; ldw = D; WT = (bf16*)(ws + WS_WDN) + (size_t)(l * NEXP + e) * D * DEXP; }
}
__device__ __forceinline__ void transpose_store(bf16* WT, int K, int k0, int d0, LAS float* scr, const f32x4 (&v)[8], int lane) {
    const int n4 = (lane & 7) * 4, kr = lane >> 3;
#pragma unroll
    for (int i = 0; i < 8; ++i) { LAS float* p = scr + (8 * i + kr) * 33 + n4; p[0] = v[i].x; p[1] = v[i].y; p[2] = v[i].z; p[3] = v[i].w; }
    asm volatile("s_waitcnt lgkmcnt(0)" ::: "memory");
    const int c = lane & 7;
#pragma unroll
    for (int j = 0; j < 4; ++j) { const int n = (lane >> 3) + 8 * j; const LAS float* sp = scr + (8 * c) * 33 + n;
        u32x4 o; o.x = pk2(sp[0 * 33], sp[1 * 33]); o.y = pk2(sp[2 * 33], sp[3 * 33]); o.z = pk2(sp[4 * 33], sp[5 * 33]); o.w = pk2(sp[6 * 33], sp[7 * 33]);
        *(u32x4*)(WT + (size_t)(d0 + n) * K + k0 + 8 * c) = o; }
    asm volatile("s_waitcnt lgkmcnt(0)" ::: "memory");
}
__device__ __forceinline__ void convert_moe_all(unsigned char* ws, LAS unsigned char* lds, CArgs& A, int cw, int nw, int wave, int lane, int it_lo = 0, int it_hi = 49152) {
    LAS float* scr = (LAS float*)(lds + wave * 16640);
    const int n4 = (lane & 15) * 4, kr = lane >> 4;
    for (int it = it_lo + cw; it < it_hi; it += 2 * nw) {
        const float* W[2]; bf16* WT[2]; int ldw[2], k0[2], n0[2], d0[2];
        const bool two = it + nw < it_hi;
#pragma unroll
        for (int u = 0; u < 2; ++u) { const int iu = (u == 1 && two) ? it + nw : it; const int le = iu / 768, r = iu % 768;
            if (r < 512) { const int kb = r >> 5, nb = r & 31; k0[u] = kb * 64; n0[u] = nb * 64; const int cc = n0[u] & 1023; d0[u] = (cc >> 7) * 256 + (n0[u] >= 1024 ? 128 : 0) + (cc & 127);
                W[u] = A.in[I_WGU] + (size_t)le * D * 2048; ldw[u] = 2048; WT[u] = (bf16*)(ws + WS_WGU) + (size_t)le * 2048 * D; }
            else { const int q = r - 512, kb = q >> 4, nb = q & 15; k0[u] = kb * 64; n0[u] = nb * 64; d0[u] = n0[u];
                W[u] = A.in[I_WDN] + (size_t)le * DEXP * D; ldw[u] = D; WT[u] = (bf16*)(ws + WS_WDN) + (size_t)le * D * DEXP; } }
        f32x4 v[2][16];
#pragma unroll
        for (int u = 0; u < 2; ++u)
#pragma unroll
            for (int i = 0; i < 16; ++i) v[u][i] = __builtin_nontemporal_load((const f32x4*)(W[u] + (size_t)(k0[u] + 4 * i + kr) * ldw[u] + n0[u] + n4));
#pragma unroll
        for (int u = 0; u < 2; ++u) { if (u == 1 && !two) break;
#pragma unroll
            for (int i = 0; i < 16; ++i) { LAS float* p = scr + (4 * i + kr) * 65 + n4; p[0] = v[u][i].x; p[1] = v[u][i].y; p[2] = v[u][i].z; p[3] = v[u][i].w; }
            asm volatile("s_waitcnt lgkmcnt(0)" ::: "memory");
            const int c = lane & 7;
#pragma unroll
            for (int j = 0; j < 8; ++j) { const int n = (lane >> 3) + 8 * j; const LAS float* sp = scr + (8 * c) * 65 + n;
                u32x4 o; o.x = pk2(sp[0 * 65], sp[1 * 65]); o.y = pk2(sp[2 * 65], sp[3 * 65]); o.z = pk2(sp[4 * 65], sp[5 * 65]); o.w = pk2(sp[6 * 65], sp[7 * 65]);
                *(u32x4*)(WT[u] + (size_t)(d0[u] + n) * 1024 + k0[u] + 8 * c) = o; }
            asm volatile("s_waitcnt lgkmcnt(0)" ::: "memory"); }
    }
}
__device__ __forceinline__ void convert_moe(unsigned char* ws, LAS unsigned char* lds, CArgs& A, int cw, int wave, int lane, int j0, int j1) {
    LAS float* scr = (LAS float*)(lds + wave * 8448);
    const int n4 = (lane & 7) * 4, kr = lane >> 3;
    for (int j = j0; j < j1; j += 2) {
        const float* W0; const float* W1; bf16* T0; bf16* T1; int l0, l1, ka, kb_, na, nb_, da, db;
        moe_item_addr(A, ws, cw + 256 * j, W0, l0, T0, ka, na, da);
        const bool two = j + 1 < j1; moe_item_addr(A, ws, cw + 256 * (two ? j + 1 : j), W1, l1, T1, kb_, nb_, db);
        f32x4 v0[8], v1[8];
#pragma unroll
        for (int i = 0; i < 8; ++i) v0[i] = __builtin_nontemporal_load((const f32x4*)(W0 + (size_t)(ka + 8 * i + kr) * l0 + na + n4));
#pragma unroll
        for (int i = 0; i < 8; ++i) v1[i] = __builtin_nontemporal_load((const f32x4*)(W1 + (size_t)(kb_ + 8 * i + kr) * l1 + nb_ + n4));
        transpose_store(T0, 1024, ka, da, scr, v0, lane);
        if (two) transpose_store(T1, 1024, kb_, db, scr, v1, lane);
    }
}

#define XB_TMO      128
#define XB_XCNT(j)  (256  + 64 * (j))
#define XB_XSUB(j)  (1280 + 64 * (j))
#define XB_XGEN(j)  (2304 + 64 * (j))
#define XB_TOP      3328
#define XB_TOPGEN   3392
#define XCD_BAR_WORDS 3456
#define XB_SPIN_CAP (1u << 18)
__device__ __forceinline__ unsigned xb_ld(unsigned* p)              { return __hip_atomic_load(p, __ATOMIC_RELAXED, __HIP_MEMORY_SCOPE_AGENT); }
__device__ __forceinline__ unsigned xb_add(unsigned* p, unsigned v) { return __hip_atomic_fetch_add(p, v, __ATOMIC_RELAXED, __HIP_MEMORY_SCOPE_AGENT); }
__device__ __forceinline__ unsigned xb_xcc_id() { return (unsigned)__builtin_amdgcn_s_getreg((3 << 11) | 20) & 0xFu; }
#define XB_SPIN(cond, bar) do { unsigned _sp = 0; while (cond) { __builtin_amdgcn_s_sleep(1); \
    if ((++_sp & 255u) == 0u) { if (xb_ld(&(bar)[XB_TMO])) break; if (_sp > XB_SPIN_CAP) { atomicAdd(&(bar)[XB_TMO], 1u); break; } } } } while (0)
struct XcdBarrier { unsigned* bar; unsigned x; volatile LAS unsigned* st; };
__device__ __forceinline__ XcdBarrier xcd_barrier_post(unsigned* bar, volatile LAS unsigned* st) {
    XcdBarrier b; b.bar = bar; b.x = xb_xcc_id(); b.st = st;
    if (threadIdx.x == 0) (void)xb_add(&bar[XB_XCNT(b.x)], 1u);
    return b;
}
__device__ __forceinline__ void xcd_barrier_complete(unsigned* bar, unsigned x, unsigned& nloc, unsigned& nx) {
    const unsigned G = gridDim.x * gridDim.y * gridDim.z;
    unsigned sum, cnt, mine, sp = 0u;
    for (;;) {
        sum = 0u; cnt = 0u; mine = 0u;
#pragma unroll
        for (unsigned j = 0; j < 16; ++j) { const unsigned c = xb_ld(&bar[XB_XCNT(j)]); sum += c; cnt += (c > 0u) ? 1u : 0u; mine = (j == x) ? c : mine; }
        if (sum == G) break;
        __builtin_amdgcn_s_sleep(1);
        if ((++sp & 255u) == 0u) { if (xb_ld(&bar[XB_TMO])) break; if (sp > XB_SPIN_CAP) { atomicAdd(&bar[XB_TMO], 1u); break; } }
    }
    nloc = mine > 0u ? mine : 1u; nx = cnt > 0u ? cnt : 1u;
}
__device__ __forceinline__ void xcd_barrier(const XcdBarrier& b) {
    asm volatile("s_waitcnt vmcnt(0)" ::: "memory");
    __syncthreads();
    if (threadIdx.x == 0) {
        unsigned* bar = b.bar;
        __builtin_amdgcn_s_waitcnt(0);
        unsigned nloc = b.st[0], nx = b.st[1];
        if (nloc == 0u) { xcd_barrier_complete(bar, b.x, nloc, nx); b.st[0] = nloc; b.st[1] = nx; }
        const unsigned old = xb_add(&bar[XB_XSUB(b.x)], 1u);
        const unsigned gen = old / nloc;
        if (old + 1u == (gen + 1u) * nloc) {
            __builtin_amdgcn_fence(__ATOMIC_RELEASE, "agent");
            asm volatile("s_waitcnt vmcnt(0)" ::: "memory");
            const unsigned og = xb_add(&bar[XB_TOP], 1u);
            const unsigned tg = og / nx;
            if (og + 1u == (tg + 1u) * nx) xb_add(&bar[XB_TOPGEN], 1u);
            else XB_SPIN(xb_ld(&bar[XB_TOPGEN]) == tg, bar);
            __builtin_amdgcn_fence(__ATOMIC_ACQUIRE, "agent");
            xb_add(&bar[XB_XGEN(b.x)], 1u);
            asm volatile("s_waitcnt vmcnt(0)" ::: "memory");
        } else {
            XB_SPIN(xb_ld(&bar[XB_XGEN(b.x)]) == gen, bar);
            __builtin_amdgcn_fence(__ATOMIC_ACQUIRE, "agent");
            asm volatile("s_waitcnt vmcnt(0)" ::: "memory");
        }
    }
    __syncthreads();
}

enum { PH_INIT = 0, PH_NORM1, PH_INPROJ, PH_CONV, PH_SCANA, PH_SCANB, PH_SCANC, PH_HNORM, PH_OUTPROJ, PH_NORM2, PH_LISTS, PH_GU, PH_DOWN, PH_COMBINE, PH_FINAL };

constexpr int NPHASE = 1 + 13 * DEPTH;
template <int ph, int l>
__device__ __forceinline__ void run_phase(LAS unsigned char* lds_raw) {
    int tid_ = threadIdx.x; asm volatile("" : "+v"(tid_));
    CArgs* ap_ = (CArgs*)__builtin_amdgcn_kernarg_segment_ptr(); asm volatile("" : "+s"(ap_));
    CArgs& A_ = *ap_;
    unsigned char* ws_ = A_.ws; asm volatile("" : "+s"(ws_));
    unsigned lb_ = 0u, bx_ = blockIdx.x, gx_ = gridDim.x; asm volatile("" : "+s"(lb_), "+s"(bx_), "+s"(gx_));
    Frame F; F.lds = lds_raw + lb_; F.out = A_.out; F.ws = ws_;
    F.tid = tid_; F.lane = F.tid & 63; F.wave = __builtin_amdgcn_readfirstlane(F.tid >> 6);
    F.G = (int)gx_; { const int bx = (int)bx_; F.vcu = (F.G % 8 == 0) ? (bx % 8) * (F.G / 8) + bx / 8 : bx; }
    constexpr int nrows = (l == DEPTH - 1) ? NLAT : NTOK;
    constexpr bool CVPH = (l == 0) && (ph <= PH_LISTS);
    constexpr int CQ0 = ph == PH_INIT ? 0 : ph == PH_NORM1 ? 25 : ph == PH_INPROJ ? 55 : ph == PH_CONV ? 140 : ph == PH_SCANA ? 165 : ph == PH_SCANB ? 205 : ph == PH_SCANC ? 233 : ph == PH_OUTPROJ ? 313 : ph == PH_NORM2 ? 344 : 378;
    constexpr int CQ1 = ph == PH_INIT ? 25 : ph == PH_NORM1 ? 55 : ph == PH_INPROJ ? 140 : ph == PH_CONV ? 165 : ph == PH_SCANA ? 205 : ph == PH_SCANB ? 233 : ph == PH_SCANC ? 313 : ph == PH_OUTPROJ ? 344 : ph == PH_NORM2 ? 378 : CV_NJ;
    const bool cvgrid = false;
    if (CVPH && cvgrid) {
        if (bx_ >= 224u) { const int cvcu = (int)(bx_ & 7u) * 4 + ((int)(bx_ >> 3) - 28); convert_moe(ws_, F.lds, A_, cvcu * 8 + F.wave, F.wave, F.lane, CQ0, CQ1); return; }
        F.G = 224; F.vcu = (int)(bx_ & 7u) * 28 + (int)(bx_ >> 3); gx_ = 224u;
    }
    switch (ph) {
        case PH_INIT: ph_init(F, A_); ph_convert(F, A_, true); break;
        case PH_INPROJ: {
            const bool cfirst = ((bx_ >> 3) & 1u) == 0u;
            int base, nblk;
            if (F.G == 256 && l == 0) { if (bx_ >= 32u) { const int ix = (int)bx_ - 32; nblk = 74 + (ix < 16 ? 1 : 0); base = ix * 74 + (ix < 16 ? ix : 16); } else { base = 16592 + (int)bx_ * 48; nblk = 48; } }
            else if (F.G == 256) { if (bx_ >= 32u) { base = ((int)bx_ - 32) * 100; nblk = 100; } else { base = 22400 + (int)bx_ * 68; nblk = 68; } }
            else { const int per = (24576 + F.G - 1) / F.G; base = F.vcu * per; nblk = base + per <= 24576 ? per : (base < 24576 ? 24576 - base : 0); }
            base += l * 24576;
            if (cfirst) { convert_moe_all(F.ws, F.lds, A_, F.wave, NWAVES, F.wave, F.lane, base, base + nblk); __syncthreads(); }
            { pg8::Gemm g{(const bf16*)(F.ws + WS_H), (const bf16*)(F.ws + WS_WIN) + (size_t)l * PW * D, D, nullptr, nullptr, 0};
              pg8::StaticOrder S; S.init(NTOK / 256, PW / 256, F.G, (int)bx_); pg8::EpiBf16 E{(bf16*)(F.ws + WS_P), PW};
              pg8::gemm_phase<pg8::EpiBf16, pg8::StaticOrder, true>(F.lds, g, S, E, F.tid); }
            if (!cfirst) { __syncthreads(); convert_moe_all(F.ws, F.lds, A_, F.wave, NWAVES, F.wave, F.lane, base, base + nblk); }
        } break;
        case PH_NORM1: if (l == 0) ph_rows<1, 0>(F, A_, 0, 0, NTOK); break;
        case PH_CONV: ph_conv(F, A_, l); break;
        case PH_SCANA: {
#define LD_(t, R) ml_passA_load(F, t, R)
#define RN_(t, R) ml_passA_run(F, t, R)
            TASK_LOOP(MlARaw, LD_, RN_, 0, 8 * NTC);
#undef LD_
#undef RN_
#define LD_(t, R) hg_passA_load(F, t, R)
#define RN_(t, R) hg_passA_run(F, A_, l, t, R)
            TASK_LOOP(HgARaw, LD_, RN_, 8 * NTC, 16 * NTC);
#undef LD_
#undef RN_
        } break;
        case PH_SCANB: scan_passB(F); break;
        case PH_SCANC: {
#define LD_(t, R) ml_passC_load(F, t, R)
#define RN_(t, R) ml_passC_run(F, A_, l, t, R)
            TASK_LOOP(MlCRaw, LD_, RN_, 0, 8 * NTC);
#undef LD_
#undef RN_
#define LD_(t, R) hg_passC_load(F, t, R)
#define RN_(t, R) hg_passC_run(F, A_, l, t, R)
            TASK_LOOP(HgCRaw, LD_, RN_, 8 * NTC, 16 * NTC);
#undef LD_
#undef RN_
        } break;
        case PH_OUTPROJ: { pg8::Gemm g{(const bf16*)(F.ws + WS_Y), (const bf16*)(F.ws + WS_WOUT) + (size_t)l * D * D, D, nullptr, nullptr, 0};
            pg8::StaticOrder S; S.init(nrows / 256, D / 256, F.G, (int)bx_);
            const float* xs = (const float*)(F.ws + WS_X);
            pg8::EpiResid E{(float*)(F.ws + WS_X), (const float*)(F.ws + WS_MOD) + (size_t)l * 3 * 6144 + 2048, l == 0 ? A_.in[I_X] : xs, l == 0 ? A_.in[I_CTX] : xs + (size_t)NLAT * D};
            pg8::gemm_phase<pg8::EpiResid, pg8::StaticOrder, true>(F.lds, g, S, E, F.tid);
            if (l == 0 && F.G == 256 && bx_ >= 8u) { __syncthreads(); const int base = 18128 + ((int)bx_ - 8) * 26; convert_moe_all(F.ws, F.lds, A_, F.wave, NWAVES, F.wave, F.lane, base, base + 26); } } break;
        case PH_GU: { const int* rt = (const int*)(F.ws + WS_ROUTE); const int ntile = rt[RT_TILEE];
            pg8::Gemm g{(const bf16*)(F.ws + WS_H), (const bf16*)(F.ws + WS_WGU) + (size_t)l * NEXP * 2048 * D, D, rt + RT_LIST, rt + RT_TILEE, (size_t)2048 * D};
            pg8::StaticOrder S; S.init(ntile, 2048 / 256, F.G, (int)bx_);
            pg8::EpiSwiglu E{(bf16*)(F.ws + WS_ACT), A_.in[I_BGU] + (size_t)l * NEXP * 2048, rt + RT_TILEE};
            pg8::gemm_phase<pg8::EpiSwiglu, pg8::StaticOrder, true>(F.lds, g, S, E, F.tid); } break;
        case PH_DOWN: { const int* rt = (const int*)(F.ws + WS_ROUTE); const int ntile = rt[RT_TILEE];
            pg8::Gemm g{(const bf16*)(F.ws + WS_ACT), (const bf16*)(F.ws + WS_WDN) + (size_t)l * NEXP * D * DEXP, DEXP, nullptr, rt + RT_TILEE, (size_t)D * DEXP};
            pg8::StaticOrder S; S.init(ntile, D / 256, F.G, (int)bx_);
            pg8::EpiDown E{(bf16*)(F.ws + WS_YS), A_.in[I_BDN] + (size_t)l * NEXP * D, (const float*)(rt + RT_SGATE), rt + RT_TILEE};
            pg8::gemm_phase<pg8::EpiDown, pg8::StaticOrder, true>(F.lds, g, S, E, F.tid); } break;
        case PH_HNORM: ph_hnorm(F, A_, l, l == DEPTH - 1); break;
        case PH_NORM2: ph_rows<0, 1>(F, A_, l, l, nrows); break;
        case PH_LISTS: ph_lists(F, A_, l, nrows); break;
        case PH_COMBINE: if (l == DEPTH - 1) ph_rows<2, 2>(F, A_, l, 0, NLAT); else ph_rows<2, 0>(F, A_, l, l + 1, NTOK); break;
        default: break;
    }
}
__global__ void __launch_bounds__(NTHR, 2) fwd(Args a) {
    extern __shared__ __attribute__((aligned(16))) unsigned char lds_raw[];
    volatile LAS unsigned* bst = (volatile LAS unsigned*)((LAS unsigned char*)lds_raw + LDS_BYTES - 64);
    if (threadIdx.x < 16) bst[threadIdx.x] = 0u;
    __syncthreads();
    XcdBarrier bar = xcd_barrier_post((unsigned*)(a.ws + WS_CTL) + CW_BAR, bst);
#ifndef TPROBE
#define TPROBE 0
#endif
#ifndef TP0
#define TP0 0
#define TP1 0
#define TP2 0
#define TD0 800
#define TD1 800
#define TD2 800
#endif
    unsigned ta0 = 0u, ta1 = 0u, ta2 = 0u; unsigned long long tprev = 0;
    const bool stamper = TPROBE && blockIdx.x == 0;
    if (stamper) tprev = __builtin_amdgcn_s_memrealtime();
#define RUN(pi, ph, l) do { run_phase<ph, l>((LAS unsigned char*)lds_raw); if ((pi) != NPHASE - 1 || TPROBE) xcd_barrier(bar); \
    if (stamper) { const unsigned long long tn = __builtin_amdgcn_s_memrealtime(); const unsigned dt = (unsigned)(tn - tprev); tprev = tn; \
        if ((ph) == TP0) ta0 += dt; if ((ph) == TP1) ta1 += dt; if ((ph) == TP2) ta2 += dt; } } while (0)
#define LAYER(l) if (l == 0) RUN(1 + 13 * l, PH_NORM1, l); RUN(2 + 13 * l, PH_INPROJ, l); RUN(3 + 13 * l, PH_CONV, l); RUN(4 + 13 * l, PH_SCANA, l); RUN(5 + 13 * l, PH_SCANB, l); RUN(6 + 13 * l, PH_SCANC, l); \
    RUN(8 + 13 * l, PH_OUTPROJ, l); RUN(9 + 13 * l, PH_NORM2, l); RUN(10 + 13 * l, PH_LISTS, l); RUN(11 + 13 * l, PH_GU, l); RUN(12 + 13 * l, PH_DOWN, l); RUN(13 + 13 * l, PH_COMBINE, l)
    RUN(0, PH_INIT, 0);
    LAYER(0);
    LAYER(1);
#undef LAYER
#undef RUN
    if (TPROBE) {
        if (stamper) { const unsigned long long tn = __builtin_amdgcn_s_memrealtime();
            unsigned q0 = (ta0 + TD0 / 2) / TD0, q1 = (ta1 + TD1 / 2) / TD1, q2 = (ta2 + TD2 / 2) / TD2;
            q0 = q0 > 31u ? 31u : q0; q1 = q1 > 31u ? 31u : q1; q2 = q2 > 31u ? 31u : q2;
            const unsigned long long delay = (unsigned long long)(q0 + 32u * q1 + 1024u * q2) * 1600ull;
            while (__builtin_amdgcn_s_memrealtime() - tn < delay) __builtin_amdgcn_s_sleep(8);
        }
    }
}

template <int NB, class Epi>
__global__ void __launch_bounds__(256) naive_gemm(const bf16* A, int lda, const int* gather, const int* tile_e, int M, const float* B, size_t bexp, int ldb, int N, int K, int bshift_from, int bshift, int bgrp, Epi E) {
    __shared__ float As[16][68]; __shared__ float Bs[NB][16][68];
    const int m0 = blockIdx.y * 64, n0 = blockIdx.x * 64, tid = threadIdx.x, tx = tid & 15, ty = tid >> 4;
    int e = 0;
    if (tile_e) { const int nt = tile_e[0]; if (m0 >= nt * 256) return; e = tile_e[8 + (m0 >> 8)]; } else if (m0 >= M) return;
    const float* Bp = B + (size_t)e * bexp + (n0 + (n0 >= bshift_from ? bshift : 0));
    const int ar = tid >> 2, ak = (tid & 3) * 4; const int arow = gather ? gather[m0 + ar] : (m0 + ar);
    const bf16* Ap = A + (size_t)arow * lda + ak;
    const int bk = tid >> 4, bn = (tid & 15) * 4;
    float acc[NB][4][4];
#pragma unroll
    for (int g = 0; g < NB; ++g)
#pragma unroll
        for (int i = 0; i < 4; ++i)
#pragma unroll
            for (int j = 0; j < 4; ++j) acc[g][i][j] = 0.f;
    for (int k0 = 0; k0 < K; k0 += 16) {
        const u32x2 av = *(const u32x2*)(Ap + k0);
        As[ak + 0][ar] = bflo(av.x); As[ak + 1][ar] = bfhi(av.x); As[ak + 2][ar] = bflo(av.y); As[ak + 3][ar] = bfhi(av.y);
#pragma unroll
        for (int g = 0; g < NB; ++g) { const f32x4 bv = *(const f32x4*)(Bp + (size_t)(k0 + bk) * ldb + g * bgrp + bn); *(f32x4*)&Bs[g][bk][bn] = bv; }
        __syncthreads();
#pragma unroll
        for (int k = 0; k < 16; ++k) { const f32x4 a4 = *(const f32x4*)&As[k][ty * 4];
#pragma unroll
            for (int g = 0; g < NB; ++g) { const f32x4 b4 = *(const f32x4*)&Bs[g][k][tx * 4];
#pragma unroll
                for (int i = 0; i < 4; ++i) { acc[g][i][0] += a4[i] * b4[0]; acc[g][i][1] += a4[i] * b4[1]; acc[g][i][2] += a4[i] * b4[2]; acc[g][i][3] += a4[i] * b4[3]; } } }
        __syncthreads();
    }
#pragma unroll
    for (int i = 0; i < 4; ++i)
#pragma unroll
        for (int j = 0; j < 4; ++j) E(m0 + ty * 4 + i, n0 + tx * 4 + j, acc[0][i][j], NB == 2 ? acc[NB - 1][i][j] : 0.f, e);
}
struct EpiP { bf16* P; __device__ void operator()(int r, int c, float v, float, int) const { P[(size_t)r * PW + c] = (bf16)f2bf(v); } };
struct EpiOut { float* X; const float* MOD; __device__ void operator()(int r, int c, float v, float, int) const { X[(size_t)r * D + c] += MOD[mrow_of(r) * 6144 + 2048 + c] * v; } };
struct EpiGU { bf16* ACT; const float* bgu; __device__ void operator()(int r, int c, float g, float li, int e) const {
    g += bgu[(size_t)e * 2048 + c]; li += bgu[(size_t)e * 2048 + 1024 + c]; g = fminf(g, 7.f); li = fminf(fmaxf(li, -7.f), 7.f);
    ACT[(size_t)r * DEXP + c] = (bf16)f2bf(g * sigmoidf_(1.702f * g) * (li + 1.f)); } };
struct EpiDown { bf16* YS; const float* bdn; const float* sgate; __device__ void operator()(int r, int c, float v, float, int e) const { YS[(size_t)r * D + c] = (bf16)f2bf((v + bdn[(size_t)e * D + c]) * sgate[r]); } };

__global__ void __launch_bounds__(128) naive_mlstm(const bf16* CQK, const bf16* P, const float* GATES, float* HF, float* HB) {
    __shared__ float qs[8][64], ks[8][64];
    const int b = blockIdx.x >> 3, h = (blockIdx.x >> 1) & 3, dir = blockIdx.x & 1, tid = threadIdx.x;
    float C[64], n[64], m = 0.f;
#pragma unroll
    for (int d = 0; d < 64; ++d) { C[d] = 0.f; n[d] = 0.f; }
    float* OUT = dir ? HB : HF;
    for (int p0 = 0; p0 < CTX + SEQ; p0 += 8) {
        __syncthreads();
        { const int st = tid >> 4, pc = tid & 15, p = p0 + st; int row;
          if (p < CTX) row = NLAT + b * CTX + (dir ? CTX - 1 - p : p); else { const int q = p - CTX; row = b * SEQ + (dir ? SEQ - 1 - q : q); }
          const u32x4 w = *(const u32x4*)(CQK + (size_t)row * 512 + (pc < 8 ? h * 64 + pc * 8 : 256 + h * 64 + (pc - 8) * 8));
          float* dst = pc < 8 ? &qs[st][pc * 8] : &ks[st][(pc - 8) * 8];
          dst[0] = bflo(w.x); dst[1] = bfhi(w.x); dst[2] = bflo(w.y); dst[3] = bfhi(w.y); dst[4] = bflo(w.z); dst[5] = bfhi(w.z); dst[6] = bflo(w.w); dst[7] = bfhi(w.w); }
        __syncthreads();
        for (int st = 0; st < 8; ++st) {
            const int p = p0 + st; int row;
            if (p < CTX) row = NLAT + b * CTX + (dir ? CTX - 1 - p : p); else { const int q = p - CTX; row = b * SEQ + (dir ? SEQ - 1 - q : q); }
            const float ig = GATES[(size_t)row * 16 + dir * 4 + h], lf = GATES[(size_t)row * 16 + 8 + dir * 4 + h];
            const float v = bf2f(P[(size_t)row * PW + PC_V + h * 128 + tid]);
            const float mn = fmaxf(lf + m, ig), a = __expf(lf + m - mn), w = __expf(ig - mn), wv = w * v; m = mn;
            float num = 0.f, den = 0.f;
#pragma unroll
            for (int d = 0; d < 64; ++d) { const float kd = ks[st][d], qd = qs[st][d]; C[d] = a * C[d] + wv * kd; n[d] = a * n[d] + w * kd; num += C[d] * qd; den += n[d] * qd; }
            OUT[(size_t)row * D + h * 128 + tid] = num / fmaxf(fabsf(den), __expf(-mn));
        }
    }
}
__global__ void __launch_bounds__(128) naive_hgrn(const bf16* CQI, const bf16* P, const float* fb_l, const float* lbraw, int l, float* HF, float* HB) {
    __shared__ float fs[8][128], ks[8][128], qs[8][128];
    const int b = blockIdx.x >> 3, h = (blockIdx.x >> 1) & 3, dir = blockIdx.x & 1, tid = threadIdx.x, ch = h * 128 + tid;
    float S[128];
#pragma unroll
    for (int d = 0; d < 128; ++d) S[d] = 0.f;
    float lb = 0.f;
    if (l == 1) { const float r0 = lbraw[ch], r1 = lbraw[512 + ch], mx = fmaxf(r0, r1), e0 = __expf(r0 - mx), e1 = __expf(r1 - mx); lb = e1 / (e0 + e1); }
    const float bias = fb_l[dir * 512 + ch];
    float* OUT = dir ? HB : HF;
    for (int p0 = 0; p0 < CTX + SEQ; p0 += 8) {
        __syncthreads();
        float vv[8]; int rows[8];
#pragma unroll
        for (int st = 0; st < 8; ++st) { const int p = p0 + st; int row;
            if (p < CTX) row = NLAT + b * CTX + (dir ? CTX - 1 - p : p); else { const int q = p - CTX; row = b * SEQ + (dir ? SEQ - 1 - q : q); }
            rows[st] = row;
            const float z = bf2f(P[(size_t)row * PW + (dir ? PC_FB : PC_FF) + ch]) + bias;
            fs[st][tid] = lb + (1.f - lb) * sigmoidf_(z); ks[st][tid] = (1.f - lb) * sigmoidf_(-z);
            qs[st][tid] = bf2f(CQI[(size_t)row * 1024 + ch]); vv[st] = bf2f(CQI[(size_t)row * 1024 + 512 + ch]); }
        __syncthreads();
#pragma unroll
        for (int st = 0; st < 8; ++st) { float o = 0.f; const float v = vv[st];
#pragma unroll
            for (int d = 0; d < 128; ++d) { S[d] = fs[st][d] * S[d] + ks[st][d] * v; o += qs[st][d] * S[d]; }
            OUT[(size_t)rows[st] * D + 512 + ch] = o; }
    }
}

extern "C" void kernel_launch(void* const* d_in, const int* in_sizes, int n_in, void* d_out, int out_size, void* d_ws, size_t ws_size, hipStream_t stream) {
    static int grid = 0;
    if (grid == 0) {
        if (n_in != 24 || in_sizes[0] != NLAT * D || out_size != NLAT * D || ws_size < WS_END) { fprintf(stderr, "kernel_launch: unexpected shapes n_in %d in0 %d out %d ws %zu (need %zu)\n", n_in, n_in > 0 ? in_sizes[0] : -1, out_size, ws_size, (size_t)WS_END); grid = -1; return; }
        int dev = 0, cus = 0;
        if (hipGetDevice(&dev) != hipSuccess || hipDeviceGetAttribute(&cus, hipDeviceAttributeMultiprocessorCount, dev) != hipSuccess) { grid = -1; return; }
        if (hipFuncSetAttribute((const void*)fwd, hipFuncAttributeMaxDynamicSharedMemorySize, LDS_BYTES) != hipSuccess) { fprintf(stderr, "kernel_launch: hipFuncSetAttribute failed\n"); grid = -1; return; }
        grid = cus;
    }
    if (grid < 0) return;
    (void)hipMemsetAsync((char*)d_ws + WS_CTL, 0, 1 * MiB, stream);
    Args a{};
    for (int i = 0; i < 24; ++i) a.in[i] = (const float*)d_in[i];
    a.out = (float*)d_out; a.ws = (unsigned char*)d_ws; a.ph_lo = 0; a.ph_hi = 0;
    unsigned char* ws = (unsigned char*)d_ws;
    const float* const* in = a.in;
    int* rt = (int*)(ws + WS_ROUTE);
    a.ph_lo = 0; a.ph_hi = NPHASE;
    hipLaunchKernelGGL(fwd, dim3(grid), dim3(NTHR), LDS_BYTES, stream, a);
}
```

```cpp
#include <hip/hip_runtime.h>
#include <cstdio>
#include <cstdint>

#define GAS __attribute__((address_space(1)))
#define LAS __attribute__((address_space(3)))
typedef unsigned short bf16;
typedef float f32x4 __attribute__((ext_vector_type(4)));
typedef unsigned u32x4 __attribute__((ext_vector_type(4)));
typedef unsigned u32x2 __attribute__((ext_vector_type(2)));

constexpr int D = 1024, BATCH = 2, SEQ = 8192, DEPTH = 2, CTX = 256, GRIDW = 64;
constexpr int NLAT = BATCH * SEQ, NCTX = BATCH * CTX, NTOK = NLAT + NCTX;
constexpr int INW = 4112, PW = 4096;
constexpr int PC_QK = 0, PC_V = 512, PC_O = 1024, PC_QI = 1536, PC_FF = 2560, PC_FB = 3072, PC_GO = 3584;
constexpr int NEXP = 32, TOPK = 4, DEXP = 1024;
constexpr int MAXSLOT = (NTOK * TOPK / 256 + NEXP) * 256;
constexpr int MAXTILE = MAXSLOT / 256;
constexpr float EPS = 1e-6f;

constexpr size_t MiB = 1u << 20;
constexpr size_t WS_CTL = 0;
constexpr size_t WS_MOD = 1 * MiB;
constexpr size_t WS_GATES = 2 * MiB;
constexpr size_t WS_ROUTE = 4 * MiB;
constexpr size_t WS_X = 8 * MiB;
constexpr size_t WS_H = 76 * MiB;
constexpr size_t WS_P = 112 * MiB;
constexpr size_t WS_CQK = 246 * MiB;
constexpr size_t WS_CQI = 264 * MiB;
constexpr size_t WS_HF = 300 * MiB;
constexpr size_t WS_HB = 368 * MiB;
constexpr size_t WS_Y = 436 * MiB;
constexpr size_t WS_ACT = 472 * MiB;
constexpr size_t WS_YS = 622 * MiB;
constexpr size_t WS_WIN = 772 * MiB;
constexpr size_t WS_WOUT = 788 * MiB;
constexpr size_t WS_WGU = 792 * MiB;
constexpr size_t WS_WDN = 1048 * MiB;
constexpr size_t WS_MLC = 1176 * MiB;
constexpr size_t WS_MLN = 1246 * MiB;
constexpr size_t WS_MLS = 1247 * MiB;
constexpr size_t WS_HGS = 1248 * MiB;
constexpr size_t WS_HGG = 1388 * MiB;
constexpr size_t WS_MLCB = 1390 * MiB;
constexpr size_t WS_HGSB = 1426 * MiB;
constexpr size_t WS_END = 1496 * MiB;
constexpr int NTC = 132;
constexpr int RT_TOPI = 0;
constexpr int RT_TOPG = RT_TOPI + NTOK * 4;
constexpr int RT_POS = RT_TOPG + NTOK * 4;
constexpr int RT_SLOT = RT_POS + NTOK * 4;
constexpr int RT_LIST = RT_SLOT + NTOK * 4;
constexpr int RT_SGATE = RT_LIST + MAXSLOT;
constexpr int RT_TILEE = RT_SGATE + MAXSLOT;
constexpr int RT_BLKCNT = RT_TILEE + MAXTILE + 8;
constexpr int MAXG = 1024;
constexpr int RT_END = RT_BLKCNT + MAXG * 32;
static_assert((size_t)RT_END * 4 <= 4 * MiB, "route map");
constexpr int CW_CNT = 1024;
constexpr int CW_BAR = 4096;

typedef float f32x2_t __attribute__((ext_vector_type(2)));
typedef __bf16 bf16x2_t __attribute__((ext_vector_type(2)));
__device__ __forceinline__ unsigned pk2(float lo, float hi) { const f32x2_t v = {lo, hi}; return __builtin_bit_cast(unsigned, __builtin_convertvector(v, bf16x2_t)); }
__device__ __forceinline__ unsigned f2bf(float f) { return pk2(f, 0.f) & 0xffffu; }
__device__ __forceinline__ float bf2f(unsigned short b) { return __builtin_bit_cast(float, (unsigned)b << 16); }
__device__ __forceinline__ float bflo(unsigned w) { return __builtin_bit_cast(float, w << 16); }
__device__ __forceinline__ float bfhi(unsigned w) { return __builtin_bit_cast(float, w & 0xffff0000u); }
__device__ __forceinline__ float sigmoidf_(float x) { return 1.f / (1.f + __expf(-x)); }
__device__ __forceinline__ float siluf_(float x) { return x / (1.f + __expf(-x)); }
__device__ __forceinline__ float logsigmoidf_(float x) { return x >= 0.f ? -log1pf(__expf(-x)) : x - log1pf(__expf(x)); }
template <int CTRL, int ROWMASK, bool BOUND0>
__device__ __forceinline__ float dppf(float old, float x) { return __builtin_bit_cast(float, __builtin_amdgcn_update_dpp(__builtin_bit_cast(int, old), __builtin_bit_cast(int, x), CTRL, ROWMASK, 0xf, BOUND0)); }
__device__ __forceinline__ float half_sum_hi(float x) {
    x += dppf<0xB1, 0xf, true>(0.f, x); x += dppf<0x4E, 0xf, true>(0.f, x); x += dppf<0x114, 0xf, true>(0.f, x); x += dppf<0x118, 0xf, true>(0.f, x);
    x += dppf<0x142, 0xa, true>(0.f, x); return x; }
__device__ __forceinline__ float wave_sum(float v) {
    v = half_sum_hi(v); v += dppf<0x143, 0xc, true>(0.f, v); return __builtin_bit_cast(float, __builtin_amdgcn_readlane(__builtin_bit_cast(int, v), 63)); }
__device__ __forceinline__ float wave_incl_sum(float v, int) {
    v += dppf<0x111, 0xf, true>(0.f, v); v += dppf<0x112, 0xf, true>(0.f, v); v += dppf<0x114, 0xf, true>(0.f, v); v += dppf<0x118, 0xf, true>(0.f, v);
    v += dppf<0x142, 0xa, true>(0.f, v); v += dppf<0x143, 0xc, true>(0.f, v); return v; }
__device__ __forceinline__ float wave_incl_max(float v, int) {
    const float NI = -INFINITY;
    v = fmaxf(v, dppf<0x111, 0xf, false>(NI, v)); v = fmaxf(v, dppf<0x112, 0xf, false>(NI, v)); v = fmaxf(v, dppf<0x114, 0xf, false>(NI, v)); v = fmaxf(v, dppf<0x118, 0xf, false>(NI, v));
    v = fmaxf(v, dppf<0x142, 0xa, false>(NI, v)); v = fmaxf(v, dppf<0x143, 0xc, false>(NI, v)); return v; }
__device__ __forceinline__ float wave_max(float v) { v = wave_incl_max(v, 0); return __builtin_bit_cast(float, __builtin_amdgcn_readlane(__builtin_bit_cast(int, v), 63)); }
__device__ __forceinline__ int mrow_of(int r) { return r < NLAT ? (r >> 13) : 2; }

struct Args { const float* in[24]; float* out; unsigned char* ws; int ph_lo, ph_hi; };
typedef const __attribute__((address_space(4))) Args CArgs;

enum { I_X = 0, I_C, I_CTX, I_CCTX, I_WADA, I_BADA, I_N1G, I_WIN, I_MLCONV, I_MLGB, I_MLNG, I_HGCONV, I_HGFB, I_HGLB, I_HGNG, I_WOUT, I_N2G, I_RW, I_RB, I_WGU, I_BGU, I_WDN, I_BDN, I_FG };

constexpr int NWAVES = 8, NTHR = 512;
constexpr int LDS_BYTES = 147456;

struct Frame {
    LAS unsigned char* lds;
    float* out; unsigned char* ws;
    int tid, lane, wave, vcu, G;
};

__device__ __forceinline__ void ph_init(Frame& F, CArgs& A) {
    const int gt = F.vcu * NTHR + F.tid, NG = F.G * NTHR;
    if (gt < 128) ((u32x4*)(F.ws + WS_H + (size_t)NTOK * D * 2))[gt] = (u32x4){0u, 0u, 0u, 0u};
    LAS float* sc = (LAS float*)F.lds;
    LAS float* part = sc + 3 * 1024;
    for (int i = F.tid; i < 3 * 1024; i += NTHR) { const int r = i >> 10, k = i & 1023; const float c = r < 2 ? A.in[I_C][r * 1024 + k] : A.in[I_CCTX][k]; sc[i] = siluf_(c); }
    __syncthreads();
    for (int item = F.vcu; item < DEPTH * 96; item += F.G) {
        const int l = item / 96, j = (item % 96) * 64 + F.lane;
        const float* w = A.in[I_WADA] + (size_t)l * D * 6144 + j;
        float a0 = 0.f, a1 = 0.f, a2 = 0.f;
        for (int k0 = F.wave * 128; k0 < F.wave * 128 + 128; k0 += 32) { float wv[32];
#pragma unroll
            for (int i = 0; i < 32; ++i) wv[i] = w[(size_t)(k0 + i) * 6144];
#pragma unroll
            for (int i = 0; i < 32; ++i) { a0 += sc[k0 + i] * wv[i]; a1 += sc[1024 + k0 + i] * wv[i]; a2 += sc[2048 + k0 + i] * wv[i]; } }
        part[(F.wave * 3 + 0) * 64 + F.lane] = a0; part[(F.wave * 3 + 1) * 64 + F.lane] = a1; part[(F.wave * 3 + 2) * 64 + F.lane] = a2;
        __syncthreads();
        if (F.tid < 192) { const int r = F.tid >> 6, ln = F.tid & 63; float s = 0.f;
#pragma unroll
            for (int w8 = 0; w8 < 8; ++w8) s += part[(w8 * 3 + r) * 64 + ln];
            const int jj = (item % 96) * 64 + ln;
            ((float*)(F.ws + WS_MOD))[(l * 3 + r) * 6144 + jj] = s + A.in[I_BADA][l * 6144 + jj]; }
        __syncthreads();
    }
}

typedef unsigned u32x2v __attribute__((ext_vector_type(2)));
__device__ __forceinline__ float xor32(float send, int lane) { const unsigned u = __builtin_bit_cast(unsigned, send); const u32x2v r = __builtin_amdgcn_permlane32_swap(u, u, false, false);
    return __builtin_bit_cast(float, (lane & 32) ? r.x : r.y); }
__device__ __forceinline__ float xor16(float send, int lane) { const unsigned u = __builtin_bit_cast(unsigned, send); const u32x2v r = __builtin_amdgcn_permlane16_swap(u, u, false, false);
    return __builtin_bit_cast(float, (lane & 16) ? r.x : r.y); }
__device__ __forceinline__ float xor8(float x) { return dppf<0x140, 0xf, true>(0.f, dppf<0x141, 0xf, true>(0.f, x)); }
__device__ __forceinline__ float xor4(float x) { return dppf<0x141, 0xf, true>(0.f, dppf<0x1B, 0xf, true>(0.f, x)); }
__device__ __forceinline__ float xor2(float x) { return dppf<0x4E, 0xf, true>(0.f, x); }
__device__ __forceinline__ float xor1(float x) { return dppf<0xB1, 0xf, true>(0.f, x); }
template <int NV> __device__ __forceinline__ float reduce_scatter(float (&v)[NV], int lane) {
    float a16[16];
    if constexpr (NV == 32) { const bool hi = lane & 32;
#pragma unroll
        for (int i = 0; i < 16; ++i) { const float keep = hi ? v[16 + i] : v[i], send = hi ? v[i] : v[16 + i]; a16[i] = keep + xor32(send, lane); } }
    else {
#pragma unroll
        for (int i = 0; i < 16; ++i) a16[i] = v[i] + xor1(v[i]); }
    float a8[8], a4[4], a2[2];
    { const bool hi = lane & 16;
#pragma unroll
      for (int i = 0; i < 8; ++i) { const float keep = hi ? a16[8 + i] : a16[i], send = hi ? a16[i] : a16[8 + i]; a8[i] = keep + xor16(send, lane); } }
    { const bool hi = lane & 8;
#pragma unroll
      for (int i = 0; i < 4; ++i) { const float keep = hi ? a8[4 + i] : a8[i], send = hi ? a8[i] : a8[4 + i]; a4[i] = keep + xor8(send); } }
    { const bool hi = lane & 4;
#pragma unroll
      for (int i = 0; i < 2; ++i) { const float keep = hi ? a4[2 + i] : a4[i], send = hi ? a4[i] : a4[2 + i]; a2[i] = keep + xor4(send); } }
    float r;
    { const bool hi = lane & 2; const float keep = hi ? a2[1] : a2[0], send = hi ? a2[0] : a2[1]; r = keep + xor2(send); }
    if constexpr (NV == 32) r += xor1(r); else r += xor32(r, lane);
    return r;
}
struct RowIn { f32x4 x[4]; u32x2 y[4][4]; };
template <int SRC>
__device__ __forceinline__ void row_load(Frame& F, CArgs& A, int r, const int (&slot)[4], RowIn& R) {
    const float* src = SRC == 1 ? (r < NLAT ? A.in[I_X] + (size_t)r * D : A.in[I_CTX] + (size_t)(r - NLAT) * D) : (const float*)(F.ws + WS_X) + (size_t)r * D;
    const f32x4* xr = (const f32x4*)src + F.lane;
#pragma unroll
    for (int j = 0; j < 4; ++j) R.x[j] = xr[64 * j];
    if (SRC == 2) {
#pragma unroll
        for (int k = 0; k < 4; ++k) { const u32x2* yp = (const u32x2*)(F.ws + WS_YS + (size_t)slot[k] * D * 2) + F.lane;
#pragma unroll
            for (int j = 0; j < 4; ++j) R.y[k][j] = yp[64 * j]; } }
}
#define LDS_BARRIER() do { asm volatile("s_waitcnt lgkmcnt(0)" ::: "memory"); __builtin_amdgcn_s_barrier(); asm volatile("" ::: "memory"); } while (0)
template <int SRC, int MODE>
__device__ __forceinline__ void ph_rows(Frame& F, CArgs& A, int lsrc, int l, int nrows) {
    constexpr int NV = MODE == 0 ? 16 : 32;
    constexpr int EPW = NV / 8;
    f32x2_t wp[EPW][4][2];
    LAS unsigned* lcnt = (LAS unsigned*)(F.lds + 131072);
    if (MODE == 1) { const float* w = A.in[I_RW] + (size_t)l * D * NEXP + 4 * F.wave; if (F.tid < 32) lcnt[F.tid] = 0u;
#pragma unroll
        for (int j = 0; j < 4; ++j) { f32x4 q[4];
#pragma unroll
            for (int i = 0; i < 4; ++i) q[i] = *(const f32x4*)(w + (size_t)(256 * j + 4 * F.lane + i) * NEXP);
#pragma unroll
            for (int e = 0; e < EPW; ++e) { wp[e][j][0] = (f32x2_t){q[0][e], q[1][e]}; wp[e][j][1] = (f32x2_t){q[2][e], q[3][e]}; } } }
    if (MODE == 0) { const float* w = A.in[I_WIN] + (size_t)l * D * INW + 1536 + 2 * F.wave;
#pragma unroll
        for (int j = 0; j < 4; ++j) { f32x2_t q[4];
#pragma unroll
            for (int i = 0; i < 4; ++i) q[i] = *(const f32x2_t*)(w + (size_t)(256 * j + 4 * F.lane + i) * INW);
#pragma unroll
            for (int e = 0; e < EPW; ++e) { wp[e][j][0] = (f32x2_t){q[0][e], q[1][e]}; wp[e][j][1] = (f32x2_t){q[2][e], q[3][e]}; } } }
    const float* gam = MODE == 0 ? A.in[I_N1G] + l * D : (MODE == 1 ? A.in[I_N2G] + l * D : A.in[I_FG]);
    const float* MOD = (const float*)(F.ws + WS_MOD) + (size_t)l * 3 * 6144;
    const float* MODS = (const float*)(F.ws + WS_MOD) + (size_t)lsrc * 3 * 6144;
    const int* rt = (const int*)(F.ws + WS_ROUTE);
    const int stride = F.G * NWAVES; int r = F.vcu * NWAVES + F.wave;
    RowIn cur; int s1[4] = {0, 0, 0, 0}, s2[4] = {0, 0, 0, 0};
    if (SRC == 2) { if (r < nrows) { const u32x4 q = *(const u32x4*)(rt + RT_SLOT + r * 4); s1[0] = q.x; s1[1] = q.y; s1[2] = q.z; s1[3] = q.w; }
                    if (r + stride < nrows) { const u32x4 q = *(const u32x4*)(rt + RT_SLOT + (r + stride) * 4); s2[0] = q.x; s2[1] = q.y; s2[2] = q.z; s2[3] = q.w; } }
    if (r < nrows) row_load<SRC>(F, A, r, s1, cur);
    f32x4 Aq[4], Sq[4], Gq[4]; int mrp = -1;
    const float rbm = MODE == 1 ? A.in[I_RB][l * NEXP + 4 * F.wave + ((F.lane >> 1) & 3)] : 0.f;
    for (; r < nrows; r += stride) {
        RowIn nxt; int s3[4] = {0, 0, 0, 0};
        { const int mr = mrow_of(r);
          if (mr != mrp) { mrp = mr; const float* mod = MOD + mr * 6144 + (MODE == 0 ? 0 : 3072); const float* g2 = MODS + mr * 6144 + 5 * 1024;
#pragma unroll
              for (int j = 0; j < 4; ++j) { const int c = 256 * j + 4 * F.lane; const f32x4 g = *(const f32x4*)(gam + c);
                  if (MODE != 2) { const f32x4 sh = *(const f32x4*)(mod + c), scl = *(const f32x4*)(mod + 1024 + c); Aq[j] = g * (1.f + scl); Sq[j] = sh; } else { Aq[j] = g; Sq[j] = (f32x4){0.f, 0.f, 0.f, 0.f}; }
                  if (SRC == 2) Gq[j] = *(const f32x4*)(g2 + c); } } }
        if (SRC == 2 && r + 2 * stride < nrows) { const u32x4 q = *(const u32x4*)(rt + RT_SLOT + (r + 2 * stride) * 4); s3[0] = q.x; s3[1] = q.y; s3[2] = q.z; s3[3] = q.w; }
        if (r + stride < nrows) row_load<SRC>(F, A, r + stride, s2, nxt);
        f32x4 v[4];
#pragma unroll
        for (int j = 0; j < 4; ++j) v[j] = cur.x[j];
        if (SRC == 2) {
#pragma unroll
            for (int j = 0; j < 4; ++j) { f32x4 a = (f32x4){0.f, 0.f, 0.f, 0.f};
#pragma unroll
                for (int k = 0; k < 4; ++k) { const u32x2 w = cur.y[k][j]; a += (f32x4){bflo(w.x), bfhi(w.x), bflo(w.y), bfhi(w.y)}; }
                v[j] = v[j] + Gq[j] * a; } }
        if (SRC == 2 && MODE != 2) { f32x4* xo = (f32x4*)((float*)(F.ws + WS_X) + (size_t)r * D) + F.lane;
#pragma unroll
            for (int j = 0; j < 4; ++j) xo[64 * j] = v[j]; }
        float ss = 0.f;
#pragma unroll
        for (int j = 0; j < 4; ++j) ss += (v[j].x * v[j].x + v[j].y * v[j].y) + (v[j].z * v[j].z + v[j].w * v[j].w);
        const float rstd = rsqrtf(wave_sum(ss) * (1.f / D) + EPS);
#pragma unroll
        for (int j = 0; j < 4; ++j) { v[j] = v[j] * rstd * Aq[j]; if (MODE != 2) v[j] = v[j] + Sq[j]; }
        if (MODE == 2) { f32x4* o = (f32x4*)(F.out + (size_t)r * D) + F.lane;
#pragma unroll
            for (int j = 0; j < 4; ++j) o[64 * j] = v[j]; }
        else {
            u32x2* ho = (u32x2*)(F.ws + WS_H + (size_t)r * D * 2) + F.lane;
#pragma unroll
            for (int j = 0; j < 4; ++j) ho[64 * j] = (u32x2){pk2(v[j].x, v[j].y), pk2(v[j].z, v[j].w)};
            LAS f32x4* hb = (LAS f32x4*)F.lds;
            LAS float* lg = (LAS float*)(F.lds + 32768);
#pragma unroll
            for (int j = 0; j < 4; ++j) hb[(F.wave * 4 + j) * 64 + F.lane] = v[j];
            LDS_BARRIER();
            float part[NV];
#pragma unroll
            for (int q = 0; q < 8; ++q) { f32x4 hq[4];
#pragma unroll
                for (int j = 0; j < 4; ++j) hq[j] = hb[(q * 4 + j) * 64 + F.lane];
#pragma unroll
                for (int e = 0; e < EPW; ++e) { f32x2_t a2 = {0.f, 0.f};
#pragma unroll
                    for (int j = 0; j < 4; ++j) { a2 += (f32x2_t){hq[j].x, hq[j].y} * wp[e][j][0]; a2 += (f32x2_t){hq[j].z, hq[j].w} * wp[e][j][1]; }
                    part[q * EPW + e] = a2.x + a2.y; } }
            const float mine = reduce_scatter<NV>(part, F.lane);
            if (MODE == 0) { const int g = (F.lane >> 1) & 15; if ((F.lane & 33) == 0) lg[(g >> 1) * 16 + 2 * F.wave + (g & 1)] = mine; }
            else { const int g = (F.lane >> 1) & 31; if ((F.lane & 1) == 0) lg[(g >> 2) * 32 + 4 * F.wave + (g & 3)] = mine + rbm; }
            LDS_BARRIER();
            if (MODE == 0) {
                if (F.lane < 16) { const int g = F.lane; float val = lg[F.wave * 16 + g] + A.in[I_MLGB][l * 16 + g];
                    if (g >= 8) val = logsigmoidf_(val);
                    ((float*)(F.ws + WS_GATES))[(size_t)r * 16 + g] = val; }
            } else {
                const int e = F.lane & 31; const float my = lg[F.wave * 32 + e]; int rank = 0;
#pragma unroll
                for (int q = 0; q < 8; ++q) { const f32x4 t = *(const LAS f32x4*)(lg + F.wave * 32 + 4 * q);
#pragma unroll
                    for (int c = 0; c < 4; ++c) { const int j = 4 * q + c; rank += (t[c] > my || (t[c] == my && j < e)) ? 1 : 0; } }
                float tv[4]; int ti[4];
#pragma unroll
                for (int p = 0; p < 4; ++p) { const unsigned bal = (unsigned)__ballot(rank == p); const int bi = __ffs((int)bal) - 1;
                    ti[p] = bi; tv[p] = __builtin_bit_cast(float, __builtin_amdgcn_readlane(__builtin_bit_cast(int, my), bi)); }
                const float e1 = __expf(tv[1] - tv[0]), e2 = __expf(tv[2] - tv[0]), e3 = __expf(tv[3] - tv[0]); const float inv = 1.f / (1.f + e1 + e2 + e3);
                if (F.lane < 4) {
                    int* rtw = (int*)(F.ws + WS_ROUTE); const int p = F.lane;
                    const int tip = p == 0 ? ti[0] : (p == 1 ? ti[1] : (p == 2 ? ti[2] : ti[3]));
                    const float gp = (p == 0 ? 1.f : (p == 1 ? e1 : (p == 2 ? e2 : e3))) * inv;
                    rtw[RT_TOPI + r * 4 + p] = tip; ((float*)rtw)[RT_TOPG + r * 4 + p] = gp; rtw[RT_POS + r * 4 + p] = (int)__hip_atomic_fetch_add(lcnt + tip, 1u, __ATOMIC_RELAXED, __HIP_MEMORY_SCOPE_WORKGROUP);
                }
            }
        }
        cur = nxt;
#pragma unroll
        for (int k = 0; k < 4; ++k) { s2[k] = s3[k]; }
    }
    if (MODE == 1) { __syncthreads(); if (F.tid < 32) ((int*)(F.ws + WS_ROUTE))[RT_BLKCNT + F.vcu * 32 + F.tid] = (int)lcnt[F.tid]; }
}

__device__ __forceinline__ void ph_lists(Frame& F, CArgs& A, int l, int nrows) {
    LAS int* off = (LAS int*)F.lds;
    LAS int* pre = (LAS int*)(F.lds + 1024);
    int* rt = (int*)(F.ws + WS_ROUTE);
    { LAS int* gsum = (LAS int*)(F.lds + 1024 + 65536);
      const int e = F.tid & 31, grp = F.tid >> 5, per = (F.G + 15) >> 4, v0 = grp * per, v1 = min(v0 + per, F.G);
      int run = 0;
      for (int vb = v0; vb < v1; vb += 16) { int c[16];
#pragma unroll
          for (int i = 0; i < 16; ++i) c[i] = vb + i < v1 ? rt[RT_BLKCNT + (vb + i) * 32 + e] : 0;
#pragma unroll
          for (int i = 0; i < 16; ++i) { if (vb + i < v1) pre[(vb + i) * 32 + e] = run; run += c[i]; } }
      gsum[grp * 32 + e] = run;
      __syncthreads();
      int base = 0, tot = 0;
#pragma unroll
      for (int g = 0; g < 16; ++g) { const int t = gsum[g * 32 + e]; base += g < grp ? t : 0; tot += t; }
      for (int v = v0; v < v1; ++v) pre[v * 32 + e] += base;
      if (grp == 0) off[64 + e] = tot; }
    __syncthreads();
    if (F.wave == 0) { const int pc = F.lane < 32 ? (off[64 + F.lane] + 255) & ~255 : 0;
        const int inc = (int)wave_incl_sum((float)(pc >> 8), F.lane) << 8;
        if (F.lane < 32) off[F.lane] = inc - pc; if (F.lane == 31) off[32] = inc; }
    __syncthreads();
    const int gt = F.vcu * NTHR + F.tid, NG = F.G * NTHR;
    for (int i = gt; i < nrows * 4; i += NG) { const int r = i >> 2, e = rt[RT_TOPI + i], v = (r % (F.G * NWAVES)) / NWAVES, s = off[e] + pre[v * 32 + e] + rt[RT_POS + i];
        rt[RT_SLOT + i] = s; rt[RT_LIST + s] = r; ((float*)rt)[RT_SGATE + s] = ((const float*)rt)[RT_TOPG + i]; }
    const int total = off[32];
    for (int s = gt; s < total; s += NG) { int e = 0;
#pragma unroll 1
        for (int q = 1; q < NEXP; ++q) if (s >= off[q]) e = q;
        if (s - off[e] >= off[64 + e]) { rt[RT_LIST + s] = NTOK; ((float*)rt)[RT_SGATE + s] = 0.f; }
        if ((s & 255) == 0) rt[RT_TILEE + 8 + (s >> 8)] = e; }
    if (gt == 0) rt[RT_TILEE] = total >> 8;
}

__device__ __forceinline__ void touch(unsigned& x) { asm volatile("" : "+v"(x)); }
__device__ __forceinline__ void touch(float& x) { asm volatile("" : "+v"(x)); }
__device__ __forceinline__ void touch(u32x4& x) { asm volatile("" : "+v"(x)); }
struct ConvItem { u32x4 tap[3][6]; int r0, c; };
__device__ __forceinline__ void conv_load_item(const bf16* P, int it, ConvItem& I) {
    constexpr int NLATQ = BATCH * 128 * 16;
    const int qd = it / 192, cg = it % 192, c = cg * 8, pc = c < 512 ? PC_QK + c : PC_QI + (c - 512);
    int base, row, x0, nrow, ncol;
    if (qd < NLATQ) { const int b = qd >> 11, y = (qd >> 4) & 127, xq = qd & 15; base = b << 13; row = y; x0 = xq * 4; nrow = 128; ncol = 64; }
    else { const int q = qd - NLATQ, b = q >> 6; base = NLAT + (b << 8); row = 0; x0 = (q & 63) * 4; nrow = 1; ncol = 256; }
    const int r0 = base + row * ncol + x0; I.r0 = r0; I.c = c;
#pragma unroll
    for (int dy = 0; dy < 3; ++dy)
#pragma unroll
        for (int j = 0; j < 6; ++j) { const int rr = row + dy - 1, cc = x0 + j - 1; const bool v = rr >= 0 && rr < nrow && cc >= 0 && cc < ncol;
            const u32x4 t = *(const u32x4*)(P + (size_t)(v ? base + rr * ncol + cc : r0) * PW + pc);
            I.tap[dy][j] = v ? t : (u32x4){0u, 0u, 0u, 0u}; }
}
__device__ __forceinline__ void ph_conv(Frame& F, CArgs& A, int l) {
    LAS float* cw = (LAS float*)F.lds;
    { const f32x4* wm = (const f32x4*)(A.in[I_MLCONV] + (size_t)l * 9 * 512); const f32x4* wh = (const f32x4*)(A.in[I_HGCONV] + (size_t)l * 9 * 1024);
      f32x4 vm[3], vh[5];
#pragma unroll
      for (int j = 0; j < 3; ++j) { const int i = F.tid + NTHR * j; vm[j] = i < 9 * 128 ? wm[i] : (f32x4){0.f, 0.f, 0.f, 0.f}; }
#pragma unroll
      for (int j = 0; j < 5; ++j) { const int i = F.tid + NTHR * j; vh[j] = i < 9 * 256 ? wh[i] : (f32x4){0.f, 0.f, 0.f, 0.f}; }
#pragma unroll
      for (int j = 0; j < 3; ++j) { const int i = F.tid + NTHR * j; if (i < 9 * 128) *(LAS f32x4*)(cw + (i / 128) * 1536 + (i % 128) * 4) = vm[j]; }
#pragma unroll
      for (int j = 0; j < 5; ++j) { const int i = F.tid + NTHR * j; if (i < 9 * 256) *(LAS f32x4*)(cw + (i / 256) * 1536 + 512 + (i % 256) * 4) = vh[j]; } }
    __syncthreads();
    const bf16* P = (const bf16*)(F.ws + WS_P);
    const int gt = F.vcu * NTHR + F.tid, NG = F.G * NTHR;
    constexpr int NLATQ = BATCH * 128 * 16, NQ = NLATQ + BATCH * 64;
    int it = gt; ConvItem cur; if (it < NQ * 192) conv_load_item(P, it, cur);
    for (; it < NQ * 192; it += NG) {
#pragma unroll
        for (int dy = 0; dy < 3; ++dy)
#pragma unroll
            for (int j = 0; j < 6; ++j) touch(cur.tap[dy][j]);
        ConvItem nxt; if (it + NG < NQ * 192) conv_load_item(P, it + NG, nxt); else nxt = cur;
        const int r0 = cur.r0, c = cur.c; u32x4 (&tap)[3][6] = cur.tap;
        f32x2_t a2[4][4];
#pragma unroll
        for (int o = 0; o < 4; ++o)
#pragma unroll
            for (int i = 0; i < 4; ++i) a2[o][i] = (f32x2_t){0.f, 0.f};
#pragma unroll
        for (int dy = 0; dy < 3; ++dy)
#pragma unroll
            for (int dx = 0; dx < 3; ++dx) { const LAS float* w = cw + (dy * 3 + dx) * 1536 + c; const f32x4 w0 = *(const LAS f32x4*)w, w1 = *(const LAS f32x4*)(w + 4);
                const f32x2_t wa = {w0.x, w0.y}, wb = {w0.z, w0.w}, wc = {w1.x, w1.y}, wd = {w1.z, w1.w};
#pragma unroll
                for (int o = 0; o < 4; ++o) { const u32x4 pv = tap[dy][o + dx];
                    a2[o][0] += (f32x2_t){bflo(pv.x), bfhi(pv.x)} * wa; a2[o][1] += (f32x2_t){bflo(pv.y), bfhi(pv.y)} * wb;
                    a2[o][2] += (f32x2_t){bflo(pv.z), bfhi(pv.z)} * wc; a2[o][3] += (f32x2_t){bflo(pv.w), bfhi(pv.w)} * wd; } }
        const float sc = c < 256 ? 0.125f : 1.f;
#pragma unroll
        for (int o = 0; o < 4; ++o) { unsigned ow[4];
#pragma unroll
            for (int i = 0; i < 4; ++i) { const f32x2_t x = a2[o][i], t = x * (-1.44269504f), dn = (f32x2_t){__builtin_amdgcn_exp2f(t.x), __builtin_amdgcn_exp2f(t.y)} + 1.f;
                const f32x2_t y = (x * sc) * (f32x2_t){__builtin_amdgcn_rcpf(dn.x), __builtin_amdgcn_rcpf(dn.y)}; ow[i] = pk2(y.x, y.y); }
            const u32x4 ov = (u32x4){ow[0], ow[1], ow[2], ow[3]};
            if (c < 512) *(u32x4*)(F.ws + WS_CQK + ((size_t)(r0 + o) * 512 + c) * 2) = ov; else *(u32x4*)(F.ws + WS_CQI + ((size_t)(r0 + o) * 1024 + (c - 512)) * 2) = ov; }
        cur = nxt;
    }
}

struct HnIn { f32x4 h[4]; u32x2 g[4]; };
__device__ __forceinline__ void hn_load(Frame& F, int r, HnIn& R) {
    const float* HF = (const float*)(F.ws + WS_HF); const bf16* P = (const bf16*)(F.ws + WS_P);
#pragma unroll
    for (int j = 0; j < 4; ++j) { const int c = 256 * j + 4 * F.lane; R.h[j] = *(const f32x4*)(HF + (size_t)r * D + c); R.g[j] = *(const u32x2*)(P + (size_t)r * PW + (c < 512 ? PC_O + c : PC_GO + (c - 512))); }
}
__device__ __forceinline__ void ph_hnorm(Frame& F, CArgs& A, int l, int nrows_lat_only) {
    const int nrows = nrows_lat_only ? NLAT : NTOK, stride = F.G * NWAVES;
    int r = F.vcu * NWAVES + F.wave; HnIn cur; if (r < nrows) hn_load(F, r, cur);
    for (; r < nrows; r += stride) {
        HnIn nxt; if (r + stride < nrows) hn_load(F, r + stride, nxt); else nxt = cur;
        u32x2* yo = (u32x2*)(F.ws + WS_Y + (size_t)r * D * 2) + F.lane;
#pragma unroll
        for (int j = 0; j < 4; ++j) {
            const int c = 256 * j + 4 * F.lane;
            f32x4 h = cur.h[j];
            float ss = (h.x * h.x + h.y * h.y) + (h.z * h.z + h.w * h.w);
#pragma unroll
            for (int o = 1; o < 32; o <<= 1) ss += __shfl_xor(ss, o);
            const float rstd = rsqrtf(ss * (1.f / 128.f) + EPS);
            const f32x4 g = c < 512 ? *(const f32x4*)(A.in[I_MLNG] + l * 512 + c) : *(const f32x4*)(A.in[I_HGNG] + l * 512 + (c - 512));
            const u32x2 gw = cur.g[j];
            float ga[4] = {bflo(gw.x), bfhi(gw.x), bflo(gw.y), bfhi(gw.y)};
#pragma unroll
            for (int i = 0; i < 4; ++i) ga[i] = c < 512 ? sigmoidf_(ga[i]) : siluf_(ga[i]);
            h = h * rstd * g;
            yo[64 * j] = (u32x2){pk2(h.x * ga[0], h.y * ga[1]), pk2(h.z * ga[2], h.w * ga[3])};
        }
        cur = nxt;
    }
}

namespace pg8 {
typedef short bf16x8 __attribute__((ext_vector_type(8)));
constexpr int BM = 256, BK = 64, HALF = 128, HTB = HALF * BK * 2, STAGE_BYTES = 8 * HTB, NXCD = 8, WGM = 8;
__device__ __forceinline__ int lds_byte(int r, int c) { const int st = (r >> 4) * 2 + (c >> 5), rr = r & 15, cc = c & 31, ob = rr * 64 + cc * 2; return st * 1024 + (ob ^ (((ob >> 9) & 1) << 5)); }
__device__ __forceinline__ void stage_rc(int b, int& R, int& C) { const int st = b / 1024, sb = b % 1024, swz = sb ^ (((sb >> 9) & 1) << 5); R = (st >> 1) * 16 + swz / 64; C = (st & 1) * 32 + (swz % 64) / 2; }
__device__ __forceinline__ int perm32(int rho) { const int n = rho >> 4, i = rho & 15; return 8 * (i >> 2) + 4 * n + (i & 3); }
struct Unit { int pm, pn, e; };
struct Gemm { const bf16* A; const bf16* Bt; int K; const int* gather; const int* tile_e; size_t bexp;   };
struct StaticOrder {
    int nM, nN, nwg, G, c;
    __device__ void init(int nM_, int nN_, int G_, int c_) { nM = nM_; nN = nN_; nwg = nM * nN; G = G_; c = c_; }
    __device__ bool next(int i, Unit& u) const {
        const long L = (long)i * G + c; if (L >= nwg) return false;
        int wgid = (int)L; { const int q = nwg / NXCD, r = nwg % NXCD, xcd = wgid % NXCD, off = wgid / NXCD; wgid = (xcd < r ? xcd * (q + 1) : r * (q + 1) + (xcd - r) * q) + off; }
        const int nig = WGM * nN, gid = wgid / nig, fm = gid * WGM, gsz = (nM - fm) < WGM ? (nM - fm) : WGM;
        u.pm = fm + ((wgid % nig) % gsz); u.pn = (wgid % nig) / gsz; u.e = 0; return true;
    }
};
__device__ __forceinline__ unsigned cvt_pk_bf16(float lo, float hi) { unsigned r; asm volatile("v_cvt_pk_bf16_f32 %0, %1, %2" : "=v"(r) : "v"(lo), "v"(hi)); return r; }

struct EpiBf16 {
    static constexpr bool PERM = true;
    bf16* O; int ldc;
    __device__ __forceinline__ void operator()(const f32x4 (&acc)[2][2][4][2], const Unit& u, int wr, int wc, int fr, int fq) const {
        const int row0 = u.pm * BM + wr * 64 + fr, col0 = u.pn * BM + wc * 32 + 8 * fq;
#pragma unroll
        for (int ai = 0; ai < 2; ++ai)
#pragma unroll
            for (int m = 0; m < 4; ++m) { bf16* rowp = O + (size_t)(row0 + ai * HALF + m * 16) * ldc + col0;
#pragma unroll
                for (int bj = 0; bj < 2; ++bj) { const f32x4 v0 = acc[ai][bj][m][0], v1 = acc[ai][bj][m][1];
                    u32x4 w; w.x = cvt_pk_bf16(v0[0], v0[1]); w.y = cvt_pk_bf16(v0[2], v0[3]); w.z = cvt_pk_bf16(v1[0], v1[1]); w.w = cvt_pk_bf16(v1[2], v1[3]);
                    *(u32x4*)(rowp + bj * HALF) = w; } }
    }
};
struct EpiResid {
    static constexpr bool PERM = false;
    float* X; const float* MODg; const float* Slat; const float* Sctx;
    __device__ __forceinline__ void operator()(const f32x4 (&acc)[2][2][4][2], const Unit& u, int wr, int wc, int fr, int fq) const {
        const int row0 = u.pm * BM + wr * 64 + fr, col0 = u.pn * BM + wc * 32 + 4 * fq;
        const float* gp = MODg + mrow_of(u.pm * BM) * 6144 + col0;
        f32x4 gv[2][2];
#pragma unroll
        for (int bj = 0; bj < 2; ++bj)
#pragma unroll
            for (int n = 0; n < 2; ++n) gv[bj][n] = *(const f32x4*)(gp + bj * HALF + n * 16);
#pragma unroll
        for (int ai = 0; ai < 2; ++ai) {
            f32x4 xv[4][2][2];
#pragma unroll
            for (int m = 0; m < 4; ++m) { const int rr = row0 + ai * HALF + m * 16; const float* rowp = (rr < NLAT ? Slat + (size_t)rr * D : Sctx + (size_t)(rr - NLAT) * D) + col0;
#pragma unroll
                for (int bj = 0; bj < 2; ++bj)
#pragma unroll
                    for (int n = 0; n < 2; ++n) xv[m][bj][n] = *(const f32x4*)(rowp + bj * HALF + n * 16); }
#pragma unroll
            for (int m = 0; m < 4; ++m) { float* rowp = X + (size_t)(row0 + ai * HALF + m * 16) * D + col0;
#pragma unroll
                for (int bj = 0; bj < 2; ++bj)
#pragma unroll
                    for (int n = 0; n < 2; ++n) *(f32x4*)(rowp + bj * HALF + n * 16) = xv[m][bj][n] + gv[bj][n] * acc[ai][bj][m][n]; } }
    }
};
struct EpiSwiglu {
    static constexpr bool PERM = true;
    bf16* ACT; const float* bgu; const int* tile_e;
    __device__ __forceinline__ void operator()(const f32x4 (&acc)[2][2][4][2], const Unit& u, int wr, int wc, int fr, int fq) const {
        const int e = u.e;
        const int row0 = u.pm * BM + wr * 64 + fr, col0 = u.pn * HALF + wc * 32 + 8 * fq;
        const float* bp = bgu + (size_t)e * 2048 + col0;
        const f32x4 bg0 = *(const f32x4*)bp, bg1 = *(const f32x4*)(bp + 4), bl0 = *(const f32x4*)(bp + 1024), bl1 = *(const f32x4*)(bp + 1028);
#pragma unroll
        for (int ai = 0; ai < 2; ++ai)
#pragma unroll
            for (int m = 0; m < 4; ++m) {
                f32x4 g0 = acc[ai][0][m][0] + bg0, g1 = acc[ai][0][m][1] + bg1, l0 = acc[ai][1][m][0] + bl0, l1 = acc[ai][1][m][1] + bl1; float o[8];
#pragma unroll
                for (int i = 0; i < 4; ++i) { g0[i] = fminf(g0[i], 7.f); g1[i] = fminf(g1[i], 7.f); l0[i] = fminf(fmaxf(l0[i], -7.f), 7.f); l1[i] = fminf(fmaxf(l1[i], -7.f), 7.f); }
                const f32x4 t0 = g0 * (-1.702f * 1.44269504f), t1 = g1 * (-1.702f * 1.44269504f);
                f32x4 e0, e1;
#pragma unroll
                for (int i = 0; i < 4; ++i) { e0[i] = __builtin_amdgcn_exp2f(t0[i]); e1[i] = __builtin_amdgcn_exp2f(t1[i]); }
                e0 = e0 + 1.f; e1 = e1 + 1.f;
#pragma unroll
                for (int i = 0; i < 4; ++i) { e0[i] = __builtin_amdgcn_rcpf(e0[i]); e1[i] = __builtin_amdgcn_rcpf(e1[i]); }
                const f32x4 r0 = (g0 * e0) * (l0 + 1.f), r1 = (g1 * e1) * (l1 + 1.f);
#pragma unroll
                for (int i = 0; i < 4; ++i) { o[i] = r0[i]; o[4 + i] = r1[i]; }
                u32x4 w; w.x = cvt_pk_bf16(o[0], o[1]); w.y = cvt_pk_bf16(o[2], o[3]); w.z = cvt_pk_bf16(o[4], o[5]); w.w = cvt_pk_bf16(o[6], o[7]);
                *(u32x4*)(ACT + (size_t)(row0 + ai * HALF + m * 16) * DEXP + col0) = w; }
    }
};
struct EpiDown {
    static constexpr bool PERM = true;
    bf16* YS; const float* bdn; const float* sgate; const int* tile_e;
    __device__ __forceinline__ void operator()(const f32x4 (&acc)[2][2][4][2], const Unit& u, int wr, int wc, int fr, int fq) const {
        const int e = u.e;
        const int row0 = u.pm * BM + wr * 64 + fr, col0 = u.pn * BM + wc * 32 + 8 * fq;
        f32x4 bv[2][2];
#pragma unroll
        for (int bj = 0; bj < 2; ++bj)
#pragma unroll
            for (int n = 0; n < 2; ++n) bv[bj][n] = *(const f32x4*)(bdn + (size_t)e * D + col0 + bj * HALF + 4 * n);
#pragma unroll
        for (int ai = 0; ai < 2; ++ai)
#pragma unroll
            for (int m = 0; m < 4; ++m) { const int row = row0 + ai * HALF + m * 16; const float sg = sgate[row]; bf16* rowp = YS + (size_t)row * D + col0;
#pragma unroll
                for (int bj = 0; bj < 2; ++bj) { const f32x4 v0 = (acc[ai][bj][m][0] + bv[bj][0]) * sg, v1 = (acc[ai][bj][m][1] + bv[bj][1]) * sg;
                    u32x4 w; w.x = cvt_pk_bf16(v0[0], v0[1]); w.y = cvt_pk_bf16(v0[2], v0[3]); w.z = cvt_pk_bf16(v1[0], v1[1]); w.w = cvt_pk_bf16(v1[2], v1[3]);
                    *(u32x4*)(rowp + bj * HALF) = w; } }
    }
};

template <class Epi, class Sched, bool ALIGN_EPI>
__device__ __forceinline__ void gemm_phase(LAS unsigned char* lds, const Gemm g, const Sched& S, const Epi& E, const int tid) {
    const int wid = __builtin_amdgcn_readfirstlane(tid >> 6), lane = tid & 63, wr = wid >> 2, wc = wid & 3, fr = lane & 15, fq = lane >> 4;
    const int K = g.K, nt = K / BK;
    int RA[2]; unsigned cbA[2], voffB[2];
#pragma unroll
    for (int i = 0; i < 2; ++i) { int R, C; stage_rc(tid * 16 + i * 8192, R, C); const int Rb = Epi::PERM ? ((R & ~31) + perm32(R & 31)) : R;
        RA[i] = R; cbA[i] = (unsigned)C * 2u; voffB[i] = (unsigned)(Rb * K + C) * 2u; }
    const size_t kstep = (size_t)(BK * 2);
    const size_t hstep = (size_t)HALF * K * 2;
    const size_t tstep = 2 * hstep;
    const unsigned ldsw = (unsigned)wid * 1024u;
    const int aoff = lds_byte(wr * 64 + fr, fq * 8), boff = lds_byte(wc * 32 + fr, fq * 8);
#define PG8_SA(b, h) (((b) * 2 + (h)) * HTB)
#define PG8_SB(b, h) ((4 + (b) * 2 + (h)) * HTB)
#define PG8_STAGE(bufoff, gbase, voff) do { _Pragma("unroll") for (int _i = 0; _i < 2; ++_i) \
        __builtin_amdgcn_global_load_lds((const unsigned*)((const char*)(gbase) + (voff)[_i]), (LAS unsigned*)(lds + (bufoff) + ldsw + _i * 8192), 16, 0, 0); } while (0)
#define PG8_LDA(dst, b, h) do { _Pragma("unroll") for (int m = 0; m < 4; ++m) _Pragma("unroll") for (int k = 0; k < 2; ++k) dst[m][k] = *(const LAS bf16x8*)(lds + PG8_SA(b, h) + aoff + m * 2048 + k * 1024); } while (0)
#define PG8_LDB(dst, b, h) do { _Pragma("unroll") for (int n = 0; n < 2; ++n) _Pragma("unroll") for (int k = 0; k < 2; ++k) dst[n][k] = *(const LAS bf16x8*)(lds + PG8_SB(b, h) + boff + n * 2048 + k * 1024); } while (0)
#define PG8_MMA(ai, bj, At, Bt) do { __builtin_amdgcn_s_setprio(1); _Pragma("unroll") for (int m = 0; m < 4; ++m) _Pragma("unroll") for (int n = 0; n < 2; ++n) _Pragma("unroll") for (int k = 0; k < 2; ++k) \
        acc[ai][bj][m][n] = __builtin_amdgcn_mfma_f32_16x16x32_bf16(Bt[n][k], At[m][k], acc[ai][bj][m][n], 0, 0, 0); __builtin_amdgcn_s_setprio(0); } while (0)
#define PG8_WAIT_V(n) asm volatile("s_waitcnt vmcnt(" #n ")" ::: "memory")
#define PG8_WAIT_L(n) asm volatile("s_waitcnt lgkmcnt(" #n ")" ::: "memory")
#define PG8_BAR __builtin_amdgcn_s_barrier()
#define PG8_SCHED __builtin_amdgcn_sched_barrier(0)
#define PG8_AOFF(va, u) do { _Pragma("unroll") for (int _h = 0; _h < 2; ++_h) _Pragma("unroll") for (int _i = 0; _i < 2; ++_i) { const int _r = (u).pm * BM + _h * HALF + RA[_i]; \
        const int _row = g.gather ? g.gather[_r] : _r; va[_h][_i] = (unsigned)_row * (unsigned)(K * 2) + cbA[_i]; } } while (0)
#define PG8_BBASE(u) ((u).e = g.tile_e ? g.tile_e[8 + (u).pm] : 0, (const char*)g.Bt + (size_t)(u).e * g.bexp * 2 + (size_t)(u).pn * tstep)
    Unit cur, nxt; int ui = 0;
    if (!S.next(0, cur)) return;
    f32x4 acc[2][2][4][2];
#pragma unroll
    for (int a = 0; a < 2; ++a)
#pragma unroll
        for (int b = 0; b < 2; ++b)
#pragma unroll
            for (int m = 0; m < 4; ++m)
#pragma unroll
                for (int n = 0; n < 2; ++n) acc[a][b][m][n] = (f32x4){0.f, 0.f, 0.f, 0.f};
    bf16x8 At[4][2], B0[2][2], B1[2][2];
    const char* Ab = (const char*)g.A;
    unsigned cva[2][2], nva[2][2];
    PG8_AOFF(cva, cur);
    const char* cB = PG8_BBASE(cur);
    PG8_STAGE(PG8_SB(0, 0), cB, voffB); PG8_STAGE(PG8_SB(0, 1), cB + hstep, voffB); PG8_STAGE(PG8_SA(0, 0), Ab, cva[0]); PG8_STAGE(PG8_SA(0, 1), Ab, cva[1]);
    if (wr == 1) PG8_BAR;
    PG8_WAIT_V(2); PG8_BAR;
    PG8_STAGE(PG8_SB(1, 0), cB + kstep, voffB); PG8_STAGE(PG8_SA(1, 0), Ab + kstep, cva[0]); PG8_STAGE(PG8_SB(1, 1), cB + hstep + kstep, voffB);
    PG8_WAIT_V(6); PG8_BAR;
    for (;;) {
        const bool has_next = S.next(ui + 1, nxt);
        const char* nB = cB;
        if (has_next) { PG8_AOFF(nva, nxt); nB = PG8_BBASE(nxt); }
        else {
#pragma unroll
            for (int h = 0; h < 2; ++h)
#pragma unroll
                for (int i = 0; i < 2; ++i) nva[h][i] = cva[h][i]; }
        for (int t = 0; t < nt; t += 2) {
            const bool last = (t == nt - 2);
            const char* a1 = Ab + (size_t)(t + 1) * kstep;
            const char* a2 = last ? Ab : Ab + (size_t)(t + 2) * kstep; const char* b2 = last ? nB : cB + (size_t)(t + 2) * kstep;
            const char* a3 = a2 + kstep; const char* b3 = b2 + kstep;
            unsigned s2[2][2];
#pragma unroll
            for (int h = 0; h < 2; ++h)
#pragma unroll
                for (int i = 0; i < 2; ++i) s2[h][i] = last ? nva[h][i] : cva[h][i];
            PG8_LDB(B0, 0, 0); PG8_LDB(B1, 0, 1); PG8_SCHED; PG8_LDA(At, 0, 0); PG8_STAGE(PG8_SA(1, 1), a1, cva[1]);
            PG8_WAIT_V(8); PG8_WAIT_L(0); PG8_BAR; PG8_MMA(0, 0, At, B0); PG8_MMA(0, 1, At, B1); PG8_BAR; PG8_SCHED;
            PG8_LDA(At, 0, 1); PG8_STAGE(PG8_SB(0, 0), b2, voffB); PG8_STAGE(PG8_SB(0, 1), b2 + hstep, voffB); PG8_STAGE(PG8_SA(0, 0), a2, s2[0]);
            PG8_WAIT_V(8); PG8_WAIT_L(0); PG8_BAR; PG8_MMA(1, 0, At, B0); PG8_MMA(1, 1, At, B1); PG8_BAR; PG8_SCHED;
            PG8_LDB(B0, 1, 0); PG8_LDB(B1, 1, 1); PG8_SCHED; PG8_LDA(At, 1, 0); PG8_STAGE(PG8_SA(0, 1), a2, s2[1]);
            PG8_WAIT_V(8); PG8_WAIT_L(0); PG8_BAR; PG8_MMA(0, 0, At, B0); PG8_MMA(0, 1, At, B1); PG8_BAR; PG8_SCHED;
            PG8_LDA(At, 1, 1); PG8_STAGE(PG8_SB(1, 0), b3, voffB); PG8_STAGE(PG8_SB(1, 1), b3 + hstep, voffB); PG8_STAGE(PG8_SA(1, 0), a3, s2[0]);
            PG8_WAIT_V(8); PG8_WAIT_L(0); PG8_BAR; PG8_MMA(1, 0, At, B0); PG8_MMA(1, 1, At, B1); PG8_BAR; PG8_SCHED;
        }
        if constexpr (ALIGN_EPI) { if (wr == 0) PG8_BAR; }
        E(acc, cur, wr, wc, fr, fq);
        if (!has_next) break;
#pragma unroll
        for (int a = 0; a < 2; ++a)
#pragma unroll
            for (int b = 0; b < 2; ++b)
#pragma unroll
                for (int m = 0; m < 4; ++m)
#pragma unroll
                    for (int n = 0; n < 2; ++n) acc[a][b][m][n] = (f32x4){0.f, 0.f, 0.f, 0.f};
        cur = nxt; cB = nB; ++ui;
#pragma unroll
        for (int h = 0; h < 2; ++h)
#pragma unroll
            for (int i = 0; i < 2; ++i) cva[h][i] = nva[h][i];
        if constexpr (ALIGN_EPI) { if (wr == 1) PG8_BAR; }
    }
    PG8_WAIT_V(0);
    if constexpr (!ALIGN_EPI) { if (wr == 0) PG8_BAR; }
    PG8_BAR;
#undef PG8_SA
#undef PG8_SB
#undef PG8_STAGE
#undef PG8_LDA
#undef PG8_LDB
#undef PG8_MMA
#undef PG8_WAIT_V
#undef PG8_WAIT_L
#undef PG8_BAR
#undef PG8_SCHED
#undef PG8_AOFF
#undef PG8_BBASE
}
}


typedef short bf16x8_t __attribute__((ext_vector_type(8)));
typedef float f32x16 __attribute__((ext_vector_type(16)));
template <int K>
__device__ __forceinline__ void mm32(f32x16& acc, const LAS unsigned char* A, int sa, const LAS unsigned char* B, int sb, int lane) {
    const LAS unsigned char* ap = A + (lane & 31) * sa + (lane >> 5) * 16;
    const LAS unsigned char* bp = B + (lane & 31) * sb + (lane >> 5) * 16;
#pragma unroll
    for (int k0 = 0; k0 < K / 16; k0 += 4) {
        bf16x8_t a[4], b[4];
#pragma unroll
        for (int k = 0; k < 4; ++k) { a[k] = *(const LAS bf16x8_t*)(ap + (k0 + k) * 32); b[k] = *(const LAS bf16x8_t*)(bp + (k0 + k) * 32); }
#pragma unroll
        for (int k = 0; k < 4; ++k) acc = __builtin_amdgcn_mfma_f32_32x32x16_bf16(a[k], b[k], acc, 0, 0, 0);
    }
}
__device__ __forceinline__ int rowmap(int reg, int hi) { return (reg & 3) + 8 * (reg >> 2) + 4 * hi; }
__device__ __forceinline__ int chunk_row0(int b, int tc) { return tc < 4 ? NLAT + b * CTX + tc * 64 : b * SEQ + (tc - 4) * 64; }
constexpr int ST64 = 144, ST128 = 272;


struct VtRaw { unsigned w[8]; };
__device__ __forceinline__ void vt_load(VtRaw& R, const bf16* src, int pitch, int row0, int col0, int tid) {
    const int cp = tid & 63, tg = tid >> 6;
#pragma unroll
    for (int i = 0; i < 8; ++i) R.w[i] = *(const unsigned*)(src + (size_t)(row0 + tg * 8 + i) * pitch + col0 + 2 * cp);
}
__device__ __forceinline__ void vt_store(LAS unsigned char* VT, const VtRaw& R, int tid) {
    const int cp = tid & 63, tg = tid >> 6; unsigned lo[4], hi[4];
#pragma unroll
    for (int i = 0; i < 4; ++i) { const unsigned w0 = R.w[2 * i], w1 = R.w[2 * i + 1]; lo[i] = (w0 & 0xffffu) | (w1 << 16); hi[i] = (w0 >> 16) | (w1 & 0xffff0000u); }
    *(LAS u32x4*)(VT + (2 * cp) * ST64 + tg * 16) = (u32x4){lo[0], lo[1], lo[2], lo[3]};
    *(LAS u32x4*)(VT + (2 * cp + 1) * ST64 + tg * 16) = (u32x4){hi[0], hi[1], hi[2], hi[3]};
}
struct TaskId { int b, h, tc, row0, sidf; };
__device__ __forceinline__ TaskId task_id(int task) { TaskId t; t.b = task / (4 * NTC); t.h = (task / NTC) & 3; t.tc = task % NTC; t.row0 = chunk_row0(t.b, t.tc); t.sidf = (t.b * 4 + t.h) * 2; return t; }

struct MlARaw { VtRaw v; unsigned kw[4]; float g[4]; };
__device__ __forceinline__ void touch(MlARaw& R) {
#pragma unroll
    for (int i = 0; i < 8; ++i) touch(R.v.w[i]);
#pragma unroll
    for (int i = 0; i < 4; ++i) { touch(R.kw[i]); touch(R.g[i]); } }
__device__ __forceinline__ void ml_passA_load(Frame& F, int task, MlARaw& R) {
    const TaskId T = task_id(task);
    vt_load(R.v, (const bf16*)(F.ws + WS_P), PW, T.row0, PC_V + T.h * 128, F.tid);
    { const int cp = F.tid & 31, tg = F.tid >> 5; const bf16* CQK = (const bf16*)(F.ws + WS_CQK);
#pragma unroll
      for (int i = 0; i < 4; ++i) R.kw[i] = *(const unsigned*)(CQK + (size_t)(T.row0 + tg * 4 + i) * 512 + 256 + T.h * 64 + 2 * cp); }
    if (F.wave == 0) { const float* gp = (const float*)(F.ws + WS_GATES) + (size_t)(T.row0 + F.lane) * 16; R.g[0] = gp[T.h]; R.g[1] = gp[4 + T.h]; R.g[2] = gp[8 + T.h]; R.g[3] = gp[12 + T.h]; }
}
__device__ __forceinline__ void ml_passA_run(Frame& F, int task, const MlARaw& R) {
    const TaskId T = task_id(task); const int tc = T.tc, sidf = T.sidf;
    LAS unsigned char* VT = F.lds; LAS unsigned char* KT = F.lds + 18432;
    LAS float* wts = (LAS float*)(F.lds + 36864);
    float* MLS = (float*)(F.ws + WS_MLS);
    LDS_BARRIER();
    if (F.wave == 0) { const int s = F.lane;
        const float igf = R.g[0], igb = R.g[1], lff = R.g[2], lfb = R.g[3];
        const float pf = wave_incl_sum(lff, s), gf = __builtin_bit_cast(float, __builtin_amdgcn_readlane(__builtin_bit_cast(int, pf), 63)), ef = (gf - pf) + igf, mf = wave_max(ef);
        const float pb = wave_incl_sum(lfb, s), gb = __builtin_bit_cast(float, __builtin_amdgcn_readlane(__builtin_bit_cast(int, pb), 63)), eb = (pb - lfb) + igb, mb = wave_max(eb);
        wts[s] = __expf(ef - mf); wts[64 + s] = __expf(eb - mb);
        if (s == 0) { float* o = MLS + (size_t)(sidf * NTC + tc) * 4; o[0] = gf; o[1] = mf; o = MLS + (size_t)((sidf + 1) * NTC + tc) * 4; o[0] = gb; o[1] = mb; } }
    vt_store(VT, R.v, F.tid);
    LDS_BARRIER();
    { const int cp = F.tid & 31, tg = F.tid >> 5;
#pragma unroll
      for (int dir = 0; dir < 2; ++dir) { float lo[4], hi[4];
#pragma unroll
          for (int i = 0; i < 4; ++i) { const float w = wts[dir * 64 + tg * 4 + i]; lo[i] = bflo(R.kw[i]) * w; hi[i] = bfhi(R.kw[i]) * w; }
          *(LAS u32x2*)(KT + dir * 9216 + (2 * cp) * ST64 + tg * 8) = (u32x2){pk2(lo[0], lo[1]), pk2(lo[2], lo[3])};
          *(LAS u32x2*)(KT + dir * 9216 + (2 * cp + 1) * ST64 + tg * 8) = (u32x2){pk2(hi[0], hi[1]), pk2(hi[2], hi[3])}; } }
    LDS_BARRIER();
    { const int dir = F.wave >> 2, mt = F.wave & 3; bf16* C = (bf16*)(F.ws + WS_MLC) + (size_t)((sidf + dir) * NTC + tc) * 8192;
#pragma unroll
      for (int nt = 0; nt < 2; ++nt) { f32x16 acc;
#pragma unroll
          for (int i = 0; i < 16; ++i) acc[i] = 0.f;
          mm32<64>(acc, VT + 32 * mt * ST64, ST64, KT + dir * 9216 + 32 * nt * ST64, ST64, F.lane);
#pragma unroll
          for (int r = 0; r < 16; ++r) C[(32 * mt + rowmap(r, F.lane >> 5)) * 64 + 32 * nt + (F.lane & 31)] = (bf16)f2bf(acc[r]); } }
    if (F.tid < 128) { const int dir = F.tid >> 6, d = F.tid & 63; const LAS unsigned char* rp = KT + dir * 9216 + d * ST64; float sum = 0.f;
#pragma unroll
        for (int i = 0; i < 8; ++i) { const u32x4 w = *(const LAS u32x4*)(rp + i * 16); sum += (bflo(w.x) + bfhi(w.x)) + (bflo(w.y) + bfhi(w.y)) + (bflo(w.z) + bfhi(w.z)) + (bflo(w.w) + bfhi(w.w)); }
        ((float*)(F.ws + WS_MLN))[(size_t)((sidf + dir) * NTC + tc) * 64 + d] = sum; }
}
__device__ __forceinline__ int tc_seq(int dir, int j) { return dir == 0 ? j : (j < 4 ? 3 - j : 135 - j); }
__device__ __forceinline__ void scan_passB(Frame& F) {
    const float* GG = (const float*)(F.ws + WS_HGG); float* MLS = (float*)(F.ws + WS_MLS);
    const int t = F.tid;
    if (t < 128) {
        for (int item = F.vcu * 128 + t; item < 16 * 2048; item += F.G * 128) {
            const int scan = item >> 11, e = (item & 2047) * 8, dir = scan & 1, d = e & 127;
            const u32x4* base = (const u32x4*)((const bf16*)(F.ws + WS_HGS) + (size_t)scan * NTC * 16384 + e); u32x4* ob = (u32x4*)((bf16*)(F.ws + WS_HGSB) + (size_t)scan * NTC * 16384 + e);
            const f32x4* gb = (const f32x4*)(GG + (size_t)scan * NTC * 128 + d);
            float st[8];
#pragma unroll
            for (int k = 0; k < 8; ++k) st[k] = 0.f;
            for (int j0 = 0; j0 < NTC; j0 += 11) {
                u32x4 dv[11]; f32x4 g0[11], g1[11];
#pragma unroll
                for (int i = 0; i < 11; ++i) { const int tc = tc_seq(dir, j0 + i); dv[i] = base[(size_t)tc * 2048]; g0[i] = gb[tc * 32]; g1[i] = gb[tc * 32 + 1]; }
#pragma unroll
                for (int i = 0; i < 11; ++i) { const int tc = tc_seq(dir, j0 + i);
                    ob[(size_t)tc * 2048] = (u32x4){pk2(st[0], st[1]), pk2(st[2], st[3]), pk2(st[4], st[5]), pk2(st[6], st[7])};
                    const f32x4 ta = g0[i] * 1.44269504f, tb = g1[i] * 1.44269504f;
                    const f32x2_t e0 = {__builtin_amdgcn_exp2f(ta.x), __builtin_amdgcn_exp2f(ta.y)}, e1 = {__builtin_amdgcn_exp2f(ta.z), __builtin_amdgcn_exp2f(ta.w)}, e2 = {__builtin_amdgcn_exp2f(tb.x), __builtin_amdgcn_exp2f(tb.y)}, e3 = {__builtin_amdgcn_exp2f(tb.z), __builtin_amdgcn_exp2f(tb.w)};
                    const f32x2_t s0 = e0 * (f32x2_t){st[0], st[1]} + (f32x2_t){bflo(dv[i].x), bfhi(dv[i].x)}, s1 = e1 * (f32x2_t){st[2], st[3]} + (f32x2_t){bflo(dv[i].y), bfhi(dv[i].y)};
                    const f32x2_t s2 = e2 * (f32x2_t){st[4], st[5]} + (f32x2_t){bflo(dv[i].z), bfhi(dv[i].z)}, s3 = e3 * (f32x2_t){st[6], st[7]} + (f32x2_t){bflo(dv[i].w), bfhi(dv[i].w)};
                    st[0] = s0.x; st[1] = s0.y; st[2] = s1.x; st[3] = s1.y; st[4] = s2.x; st[5] = s2.y; st[6] = s3.x; st[7] = s3.y; }
            }
        }
    } else if (t < 192) {
        for (int item = F.vcu * 64 + (t - 128); item < 16 * 1024; item += F.G * 64) {
            const int scan = item >> 10, e = (item & 1023) * 8, dir = scan & 1;
            const u32x4* cb = (const u32x4*)((const bf16*)(F.ws + WS_MLC) + (size_t)scan * NTC * 8192 + e); u32x4* ob = (u32x4*)((bf16*)(F.ws + WS_MLCB) + (size_t)scan * NTC * 8192 + e);
            float m = 0.f, st[8];
#pragma unroll
            for (int k = 0; k < 8; ++k) st[k] = 0.f;
            for (int j0 = 0; j0 < NTC; j0 += 12) {
                u32x4 dv[12]; float gg[12], ml[12];
#pragma unroll
                for (int i = 0; i < 12; ++i) { const int tc = tc_seq(dir, j0 + i); dv[i] = cb[(size_t)tc * 1024]; const float* sp = MLS + (size_t)(scan * NTC + tc) * 4; gg[i] = sp[0]; ml[i] = sp[1]; }
#pragma unroll
                for (int i = 0; i < 12; ++i) { const int tc = tc_seq(dir, j0 + i);
                    const float mn = fmaxf(gg[i] + m, ml[i]), a = __expf(gg[i] + m - mn), w = __expf(ml[i] - mn);
                    if ((item & 1023) == 0) MLS[(size_t)(scan * NTC + tc) * 4 + 2] = m;
                    ob[(size_t)tc * 1024] = (u32x4){pk2(st[0], st[1]), pk2(st[2], st[3]), pk2(st[4], st[5]), pk2(st[6], st[7])};
                    const f32x2_t s0 = (f32x2_t){st[0], st[1]} * a + (f32x2_t){bflo(dv[i].x), bfhi(dv[i].x)} * w, s1 = (f32x2_t){st[2], st[3]} * a + (f32x2_t){bflo(dv[i].y), bfhi(dv[i].y)} * w;
                    const f32x2_t s2 = (f32x2_t){st[4], st[5]} * a + (f32x2_t){bflo(dv[i].z), bfhi(dv[i].z)} * w, s3 = (f32x2_t){st[6], st[7]} * a + (f32x2_t){bflo(dv[i].w), bfhi(dv[i].w)} * w;
                    st[0] = s0.x; st[1] = s0.y; st[2] = s1.x; st[3] = s1.y; st[4] = s2.x; st[5] = s2.y; st[6] = s3.x; st[7] = s3.y; m = mn; }
            }
        }
    } else if (t < 196) {
        for (int item = F.vcu * 4 + (t - 192); item < 16 * 64; item += F.G * 4) {
            const int scan = item >> 6, e = item & 63, dir = scan & 1; float* nb = (float*)(F.ws + WS_MLN) + (size_t)scan * NTC * 64 + e;
            float m = 0.f, s0 = 0.f;
            for (int j0 = 0; j0 < NTC; j0 += 12) {
                float dv[12];
#pragma unroll
                for (int i = 0; i < 12; ++i) dv[i] = nb[tc_seq(dir, j0 + i) * 64];
#pragma unroll
                for (int i = 0; i < 12; ++i) { const int tc = tc_seq(dir, j0 + i); const float* sp = MLS + (size_t)(scan * NTC + tc) * 4;
                    const float g = sp[0], ml = sp[1], mn = fmaxf(g + m, ml), a = __expf(g + m - mn), w = __expf(ml - mn);
                    nb[tc * 64] = s0; s0 = a * s0 + w * dv[i]; m = mn; }
            }
        }
    }
}
template <int MIX>
__device__ __forceinline__ void gate_load(Frame& F, int row0, int h, unsigned (&gate)[16]) {
    const int mt = F.wave >> 2, nt = F.wave & 3; const bf16* P = (const bf16*)(F.ws + WS_P) + (MIX == 0 ? PC_O : PC_GO) + h * 128 + 32 * nt + (F.lane & 31);
#pragma unroll
    for (int r = 0; r < 16; ++r) gate[r] = P[(size_t)(row0 + 32 * mt + rowmap(r, F.lane >> 5)) * PW];
}
template <int MIX>
__device__ __forceinline__ void head_epilogue(Frame& F, const float ng, const f32x16& hv, const unsigned (&gate)[16], LAS float* part, int row0, int h) {
    const int mt = F.wave >> 2, nt = F.wave & 3, lane = F.lane, hi = lane >> 5;
    float ps[16];
#pragma unroll
    for (int r = 0; r < 16; ++r) ps[r] = hv[r] * hv[r];
#pragma unroll
    for (int r = 0; r < 16; ++r) ps[r] = half_sum_hi(ps[r]);
    if ((lane & 31) == 31) {
#pragma unroll
        for (int r = 0; r < 16; ++r) part[(32 * mt + rowmap(r, hi)) * 4 + nt] = ps[r]; }
    LDS_BARRIER();
    bf16* Y = (bf16*)(F.ws + WS_Y) + (MIX == 0 ? 0 : 512) + h * 128 + 32 * nt + (lane & 31);
#pragma unroll
    for (int r = 0; r < 16; r += 2) { const int t0 = 32 * mt + rowmap(r, hi), t1 = 32 * mt + rowmap(r + 1, hi); const f32x4 p4 = *(const LAS f32x4*)(part + t0 * 4), q4 = *(const LAS f32x4*)(part + t1 * 4);
        const f32x2_t ms = (f32x2_t){(p4.x + p4.y) + (p4.z + p4.w), (q4.x + q4.y) + (q4.z + q4.w)} * (1.f / 128.f) + EPS;
        const f32x2_t rstd = {__builtin_amdgcn_rsqf(ms.x), __builtin_amdgcn_rsqf(ms.y)}, gz = {bf2f((unsigned short)gate[r]), bf2f((unsigned short)gate[r + 1])};
        const f32x2_t te = gz * (-1.44269504f), dn = (f32x2_t){__builtin_amdgcn_exp2f(te.x), __builtin_amdgcn_exp2f(te.y)} + 1.f;
        const f32x2_t sg = {__builtin_amdgcn_rcpf(dn.x), __builtin_amdgcn_rcpf(dn.y)}, gv = MIX == 0 ? sg : gz * sg;
        const f32x2_t y = ((f32x2_t){hv[r], hv[r + 1]} * rstd) * (gv * ng); const unsigned w = pk2(y.x, y.y);
        Y[(size_t)(row0 + t0) * D] = (bf16)w; Y[(size_t)(row0 + t1) * D] = (bf16)(w >> 16); }
}
struct MlCRaw { VtRaw v; u32x4 q, k; u32x4 cf[2]; float g0, g1, ms; };
__device__ __forceinline__ void touch(MlCRaw& R) {
#pragma unroll
    for (int i = 0; i < 8; ++i) touch(R.v.w[i]);
    touch(R.q); touch(R.k); touch(R.cf[0]); touch(R.cf[1]); touch(R.g0); touch(R.g1); touch(R.ms); }
__device__ __forceinline__ void ml_passC_load(Frame& F, int task, MlCRaw& R) {
    const TaskId T = task_id(task); const bf16* CQK = (const bf16*)(F.ws + WS_CQK);
    vt_load(R.v, (const bf16*)(F.ws + WS_P), PW, T.row0, PC_V + T.h * 128, F.tid);
    { const int row = F.tid >> 3, pc = F.tid & 7;
      R.q = *(const u32x4*)(CQK + (size_t)(T.row0 + row) * 512 + T.h * 64 + pc * 8); R.k = *(const u32x4*)(CQK + (size_t)(T.row0 + row) * 512 + 256 + T.h * 64 + pc * 8); }
    { const u32x4* cp = (const u32x4*)((const bf16*)(F.ws + WS_MLCB) + (size_t)(T.sidf * NTC + T.tc) * 8192 + (F.tid >> 2) * 64 + (F.tid & 3) * 16); R.cf[0] = cp[0]; R.cf[1] = cp[1]; }
    R.g0 = 0.f; R.g1 = 0.f; R.ms = 0.f;
    if (F.wave < 2) { const int dir = F.wave; const float* gp = (const float*)(F.ws + WS_GATES) + (size_t)(T.row0 + F.lane) * 16; R.g0 = gp[dir * 4 + T.h]; R.g1 = gp[8 + dir * 4 + T.h];
        R.ms = ((const float*)(F.ws + WS_MLS))[(size_t)((T.sidf + dir) * NTC + T.tc) * 4 + 2]; }
}
__device__ __forceinline__ void ml_passC_run(Frame& F, CArgs& A, int l, int task, const MlCRaw& R) {
    const TaskId T = task_id(task); const int h = T.h, tc = T.tc, row0 = T.row0, sidf = T.sidf;
    if (l == DEPTH - 1 && tc < 4) return;
    unsigned gate[16];
    const float ng = A.in[I_MLNG][l * 512 + h * 128 + 32 * (F.wave & 3) + (F.lane & 31)];
    LAS unsigned char* Q = F.lds; LAS unsigned char* Kn = F.lds + 9216; LAS unsigned char* VT = F.lds + 18432; LAS unsigned char* Cs = F.lds + 36864;
    LAS unsigned char* Pm = F.lds + 55296; LAS unsigned char* Qs = F.lds + 64512;
    LAS float* sm = (LAS float*)(F.lds + 73728);
    const int tid = F.tid, lane = F.lane;
    u32x4 cb[2]; { const u32x4* cp = (const u32x4*)((const bf16*)(F.ws + WS_MLCB) + (size_t)((sidf + 1) * NTC + tc) * 8192 + (tid >> 2) * 64 + (tid & 3) * 16); cb[0] = cp[0]; cb[1] = cp[1]; }
    float nv = 0.f; if (tid < 128) nv = ((const float*)(F.ws + WS_MLN))[(size_t)((sidf + (tid >> 6)) * NTC + tc) * 64 + (tid & 63)];
    LDS_BARRIER();
    { const int row = tid >> 3, pc = tid & 7; *(LAS u32x4*)(Q + row * ST64 + pc * 16) = R.q; *(LAS u32x4*)(Kn + row * ST64 + pc * 16) = R.k; }
    vt_store(VT, R.v, tid);
    if (tid < 128) sm[512 + tid] = nv;
    if (F.wave < 2) { const int dir = F.wave, s = lane; const float ig = R.g0, lf = R.g1, ms = R.ms;
        float bt, u, pm;
        if (dir == 0) { bt = wave_incl_sum(lf, s); u = ig - bt; pm = wave_incl_max(u, s); }
        else { const float pf = wave_incl_sum(lf, s), tot = __builtin_bit_cast(float, __builtin_amdgcn_readlane(__builtin_bit_cast(int, pf), 63)); bt = tot - pf + lf; u = ig - bt;
               float r = __shfl(u, 63 - s); r = wave_incl_max(r, s); pm = __shfl(r, 63 - s); }
        const float M = fmaxf(ms, pm);
        LAS float* o = sm + dir * 256; o[s] = u; o[64 + s] = M; o[128 + s] = __expf(ms - M); o[192 + s] = __expf(-(bt + M)); }
    LDS_BARRIER();
    f32x16 qk;
#pragma unroll
    for (int i = 0; i < 16; ++i) qk[i] = 0.f;
    if (F.wave < 4) mm32<64>(qk, Q + 32 * (F.wave >> 1) * ST64, ST64, Kn + 32 * (F.wave & 1) * ST64, ST64, lane);
    f32x16 hs;
#pragma unroll
    for (int i = 0; i < 16; ++i) hs[i] = 0.f;
#pragma unroll 1
    for (int dir = 0; dir < 2; ++dir) {
        const LAS float* sd = sm + dir * 256;
        { const int v = tid >> 2, pc = tid & 3; *(LAS u32x4*)(Cs + v * ST64 + pc * 32) = dir == 0 ? R.cf[0] : cb[0]; *(LAS u32x4*)(Cs + v * ST64 + pc * 32 + 16) = dir == 0 ? R.cf[1] : cb[1]; }
        { const int row = tid >> 3, pc = tid & 7; const u32x4 q = R.q; const float w = sd[128 + row];
          *(LAS u32x4*)(Qs + row * ST64 + pc * 16) = (u32x4){pk2(bflo(q.x) * w, bfhi(q.x) * w), pk2(bflo(q.y) * w, bfhi(q.y) * w), pk2(bflo(q.z) * w, bfhi(q.z) * w), pk2(bflo(q.w) * w, bfhi(q.w) * w)}; }
        if (F.wave < 4) { const int s = 32 * (F.wave & 1) + (lane & 31); const float us = sd[s]; float Mt[16];
#pragma unroll
            for (int r = 0; r < 16; ++r) Mt[r] = sd[64 + 32 * (F.wave >> 1) + rowmap(r, lane >> 5)];
#pragma unroll
            for (int r = 0; r < 16; r += 2) { const int t0 = 32 * (F.wave >> 1) + rowmap(r, lane >> 5), t1 = 32 * (F.wave >> 1) + rowmap(r + 1, lane >> 5);
                const bool ok0 = dir == 0 ? (s <= t0) : (s >= t0), ok1 = dir == 0 ? (s <= t1) : (s >= t1);
                f32x2_t ex = (f32x2_t){us - Mt[r], us - Mt[r + 1]}; ex.x = fminf(ex.x, 0.f); ex.y = fminf(ex.y, 0.f); ex = ex * 1.44269504f;
                const f32x2_t p = (f32x2_t){qk[r], qk[r + 1]} * (f32x2_t){__builtin_amdgcn_exp2f(ex.x), __builtin_amdgcn_exp2f(ex.y)}; const unsigned w = pk2(ok0 ? p.x : 0.f, ok1 ? p.y : 0.f);
                *(LAS unsigned short*)(Pm + t0 * ST64 + s * 2) = (unsigned short)w; *(LAS unsigned short*)(Pm + t1 * ST64 + s * 2) = (unsigned short)(w >> 16); } }
        LDS_BARRIER();
        if (tid < 256) { const int t = tid >> 2, qd = tid & 3; float den = 0.f, qn = 0.f;
#pragma unroll
            for (int i = 0; i < 2; ++i) { const u32x4 w = *(const LAS u32x4*)(Pm + t * ST64 + qd * 32 + i * 16); den += (bflo(w.x) + bfhi(w.x)) + (bflo(w.y) + bfhi(w.y)) + (bflo(w.z) + bfhi(w.z)) + (bflo(w.w) + bfhi(w.w));
                const u32x4 q = *(const LAS u32x4*)(Q + t * ST64 + qd * 32 + i * 16); const LAS float* nvp = sm + 512 + dir * 64 + qd * 16 + i * 8; const f32x4 n0 = *(const LAS f32x4*)nvp, n1 = *(const LAS f32x4*)(nvp + 4);
                qn += (bflo(q.x) * n0.x + bfhi(q.x) * n0.y) + (bflo(q.y) * n0.z + bfhi(q.y) * n0.w) + (bflo(q.z) * n1.x + bfhi(q.z) * n1.y) + (bflo(q.w) * n1.z + bfhi(q.w) * n1.w); }
            den += sd[128 + t] * qn;
            den += dppf<0xB1, 0xf, true>(0.f, den); den += dppf<0x4E, 0xf, true>(0.f, den);
            if (qd == 0) sm[640 + t] = 1.f / fmaxf(fabsf(den), sd[192 + t]); }
        f32x16 acc;
#pragma unroll
        for (int i = 0; i < 16; ++i) acc[i] = 0.f;
        { const int mt = F.wave >> 2, nt = F.wave & 3;
          mm32<64>(acc, Pm + 32 * mt * ST64, ST64, VT + 32 * nt * ST64, ST64, lane);
          mm32<64>(acc, Qs + 32 * mt * ST64, ST64, Cs + 32 * nt * ST64, ST64, lane); }
        LDS_BARRIER();
        float dsc[16];
#pragma unroll
        for (int r = 0; r < 16; ++r) dsc[r] = sm[640 + 32 * (F.wave >> 2) + rowmap(r, lane >> 5)];
#pragma unroll
        for (int r = 0; r < 16; ++r) hs[r] += acc[r] * dsc[r];
        if (dir == 0) LDS_BARRIER();
    }
    gate_load<0>(F, row0, h, gate);
    head_epilogue<0>(F, ng, hs, gate, sm + 768, row0, h);
}

struct HgPrep { float k[16], x[16]; float T[4]; };
__device__ __forceinline__ void hg_zload(Frame& F, int h, int row0, int dir, unsigned (&z)[16]) {
    const int d = F.tid & 127, qtr = F.tid >> 7;
    const bf16* P = (const bf16*)(F.ws + WS_P) + (size_t)(row0 + qtr * 16) * PW + (dir == 0 ? PC_FF : PC_FB) + h * 128 + d;
#pragma unroll
    for (int i = 0; i < 16; ++i) z[i] = P[(size_t)i * PW];
}
struct HgConst { float lb, bf, bb; };
__device__ __forceinline__ HgConst hg_const(Frame& F, CArgs& A, int l, int h) { const int ch = h * 128 + (F.tid & 127); HgConst c; c.lb = 0.f;
    if (l == 1) { const float r0 = A.in[I_HGLB][ch], r1 = A.in[I_HGLB][512 + ch], mx = fmaxf(r0, r1), e0 = __expf(r0 - mx), e1 = __expf(r1 - mx); c.lb = e1 / (e0 + e1); }
    c.bf = A.in[I_HGFB][l * 1024 + ch]; c.bb = A.in[I_HGFB][l * 1024 + 512 + ch]; return c; }
template <int dir>
__device__ __forceinline__ void hg_prep(Frame& F, const HgConst& C, int l, const unsigned (&zr)[16], LAS float* tot, HgPrep& R) {
    const int d = F.tid & 127, qtr = F.tid >> 7;
    const float lb = C.lb, bias = dir == 0 ? C.bf : C.bb, omlb = 1.f - lb;
    float cs = 0.f;
#pragma unroll
    for (int i = 0; i < 16; i += 2) {
        f32x2_t z = (f32x2_t){bf2f((unsigned short)zr[i]), bf2f((unsigned short)zr[i + 1])} + bias;
        z.x = fminf(fmaxf(z.x, -30.f), 30.f); z.y = fminf(fmaxf(z.y, -30.f), 30.f);
        const f32x2_t t = z * (-1.44269504f);
        const f32x2_t ez = {__builtin_amdgcn_exp2f(t.x), __builtin_amdgcn_exp2f(t.y)}, dn = ez + 1.f;
        const f32x2_t sg = {__builtin_amdgcn_rcpf(dn.x), __builtin_amdgcn_rcpf(dn.y)};
        const f32x2_t kk = (ez * sg) * omlb, ff = sg * omlb + lb;
        R.k[i] = kk.x; R.k[i + 1] = kk.y;
        const f32x2_t lf = (f32x2_t){__builtin_amdgcn_logf(ff.x), __builtin_amdgcn_logf(ff.y)} * 0.69314718f;
        if (dir == 0) { cs += lf.x; R.x[i] = cs; cs += lf.y; R.x[i + 1] = cs; } else { R.x[i] = cs; cs += lf.x; R.x[i + 1] = cs; cs += lf.y; } }
    tot[dir * 512 + qtr * 128 + d] = cs;
    LDS_BARRIER();
    float off = 0.f;
#pragma unroll
    for (int q = 0; q < 4; ++q) { R.T[q] = tot[dir * 512 + q * 128 + d]; if (q < qtr) off += R.T[q]; }
#pragma unroll
    for (int i = 0; i < 16; ++i) R.x[i] += off;
}
__device__ __forceinline__ void put16(LAS unsigned char* p, const float (&v)[16]) {
    *(LAS u32x4*)p = (u32x4){pk2(v[0], v[1]), pk2(v[2], v[3]), pk2(v[4], v[5]), pk2(v[6], v[7])};
    *(LAS u32x4*)(p + 16) = (u32x4){pk2(v[8], v[9]), pk2(v[10], v[11]), pk2(v[12], v[13]), pk2(v[14], v[15])};
}
struct HgARaw { VtRaw v; unsigned zf[16], zb[16]; };
__device__ __forceinline__ void touch(HgARaw& R) {
#pragma unroll
    for (int i = 0; i < 8; ++i) touch(R.v.w[i]);
#pragma unroll
    for (int i = 0; i < 16; ++i) { touch(R.zf[i]); touch(R.zb[i]); } }
__device__ __forceinline__ void hg_passA_load(Frame& F, int task, HgARaw& R) {
    const TaskId T = task_id(task);
    vt_load(R.v, (const bf16*)(F.ws + WS_CQI), 1024, T.row0, 512 + T.h * 128, F.tid);
    hg_zload(F, T.h, T.row0, 0, R.zf); hg_zload(F, T.h, T.row0, 1, R.zb);
}
__device__ __forceinline__ void hg_passA_run(Frame& F, CArgs& A, int l, int task, const HgARaw& RW) {
    const TaskId T = task_id(task); const int h = T.h, tc = T.tc, sidf = T.sidf;
    LAS unsigned char* VT = F.lds; LAS unsigned char* KT = F.lds + 18432; LAS float* tot = (LAS float*)(F.lds + 55296);
    const int d = F.tid & 127, qtr = F.tid >> 7;
    const HgConst HC = hg_const(F, A, l, h);
    LDS_BARRIER();
    vt_store(VT, RW.v, F.tid);
    float* GG = (float*)(F.ws + WS_HGG);
    { HgPrep R; hg_prep<0>(F, HC, l, RW.zf, tot, R);
      const float G = (R.T[0] + R.T[1]) + (R.T[2] + R.T[3]);
      if (qtr == 0) GG[(size_t)(sidf * NTC + tc) * 128 + d] = G;
      float t[16];
#pragma unroll
      for (int i = 0; i < 16; i += 2) { const f32x2_t te = ((f32x2_t){R.x[i], R.x[i + 1]} - G) * (-1.44269504f);
          const f32x2_t kv = (f32x2_t){R.k[i], R.k[i + 1]} * (f32x2_t){__builtin_amdgcn_exp2f(te.x), __builtin_amdgcn_exp2f(te.y)}; t[i] = kv.x; t[i + 1] = kv.y; }
      put16(KT + d * ST64 + qtr * 32, t); }
    { HgPrep R; hg_prep<1>(F, HC, l, RW.zb, tot, R);
      const float G = (R.T[0] + R.T[1]) + (R.T[2] + R.T[3]);
      if (qtr == 0) GG[(size_t)((sidf + 1) * NTC + tc) * 128 + d] = G;
      float t[16];
#pragma unroll
      for (int i = 0; i < 16; i += 2) { const f32x2_t te = (f32x2_t){R.x[i], R.x[i + 1]} * 1.44269504f;
          const f32x2_t kv = (f32x2_t){R.k[i], R.k[i + 1]} * (f32x2_t){__builtin_amdgcn_exp2f(te.x), __builtin_amdgcn_exp2f(te.y)}; t[i] = kv.x; t[i + 1] = kv.y; }
      put16(KT + 18432 + d * ST64 + qtr * 32, t); }
    LDS_BARRIER();
    { const int dir = F.wave >> 2, mt = F.wave & 3; bf16* S = (bf16*)(F.ws + WS_HGS) + (size_t)((sidf + dir) * NTC + tc) * 16384;
#pragma unroll
      for (int nt = 0; nt < 4; ++nt) { f32x16 acc;
#pragma unroll
          for (int i = 0; i < 16; ++i) acc[i] = 0.f;
          mm32<64>(acc, VT + 32 * mt * ST64, ST64, KT + dir * 18432 + 32 * nt * ST64, ST64, F.lane);
#pragma unroll
          for (int r = 0; r < 16; ++r) S[(32 * mt + rowmap(r, F.lane >> 5)) * 128 + 32 * nt + (F.lane & 31)] = (bf16)f2bf(acc[r]); } }
}
struct HgCRaw { VtRaw v; unsigned zf[16], q[16]; };
__device__ __forceinline__ void touch(HgCRaw& R) {
#pragma unroll
    for (int i = 0; i < 8; ++i) touch(R.v.w[i]);
#pragma unroll
    for (int i = 0; i < 16; ++i) { touch(R.zf[i]); touch(R.q[i]); } }
__device__ __forceinline__ void hg_passC_load(Frame& F, int task, HgCRaw& R) {
    const TaskId T = task_id(task); const bf16* CQI = (const bf16*)(F.ws + WS_CQI);
    vt_load(R.v, CQI, 1024, T.row0, 512 + T.h * 128, F.tid);
    hg_zload(F, T.h, T.row0, 0, R.zf);
    { const int d = F.tid & 127, qtr = F.tid >> 7;
#pragma unroll
      for (int i = 0; i < 16; ++i) R.q[i] = CQI[(size_t)(T.row0 + qtr * 16 + i) * 1024 + T.h * 128 + d]; }
}
__device__ __forceinline__ void hg_passC_run(Frame& F, CArgs& A, int l, int task, const HgCRaw& RW) {
    const TaskId T = task_id(task); const int h = T.h, tc = T.tc, row0 = T.row0, sidf = T.sidf;
    LAS unsigned char* VT = F.lds; LAS unsigned char* Ss = F.lds + 18432; LAS unsigned char* Qh = F.lds + 53248; LAS unsigned char* Kh = F.lds + 70656;
    LAS unsigned char* Qc = F.lds + 88064; LAS unsigned char* Kc = F.lds + 96768; LAS unsigned char* Qt = F.lds + 105472; LAS unsigned char* Am = F.lds + 122880;
    LAS float* tot = (LAS float*)(F.lds + 132096);
    const int tid = F.tid, lane = F.lane, d = tid & 127, qtr = tid >> 7;
    if (l == DEPTH - 1 && tc < 4) return;
    unsigned gate[16];
    const HgConst HC = hg_const(F, A, l, h);
    unsigned zb[16]; hg_zload(F, h, row0, 1, zb);
    u32x4 sf[4], sb[4]; { const u32x4* sp = (const u32x4*)((const bf16*)(F.ws + WS_HGSB) + (size_t)(sidf * NTC + tc) * 16384 + (tid >> 2) * 128 + (tid & 3) * 32);
#pragma unroll
      for (int j = 0; j < 4; ++j) { sf[j] = sp[j]; sb[j] = sp[j + (size_t)NTC * 16384 * 2 / 16]; } }
    LDS_BARRIER();
    vt_store(VT, RW.v, tid);
    f32x16 acc;
#pragma unroll
    for (int i = 0; i < 16; ++i) acc[i] = 0.f;
#pragma unroll
    for (int dir = 0; dir < 2; ++dir) {
        HgPrep R;
        if (dir == 1) gate_load<1>(F, row0, h, gate);
        if (dir == 0) hg_prep<0>(F, HC, l, RW.zf, tot, R); else hg_prep<1>(F, HC, l, zb, tot, R);
        const float T0 = R.T[0], T1 = R.T[1], T2 = R.T[2], T3 = R.T[3];
        const float sg = dir == 0 ? 1.f : -1.f;
        const float rI = sg * ((qtr >> 1) == 0 ? T0 : (T0 + T1) + T2);
        const float rO = sg * (T0 + T1);
        const float Gall = (T0 + T1) + (T2 + T3);
        const bool isq = dir == 0 ? (qtr >= 2) : (qtr < 2);
        const float cO = __expf(isq ? rI - rO : rO - rI), cT = __expf(dir == 0 ? rI : Gall + rI);
        { const int v = tid >> 2, pc = tid & 3;
#pragma unroll
          for (int j = 0; j < 4; ++j) *(LAS u32x4*)(Ss + v * ST128 + pc * 64 + j * 16) = dir == 0 ? sf[j] : sb[j]; }
#pragma unroll
        for (int i = 0; i < 16; i += 2) {
            const int t = qtr * 16 + i;
            const f32x2_t x = dir == 0 ? (f32x2_t){R.x[i], R.x[i + 1]} : (f32x2_t){-R.x[i], -R.x[i + 1]}, kk = {R.k[i], R.k[i + 1]}, qv = {bf2f((unsigned short)RW.q[i]), bf2f((unsigned short)RW.q[i + 1])};
            const f32x2_t te = (x - rI) * 1.44269504f;
            const f32x2_t eh = {__builtin_amdgcn_exp2f(te.x), __builtin_amdgcn_exp2f(te.y)}, ehr = {__builtin_amdgcn_rcpf(eh.x), __builtin_amdgcn_rcpf(eh.y)};
            const f32x2_t qe = qv * eh, ke = kk * ehr, of = (isq ? qe : ke) * cO, qt = qe * cT;
            const unsigned wq = pk2(qe.x, qe.y), wk = pk2(ke.x, ke.y), wo = pk2(of.x, of.y), wt = pk2(qt.x, qt.y);
            *(LAS unsigned short*)(Qh + t * ST128 + d * 2) = (unsigned short)wq; *(LAS unsigned short*)(Qh + (t + 1) * ST128 + d * 2) = (unsigned short)(wq >> 16);
            *(LAS unsigned short*)(Kh + t * ST128 + d * 2) = (unsigned short)wk; *(LAS unsigned short*)(Kh + (t + 1) * ST128 + d * 2) = (unsigned short)(wk >> 16);
            LAS unsigned char* oc = isq ? Qc : Kc;
            *(LAS unsigned short*)(oc + (t & 31) * ST128 + d * 2) = (unsigned short)wo; *(LAS unsigned short*)(oc + ((t + 1) & 31) * ST128 + d * 2) = (unsigned short)(wo >> 16);
            *(LAS unsigned short*)(Qt + t * ST128 + d * 2) = (unsigned short)wt; *(LAS unsigned short*)(Qt + (t + 1) * ST128 + d * 2) = (unsigned short)(wt >> 16);
        }
        LDS_BARRIER();
        if (F.wave < 4) { f32x16 a;
#pragma unroll
            for (int i = 0; i < 16; ++i) a[i] = 0.f;
            int tt = 0, ts = 0;
            if (F.wave < 2) { tt = ts = F.wave; mm32<128>(a, Qh + 32 * tt * ST128, ST128, Kh + 32 * ts * ST128, ST128, lane);
#pragma unroll
                for (int r = 0; r < 16; ++r) { const int tl = rowmap(r, lane >> 5), sl = lane & 31; const bool ok = dir == 0 ? (sl <= tl) : (sl >= tl); a[r] = ok ? a[r] : 0.f; } }
            else if (F.wave == 2) { tt = dir == 0 ? 1 : 0; ts = 1 - tt; mm32<128>(a, Qc, ST128, Kc, ST128, lane); }
            else { tt = dir == 0 ? 0 : 1; ts = 1 - tt; }
#pragma unroll
            for (int r = 0; r < 16; r += 2) { const unsigned w = pk2(a[r], a[r + 1]); *(LAS unsigned short*)(Am + (32 * tt + rowmap(r, lane >> 5)) * ST64 + (32 * ts + (lane & 31)) * 2) = (unsigned short)w;
                *(LAS unsigned short*)(Am + (32 * tt + rowmap(r + 1, lane >> 5)) * ST64 + (32 * ts + (lane & 31)) * 2) = (unsigned short)(w >> 16); } }
        LDS_BARRIER();
        { const int mt = F.wave >> 2, nt = F.wave & 3;
          mm32<64>(acc, Am + 32 * mt * ST64, ST64, VT + 32 * nt * ST64, ST64, lane);
          mm32<128>(acc, Qt + 32 * mt * ST128, ST128, Ss + 32 * nt * ST128, ST128, lane); }
        if (dir == 0) LDS_BARRIER();
    }
    const float ng = A.in[I_HGNG][l * 512 + h * 128 + 32 * (F.wave & 3) + (lane & 31)];
    head_epilogue<1>(F, ng, acc, gate, (LAS float*)(F.lds + 136192), row0, h);
}
#define TASK_LOOP(RAW, LOADFN, RUNFN, T0, T1) do { int t_ = F.vcu; while (t_ < (T0)) t_ += F.G; RAW cur_; if (t_ < (T1)) { LOADFN(t_ - (T0), cur_); } \
    for (; t_ < (T1); t_ += F.G) { touch(cur_); RAW nxt_; if (t_ + F.G < (T1)) { LOADFN(t_ + F.G - (T0), nxt_); } else nxt_ = cur_; RUNFN(t_ - (T0), cur_); cur_ = nxt_; } } while (0)

__device__ __forceinline__ void transpose_item(const float* W, int ldw, int K, bf16* WT, int k0, int n0, int drow0, LAS float* scr, int lane) {
    const int n4 = (lane & 7) * 4, kr = lane >> 3;
    f32x4 v[8];
#pragma unroll
    for (int i = 0; i < 8; ++i) v[i] = __builtin_nontemporal_load((const f32x4*)(W + (size_t)(k0 + 8 * i + kr) * ldw + n0 + n4));
#pragma unroll
    for (int i = 0; i < 8; ++i) { LAS float* p = scr + (8 * i + kr) * 33 + n4; p[0] = v[i].x; p[1] = v[i].y; p[2] = v[i].z; p[3] = v[i].w; }
    asm volatile("s_waitcnt lgkmcnt(0)" ::: "memory");
    const int c = lane & 7;
#pragma unroll
    for (int j = 0; j < 4; ++j) { const int n = (lane >> 3) + 8 * j; const LAS float* s = scr + (8 * c) * 33 + n;
        u32x4 o; o.x = pk2(s[0 * 33], s[1 * 33]); o.y = pk2(s[2 * 33], s[3 * 33]); o.z = pk2(s[4 * 33], s[5 * 33]); o.w = pk2(s[6 * 33], s[7 * 33]);
        *(u32x4*)(WT + (size_t)(drow0 + n) * K + k0 + 8 * c) = o; }
    asm volatile("s_waitcnt lgkmcnt(0)" ::: "memory");
}
__device__ __forceinline__ void ph_convert(Frame& F, CArgs& A, bool small_only) {
    LAS float* scr = (LAS float*)(F.lds + 32768 + F.wave * 8448);
    const int gw = F.vcu * NWAVES + F.wave, NGW = F.G * NWAVES;
    constexpr int I_IN = DEPTH * 16 * 128, I_OUT = DEPTH * 16 * 32, I_GU = DEPTH * NEXP * 16 * 64, I_DN = DEPTH * NEXP * 16 * 32;
    for (int it = gw; it < (small_only ? I_IN + I_OUT : I_IN + I_OUT + I_GU + I_DN); it += NGW) {
        int r = it;
        if (r < I_IN) { const int l = r / 2048, q = r % 2048, kb = q / 128, nb = q % 128, d0 = nb * 32, n0 = d0 < 1536 ? d0 : d0 + 16;
            transpose_item(A.in[I_WIN] + (size_t)l * D * INW, INW, D, (bf16*)(F.ws + WS_WIN) + (size_t)l * PW * D, kb * 64, n0, d0, scr, F.lane); continue; }
        r -= I_IN;
        if (r < I_OUT) { const int l = r / 512, q = r % 512, kb = q / 32, nb = q % 32;
            transpose_item(A.in[I_WOUT] + (size_t)l * D * D, D, D, (bf16*)(F.ws + WS_WOUT) + (size_t)l * D * D, kb * 64, nb * 32, nb * 32, scr, F.lane); continue; }
        r -= I_OUT;
        if (r < I_GU) { const int m = r / 1024, q = r % 1024, kb = q / 64, nb = q % 64, n0 = nb * 32;
            const int cc = n0 & 1023, d0 = (cc >> 7) * 256 + (n0 >= 1024 ? 128 : 0) + (cc & 127);
            transpose_item(A.in[I_WGU] + (size_t)m * D * 2048, 2048, D, (bf16*)(F.ws + WS_WGU) + (size_t)m * 2048 * D, kb * 64, n0, d0, scr, F.lane); continue; }
        r -= I_GU;
        { const int m = r / 512, q = r % 512, kb = q / 32, nb = q % 32;
            transpose_item(A.in[I_WDN] + (size_t)m * DEXP * D, D, DEXP, (bf16*)(F.ws + WS_WDN) + (size_t)m * D * DEXP, kb * 64, nb * 32, nb * 32, scr, F.lane); }
    }
}


constexpr int CV_NJ = 384;
__device__ __forceinline__ void moe_item_addr(CArgs& A, unsigned char* ws, int item, const float*& W, int& ldw, bf16*& WT, int& k0, int& n0, int& d0) {
    const int l = item / 49152, r = item % 49152;
    if (r < 32768) { const int e = r >> 10, q = r & 1023, kb = q >> 6, nb = q & 63; n0 = nb * 32; const int cc = n0 & 1023; d0 = (cc >> 7) * 256 + (n0 >= 1024 ? 128 : 0) + (cc & 127); k0 = kb * 64;
        W = A.in[I_WGU] + (size_t)(l * NEXP + e) * D * 2048; ldw = 2048; WT = (bf16*)(ws + WS_WGU) + (size_t)(l * NEXP + e) * 2048 * D; }
    else { const int r2 = r - 32768, e = r2 >> 9, q = r2 & 511, kb = q >> 5, nb = q & 31; n0 = nb * 32; d0 = n0; k0 = kb * 64;
        W = A.in[I_WDN] + (size_t)(l * NEXP + e) * DEXP * D; ldw = D; WT = (bf16*)(ws + WS_WDN) + (size_t)(l * NEXP + e) * D * DEXP; }
}
__device__ __forceinline__ void transpose_store(bf16* WT, int K, int k0, int d0, LAS float* scr, const f32x4 (&v)[8], int lane) {
    const int n4 = (lane & 7) * 4, kr = lane >> 3;
#pragma unroll
    for (int i = 0; i < 8; ++i) { LAS float* p = scr + (8 * i + kr) * 33 + n4; p[0] = v[i].x; p[1] = v[i].y; p[2] = v[i].z; p[3] = v[i].w; }
    asm volatile("s_waitcnt lgkmcnt(0)" ::: "memory");
    const int c = lane & 7;
#pragma unroll
    for (int j = 0; j < 4; ++j) { const int n = (lane >> 3) + 8 * j; const LAS float* sp = scr + (8 * c) * 33 + n;
        u32x4 o; o.x = pk2(sp[0 * 33], sp[1 * 33]); o.y = pk2(sp[2 * 33], sp[3 * 33]); o.z = pk2(sp[4 * 33], sp[5 * 33]); o.w = pk2(sp[6 * 33], sp[7 * 33]);
        *(u32x4*)(WT + (size_t)(d0 + n) * K + k0 + 8 * c) = o; }
    asm volatile("s_waitcnt lgkmcnt(0)" ::: "memory");
}
__device__ __forceinline__ void convert_moe_all(unsigned char* ws, LAS unsigned char* lds, CArgs& A, int cw, int nw, int wave, int lane, int it_lo = 0, int it_hi = 49152) {
    LAS float* scr = (LAS float*)(lds + wave * 16640);
    const int n4 = (lane & 15) * 4, kr = lane >> 4;
    for (int it = it_lo + cw; it < it_hi; it += 2 * nw) {
        const float* W[2]; bf16* WT[2]; int ldw[2], k0[2], n0[2], d0[2];
        const bool two = it + nw < it_hi;
#pragma unroll
        for (int u = 0; u < 2; ++u) { const int iu = (u == 1 && two) ? it + nw : it; const int le = iu / 768, r = iu % 768;
            if (r < 512) { const int kb = r >> 5, nb = r & 31; k0[u] = kb * 64; n0[u] = nb * 64; const int cc = n0[u] & 1023; d0[u] = (cc >> 7) * 256 + (n0[u] >= 1024 ? 128 : 0) + (cc & 127);
                W[u] = A.in[I_WGU] + (size_t)le * D * 2048; ldw[u] = 2048; WT[u] = (bf16*)(ws + WS_WGU) + (size_t)le * 2048 * D; }
            else { const int q = r - 512, kb = q >> 4, nb = q & 15; k0[u] = kb * 64; n0[u] = nb * 64; d0[u] = n0[u];
                W[u] = A.in[I_WDN] + (size_t)le * DEXP * D; ldw[u] = D; WT[u] = (bf16*)(ws + WS_WDN) + (size_t)le * D * DEXP; } }
        f32x4 v[2][16];
#pragma unroll
        for (int u = 0; u < 2; ++u)
#pragma unroll
            for (int i = 0; i < 16; ++i) v[u][i] = __builtin_nontemporal_load((const f32x4*)(W[u] + (size_t)(k0[u] + 4 * i + kr) * ldw[u] + n0[u] + n4));
#pragma unroll
        for (int u = 0; u < 2; ++u) { if (u == 1 && !two) break;
#pragma unroll
            for (int i = 0; i < 16; ++i) { LAS float* p = scr + (4 * i + kr) * 65 + n4; p[0] = v[u][i].x; p[1] = v[u][i].y; p[2] = v[u][i].z; p[3] = v[u][i].w; }
            asm volatile("s_waitcnt lgkmcnt(0)" ::: "memory");
            const int c = lane & 7;
#pragma unroll
            for (int j = 0; j < 8; ++j) { const int n = (lane >> 3) + 8 * j; const LAS float* sp = scr + (8 * c) * 65 + n;
                u32x4 o; o.x = pk2(sp[0 * 65], sp[1 * 65]); o.y = pk2(sp[2 * 65], sp[3 * 65]); o.z = pk2(sp[4 * 65], sp[5 * 65]); o.w = pk2(sp[6 * 65], sp[7 * 65]);
                *(u32x4*)(WT[u] + (size_t)(d0[u] + n) * 1024 + k0[u] + 8 * c) = o; }
            asm volatile("s_waitcnt lgkmcnt(0)" ::: "memory"); }
    }
}
__device__ __forceinline__ void convert_moe(unsigned char* ws, LAS unsigned char* lds, CArgs& A, int cw, int wave, int lane, int j0, int j1) {
    LAS float* scr = (LAS float*)(lds + wave * 8448);
    const int n4 = (lane & 7) * 4, kr = lane >> 3;
    for (int j = j0; j < j1; j += 2) {
        const float* W0; const float* W1; bf16* T0; bf16* T1; int l0, l1, ka, kb_, na, nb_, da, db;
        moe_item_addr(A, ws, cw + 256 * j, W0, l0, T0, ka, na, da);
        const bool two = j + 1 < j1; moe_item_addr(A, ws, cw + 256 * (two ? j + 1 : j), W1, l1, T1, kb_, nb_, db);
        f32x4 v0[8], v1[8];
#pragma unroll
        for (int i = 0; i < 8; ++i) v0[i] = __builtin_nontemporal_load((const f32x4*)(W0 + (size_t)(ka + 8 * i + kr) * l0 + na + n4));
#pragma unroll
        for (int i = 0; i < 8; ++i) v1[i] = __builtin_nontemporal_load((const f32x4*)(W1 + (size_t)(kb_ + 8 * i + kr) * l1 + nb_ + n4));
        transpose_store(T0, 1024, ka, da, scr, v0, lane);
        if (two) transpose_store(T1, 1024, kb_, db, scr, v1, lane);
    }
}

#define XB_TMO      128
#define XB_XCNT(j)  (256  + 64 * (j))
#define XB_XSUB(j)  (1280 + 64 * (j))
#define XB_XGEN(j)  (2304 + 64 * (j))
#define XB_TOP      3328
#define XB_TOPGEN   3392
#define XCD_BAR_WORDS 3456
#define XB_SPIN_CAP (1u << 18)
__device__ __forceinline__ unsigned xb_ld(unsigned* p)              { return __hip_atomic_load(p, __ATOMIC_RELAXED, __HIP_MEMORY_SCOPE_AGENT); }
__device__ __forceinline__ unsigned xb_add(unsigned* p, unsigned v) { return __hip_atomic_fetch_add(p, v, __ATOMIC_RELAXED, __HIP_MEMORY_SCOPE_AGENT); }
__device__ __forceinline__ unsigned xb_xcc_id() { return (unsigned)__builtin_amdgcn_s_getreg((3 << 11) | 20) & 0xFu; }
#define XB_SPIN(cond, bar) do { unsigned _sp = 0; while (cond) { __builtin_amdgcn_s_sleep(1); \
    if ((++_sp & 255u) == 0u) { if (xb_ld(&(bar)[XB_TMO])) break; if (_sp > XB_SPIN_CAP) { atomicAdd(&(bar)[XB_TMO], 1u); break; } } } } while (0)
struct XcdBarrier { unsigned* bar; unsigned x; volatile LAS unsigned* st; };
__device__ __forceinline__ XcdBarrier xcd_barrier_post(unsigned* bar, volatile LAS unsigned* st) {
    XcdBarrier b; b.bar = bar; b.x = xb_xcc_id(); b.st = st;
    if (threadIdx.x == 0) (void)xb_add(&bar[XB_XCNT(b.x)], 1u);
    return b;
}
__device__ __forceinline__ void xcd_barrier_complete(unsigned* bar, unsigned x, unsigned& nloc, unsigned& nx) {
    const unsigned G = gridDim.x * gridDim.y * gridDim.z;
    unsigned sum, cnt, mine, sp = 0u;
    for (;;) {
        sum = 0u; cnt = 0u; mine = 0u;
#pragma unroll
        for (unsigned j = 0; j < 16; ++j) { const unsigned c = xb_ld(&bar[XB_XCNT(j)]); sum += c; cnt += (c > 0u) ? 1u : 0u; mine = (j == x) ? c : mine; }
        if (sum == G) break;
        __builtin_amdgcn_s_sleep(1);
        if ((++sp & 255u) == 0u) { if (xb_ld(&bar[XB_TMO])) break; if (sp > XB_SPIN_CAP) { atomicAdd(&bar[XB_TMO], 1u); break; } }
    }
    nloc = mine > 0u ? mine : 1u; nx = cnt > 0u ? cnt : 1u;
}
__device__ __forceinline__ void xcd_barrier(const XcdBarrier& b) {
    asm volatile("s_waitcnt vmcnt(0)" ::: "memory");
    __syncthreads();
    if (threadIdx.x == 0) {
        unsigned* bar = b.bar;
        __builtin_amdgcn_s_waitcnt(0);
        unsigned nloc = b.st[0], nx = b.st[1];
        if (nloc == 0u) { xcd_barrier_complete(bar, b.x, nloc, nx); b.st[0] = nloc; b.st[1] = nx; }
        const unsigned old = xb_add(&bar[XB_XSUB(b.x)], 1u);
        const unsigned gen = old / nloc;
        if (old + 1u == (gen + 1u) * nloc) {
            __builtin_amdgcn_fence(__ATOMIC_RELEASE, "agent");
            asm volatile("s_waitcnt vmcnt(0)" ::: "memory");
            const unsigned og = xb_add(&bar[XB_TOP], 1u);
            const unsigned tg = og / nx;
            if (og + 1u == (tg + 1u) * nx) xb_add(&bar[XB_TOPGEN], 1u);
            else XB_SPIN(xb_ld(&bar[XB_TOPGEN]) == tg, bar);
            __builtin_amdgcn_fence(__ATOMIC_ACQUIRE, "agent");
            xb_add(&bar[XB_XGEN(b.x)], 1u);
            asm volatile("s_waitcnt vmcnt(0)" ::: "memory");
        } else {
            XB_SPIN(xb_ld(&bar[XB_XGEN(b.x)]) == gen, bar);
            __builtin_amdgcn_fence(__ATOMIC_ACQUIRE, "agent");
            asm volatile("s_waitcnt vmcnt(0)" ::: "memory");
        }
    }
    __syncthreads();
}

enum { PH_INIT = 0, PH_NORM1, PH_INPROJ, PH_CONV, PH_SCANA, PH_SCANB, PH_SCANC, PH_HNORM, PH_OUTPROJ, PH_NORM2, PH_LISTS, PH_GU, PH_DOWN, PH_COMBINE, PH_FINAL };

constexpr int NPHASE = 1 + 13 * DEPTH;
template <int ph, int l>
__device__ __forceinline__ void run_phase(LAS unsigned char* lds_raw) {
    int tid_ = threadIdx.x; asm volatile("" : "+v"(tid_));
    CArgs* ap_ = (CArgs*)__builtin_amdgcn_kernarg_segment_ptr(); asm volatile("" : "+s"(ap_));
    CArgs& A_ = *ap_;
    unsigned char* ws_ = A_.ws; asm volatile("" : "+s"(ws_));
    unsigned lb_ = 0u, bx_ = blockIdx.x, gx_ = gridDim.x; asm volatile("" : "+s"(lb_), "+s"(bx_), "+s"(gx_));
    Frame F; F.lds = lds_raw + lb_; F.out = A_.out; F.ws = ws_;
    F.tid = tid_; F.lane = F.tid & 63; F.wave = __builtin_amdgcn_readfirstlane(F.tid >> 6);
    F.G = (int)gx_; { const int bx = (int)bx_; F.vcu = (F.G % 8 == 0) ? (bx % 8) * (F.G / 8) + bx / 8 : bx; }
    constexpr int nrows = (l == DEPTH - 1) ? NLAT : NTOK;
    constexpr bool CVPH = (l == 0) && (ph <= PH_LISTS);
    constexpr int CQ0 = ph == PH_INIT ? 0 : ph == PH_NORM1 ? 25 : ph == PH_INPROJ ? 55 : ph == PH_CONV ? 140 : ph == PH_SCANA ? 165 : ph == PH_SCANB ? 205 : ph == PH_SCANC ? 233 : ph == PH_OUTPROJ ? 313 : ph == PH_NORM2 ? 344 : 378;
    constexpr int CQ1 = ph == PH_INIT ? 25 : ph == PH_NORM1 ? 55 : ph == PH_INPROJ ? 140 : ph == PH_CONV ? 165 : ph == PH_SCANA ? 205 : ph == PH_SCANB ? 233 : ph == PH_SCANC ? 313 : ph == PH_OUTPROJ ? 344 : ph == PH_NORM2 ? 378 : CV_NJ;
    const bool cvgrid = false;
    if (CVPH && cvgrid) {
        if (bx_ >= 224u) { const int cvcu = (int)(bx_ & 7u) * 4 + ((int)(bx_ >> 3) - 28); convert_moe(ws_, F.lds, A_, cvcu * 8 + F.wave, F.wave, F.lane, CQ0, CQ1); return; }
        F.G = 224; F.vcu = (int)(bx_ & 7u) * 28 + (int)(bx_ >> 3); gx_ = 224u;
    }
    switch (ph) {
        case PH_INIT: ph_init(F, A_); ph_convert(F, A_, true); break;
        case PH_INPROJ: {
            const bool cfirst = ((bx_ >> 3) & 1u) == 0u;
            int base, nblk;
            if (F.G == 256 && l == 0) { if (bx_ >= 32u) { const int ix = (int)bx_ - 32; nblk = 74 + (ix < 16 ? 1 : 0); base = ix * 74 + (ix < 16 ? ix : 16); } else { base = 16592 + (int)bx_ * 48; nblk = 48; } }
            else if (F.G == 256) { if (bx_ >= 32u) { base = ((int)bx_ - 32) * 100; nblk = 100; } else { base = 22400 + (int)bx_ * 68; nblk = 68; } }
            else { const int per = (24576 + F.G - 1) / F.G; base = F.vcu * per; nblk = base + per <= 24576 ? per : (base < 24576 ? 24576 - base : 0); }
            base += l * 24576;
            if (cfirst) { convert_moe_all(F.ws, F.lds, A_, F.wave, NWAVES, F.wave, F.lane, base, base + nblk); __syncthreads(); }
            { pg8::Gemm g{(const bf16*)(F.ws + WS_H), (const bf16*)(F.ws + WS_WIN) + (size_t)l * PW * D, D, nullptr, nullptr, 0};
              pg8::StaticOrder S; S.init(NTOK / 256, PW / 256, F.G, (int)bx_); pg8::EpiBf16 E{(bf16*)(F.ws + WS_P), PW};
              pg8::gemm_phase<pg8::EpiBf16, pg8::StaticOrder, true>(F.lds, g, S, E, F.tid); }
            if (!cfirst) { __syncthreads(); convert_moe_all(F.ws, F.lds, A_, F.wave, NWAVES, F.wave, F.lane, base, base + nblk); }
        } break;
        case PH_NORM1: if (l == 0) ph_rows<1, 0>(F, A_, 0, 0, NTOK); break;
        case PH_CONV: ph_conv(F, A_, l); break;
        case PH_SCANA: {
#define LD_(t, R) ml_passA_load(F, t, R)
#define RN_(t, R) ml_passA_run(F, t, R)
            TASK_LOOP(MlARaw, LD_, RN_, 0, 8 * NTC);
#undef LD_
#undef RN_
#define LD_(t, R) hg_passA_load(F, t, R)
#define RN_(t, R) hg_passA_run(F, A_, l, t, R)
            TASK_LOOP(HgARaw, LD_, RN_, 8 * NTC, 16 * NTC);
#undef LD_
#undef RN_
        } break;
        case PH_SCANB: scan_passB(F); break;
        case PH_SCANC: {
#define LD_(t, R) ml_passC_load(F, t, R)
#define RN_(t, R) ml_passC_run(F, A_, l, t, R)
            TASK_LOOP(MlCRaw, LD_, RN_, 0, 8 * NTC);
#undef LD_
#undef RN_
#define LD_(t, R) hg_passC_load(F, t, R)
#define RN_(t, R) hg_passC_run(F, A_, l, t, R)
            TASK_LOOP(HgCRaw, LD_, RN_, 8 * NTC, 16 * NTC);
#undef LD_
#undef RN_
        } break;
        case PH_OUTPROJ: { pg8::Gemm g{(const bf16*)(F.ws + WS_Y), (const bf16*)(F.ws + WS_WOUT) + (size_t)l * D * D, D, nullptr, nullptr, 0};
            pg8::StaticOrder S; S.init(nrows / 256, D / 256, F.G, (int)bx_);
            const float* xs = (const float*)(F.ws + WS_X);
            pg8::EpiResid E{(float*)(F.ws + WS_X), (const float*)(F.ws + WS_MOD) + (size_t)l * 3 * 6144 + 2048, l == 0 ? A_.in[I_X] : xs, l == 0 ? A_.in[I_CTX] : xs + (size_t)NLAT * D};
            pg8::gemm_phase<pg8::EpiResid, pg8::StaticOrder, true>(F.lds, g, S, E, F.tid);
            if (l == 0 && F.G == 256 && bx_ >= 8u) { __syncthreads(); const int base = 18128 + ((int)bx_ - 8) * 26; convert_moe_all(F.ws, F.lds, A_, F.wave, NWAVES, F.wave, F.lane, base, base + 26); } } break;
        case PH_GU: { const int* rt = (const int*)(F.ws + WS_ROUTE); const int ntile = rt[RT_TILEE];
            pg8::Gemm g{(const bf16*)(F.ws + WS_H), (const bf16*)(F.ws + WS_WGU) + (size_t)l * NEXP * 2048 * D, D, rt + RT_LIST, rt + RT_TILEE, (size_t)2048 * D};
            pg8::StaticOrder S; S.init(ntile, 2048 / 256, F.G, (int)bx_);
            pg8::EpiSwiglu E{(bf16*)(F.ws + WS_ACT), A_.in[I_BGU] + (size_t)l * NEXP * 2048, rt + RT_TILEE};
            pg8::gemm_phase<pg8::EpiSwiglu, pg8::StaticOrder, true>(F.lds, g, S, E, F.tid); } break;
        case PH_DOWN: { const int* rt = (const int*)(F.ws + WS_ROUTE); const int ntile = rt[RT_TILEE];
            pg8::Gemm g{(const bf16*)(F.ws + WS_ACT), (const bf16*)(F.ws + WS_WDN) + (size_t)l * NEXP * D * DEXP, DEXP, nullptr, rt + RT_TILEE, (size_t)D * DEXP};
            pg8::StaticOrder S; S.init(ntile, D / 256, F.G, (int)bx_);
            pg8::EpiDown E{(bf16*)(F.ws + WS_YS), A_.in[I_BDN] + (size_t)l * NEXP * D, (const float*)(rt + RT_SGATE), rt + RT_TILEE};
            pg8::gemm_phase<pg8::EpiDown, pg8::StaticOrder, true>(F.lds, g, S, E, F.tid); } break;
        case PH_HNORM: ph_hnorm(F, A_, l, l == DEPTH - 1); break;
        case PH_NORM2: ph_rows<0, 1>(F, A_, l, l, nrows); break;
        case PH_LISTS: ph_lists(F, A_, l, nrows); break;
        case PH_COMBINE: if (l == DEPTH - 1) ph_rows<2, 2>(F, A_, l, 0, NLAT); else ph_rows<2, 0>(F, A_, l, l + 1, NTOK); break;
        default: break;
    }
}
__global__ void __launch_bounds__(NTHR, 2) fwd(Args a) {
    extern __shared__ __attribute__((aligned(16))) unsigned char lds_raw[];
    volatile LAS unsigned* bst = (volatile LAS unsigned*)((LAS unsigned char*)lds_raw + LDS_BYTES - 64);
    if (threadIdx.x < 16) bst[threadIdx.x] = 0u;
    __syncthreads();
    XcdBarrier bar = xcd_barrier_post((unsigned*)(a.ws + WS_CTL) + CW_BAR, bst);
#ifndef TPROBE
#define TPROBE 0
#endif
#ifndef TP0
#define TP0 0
#define TP1 0
#define TP2 0
#define TD0 800
#define TD1 800
#define TD2 800
#endif
    unsigned ta0 = 0u, ta1 = 0u, ta2 = 0u; unsigned long long tprev = 0;
    const bool stamper = TPROBE && blockIdx.x == 0;
    if (stamper) tprev = __builtin_amdgcn_s_memrealtime();
#define RUN(pi, ph, l) do { run_phase<ph, l>((LAS unsigned char*)lds_raw); if ((pi) != NPHASE - 1 || TPROBE) xcd_barrier(bar); \
    if (stamper) { const unsigned long long tn = __builtin_amdgcn_s_memrealtime(); const unsigned dt = (unsigned)(tn - tprev); tprev = tn; \
        if ((ph) == TP0) ta0 += dt; if ((ph) == TP1) ta1 += dt; if ((ph) == TP2) ta2 += dt; } } while (0)
#define LAYER(l) if (l == 0) RUN(1 + 13 * l, PH_NORM1, l); RUN(2 + 13 * l, PH_INPROJ, l); RUN(3 + 13 * l, PH_CONV, l); RUN(4 + 13 * l, PH_SCANA, l); RUN(5 + 13 * l, PH_SCANB, l); RUN(6 + 13 * l, PH_SCANC, l); \
    RUN(8 + 13 * l, PH_OUTPROJ, l); RUN(9 + 13 * l, PH_NORM2, l); RUN(10 + 13 * l, PH_LISTS, l); RUN(11 + 13 * l, PH_GU, l); RUN(12 + 13 * l, PH_DOWN, l); RUN(13 + 13 * l, PH_COMBINE, l)
    RUN(0, PH_INIT, 0);
    LAYER(0);
    LAYER(1);
#undef LAYER
#undef RUN
    if (TPROBE) {
        if (stamper) { const unsigned long long tn = __builtin_amdgcn_s_memrealtime();
            unsigned q0 = (ta0 + TD0 / 2) / TD0, q1 = (ta1 + TD1 / 2) / TD1, q2 = (ta2 + TD2 / 2) / TD2;
            q0 = q0 > 31u ? 31u : q0; q1 = q1 > 31u ? 31u : q1; q2 = q2 > 31u ? 31u : q2;
            const unsigned long long delay = (unsigned long long)(q0 + 32u * q1 + 1024u * q2) * 1600ull;
            while (__builtin_amdgcn_s_memrealtime() - tn < delay) __builtin_amdgcn_s_sleep(8);
        }
    }
}

template <int NB, class Epi>
__global__ void __launch_bounds__(256) naive_gemm(const bf16* A, int lda, const int* gather, const int* tile_e, int M, const float* B, size_t bexp, int ldb, int N, int K, int bshift_from, int bshift, int bgrp, Epi E) {
    __shared__ float As[16][68]; __shared__ float Bs[NB][16][68];
    const int m0 = blockIdx.y * 64, n0 = blockIdx.x * 64, tid = threadIdx.x, tx = tid & 15, ty = tid >> 4;
    int e = 0;
    if (tile_e) { const int nt = tile_e[0]; if (m0 >= nt * 256) return; e = tile_e[8 + (m0 >> 8)]; } else if (m0 >= M) return;
    const float* Bp = B + (size_t)e * bexp + (n0 + (n0 >= bshift_from ? bshift : 0));
    const int ar = tid >> 2, ak = (tid & 3) * 4; const int arow = gather ? gather[m0 + ar] : (m0 + ar);
    const bf16* Ap = A + (size_t)arow * lda + ak;
    const int bk = tid >> 4, bn = (tid & 15) * 4;
    float acc[NB][4][4];
#pragma unroll
    for (int g = 0; g < NB; ++g)
#pragma unroll
        for (int i = 0; i < 4; ++i)
#pragma unroll
            for (int j = 0; j < 4; ++j) acc[g][i][j] = 0.f;
    for (int k0 = 0; k0 < K; k0 += 16) {
        const u32x2 av = *(const u32x2*)(Ap + k0);
        As[ak + 0][ar] = bflo(av.x); As[ak + 1][ar] = bfhi(av.x); As[ak + 2][ar] = bflo(av.y); As[ak + 3][ar] = bfhi(av.y);
#pragma unroll
        for (int g = 0; g < NB; ++g) { const f32x4 bv = *(const f32x4*)(Bp + (size_t)(k0 + bk) * ldb + g * bgrp + bn); *(f32x4*)&Bs[g][bk][bn] = bv; }
        __syncthreads();
#pragma unroll
        for (int k = 0; k < 16; ++k) { const f32x4 a4 = *(const f32x4*)&As[k][ty * 4];
#pragma unroll
            for (int g = 0; g < NB; ++g) { const f32x4 b4 = *(const f32x4*)&Bs[g][k][tx * 4];
#pragma unroll
                for (int i = 0; i < 4; ++i) { acc[g][i][0] += a4[i] * b4[0]; acc[g][i][1] += a4[i] * b4[1]; acc[g][i][2] += a4[i] * b4[2]; acc[g][i][3] += a4[i] * b4[3]; } } }
        __syncthreads();
    }
#pragma unroll
    for (int i = 0; i < 4; ++i)
#pragma unroll
        for (int j = 0; j < 4; ++j) E(m0 + ty * 4 + i, n0 + tx * 4 + j, acc[0][i][j], NB == 2 ? acc[NB - 1][i][j] : 0.f, e);
}
struct EpiP { bf16* P; __device__ void operator()(int r, int c, float v, float, int) const { P[(size_t)r * PW + c] = (bf16)f2bf(v); } };
struct EpiOut { float* X; const float* MOD; __device__ void operator()(int r, int c, float v, float, int) const { X[(size_t)r * D + c] += MOD[mrow_of(r) * 6144 + 2048 + c] * v; } };
struct EpiGU { bf16* ACT; const float* bgu; __device__ void operator()(int r, int c, float g, float li, int e) const {
    g += bgu[(size_t)e * 2048 + c]; li += bgu[(size_t)e * 2048 + 1024 + c]; g = fminf(g, 7.f); li = fminf(fmaxf(li, -7.f), 7.f);
    ACT[(size_t)r * DEXP + c] = (bf16)f2bf(g * sigmoidf_(1.702f * g) * (li + 1.f)); } };
struct EpiDown { bf16* YS; const float* bdn; const float* sgate; __device__ void operator()(int r, int c, float v, float, int e) const { YS[(size_t)r * D + c] = (bf16)f2bf((v + bdn[(size_t)e * D + c]) * sgate[r]); } };

__global__ void __launch_bounds__(128) naive_mlstm(const bf16* CQK, const bf16* P, const float* GATES, float* HF, float* HB) {
    __shared__ float qs[8][64], ks[8][64];
    const int b = blockIdx.x >> 3, h = (blockIdx.x >> 1) & 3, dir = blockIdx.x & 1, tid = threadIdx.x;
    float C[64], n[64], m = 0.f;
#pragma unroll
    for (int d = 0; d < 64; ++d) { C[d] = 0.f; n[d] = 0.f; }
    float* OUT = dir ? HB : HF;
    for (int p0 = 0; p0 < CTX + SEQ; p0 += 8) {
        __syncthreads();
        { const int st = tid >> 4, pc = tid & 15, p = p0 + st; int row;
          if (p < CTX) row = NLAT + b * CTX + (dir ? CTX - 1 - p : p); else { const int q = p - CTX; row = b * SEQ + (dir ? SEQ - 1 - q : q); }
          const u32x4 w = *(const u32x4*)(CQK + (size_t)row * 512 + (pc < 8 ? h * 64 + pc * 8 : 256 + h * 64 + (pc - 8) * 8));
          float* dst = pc < 8 ? &qs[st][pc * 8] : &ks[st][(pc - 8) * 8];
          dst[0] = bflo(w.x); dst[1] = bfhi(w.x); dst[2] = bflo(w.y); dst[3] = bfhi(w.y); dst[4] = bflo(w.z); dst[5] = bfhi(w.z); dst[6] = bflo(w.w); dst[7] = bfhi(w.w); }
        __syncthreads();
        for (int st = 0; st < 8; ++st) {
            const int p = p0 + st; int row;
            if (p < CTX) row = NLAT + b * CTX + (dir ? CTX - 1 - p : p); else { const int q = p - CTX; row = b * SEQ + (dir ? SEQ - 1 - q : q); }
            const float ig = GATES[(size_t)row * 16 + dir * 4 + h], lf = GATES[(size_t)row * 16 + 8 + dir * 4 + h];
            const float v = bf2f(P[(size_t)row * PW + PC_V + h * 128 + tid]);
            const float mn = fmaxf(lf + m, ig), a = __expf(lf + m - mn), w = __expf(ig - mn), wv = w * v; m = mn;
            float num = 0.f, den = 0.f;
#pragma unroll
            for (int d = 0; d < 64; ++d) { const float kd = ks[st][d], qd = qs[st][d]; C[d] = a * C[d] + wv * kd; n[d] = a * n[d] + w * kd; num += C[d] * qd; den += n[d] * qd; }
            OUT[(size_t)row * D + h * 128 + tid] = num / fmaxf(fabsf(den), __expf(-mn));
        }
    }
}
__global__ void __launch_bounds__(128) naive_hgrn(const bf16* CQI, const bf16* P, const float* fb_l, const float* lbraw, int l, float* HF, float* HB) {
    __shared__ float fs[8][128], ks[8][128], qs[8][128];
    const int b = blockIdx.x >> 3, h = (blockIdx.x >> 1) & 3, dir = blockIdx.x & 1, tid = threadIdx.x, ch = h * 128 + tid;
    float S[128];
#pragma unroll
    for (int d = 0; d < 128; ++d) S[d] = 0.f;
    float lb = 0.f;
    if (l == 1) { const float r0 = lbraw[ch], r1 = lbraw[512 + ch], mx = fmaxf(r0, r1), e0 = __expf(r0 - mx), e1 = __expf(r1 - mx); lb = e1 / (e0 + e1); }
    const float bias = fb_l[dir * 512 + ch];
    float* OUT = dir ? HB : HF;
    for (int p0 = 0; p0 < CTX + SEQ; p0 += 8) {
        __syncthreads();
        float vv[8]; int rows[8];
#pragma unroll
        for (int st = 0; st < 8; ++st) { const int p = p0 + st; int row;
            if (p < CTX) row = NLAT + b * CTX + (dir ? CTX - 1 - p : p); else { const int q = p - CTX; row = b * SEQ + (dir ? SEQ - 1 - q : q); }
            rows[st] = row;
            const float z = bf2f(P[(size_t)row * PW + (dir ? PC_FB : PC_FF) + ch]) + bias;
            fs[st][tid] = lb + (1.f - lb) * sigmoidf_(z); ks[st][tid] = (1.f - lb) * sigmoidf_(-z);
            qs[st][tid] = bf2f(CQI[(size_t)row * 1024 + ch]); vv[st] = bf2f(CQI[(size_t)row * 1024 + 512 + ch]); }
        __syncthreads();
#pragma unroll
        for (int st = 0; st < 8; ++st) { float o = 0.f; const float v = vv[st];
#pragma unroll
            for (int d = 0; d < 128; ++d) { S[d] = fs[st][d] * S[d] + ks[st][d] * v; o += qs[st][d] * S[d]; }
            OUT[(size_t)rows[st] * D + 512 + ch] = o; }
    }
}

extern "C" void kernel_launch(void* const* d_in, const int* in_sizes, int n_in, void* d_out, int out_size, void* d_ws, size_t ws_size, hipStream_t stream) {
    static int grid = 0;
    if (grid == 0) {
        if (n_in != 24 || in_sizes[0] != NLAT * D || out_size != NLAT * D || ws_size < WS_END) { fprintf(stderr, "kernel_launch: unexpected shapes n_in %d in0 %d out %d ws %zu (need %zu)\n", n_in, n_in > 0 ? in_sizes[0] : -1, out_size, ws_size, (size_t)WS_END); grid = -1; return; }
        int dev = 0, cus = 0;
        if (hipGetDevice(&dev) != hipSuccess || hipDeviceGetAttribute(&cus, hipDeviceAttributeMultiprocessorCount, dev) != hipSuccess) { grid = -1; return; }
        if (hipFuncSetAttribute((const void*)fwd, hipFuncAttributeMaxDynamicSharedMemorySize, LDS_BYTES) != hipSuccess) { fprintf(stderr, "kernel_launch: hipFuncSetAttribute failed\n"); grid = -1; return; }
        grid = cus;
    }
    if (grid < 0) return;
    (void)hipMemsetAsync((char*)d_ws + WS_CTL, 0, 1 * MiB, stream);
    Args a{};
    for (int i = 0; i < 24; ++i) a.in[i] = (const float*)d_in[i];
    a.out = (float*)d_out; a.ws = (unsigned char*)d_ws; a.ph_lo = 0; a.ph_hi = 0;
    unsigned char* ws = (unsigned char*)d_ws;
    const float* const* in = a.in;
    int* rt = (int*)(ws + WS_ROUTE);
    a.ph_lo = 0; a.ph_hi = NPHASE;
    hipLaunchKernelGGL(fwd, dim3(grid), dim3(NTHR), LDS_BYTES, stream, a);
}
```

```cpp
#include <hip/hip_runtime.h>
#include <cstdio>
#include <cstdint>

#define GAS __attribute__((address_space(1)))
#define LAS __attribute__((address_space(3)))
typedef unsigned short bf16;
typedef float f32x4 __attribute__((ext_vector_type(4)));
typedef unsigned u32x4 __attribute__((ext_vector_type(4)));
typedef unsigned u32x2 __attribute__((ext_vector_type(2)));

constexpr int D = 1024, BATCH = 2, SEQ = 8192, DEPTH = 2, CTX = 256, GRIDW = 64;
constexpr int NLAT = BATCH * SEQ, NCTX = BATCH * CTX, NTOK = NLAT + NCTX;
constexpr int INW = 4112, PW = 4096;
constexpr int PC_QK = 0, PC_V = 512, PC_O = 1024, PC_QI = 1536, PC_FF = 2560, PC_FB = 3072, PC_GO = 3584;
constexpr int NEXP = 32, TOPK = 4, DEXP = 1024;
constexpr int MAXSLOT = (NTOK * TOPK / 256 + NEXP) * 256;
constexpr int MAXTILE = MAXSLOT / 256;
constexpr float EPS = 1e-6f;

constexpr size_t MiB = 1u << 20;
constexpr size_t WS_CTL = 0;
constexpr size_t WS_MOD = 1 * MiB;
constexpr size_t WS_GATES = 2 * MiB;
constexpr size_t WS_ROUTE = 4 * MiB;
constexpr size_t WS_X = 8 * MiB;
constexpr size_t WS_H = 76 * MiB;
constexpr size_t WS_P = 112 * MiB;
constexpr size_t WS_CQK = 246 * MiB;
constexpr size_t WS_CQI = 264 * MiB;
constexpr size_t WS_HF = 300 * MiB;
constexpr size_t WS_HB = 368 * MiB;
constexpr size_t WS_Y = 436 * MiB;
constexpr size_t WS_ACT = 472 * MiB;
constexpr size_t WS_YS = 622 * MiB;
constexpr size_t WS_WIN = 772 * MiB;
constexpr size_t WS_WOUT = 788 * MiB;
constexpr size_t WS_WGU = 792 * MiB;
constexpr size_t WS_WDN = 1048 * MiB;
constexpr size_t WS_MLC = 1176 * MiB;
constexpr size_t WS_MLN = 1246 * MiB;
constexpr size_t WS_MLS = 1247 * MiB;
constexpr size_t WS_HGS = 1248 * MiB;
constexpr size_t WS_HGG = 1388 * MiB;
constexpr size_t WS_MLCB = 1390 * MiB;
constexpr size_t WS_HGSB = 1426 * MiB;
constexpr size_t WS_END = 1496 * MiB;
constexpr int NTC = 132;
constexpr int RT_TOPI = 0;
constexpr int RT_TOPG = RT_TOPI + NTOK * 4;
constexpr int RT_POS = RT_TOPG + NTOK * 4;
constexpr int RT_SLOT = RT_POS + NTOK * 4;
constexpr int RT_LIST = RT_SLOT + NTOK * 4;
constexpr int RT_SGATE = RT_LIST + MAXSLOT;
constexpr int RT_TILEE = RT_SGATE + MAXSLOT;
constexpr int RT_BLKCNT = RT_TILEE + MAXTILE + 8;
constexpr int MAXG = 1024;
constexpr int RT_END = RT_BLKCNT + MAXG * 32;
static_assert((size_t)RT_END * 4 <= 4 * MiB, "route map");
constexpr int CW_CNT = 1024;
constexpr int CW_BAR = 4096;

typedef float f32x2_t __attribute__((ext_vector_type(2)));
typedef __bf16 bf16x2_t __attribute__((ext_vector_type(2)));
__device__ __forceinline__ unsigned pk2(float lo, float hi) { const f32x2_t v = {lo, hi}; return __builtin_bit_cast(unsigned, __builtin_convertvector(v, bf16x2_t)); }
__device__ __forceinline__ unsigned f2bf(float f) { return pk2(f, 0.f) & 0xffffu; }
__device__ __forceinline__ float bf2f(unsigned short b) { return __builtin_bit_cast(float, (unsigned)b << 16); }
__device__ __forceinline__ float bflo(unsigned w) { return __builtin_bit_cast(float, w << 16); }
__device__ __forceinline__ float bfhi(unsigned w) { return __builtin_bit_cast(float, w & 0xffff0000u); }
__device__ __forceinline__ float sigmoidf_(float x) { return 1.f / (1.f + __expf(-x)); }
__device__ __forceinline__ float siluf_(float x) { return x / (1.f + __expf(-x)); }
__device__ __forceinline__ float logsigmoidf_(float x) { return x >= 0.f ? -log1pf(__expf(-x)) : x - log1pf(__expf(x)); }
template <int CTRL, int ROWMASK, bool BOUND0>
__device__ __forceinline__ float dppf(float old, float x) { return __builtin_bit_cast(float, __builtin_amdgcn_update_dpp(__builtin_bit_cast(int, old), __builtin_bit_cast(int, x), CTRL, ROWMASK, 0xf, BOUND0)); }
__device__ __forceinline__ float half_sum_hi(float x) {
    x += dppf<0xB1, 0xf, true>(0.f, x); x += dppf<0x4E, 0xf, true>(0.f, x); x += dppf<0x114, 0xf, true>(0.f, x); x += dppf<0x118, 0xf, true>(0.f, x);
    x += dppf<0x142, 0xa, true>(0.f, x); return x; }
__device__ __forceinline__ float wave_sum(float v) {
    v = half_sum_hi(v); v += dppf<0x143, 0xc, true>(0.f, v); return __builtin_bit_cast(float, __builtin_amdgcn_readlane(__builtin_bit_cast(int, v), 63)); }
__device__ __forceinline__ float wave_incl_sum(float v, int) {
    v += dppf<0x111, 0xf, true>(0.f, v); v += dppf<0x112, 0xf, true>(0.f, v); v += dppf<0x114, 0xf, true>(0.f, v); v += dppf<0x118, 0xf, true>(0.f, v);
    v += dppf<0x142, 0xa, true>(0.f, v); v += dppf<0x143, 0xc, true>(0.f, v); return v; }
__device__ __forceinline__ float wave_incl_max(float v, int) {
    const float NI = -INFINITY;
    v = fmaxf(v, dppf<0x111, 0xf, false>(NI, v)); v = fmaxf(v, dppf<0x112, 0xf, false>(NI, v)); v = fmaxf(v, dppf<0x114, 0xf, false>(NI, v)); v = fmaxf(v, dppf<0x118, 0xf, false>(NI, v));
    v = fmaxf(v, dppf<0x142, 0xa, false>(NI, v)); v = fmaxf(v, dppf<0x143, 0xc, false>(NI, v)); return v; }
__device__ __forceinline__ float wave_max(float v) { v = wave_incl_max(v, 0); return __builtin_bit_cast(float, __builtin_amdgcn_readlane(__builtin_bit_cast(int, v), 63)); }
__device__ __forceinline__ int mrow_of(int r) { return r < NLAT ? (r >> 13) : 2; }

struct Args { const float* in[24]; float* out; unsigned char* ws; int ph_lo, ph_hi; };
typedef const __attribute__((address_space(4))) Args CArgs;

enum { I_X = 0, I_C, I_CTX, I_CCTX, I_WADA, I_BADA, I_N1G, I_WIN, I_MLCONV, I_MLGB, I_MLNG, I_HGCONV, I_HGFB, I_HGLB, I_HGNG, I_WOUT, I_N2G, I_RW, I_RB, I_WGU, I_BGU, I_WDN, I_BDN, I_FG };

constexpr int NWAVES = 8, NTHR = 512;
constexpr int LDS_BYTES = 147456;

typedef __attribute__((address_space(1))) unsigned char gas_u8; typedef __attribute__((address_space(1))) bf16 gbf16;
struct Frame {
    LAS unsigned char* lds;
    float* out; gas_u8* ws;
    int tid, lane, wave, vcu, G;
};

__device__ __forceinline__ void ph_init(Frame& F, CArgs& A) {
    const int gt = F.vcu * NTHR + F.tid, NG = F.G * NTHR;
    if (gt < 128) ((u32x4*)(F.ws + WS_H + (size_t)NTOK * D * 2))[gt] = (u32x4){0u, 0u, 0u, 0u};
    LAS float* sc = (LAS float*)F.lds;
    LAS float* part = sc + 3 * 1024;
    for (int i = F.tid; i < 3 * 1024; i += NTHR) { const int r = i >> 10, k = i & 1023; const float c = r < 2 ? A.in[I_C][r * 1024 + k] : A.in[I_CCTX][k]; sc[i] = siluf_(c); }
    __syncthreads();
    for (int item = F.vcu; item < DEPTH * 96; item += F.G) {
        const int l = item / 96, j = (item % 96) * 64 + F.lane;
        const float* w = A.in[I_WADA] + (size_t)l * D * 6144 + j;
        float a0 = 0.f, a1 = 0.f, a2 = 0.f;
        for (int k0 = F.wave * 128; k0 < F.wave * 128 + 128; k0 += 32) { float wv[32];
#pragma unroll
            for (int i = 0; i < 32; ++i) wv[i] = w[(size_t)(k0 + i) * 6144];
#pragma unroll
            for (int i = 0; i < 32; ++i) { a0 += sc[k0 + i] * wv[i]; a1 += sc[1024 + k0 + i] * wv[i]; a2 += sc[2048 + k0 + i] * wv[i]; } }
        part[(F.wave * 3 + 0) * 64 + F.lane] = a0; part[(F.wave * 3 + 1) * 64 + F.lane] = a1; part[(F.wave * 3 + 2) * 64 + F.lane] = a2;
        __syncthreads();
        if (F.tid < 192) { const int r = F.tid >> 6, ln = F.tid & 63; float s = 0.f;
#pragma unroll
            for (int w8 = 0; w8 < 8; ++w8) s += part[(w8 * 3 + r) * 64 + ln];
            const int jj = (item % 96) * 64 + ln;
            ((float*)(F.ws + WS_MOD))[(l * 3 + r) * 6144 + jj] = s + A.in[I_BADA][l * 6144 + jj]; }
        __syncthreads();
    }
}

typedef unsigned u32x2v __attribute__((ext_vector_type(2)));
__device__ __forceinline__ float xor32(float send, int lane) { const unsigned u = __builtin_bit_cast(unsigned, send); const u32x2v r = __builtin_amdgcn_permlane32_swap(u, u, false, false);
    return __builtin_bit_cast(float, (lane & 32) ? r.x : r.y); }
__device__ __forceinline__ float xor16(float send, int lane) { const unsigned u = __builtin_bit_cast(unsigned, send); const u32x2v r = __builtin_amdgcn_permlane16_swap(u, u, false, false);
    return __builtin_bit_cast(float, (lane & 16) ? r.x : r.y); }
__device__ __forceinline__ float xor8(float x) { return dppf<0x140, 0xf, true>(0.f, dppf<0x141, 0xf, true>(0.f, x)); }
__device__ __forceinline__ float xor4(float x) { return dppf<0x141, 0xf, true>(0.f, dppf<0x1B, 0xf, true>(0.f, x)); }
__device__ __forceinline__ float xor2(float x) { return dppf<0x4E, 0xf, true>(0.f, x); }
__device__ __forceinline__ float xor1(float x) { return dppf<0xB1, 0xf, true>(0.f, x); }
template <int NV> __device__ __forceinline__ float reduce_scatter(float (&v)[NV], int lane) {
    float a16[16];
    if constexpr (NV == 32) { const bool hi = lane & 32;
#pragma unroll
        for (int i = 0; i < 16; ++i) { const float keep = hi ? v[16 + i] : v[i], send = hi ? v[i] : v[16 + i]; a16[i] = keep + xor32(send, lane); } }
    else {
#pragma unroll
        for (int i = 0; i < 16; ++i) a16[i] = v[i] + xor1(v[i]); }
    float a8[8], a4[4], a2[2];
    { const bool hi = lane & 16;
#pragma unroll
      for (int i = 0; i < 8; ++i) { const float keep = hi ? a16[8 + i] : a16[i], send = hi ? a16[i] : a16[8 + i]; a8[i] = keep + xor16(send, lane); } }
    { const bool hi = lane & 8;
#pragma unroll
      for (int i = 0; i < 4; ++i) { const float keep = hi ? a8[4 + i] : a8[i], send = hi ? a8[i] : a8[4 + i]; a4[i] = keep + xor8(send); } }
    { const bool hi = lane & 4;
#pragma unroll
      for (int i = 0; i < 2; ++i) { const float keep = hi ? a4[2 + i] : a4[i], send = hi ? a4[i] : a4[2 + i]; a2[i] = keep + xor4(send); } }
    float r;
    { const bool hi = lane & 2; const float keep = hi ? a2[1] : a2[0], send = hi ? a2[0] : a2[1]; r = keep + xor2(send); }
    if constexpr (NV == 32) r += xor1(r); else r += xor32(r, lane);
    return r;
}
struct RowIn { f32x4 x[4]; u32x2 xb[4]; u32x2 y[4][4]; };
template <int SRC>
__device__ __forceinline__ void row_load(Frame& F, CArgs& A, int r, const int (&slot)[4], RowIn& R, bool inp = false) {
    if (SRC == 1 || (SRC == 3 && inp)) { const float* src = r < NLAT ? A.in[I_X] + (size_t)r * D : A.in[I_CTX] + (size_t)(r - NLAT) * D;
        const f32x4* xr = (const f32x4*)src + F.lane;
#pragma unroll
        for (int j = 0; j < 4; ++j) R.x[j] = xr[64 * j]; }
    else { const u32x2* xr = (const u32x2*)(F.ws + WS_X + (size_t)r * D * 2) + F.lane;
#pragma unroll
        for (int j = 0; j < 4; ++j) R.xb[j] = xr[64 * j]; }
    if (SRC == 3) { const u32x2* yp = (const u32x2*)(F.ws + WS_HF + (size_t)r * D * 2) + F.lane;
#pragma unroll
        for (int j = 0; j < 4; ++j) R.y[0][j] = yp[64 * j]; }
    if (SRC == 2) {
#pragma unroll
        for (int k = 0; k < 4; ++k) { const u32x2* yp = (const u32x2*)(F.ws + WS_YS + (size_t)slot[k] * D * 2) + F.lane;
#pragma unroll
            for (int j = 0; j < 4; ++j) R.y[k][j] = __builtin_nontemporal_load(yp + 64 * j); } }
}
template <int MODE>
__device__ __forceinline__ void row_tail(Frame& F, CArgs& A, int l, const LAS float* lg, int r, LAS unsigned* lcnt) {
    if (MODE == 0) {
        if (F.lane < 16) { const int g = F.lane; float val = lg[F.wave * 16 + g] + A.in[I_MLGB][l * 16 + g];
            if (g >= 8) val = logsigmoidf_(val);
            ((float*)(F.ws + WS_GATES))[(size_t)r * 16 + g] = val; }
    } else {
        const int e = F.lane & 31; const float my = lg[F.wave * 32 + e]; int rank = 0;
#pragma unroll
        for (int q = 0; q < 8; ++q) { const f32x4 t = *(const LAS f32x4*)(lg + F.wave * 32 + 4 * q);
#pragma unroll
            for (int c = 0; c < 4; ++c) { const int j = 4 * q + c; rank += (t[c] > my || (t[c] == my && j < e)) ? 1 : 0; } }
        float tv[4]; int ti[4];
#pragma unroll
        for (int p = 0; p < 4; ++p) { const unsigned bal = (unsigned)__ballot(rank == p); const int bi = __ffs((int)bal) - 1;
            ti[p] = bi; tv[p] = __builtin_bit_cast(float, __builtin_amdgcn_readlane(__builtin_bit_cast(int, my), bi)); }
        const float e1 = __expf(tv[1] - tv[0]), e2 = __expf(tv[2] - tv[0]), e3 = __expf(tv[3] - tv[0]); const float inv = 1.f / (1.f + e1 + e2 + e3);
        if (F.lane < 4) {
            int* rtw = (int*)(F.ws + WS_ROUTE); const int p = F.lane;
            const int tip = p == 0 ? ti[0] : (p == 1 ? ti[1] : (p == 2 ? ti[2] : ti[3]));
            const float gp = (p == 0 ? 1.f : (p == 1 ? e1 : (p == 2 ? e2 : e3))) * inv;
            rtw[RT_TOPI + r * 4 + p] = tip; ((float*)rtw)[RT_TOPG + r * 4 + p] = gp; rtw[RT_POS + r * 4 + p] = (int)__hip_atomic_fetch_add(lcnt + tip, 1u, __ATOMIC_RELAXED, __HIP_MEMORY_SCOPE_WORKGROUP);
        }
    }
}
#define LDS_BARRIER() do { asm volatile("s_waitcnt lgkmcnt(0)" ::: "memory"); __builtin_amdgcn_s_barrier(); asm volatile("" ::: "memory"); } while (0)
template <int SRC, int MODE>
__device__ __forceinline__ void ph_rows(Frame& F, CArgs& A, int lsrc, int l, int nrows) {
    constexpr int NV = MODE == 0 ? 16 : 32;
    constexpr int EPW = NV / 8;
    f32x2_t wp[EPW][4][2];
    LAS unsigned* lcnt = (LAS unsigned*)(F.lds + 131072);
    if (MODE == 1) { const float* w = A.in[I_RW] + (size_t)l * D * NEXP + 4 * F.wave; if (F.tid < 32) lcnt[F.tid] = 0u;
#pragma unroll
        for (int j = 0; j < 4; ++j) { f32x4 q[4];
#pragma unroll
            for (int i = 0; i < 4; ++i) q[i] = *(const f32x4*)(w + (size_t)(256 * j + 4 * F.lane + i) * NEXP);
#pragma unroll
            for (int e = 0; e < EPW; ++e) { wp[e][j][0] = (f32x2_t){q[0][e], q[1][e]}; wp[e][j][1] = (f32x2_t){q[2][e], q[3][e]}; } } }
    if (MODE == 0) { const float* w = A.in[I_WIN] + (size_t)l * D * INW + 1536 + 2 * F.wave;
#pragma unroll
        for (int j = 0; j < 4; ++j) { f32x2_t q[4];
#pragma unroll
            for (int i = 0; i < 4; ++i) q[i] = *(const f32x2_t*)(w + (size_t)(256 * j + 4 * F.lane + i) * INW);
#pragma unroll
            for (int e = 0; e < EPW; ++e) { wp[e][j][0] = (f32x2_t){q[0][e], q[1][e]}; wp[e][j][1] = (f32x2_t){q[2][e], q[3][e]}; } } }
    const float* gam = MODE == 0 ? A.in[I_N1G] + l * D : (MODE == 1 ? A.in[I_N2G] + l * D : A.in[I_FG]);
    const float* MOD = (const float*)(F.ws + WS_MOD) + (size_t)l * 3 * 6144;
    const float* MODS = (const float*)(F.ws + WS_MOD) + (size_t)lsrc * 3 * 6144;
    const int* rt = (const int*)(F.ws + WS_ROUTE);
    const int stride = F.G * NWAVES; int r = F.vcu * NWAVES + F.wave;
    RowIn cur; int s1[4] = {0, 0, 0, 0}, s2[4] = {0, 0, 0, 0};
    if (SRC == 2) { if (r < nrows) { const u32x4 q = *(const u32x4*)(rt + RT_SLOT + r * 4); s1[0] = q.x; s1[1] = q.y; s1[2] = q.z; s1[3] = q.w; }
                    if (r + stride < nrows) { const u32x4 q = *(const u32x4*)(rt + RT_SLOT + (r + stride) * 4); s2[0] = q.x; s2[1] = q.y; s2[2] = q.z; s2[3] = q.w; } }
    const bool inp = SRC == 3 && l == 0;
    if (r < nrows) row_load<SRC>(F, A, r, s1, cur, inp);
    int rprev = -1, par = 0;
    f32x4 Aq[4], Sq[4], Gq[4]; int mrp = -1;
    const float rbm = MODE == 1 ? A.in[I_RB][l * NEXP + 4 * F.wave + ((F.lane >> 1) & 3)] : 0.f;
    for (; r < nrows; r += stride) {
        RowIn nxt; int s3[4] = {0, 0, 0, 0};
        { const int mr = mrow_of(r);
          if (mr != mrp) { mrp = mr; const float* mod = MOD + mr * 6144 + (MODE == 0 ? 0 : 3072); const float* g2 = MODS + mr * 6144 + 5 * 1024;
#pragma unroll
              for (int j = 0; j < 4; ++j) { const int c = 256 * j + 4 * F.lane; const f32x4 g = *(const f32x4*)(gam + c);
                  if (MODE != 2) { const f32x4 sh = *(const f32x4*)(mod + c), scl = *(const f32x4*)(mod + 1024 + c); Aq[j] = g * (1.f + scl); Sq[j] = sh; } else { Aq[j] = g; Sq[j] = (f32x4){0.f, 0.f, 0.f, 0.f}; }
                  if (SRC == 2) Gq[j] = *(const f32x4*)(g2 + c);
                  if (SRC == 3) Gq[j] = *(const f32x4*)(MOD + mr * 6144 + 2048 + c); } } }
        if (SRC == 2) { const int r2 = r + 2 * stride < nrows ? r + 2 * stride : r; const u32x4 q = *(const u32x4*)(rt + RT_SLOT + r2 * 4); s3[0] = q.x; s3[1] = q.y; s3[2] = q.z; s3[3] = q.w; }
        { const int rn = r + stride < nrows ? r + stride : r; row_load<SRC>(F, A, rn, s2, nxt, inp); }
        f32x4 v[4];
#pragma unroll
        for (int j = 0; j < 4; ++j) { const u32x2 w = cur.xb[j]; v[j] = (SRC == 1 || inp) ? cur.x[j] : (f32x4){bflo(w.x), bfhi(w.x), bflo(w.y), bfhi(w.y)}; }
        if (SRC == 2) {
#pragma unroll
            for (int j = 0; j < 4; ++j) { f32x4 a = (f32x4){0.f, 0.f, 0.f, 0.f};
#pragma unroll
                for (int k = 0; k < 4; ++k) { const u32x2 w = cur.y[k][j]; a += (f32x4){bflo(w.x), bfhi(w.x), bflo(w.y), bfhi(w.y)}; }
                v[j] = v[j] + Gq[j] * a; } }
        if (SRC == 3) {
#pragma unroll
            for (int j = 0; j < 4; ++j) { const u32x2 w = cur.y[0][j]; v[j] = v[j] + Gq[j] * (f32x4){bflo(w.x), bfhi(w.x), bflo(w.y), bfhi(w.y)}; } }
        if ((SRC == 2 && MODE != 2) || SRC == 3) { u32x2* xo = (u32x2*)(F.ws + WS_X + (size_t)r * D * 2) + F.lane;
#pragma unroll
            for (int j = 0; j < 4; ++j) xo[64 * j] = (u32x2){pk2(v[j].x, v[j].y), pk2(v[j].z, v[j].w)}; }
        float ss = 0.f;
#pragma unroll
        for (int j = 0; j < 4; ++j) ss += (v[j].x * v[j].x + v[j].y * v[j].y) + (v[j].z * v[j].z + v[j].w * v[j].w);
        const float rstd = rsqrtf(wave_sum(ss) * (1.f / D) + EPS);
#pragma unroll
        for (int j = 0; j < 4; ++j) { v[j] = v[j] * rstd * Aq[j]; if (MODE != 2) v[j] = v[j] + Sq[j]; }
        if (MODE == 2) { f32x4* o = (f32x4*)(F.out + (size_t)r * D) + F.lane;
#pragma unroll
            for (int j = 0; j < 4; ++j) o[64 * j] = v[j]; }
        else {
            u32x2* ho = (u32x2*)(F.ws + WS_H + (size_t)r * D * 2) + F.lane;
#pragma unroll
            for (int j = 0; j < 4; ++j) ho[64 * j] = (u32x2){pk2(v[j].x, v[j].y), pk2(v[j].z, v[j].w)};
            LAS f32x4* hb = (LAS f32x4*)(F.lds + par * 36864);
            LAS float* lg = (LAS float*)(F.lds + 32768 + par * 36864);
#pragma unroll
            for (int j = 0; j < 4; ++j) hb[(F.wave * 4 + j) * 64 + F.lane] = v[j];
            LDS_BARRIER();
            if (rprev >= 0) row_tail<MODE>(F, A, l, (const LAS float*)(F.lds + 32768 + (par ^ 1) * 36864), rprev, lcnt);
            float part[NV];
#pragma unroll
            for (int q = 0; q < 8; ++q) { f32x4 hq[4];
#pragma unroll
                for (int j = 0; j < 4; ++j) hq[j] = hb[(q * 4 + j) * 64 + F.lane];
#pragma unroll
                for (int e = 0; e < EPW; ++e) { f32x2_t a2 = {0.f, 0.f};
#pragma unroll
                    for (int j = 0; j < 4; ++j) { a2 += (f32x2_t){hq[j].x, hq[j].y} * wp[e][j][0]; a2 += (f32x2_t){hq[j].z, hq[j].w} * wp[e][j][1]; }
                    part[q * EPW + e] = a2.x + a2.y; } }
            const float mine = reduce_scatter<NV>(part, F.lane);
            if (MODE == 0) { const int g = (F.lane >> 1) & 15; if ((F.lane & 33) == 0) lg[(g >> 1) * 16 + 2 * F.wave + (g & 1)] = mine; }
            else { const int g = (F.lane >> 1) & 31; if ((F.lane & 1) == 0) lg[(g >> 2) * 32 + 4 * F.wave + (g & 3)] = mine + rbm; }
            rprev = r; par ^= 1;
        }
        cur = nxt;
#pragma unroll
        for (int k = 0; k < 4; ++k) { s2[k] = s3[k]; }
    }
    if (MODE != 2 && rprev >= 0) { LDS_BARRIER(); row_tail<MODE>(F, A, l, (const LAS float*)(F.lds + 32768 + (par ^ 1) * 36864), rprev, lcnt); }
    if (MODE == 1) { __syncthreads(); if (F.tid < 32) ((int*)(F.ws + WS_ROUTE))[RT_BLKCNT + F.vcu * 32 + F.tid] = (int)lcnt[F.tid]; }
}

__device__ __forceinline__ void ph_lists(Frame& F, CArgs& A, int l, int nrows) {
    LAS int* off = (LAS int*)F.lds;
    LAS int* pre = (LAS int*)(F.lds + 1024);
    int* rt = (int*)(F.ws + WS_ROUTE);
    { LAS int* gsum = (LAS int*)(F.lds + 1024 + 65536);
      const int e = F.tid & 31, grp = F.tid >> 5, per = (F.G + 15) >> 4, v0 = grp * per, v1 = min(v0 + per, F.G);
      int run = 0;
      for (int vb = v0; vb < v1; vb += 16) { int c[16];
#pragma unroll
          for (int i = 0; i < 16; ++i) c[i] = vb + i < v1 ? rt[RT_BLKCNT + (vb + i) * 32 + e] : 0;
#pragma unroll
          for (int i = 0; i < 16; ++i) { if (vb + i < v1) pre[(vb + i) * 32 + e] = run; run += c[i]; } }
      gsum[grp * 32 + e] = run;
      __syncthreads();
      int base = 0, tot = 0;
#pragma unroll
      for (int g = 0; g < 16; ++g) { const int t = gsum[g * 32 + e]; base += g < grp ? t : 0; tot += t; }
      for (int v = v0; v < v1; ++v) pre[v * 32 + e] += base;
      if (grp == 0) off[64 + e] = tot; }
    __syncthreads();
    if (F.wave == 0) { const int pc = F.lane < 32 ? (off[64 + F.lane] + 255) & ~255 : 0;
        const int inc = (int)wave_incl_sum((float)(pc >> 8), F.lane) << 8;
        if (F.lane < 32) off[F.lane] = inc - pc; if (F.lane == 31) off[32] = inc; }
    __syncthreads();
    const int gt = F.vcu * NTHR + F.tid, NG = F.G * NTHR;
    for (int i = gt; i < nrows * 4; i += NG) { const int r = i >> 2, e = rt[RT_TOPI + i], v = (r % (F.G * NWAVES)) / NWAVES, s = off[e] + pre[v * 32 + e] + rt[RT_POS + i];
        rt[RT_SLOT + i] = s; rt[RT_LIST + s] = r; ((float*)rt)[RT_SGATE + s] = ((const float*)rt)[RT_TOPG + i]; }
    const int total = off[32];
    for (int s = gt; s < total; s += NG) { int e = 0;
#pragma unroll 1
        for (int q = 1; q < NEXP; ++q) if (s >= off[q]) e = q;
        if (s - off[e] >= off[64 + e]) { rt[RT_LIST + s] = NTOK; ((float*)rt)[RT_SGATE + s] = 0.f; }
        if ((s & 255) == 0) rt[RT_TILEE + 8 + (s >> 8)] = e; }
    if (gt == 0) rt[RT_TILEE] = total >> 8;
}

__device__ __forceinline__ void touch(unsigned& x) { asm volatile("" : "+v"(x)); }
__device__ __forceinline__ void touch(float& x) { asm volatile("" : "+v"(x)); }
__device__ __forceinline__ void touch(u32x4& x) { asm volatile("" : "+v"(x)); }
struct ConvItem { u32x4 tap[3][6]; int r0, c; };
__device__ __forceinline__ void conv_load_item(const bf16* P, int it, ConvItem& I) {
    constexpr int NLATQ = BATCH * 128 * 16;
    const int qd = it / 192, cg = it % 192, c = cg * 8, pc = c < 512 ? PC_QK + c : PC_QI + (c - 512);
    int base, row, x0, nrow, ncol;
    if (qd < NLATQ) { const int b = qd >> 11, y = (qd >> 4) & 127, xq = qd & 15; base = b << 13; row = y; x0 = xq * 4; nrow = 128; ncol = 64; }
    else { const int q = qd - NLATQ, b = q >> 6; base = NLAT + (b << 8); row = 0; x0 = (q & 63) * 4; nrow = 1; ncol = 256; }
    const int r0 = base + row * ncol + x0; I.r0 = r0; I.c = c;
#pragma unroll
    for (int dy = 0; dy < 3; ++dy)
#pragma unroll
        for (int j = 0; j < 6; ++j) { const int rr = row + dy - 1, cc = x0 + j - 1; const bool v = rr >= 0 && rr < nrow && cc >= 0 && cc < ncol;
            const u32x4 t = *(const u32x4*)(P + (size_t)(v ? base + rr * ncol + cc : r0) * PW + pc);
            I.tap[dy][j] = v ? t : (u32x4){0u, 0u, 0u, 0u}; }
}
__device__ __forceinline__ void ph_conv(Frame& F, CArgs& A, int l) {
    LAS float* cw = (LAS float*)F.lds;
    { const f32x4* wm = (const f32x4*)(A.in[I_MLCONV] + (size_t)l * 9 * 512); const f32x4* wh = (const f32x4*)(A.in[I_HGCONV] + (size_t)l * 9 * 1024);
      f32x4 vm[3], vh[5];
#pragma unroll
      for (int j = 0; j < 3; ++j) { const int i = F.tid + NTHR * j; vm[j] = i < 9 * 128 ? wm[i] : (f32x4){0.f, 0.f, 0.f, 0.f}; }
#pragma unroll
      for (int j = 0; j < 5; ++j) { const int i = F.tid + NTHR * j; vh[j] = i < 9 * 256 ? wh[i] : (f32x4){0.f, 0.f, 0.f, 0.f}; }
#pragma unroll
      for (int j = 0; j < 3; ++j) { const int i = F.tid + NTHR * j; if (i < 9 * 128) *(LAS f32x4*)(cw + (i / 128) * 1536 + (i % 128) * 4) = vm[j]; }
#pragma unroll
      for (int j = 0; j < 5; ++j) { const int i = F.tid + NTHR * j; if (i < 9 * 256) *(LAS f32x4*)(cw + (i / 256) * 1536 + 512 + (i % 256) * 4) = vh[j]; } }
    __syncthreads();
    const bf16* P = (const bf16*)(F.ws + WS_P);
    const int gt = F.vcu * NTHR + F.tid, NG = F.G * NTHR;
    constexpr int NLATQ = BATCH * 128 * 16, NQ = NLATQ + BATCH * 64;
    constexpr int NI = NQ * 192; const int nfull = NI / NG, rem = NI - nfull * NG;
    const int xlo = (int)((long long)F.vcu * rem / F.G), xhi = (int)((long long)(F.vcu + 1) * rem / F.G), nit = nfull + (F.tid < xhi - xlo ? 1 : 0), xit = nfull * NG + xlo + F.tid;
    ConvItem cur; if (nit > 0) conv_load_item(P, nfull > 0 ? gt : xit, cur);
    for (int k = 0; k < nit; ++k) {
#pragma unroll
        for (int dy = 0; dy < 3; ++dy)
#pragma unroll
            for (int j = 0; j < 6; ++j) touch(cur.tap[dy][j]);
        ConvItem nxt; conv_load_item(P, k + 1 < nit ? (k + 1 < nfull ? gt + (k + 1) * NG : xit) : (k < nfull ? gt + k * NG : xit), nxt);
        const int r0 = cur.r0, c = cur.c; u32x4 (&tap)[3][6] = cur.tap;
        f32x2_t a2[4][4];
#pragma unroll
        for (int o = 0; o < 4; ++o)
#pragma unroll
            for (int i = 0; i < 4; ++i) a2[o][i] = (f32x2_t){0.f, 0.f};
#pragma unroll
        for (int dy = 0; dy < 3; ++dy)
#pragma unroll
            for (int dx = 0; dx < 3; ++dx) { const LAS float* w = cw + (dy * 3 + dx) * 1536 + c; const f32x4 w0 = *(const LAS f32x4*)w, w1 = *(const LAS f32x4*)(w + 4);
                const f32x2_t wa = {w0.x, w0.y}, wb = {w0.z, w0.w}, wc = {w1.x, w1.y}, wd = {w1.z, w1.w};
#pragma unroll
                for (int o = 0; o < 4; ++o) { const u32x4 pv = tap[dy][o + dx];
                    a2[o][0] += (f32x2_t){bflo(pv.x), bfhi(pv.x)} * wa; a2[o][1] += (f32x2_t){bflo(pv.y), bfhi(pv.y)} * wb;
                    a2[o][2] += (f32x2_t){bflo(pv.z), bfhi(pv.z)} * wc; a2[o][3] += (f32x2_t){bflo(pv.w), bfhi(pv.w)} * wd; } }
        const float sc = c < 256 ? 0.125f : 1.f;
#pragma unroll
        for (int o = 0; o < 4; ++o) { unsigned ow[4];
#pragma unroll
            for (int i = 0; i < 4; ++i) { const f32x2_t x = a2[o][i], t = x * (-1.44269504f), dn = (f32x2_t){__builtin_amdgcn_exp2f(t.x), __builtin_amdgcn_exp2f(t.y)} + 1.f;
                const f32x2_t y = (x * sc) * (f32x2_t){__builtin_amdgcn_rcpf(dn.x), __builtin_amdgcn_rcpf(dn.y)}; ow[i] = pk2(y.x, y.y); }
            const u32x4 ov = (u32x4){ow[0], ow[1], ow[2], ow[3]};
            if (c < 512) *(u32x4*)(F.ws + WS_CQK + ((size_t)(r0 + o) * 512 + c) * 2) = ov; else *(u32x4*)(F.ws + WS_CQI + ((size_t)(r0 + o) * 1024 + (c - 512)) * 2) = ov; }
        cur = nxt;
    }
}

struct HnIn { f32x4 h[4]; u32x2 g[4]; };
__device__ __forceinline__ void hn_load(Frame& F, int r, HnIn& R) {
    const float* HF = (const float*)(F.ws + WS_HF); const bf16* P = (const bf16*)(F.ws + WS_P);
#pragma unroll
    for (int j = 0; j < 4; ++j) { const int c = 256 * j + 4 * F.lane; R.h[j] = *(const f32x4*)(HF + (size_t)r * D + c); R.g[j] = *(const u32x2*)(P + (size_t)r * PW + (c < 512 ? PC_O + c : PC_GO + (c - 512))); }
}
__device__ __forceinline__ void ph_hnorm(Frame& F, CArgs& A, int l, int nrows_lat_only) {
    const int nrows = nrows_lat_only ? NLAT : NTOK, stride = F.G * NWAVES;
    int r = F.vcu * NWAVES + F.wave; HnIn cur; if (r < nrows) hn_load(F, r, cur);
    for (; r < nrows; r += stride) {
        HnIn nxt; if (r + stride < nrows) hn_load(F, r + stride, nxt); else nxt = cur;
        u32x2* yo = (u32x2*)(F.ws + WS_Y + (size_t)r * D * 2) + F.lane;
#pragma unroll
        for (int j = 0; j < 4; ++j) {
            const int c = 256 * j + 4 * F.lane;
            f32x4 h = cur.h[j];
            float ss = (h.x * h.x + h.y * h.y) + (h.z * h.z + h.w * h.w);
#pragma unroll
            for (int o = 1; o < 32; o <<= 1) ss += __shfl_xor(ss, o);
            const float rstd = rsqrtf(ss * (1.f / 128.f) + EPS);
            const f32x4 g = c < 512 ? *(const f32x4*)(A.in[I_MLNG] + l * 512 + c) : *(const f32x4*)(A.in[I_HGNG] + l * 512 + (c - 512));
            const u32x2 gw = cur.g[j];
            float ga[4] = {bflo(gw.x), bfhi(gw.x), bflo(gw.y), bfhi(gw.y)};
#pragma unroll
            for (int i = 0; i < 4; ++i) ga[i] = c < 512 ? sigmoidf_(ga[i]) : siluf_(ga[i]);
            h = h * rstd * g;
            yo[64 * j] = (u32x2){pk2(h.x * ga[0], h.y * ga[1]), pk2(h.z * ga[2], h.w * ga[3])};
        }
        cur = nxt;
    }
}

namespace pg8 {
typedef short bf16x8 __attribute__((ext_vector_type(8)));
constexpr int BM = 256, BK = 64, HALF = 128, HTB = HALF * BK * 2, STAGE_BYTES = 8 * HTB, NXCD = 8, WGM = 8;
__device__ __forceinline__ int lds_byte(int r, int c) { const int st = (r >> 4) * 2 + (c >> 5), rr = r & 15, cc = c & 31, ob = rr * 64 + cc * 2; return st * 1024 + (ob ^ (((ob >> 9) & 1) << 5)); }
__device__ __forceinline__ void stage_rc(int b, int& R, int& C) { const int st = b / 1024, sb = b % 1024, swz = sb ^ (((sb >> 9) & 1) << 5); R = (st >> 1) * 16 + swz / 64; C = (st & 1) * 32 + (swz % 64) / 2; }
__device__ __forceinline__ int perm32(int rho) { const int n = rho >> 4, i = rho & 15; return 8 * (i >> 2) + 4 * n + (i & 3); }
struct Unit { int pm, pn, e; };
struct Gemm { const bf16* A; const bf16* Bt; int K; const int* gather; const int* tile_e; size_t bexp;   };
struct StaticOrder {
    int nM, nN, nwg, G, c;
    __device__ void init(int nM_, int nN_, int G_, int c_) { nM = nM_; nN = nN_; nwg = nM * nN; G = G_; c = c_; }
    __device__ bool next(int i, Unit& u) const {
        const long L = (long)i * G + c; if (L >= nwg) return false;
        int wgid = (int)L; { const int q = nwg / NXCD, r = nwg % NXCD, xcd = wgid % NXCD, off = wgid / NXCD; wgid = (xcd < r ? xcd * (q + 1) : r * (q + 1) + (xcd - r) * q) + off; }
        const int nig = WGM * nN, gid = wgid / nig, fm = gid * WGM, gsz = (nM - fm) < WGM ? (nM - fm) : WGM;
        u.pm = fm + ((wgid % nig) % gsz); u.pn = (wgid % nig) / gsz; u.e = 0; return true;
    }
};
__device__ __forceinline__ unsigned cvt_pk_bf16(float lo, float hi) { unsigned r; asm volatile("v_cvt_pk_bf16_f32 %0, %1, %2" : "=v"(r) : "v"(lo), "v"(hi)); return r; }

struct EpiBf16 {
    static constexpr bool PERM = true;
    bf16* O; int ldc;
    __device__ __forceinline__ void operator()(const f32x4 (&acc)[2][2][4][2], const Unit& u, int wr, int wc, int fr, int fq) const {
        const int row0 = u.pm * BM + wr * 64 + fr, col0 = u.pn * BM + wc * 32 + 8 * fq;
#pragma unroll
        for (int ai = 0; ai < 2; ++ai)
#pragma unroll
            for (int m = 0; m < 4; ++m) { bf16* rowp = O + (size_t)(row0 + ai * HALF + m * 16) * ldc + col0;
#pragma unroll
                for (int bj = 0; bj < 2; ++bj) { const f32x4 v0 = acc[ai][bj][m][0], v1 = acc[ai][bj][m][1];
                    u32x4 w; w.x = cvt_pk_bf16(v0[0], v0[1]); w.y = cvt_pk_bf16(v0[2], v0[3]); w.z = cvt_pk_bf16(v1[0], v1[1]); w.w = cvt_pk_bf16(v1[2], v1[3]);
                    *(u32x4*)(rowp + bj * HALF) = w; } }
    }
};
struct EpiResid {
    static constexpr bool PERM = false;
    float* X; const float* MODg; const float* Slat; const float* Sctx;
    __device__ __forceinline__ void operator()(const f32x4 (&acc)[2][2][4][2], const Unit& u, int wr, int wc, int fr, int fq) const {
        const int row0 = u.pm * BM + wr * 64 + fr, col0 = u.pn * BM + wc * 32 + 4 * fq;
        const float* gp = MODg + mrow_of(u.pm * BM) * 6144 + col0;
        f32x4 gv[2][2];
#pragma unroll
        for (int bj = 0; bj < 2; ++bj)
#pragma unroll
            for (int n = 0; n < 2; ++n) gv[bj][n] = *(const f32x4*)(gp + bj * HALF + n * 16);
#pragma unroll
        for (int ai = 0; ai < 2; ++ai) {
            f32x4 xv[4][2][2];
#pragma unroll
            for (int m = 0; m < 4; ++m) { const int rr = row0 + ai * HALF + m * 16; const float* rowp = (rr < NLAT ? Slat + (size_t)rr * D : Sctx + (size_t)(rr - NLAT) * D) + col0;
#pragma unroll
                for (int bj = 0; bj < 2; ++bj)
#pragma unroll
                    for (int n = 0; n < 2; ++n) xv[m][bj][n] = *(const f32x4*)(rowp + bj * HALF + n * 16); }
#pragma unroll
            for (int m = 0; m < 4; ++m) { float* rowp = X + (size_t)(row0 + ai * HALF + m * 16) * D + col0;
#pragma unroll
                for (int bj = 0; bj < 2; ++bj)
#pragma unroll
                    for (int n = 0; n < 2; ++n) *(f32x4*)(rowp + bj * HALF + n * 16) = xv[m][bj][n] + gv[bj][n] * acc[ai][bj][m][n]; } }
    }
};
struct EpiSwiglu {
    static constexpr bool PERM = true;
    bf16* ACT; const float* bgu; const int* tile_e;
    __device__ __forceinline__ void operator()(const f32x4 (&acc)[2][2][4][2], const Unit& u, int wr, int wc, int fr, int fq) const {
        const int e = u.e;
        const int row0 = u.pm * BM + wr * 64 + fr, col0 = u.pn * HALF + wc * 32 + 8 * fq;
        const float* bp = bgu + (size_t)e * 2048 + col0;
        const f32x4 bg0 = *(const f32x4*)bp, bg1 = *(const f32x4*)(bp + 4), bl0 = *(const f32x4*)(bp + 1024), bl1 = *(const f32x4*)(bp + 1028);
#pragma unroll
        for (int ai = 0; ai < 2; ++ai)
#pragma unroll
            for (int m = 0; m < 4; ++m) {
                f32x4 g0 = acc[ai][0][m][0] + bg0, g1 = acc[ai][0][m][1] + bg1, l0 = acc[ai][1][m][0] + bl0, l1 = acc[ai][1][m][1] + bl1; float o[8];
#pragma unroll
                for (int i = 0; i < 4; ++i) { g0[i] = fminf(g0[i], 7.f); g1[i] = fminf(g1[i], 7.f); l0[i] = fminf(fmaxf(l0[i], -7.f), 7.f); l1[i] = fminf(fmaxf(l1[i], -7.f), 7.f); }
                const f32x4 t0 = g0 * (-1.702f * 1.44269504f), t1 = g1 * (-1.702f * 1.44269504f);
                f32x4 e0, e1;
#pragma unroll
                for (int i = 0; i < 4; ++i) { e0[i] = __builtin_amdgcn_exp2f(t0[i]); e1[i] = __builtin_amdgcn_exp2f(t1[i]); }
                e0 = e0 + 1.f; e1 = e1 + 1.f;
#pragma unroll
                for (int i = 0; i < 4; ++i) { e0[i] = __builtin_amdgcn_rcpf(e0[i]); e1[i] = __builtin_amdgcn_rcpf(e1[i]); }
                const f32x4 r0 = (g0 * e0) * (l0 + 1.f), r1 = (g1 * e1) * (l1 + 1.f);
#pragma unroll
                for (int i = 0; i < 4; ++i) { o[i] = r0[i]; o[4 + i] = r1[i]; }
                u32x4 w; w.x = cvt_pk_bf16(o[0], o[1]); w.y = cvt_pk_bf16(o[2], o[3]); w.z = cvt_pk_bf16(o[4], o[5]); w.w = cvt_pk_bf16(o[6], o[7]);
                *(u32x4*)(ACT + (size_t)(row0 + ai * HALF + m * 16) * DEXP + col0) = w; }
    }
};
struct EpiDown {
    static constexpr bool PERM = true;
    bf16* YS; const float* bdn; const float* sgate; const int* tile_e;
    __device__ __forceinline__ void operator()(const f32x4 (&acc)[2][2][4][2], const Unit& u, int wr, int wc, int fr, int fq) const {
        const int e = u.e;
        const int row0 = u.pm * BM + wr * 64 + fr, col0 = u.pn * BM + wc * 32 + 8 * fq;
        f32x4 bv[2][2];
#pragma unroll
        for (int bj = 0; bj < 2; ++bj)
#pragma unroll
            for (int n = 0; n < 2; ++n) bv[bj][n] = *(const f32x4*)(bdn + (size_t)e * D + col0 + bj * HALF + 4 * n);
#pragma unroll
        for (int ai = 0; ai < 2; ++ai)
#pragma unroll
            for (int m = 0; m < 4; ++m) { const int row = row0 + ai * HALF + m * 16; const float sg = sgate[row]; bf16* rowp = YS + (size_t)row * D + col0;
#pragma unroll
                for (int bj = 0; bj < 2; ++bj) { const f32x4 v0 = (acc[ai][bj][m][0] + bv[bj][0]) * sg, v1 = (acc[ai][bj][m][1] + bv[bj][1]) * sg;
                    u32x4 w; w.x = cvt_pk_bf16(v0[0], v0[1]); w.y = cvt_pk_bf16(v0[2], v0[3]); w.z = cvt_pk_bf16(v1[0], v1[1]); w.w = cvt_pk_bf16(v1[2], v1[3]);
                    *(u32x4*)(rowp + bj * HALF) = w; } }
    }
};

template <class Epi, class Sched, bool ALIGN_EPI>
__device__ __forceinline__ void gemm_phase(LAS unsigned char* lds, const Gemm g, const Sched& S, const Epi& E, const int tid) {
    const int wid = __builtin_amdgcn_readfirstlane(tid >> 6), lane = tid & 63, wr = wid >> 2, wc = wid & 3, fr = lane & 15, fq = lane >> 4;
    const int K = g.K, nt = K / BK;
    int RA[2]; unsigned cbA[2], voffB[2];
#pragma unroll
    for (int i = 0; i < 2; ++i) { int R, C; stage_rc(tid * 16 + i * 8192, R, C); const int Rb = Epi::PERM ? ((R & ~31) + perm32(R & 31)) : R;
        RA[i] = R; cbA[i] = (unsigned)C * 2u; voffB[i] = (unsigned)(Rb * K + C) * 2u; }
    const size_t kstep = (size_t)(BK * 2);
    const size_t hstep = (size_t)HALF * K * 2;
    const size_t tstep = 2 * hstep;
    const unsigned ldsw = (unsigned)wid * 1024u;
    const int aoff = lds_byte(wr * 64 + fr, fq * 8), boff = lds_byte(wc * 32 + fr, fq * 8);
#define PG8_SA(b, h) (((b) * 2 + (h)) * HTB)
#define PG8_SB(b, h) ((4 + (b) * 2 + (h)) * HTB)
#define PG8_STAGE(bufoff, gbase, voff) do { _Pragma("unroll") for (int _i = 0; _i < 2; ++_i) \
        __builtin_amdgcn_global_load_lds((const unsigned*)((const char*)(gbase) + (voff)[_i]), (LAS unsigned*)(lds + (bufoff) + ldsw + _i * 8192), 16, 0, 0); } while (0)
#define PG8_LDA(dst, b, h) do { _Pragma("unroll") for (int m = 0; m < 4; ++m) _Pragma("unroll") for (int k = 0; k < 2; ++k) dst[m][k] = *(const LAS bf16x8*)(lds + PG8_SA(b, h) + aoff + m * 2048 + k * 1024); } while (0)
#define PG8_LDB(dst, b, h) do { _Pragma("unroll") for (int n = 0; n < 2; ++n) _Pragma("unroll") for (int k = 0; k < 2; ++k) dst[n][k] = *(const LAS bf16x8*)(lds + PG8_SB(b, h) + boff + n * 2048 + k * 1024); } while (0)
#define PG8_MMA(ai, bj, At, Bt) do { __builtin_amdgcn_s_setprio(1); _Pragma("unroll") for (int m = 0; m < 4; ++m) _Pragma("unroll") for (int n = 0; n < 2; ++n) _Pragma("unroll") for (int k = 0; k < 2; ++k) \
        acc[ai][bj][m][n] = __builtin_amdgcn_mfma_f32_16x16x32_bf16(Bt[n][k], At[m][k], acc[ai][bj][m][n], 0, 0, 0); __builtin_amdgcn_s_setprio(0); } while (0)
#define PG8_WAIT_V(n) asm volatile("s_waitcnt vmcnt(" #n ")" ::: "memory")
#define PG8_WAIT_L(n) asm volatile("s_waitcnt lgkmcnt(" #n ")" ::: "memory")
#define PG8_BAR __builtin_amdgcn_s_barrier()
#define PG8_SCHED __builtin_amdgcn_sched_barrier(0)
#define PG8_AOFF(va, u) do { _Pragma("unroll") for (int _h = 0; _h < 2; ++_h) _Pragma("unroll") for (int _i = 0; _i < 2; ++_i) { const int _r = (u).pm * BM + _h * HALF + RA[_i]; \
        const int _row = g.gather ? g.gather[_r] : _r; va[_h][_i] = (unsigned)_row * (unsigned)(K * 2) + cbA[_i]; } } while (0)
#define PG8_BBASE(u) ((u).e = g.tile_e ? g.tile_e[8 + (u).pm] : 0, (const char*)g.Bt + (size_t)(u).e * g.bexp * 2 + (size_t)(u).pn * tstep)
    Unit cur, nxt; int ui = 0;
    if (!S.next(0, cur)) return;
    f32x4 acc[2][2][4][2];
#pragma unroll
    for (int a = 0; a < 2; ++a)
#pragma unroll
        for (int b = 0; b < 2; ++b)
#pragma unroll
            for (int m = 0; m < 4; ++m)
#pragma unroll
                for (int n = 0; n < 2; ++n) acc[a][b][m][n] = (f32x4){0.f, 0.f, 0.f, 0.f};
    bf16x8 At[4][2], B0[2][2], B1[2][2];
    const char* Ab = (const char*)g.A;
    unsigned cva[2][2], nva[2][2];
    PG8_AOFF(cva, cur);
    const char* cB = PG8_BBASE(cur);
    PG8_STAGE(PG8_SB(0, 0), cB, voffB); PG8_STAGE(PG8_SB(0, 1), cB + hstep, voffB); PG8_STAGE(PG8_SA(0, 0), Ab, cva[0]); PG8_STAGE(PG8_SA(0, 1), Ab, cva[1]);
    if (wr == 1) PG8_BAR;
    PG8_WAIT_V(2); PG8_BAR;
    PG8_STAGE(PG8_SB(1, 0), cB + kstep, voffB); PG8_STAGE(PG8_SA(1, 0), Ab + kstep, cva[0]); PG8_STAGE(PG8_SB(1, 1), cB + hstep + kstep, voffB);
    PG8_WAIT_V(6); PG8_BAR;
    for (;;) {
        const bool has_next = S.next(ui + 1, nxt);
        const char* nB = cB;
        if (has_next) { PG8_AOFF(nva, nxt); nB = PG8_BBASE(nxt); }
        else {
#pragma unroll
            for (int h = 0; h < 2; ++h)
#pragma unroll
                for (int i = 0; i < 2; ++i) nva[h][i] = cva[h][i]; }
        for (int t = 0; t < nt; t += 2) {
            const bool last = (t == nt - 2);
            const char* a1 = Ab + (size_t)(t + 1) * kstep;
            const char* a2 = last ? Ab : Ab + (size_t)(t + 2) * kstep; const char* b2 = last ? nB : cB + (size_t)(t + 2) * kstep;
            const char* a3 = a2 + kstep; const char* b3 = b2 + kstep;
            unsigned s2[2][2];
#pragma unroll
            for (int h = 0; h < 2; ++h)
#pragma unroll
                for (int i = 0; i < 2; ++i) s2[h][i] = last ? nva[h][i] : cva[h][i];
            PG8_LDB(B0, 0, 0); PG8_LDB(B1, 0, 1); PG8_SCHED; PG8_LDA(At, 0, 0); PG8_STAGE(PG8_SA(1, 1), a1, cva[1]);
            PG8_WAIT_V(8); PG8_WAIT_L(0); PG8_BAR; PG8_MMA(0, 0, At, B0); PG8_MMA(0, 1, At, B1); PG8_BAR; PG8_SCHED;
            PG8_LDA(At, 0, 1); PG8_STAGE(PG8_SB(0, 0), b2, voffB); PG8_STAGE(PG8_SB(0, 1), b2 + hstep, voffB); PG8_STAGE(PG8_SA(0, 0), a2, s2[0]);
            PG8_WAIT_V(8); PG8_WAIT_L(0); PG8_BAR; PG8_MMA(1, 0, At, B0); PG8_MMA(1, 1, At, B1); PG8_BAR; PG8_SCHED;
            PG8_LDB(B0, 1, 0); PG8_LDB(B1, 1, 1); PG8_SCHED; PG8_LDA(At, 1, 0); PG8_STAGE(PG8_SA(0, 1), a2, s2[1]);
            PG8_WAIT_V(8); PG8_WAIT_L(0); PG8_BAR; PG8_MMA(0, 0, At, B0); PG8_MMA(0, 1, At, B1); PG8_BAR; PG8_SCHED;
            PG8_LDA(At, 1, 1); PG8_STAGE(PG8_SB(1, 0), b3, voffB); PG8_STAGE(PG8_SB(1, 1), b3 + hstep, voffB); PG8_STAGE(PG8_SA(1, 0), a3, s2[0]);
            PG8_WAIT_V(8); PG8_WAIT_L(0); PG8_BAR; PG8_MMA(1, 0, At, B0); PG8_MMA(1, 1, At, B1); PG8_BAR; PG8_SCHED;
        }
        if constexpr (ALIGN_EPI) { if (wr == 0) PG8_BAR; }
        E(acc, cur, wr, wc, fr, fq);
        if (!has_next) break;
#pragma unroll
        for (int a = 0; a < 2; ++a)
#pragma unroll
            for (int b = 0; b < 2; ++b)
#pragma unroll
                for (int m = 0; m < 4; ++m)
#pragma unroll
                    for (int n = 0; n < 2; ++n) acc[a][b][m][n] = (f32x4){0.f, 0.f, 0.f, 0.f};
        cur = nxt; cB = nB; ++ui;
#pragma unroll
        for (int h = 0; h < 2; ++h)
#pragma unroll
            for (int i = 0; i < 2; ++i) cva[h][i] = nva[h][i];
        if constexpr (ALIGN_EPI) { if (wr == 1) PG8_BAR; }
    }
    PG8_WAIT_V(0);
    if constexpr (!ALIGN_EPI) { if (wr == 0) PG8_BAR; }
    PG8_BAR;
#undef PG8_SA
#undef PG8_SB
#undef PG8_STAGE
#undef PG8_LDA
#undef PG8_LDB
#undef PG8_MMA
#undef PG8_WAIT_V
#undef PG8_WAIT_L
#undef PG8_BAR
#undef PG8_SCHED
#undef PG8_AOFF
#undef PG8_BBASE
}
}


typedef short bf16x8_t __attribute__((ext_vector_type(8)));
typedef float f32x16 __attribute__((ext_vector_type(16)));
template <int K>
__device__ __forceinline__ void mm32(f32x16& acc, const LAS unsigned char* A, int sa, const LAS unsigned char* B, int sb, int lane) {
    const LAS unsigned char* ap = A + (lane & 31) * sa + (lane >> 5) * 16;
    const LAS unsigned char* bp = B + (lane & 31) * sb + (lane >> 5) * 16;
#pragma unroll
    for (int k0 = 0; k0 < K / 16; k0 += 4) {
        bf16x8_t a[4], b[4];
#pragma unroll
        for (int k = 0; k < 4; ++k) { a[k] = *(const LAS bf16x8_t*)(ap + (k0 + k) * 32); b[k] = *(const LAS bf16x8_t*)(bp + (k0 + k) * 32); }
#pragma unroll
        for (int k = 0; k < 4; ++k) acc = __builtin_amdgcn_mfma_f32_32x32x16_bf16(a[k], b[k], acc, 0, 0, 0);
    }
}
__device__ __forceinline__ int rowmap(int reg, int hi) { return (reg & 3) + 8 * (reg >> 2) + 4 * hi; }
__device__ __forceinline__ int chunk_row0(int b, int tc) { return tc < 4 ? NLAT + b * CTX + tc * 64 : b * SEQ + (tc - 4) * 64; }
constexpr int ST64 = 144, ST128 = 272;


struct VtRaw { unsigned w[8]; };
__device__ __forceinline__ void vt_load(VtRaw& R, const bf16* src, int pitch, int row0, int col0, int tid) {
    const int cp = tid & 63, tg = tid >> 6;
#pragma unroll
    for (int i = 0; i < 8; ++i) R.w[i] = *(const unsigned*)(src + (size_t)(row0 + tg * 8 + i) * pitch + col0 + 2 * cp);
}
__device__ __forceinline__ void vt_store(LAS unsigned char* VT, const VtRaw& R, int tid) {
    const int cp = tid & 63, tg = tid >> 6; unsigned lo[4], hi[4];
#pragma unroll
    for (int i = 0; i < 4; ++i) { const unsigned w0 = R.w[2 * i], w1 = R.w[2 * i + 1]; lo[i] = (w0 & 0xffffu) | (w1 << 16); hi[i] = (w0 >> 16) | (w1 & 0xffff0000u); }
    *(LAS u32x4*)(VT + (2 * cp) * ST64 + tg * 16) = (u32x4){lo[0], lo[1], lo[2], lo[3]};
    *(LAS u32x4*)(VT + (2 * cp + 1) * ST64 + tg * 16) = (u32x4){hi[0], hi[1], hi[2], hi[3]};
}
struct TaskId { int b, h, tc, row0, sidf; };
__device__ __forceinline__ TaskId task_id(int task) { TaskId t; t.b = task / (4 * NTC); t.h = (task / NTC) & 3; t.tc = task % NTC; t.row0 = chunk_row0(t.b, t.tc); t.sidf = (t.b * 4 + t.h) * 2; return t; }

struct MlARaw { VtRaw v; unsigned kw[4]; float g[4]; };
__device__ __forceinline__ void touch(MlARaw& R) {
#pragma unroll
    for (int i = 0; i < 8; ++i) touch(R.v.w[i]);
#pragma unroll
    for (int i = 0; i < 4; ++i) { touch(R.kw[i]); touch(R.g[i]); } }
__device__ __forceinline__ void ml_passA_load(Frame& F, int task, MlARaw& R) {
    const TaskId T = task_id(task);
    vt_load(R.v, (const bf16*)(F.ws + WS_P), PW, T.row0, PC_V + T.h * 128, F.tid);
    { const int cp = F.tid & 31, tg = F.tid >> 5; const bf16* CQK = (const bf16*)(F.ws + WS_CQK);
#pragma unroll
      for (int i = 0; i < 4; ++i) R.kw[i] = *(const unsigned*)(CQK + (size_t)(T.row0 + tg * 4 + i) * 512 + 256 + T.h * 64 + 2 * cp); }
    if (F.wave == 0) { const float* gp = (const float*)(F.ws + WS_GATES) + (size_t)(T.row0 + F.lane) * 16; R.g[0] = gp[T.h]; R.g[1] = gp[4 + T.h]; R.g[2] = gp[8 + T.h]; R.g[3] = gp[12 + T.h]; }
}
__device__ __forceinline__ void ml_passA_run(Frame& F, int task, const MlARaw& R) {
    const TaskId T = task_id(task); const int tc = T.tc, sidf = T.sidf;
    LAS unsigned char* VT = F.lds; LAS unsigned char* KT = F.lds + 18432;
    LAS float* wts = (LAS float*)(F.lds + 36864);
    float* MLS = (float*)(F.ws + WS_MLS);
    LDS_BARRIER();
    if (F.wave == 0) { const int s = F.lane;
        const float igf = R.g[0], igb = R.g[1], lff = R.g[2], lfb = R.g[3];
        const float pf = wave_incl_sum(lff, s), gf = __builtin_bit_cast(float, __builtin_amdgcn_readlane(__builtin_bit_cast(int, pf), 63)), ef = (gf - pf) + igf, mf = wave_max(ef);
        const float pb = wave_incl_sum(lfb, s), gb = __builtin_bit_cast(float, __builtin_amdgcn_readlane(__builtin_bit_cast(int, pb), 63)), eb = (pb - lfb) + igb, mb = wave_max(eb);
        wts[s] = __expf(ef - mf); wts[64 + s] = __expf(eb - mb);
        if (s == 0) { float* o = MLS + (size_t)(sidf * NTC + tc) * 4; o[0] = gf; o[1] = mf; o = MLS + (size_t)((sidf + 1) * NTC + tc) * 4; o[0] = gb; o[1] = mb; } }
    vt_store(VT, R.v, F.tid);
    LDS_BARRIER();
    { const int cp = F.tid & 31, tg = F.tid >> 5;
#pragma unroll
      for (int dir = 0; dir < 2; ++dir) { float lo[4], hi[4];
#pragma unroll
          for (int i = 0; i < 4; ++i) { const float w = wts[dir * 64 + tg * 4 + i]; lo[i] = bflo(R.kw[i]) * w; hi[i] = bfhi(R.kw[i]) * w; }
          *(LAS u32x2*)(KT + dir * 9216 + (2 * cp) * ST64 + tg * 8) = (u32x2){pk2(lo[0], lo[1]), pk2(lo[2], lo[3])};
          *(LAS u32x2*)(KT + dir * 9216 + (2 * cp + 1) * ST64 + tg * 8) = (u32x2){pk2(hi[0], hi[1]), pk2(hi[2], hi[3])}; } }
    LDS_BARRIER();
    { const int dir = F.wave >> 2, mt = F.wave & 3; bf16* C = (bf16*)(F.ws + WS_MLC) + (size_t)((sidf + dir) * NTC + tc) * 8192;
#pragma unroll
      for (int nt = 0; nt < 2; ++nt) { f32x16 acc;
#pragma unroll
          for (int i = 0; i < 16; ++i) acc[i] = 0.f;
          mm32<64>(acc, VT + 32 * mt * ST64, ST64, KT + dir * 9216 + 32 * nt * ST64, ST64, F.lane);
#pragma unroll
          for (int r = 0; r < 16; ++r) C[(32 * mt + rowmap(r, F.lane >> 5)) * 64 + 32 * nt + (F.lane & 31)] = (bf16)f2bf(acc[r]); } }
    if (F.tid < 128) { const int dir = F.tid >> 6, d = F.tid & 63; const LAS unsigned char* rp = KT + dir * 9216 + d * ST64; float sum = 0.f;
#pragma unroll
        for (int i = 0; i < 8; ++i) { const u32x4 w = *(const LAS u32x4*)(rp + i * 16); sum += (bflo(w.x) + bfhi(w.x)) + (bflo(w.y) + bfhi(w.y)) + (bflo(w.z) + bfhi(w.z)) + (bflo(w.w) + bfhi(w.w)); }
        ((float*)(F.ws + WS_MLN))[(size_t)((sidf + dir) * NTC + tc) * 64 + d] = sum; }
}
__device__ __forceinline__ int tc_seq(int dir, int j) { return dir == 0 ? j : (j < 4 ? 3 - j : 135 - j); }
__device__ __forceinline__ void scan_passB(Frame& F) {
    const float* GG = (const float*)(F.ws + WS_HGG); float* MLS = (float*)(F.ws + WS_MLS);
    const int t = F.tid;
    if (t < 128) {
        for (int item = F.vcu * 128 + t; item < 16 * 2048; item += F.G * 128) {
            const int scan = item >> 11, e = (item & 2047) * 8, dir = scan & 1, d = e & 127;
            const u32x4* base = (const u32x4*)((const bf16*)(F.ws + WS_HGS) + (size_t)scan * NTC * 16384 + e); u32x4* ob = (u32x4*)((bf16*)(F.ws + WS_HGSB) + (size_t)scan * NTC * 16384 + e);
            const f32x4* gb = (const f32x4*)(GG + (size_t)scan * NTC * 128 + d);
            float st[8];
#pragma unroll
            for (int k = 0; k < 8; ++k) st[k] = 0.f;
            for (int j0 = 0; j0 < NTC; j0 += 11) {
                u32x4 dv[11]; f32x4 g0[11], g1[11];
#pragma unroll
                for (int i = 0; i < 11; ++i) { const int tc = tc_seq(dir, j0 + i); dv[i] = __builtin_nontemporal_load(base + (size_t)tc * 2048); g0[i] = gb[tc * 32]; g1[i] = gb[tc * 32 + 1]; }
#pragma unroll
                for (int i = 0; i < 11; ++i) { const int tc = tc_seq(dir, j0 + i);
                    ob[(size_t)tc * 2048] = (u32x4){pk2(st[0], st[1]), pk2(st[2], st[3]), pk2(st[4], st[5]), pk2(st[6], st[7])};
                    const f32x4 ta = g0[i] * 1.44269504f, tb = g1[i] * 1.44269504f;
                    const f32x2_t e0 = {__builtin_amdgcn_exp2f(ta.x), __builtin_amdgcn_exp2f(ta.y)}, e1 = {__builtin_amdgcn_exp2f(ta.z), __builtin_amdgcn_exp2f(ta.w)}, e2 = {__builtin_amdgcn_exp2f(tb.x), __builtin_amdgcn_exp2f(tb.y)}, e3 = {__builtin_amdgcn_exp2f(tb.z), __builtin_amdgcn_exp2f(tb.w)};
                    const f32x2_t s0 = e0 * (f32x2_t){st[0], st[1]} + (f32x2_t){bflo(dv[i].x), bfhi(dv[i].x)}, s1 = e1 * (f32x2_t){st[2], st[3]} + (f32x2_t){bflo(dv[i].y), bfhi(dv[i].y)};
                    const f32x2_t s2 = e2 * (f32x2_t){st[4], st[5]} + (f32x2_t){bflo(dv[i].z), bfhi(dv[i].z)}, s3 = e3 * (f32x2_t){st[6], st[7]} + (f32x2_t){bflo(dv[i].w), bfhi(dv[i].w)};
                    st[0] = s0.x; st[1] = s0.y; st[2] = s1.x; st[3] = s1.y; st[4] = s2.x; st[5] = s2.y; st[6] = s3.x; st[7] = s3.y; }
            }
        }
    } else if (t < 192) {
        for (int item = F.vcu * 64 + (t - 128); item < 16 * 1024; item += F.G * 64) {
            const int scan = item >> 10, e = (item & 1023) * 8, dir = scan & 1;
            const u32x4* cb = (const u32x4*)((const bf16*)(F.ws + WS_MLC) + (size_t)scan * NTC * 8192 + e); u32x4* ob = (u32x4*)((bf16*)(F.ws + WS_MLCB) + (size_t)scan * NTC * 8192 + e);
            float m = 0.f, st[8];
#pragma unroll
            for (int k = 0; k < 8; ++k) st[k] = 0.f;
            for (int j0 = 0; j0 < NTC; j0 += 12) {
                u32x4 dv[12]; float gg[12], ml[12];
#pragma unroll
                for (int i = 0; i < 12; ++i) { const int tc = tc_seq(dir, j0 + i); dv[i] = __builtin_nontemporal_load(cb + (size_t)tc * 1024); const float* sp = MLS + (size_t)(scan * NTC + tc) * 4; gg[i] = sp[0]; ml[i] = sp[1]; }
#pragma unroll
                for (int i = 0; i < 12; ++i) { const int tc = tc_seq(dir, j0 + i);
                    const float mn = fmaxf(gg[i] + m, ml[i]), a = __expf(gg[i] + m - mn), w = __expf(ml[i] - mn);
                    if ((item & 1023) == 0) MLS[(size_t)(scan * NTC + tc) * 4 + 2] = m;
                    ob[(size_t)tc * 1024] = (u32x4){pk2(st[0], st[1]), pk2(st[2], st[3]), pk2(st[4], st[5]), pk2(st[6], st[7])};
                    const f32x2_t s0 = (f32x2_t){st[0], st[1]} * a + (f32x2_t){bflo(dv[i].x), bfhi(dv[i].x)} * w, s1 = (f32x2_t){st[2], st[3]} * a + (f32x2_t){bflo(dv[i].y), bfhi(dv[i].y)} * w;
                    const f32x2_t s2 = (f32x2_t){st[4], st[5]} * a + (f32x2_t){bflo(dv[i].z), bfhi(dv[i].z)} * w, s3 = (f32x2_t){st[6], st[7]} * a + (f32x2_t){bflo(dv[i].w), bfhi(dv[i].w)} * w;
                    st[0] = s0.x; st[1] = s0.y; st[2] = s1.x; st[3] = s1.y; st[4] = s2.x; st[5] = s2.y; st[6] = s3.x; st[7] = s3.y; m = mn; }
            }
        }
    } else if (t < 196) {
        for (int item = F.vcu * 4 + (t - 192); item < 16 * 64; item += F.G * 4) {
            const int scan = item >> 6, e = item & 63, dir = scan & 1; float* nb = (float*)(F.ws + WS_MLN) + (size_t)scan * NTC * 64 + e;
            float m = 0.f, s0 = 0.f;
            for (int j0 = 0; j0 < NTC; j0 += 12) {
                float dv[12], gq[12], mq[12];
#pragma unroll
                for (int i = 0; i < 12; ++i) { const int tc = tc_seq(dir, j0 + i); dv[i] = nb[tc * 64]; const float* sp = MLS + (size_t)(scan * NTC + tc) * 4; gq[i] = sp[0]; mq[i] = sp[1]; }
#pragma unroll
                for (int i = 0; i < 12; ++i) { const int tc = tc_seq(dir, j0 + i);
                    const float g = gq[i], ml = mq[i], mn = fmaxf(g + m, ml), a = __expf(g + m - mn), w = __expf(ml - mn);
                    nb[tc * 64] = s0; s0 = a * s0 + w * dv[i]; m = mn; }
            }
        }
    }
}
template <int MIX>
__device__ __forceinline__ void gate_load(Frame& F, int row0, int h, unsigned (&gate)[16]) {
    const int mt = F.wave >> 2, nt = F.wave & 3; const bf16* P = (const bf16*)(F.ws + WS_P) + (MIX == 0 ? PC_O : PC_GO) + h * 128 + 32 * nt + (F.lane & 31);
#pragma unroll
    for (int r = 0; r < 16; ++r) gate[r] = P[(size_t)(row0 + 32 * mt + rowmap(r, F.lane >> 5)) * PW];
}
template <int MIX>
__device__ __forceinline__ void head_epilogue(Frame& F, const float ng, const f32x16& hv, const unsigned (&gate)[16], LAS float* part, int row0, int h) {
    const int mt = F.wave >> 2, nt = F.wave & 3, lane = F.lane, hi = lane >> 5;
    float ps[16];
#pragma unroll
    for (int r = 0; r < 16; ++r) ps[r] = hv[r] * hv[r];
#pragma unroll
    for (int r = 0; r < 16; ++r) ps[r] = half_sum_hi(ps[r]);
    if ((lane & 31) == 31) {
#pragma unroll
        for (int r = 0; r < 16; ++r) part[(32 * mt + rowmap(r, hi)) * 4 + nt] = ps[r]; }
    LDS_BARRIER();
    bf16* Y = (bf16*)(F.ws + WS_Y) + (MIX == 0 ? 0 : 512) + h * 128 + 32 * nt + (lane & 31);
#pragma unroll
    for (int r = 0; r < 16; r += 2) { const int t0 = 32 * mt + rowmap(r, hi), t1 = 32 * mt + rowmap(r + 1, hi); const f32x4 p4 = *(const LAS f32x4*)(part + t0 * 4), q4 = *(const LAS f32x4*)(part + t1 * 4);
        const f32x2_t ms = (f32x2_t){(p4.x + p4.y) + (p4.z + p4.w), (q4.x + q4.y) + (q4.z + q4.w)} * (1.f / 128.f) + EPS;
        const f32x2_t rstd = {__builtin_amdgcn_rsqf(ms.x), __builtin_amdgcn_rsqf(ms.y)}, gz = {bf2f((unsigned short)gate[r]), bf2f((unsigned short)gate[r + 1])};
        const f32x2_t te = gz * (-1.44269504f), dn = (f32x2_t){__builtin_amdgcn_exp2f(te.x), __builtin_amdgcn_exp2f(te.y)} + 1.f;
        const f32x2_t sg = {__builtin_amdgcn_rcpf(dn.x), __builtin_amdgcn_rcpf(dn.y)}, gv = MIX == 0 ? sg : gz * sg;
        const f32x2_t y = ((f32x2_t){hv[r], hv[r + 1]} * rstd) * (gv * ng); const unsigned w = pk2(y.x, y.y);
        Y[(size_t)(row0 + t0) * D] = (bf16)w; Y[(size_t)(row0 + t1) * D] = (bf16)(w >> 16); }
}
struct MlCRaw { VtRaw v; u32x4 q, k; u32x4 cf[2]; float g0, g1, ms, nv, ng; };
__device__ __forceinline__ void touch(MlCRaw& R) {
#pragma unroll
    for (int i = 0; i < 8; ++i) touch(R.v.w[i]);
    touch(R.q); touch(R.k); touch(R.cf[0]); touch(R.cf[1]); touch(R.g0); touch(R.g1); touch(R.ms); touch(R.nv); touch(R.ng); }
__device__ __forceinline__ void ml_passC_load(Frame& F, CArgs& A, int l, int task, MlCRaw& R) {
    const TaskId T = task_id(task); const bf16* CQK = (const bf16*)(F.ws + WS_CQK);
    R.ng = A.in[I_MLNG][l * 512 + T.h * 128 + 32 * (F.wave & 3) + (F.lane & 31)];
    R.nv = 0.f; if (F.tid < 128) R.nv = ((const float*)(F.ws + WS_MLN))[(size_t)((T.sidf + (F.tid >> 6)) * NTC + T.tc) * 64 + (F.tid & 63)];
    vt_load(R.v, (const bf16*)(F.ws + WS_P), PW, T.row0, PC_V + T.h * 128, F.tid);
    { const int row = F.tid >> 3, pc = F.tid & 7;
      R.q = *(const u32x4*)(CQK + (size_t)(T.row0 + row) * 512 + T.h * 64 + pc * 8); R.k = *(const u32x4*)(CQK + (size_t)(T.row0 + row) * 512 + 256 + T.h * 64 + pc * 8); }
    { const u32x4* cp = (const u32x4*)((const bf16*)(F.ws + WS_MLCB) + (size_t)(T.sidf * NTC + T.tc) * 8192 + (F.tid >> 2) * 64 + (F.tid & 3) * 16); R.cf[0] = cp[0]; R.cf[1] = cp[1]; }
    R.g0 = 0.f; R.g1 = 0.f; R.ms = 0.f;
    if (F.wave < 2) { const int dir = F.wave; const float* gp = (const float*)(F.ws + WS_GATES) + (size_t)(T.row0 + F.lane) * 16; R.g0 = gp[dir * 4 + T.h]; R.g1 = gp[8 + dir * 4 + T.h];
        R.ms = ((const float*)(F.ws + WS_MLS))[(size_t)((T.sidf + dir) * NTC + T.tc) * 4 + 2]; }
}
__device__ __forceinline__ void ml_passC_run(Frame& F, CArgs& A, int l, int task, const MlCRaw& R) {
    const TaskId T = task_id(task); const int h = T.h, tc = T.tc, row0 = T.row0, sidf = T.sidf;
    if (l == DEPTH - 1 && tc < 4) return;
    unsigned gate[16];
    const float ng = R.ng;
    LAS unsigned char* Q = F.lds; LAS unsigned char* Kn = F.lds + 9216; LAS unsigned char* VT = F.lds + 18432; LAS unsigned char* Cs = F.lds + 36864;
    LAS unsigned char* Pm = F.lds + 55296; LAS unsigned char* Qs = F.lds + 64512;
    LAS float* sm = (LAS float*)(F.lds + 73728);
    const int tid = F.tid, lane = F.lane;
    u32x4 cb[2]; { const u32x4* cp = (const u32x4*)((const bf16*)(F.ws + WS_MLCB) + (size_t)((sidf + 1) * NTC + tc) * 8192 + (tid >> 2) * 64 + (tid & 3) * 16); cb[0] = cp[0]; cb[1] = cp[1]; }
    const float nv = R.nv;
    LDS_BARRIER();
    { const int row = tid >> 3, pc = tid & 7; *(LAS u32x4*)(Q + row * ST64 + pc * 16) = R.q; *(LAS u32x4*)(Kn + row * ST64 + pc * 16) = R.k; }
    vt_store(VT, R.v, tid);
    if (tid < 128) sm[512 + tid] = nv;
    if (F.wave < 2) { const int dir = F.wave, s = lane; const float ig = R.g0, lf = R.g1, ms = R.ms;
        float bt, u, pm;
        if (dir == 0) { bt = wave_incl_sum(lf, s); u = ig - bt; pm = wave_incl_max(u, s); }
        else { const float pf = wave_incl_sum(lf, s), tot = __builtin_bit_cast(float, __builtin_amdgcn_readlane(__builtin_bit_cast(int, pf), 63)); bt = tot - pf + lf; u = ig - bt;
               float r = __shfl(u, 63 - s); r = wave_incl_max(r, s); pm = __shfl(r, 63 - s); }
        const float M = fmaxf(ms, pm);
        LAS float* o = sm + dir * 256; o[s] = u; o[64 + s] = M; o[128 + s] = __expf(ms - M); o[192 + s] = __expf(-(bt + M)); }
    LDS_BARRIER();
    f32x16 qk;
#pragma unroll
    for (int i = 0; i < 16; ++i) qk[i] = 0.f;
    if (F.wave < 4) mm32<64>(qk, Q + 32 * (F.wave >> 1) * ST64, ST64, Kn + 32 * (F.wave & 1) * ST64, ST64, lane);
    f32x16 hs;
#pragma unroll
    for (int i = 0; i < 16; ++i) hs[i] = 0.f;
#pragma unroll 1
    for (int dir = 0; dir < 2; ++dir) {
        const LAS float* sd = sm + dir * 256;
        if (dir == 1) gate_load<0>(F, row0, h, gate);
        { const int v = tid >> 2, pc = tid & 3; *(LAS u32x4*)(Cs + v * ST64 + pc * 32) = dir == 0 ? R.cf[0] : cb[0]; *(LAS u32x4*)(Cs + v * ST64 + pc * 32 + 16) = dir == 0 ? R.cf[1] : cb[1]; }
        { const int row = tid >> 3, pc = tid & 7; const u32x4 q = R.q; const float w = sd[128 + row];
          *(LAS u32x4*)(Qs + row * ST64 + pc * 16) = (u32x4){pk2(bflo(q.x) * w, bfhi(q.x) * w), pk2(bflo(q.y) * w, bfhi(q.y) * w), pk2(bflo(q.z) * w, bfhi(q.z) * w), pk2(bflo(q.w) * w, bfhi(q.w) * w)}; }
        if (F.wave < 4) { const int s = 32 * (F.wave & 1) + (lane & 31); const float us = sd[s]; float Mt[16];
#pragma unroll
            for (int r = 0; r < 16; ++r) Mt[r] = sd[64 + 32 * (F.wave >> 1) + rowmap(r, lane >> 5)];
#pragma unroll
            for (int r = 0; r < 16; r += 2) { const int t0 = 32 * (F.wave >> 1) + rowmap(r, lane >> 5), t1 = 32 * (F.wave >> 1) + rowmap(r + 1, lane >> 5);
                const bool ok0 = dir == 0 ? (s <= t0) : (s >= t0), ok1 = dir == 0 ? (s <= t1) : (s >= t1);
                f32x2_t ex = (f32x2_t){us - Mt[r], us - Mt[r + 1]}; ex.x = fminf(ex.x, 0.f); ex.y = fminf(ex.y, 0.f); ex = ex * 1.44269504f;
                const f32x2_t p = (f32x2_t){qk[r], qk[r + 1]} * (f32x2_t){__builtin_amdgcn_exp2f(ex.x), __builtin_amdgcn_exp2f(ex.y)}; const unsigned w = pk2(ok0 ? p.x : 0.f, ok1 ? p.y : 0.f);
                *(LAS unsigned short*)(Pm + t0 * ST64 + s * 2) = (unsigned short)w; *(LAS unsigned short*)(Pm + t1 * ST64 + s * 2) = (unsigned short)(w >> 16); } }
        LDS_BARRIER();
        if (tid < 256) { const int t = tid >> 2, qd = tid & 3; float den = 0.f, qn = 0.f;
#pragma unroll
            for (int i = 0; i < 2; ++i) { const u32x4 w = *(const LAS u32x4*)(Pm + t * ST64 + qd * 32 + i * 16); den += (bflo(w.x) + bfhi(w.x)) + (bflo(w.y) + bfhi(w.y)) + (bflo(w.z) + bfhi(w.z)) + (bflo(w.w) + bfhi(w.w));
                const u32x4 q = *(const LAS u32x4*)(Q + t * ST64 + qd * 32 + i * 16); const LAS float* nvp = sm + 512 + dir * 64 + qd * 16 + i * 8; const f32x4 n0 = *(const LAS f32x4*)nvp, n1 = *(const LAS f32x4*)(nvp + 4);
                qn += (bflo(q.x) * n0.x + bfhi(q.x) * n0.y) + (bflo(q.y) * n0.z + bfhi(q.y) * n0.w) + (bflo(q.z) * n1.x + bfhi(q.z) * n1.y) + (bflo(q.w) * n1.z + bfhi(q.w) * n1.w); }
            den += sd[128 + t] * qn;
            den += dppf<0xB1, 0xf, true>(0.f, den); den += dppf<0x4E, 0xf, true>(0.f, den);
            if (qd == 0) sm[640 + t] = 1.f / fmaxf(fabsf(den), sd[192 + t]); }
        f32x16 acc;
#pragma unroll
        for (int i = 0; i < 16; ++i) acc[i] = 0.f;
        { const int mt = F.wave >> 2, nt = F.wave & 3;
          mm32<64>(acc, Pm + 32 * mt * ST64, ST64, VT + 32 * nt * ST64, ST64, lane);
          mm32<64>(acc, Qs + 32 * mt * ST64, ST64, Cs + 32 * nt * ST64, ST64, lane); }
        LDS_BARRIER();
        float dsc[16];
#pragma unroll
        for (int r = 0; r < 16; ++r) dsc[r] = sm[640 + 32 * (F.wave >> 2) + rowmap(r, lane >> 5)];
#pragma unroll
        for (int r = 0; r < 16; ++r) hs[r] += acc[r] * dsc[r];
        if (dir == 0) LDS_BARRIER();
    }
    head_epilogue<0>(F, ng, hs, gate, sm + 768, row0, h);
}

struct HgPrep { float k[16], x[16]; float T[4]; };
__device__ __forceinline__ void hg_zload(Frame& F, int h, int row0, int dir, unsigned (&z)[16]) {
    const int d = F.tid & 127, qtr = F.tid >> 7;
    const bf16* P = (const bf16*)(F.ws + WS_P) + (size_t)(row0 + qtr * 16) * PW + (dir == 0 ? PC_FF : PC_FB) + h * 128 + d;
#pragma unroll
    for (int i = 0; i < 16; ++i) z[i] = P[(size_t)i * PW];
}
struct HgConst { float lb, bf, bb; };
struct HgCRawC { float r0, r1, bf, bb; };
__device__ __forceinline__ void hg_const_load(Frame& F, CArgs& A, int l, int h, HgCRawC& c) { const int ch = h * 128 + (F.tid & 127); c.r0 = 0.f; c.r1 = 0.f;
    if (l == 1) { c.r0 = A.in[I_HGLB][ch]; c.r1 = A.in[I_HGLB][512 + ch]; }
    c.bf = A.in[I_HGFB][l * 1024 + ch]; c.bb = A.in[I_HGFB][l * 1024 + 512 + ch]; }
__device__ __forceinline__ HgConst hg_const(const HgCRawC& r, int l) { HgConst c; c.lb = 0.f;
    if (l == 1) { const float mx = fmaxf(r.r0, r.r1), e0 = __expf(r.r0 - mx), e1 = __expf(r.r1 - mx); c.lb = e1 / (e0 + e1); }
    c.bf = r.bf; c.bb = r.bb; return c; }
__device__ __forceinline__ void touch(HgCRawC& c) { touch(c.r0); touch(c.r1); touch(c.bf); touch(c.bb); }
template <int dir>
__device__ __forceinline__ void hg_prep(Frame& F, const HgConst& C, int l, const unsigned (&zr)[16], LAS float* tot, HgPrep& R) {
    const int d = F.tid & 127, qtr = F.tid >> 7;
    const float lb = C.lb, bias = dir == 0 ? C.bf : C.bb, omlb = 1.f - lb;
    float cs = 0.f;
#pragma unroll
    for (int i = 0; i < 16; i += 2) {
        f32x2_t z = (f32x2_t){bf2f((unsigned short)zr[i]), bf2f((unsigned short)zr[i + 1])} + bias;
        z.x = fminf(fmaxf(z.x, -30.f), 30.f); z.y = fminf(fmaxf(z.y, -30.f), 30.f);
        const f32x2_t t = z * (-1.44269504f);
        const f32x2_t ez = {__builtin_amdgcn_exp2f(t.x), __builtin_amdgcn_exp2f(t.y)}, dn = ez + 1.f;
        const f32x2_t sg = {__builtin_amdgcn_rcpf(dn.x), __builtin_amdgcn_rcpf(dn.y)};
        const f32x2_t kk = (ez * sg) * omlb, ff = sg * omlb + lb;
        R.k[i] = kk.x; R.k[i + 1] = kk.y;
        const f32x2_t lf = (f32x2_t){__builtin_amdgcn_logf(ff.x), __builtin_amdgcn_logf(ff.y)} * 0.69314718f;
        if (dir == 0) { cs += lf.x; R.x[i] = cs; cs += lf.y; R.x[i + 1] = cs; } else { R.x[i] = cs; cs += lf.x; R.x[i + 1] = cs; cs += lf.y; } }
    tot[dir * 512 + qtr * 128 + d] = cs;
    LDS_BARRIER();
    float off = 0.f;
#pragma unroll
    for (int q = 0; q < 4; ++q) { R.T[q] = tot[dir * 512 + q * 128 + d]; if (q < qtr) off += R.T[q]; }
#pragma unroll
    for (int i = 0; i < 16; ++i) R.x[i] += off;
}
__device__ __forceinline__ void put16(LAS unsigned char* p, const float (&v)[16]) {
    *(LAS u32x4*)p = (u32x4){pk2(v[0], v[1]), pk2(v[2], v[3]), pk2(v[4], v[5]), pk2(v[6], v[7])};
    *(LAS u32x4*)(p + 16) = (u32x4){pk2(v[8], v[9]), pk2(v[10], v[11]), pk2(v[12], v[13]), pk2(v[14], v[15])};
}
struct HgARaw { VtRaw v; unsigned zf[16], zb[16]; HgCRawC c; };
__device__ __forceinline__ void touch(HgARaw& R) {
#pragma unroll
    for (int i = 0; i < 8; ++i) touch(R.v.w[i]);
#pragma unroll
    for (int i = 0; i < 16; ++i) { touch(R.zf[i]); touch(R.zb[i]); } touch(R.c); }
__device__ __forceinline__ void hg_passA_load(Frame& F, CArgs& A, int l, int task, HgARaw& R) {
    const TaskId T = task_id(task); hg_const_load(F, A, l, T.h, R.c);
    vt_load(R.v, (const bf16*)(F.ws + WS_CQI), 1024, T.row0, 512 + T.h * 128, F.tid);
    hg_zload(F, T.h, T.row0, 0, R.zf); hg_zload(F, T.h, T.row0, 1, R.zb);
}
__device__ __forceinline__ void hg_passA_run(Frame& F, CArgs& A, int l, int task, const HgARaw& RW) {
    const TaskId T = task_id(task); const int h = T.h, tc = T.tc, sidf = T.sidf;
    LAS unsigned char* VT = F.lds; LAS unsigned char* KT = F.lds + 18432; LAS float* tot = (LAS float*)(F.lds + 55296);
    const int d = F.tid & 127, qtr = F.tid >> 7;
    const HgConst HC = hg_const(RW.c, l);
    LDS_BARRIER();
    vt_store(VT, RW.v, F.tid);
    float* GG = (float*)(F.ws + WS_HGG);
    { HgPrep R; hg_prep<0>(F, HC, l, RW.zf, tot, R);
      const float G = (R.T[0] + R.T[1]) + (R.T[2] + R.T[3]);
      if (qtr == 0) GG[(size_t)(sidf * NTC + tc) * 128 + d] = G;
      float t[16];
#pragma unroll
      for (int i = 0; i < 16; i += 2) { const f32x2_t te = ((f32x2_t){R.x[i], R.x[i + 1]} - G) * (-1.44269504f);
          const f32x2_t kv = (f32x2_t){R.k[i], R.k[i + 1]} * (f32x2_t){__builtin_amdgcn_exp2f(te.x), __builtin_amdgcn_exp2f(te.y)}; t[i] = kv.x; t[i + 1] = kv.y; }
      put16(KT + d * ST64 + qtr * 32, t); }
    { HgPrep R; hg_prep<1>(F, HC, l, RW.zb, tot, R);
      const float G = (R.T[0] + R.T[1]) + (R.T[2] + R.T[3]);
      if (qtr == 0) GG[(size_t)((sidf + 1) * NTC + tc) * 128 + d] = G;
      float t[16];
#pragma unroll
      for (int i = 0; i < 16; i += 2) { const f32x2_t te = (f32x2_t){R.x[i], R.x[i + 1]} * 1.44269504f;
          const f32x2_t kv = (f32x2_t){R.k[i], R.k[i + 1]} * (f32x2_t){__builtin_amdgcn_exp2f(te.x), __builtin_amdgcn_exp2f(te.y)}; t[i] = kv.x; t[i + 1] = kv.y; }
      put16(KT + 18432 + d * ST64 + qtr * 32, t); }
    LDS_BARRIER();
    { const int dir = F.wave >> 2, mt = F.wave & 3; bf16* S = (bf16*)(F.ws + WS_HGS) + (size_t)((sidf + dir) * NTC + tc) * 16384;
#pragma unroll
      for (int nt = 0; nt < 4; ++nt) { f32x16 acc;
#pragma unroll
          for (int i = 0; i < 16; ++i) acc[i] = 0.f;
          mm32<64>(acc, VT + 32 * mt * ST64, ST64, KT + dir * 18432 + 32 * nt * ST64, ST64, F.lane);
#pragma unroll
          for (int r = 0; r < 16; ++r) S[(32 * mt + rowmap(r, F.lane >> 5)) * 128 + 32 * nt + (F.lane & 31)] = (bf16)f2bf(acc[r]); } }
}
struct HgCRaw { VtRaw v; unsigned zf[16], q[16]; HgCRawC c; };
__device__ __forceinline__ void touch(HgCRaw& R) {
#pragma unroll
    for (int i = 0; i < 8; ++i) touch(R.v.w[i]);
#pragma unroll
    for (int i = 0; i < 16; ++i) { touch(R.zf[i]); touch(R.q[i]); } touch(R.c); }
__device__ __forceinline__ void hg_passC_load(Frame& F, CArgs& A, int l, int task, HgCRaw& R) {
    const TaskId T = task_id(task); const bf16* CQI = (const bf16*)(F.ws + WS_CQI); hg_const_load(F, A, l, T.h, R.c);
    vt_load(R.v, CQI, 1024, T.row0, 512 + T.h * 128, F.tid);
    hg_zload(F, T.h, T.row0, 0, R.zf);
    { const int d = F.tid & 127, qtr = F.tid >> 7;
#pragma unroll
      for (int i = 0; i < 16; ++i) R.q[i] = CQI[(size_t)(T.row0 + qtr * 16 + i) * 1024 + T.h * 128 + d]; }
}
__device__ __forceinline__ void hg_passC_run(Frame& F, CArgs& A, int l, int task, const HgCRaw& RW) {
    const TaskId T = task_id(task); const int h = T.h, tc = T.tc, row0 = T.row0, sidf = T.sidf;
    LAS unsigned char* VT = F.lds; LAS unsigned char* Ss = F.lds + 18432; LAS unsigned char* Qh = F.lds + 53248; LAS unsigned char* Kh = F.lds + 70656;
    LAS unsigned char* Qc = F.lds + 88064; LAS unsigned char* Kc = F.lds + 96768; LAS unsigned char* Qt = F.lds + 105472; LAS unsigned char* Am = F.lds + 122880;
    LAS float* tot = (LAS float*)(F.lds + 132096);
    const int tid = F.tid, lane = F.lane, d = tid & 127, qtr = tid >> 7;
    if (l == DEPTH - 1 && tc < 4) return;
    unsigned gate[16];
    const HgConst HC = hg_const(RW.c, l);
    unsigned zb[16]; hg_zload(F, h, row0, 1, zb);
    u32x4 sf[4], sb[4]; { const u32x4* sp = (const u32x4*)((const bf16*)(F.ws + WS_HGSB) + (size_t)(sidf * NTC + tc) * 16384 + (tid >> 2) * 128 + (tid & 3) * 32);
#pragma unroll
      for (int j = 0; j < 4; ++j) { sf[j] = sp[j]; sb[j] = sp[j + (size_t)NTC * 16384 * 2 / 16]; } }
    LDS_BARRIER();
    vt_store(VT, RW.v, tid);
    f32x16 acc;
#pragma unroll
    for (int i = 0; i < 16; ++i) acc[i] = 0.f;
#pragma unroll
    for (int dir = 0; dir < 2; ++dir) {
        HgPrep R;
        if (dir == 1) gate_load<1>(F, row0, h, gate);
        if (dir == 0) hg_prep<0>(F, HC, l, RW.zf, tot, R); else hg_prep<1>(F, HC, l, zb, tot, R);
        const float T0 = R.T[0], T1 = R.T[1], T2 = R.T[2], T3 = R.T[3];
        const float sg = dir == 0 ? 1.f : -1.f;
        const float rI = sg * ((qtr >> 1) == 0 ? T0 : (T0 + T1) + T2);
        const float rO = sg * (T0 + T1);
        const float Gall = (T0 + T1) + (T2 + T3);
        const bool isq = dir == 0 ? (qtr >= 2) : (qtr < 2);
        const float cO = __expf(isq ? rI - rO : rO - rI), cT = __expf(dir == 0 ? rI : Gall + rI);
        { const int v = tid >> 2, pc = tid & 3;
#pragma unroll
          for (int j = 0; j < 4; ++j) *(LAS u32x4*)(Ss + v * ST128 + pc * 64 + j * 16) = dir == 0 ? sf[j] : sb[j]; }
#pragma unroll
        for (int i = 0; i < 16; i += 2) {
            const int t = qtr * 16 + i;
            const f32x2_t x = dir == 0 ? (f32x2_t){R.x[i], R.x[i + 1]} : (f32x2_t){-R.x[i], -R.x[i + 1]}, kk = {R.k[i], R.k[i + 1]}, qv = {bf2f((unsigned short)RW.q[i]), bf2f((unsigned short)RW.q[i + 1])};
            const f32x2_t te = (x - rI) * 1.44269504f;
            const f32x2_t eh = {__builtin_amdgcn_exp2f(te.x), __builtin_amdgcn_exp2f(te.y)}, ehr = {__builtin_amdgcn_rcpf(eh.x), __builtin_amdgcn_rcpf(eh.y)};
            const f32x2_t qe = qv * eh, ke = kk * ehr, of = (isq ? qe : ke) * cO, qt = qe * cT;
            const unsigned wq = pk2(qe.x, qe.y), wk = pk2(ke.x, ke.y), wo = pk2(of.x, of.y), wt = pk2(qt.x, qt.y);
            *(LAS unsigned short*)(Qh + t * ST128 + d * 2) = (unsigned short)wq; *(LAS unsigned short*)(Qh + (t + 1) * ST128 + d * 2) = (unsigned short)(wq >> 16);
            *(LAS unsigned short*)(Kh + t * ST128 + d * 2) = (unsigned short)wk; *(LAS unsigned short*)(Kh + (t + 1) * ST128 + d * 2) = (unsigned short)(wk >> 16);
            LAS unsigned char* oc = isq ? Qc : Kc;
            *(LAS unsigned short*)(oc + (t & 31) * ST128 + d * 2) = (unsigned short)wo; *(LAS unsigned short*)(oc + ((t + 1) & 31) * ST128 + d * 2) = (unsigned short)(wo >> 16);
            *(LAS unsigned short*)(Qt + t * ST128 + d * 2) = (unsigned short)wt; *(LAS unsigned short*)(Qt + (t + 1) * ST128 + d * 2) = (unsigned short)(wt >> 16);
        }
        LDS_BARRIER();
        if (F.wave < 4) { f32x16 a;
#pragma unroll
            for (int i = 0; i < 16; ++i) a[i] = 0.f;
            int tt = 0, ts = 0;
            if (F.wave < 2) { tt = ts = F.wave; mm32<128>(a, Qh + 32 * tt * ST128, ST128, Kh + 32 * ts * ST128, ST128, lane);
#pragma unroll
                for (int r = 0; r < 16; ++r) { const int tl = rowmap(r, lane >> 5), sl = lane & 31; const bool ok = dir == 0 ? (sl <= tl) : (sl >= tl); a[r] = ok ? a[r] : 0.f; } }
            else if (F.wave == 2) { tt = dir == 0 ? 1 : 0; ts = 1 - tt; mm32<128>(a, Qc, ST128, Kc, ST128, lane); }
            else { tt = dir == 0 ? 0 : 1; ts = 1 - tt; }
#pragma unroll
            for (int r = 0; r < 16; r += 2) { const unsigned w = pk2(a[r], a[r + 1]); *(LAS unsigned short*)(Am + (32 * tt + rowmap(r, lane >> 5)) * ST64 + (32 * ts + (lane & 31)) * 2) = (unsigned short)w;
                *(LAS unsigned short*)(Am + (32 * tt + rowmap(r + 1, lane >> 5)) * ST64 + (32 * ts + (lane & 31)) * 2) = (unsigned short)(w >> 16); } }
        LDS_BARRIER();
        { const int mt = F.wave >> 2, nt = F.wave & 3;
          mm32<64>(acc, Am + 32 * mt * ST64, ST64, VT + 32 * nt * ST64, ST64, lane);
          mm32<128>(acc, Qt + 32 * mt * ST128, ST128, Ss + 32 * nt * ST128, ST128, lane); }
        if (dir == 0) LDS_BARRIER();
    }
    const float ng = A.in[I_HGNG][l * 512 + h * 128 + 32 * (F.wave & 3) + (lane & 31)];
    head_epilogue<1>(F, ng, acc, gate, (LAS float*)(F.lds + 136192), row0, h);
}
__device__ __forceinline__ int ml_ntask(int vcu, int G) { return G == 256 ? (vcu < 32 ? 5 : (vcu < 64 ? 3 : (vcu < 96 ? 5 : 4))) : (vcu < 8 * NTC ? (8 * NTC - vcu + G - 1) / G : 0); }
__device__ __forceinline__ int ml_taskid(int vcu, int G, int i) { if (G != 256) return vcu + G * i; return i < 4 ? vcu + 256 * i : (vcu < 32 ? vcu + 1024 : vcu - 32 + 768); }
#define TASK_LOOP_ML(RAW, LOADFN, RUNFN) do { const int nt_ = ml_ntask(F.vcu, F.G); RAW cur_; if (nt_ > 0) { LOADFN(ml_taskid(F.vcu, F.G, 0), cur_); } \
    for (int i_ = 0; i_ < nt_; ++i_) { touch(cur_); RAW nxt_; if (i_ + 1 < nt_) { LOADFN(ml_taskid(F.vcu, F.G, i_ + 1), nxt_); } else nxt_ = cur_; RUNFN(ml_taskid(F.vcu, F.G, i_), cur_); cur_ = nxt_; } } while (0)
__device__ __forceinline__ int lat_task(int c) { return (c >> 7) * NTC + 4 + (c & 127); }
#define TASK_LOOP_LAT(RAW, LOADFN, RUNFN) do { RAW cur_; LOADFN(lat_task(F.vcu), cur_); \
    for (int i_ = 0; i_ < 4; ++i_) { touch(cur_); RAW nxt_; if (i_ + 1 < 4) { LOADFN(lat_task(F.vcu + 256 * (i_ + 1)), nxt_); } else nxt_ = cur_; RUNFN(lat_task(F.vcu + 256 * i_), cur_); cur_ = nxt_; } } while (0)
#define TASK_LOOP(RAW, LOADFN, RUNFN, T0, T1) do { int t_ = F.vcu; while (t_ < (T0)) t_ += F.G; RAW cur_; if (t_ < (T1)) { LOADFN(t_ - (T0), cur_); } \
    for (; t_ < (T1); t_ += F.G) { touch(cur_); RAW nxt_; if (t_ + F.G < (T1)) { LOADFN(t_ + F.G - (T0), nxt_); } else nxt_ = cur_; RUNFN(t_ - (T0), cur_); cur_ = nxt_; } } while (0)

__device__ __forceinline__ void transpose_item(const float* W, int ldw, int K, gbf16* WT, int k0, int n0, int drow0, LAS float* scr, int lane) {
    const int n4 = (lane & 7) * 4, kr = lane >> 3;
    f32x4 v[8];
#pragma unroll
    for (int i = 0; i < 8; ++i) v[i] = __builtin_nontemporal_load((const f32x4*)(W + (size_t)(k0 + 8 * i + kr) * ldw + n0 + n4));
#pragma unroll
    for (int i = 0; i < 8; ++i) { LAS float* p = scr + (8 * i + kr) * 33 + n4; p[0] = v[i].x; p[1] = v[i].y; p[2] = v[i].z; p[3] = v[i].w; }
    asm volatile("s_waitcnt lgkmcnt(0)" ::: "memory");
    const int c = lane & 7;
#pragma unroll
    for (int j = 0; j < 4; ++j) { const int n = (lane >> 3) + 8 * j; const LAS float* s = scr + (8 * c) * 33 + n;
        u32x4 o; o.x = pk2(s[0 * 33], s[1 * 33]); o.y = pk2(s[2 * 33], s[3 * 33]); o.z = pk2(s[4 * 33], s[5 * 33]); o.w = pk2(s[6 * 33], s[7 * 33]);
        *(u32x4*)(WT + (size_t)(drow0 + n) * K + k0 + 8 * c) = o; }
    asm volatile("s_waitcnt lgkmcnt(0)" ::: "memory");
}
__device__ __forceinline__ void ph_convert(Frame& F, CArgs& A, bool small_only) {
    LAS float* scr = (LAS float*)(F.lds + 32768 + F.wave * 8448);
    const int gw = F.vcu * NWAVES + F.wave, NGW = F.G * NWAVES;
    constexpr int I_IN = DEPTH * 16 * 128, I_OUT = DEPTH * 16 * 32, I_GU = DEPTH * NEXP * 16 * 64, I_DN = DEPTH * NEXP * 16 * 32;
    for (int it = gw; it < (small_only ? I_IN + I_OUT : I_IN + I_OUT + I_GU + I_DN); it += NGW) {
        int r = it;
        if (r < I_IN) { const int l = r / 2048, q = r % 2048, kb = q / 128, nb = q % 128, d0 = nb * 32, n0 = d0 < 1536 ? d0 : d0 + 16;
            transpose_item(A.in[I_WIN] + (size_t)l * D * INW, INW, D, (gbf16*)(F.ws + WS_WIN) + (size_t)l * PW * D, kb * 64, n0, d0, scr, F.lane); continue; }
        r -= I_IN;
        if (r < I_OUT) { const int l = r / 512, q = r % 512, kb = q / 32, nb = q % 32;
            transpose_item(A.in[I_WOUT] + (size_t)l * D * D, D, D, (gbf16*)(F.ws + WS_WOUT) + (size_t)l * D * D, kb * 64, nb * 32, nb * 32, scr, F.lane); continue; }
        r -= I_OUT;
        if (r < I_GU) { const int m = r / 1024, q = r % 1024, kb = q / 64, nb = q % 64, n0 = nb * 32;
            const int cc = n0 & 1023, d0 = (cc >> 7) * 256 + (n0 >= 1024 ? 128 : 0) + (cc & 127);
            transpose_item(A.in[I_WGU] + (size_t)m * D * 2048, 2048, D, (gbf16*)(F.ws + WS_WGU) + (size_t)m * 2048 * D, kb * 64, n0, d0, scr, F.lane); continue; }
        r -= I_GU;
        { const int m = r / 512, q = r % 512, kb = q / 32, nb = q % 32;
            transpose_item(A.in[I_WDN] + (size_t)m * DEXP * D, D, DEXP, (gbf16*)(F.ws + WS_WDN) + (size_t)m * D * DEXP, kb * 64, nb * 32, nb * 32, scr, F.lane); }
    }
}


constexpr int CV_NJ = 384;
__device__ __forceinline__ void moe_item_addr(CArgs& A, unsigned char* ws, int item, const float*& W, int& ldw, bf16*& WT, int& k0, int& n0, int& d0) {
    const int l = item / 49152, r = item % 49152;
    if (r < 32768) { const int e = r >> 10, q = r & 1023, kb = q >> 6, nb = q & 63; n0 = nb * 32; const int cc = n0 & 1023; d0 = (cc >> 7) * 256 + (n0 >= 1024 ? 128 : 0) + (cc & 127); k0 = kb * 64;
        W = A.in[I_WGU] + (size_t)(l * NEXP + e) * D * 2048; ldw = 2048; WT = (bf16*)(ws + WS_WGU) + (size_t)(l * NEXP + e) * 2048 * D; }
    else { const int r2 = r - 32768, e = r2 >> 9, q = r2 & 511, kb = q >> 5, nb = q & 31; n0 = nb * 32; d0 = n0; k0 = kb * 64;
        W = A.in[I_WDN] + (size_t)(l * NEXP + e) * DEXP * D; ldw = D; WT = (bf16*)(ws + WS_WDN) + (size_t)(l * NEXP + e) * D * DEXP; }
}
__device__ __forceinline__ void transpose_store(gbf16* WT, int K, int k0, int d0, LAS float* scr, const f32x4 (&v)[8], int lane) {
    const int n4 = (lane & 7) * 4, kr = lane >> 3;
#pragma unroll
    for (int i = 0; i < 8; ++i) { LAS float* p = scr + (8 * i + kr) * 33 + n4; p[0] = v[i].x; p[1] = v[i].y; p[2] = v[i].z; p[3] = v[i].w; }
    asm volatile("s_waitcnt lgkmcnt(0)" ::: "memory");
    const int c = lane & 7;
#pragma unroll
    for (int j = 0; j < 4; ++j) { const int n = (lane >> 3) + 8 * j; const LAS float* sp = scr + (8 * c) * 33 + n;
        u32x4 o; o.x = pk2(sp[0 * 33], sp[1 * 33]); o.y = pk2(sp[2 * 33], sp[3 * 33]); o.z = pk2(sp[4 * 33], sp[5 * 33]); o.w = pk2(sp[6 * 33], sp[7 * 33]);
        *(u32x4*)(WT + (size_t)(d0 + n) * K + k0 + 8 * c) = o; }
    asm volatile("s_waitcnt lgkmcnt(0)" ::: "memory");
}
__device__ __forceinline__ void convert_moe_all(gas_u8* ws, LAS unsigned char* lds, CArgs& A, int cw, int nw, int wave, int lane, int it_lo = 0, int it_hi = 49152) {
    LAS float* scr = (LAS float*)(lds + wave * 16640);
    const int n4 = (lane & 15) * 4, kr = lane >> 4;
    for (int it = it_lo + cw; it < it_hi; it += 2 * nw) {
        const float* W[2]; gbf16* WT[2]; int ldw[2], k0[2], n0[2], d0[2];
        const bool two = it + nw < it_hi;
#pragma unroll
        for (int u = 0; u < 2; ++u) { const int iu = (u == 1 && two) ? it + nw : it; const int le = iu / 768, r = iu % 768;
            if (r < 512) { const int kb = r >> 5, nb = r & 31; k0[u] = kb * 64; n0[u] = nb * 64; const int cc = n0[u] & 1023; d0[u] = (cc >> 7) * 256 + (n0[u] >= 1024 ? 128 : 0) + (cc & 127);
                W[u] = A.in[I_WGU] + (size_t)le * D * 2048; ldw[u] = 2048; WT[u] = (gbf16*)(ws + WS_WGU) + (size_t)le * 2048 * D; }
            else { const int q = r - 512, kb = q >> 4, nb = q & 15; k0[u] = kb * 64; n0[u] = nb * 64; d0[u] = n0[u];
                W[u] = A.in[I_WDN] + (size_t)le * DEXP * D; ldw[u] = D; WT[u] = (gbf16*)(ws + WS_WDN) + (size_t)le * D * DEXP; } }
        f32x4 v[2][16];
#pragma unroll
        for (int u = 0; u < 2; ++u)
#pragma unroll
            for (int i = 0; i < 16; ++i) v[u][i] = __builtin_nontemporal_load((const f32x4*)(W[u] + (size_t)(k0[u] + 4 * i + kr) * ldw[u] + n0[u] + n4));
#pragma unroll
        for (int u = 0; u < 2; ++u) { if (u == 1 && !two) break;
#pragma unroll
            for (int i = 0; i < 16; ++i) { LAS float* p = scr + (4 * i + kr) * 65 + n4; p[0] = v[u][i].x; p[1] = v[u][i].y; p[2] = v[u][i].z; p[3] = v[u][i].w; }
            asm volatile("s_waitcnt lgkmcnt(0)" ::: "memory");
            const int c = lane & 7;
#pragma unroll
            for (int j = 0; j < 8; ++j) { const int n = (lane >> 3) + 8 * j; const LAS float* sp = scr + (8 * c) * 65 + n;
                u32x4 o; o.x = pk2(sp[0 * 65], sp[1 * 65]); o.y = pk2(sp[2 * 65], sp[3 * 65]); o.z = pk2(sp[4 * 65], sp[5 * 65]); o.w = pk2(sp[6 * 65], sp[7 * 65]);
                __builtin_nontemporal_store(o, (__attribute__((address_space(1))) u32x4*)(WT[u] + (size_t)(d0[u] + n) * 1024 + k0[u] + 8 * c)); }
            asm volatile("s_waitcnt lgkmcnt(0)" ::: "memory"); }
    }
}
__device__ __forceinline__ void convert_moe(unsigned char* ws, LAS unsigned char* lds, CArgs& A, int cw, int wave, int lane, int j0, int j1) {
    LAS float* scr = (LAS float*)(lds + wave * 8448);
    const int n4 = (lane & 7) * 4, kr = lane >> 3;
    for (int j = j0; j < j1; j += 2) {
        const float* W0; const float* W1; bf16* T0; bf16* T1; int l0, l1, ka, kb_, na, nb_, da, db;
        moe_item_addr(A, ws, cw + 256 * j, W0, l0, T0, ka, na, da);
        const bool two = j + 1 < j1; moe_item_addr(A, ws, cw + 256 * (two ? j + 1 : j), W1, l1, T1, kb_, nb_, db);
        f32x4 v0[8], v1[8];
#pragma unroll
        for (int i = 0; i < 8; ++i) v0[i] = __builtin_nontemporal_load((const f32x4*)(W0 + (size_t)(ka + 8 * i + kr) * l0 + na + n4));
#pragma unroll
        for (int i = 0; i < 8; ++i) v1[i] = __builtin_nontemporal_load((const f32x4*)(W1 + (size_t)(kb_ + 8 * i + kr) * l1 + nb_ + n4));
        transpose_store((gbf16*)T0, 1024, ka, da, scr, v0, lane);
        if (two) transpose_store((gbf16*)T1, 1024, kb_, db, scr, v1, lane);
    }
}

#define XB_TMO      128
#define XB_XCNT(j)  (256  + 64 * (j))
#define XB_XSUB(j)  (1280 + 64 * (j))
#define XB_XGEN(j)  (2304 + 64 * (j))
#define XB_TOP      3328
#define XB_TOPGEN   3392
#define XCD_BAR_WORDS 3456
#define XB_SPIN_CAP (1u << 18)
__device__ __forceinline__ unsigned xb_ld(unsigned* p)              { return __hip_atomic_load(p, __ATOMIC_RELAXED, __HIP_MEMORY_SCOPE_AGENT); }
__device__ __forceinline__ unsigned xb_add(unsigned* p, unsigned v) { return __hip_atomic_fetch_add(p, v, __ATOMIC_RELAXED, __HIP_MEMORY_SCOPE_AGENT); }
__device__ __forceinline__ unsigned xb_xcc_id() { return (unsigned)__builtin_amdgcn_s_getreg((3 << 11) | 20) & 0xFu; }
#define XB_SPIN(cond, bar) do { unsigned _sp = 0; while (cond) { __builtin_amdgcn_s_sleep(1); \
    if ((++_sp & 255u) == 0u) { if (xb_ld(&(bar)[XB_TMO])) break; if (_sp > XB_SPIN_CAP) { atomicAdd(&(bar)[XB_TMO], 1u); break; } } } } while (0)
struct XcdBarrier { unsigned* bar; unsigned x; volatile LAS unsigned* st; };
__device__ __forceinline__ XcdBarrier xcd_barrier_post(unsigned* bar, volatile LAS unsigned* st) {
    XcdBarrier b; b.bar = bar; b.x = xb_xcc_id(); b.st = st;
    if (threadIdx.x == 0) (void)xb_add(&bar[XB_XCNT(b.x)], 1u);
    return b;
}
__device__ __forceinline__ void xcd_barrier_complete(unsigned* bar, unsigned x, unsigned& nloc, unsigned& nx) {
    const unsigned G = gridDim.x * gridDim.y * gridDim.z;
    unsigned sum, cnt, mine, sp = 0u;
    for (;;) {
        sum = 0u; cnt = 0u; mine = 0u;
#pragma unroll
        for (unsigned j = 0; j < 16; ++j) { const unsigned c = xb_ld(&bar[XB_XCNT(j)]); sum += c; cnt += (c > 0u) ? 1u : 0u; mine = (j == x) ? c : mine; }
        if (sum == G) break;
        __builtin_amdgcn_s_sleep(1);
        if ((++sp & 255u) == 0u) { if (xb_ld(&bar[XB_TMO])) break; if (sp > XB_SPIN_CAP) { atomicAdd(&bar[XB_TMO], 1u); break; } }
    }
    nloc = mine > 0u ? mine : 1u; nx = cnt > 0u ? cnt : 1u;
}
__device__ __forceinline__ int lane_now() { int l; asm volatile("v_mbcnt_lo_u32_b32 %0, -1, 0\n\tv_mbcnt_hi_u32_b32 %0, -1, %0" : "=v"(l)); return l; }
__device__ __forceinline__ void xcd_barrier(const XcdBarrier& b, int wv) {
    asm volatile("s_waitcnt vmcnt(0)" ::: "memory");
    __syncthreads();
    if (wv * 64 + lane_now() == 0) {
        unsigned* bar = b.bar;
        __builtin_amdgcn_s_waitcnt(0);
        unsigned nloc = b.st[0], nx = b.st[1];
        if (nloc == 0u) { xcd_barrier_complete(bar, b.x, nloc, nx); b.st[0] = nloc; b.st[1] = nx; }
        const unsigned old = xb_add(&bar[XB_XSUB(b.x)], 1u);
        const unsigned gen = old / nloc;
        if (old + 1u == (gen + 1u) * nloc) {
            __builtin_amdgcn_fence(__ATOMIC_RELEASE, "agent");
            asm volatile("s_waitcnt vmcnt(0)" ::: "memory");
            const unsigned og = xb_add(&bar[XB_TOP], 1u);
            const unsigned tg = og / nx;
            if (og + 1u == (tg + 1u) * nx) xb_add(&bar[XB_TOPGEN], 1u);
            else XB_SPIN(xb_ld(&bar[XB_TOPGEN]) == tg, bar);
            __builtin_amdgcn_fence(__ATOMIC_ACQUIRE, "agent");
            xb_add(&bar[XB_XGEN(b.x)], 1u);
            asm volatile("s_waitcnt vmcnt(0)" ::: "memory");
        } else {
            XB_SPIN(xb_ld(&bar[XB_XGEN(b.x)]) == gen, bar);
            __builtin_amdgcn_fence(__ATOMIC_ACQUIRE, "agent");
            asm volatile("s_waitcnt vmcnt(0)" ::: "memory");
        }
    }
    __syncthreads();
}

enum { PH_INIT = 0, PH_NORM1, PH_INPROJ, PH_CONV, PH_SCANA, PH_SCANB, PH_SCANC, PH_HNORM, PH_OUTPROJ, PH_NORM2, PH_LISTS, PH_GU, PH_DOWN, PH_COMBINE, PH_FINAL };

constexpr int NPHASE = 1 + 13 * DEPTH;
template <int ph, int l>
__device__ __forceinline__ void run_phase(LAS unsigned char* lds_raw, int wv) {
    int tid_ = wv * 64 + lane_now(); asm volatile("" : "+v"(tid_));
    CArgs* ap_ = (CArgs*)__builtin_amdgcn_kernarg_segment_ptr(); asm volatile("" : "+s"(ap_));
    CArgs& A_ = *ap_;
    unsigned char* ws_ = A_.ws; asm volatile("" : "+s"(ws_));
    unsigned lb_ = 0u, bx_ = blockIdx.x, gx_ = gridDim.x; asm volatile("" : "+s"(lb_), "+s"(bx_), "+s"(gx_));
    Frame F; F.lds = lds_raw + lb_; F.out = A_.out; F.ws = (gas_u8*)ws_;
    F.tid = tid_; F.lane = F.tid & 63; F.wave = __builtin_amdgcn_readfirstlane(F.tid >> 6);
    F.G = (int)gx_; { const int bx = (int)bx_; F.vcu = (F.G % 8 == 0) ? (bx % 8) * (F.G / 8) + bx / 8 : bx; }
    constexpr int nrows = (l == DEPTH - 1) ? NLAT : NTOK;
    constexpr bool CVPH = (l == 0) && (ph <= PH_LISTS);
    constexpr int CQ0 = ph == PH_INIT ? 0 : ph == PH_NORM1 ? 25 : ph == PH_INPROJ ? 55 : ph == PH_CONV ? 140 : ph == PH_SCANA ? 165 : ph == PH_SCANB ? 205 : ph == PH_SCANC ? 233 : ph == PH_OUTPROJ ? 313 : ph == PH_NORM2 ? 344 : 378;
    constexpr int CQ1 = ph == PH_INIT ? 25 : ph == PH_NORM1 ? 55 : ph == PH_INPROJ ? 140 : ph == PH_CONV ? 165 : ph == PH_SCANA ? 205 : ph == PH_SCANB ? 233 : ph == PH_SCANC ? 313 : ph == PH_OUTPROJ ? 344 : ph == PH_NORM2 ? 378 : CV_NJ;
    const bool cvgrid = false;
    if (CVPH && cvgrid) {
        if (bx_ >= 224u) { const int cvcu = (int)(bx_ & 7u) * 4 + ((int)(bx_ >> 3) - 28); convert_moe(ws_, F.lds, A_, cvcu * 8 + F.wave, F.wave, F.lane, CQ0, CQ1); return; }
        F.G = 224; F.vcu = (int)(bx_ & 7u) * 28 + (int)(bx_ >> 3); gx_ = 224u;
    }
    switch (ph) {
        case PH_INIT: ph_init(F, A_); ph_convert(F, A_, true); break;
        case PH_INPROJ: {
            const bool cfirst = ((bx_ >> 3) & 1u) == 0u;
            int base, nblk;
            if (F.G == 256 && l == 0) { if (bx_ >= 32u) { const int ix = (int)bx_ - 32; nblk = 74 + (ix < 16 ? 1 : 0); base = ix * 74 + (ix < 16 ? ix : 16); } else { base = 16592 + (int)bx_ * 48; nblk = 48; } }
            else if (F.G == 256) { if (bx_ >= 32u) { base = ((int)bx_ - 32) * 100; nblk = 100; } else { base = 22400 + (int)bx_ * 68; nblk = 68; } }
            else { const int per = (24576 + F.G - 1) / F.G; base = F.vcu * per; nblk = base + per <= 24576 ? per : (base < 24576 ? 24576 - base : 0); }
            base += l * 24576;
            if (cfirst) { convert_moe_all(F.ws, F.lds, A_, F.wave, NWAVES, F.wave, F.lane, base, base + nblk); __syncthreads(); }
            { pg8::Gemm g{(const bf16*)(F.ws + WS_H), (const bf16*)(F.ws + WS_WIN) + (size_t)l * PW * D, D, nullptr, nullptr, 0};
              pg8::StaticOrder S; S.init(NTOK / 256, PW / 256, F.G, (int)bx_); pg8::EpiBf16 E{(bf16*)(F.ws + WS_P), PW};
              pg8::gemm_phase<pg8::EpiBf16, pg8::StaticOrder, true>(F.lds, g, S, E, F.tid); }
            if (!cfirst) { __syncthreads(); convert_moe_all(F.ws, F.lds, A_, F.wave, NWAVES, F.wave, F.lane, base, base + nblk); }
        } break;
        case PH_NORM1: if (l == 0) ph_rows<1, 0>(F, A_, 0, 0, NTOK); break;
        case PH_CONV: ph_conv(F, A_, l); break;
        case PH_SCANA: {
#define LD_(t, R) ml_passA_load(F, t, R)
#define RN_(t, R) ml_passA_run(F, t, R)
            TASK_LOOP_ML(MlARaw, LD_, RN_);
#undef LD_
#undef RN_
#define LD_(t, R) hg_passA_load(F, A_, l, t, R)
#define RN_(t, R) hg_passA_run(F, A_, l, t, R)
            TASK_LOOP(HgARaw, LD_, RN_, 8 * NTC, 16 * NTC);
#undef LD_
#undef RN_
        } break;
        case PH_SCANB: scan_passB(F); break;
        case PH_SCANC: {
#define LD_(t, R) ml_passC_load(F, A_, l, t, R)
#define RN_(t, R) ml_passC_run(F, A_, l, t, R)
            if (l == DEPTH - 1 && F.G == 256) TASK_LOOP_LAT(MlCRaw, LD_, RN_); else TASK_LOOP_ML(MlCRaw, LD_, RN_);
#undef LD_
#undef RN_
#define LD_(t, R) hg_passC_load(F, A_, l, t, R)
#define RN_(t, R) hg_passC_run(F, A_, l, t, R)
            if (l == DEPTH - 1 && F.G == 256) TASK_LOOP_LAT(HgCRaw, LD_, RN_); else TASK_LOOP(HgCRaw, LD_, RN_, 8 * NTC, 16 * NTC);
#undef LD_
#undef RN_
        } break;
        case PH_OUTPROJ: { pg8::Gemm g{(const bf16*)(F.ws + WS_Y), (const bf16*)(F.ws + WS_WOUT) + (size_t)l * D * D, D, nullptr, nullptr, 0};
            pg8::StaticOrder S; S.init(nrows / 256, D / 256, F.G, (int)bx_);
            const float* xs = (const float*)(F.ws + WS_X);
            (void)xs; pg8::EpiBf16 E{(bf16*)(F.ws + WS_HF), D};
            pg8::gemm_phase<pg8::EpiBf16, pg8::StaticOrder, true>(F.lds, g, S, E, F.tid);
            if (l == 0 && F.G == 256 && bx_ >= 8u) { __syncthreads(); const int base = 18128 + ((int)bx_ - 8) * 26; convert_moe_all(F.ws, F.lds, A_, F.wave, NWAVES, F.wave, F.lane, base, base + 26); } } break;
        case PH_GU: { const int* rt = (const int*)(F.ws + WS_ROUTE); const int ntile = rt[RT_TILEE];
            pg8::Gemm g{(const bf16*)(F.ws + WS_H), (const bf16*)(F.ws + WS_WGU) + (size_t)l * NEXP * 2048 * D, D, rt + RT_LIST, rt + RT_TILEE, (size_t)2048 * D};
            pg8::StaticOrder S; S.init(ntile, 2048 / 256, F.G, (int)bx_);
            pg8::EpiSwiglu E{(bf16*)(F.ws + WS_ACT), A_.in[I_BGU] + (size_t)l * NEXP * 2048, rt + RT_TILEE};
            pg8::gemm_phase<pg8::EpiSwiglu, pg8::StaticOrder, true>(F.lds, g, S, E, F.tid); } break;
        case PH_DOWN: { const int* rt = (const int*)(F.ws + WS_ROUTE); const int ntile = rt[RT_TILEE];
            pg8::Gemm g{(const bf16*)(F.ws + WS_ACT), (const bf16*)(F.ws + WS_WDN) + (size_t)l * NEXP * D * DEXP, DEXP, nullptr, rt + RT_TILEE, (size_t)D * DEXP};
            pg8::StaticOrder S; S.init(ntile, D / 256, F.G, (int)bx_);
            pg8::EpiDown E{(bf16*)(F.ws + WS_YS), A_.in[I_BDN] + (size_t)l * NEXP * D, (const float*)(rt + RT_SGATE), rt + RT_TILEE};
            pg8::gemm_phase<pg8::EpiDown, pg8::StaticOrder, true>(F.lds, g, S, E, F.tid); } break;
        case PH_HNORM: ph_hnorm(F, A_, l, l == DEPTH - 1); break;
        case PH_NORM2: ph_rows<3, 1>(F, A_, l, l, nrows); break;
        case PH_LISTS: ph_lists(F, A_, l, nrows); break;
        case PH_COMBINE: if (l == DEPTH - 1) ph_rows<2, 2>(F, A_, l, 0, NLAT); else ph_rows<2, 0>(F, A_, l, l + 1, NTOK); break;
        default: break;
    }
}
__global__ void __launch_bounds__(NTHR, 2) fwd(Args a) {
    extern __shared__ __attribute__((aligned(16))) unsigned char lds_raw[];
    volatile LAS unsigned* bst = (volatile LAS unsigned*)((LAS unsigned char*)lds_raw + LDS_BYTES - 64);
    if (threadIdx.x < 16) bst[threadIdx.x] = 0u;
    __syncthreads();
    XcdBarrier bar = xcd_barrier_post((unsigned*)(a.ws + WS_CTL) + CW_BAR, bst);
    int wv_ = __builtin_amdgcn_readfirstlane((int)(threadIdx.x >> 6)); asm volatile("" : "+s"(wv_));
#ifndef TPROBE
#define TPROBE 0
#endif
#ifndef TP0
#define TP0 0
#define TP1 0
#define TP2 0
#define TD0 800
#define TD1 800
#define TD2 800
#endif
    unsigned ta0 = 0u, ta1 = 0u, ta2 = 0u; unsigned long long tprev = 0;
    const bool stamper = TPROBE && blockIdx.x == 0;
    if (stamper) tprev = __builtin_amdgcn_s_memrealtime();
#define RUN(pi, ph, l) do { run_phase<ph, l>((LAS unsigned char*)lds_raw, wv_); if ((pi) != NPHASE - 1 || TPROBE) xcd_barrier(bar, wv_); \
    if (stamper) { const unsigned long long tn = __builtin_amdgcn_s_memrealtime(); const unsigned dt = (unsigned)(tn - tprev); tprev = tn; \
        if ((ph) == TP0) ta0 += dt; if ((ph) == TP1) ta1 += dt; if ((ph) == TP2) ta2 += dt; } } while (0)
#define LAYER(l) if (l == 0) RUN(1 + 13 * l, PH_NORM1, l); RUN(2 + 13 * l, PH_INPROJ, l); RUN(3 + 13 * l, PH_CONV, l); RUN(4 + 13 * l, PH_SCANA, l); RUN(5 + 13 * l, PH_SCANB, l); RUN(6 + 13 * l, PH_SCANC, l); \
    RUN(8 + 13 * l, PH_OUTPROJ, l); RUN(9 + 13 * l, PH_NORM2, l); RUN(10 + 13 * l, PH_LISTS, l); RUN(11 + 13 * l, PH_GU, l); RUN(12 + 13 * l, PH_DOWN, l); RUN(13 + 13 * l, PH_COMBINE, l)
    RUN(0, PH_INIT, 0);
    LAYER(0);
    LAYER(1);
#undef LAYER
#undef RUN
    if (TPROBE) {
        if (stamper) { const unsigned long long tn = __builtin_amdgcn_s_memrealtime();
            unsigned q0 = (ta0 + TD0 / 2) / TD0, q1 = (ta1 + TD1 / 2) / TD1, q2 = (ta2 + TD2 / 2) / TD2;
            q0 = q0 > 31u ? 31u : q0; q1 = q1 > 31u ? 31u : q1; q2 = q2 > 31u ? 31u : q2;
            const unsigned long long delay = (unsigned long long)(q0 + 32u * q1 + 1024u * q2) * 1600ull;
            while (__builtin_amdgcn_s_memrealtime() - tn < delay) __builtin_amdgcn_s_sleep(8);
        }
    }
}

template <int NB, class Epi>
__global__ void __launch_bounds__(256) naive_gemm(const bf16* A, int lda, const int* gather, const int* tile_e, int M, const float* B, size_t bexp, int ldb, int N, int K, int bshift_from, int bshift, int bgrp, Epi E) {
    __shared__ float As[16][68]; __shared__ float Bs[NB][16][68];
    const int m0 = blockIdx.y * 64, n0 = blockIdx.x * 64, tid = threadIdx.x, tx = tid & 15, ty = tid >> 4;
    int e = 0;
    if (tile_e) { const int nt = tile_e[0]; if (m0 >= nt * 256) return; e = tile_e[8 + (m0 >> 8)]; } else if (m0 >= M) return;
    const float* Bp = B + (size_t)e * bexp + (n0 + (n0 >= bshift_from ? bshift : 0));
    const int ar = tid >> 2, ak = (tid & 3) * 4; const int arow = gather ? gather[m0 + ar] : (m0 + ar);
    const bf16* Ap = A + (size_t)arow * lda + ak;
    const int bk = tid >> 4, bn = (tid & 15) * 4;
    float acc[NB][4][4];
#pragma unroll
    for (int g = 0; g < NB; ++g)
#pragma unroll
        for (int i = 0; i < 4; ++i)
#pragma unroll
            for (int j = 0; j < 4; ++j) acc[g][i][j] = 0.f;
    for (int k0 = 0; k0 < K; k0 += 16) {
        const u32x2 av = *(const u32x2*)(Ap + k0);
        As[ak + 0][ar] = bflo(av.x); As[ak + 1][ar] = bfhi(av.x); As[ak + 2][ar] = bflo(av.y); As[ak + 3][ar] = bfhi(av.y);
#pragma unroll
        for (int g = 0; g < NB; ++g) { const f32x4 bv = *(const f32x4*)(Bp + (size_t)(k0 + bk) * ldb + g * bgrp + bn); *(f32x4*)&Bs[g][bk][bn] = bv; }
        __syncthreads();
#pragma unroll
        for (int k = 0; k < 16; ++k) { const f32x4 a4 = *(const f32x4*)&As[k][ty * 4];
#pragma unroll
            for (int g = 0; g < NB; ++g) { const f32x4 b4 = *(const f32x4*)&Bs[g][k][tx * 4];
#pragma unroll
                for (int i = 0; i < 4; ++i) { acc[g][i][0] += a4[i] * b4[0]; acc[g][i][1] += a4[i] * b4[1]; acc[g][i][2] += a4[i] * b4[2]; acc[g][i][3] += a4[i] * b4[3]; } } }
        __syncthreads();
    }
#pragma unroll
    for (int i = 0; i < 4; ++i)
#pragma unroll
        for (int j = 0; j < 4; ++j) E(m0 + ty * 4 + i, n0 + tx * 4 + j, acc[0][i][j], NB == 2 ? acc[NB - 1][i][j] : 0.f, e);
}
struct EpiP { bf16* P; __device__ void operator()(int r, int c, float v, float, int) const { P[(size_t)r * PW + c] = (bf16)f2bf(v); } };
struct EpiOut { float* X; const float* MOD; __device__ void operator()(int r, int c, float v, float, int) const { X[(size_t)r * D + c] += MOD[mrow_of(r) * 6144 + 2048 + c] * v; } };
struct EpiGU { bf16* ACT; const float* bgu; __device__ void operator()(int r, int c, float g, float li, int e) const {
    g += bgu[(size_t)e * 2048 + c]; li += bgu[(size_t)e * 2048 + 1024 + c]; g = fminf(g, 7.f); li = fminf(fmaxf(li, -7.f), 7.f);
    ACT[(size_t)r * DEXP + c] = (bf16)f2bf(g * sigmoidf_(1.702f * g) * (li + 1.f)); } };
struct EpiDown { bf16* YS; const float* bdn; const float* sgate; __device__ void operator()(int r, int c, float v, float, int e) const { YS[(size_t)r * D + c] = (bf16)f2bf((v + bdn[(size_t)e * D + c]) * sgate[r]); } };

__global__ void __launch_bounds__(128) naive_mlstm(const bf16* CQK, const bf16* P, const float* GATES, float* HF, float* HB) {
    __shared__ float qs[8][64], ks[8][64];
    const int b = blockIdx.x >> 3, h = (blockIdx.x >> 1) & 3, dir = blockIdx.x & 1, tid = threadIdx.x;
    float C[64], n[64], m = 0.f;
#pragma unroll
    for (int d = 0; d < 64; ++d) { C[d] = 0.f; n[d] = 0.f; }
    float* OUT = dir ? HB : HF;
    for (int p0 = 0; p0 < CTX + SEQ; p0 += 8) {
        __syncthreads();
        { const int st = tid >> 4, pc = tid & 15, p = p0 + st; int row;
          if (p < CTX) row = NLAT + b * CTX + (dir ? CTX - 1 - p : p); else { const int q = p - CTX; row = b * SEQ + (dir ? SEQ - 1 - q : q); }
          const u32x4 w = *(const u32x4*)(CQK + (size_t)row * 512 + (pc < 8 ? h * 64 + pc * 8 : 256 + h * 64 + (pc - 8) * 8));
          float* dst = pc < 8 ? &qs[st][pc * 8] : &ks[st][(pc - 8) * 8];
          dst[0] = bflo(w.x); dst[1] = bfhi(w.x); dst[2] = bflo(w.y); dst[3] = bfhi(w.y); dst[4] = bflo(w.z); dst[5] = bfhi(w.z); dst[6] = bflo(w.w); dst[7] = bfhi(w.w); }
        __syncthreads();
        for (int st = 0; st < 8; ++st) {
            const int p = p0 + st; int row;
            if (p < CTX) row = NLAT + b * CTX + (dir ? CTX - 1 - p : p); else { const int q = p - CTX; row = b * SEQ + (dir ? SEQ - 1 - q : q); }
            const float ig = GATES[(size_t)row * 16 + dir * 4 + h], lf = GATES[(size_t)row * 16 + 8 + dir * 4 + h];
            const float v = bf2f(P[(size_t)row * PW + PC_V + h * 128 + tid]);
            const float mn = fmaxf(lf + m, ig), a = __expf(lf + m - mn), w = __expf(ig - mn), wv = w * v; m = mn;
            float num = 0.f, den = 0.f;
#pragma unroll
            for (int d = 0; d < 64; ++d) { const float kd = ks[st][d], qd = qs[st][d]; C[d] = a * C[d] + wv * kd; n[d] = a * n[d] + w * kd; num += C[d] * qd; den += n[d] * qd; }
            OUT[(size_t)row * D + h * 128 + tid] = num / fmaxf(fabsf(den), __expf(-mn));
        }
    }
}
__global__ void __launch_bounds__(128) naive_hgrn(const bf16* CQI, const bf16* P, const float* fb_l, const float* lbraw, int l, float* HF, float* HB) {
    __shared__ float fs[8][128], ks[8][128], qs[8][128];
    const int b = blockIdx.x >> 3, h = (blockIdx.x >> 1) & 3, dir = blockIdx.x & 1, tid = threadIdx.x, ch = h * 128 + tid;
    float S[128];
#pragma unroll
    for (int d = 0; d < 128; ++d) S[d] = 0.f;
    float lb = 0.f;
    if (l == 1) { const float r0 = lbraw[ch], r1 = lbraw[512 + ch], mx = fmaxf(r0, r1), e0 = __expf(r0 - mx), e1 = __expf(r1 - mx); lb = e1 / (e0 + e1); }
    const float bias = fb_l[dir * 512 + ch];
    float* OUT = dir ? HB : HF;
    for (int p0 = 0; p0 < CTX + SEQ; p0 += 8) {
        __syncthreads();
        float vv[8]; int rows[8];
#pragma unroll
        for (int st = 0; st < 8; ++st) { const int p = p0 + st; int row;
            if (p < CTX) row = NLAT + b * CTX + (dir ? CTX - 1 - p : p); else { const int q = p - CTX; row = b * SEQ + (dir ? SEQ - 1 - q : q); }
            rows[st] = row;
            const float z = bf2f(P[(size_t)row * PW + (dir ? PC_FB : PC_FF) + ch]) + bias;
            fs[st][tid] = lb + (1.f - lb) * sigmoidf_(z); ks[st][tid] = (1.f - lb) * sigmoidf_(-z);
            qs[st][tid] = bf2f(CQI[(size_t)row * 1024 + ch]); vv[st] = bf2f(CQI[(size_t)row * 1024 + 512 + ch]); }
        __syncthreads();
#pragma unroll
        for (int st = 0; st < 8; ++st) { float o = 0.f; const float v = vv[st];
#pragma unroll
            for (int d = 0; d < 128; ++d) { S[d] = fs[st][d] * S[d] + ks[st][d] * v; o += qs[st][d] * S[d]; }
            OUT[(size_t)rows[st] * D + 512 + ch] = o; }
    }
}

extern "C" void kernel_launch(void* const* d_in, const int* in_sizes, int n_in, void* d_out, int out_size, void* d_ws, size_t ws_size, hipStream_t stream) {
    static int grid = 0;
    if (grid == 0) {
        if (n_in != 24 || in_sizes[0] != NLAT * D || out_size != NLAT * D || ws_size < WS_END) { fprintf(stderr, "kernel_launch: unexpected shapes n_in %d in0 %d out %d ws %zu (need %zu)\n", n_in, n_in > 0 ? in_sizes[0] : -1, out_size, ws_size, (size_t)WS_END); grid = -1; return; }
        int dev = 0, cus = 0;
        if (hipGetDevice(&dev) != hipSuccess || hipDeviceGetAttribute(&cus, hipDeviceAttributeMultiprocessorCount, dev) != hipSuccess) { grid = -1; return; }
        if (hipFuncSetAttribute((const void*)fwd, hipFuncAttributeMaxDynamicSharedMemorySize, LDS_BYTES) != hipSuccess) { fprintf(stderr, "kernel_launch: hipFuncSetAttribute failed\n"); grid = -1; return; }
        grid = cus;
    }
    if (grid < 0) return;
    (void)hipMemsetAsync((char*)d_ws + WS_CTL, 0, 1 * MiB, stream);
    Args a{};
    for (int i = 0; i < 24; ++i) a.in[i] = (const float*)d_in[i];
    a.out = (float*)d_out; a.ws = (unsigned char*)d_ws; a.ph_lo = 0; a.ph_hi = 0;
    unsigned char* ws = (unsigned char*)d_ws;
    const float* const* in = a.in;
    int* rt = (int*)(ws + WS_ROUTE);
    a.ph_lo = 0; a.ph_hi = NPHASE;
    hipLaunchKernelGGL(fwd, dim3(grid), dim3(NTHR), LDS_BYTES, stream, a);
}
```
